# Optimizing an MI355X kernel written in HIP

```python
import math
import jax, jax.numpy as jnp
from jax import lax
import numpy as np

D_MODEL = 1024
BATCH = 32
SEQ = 2048
DEPTH = 1
DEC_BATCH = 128
DEC_SEQ = 4
PAST_LEN = 8192
PAGE_SIZE = 128

HEAD_DIM = 128
SWA_GROUPS = ((128, 1), (512, 4), (2048, 16))
N_SWA = 3
SWA_HEADS = 4
SWA_BAND = 128
GLA_HEADS = 4
GLA_DK = 64
GLA_DV = 128
GLA_RANK = 16
GLA_TAU = 16.0
GLA_CHUNK = 64
MEM_LEN = 256
MEM_HEADS = 4
BRANCH_W = 512
N_BRANCH = 3
D_FF = 2816
ROPE_THETA = 10000.0
EPS = 1e-6
NEG = -1e30

SPLIT_SIZES = (3 * N_SWA * SWA_HEADS * HEAD_DIM,
               GLA_HEADS * GLA_DK,
               GLA_HEADS * GLA_DK,
               GLA_HEADS * GLA_DV,
               GLA_HEADS * GLA_DV,
               GLA_RANK,
               MEM_HEADS * HEAD_DIM)
SPLIT_POINTS = tuple(sum(SPLIT_SIZES[:i + 1]) for i in range(len(SPLIT_SIZES) - 1))
D_IN = sum(SPLIT_SIZES)

kernel_name = 'hybrid_dilated_gla_memory_decode_step'


def _rmsnorm(x, g):
    xf = x.astype(jnp.float32)
    y = xf * lax.rsqrt(jnp.mean(xf * xf, axis=-1, keepdims=True) + EPS)
    return (y * g.astype(jnp.float32)).astype(x.dtype)


def _swiglu(x, w_in, w_out):
    a, b = jnp.split(x @ w_in, 2, axis=-1)
    return (jax.nn.silu(a) * b) @ w_out


def _rope(x, pos):
    half = HEAD_DIM // 2
    inv = ROPE_THETA ** (-jnp.arange(half, dtype=jnp.float32) / half)
    ang = pos.astype(jnp.float32)[:, None] * inv[None, :]
    shape = (1, ang.shape[0]) + (1,) * (x.ndim - 3) + (half,)
    cos = jnp.cos(ang).reshape(shape)
    sin = jnp.sin(ang).reshape(shape)
    xf = x.astype(jnp.float32)
    x1, x2 = xf[..., :half], xf[..., half:]
    return jnp.concatenate([x1 * cos - x2 * sin, x2 * cos + x1 * sin], axis=-1).astype(x.dtype)


def _dilated_prompt(q, k, v, dil):
    B, S, H, E = q.shape
    M = S // dil
    nb = -(-M // SWA_BAND)
    Mp = nb * SWA_BAND

    def strided(t, front):
        t = t.astype(jnp.float32).reshape(B, M, dil, H, E)
        return jnp.pad(t, ((0, 0), (front, Mp - M), (0, 0), (0, 0), (0, 0)))

    def band(t):
        t = strided(t, SWA_BAND).reshape(B, nb + 1, SWA_BAND, dil, H, E)
        return jnp.concatenate([t[:, :-1], t[:, 1:]], axis=2)

    qb = strided(q, 0).reshape(B, nb, SWA_BAND, dil, H, E)
    kb, vb = band(k), band(v)
    s = jnp.einsum('bnqrhe,bnkrhe->bnrhqk', qb, kb) * (E ** -0.5)
    qi = jnp.arange(SWA_BAND)[:, None]
    kj = jnp.arange(2 * SWA_BAND)[None, :]
    dist = SWA_BAND + qi - kj
    key_m = jnp.arange(nb)[:, None, None] * SWA_BAND + kj[None] - SWA_BAND
    valid = (dist >= 0)[None] & (dist <= SWA_BAND)[None] & (key_m >= 0)
    s = jnp.where(valid[None, :, None, None], s, NEG)
    lse = jax.nn.logsumexp(s, axis=-1)
    p = jnp.exp(s - lse[..., None])
    o = jnp.einsum('bnrhqk,bnkrhe->bnqrhe', p, vb)
    o = o.reshape(B, Mp, dil, H, E)[:, :M].reshape(B, S, H, E)
    lse = lse.transpose(0, 1, 4, 2, 3).reshape(B, Mp, dil, H)[:, :M].reshape(B, S, H)
    return o, lse


def _dilated_sample(q, k, v, buf, dil):
    L = buf.shape[1]
    T = q.shape[1]
    k_all = jnp.concatenate([buf[:, :, 0].astype(jnp.float32), k.astype(jnp.float32)], axis=1)
    v_all = jnp.concatenate([buf[:, :, 1].astype(jnp.float32), v.astype(jnp.float32)], axis=1)
    idx = L + jnp.arange(T)[:, None] - dil * jnp.arange(SWA_BAND + 1)[None, :]
    valid = idx >= 0
    idx = jnp.maximum(idx, 0)
    kg = k_all[:, idx]
    vg = v_all[:, idx]
    s = jnp.einsum('bthe,btnhe->bthn', q.astype(jnp.float32), kg) * (q.shape[-1] ** -0.5)
    s = jnp.where(valid[None, :, None, :], s, NEG)
    lse = jax.nn.logsumexp(s, axis=-1)
    p = jnp.exp(s - lse[..., None])
    o = jnp.einsum('bthn,btnhe->bthe', p, vg)
    return o, lse


def _gla(q, k, v, log_a, s0):
    B, T, H, DK = q.shape
    C = GLA_CHUNK if T % GLA_CHUNK == 0 else T
    nc = T // C

    def chunks(t):
        return t.astype(jnp.float32).reshape((B, nc, C) + t.shape[2:]).swapaxes(0, 1)

    causal = jnp.tril(jnp.ones((C, C), dtype=bool))

    def step(s, inp):
        qc, kc, vc, lc = inp
        b = jnp.cumsum(lc, axis=1)
        b_end = b[:, -1]
        qe = qc * jnp.exp(b)
        ke = kc * jnp.exp(-b)
        att = jnp.where(causal, jnp.einsum('bihk,bjhk->bhij', qe, ke), 0.0)
        o = jnp.einsum('bchk,bhkv->bchv', qe, s) + jnp.einsum('bhij,bjhv->bihv', att, vc)
        kd = kc * jnp.exp(b_end[:, None] - b)
        s = s * jnp.exp(b_end)[..., None] + jnp.einsum('bchk,bchv->bhkv', kd, vc)
        return s, o

    s, o = lax.scan(step, s0.astype(jnp.float32), (chunks(q), chunks(k), chunks(v), chunks(log_a)))
    return o.swapaxes(0, 1).reshape(B, T, H, v.shape[-1]), s


def _mem_kv(mem, g_mem, w_mem_kv):
    B = mem.shape[0]
    return (_rmsnorm(mem, g_mem) @ w_mem_kv).reshape(B, MEM_LEN, 2, MEM_HEADS, HEAD_DIM)


def _mem_attend(q, kv):
    s = jnp.einsum('bthe,bmhe->bhtm', q.astype(jnp.float32), kv[:, :, 0].astype(jnp.float32)) * (HEAD_DIM ** -0.5)
    p = jax.nn.softmax(s, axis=-1)
    return jnp.einsum('bhtm,bmhe->bthe', p, kv[:, :, 1].astype(jnp.float32))


def _layer(x, pos, mem_kv, gla_s0, swa_bufs, g_ffn1, w_ffn1_in, w_ffn1_out, g_mix, w_in,
           w_gla_a2, b_gla_a, g_gla_out, w_gate, w_branch, w_out, g_ffn2, w_ffn2_in, w_ffn2_out):
    B, T, _ = x.shape
    h = x + 0.5 * _swiglu(_rmsnorm(x, g_ffn1), w_ffn1_in, w_ffn1_out)
    u = _rmsnorm(h, g_mix)
    z_swa, z_gq, z_gk, z_gv, z_gr, z_ga, z_mq = jnp.split(u @ w_in, SPLIT_POINTS, axis=-1)

    qkv = z_swa.reshape(B, T, 3, N_SWA, SWA_HEADS, HEAD_DIM)
    q = _rope(qkv[:, :, 0], pos)
    k = _rope(qkv[:, :, 1], pos)
    v = qkv[:, :, 2]
    outs, lses, rows = [], [], []
    for g, (win, dil) in enumerate(SWA_GROUPS):
        if swa_bufs is None:
            o_g, lse_g = _dilated_prompt(q[:, :, g], k[:, :, g], v[:, :, g], dil)
            keep = min(win, T)
            rows.append(jnp.stack([k[:, T - keep:, g], v[:, T - keep:, g]], axis=2))
        else:
            o_g, lse_g = _dilated_sample(q[:, :, g], k[:, :, g], v[:, :, g], swa_bufs[g], dil)
            rows.append(jnp.stack([k[:, :, g], v[:, :, g]], axis=2))
        outs.append(o_g)
        lses.append(lse_g)
    wgt = jax.nn.softmax(jnp.stack(lses, axis=0), axis=0)
    o_swa = jnp.sum(wgt[..., None] * jnp.stack(outs, axis=0), axis=0).reshape(B, T, BRANCH_W).astype(x.dtype)

    gq = z_gq.reshape(B, T, GLA_HEADS, GLA_DK) * (GLA_DK ** -0.5)
    gk = z_gk.reshape(B, T, GLA_HEADS, GLA_DK)
    gv = z_gv.reshape(B, T, GLA_HEADS, GLA_DV)
    gr = z_gr.reshape(B, T, GLA_HEADS, GLA_DV)
    log_a = jax.nn.log_sigmoid((z_ga @ w_gla_a2 + b_gla_a).astype(jnp.float32)) / GLA_TAU
    o_g, gla_state = _gla(gq, gk, gv, log_a.reshape(B, T, GLA_HEADS, GLA_DK), gla_s0)
    o_gla = (_rmsnorm(o_g, g_gla_out) * jax.nn.silu(gr.astype(jnp.float32))).reshape(B, T, BRANCH_W).astype(x.dtype)

    mq = z_mq.reshape(B, T, MEM_HEADS, HEAD_DIM)
    o_mem = _mem_attend(mq, mem_kv).reshape(B, T, BRANCH_W).astype(x.dtype)

    gates = jax.nn.sigmoid(u @ w_gate).reshape(B, T, N_BRANCH, D_MODEL)
    br = jnp.einsum('btnc,ncd->btnd', jnp.stack([o_swa, o_gla, o_mem], axis=2), w_branch)
    h = h + jnp.sum(gates * br, axis=2) @ w_out

    h = h + 0.5 * _swiglu(_rmsnorm(h, g_ffn2), w_ffn2_in, w_ffn2_out)
    return h, rows, gla_state


def setup_inputs(seed: int = 0) -> dict:
    key = jax.random.key(seed)
    ks = jax.random.split(key, 32)
    f32 = jnp.float32

    def nrm(k, shape, scale):
        return jax.random.normal(k, shape, f32) * scale

    def gain(k, n):
        return 1.0 + 0.02 * jax.random.normal(k, (DEPTH, n), f32)

    lens = [min(w, PAST_LEN) for w, _ in SWA_GROUPS]
    return {
        'x_prompt': nrm(ks[0], (BATCH, SEQ, D_MODEL), 1.0),
        'x_sample': nrm(ks[1], (DEC_BATCH, DEC_SEQ, D_MODEL), 1.0),
        'mem_prompt': nrm(ks[2], (BATCH, MEM_LEN, D_MODEL), 1.0),
        'cache_swa0': nrm(ks[3], (DEPTH, DEC_BATCH, lens[0], 2, SWA_HEADS, HEAD_DIM), 1.0),
        'cache_swa1': nrm(ks[4], (DEPTH, DEC_BATCH, lens[1], 2, SWA_HEADS, HEAD_DIM), 1.0),
        'cache_swa2': nrm(ks[5], (DEPTH, DEC_BATCH, lens[2], 2, SWA_HEADS, HEAD_DIM), 1.0),
        'cache_mem_kv': nrm(ks[6], (DEPTH, DEC_BATCH, MEM_LEN, 2, MEM_HEADS, HEAD_DIM), 1.0),
        'state_gla': nrm(ks[7], (DEPTH, DEC_BATCH, GLA_HEADS, GLA_DK, GLA_DV), 0.5),
        'g_ffn1': gain(ks[8], D_MODEL),
        'w_ffn1_in': nrm(ks[9], (DEPTH, D_MODEL, 2 * D_FF), D_MODEL ** -0.5),
        'w_ffn1_out': nrm(ks[10], (DEPTH, D_FF, D_MODEL), D_FF ** -0.5),
        'g_mix': gain(ks[11], D_MODEL),
        'w_in': nrm(ks[12], (DEPTH, D_MODEL, D_IN), D_MODEL ** -0.5),
        'w_gla_a2': nrm(ks[13], (DEPTH, GLA_RANK, GLA_HEADS * GLA_DK), GLA_RANK ** -0.5),
        'b_gla_a': nrm(ks[14], (DEPTH, GLA_HEADS * GLA_DK), 0.1),
        'g_gla_out': gain(ks[15], GLA_DV),
        'w_gate': nrm(ks[16], (DEPTH, D_MODEL, N_BRANCH * D_MODEL), D_MODEL ** -0.5),
        'w_branch': nrm(ks[17], (DEPTH, N_BRANCH, BRANCH_W, D_MODEL), BRANCH_W ** -0.5),
        'w_out': nrm(ks[18], (DEPTH, D_MODEL, D_MODEL), D_MODEL ** -0.5),
        'g_mem': gain(ks[19], D_MODEL),
        'w_mem_kv': nrm(ks[20], (DEPTH, D_MODEL, 2 * MEM_HEADS * HEAD_DIM), D_MODEL ** -0.5),
        'g_ffn2': gain(ks[21], D_MODEL),
        'w_ffn2_in': nrm(ks[22], (DEPTH, D_MODEL, 2 * D_FF), D_MODEL ** -0.5),
        'w_ffn2_out': nrm(ks[23], (DEPTH, D_FF, D_MODEL), D_FF ** -0.5),
        'g_final': 1.0 + 0.02 * jax.random.normal(ks[24], (D_MODEL,), f32),
    }


def reference(x_prompt, x_sample, mem_prompt, cache_swa0, cache_swa1, cache_swa2, cache_mem_kv, state_gla,
              g_ffn1, w_ffn1_in, w_ffn1_out, g_mix, w_in, w_gla_a2, b_gla_a, g_gla_out, w_gate, w_branch,
              w_out, g_mem, w_mem_kv, g_ffn2, w_ffn2_in, w_ffn2_out, g_final):
    pos_p = jnp.arange(x_prompt.shape[1], dtype=jnp.int32)
    pos_s = PAST_LEN + jnp.arange(x_sample.shape[1], dtype=jnp.int32)
    hp, hs = x_prompt, x_sample
    swa_p = [[] for _ in range(N_SWA)]
    swa_s = [[] for _ in range(N_SWA)]
    memkv_p, gla_p, gla_s = [], [], []
    for l in range(DEPTH):
        lw = (g_ffn1[l], w_ffn1_in[l], w_ffn1_out[l], g_mix[l], w_in[l], w_gla_a2[l], b_gla_a[l],
              g_gla_out[l], w_gate[l], w_branch[l], w_out[l], g_ffn2[l], w_ffn2_in[l], w_ffn2_out[l])
        kv_p = _mem_kv(mem_prompt, g_mem[l], w_mem_kv[l])
        s0 = jnp.zeros((x_prompt.shape[0], GLA_HEADS, GLA_DK, GLA_DV), jnp.float32)
        hp, rows_p, st_p = _layer(hp, pos_p, kv_p, s0, None, *lw)
        hs, rows_s, st_s = _layer(hs, pos_s, cache_mem_kv[l], state_gla[l],
                                  (cache_swa0[l], cache_swa1[l], cache_swa2[l]), *lw)
        for g in range(N_SWA):
            swa_p[g].append(rows_p[g])
            swa_s[g].append(rows_s[g])
        memkv_p.append(kv_p)
        gla_p.append(st_p)
        gla_s.append(st_s)
    y_prompt = _rmsnorm(hp, g_final)
    y_sample = _rmsnorm(hs, g_final)
    return (y_prompt, y_sample,
            jnp.stack(swa_p[0]), jnp.stack(swa_p[1]), jnp.stack(swa_p[2]), jnp.stack(memkv_p), jnp.stack(gla_p),
            jnp.stack(swa_s[0]), jnp.stack(swa_s[1]), jnp.stack(swa_s[2]), jnp.stack(gla_s))
```

```cpp
#include <hip/hip_runtime.h>
#include <cstdio>
#include <cstdint>

#ifndef MK_N_LAUNCHES
#define MK_N_LAUNCHES 11
#endif

#ifndef MK_STOP_AFTER
#define MK_STOP_AFTER 10
#endif
#define GAS __attribute__((address_space(1)))
#define LAS __attribute__((address_space(3)))
typedef unsigned short bf16;
typedef unsigned v4u __attribute__((ext_vector_type(4)));
typedef unsigned v2u __attribute__((ext_vector_type(2)));
typedef float f32x4 __attribute__((ext_vector_type(4)));
typedef float f32x2 __attribute__((ext_vector_type(2)));
typedef short bf16x8 __attribute__((ext_vector_type(8)));
typedef short s16x4 __attribute__((ext_vector_type(4)));
typedef GAS unsigned gu32;

constexpr int D = 1024, NB = 32, SEQ = 2048, DECB = 128, DECT = 4, PAST = 8192, MEML = 256;
constexpr int MP = NB * SEQ;
constexpr int MS = DECB * DECT;
constexpr int MR = MP + MS;
constexpr int MM = NB * MEML;
constexpr int FF = 2816, NZ = 9984;
constexpr int DIN = 6672;
constexpr int NPOS = SEQ + DECT;
constexpr float EPS = 1e-6f;
constexpr float QSCALE = 0.08838834764831845f * 1.4426950408889634f;
constexpr float LN2 = 0.6931471805599453f;

constexpr size_t O_Y = 0, O_YS = (size_t)MP * D, O_SWA0P = O_YS + (size_t)MS * D, O_SWA1P = O_SWA0P + (size_t)NB * 128 * 1024, O_SWA2P = O_SWA1P + (size_t)NB * 512 * 1024,
                 O_MEMKV = O_SWA2P + (size_t)NB * 2048 * 1024, O_GLAP = O_MEMKV + (size_t)MM * 1024, O_SWA0S = O_GLAP + (size_t)NB * 4 * 64 * 128, O_SWA1S = O_SWA0S + (size_t)MS * 1024,
                 O_SWA2S = O_SWA1S + (size_t)MS * 1024, O_GLAS = O_SWA2S + (size_t)MS * 1024, O_END = O_GLAS + (size_t)DECB * 4 * 64 * 128;
static_assert(O_END == 170917888ull, "output size");

constexpr size_t MiB = 1u << 20;
constexpr size_t al(size_t x) { return (x + 2 * MiB - 1) / (2 * MiB) * (2 * MiB); }
constexpr size_t WS_CTL = 0, CTL_ZERO_BYTES = 1 * MiB;
constexpr size_t WS_ROPE = 2 * MiB;
constexpr size_t WS_PQ1 = WS_ROPE + al((size_t)NPOS * 64 * 4 * 2);
constexpr size_t WS_PQ2 = WS_PQ1 + al((size_t)MR * 16 * 4);
constexpr size_t WS_W1A = WS_PQ2 + al((size_t)MR * 16 * 4);
constexpr size_t WS_W1O = WS_W1A + al((size_t)2 * FF * D * 2);
constexpr size_t WS_WIN = WS_W1O + al((size_t)D * FF * 2);
constexpr size_t WS_WBR = WS_WIN + al((size_t)NZ * D * 2);
constexpr size_t WS_WOUT = WS_WBR + al((size_t)3 * D * 512 * 2);
constexpr size_t WS_W2A = WS_WOUT + al((size_t)D * D * 2);
constexpr size_t WS_W2O = WS_W2A + al((size_t)2 * FF * D * 2);
constexpr size_t WS_WMEM = WS_W2O + al((size_t)D * FF * 2);
constexpr size_t WS_XB = WS_WMEM + al((size_t)D * D * 2);
constexpr size_t WS_MEMB = WS_XB + al((size_t)MR * D * 2);
constexpr size_t WS_MKV = WS_MEMB + al((size_t)MM * D * 2);
constexpr size_t WS_G = WS_MKV + al((size_t)MM * D * 2);
constexpr size_t WS_H = WS_G + al((size_t)MR * FF * 2);
constexpr size_t WS_HB = WS_H + al((size_t)MR * D * 4);
constexpr size_t WS_QS = WS_HB + al((size_t)MR * D * 2);
constexpr size_t WS_KS = WS_QS + al((size_t)MR * 1536 * 2);
constexpr size_t WS_VS = WS_KS + al((size_t)MR * 1536 * 2);
constexpr size_t WS_GQ = WS_VS + al((size_t)MR * 1536 * 2);
constexpr size_t WS_GK = WS_GQ + al((size_t)MR * 256 * 2);
constexpr size_t WS_GV = WS_GK + al((size_t)MR * 256 * 2);
constexpr size_t WS_GRS = WS_GV + al((size_t)MR * 512 * 2);
constexpr size_t WS_GA = WS_GRS + al((size_t)MR * 512 * 2);
constexpr size_t WS_MQ = WS_GA + al((size_t)MR * 256 * 4);
constexpr size_t WS_GATE = WS_MQ + al((size_t)MR * 512 * 2);
constexpr size_t WS_OG = WS_GATE + al((size_t)MR * 3072 * 2);
constexpr size_t WS_LSE = WS_OG + al((size_t)MR * 1536 * 2);
constexpr size_t WS_GO = WS_LSE + al((size_t)MR * 12 * 4);
constexpr size_t WS_OALL = WS_GO + al((size_t)MR * 512 * 4);
constexpr size_t WS_END = WS_OALL + al((size_t)MR * 1536 * 2);
constexpr size_t WS_T = WS_G, WS_MB = WS_XB;
static_assert((size_t)MR * D * 4 <= (size_t)MR * FF * 2, "T fits in G");

constexpr int CW_TMO = 0, CW_CODE = 1, CW_BAR = 4096;

constexpr int RING_OFF = 0, RING_BYTES = 131072;
constexpr int LDSCTL_OFF = RING_BYTES, MISC_OFF = LDSCTL_OFF + 320;
constexpr int LDS_BYTES = 147456;
constexpr int NWAVES = 8;

#define RLX_AGENT __ATOMIC_RELAXED, __HIP_MEMORY_SCOPE_AGENT
#define LDS_WAIT() asm volatile("s_waitcnt lgkmcnt(0)" ::: "memory")
#define VM_WAIT() asm volatile("s_waitcnt vmcnt(0)" ::: "memory")
__device__ __forceinline__ unsigned f2bf(float f) { unsigned u = __builtin_bit_cast(unsigned, f); return (u + 0x7fffu + ((u >> 16) & 1u)) >> 16; }
__device__ __forceinline__ unsigned pk2(float lo, float hi) { return f2bf(lo) | (f2bf(hi) << 16); }
__device__ __forceinline__ float bf2f(unsigned b) { return __builtin_bit_cast(float, b << 16); }
__device__ __forceinline__ float bflo(unsigned w) { return __builtin_bit_cast(float, w << 16); }
__device__ __forceinline__ float bfhi(unsigned w) { return __builtin_bit_cast(float, w & 0xffff0000u); }
typedef __bf16 bf16x2_t __attribute__((ext_vector_type(2)));
__device__ __forceinline__ unsigned cvt_pk_bf16(float lo, float hi) { const f32x2 v = {lo, hi}; const bf16x2_t b = __builtin_convertvector(v, bf16x2_t); return __builtin_bit_cast(unsigned, b); }
__device__ __forceinline__ float fast_exp2(float x) { return __builtin_amdgcn_exp2f(x); }
__device__ __forceinline__ float fast_rcp(float x) { return __builtin_amdgcn_rcpf(x); }
__device__ __forceinline__ float fast_log2(float x) { return __builtin_amdgcn_logf(x); }
__device__ __forceinline__ float sigmoidf_(float x) { return fast_rcp(1.0f + fast_exp2(-1.4426950408889634f * x)); }
__device__ __forceinline__ float siluf_(float x) { return x * sigmoidf_(x); }
__device__ __forceinline__ int perm32(int rho) { return 8 * ((rho >> 2) & 3) + 4 * (rho >> 4) + (rho & 3); }
__device__ __forceinline__ int sig_plain(int r) { return (r & ~31) + perm32(r & 31); }
__device__ __forceinline__ int sig_rope(int r7) { return 64 * ((r7 >> 4) & 1) + 16 * (r7 >> 5) + 4 * ((r7 >> 2) & 3) + (r7 & 3); }

namespace pg8 {
constexpr int BM = 256, BK = 64, HALF = 128, HTB = HALF * BK * 2, STAGE_BYTES = 8 * HTB, NXCD = 8, WGM = 8;
__host__ __device__ __forceinline__ int lds_byte(int r, int c) { const int st = (r >> 4) * 2 + (c >> 5), rr = r & 15, cc = c & 31, ob = rr * 64 + cc * 2; return st * 1024 + (ob ^ (((ob >> 9) & 1) << 5)); }
__host__ __device__ __forceinline__ void stage_rc(int b, int& R, int& C) { const int st = b / 1024, sb = b % 1024, swz = sb ^ (((sb >> 9) & 1) << 5); R = (st >> 1) * 16 + swz / 64; C = (st & 1) * 32 + (swz % 64) / 2; }
struct Unit { int pm, pn; };
struct Gemm { const bf16* A; const bf16* Bt; int M, N, K, lda; };
struct StaticOrder {
    int nM, nN, nwg, G, c;
    __host__ __device__ void init(int M, int N, int G_, int c_) { nM = M / BM; nN = N / BM; nwg = nM * nN; G = G_; c = c_; }
    __host__ __device__ bool next(int i, Unit& u) const {
        const long L = (long)i * G + c; if (L >= nwg) return false;
        int wgid = (int)L; { const int q = nwg / NXCD, r = nwg % NXCD, xcd = wgid % NXCD, off = wgid / NXCD; wgid = (xcd < r ? xcd * (q + 1) : r * (q + 1) + (xcd - r) * q) + off; }
        const int nig = WGM * nN, gid = wgid / nig, fm = gid * WGM, gsz = (nM - fm) < WGM ? (nM - fm) : WGM;
        u.pm = fm + ((wgid % nig) % gsz); u.pn = (wgid % nig) / gsz; return true;
    }
};
template <class Epi, class Sched, bool ALIGN_EPI = true>
__device__ __forceinline__ void gemm_phase(LAS unsigned char* lds, const Gemm g, const Sched& S, const Epi& E) {
    const int tid = threadIdx.x, wid = __builtin_amdgcn_readfirstlane(tid >> 6), lane = tid & 63, wr = wid >> 2, wc = wid & 3, fr = lane & 15, fq = lane >> 4;
    const int K = g.K, nt = K / BK;
    unsigned voffA[2], voffB[2];
#pragma unroll
    for (int i = 0; i < 2; ++i) { int R, C; stage_rc(tid * 16 + i * 8192, R, C); voffA[i] = (unsigned)(R * g.lda + C) * 2u; voffB[i] = (unsigned)(R * K + C) * 2u; }
    const size_t kstep = (size_t)(BK * 2);
    const size_t hA = (size_t)HALF * g.lda * 2, tA = 2 * hA, hB = (size_t)HALF * K * 2, tB = 2 * hB;
    const unsigned ldsw = (unsigned)wid * 1024u;
    const int aoff = lds_byte(wr * 64 + fr, fq * 8), boff = lds_byte(wc * 32 + fr, fq * 8);
#define PG8_SA(b, h) (((b) * 2 + (h)) * HTB)
#define PG8_SB(b, h) ((4 + (b) * 2 + (h)) * HTB)
#define PG8_STAGE(bufoff, gbase, voff) do { _Pragma("unroll") for (int _i = 0; _i < 2; ++_i) \
        __builtin_amdgcn_global_load_lds((const unsigned*)((const char*)(gbase) + (voff)[_i]), (LAS unsigned*)(lds + (bufoff) + ldsw + _i * 8192), 16, 0, 0); } while (0)
#define PG8_LDA(dst, b, h) do { _Pragma("unroll") for (int m = 0; m < 4; ++m) _Pragma("unroll") for (int k = 0; k < 2; ++k) dst[m][k] = *(const LAS bf16x8*)(lds + PG8_SA(b, h) + aoff + m * 2048 + k * 1024); } while (0)
#define PG8_LDB(dst, b, h) do { _Pragma("unroll") for (int n = 0; n < 2; ++n) _Pragma("unroll") for (int k = 0; k < 2; ++k) dst[n][k] = *(const LAS bf16x8*)(lds + PG8_SB(b, h) + boff + n * 2048 + k * 1024); } while (0)
#define PG8_MMA(ai, bj, At, Bt) do { __builtin_amdgcn_s_setprio(1); _Pragma("unroll") for (int m = 0; m < 4; ++m) _Pragma("unroll") for (int n = 0; n < 2; ++n) _Pragma("unroll") for (int k = 0; k < 2; ++k) \
        acc[ai][bj][m][n] = __builtin_amdgcn_mfma_f32_16x16x32_bf16(Bt[n][k], At[m][k], acc[ai][bj][m][n], 0, 0, 0); __builtin_amdgcn_s_setprio(0); } while (0)
#define PG8_WAIT_V(n) asm volatile("s_waitcnt vmcnt(" #n ")" ::: "memory")
#define PG8_WAIT_L(n) asm volatile("s_waitcnt lgkmcnt(" #n ")" ::: "memory")
#define PG8_BAR __builtin_amdgcn_s_barrier()
#define PG8_SCHED __builtin_amdgcn_sched_barrier(0)
    Unit cur, nxt; int ui = 0;
    if (!S.next(0, cur)) return;
    f32x4 acc[2][2][4][2];
#pragma unroll
    for (int a = 0; a < 2; ++a)
#pragma unroll
        for (int b = 0; b < 2; ++b)
#pragma unroll
            for (int m = 0; m < 4; ++m)
#pragma unroll
                for (int n = 0; n < 2; ++n) acc[a][b][m][n] = (f32x4){0.f, 0.f, 0.f, 0.f};
    bf16x8 At[4][2], B0[2][2], B1[2][2];
    const char* cA = (const char*)g.A + (size_t)cur.pm * tA; const char* cB = (const char*)g.Bt + (size_t)cur.pn * tB;
    PG8_STAGE(PG8_SB(0, 0), cB, voffB); PG8_STAGE(PG8_SB(0, 1), cB + hB, voffB); PG8_STAGE(PG8_SA(0, 0), cA, voffA); PG8_STAGE(PG8_SA(0, 1), cA + hA, voffA);
    if (wr == 1) PG8_BAR;
    PG8_WAIT_V(2); PG8_BAR;
    PG8_STAGE(PG8_SB(1, 0), cB + kstep, voffB); PG8_STAGE(PG8_SA(1, 0), cA + kstep, voffA); PG8_STAGE(PG8_SB(1, 1), cB + hB + kstep, voffB);
    PG8_WAIT_V(6); PG8_BAR;
    for (;;) {
        const bool has_next = S.next(ui + 1, nxt);
        const char* nA = has_next ? (const char*)g.A + (size_t)nxt.pm * tA : cA; const char* nB = has_next ? (const char*)g.Bt + (size_t)nxt.pn * tB : cB;
        for (int t = 0; t < nt; t += 2) {
            const bool last = (t == nt - 2);
            const char* a1 = cA + (size_t)(t + 1) * kstep;
            const char* a2 = last ? nA : cA + (size_t)(t + 2) * kstep; const char* b2 = last ? nB : cB + (size_t)(t + 2) * kstep;
            const char* a3 = a2 + kstep; const char* b3 = b2 + kstep;
            PG8_LDB(B0, 0, 0); PG8_LDB(B1, 0, 1); PG8_SCHED; PG8_LDA(At, 0, 0); PG8_STAGE(PG8_SA(1, 1), a1 + hA, voffA);
            PG8_WAIT_V(8); PG8_WAIT_L(0); PG8_BAR; PG8_MMA(0, 0, At, B0); PG8_MMA(0, 1, At, B1); PG8_BAR; PG8_SCHED;
            PG8_LDA(At, 0, 1); PG8_STAGE(PG8_SB(0, 0), b2, voffB); PG8_STAGE(PG8_SB(0, 1), b2 + hB, voffB); PG8_STAGE(PG8_SA(0, 0), a2, voffA);
            PG8_WAIT_V(8); PG8_WAIT_L(0); PG8_BAR; PG8_MMA(1, 0, At, B0); PG8_MMA(1, 1, At, B1); PG8_BAR; PG8_SCHED;
            PG8_LDB(B0, 1, 0); PG8_LDB(B1, 1, 1); PG8_SCHED; PG8_LDA(At, 1, 0); PG8_STAGE(PG8_SA(0, 1), a2 + hA, voffA);
            PG8_WAIT_V(8); PG8_WAIT_L(0); PG8_BAR; PG8_MMA(0, 0, At, B0); PG8_MMA(0, 1, At, B1); PG8_BAR; PG8_SCHED;
            PG8_LDA(At, 1, 1); PG8_STAGE(PG8_SB(1, 0), b3, voffB); PG8_STAGE(PG8_SB(1, 1), b3 + hB, voffB); PG8_STAGE(PG8_SA(1, 0), a3, voffA);
            PG8_WAIT_V(8); PG8_WAIT_L(0); PG8_BAR; PG8_MMA(1, 0, At, B0); PG8_MMA(1, 1, At, B1); PG8_BAR; PG8_SCHED;
        }
        if constexpr (ALIGN_EPI) { if (wr == 0) PG8_BAR; }
        E(acc, cur, wr, wc, fr, fq);
        if (!has_next) break;
#pragma unroll
        for (int a = 0; a < 2; ++a)
#pragma unroll
            for (int b = 0; b < 2; ++b)
#pragma unroll
                for (int m = 0; m < 4; ++m)
#pragma unroll
                    for (int n = 0; n < 2; ++n) acc[a][b][m][n] = (f32x4){0.f, 0.f, 0.f, 0.f};
        cur = nxt; cA = nA; cB = nB; ++ui;
        if constexpr (ALIGN_EPI) { if (wr == 1) PG8_BAR; }
    }
    PG8_WAIT_V(0);
    if constexpr (!ALIGN_EPI) { if (wr == 0) PG8_BAR; }
    PG8_BAR;
#undef PG8_SA
#undef PG8_SB
#undef PG8_STAGE
#undef PG8_LDA
#undef PG8_LDB
#undef PG8_MMA
#undef PG8_WAIT_V
#undef PG8_WAIT_L
#undef PG8_BAR
#undef PG8_SCHED
}
}
using pg8::Unit;

typedef const f32x4 (&AccRef)[2][2][4][2];
struct EpiSwiglu {
    bf16* G; const float* pq;
    __device__ __forceinline__ void operator()(AccRef acc, const Unit& u, int wr, int wc, int fr, int fq) const {
        const int row0 = u.pm * 256 + wr * 64 + fr, j0 = u.pn * 128 + wc * 32 + 8 * fq;
#pragma unroll
        for (int ai = 0; ai < 2; ++ai)
#pragma unroll
            for (int m = 0; m < 4; ++m) {
                const int row = row0 + ai * 128 + m * 16; float s = 1.f;
                if (pq) { const f32x4 pv = *(const f32x4*)(pq + (size_t)row * 16 + 4 * fq); float t = (pv.x + pv.y) + (pv.z + pv.w); t += __shfl_xor(t, 16); t += __shfl_xor(t, 32); s = __builtin_amdgcn_rsqf(t * (1.f / D) + EPS); }
                float o[8];
#pragma unroll
                for (int n = 0; n < 2; ++n)
#pragma unroll
                    for (int i = 0; i < 4; ++i) { const float a = acc[ai][0][m][n][i] * s, b = acc[ai][1][m][n][i] * s; o[4 * n + i] = siluf_(a) * b; }
                v4u w; w.x = cvt_pk_bf16(o[0], o[1]); w.y = cvt_pk_bf16(o[2], o[3]); w.z = cvt_pk_bf16(o[4], o[5]); w.w = cvt_pk_bf16(o[6], o[7]);
                *(v4u*)(G + (size_t)row * FF + j0) = w;
            }
    }
};
template <bool WRITE_HB, bool WRITE_PQ> struct EpiResid {
    const float* baseP; const float* baseS; float* outP; float* outS; bf16* HB; float* pq; float scale;
    __device__ __forceinline__ void operator()(AccRef acc, const Unit& u, int wr, int wc, int fr, int fq) const {
        const int row0 = u.pm * 256 + wr * 64 + fr, c0 = u.pn * 256 + wc * 32 + 8 * fq; const bool smp = u.pm >= MP / 256;
#pragma unroll
        for (int ai = 0; ai < 2; ++ai)
#pragma unroll
            for (int m = 0; m < 4; ++m) {
                const int row = row0 + ai * 128 + m * 16; const size_t ro = smp ? (size_t)(row - MP) * D : (size_t)row * D;
                const float* bp = (smp ? baseS : baseP) + ro + c0; float* op = (smp ? outS : outP) + ro + c0; float ss = 0.f;
#pragma unroll
                for (int bj = 0; bj < 2; ++bj) {
                    const f32x4 b0 = *(const f32x4*)(bp + bj * 128), b1 = *(const f32x4*)(bp + bj * 128 + 4);
                    const f32x4 o0 = b0 + acc[ai][bj][m][0] * scale, o1 = b1 + acc[ai][bj][m][1] * scale;
                    *(f32x4*)(op + bj * 128) = o0; *(f32x4*)(op + bj * 128 + 4) = o1;
                    if (WRITE_HB) { v4u w; w.x = cvt_pk_bf16(o0.x, o0.y); w.y = cvt_pk_bf16(o0.z, o0.w); w.z = cvt_pk_bf16(o1.x, o1.y); w.w = cvt_pk_bf16(o1.z, o1.w); *(v4u*)(HB + (size_t)row * D + c0 + bj * 128) = w; }
                    if (WRITE_PQ) ss += (o0.x * o0.x + o0.y * o0.y) + (o0.z * o0.z + o0.w * o0.w) + (o1.x * o1.x + o1.y * o1.y) + (o1.z * o1.z + o1.w * o1.w);
                }
                if (WRITE_PQ) { ss += __shfl_xor(ss, 16); ss += __shfl_xor(ss, 32); if (fq == 0) pq[(size_t)row * 16 + u.pn * 4 + wc] = ss; }
            }
    }
};
struct EpiMemKV {
    float* out; bf16* MKV;
    __device__ __forceinline__ void operator()(AccRef acc, const Unit& u, int wr, int wc, int fr, int fq) const {
        const int row0 = u.pm * 256 + wr * 64 + fr, c0 = u.pn * 256 + wc * 32 + 8 * fq;
#pragma unroll
        for (int ai = 0; ai < 2; ++ai)
#pragma unroll
            for (int m = 0; m < 4; ++m) {
                const int row = row0 + ai * 128 + m * 16;
#pragma unroll
                for (int bj = 0; bj < 2; ++bj) { const f32x4 o0 = acc[ai][bj][m][0], o1 = acc[ai][bj][m][1]; float* op = out + (size_t)row * D + c0 + bj * 128;
                    *(f32x4*)op = o0; *(f32x4*)(op + 4) = o1;
                    v4u w; w.x = cvt_pk_bf16(o0.x, o0.y); w.y = cvt_pk_bf16(o0.z, o0.w); w.z = cvt_pk_bf16(o1.x, o1.y); w.w = cvt_pk_bf16(o1.z, o1.w); *(v4u*)(MKV + (size_t)row * D + c0 + bj * 128) = w; }
            }
    }
};
template <int BR> struct EpiMerge {
    const bf16* GATE; float* T; bf16* MB;
    __device__ __forceinline__ void operator()(AccRef acc, const Unit& u, int wr, int wc, int fr, int fq) const {
        const int row0 = u.pm * 256 + wr * 64 + fr, c0 = u.pn * 256 + wc * 32 + 8 * fq;
#pragma unroll
        for (int ai = 0; ai < 2; ++ai)
#pragma unroll
            for (int m = 0; m < 4; ++m) {
                const int row = row0 + ai * 128 + m * 16;
#pragma unroll
                for (int bj = 0; bj < 2; ++bj) {
                    const v4u gw = *(const v4u*)(GATE + (size_t)row * 3072 + BR * 1024 + c0 + bj * 128);
                    float* tp = T + (size_t)row * D + c0 + bj * 128;
                    f32x4 o0 = acc[ai][bj][m][0] * (f32x4){bflo(gw.x), bfhi(gw.x), bflo(gw.y), bfhi(gw.y)}, o1 = acc[ai][bj][m][1] * (f32x4){bflo(gw.z), bfhi(gw.z), bflo(gw.w), bfhi(gw.w)};
#ifndef MK_E3
                    if (BR > 0) { o0 += *(const f32x4*)tp; o1 += *(const f32x4*)(tp + 4); }
#endif
                    if (BR < 2) { *(f32x4*)tp = o0; *(f32x4*)(tp + 4) = o1; }
                    else { v4u w; w.x = cvt_pk_bf16(o0.x, o0.y); w.y = cvt_pk_bf16(o0.z, o0.w); w.z = cvt_pk_bf16(o1.x, o1.y); w.w = cvt_pk_bf16(o1.z, o1.w); *(v4u*)(MB + (size_t)row * D + c0 + bj * 128) = w; }
                }
            }
    }
};
struct EpiZ {
    const float* pq; const float* ropeC; const float* ropeS; const float* bga; float* out;
    bf16 *QS, *KS, *VS, *GQ, *GK, *GV, *GRS, *MQ, *GATE; float* GA;
    template <int ACT> __device__ __forceinline__ void plain(AccRef acc, const float (&rs)[2][4], int row0, bf16* dst, int ld, int col0, float scale) const {
#pragma unroll
        for (int ai = 0; ai < 2; ++ai)
#pragma unroll
            for (int m = 0; m < 4; ++m) { const int row = row0 + ai * 128 + m * 16; const float s = rs[ai][m];
#pragma unroll
                for (int bj = 0; bj < 2; ++bj) { float o[8];
#pragma unroll
                    for (int n = 0; n < 2; ++n)
#pragma unroll
                        for (int i = 0; i < 4; ++i) { const float x = acc[ai][bj][m][n][i] * s; o[4 * n + i] = ACT == 0 ? x * scale : (ACT == 1 ? siluf_(x) : sigmoidf_(x)); }
                    v4u w; w.x = cvt_pk_bf16(o[0], o[1]); w.y = cvt_pk_bf16(o[2], o[3]); w.z = cvt_pk_bf16(o[4], o[5]); w.w = cvt_pk_bf16(o[6], o[7]);
                    *(v4u*)(dst + (size_t)row * ld + col0 + bj * 128) = w; } }
    }
    __device__ __forceinline__ float* swa_dst(int row, int g, int kv, int h) const {
        if (row >= MP) return out + (g == 0 ? O_SWA0S : (g == 1 ? O_SWA1S : O_SWA2S)) + ((size_t)(row - MP) * 2 + kv) * 512 + h * 128;
        const int b = row >> 11, t = row & 2047, keep = 128 << (2 * g), t0 = SEQ - keep;
        if (t < t0) return nullptr;
        return out + (g == 0 ? O_SWA0P : (g == 1 ? O_SWA1P : O_SWA2P)) + (((size_t)b * keep + (t - t0)) * 2 + kv) * 512 + h * 128;
    }
    __device__ __forceinline__ void operator()(AccRef acc, const Unit& u, int wr, int wc, int fr, int fq) const {
        const int row0 = u.pm * 256 + wr * 64 + fr, pn = u.pn, cl = wc * 32 + 8 * fq;
        float rs[2][4];
#pragma unroll
        for (int ai = 0; ai < 2; ++ai)
#pragma unroll
            for (int m = 0; m < 4; ++m) { const int row = row0 + ai * 128 + m * 16;
                const f32x4 pv = *(const f32x4*)(pq + (size_t)row * 16 + 4 * fq); float t = (pv.x + pv.y) + (pv.z + pv.w); t += __shfl_xor(t, 16); t += __shfl_xor(t, 32); rs[ai][m] = __builtin_amdgcn_rsqf(t * (1.f / D) + EPS); }
        if (pn < 12) {
            const int isk = pn >= 6, g = (pn % 6) >> 1, hp = pn & 1, e0 = wc * 16 + 4 * fq;
#pragma unroll
            for (int ai = 0; ai < 2; ++ai)
#pragma unroll
                for (int m = 0; m < 4; ++m) { const int row = row0 + ai * 128 + m * 16; const float s = rs[ai][m];
                    const int pidx = row < MP ? (row & 2047) : SEQ + ((row - MP) & 3);
                    const f32x4 cs = *(const f32x4*)(ropeC + pidx * 64 + e0), sn = *(const f32x4*)(ropeS + pidx * 64 + e0);
#pragma unroll
                    for (int bj = 0; bj < 2; ++bj) { const int h = 2 * hp + bj;
                        const f32x4 x1 = acc[ai][bj][m][0] * s, x2 = acc[ai][bj][m][1] * s;
                        f32x4 r1 = x1 * cs - x2 * sn, r2 = x2 * cs + x1 * sn;
                        if (!isk) { r1 *= QSCALE; r2 *= QSCALE; }
                        bf16* dp = (isk ? KS : QS) + (size_t)row * 1536 + g * 512 + h * 128 + e0;
                        v2u w1, w2; w1.x = cvt_pk_bf16(r1.x, r1.y); w1.y = cvt_pk_bf16(r1.z, r1.w); w2.x = cvt_pk_bf16(r2.x, r2.y); w2.y = cvt_pk_bf16(r2.z, r2.w);
                        *(v2u*)dp = w1; *(v2u*)(dp + 64) = w2;
                        if (isk) { float* fo = swa_dst(row, g, 0, h); if (fo) { *(f32x4*)(fo + e0) = r1; *(f32x4*)(fo + 64 + e0) = r2; } }
                    } }
        } else if (pn < 18) {
            const int g = (pn - 12) >> 1, hp = pn & 1;
#pragma unroll
            for (int ai = 0; ai < 2; ++ai)
#pragma unroll
                for (int m = 0; m < 4; ++m) { const int row = row0 + ai * 128 + m * 16; const float s = rs[ai][m];
#pragma unroll
                    for (int bj = 0; bj < 2; ++bj) { const int h = 2 * hp + bj; const f32x4 o0 = acc[ai][bj][m][0] * s, o1 = acc[ai][bj][m][1] * s;
                        v4u w; w.x = cvt_pk_bf16(o0.x, o0.y); w.y = cvt_pk_bf16(o0.z, o0.w); w.z = cvt_pk_bf16(o1.x, o1.y); w.w = cvt_pk_bf16(o1.z, o1.w);
                        *(v4u*)(VS + (size_t)row * 1536 + g * 512 + h * 128 + cl) = w;
                        float* fo = swa_dst(row, g, 1, h); if (fo) { *(f32x4*)(fo + cl) = o0; *(f32x4*)(fo + cl + 4) = o1; } } }
        } else if (pn == 18) plain<0>(acc, rs, row0, GQ, 256, cl, 0.125f);
        else if (pn == 19) plain<0>(acc, rs, row0, GK, 256, cl, 1.f);
        else if (pn < 22) plain<0>(acc, rs, row0, GV, 512, (pn - 20) * 256 + cl, 1.f);
        else if (pn < 24) plain<1>(acc, rs, row0, GRS, 512, (pn - 22) * 256 + cl, 1.f);
        else if (pn == 24) {
#pragma unroll
            for (int ai = 0; ai < 2; ++ai)
#pragma unroll
                for (int m = 0; m < 4; ++m) { const int row = row0 + ai * 128 + m * 16; const float s = rs[ai][m];
#pragma unroll
                    for (int bj = 0; bj < 2; ++bj)
#pragma unroll
                        for (int n = 0; n < 2; ++n) { const int c = bj * 128 + cl + 4 * n; const f32x4 bv = *(const f32x4*)(bga + c); f32x4 o;
#pragma unroll
                            for (int i = 0; i < 4; ++i) { const float x = acc[ai][bj][m][n][i] * s + bv[i];
                                o[i] = (fminf(x, 0.f) - LN2 * fast_log2(1.f + fast_exp2(-1.4426950408889634f * fabsf(x)))) * (1.f / 16.f); }
                            *(f32x4*)(GA + (size_t)row * 256 + c) = o; } }
        } else if (pn < 27) plain<0>(acc, rs, row0, MQ, 512, (pn - 25) * 256 + cl, QSCALE);
        else plain<2>(acc, rs, row0, GATE, 3072, (pn - 27) * 256 + cl, 1.f);
    }
};

#define XB_TMO      128
#define XB_XCNT(j)  (256  + 64 * (j))
#define XB_XSUB(j)  (1280 + 64 * (j))
#define XB_XGEN(j)  (2304 + 64 * (j))
#define XB_TOP      3328
#define XB_TOPGEN   3392
#define XCD_BAR_WORDS 3456
#define XB_SPIN_CAP (1u << 18)
__device__ __forceinline__ unsigned xb_ld(unsigned* p)              { return __hip_atomic_load(p, __ATOMIC_RELAXED, __HIP_MEMORY_SCOPE_AGENT); }
__device__ __forceinline__ unsigned xb_add(unsigned* p, unsigned v) { return __hip_atomic_fetch_add(p, v, __ATOMIC_RELAXED, __HIP_MEMORY_SCOPE_AGENT); }
__device__ __forceinline__ unsigned xb_xcc_id() { return (unsigned)__builtin_amdgcn_s_getreg((3 << 11) | 20) & 0xFu; }
#define XB_SPIN(cond, bar) do { unsigned _sp = 0; while (cond) { __builtin_amdgcn_s_sleep(1); \
    if ((++_sp & 255u) == 0u) { if (xb_ld(&(bar)[XB_TMO])) break; if (_sp > XB_SPIN_CAP) { atomicAdd(&(bar)[XB_TMO], 1u); break; } } } } while (0)
struct XcdBarrier { unsigned* bar; unsigned x; volatile LAS unsigned* st; };
__device__ __forceinline__ XcdBarrier xcd_barrier_post(unsigned* bar, volatile LAS unsigned* st) {
    XcdBarrier b; b.bar = bar; b.x = xb_xcc_id(); b.st = st;
    if (threadIdx.x == 0) (void)xb_add(&bar[XB_XCNT(b.x)], 1u);
    return b;
}
__device__ __forceinline__ void xcd_barrier_complete(unsigned* bar, unsigned x, unsigned& nloc, unsigned& nx) {
    const unsigned G = gridDim.x * gridDim.y * gridDim.z;
    unsigned sum, cnt, mine, sp = 0u;
    for (;;) {
        sum = 0u; cnt = 0u; mine = 0u;
#pragma unroll
        for (unsigned j = 0; j < 16; ++j) { const unsigned c = xb_ld(&bar[XB_XCNT(j)]); sum += c; cnt += (c > 0u) ? 1u : 0u; mine = (j == x) ? c : mine; }
        if (sum == G) break;
        __builtin_amdgcn_s_sleep(1);
        if ((++sp & 255u) == 0u) { if (xb_ld(&bar[XB_TMO])) break; if (sp > XB_SPIN_CAP) { atomicAdd(&bar[XB_TMO], 1u); break; } }
    }
    nloc = mine > 0u ? mine : 1u; nx = cnt > 0u ? cnt : 1u;
}
__device__ __forceinline__ void xcd_barrier(const XcdBarrier& b) {
    asm volatile("s_waitcnt vmcnt(0)" ::: "memory");
    __syncthreads();
    if (threadIdx.x == 0) {
        unsigned* bar = b.bar;
        __builtin_amdgcn_s_waitcnt(0);
        unsigned nloc = b.st[0], nx = b.st[1];
        if (nloc == 0u) { xcd_barrier_complete(bar, b.x, nloc, nx); b.st[0] = nloc; b.st[1] = nx; }
        const unsigned old = xb_add(&bar[XB_XSUB(b.x)], 1u);
        const unsigned gen = old / nloc;
        if (old + 1u == (gen + 1u) * nloc) {
            __builtin_amdgcn_fence(__ATOMIC_RELEASE, "agent");
            asm volatile("s_waitcnt vmcnt(0)" ::: "memory");
            const unsigned og = xb_add(&bar[XB_TOP], 1u);
            const unsigned tg = og / nx;
            if (og + 1u == (tg + 1u) * nx) xb_add(&bar[XB_TOPGEN], 1u);
            else XB_SPIN(xb_ld(&bar[XB_TOPGEN]) == tg, bar);
            __builtin_amdgcn_fence(__ATOMIC_ACQUIRE, "agent");
            xb_add(&bar[XB_XGEN(b.x)], 1u);
            asm volatile("s_waitcnt vmcnt(0)" ::: "memory");
        } else {
            XB_SPIN(xb_ld(&bar[XB_XGEN(b.x)]) == gen, bar);
            __builtin_amdgcn_fence(__ATOMIC_ACQUIRE, "agent");
            asm volatile("s_waitcnt vmcnt(0)" ::: "memory");
        }
    }
    __syncthreads();
}

struct Args { const float* in[25]; float* out; unsigned char* ws; int ph_lo, ph_hi, li, pad; };
struct Frame {
    LAS unsigned char* lds; int tid, lane, wave, vcu, G;
    const float *i0, *i1, *i2, *i3, *i4, *i5, *i6, *i7, *i8, *i9, *i10, *i11, *i12, *i13, *i14, *i15, *i16, *i17, *i18, *i19, *i20, *i21, *i22, *i23, *i24;
    float* out; unsigned char* ws;
};
__device__ __forceinline__ float wave_sum(float v) {
#pragma unroll
    for (int o = 1; o < 64; o <<= 1) v += __shfl_xor(v, o);
    return v;
}

enum WKind { WK_PLAIN = 0, WK_SWIGLU = 1, WK_IN = 2 };
__device__ __forceinline__ int p0_win_col(int np) {
    const int pn = np >> 8, r = np & 255;
    if (pn < 18) { const int qkv = pn / 6, g = (pn % 6) >> 1, hp = pn & 1, h = 2 * hp + (r >> 7); const int d = qkv < 2 ? sig_rope(r & 127) : sig_plain(r & 127); return ((qkv * 3 + g) * 4 + h) * 128 + d; }
    const int c = sig_plain(r);
    if (pn == 18) return 4608 + c;
    if (pn == 19) return 4864 + c;
    if (pn < 22) return 5120 + (pn - 20) * 256 + c;
    if (pn < 24) return 5632 + (pn - 22) * 256 + c;
    if (pn == 24) return -1 - c;
    if (pn < 27) return 6160 + (pn - 25) * 256 + c;
    return DIN + (pn - 27) * 256 + c;
}
__device__ __forceinline__ void p0_item(const Frame& F, int kind, const float* W, int ldw, const float* W2, const float* gain, const float* a2, bf16* WT, int K, int kb, int nb, LAS float* scr) {
    const int lane = F.lane, k0 = 64 * kb, n0 = 32 * nb, np = n0 + (lane & 31);
    int sc; const float* Wp = W; int ld = ldw;
    if (kind == WK_PLAIN) sc = sig_plain(np);
    else if (kind == WK_SWIGLU) { const int r = np & 255; sc = (r >> 7) * FF + (np >> 8) * 128 + sig_plain(r & 127); }
    else { sc = p0_win_col(np); if (sc >= DIN) { sc -= DIN; Wp = W2; ld = 3072; } }
    if (sc >= 0) {
#pragma unroll 8
        for (int i = 0; i < 32; ++i) { const int kk = 2 * i + (lane >> 5); float v = Wp[(size_t)(k0 + kk) * ld + sc]; if (gain) v *= gain[k0 + kk]; scr[kk * 33 + (lane & 31)] = v; }
    } else {
        const int j = -1 - sc; float a2c[16];
#pragma unroll
        for (int r = 0; r < 16; ++r) a2c[r] = a2[r * 256 + j];
        for (int i = 0; i < 32; ++i) { const int kk = 2 * i + (lane >> 5); const float* wr_ = W + (size_t)(k0 + kk) * ldw + 6144; float v = 0.f;
#pragma unroll
            for (int r = 0; r < 16; ++r) v += wr_[r] * a2c[r];
            scr[kk * 33 + (lane & 31)] = v * gain[k0 + kk]; }
    }
    LDS_WAIT(); asm volatile("" ::: "memory");
    const int c = lane & 7;
#pragma unroll
    for (int j = 0; j < 4; ++j) { const int n = (lane >> 3) + 8 * j; const LAS float* s = scr + (8 * c) * 33 + n;
        v4u o; o.x = pk2(s[0 * 33], s[1 * 33]); o.y = pk2(s[2 * 33], s[3 * 33]); o.z = pk2(s[4 * 33], s[5 * 33]); o.w = pk2(s[6 * 33], s[7 * 33]);
        *(GAS v4u*)(WT + (size_t)(n0 + n) * K + k0 + 8 * c) = o; }
    LDS_WAIT(); asm volatile("" ::: "memory");
}
__device__ __forceinline__ void rms_row_to_bf16(int lane, const float* xrow, const float* gain, bf16* orow) {
    const GAS f32x4* xr = (const GAS f32x4*)xrow + lane; const GAS f32x4* gr = (const GAS f32x4*)gain + lane;
    f32x4 v[4]; float s = 0.f;
#pragma unroll
    for (int j = 0; j < 4; ++j) { v[j] = xr[64 * j]; s += (v[j].x * v[j].x + v[j].y * v[j].y) + (v[j].z * v[j].z + v[j].w * v[j].w); }
    const float rstd = 1.0f / sqrtf(wave_sum(s) * (1.f / D) + EPS);
    GAS v2u* o8 = (GAS v2u*)orow + lane;
#pragma unroll
    for (int j = 0; j < 4; ++j) { const f32x4 gg = gr[64 * j]; v2u w; w.x = pk2(v[j].x * rstd * gg.x, v[j].y * rstd * gg.y); w.y = pk2(v[j].z * rstd * gg.z, v[j].w * rstd * gg.w); o8[64 * j] = w; }
}
__device__ __forceinline__ void sincos_d(double x, double& s, double& c) {
    const double TWO_PI = 6.283185307179586476925286766559;
    const double n = __builtin_rint(x / TWO_PI); const double r = x - n * TWO_PI, r2 = r * r;
    double ts = 1.0, tc = 1.0;
#pragma unroll
    for (int k = 14; k >= 1; --k) { ts = 1.0 - ts * r2 / (double)((2 * k) * (2 * k + 1)); tc = 1.0 - tc * r2 / (double)((2 * k - 1) * (2 * k)); }
    s = ts * r; c = tc;
}
__device__ __forceinline__ void p0_prologue(Frame& F) {
    unsigned char* ws = F.ws;
    LAS float* scr = (LAS float*)(F.lds + RING_OFF + F.wave * 16384);
    const int gw = F.vcu * NWAVES + F.wave, NGW = F.G * NWAVES;
    constexpr int I_A = 16 * 176, I_O = 44 * 32, I_IN = 16 * 312, I_BR = 8 * 32, I_SQ = 16 * 32;
    constexpr int NITEMS = 2 * I_A + 2 * I_O + I_IN + 3 * I_BR + 2 * I_SQ;
    for (int it = gw; it < NITEMS; it += NGW) {
        int r = it;
        if (r < I_A) { p0_item(F, WK_SWIGLU, F.i9, 2 * FF, nullptr, nullptr, nullptr, (bf16*)(ws + WS_W1A), D, r / 176, r % 176, scr); continue; } r -= I_A;
        if (r < I_A) { p0_item(F, WK_SWIGLU, F.i22, 2 * FF, nullptr, F.i21, nullptr, (bf16*)(ws + WS_W2A), D, r / 176, r % 176, scr); continue; } r -= I_A;
        if (r < I_O) { p0_item(F, WK_PLAIN, F.i10, D, nullptr, nullptr, nullptr, (bf16*)(ws + WS_W1O), FF, r / 32, r % 32, scr); continue; } r -= I_O;
        if (r < I_O) { p0_item(F, WK_PLAIN, F.i23, D, nullptr, nullptr, nullptr, (bf16*)(ws + WS_W2O), FF, r / 32, r % 32, scr); continue; } r -= I_O;
        if (r < I_IN) { p0_item(F, WK_IN, F.i12, DIN, F.i16, F.i11, F.i13, (bf16*)(ws + WS_WIN), D, r / 312, r % 312, scr); continue; } r -= I_IN;
        if (r < 3 * I_BR) { const int br = r / I_BR, q = r % I_BR; p0_item(F, WK_PLAIN, F.i17 + (size_t)br * 512 * D, D, nullptr, nullptr, nullptr, (bf16*)(ws + WS_WBR) + (size_t)br * D * 512, 512, q / 32, q % 32, scr); continue; } r -= 3 * I_BR;
        if (r < I_SQ) { p0_item(F, WK_PLAIN, F.i18, D, nullptr, nullptr, nullptr, (bf16*)(ws + WS_WOUT), D, r / 32, r % 32, scr); continue; } r -= I_SQ;
        p0_item(F, WK_PLAIN, F.i20, D, nullptr, nullptr, nullptr, (bf16*)(ws + WS_WMEM), D, r / 32, r % 32, scr);
    }
    for (int m = gw; m < MR + MM; m += NGW) {
        if (m < MP) rms_row_to_bf16(F.lane, F.i0 + (size_t)m * D, F.i8, (bf16*)(ws + WS_XB) + (size_t)m * D);
        else if (m < MR) rms_row_to_bf16(F.lane, F.i1 + (size_t)(m - MP) * D, F.i8, (bf16*)(ws + WS_XB) + (size_t)m * D);
        else rms_row_to_bf16(F.lane, F.i2 + (size_t)(m - MR) * D, F.i19, (bf16*)(ws + WS_MEMB) + (size_t)(m - MR) * D);
    }
    float* rc = (float*)(ws + WS_ROPE); float* rsn = rc + NPOS * 64;
    for (int i = (F.vcu * NWAVES * 64) + F.tid; i < NPOS * 64; i += F.G * NWAVES * 64) {
        const int p = i >> 6, e = i & 63; const int pos = p < SEQ ? p : PAST + (p - SEQ);
        const double y = -(double)e * 9.210340371976182736 / 64.0 / 16.0; double ex = 1.0;
#pragma unroll
        for (int k = 14; k >= 1; --k) ex = 1.0 + ex * y / (double)k;
        ex *= ex; ex *= ex; ex *= ex; ex *= ex;
        const float inv = (float)ex; const float ang = (float)pos * inv;
        double s, c; sincos_d((double)ang, s, c); rc[i] = (float)c; rsn[i] = (float)s;
    }
}

__device__ __forceinline__ int koff(int row, int ch) { return 256 * row + 16 * (ch ^ (row & 15)); }
__device__ __forceinline__ int voff(int row, int ch) { return 256 * row + 16 * (ch ^ ((row & 7) << 1)); }
typedef short v4i16_t __attribute__((ext_vector_type(4)));
__device__ __forceinline__ s16x4 vtr(const LAS unsigned char* p) { return __builtin_bit_cast(s16x4, __builtin_amdgcn_ds_read_tr16_b64_v4i16((LAS v4i16_t*)p)); }
template <int MODE>
__device__ __forceinline__ void attn_unit(const Frame& F, const bf16* Qp, int qpitch, const bf16* Kp, const bf16* Vp, int kpitch, long qrow0, int qstride, long krow0, int kstride, int kmin,
                                          bf16* Op, int opitch, float* lsep) {
    LAS unsigned char* ldsK = F.lds + RING_OFF; LAS unsigned char* ldsV = F.lds + RING_OFF + 65536;
    const int tid = F.tid, lane = F.lane, w = F.wave, l15 = lane & 15, g4 = lane >> 4;
    __syncthreads();
    {   const int c = tid & 15, r0 = tid >> 4; v4u kv[8], vv[8];
#pragma unroll
        for (int i = 0; i < 8; ++i) { const int kj = r0 + 32 * i; const long row = krow0 + (long)(kj < kmin ? kmin : kj) * kstride;
            kv[i] = *(const v4u*)(Kp + row * kpitch + c * 8); vv[i] = *(const v4u*)(Vp + row * kpitch + c * 8); }
#pragma unroll
        for (int i = 0; i < 8; ++i) { const int kj = r0 + 32 * i; *(LAS v4u*)(ldsK + koff(kj, c)) = kv[i]; *(LAS v4u*)(ldsV + voff(kj, c)) = vv[i]; }
    }
    const long qrow = qrow0 + (long)(16 * w + l15) * qstride;
    bf16x8 qf[4];
#pragma unroll
    for (int s = 0; s < 4; ++s) qf[s] = *(const bf16x8*)(Qp + qrow * qpitch + 32 * s + 8 * g4);
    __syncthreads();
    constexpr int NF = MODE == 0 ? 9 : 16, NP = (NF + 1) / 2;
    const int f0 = MODE == 0 ? w : 0;
    f32x4 S[NF];
#pragma unroll
    for (int i = 0; i < NF; ++i) { S[i] = (f32x4){0.f, 0.f, 0.f, 0.f}; const int krow = 16 * (f0 + i) + l15;
#pragma unroll
        for (int s = 0; s < 4; ++s) { const bf16x8 kf = *(const LAS bf16x8*)(ldsK + koff(krow, 4 * s + g4)); S[i] = __builtin_amdgcn_mfma_f32_16x16x32_bf16(kf, qf[s], S[i], 0, 0, 0); } }
    float mx = -3.0e38f;
    const int iq = 16 * w + l15;
#pragma unroll
    for (int i = 0; i < NF; ++i)
#pragma unroll
        for (int r = 0; r < 4; ++r) { if (MODE == 0) { const int kj = 16 * (f0 + i) + 4 * g4 + r; const bool ok = kj >= iq && kj <= iq + 128 && kj >= kmin; S[i][r] = ok ? S[i][r] : -3.0e38f; } mx = fmaxf(mx, S[i][r]); }
    mx = fmaxf(mx, __shfl_xor(mx, 16)); mx = fmaxf(mx, __shfl_xor(mx, 32));
    float ls = 0.f;
#pragma unroll
    for (int i = 0; i < NF; ++i)
#pragma unroll
        for (int r = 0; r < 4; ++r) { const float p = fast_exp2(S[i][r] - mx); S[i][r] = p; ls += p; }
    ls += __shfl_xor(ls, 16); ls += __shfl_xor(ls, 32);
    f32x4 O[8];
#pragma unroll
    for (int df = 0; df < 8; ++df) O[df] = (f32x4){0.f, 0.f, 0.f, 0.f};
    const int q4 = l15 >> 2, p4 = lane & 3;
#pragma unroll
    for (int pr = 0; pr < NP; ++pr) {
        const f32x4 pa = S[2 * pr], pb = (2 * pr + 1 < NF) ? S[(2 * pr + 1 < NF) ? 2 * pr + 1 : 0] : (f32x4){0.f, 0.f, 0.f, 0.f};
        v4u pw; pw.x = cvt_pk_bf16(pa.x, pa.y); pw.y = cvt_pk_bf16(pa.z, pa.w); pw.z = cvt_pk_bf16(pb.x, pb.y); pw.w = cvt_pk_bf16(pb.z, pb.w);
        const bf16x8 pf = __builtin_bit_cast(bf16x8, pw);
        const int fa = f0 + 2 * pr, fb = (fa + 1 > 15) ? 15 : fa + 1;
        const int ra = 16 * fa + 4 * g4 + q4, rb = 16 * fb + 4 * g4 + q4;
#pragma unroll
        for (int df = 0; df < 8; ++df) {
            const s16x4 t1 = vtr(ldsV + voff(ra, 2 * df + (p4 >> 1)) + 8 * (p4 & 1)), t2 = vtr(ldsV + voff(rb, 2 * df + (p4 >> 1)) + 8 * (p4 & 1));
            const bf16x8 vf = {t1[0], t1[1], t1[2], t1[3], t2[0], t2[1], t2[2], t2[3]};
            O[df] = __builtin_amdgcn_mfma_f32_16x16x32_bf16(vf, pf, O[df], 0, 0, 0);
        }
    }
    const float inv = 1.0f / ls;
    bf16* op = Op + qrow * opitch + 4 * g4;
#pragma unroll
    for (int df = 0; df < 8; ++df) { const f32x4 o = O[df] * inv; v2u wv; wv.x = cvt_pk_bf16(o.x, o.y); wv.y = cvt_pk_bf16(o.z, o.w); *(v2u*)(op + 16 * df) = wv; }
    if (MODE == 0 && g4 == 0) lsep[qrow * 12] = (mx + fast_log2(ls)) * LN2;
}
__device__ __forceinline__ void p4_attn_unit(const Frame& F, int id) {
    unsigned char* ws = F.ws;
    if (id < 6144) {
        const int b = id / 192, rem = id % 192, gh = rem >> 4, u = rem & 15, g = gh >> 2;
        const int dil = g == 0 ? 1 : (g == 1 ? 4 : 16), r = g == 0 ? 0 : (g == 1 ? (u & 3) : u), n = g == 0 ? u : (g == 1 ? (u >> 2) : 0);
        const long base = (long)b * SEQ + r;
        attn_unit<0>(F, (const bf16*)(ws + WS_QS) + gh * 128, 1536, (const bf16*)(ws + WS_KS) + gh * 128, (const bf16*)(ws + WS_VS) + gh * 128, 1536,
                     base + (long)128 * n * dil, dil, base + (long)128 * (n - 1) * dil, dil, n == 0 ? 128 : 0, (bf16*)(ws + WS_OG) + gh * 128, 1536, (float*)(ws + WS_LSE) + gh);
    } else {
        const int j = id - 6144, b = j >> 6, h = (j >> 4) & 3, n = j & 15;
        attn_unit<1>(F, (const bf16*)(ws + WS_MQ) + h * 128, 512, (const bf16*)(ws + WS_MKV) + h * 128, (const bf16*)(ws + WS_MKV) + 512 + h * 128, 1024,
                     (long)b * SEQ + 128 * n, 1, (long)b * MEML, 1, 0, (bf16*)(ws + WS_OALL) + 1024 + h * 128, 1536, nullptr);
    }
}
__device__ __forceinline__ void p4_sample_attn(const Frame& F, int wt, const float* c0, const float* c1, const float* c2, const float* cm) {
    unsigned char* ws = F.ws; const int lane = F.lane, sub = lane & 15, t = lane >> 4;
    const int db = wt >> 4, h = (wt >> 2) & 3, src = wt & 3;
    const int row = MP + db * 4 + t;
    const bf16* qp = src < 3 ? (const bf16*)(ws + WS_QS) + (size_t)row * 1536 + src * 512 + h * 128 + 8 * sub : (const bf16*)(ws + WS_MQ) + (size_t)row * 512 + h * 128 + 8 * sub;
    float q[8]; { const v4u qw = *(const v4u*)qp; q[0] = bflo(qw.x); q[1] = bfhi(qw.x); q[2] = bflo(qw.y); q[3] = bfhi(qw.y); q[4] = bflo(qw.z); q[5] = bfhi(qw.z); q[6] = bflo(qw.w); q[7] = bfhi(qw.w); }
    float mx = -3.0e38f, ls = 0.f, o[8];
#pragma unroll
    for (int j = 0; j < 8; ++j) o[j] = 0.f;
#define SA_STEP(K0, K1, V0, V1) do { float s_ = (q[0] * K0.x + q[1] * K0.y) + (q[2] * K0.z + q[3] * K0.w) + (q[4] * K1.x + q[5] * K1.y) + (q[6] * K1.z + q[7] * K1.w); \
        s_ += __shfl_xor(s_, 1); s_ += __shfl_xor(s_, 2); s_ += __shfl_xor(s_, 4); s_ += __shfl_xor(s_, 8); \
        const float mn_ = fmaxf(mx, s_), sc_ = fast_exp2(mx - mn_), p_ = fast_exp2(s_ - mn_); mx = mn_; ls = ls * sc_ + p_; \
        o[0] = o[0] * sc_ + p_ * V0.x; o[1] = o[1] * sc_ + p_ * V0.y; o[2] = o[2] * sc_ + p_ * V0.z; o[3] = o[3] * sc_ + p_ * V0.w; \
        o[4] = o[4] * sc_ + p_ * V1.x; o[5] = o[5] * sc_ + p_ * V1.y; o[6] = o[6] * sc_ + p_ * V1.z; o[7] = o[7] * sc_ + p_ * V1.w; } while (0)
    int nstart = 0, NK; const float* cache; int L = 256, dil = 1;
    if (src == 3) { cache = cm; NK = 256; }
    else { cache = src == 0 ? c0 : (src == 1 ? c1 : c2); L = 128 << (2 * src); dil = src == 0 ? 1 : (src == 1 ? 4 : 16); NK = 129; nstart = 4;
        for (int n = 0; n < 4; ++n) {
            const int idx = L + t - dil * n; f32x4 k0, k1, v0, v1;
            if (idx >= L) { const size_t ro = (size_t)(MP + db * 4 + (idx - L)) * 1536 + src * 512 + h * 128 + 8 * sub;
                const v4u kw = *(const v4u*)((const bf16*)(ws + WS_KS) + ro), vw = *(const v4u*)((const bf16*)(ws + WS_VS) + ro);
                k0 = (f32x4){bflo(kw.x), bfhi(kw.x), bflo(kw.y), bfhi(kw.y)}; k1 = (f32x4){bflo(kw.z), bfhi(kw.z), bflo(kw.w), bfhi(kw.w)};
                v0 = (f32x4){bflo(vw.x), bfhi(vw.x), bflo(vw.y), bfhi(vw.y)}; v1 = (f32x4){bflo(vw.z), bfhi(vw.z), bflo(vw.w), bfhi(vw.w)};
            } else { const float* kp = cache + (((size_t)db * L + idx) * 2) * 512 + h * 128 + 8 * sub;
                k0 = *(const f32x4*)kp; k1 = *(const f32x4*)(kp + 4); v0 = *(const f32x4*)(kp + 512); v1 = *(const f32x4*)(kp + 516); }
            SA_STEP(k0, k1, v0, v1);
        }
    }
#pragma unroll 4
    for (int n = nstart; n < NK; ++n) {
        const int idx = src == 3 ? n : L + t - dil * n;
        const float* kp = cache + (((size_t)db * L + idx) * 2) * 512 + h * 128 + 8 * sub;
        const f32x4 k0 = *(const f32x4*)kp, k1 = *(const f32x4*)(kp + 4), v0 = *(const f32x4*)(kp + 512), v1 = *(const f32x4*)(kp + 516);
        SA_STEP(k0, k1, v0, v1);
    }
#undef SA_STEP
    const float inv = 1.0f / ls;
    v4u w; w.x = cvt_pk_bf16(o[0] * inv, o[1] * inv); w.y = cvt_pk_bf16(o[2] * inv, o[3] * inv); w.z = cvt_pk_bf16(o[4] * inv, o[5] * inv); w.w = cvt_pk_bf16(o[6] * inv, o[7] * inv);
    if (src < 3) { *(v4u*)((bf16*)(ws + WS_OG) + (size_t)row * 1536 + src * 512 + h * 128 + 8 * sub) = w; if (sub == 0) ((float*)(ws + WS_LSE))[(size_t)row * 12 + src * 4 + h] = (mx + fast_log2(ls)) * LN2; }
    else *(v4u*)((bf16*)(ws + WS_OALL) + (size_t)row * 1536 + 1024 + h * 128 + 8 * sub) = w;
}
__device__ __forceinline__ void p4_gla_chain(const Frame& F, int row0, int T, int h, const float* S0, float* Sout) {
    unsigned char* ws = F.ws; const int tid = F.tid, v = tid & 127, ks = __builtin_amdgcn_readfirstlane(tid >> 7);
    const float* GA = (const float*)(ws + WS_GA); const bf16* GQ = (const bf16*)(ws + WS_GQ); const bf16* GK = (const bf16*)(ws + WS_GK); const bf16* GV = (const bf16*)(ws + WS_GV); float* GO = (float*)(ws + WS_GO);
    LAS float* part = (LAS float*)(F.lds + RING_OFF);
    float S[16];
#pragma unroll
    for (int i = 0; i < 16; ++i) S[i] = S0 ? S0[(size_t)(16 * ks + i) * 128 + v] : 0.f;
    for (int t0 = 0; t0 < T; t0 += 16) {
        const int nb = (T - t0) < 16 ? (T - t0) : 16;
        __syncthreads();
        for (int tt = 0; tt < nb; ++tt) {
            const size_t row = (size_t)(row0 + t0 + tt);
            const float* ap = GA + row * 256 + h * 64 + 16 * ks; const v4u kw0 = *(const v4u*)(GK + row * 256 + h * 64 + 16 * ks), kw1 = *(const v4u*)(GK + row * 256 + h * 64 + 16 * ks + 8);
            const v4u qw0 = *(const v4u*)(GQ + row * 256 + h * 64 + 16 * ks), qw1 = *(const v4u*)(GQ + row * 256 + h * 64 + 16 * ks + 8);
            const float vv = bf2f(GV[row * 512 + h * 128 + v]);
            const f32x4 a0 = *(const f32x4*)ap, a1 = *(const f32x4*)(ap + 4), a2 = *(const f32x4*)(ap + 8), a3 = *(const f32x4*)(ap + 12);
            const float la[16] = {a0.x, a0.y, a0.z, a0.w, a1.x, a1.y, a1.z, a1.w, a2.x, a2.y, a2.z, a2.w, a3.x, a3.y, a3.z, a3.w};
            const float kk[16] = {bflo(kw0.x), bfhi(kw0.x), bflo(kw0.y), bfhi(kw0.y), bflo(kw0.z), bfhi(kw0.z), bflo(kw0.w), bfhi(kw0.w), bflo(kw1.x), bfhi(kw1.x), bflo(kw1.y), bfhi(kw1.y), bflo(kw1.z), bfhi(kw1.z), bflo(kw1.w), bfhi(kw1.w)};
            const float qq[16] = {bflo(qw0.x), bfhi(qw0.x), bflo(qw0.y), bfhi(qw0.y), bflo(qw0.z), bfhi(qw0.z), bflo(qw0.w), bfhi(qw0.w), bflo(qw1.x), bfhi(qw1.x), bflo(qw1.y), bfhi(qw1.y), bflo(qw1.z), bfhi(qw1.z), bflo(qw1.w), bfhi(qw1.w)};
            float o = 0.f;
#pragma unroll
            for (int i = 0; i < 16; ++i) { S[i] = fast_exp2(la[i] * 1.4426950408889634f) * S[i] + kk[i] * vv; o += qq[i] * S[i]; }
            part[(tt * 4 + ks) * 128 + v] = o;
        }
        __syncthreads();
        for (int e = tid; e < nb * 128; e += 512) { const int tt = e >> 7, vv_ = e & 127;
            GO[(size_t)(row0 + t0 + tt) * 512 + h * 128 + vv_] = (part[(tt * 4 + 0) * 128 + vv_] + part[(tt * 4 + 1) * 128 + vv_]) + (part[(tt * 4 + 2) * 128 + vv_] + part[(tt * 4 + 3) * 128 + vv_]); }
    }
#pragma unroll
    for (int i = 0; i < 16; ++i) Sout[(size_t)(16 * ks + i) * 128 + v] = S[i];
}
__device__ __forceinline__ void p5_combine_row(const Frame& F, int row) {
    unsigned char* ws = F.ws; const int lane = F.lane, hh = lane >> 4, sub = lane & 15, col = hh * 128 + 8 * sub;
    const float* lse = (const float*)(ws + WS_LSE) + (size_t)row * 12;
    const float l0 = lse[hh], l1 = lse[4 + hh], l2 = lse[8 + hh], mx = fmaxf(l0, fmaxf(l1, l2));
    float w0 = __expf(l0 - mx), w1 = __expf(l1 - mx), w2 = __expf(l2 - mx); const float wi = 1.0f / (w0 + w1 + w2); w0 *= wi; w1 *= wi; w2 *= wi;
    const bf16* og = (const bf16*)(ws + WS_OG) + (size_t)row * 1536 + col;
    const v4u a = *(const v4u*)og, b = *(const v4u*)(og + 512), c = *(const v4u*)(og + 1024);
    v4u o;
    o.x = cvt_pk_bf16(w0 * bflo(a.x) + w1 * bflo(b.x) + w2 * bflo(c.x), w0 * bfhi(a.x) + w1 * bfhi(b.x) + w2 * bfhi(c.x));
    o.y = cvt_pk_bf16(w0 * bflo(a.y) + w1 * bflo(b.y) + w2 * bflo(c.y), w0 * bfhi(a.y) + w1 * bfhi(b.y) + w2 * bfhi(c.y));
    o.z = cvt_pk_bf16(w0 * bflo(a.z) + w1 * bflo(b.z) + w2 * bflo(c.z), w0 * bfhi(a.z) + w1 * bfhi(b.z) + w2 * bfhi(c.z));
    o.w = cvt_pk_bf16(w0 * bflo(a.w) + w1 * bflo(b.w) + w2 * bflo(c.w), w0 * bfhi(a.w) + w1 * bfhi(b.w) + w2 * bfhi(c.w));
    bf16* oall = (bf16*)(ws + WS_OALL) + (size_t)row * 1536;
    *(v4u*)(oall + col) = o;
    const float* go = (const float*)(ws + WS_GO) + (size_t)row * 512 + col;
    const f32x4 x0 = *(const f32x4*)go, x1 = *(const f32x4*)(go + 4);
    float ss = (x0.x * x0.x + x0.y * x0.y) + (x0.z * x0.z + x0.w * x0.w) + (x1.x * x1.x + x1.y * x1.y) + (x1.z * x1.z + x1.w * x1.w);
    ss += __shfl_xor(ss, 1); ss += __shfl_xor(ss, 2); ss += __shfl_xor(ss, 4); ss += __shfl_xor(ss, 8);
    const float rstd = 1.0f / sqrtf(ss * (1.f / 128.f) + EPS);
    const float* gg = F.i15 + 8 * sub; const f32x4 g0 = *(const f32x4*)gg, g1 = *(const f32x4*)(gg + 4);
    const v4u gr = *(const v4u*)((const bf16*)(ws + WS_GRS) + (size_t)row * 512 + col);
    v4u y;
    y.x = cvt_pk_bf16(x0.x * rstd * g0.x * bflo(gr.x), x0.y * rstd * g0.y * bfhi(gr.x)); y.y = cvt_pk_bf16(x0.z * rstd * g0.z * bflo(gr.y), x0.w * rstd * g0.w * bfhi(gr.y));
    y.z = cvt_pk_bf16(x1.x * rstd * g1.x * bflo(gr.z), x1.y * rstd * g1.y * bfhi(gr.z)); y.w = cvt_pk_bf16(x1.z * rstd * g1.z * bflo(gr.w), x1.w * rstd * g1.w * bfhi(gr.w));
    *(v4u*)(oall + 512 + col) = y;
}
__device__ __forceinline__ void p10_final_row(const Frame& F, int row) {
    GAS f32x4* yr = (GAS f32x4*)(F.out + (size_t)row * D) + F.lane; const GAS f32x4* gr = (const GAS f32x4*)F.i24 + F.lane;
    f32x4 v[4]; float s = 0.f;
#pragma unroll
    for (int j = 0; j < 4; ++j) { v[j] = yr[64 * j]; s += (v[j].x * v[j].x + v[j].y * v[j].y) + (v[j].z * v[j].z + v[j].w * v[j].w); }
    const float rstd = 1.0f / sqrtf(wave_sum(s) * (1.f / D) + EPS);
#pragma unroll
    for (int j = 0; j < 4; ++j) yr[64 * j] = v[j] * rstd * gr[64 * j];
}

constexpr int N_PHASES = 11;
__global__ void __launch_bounds__(NWAVES * 64, 2) mk_fwd(Args args) {
    extern __shared__ __attribute__((aligned(16))) unsigned char lds[];
    Frame F;
    F.lds = (LAS unsigned char*)lds;
    F.tid = threadIdx.x; F.lane = F.tid & 63; F.wave = __builtin_amdgcn_readfirstlane(F.tid >> 6);
    F.G = gridDim.x; { const int bx = blockIdx.x; F.vcu = (F.G % 8 == 0) ? (bx % 8) * (F.G / 8) + bx / 8 : bx; }
    F.i0 = args.in[0]; F.i1 = args.in[1]; F.i2 = args.in[2]; F.i3 = args.in[3]; F.i4 = args.in[4]; F.i5 = args.in[5]; F.i6 = args.in[6]; F.i7 = args.in[7]; F.i8 = args.in[8]; F.i9 = args.in[9]; F.i10 = args.in[10]; F.i11 = args.in[11]; F.i12 = args.in[12]; F.i13 = args.in[13]; F.i14 = args.in[14]; F.i15 = args.in[15]; F.i16 = args.in[16]; F.i17 = args.in[17]; F.i18 = args.in[18]; F.i19 = args.in[19]; F.i20 = args.in[20]; F.i21 = args.in[21]; F.i22 = args.in[22]; F.i23 = args.in[23]; F.i24 = args.in[24];
    F.out = args.out; F.ws = args.ws;
    unsigned char* ws = args.ws; gu32* ctl = (gu32*)(ws + WS_CTL);
    volatile LAS unsigned* MISC = (volatile LAS unsigned*)(F.lds + MISC_OFF);
    for (int u = F.tid; u < (LDS_BYTES - LDSCTL_OFF) / 4; u += NWAVES * 64) ((LAS unsigned*)(F.lds + LDSCTL_OFF))[u] = 0u;
    __syncthreads();
    XcdBarrier bar; bar.bar = (unsigned*)(ctl + CW_BAR); bar.x = 0; bar.st = nullptr;
    if (MK_N_LAUNCHES == 1) bar = xcd_barrier_post((unsigned*)(ctl + CW_BAR), MISC + 8);
    const int lo = args.ph_lo, hi = args.ph_hi;
#define IN(k) (lo <= (k) && (k) < hi && (k) <= MK_STOP_AFTER)
#define GRID_BAR(k) do { if (IN((k) + 1)) xcd_barrier(bar); } while (0)
    const int G = F.G, bx = (int)blockIdx.x;

    if (IN(0)) { p0_prologue(F); GRID_BAR(0); }

    if (IN(1)) {
        { pg8::Gemm g{(const bf16*)(ws + WS_XB), (const bf16*)(ws + WS_W1A), MR, 2 * FF, D, D}; pg8::StaticOrder S; S.init(MR, 2 * FF, G, bx);
          EpiSwiglu E{(bf16*)(ws + WS_G), nullptr}; pg8::gemm_phase<EpiSwiglu, pg8::StaticOrder>(F.lds + RING_OFF, g, S, E); }
        { pg8::Gemm g{(const bf16*)(ws + WS_MEMB), (const bf16*)(ws + WS_WMEM), MM, D, D, D}; pg8::StaticOrder S; S.init(MM, D, G, (bx + G / 2) % G);
          EpiMemKV E{F.out + O_MEMKV, (bf16*)(ws + WS_MKV)}; pg8::gemm_phase<EpiMemKV, pg8::StaticOrder>(F.lds + RING_OFF, g, S, E); }
        GRID_BAR(1);
    }
    if (IN(2)) {
        pg8::Gemm g{(const bf16*)(ws + WS_G), (const bf16*)(ws + WS_W1O), MR, D, FF, FF}; pg8::StaticOrder S; S.init(MR, D, G, bx);
        EpiResid<true, true> E{F.i0, F.i1, (float*)(ws + WS_H), (float*)(ws + WS_H) + (size_t)MP * D, (bf16*)(ws + WS_HB), (float*)(ws + WS_PQ1), 0.5f};
        pg8::gemm_phase<EpiResid<true, true>, pg8::StaticOrder>(F.lds + RING_OFF, g, S, E);
        GRID_BAR(2);
    }
    if (IN(3)) {
        pg8::Gemm g{(const bf16*)(ws + WS_HB), (const bf16*)(ws + WS_WIN), MR, NZ, D, D}; pg8::StaticOrder S; S.init(MR, NZ, G, bx);
        EpiZ E{(const float*)(ws + WS_PQ1), (const float*)(ws + WS_ROPE), (const float*)(ws + WS_ROPE) + NPOS * 64, F.i14, F.out,
               (bf16*)(ws + WS_QS), (bf16*)(ws + WS_KS), (bf16*)(ws + WS_VS), (bf16*)(ws + WS_GQ), (bf16*)(ws + WS_GK), (bf16*)(ws + WS_GV), (bf16*)(ws + WS_GRS), (bf16*)(ws + WS_MQ), (bf16*)(ws + WS_GATE), (float*)(ws + WS_GA)};
        pg8::gemm_phase<EpiZ, pg8::StaticOrder>(F.lds + RING_OFF, g, S, E);
        GRID_BAR(3);
    }
    if (IN(4)) {
        const int half = G / 2;
        if (bx < half) {
            for (int c = bx; c < NB * 4; c += half) p4_gla_chain(F, (c >> 2) * SEQ, SEQ, c & 3, nullptr, F.out + O_GLAP + (size_t)c * 64 * 128);
            for (int c = bx; c < DECB * 4; c += half) p4_gla_chain(F, MP + (c >> 2) * DECT, DECT, c & 3, F.i7 + (size_t)c * 64 * 128, F.out + O_GLAS + (size_t)c * 64 * 128);
        } else {
            for (int id = bx - half; id < 8192; id += G - half) p4_attn_unit(F, id);
            for (int wt = (bx - half) * NWAVES + F.wave; wt < DECB * 16; wt += (G - half) * NWAVES) p4_sample_attn(F, wt, args.in[3], args.in[4], args.in[5], args.in[6]);
        }
        GRID_BAR(4);
    }
    if (IN(5)) {
        for (int m = F.vcu * NWAVES + F.wave; m < MR; m += G * NWAVES) p5_combine_row(F, m);
        GRID_BAR(5);
    }
    if (IN(6)) {
        pg8::StaticOrder S; S.init(MR, D, G, bx);
        { pg8::Gemm g{(const bf16*)(ws + WS_OALL), (const bf16*)(ws + WS_WBR), MR, D, 512, 1536}; EpiMerge<0> E{(const bf16*)(ws + WS_GATE), (float*)(ws + WS_T), (bf16*)(ws + WS_MB)}; pg8::gemm_phase<EpiMerge<0>, pg8::StaticOrder>(F.lds + RING_OFF, g, S, E); }
        { pg8::Gemm g{(const bf16*)(ws + WS_OALL) + 512, (const bf16*)(ws + WS_WBR) + (size_t)D * 512, MR, D, 512, 1536}; EpiMerge<1> E{(const bf16*)(ws + WS_GATE), (float*)(ws + WS_T), (bf16*)(ws + WS_MB)}; pg8::gemm_phase<EpiMerge<1>, pg8::StaticOrder>(F.lds + RING_OFF, g, S, E); }
        { pg8::Gemm g{(const bf16*)(ws + WS_OALL) + 1024, (const bf16*)(ws + WS_WBR) + (size_t)2 * D * 512, MR, D, 512, 1536}; EpiMerge<2> E{(const bf16*)(ws + WS_GATE), (float*)(ws + WS_T), (bf16*)(ws + WS_MB)}; pg8::gemm_phase<EpiMerge<2>, pg8::StaticOrder>(F.lds + RING_OFF, g, S, E); }
        GRID_BAR(6);
    }
    if (IN(7)) {
        pg8::Gemm g{(const bf16*)(ws + WS_MB), (const bf16*)(ws + WS_WOUT), MR, D, D, D}; pg8::StaticOrder S; S.init(MR, D, G, bx);
        float* H = (float*)(ws + WS_H);
        EpiResid<true, true> E{H, H + (size_t)MP * D, H, H + (size_t)MP * D, (bf16*)(ws + WS_HB), (float*)(ws + WS_PQ2), 1.0f};
        pg8::gemm_phase<EpiResid<true, true>, pg8::StaticOrder>(F.lds + RING_OFF, g, S, E);
        GRID_BAR(7);
    }
    if (IN(8)) {
        pg8::Gemm g{(const bf16*)(ws + WS_HB), (const bf16*)(ws + WS_W2A), MR, 2 * FF, D, D}; pg8::StaticOrder S; S.init(MR, 2 * FF, G, bx);
        EpiSwiglu E{(bf16*)(ws + WS_G), (const float*)(ws + WS_PQ2)}; pg8::gemm_phase<EpiSwiglu, pg8::StaticOrder>(F.lds + RING_OFF, g, S, E);
        GRID_BAR(8);
    }
    if (IN(9)) {
        pg8::Gemm g{(const bf16*)(ws + WS_G), (const bf16*)(ws + WS_W2O), MR, D, FF, FF}; pg8::StaticOrder S; S.init(MR, D, G, bx);
        float* H = (float*)(ws + WS_H);
        EpiResid<false, false> E{H, H + (size_t)MP * D, F.out + O_Y, F.out + O_YS, nullptr, nullptr, 0.5f};
        pg8::gemm_phase<EpiResid<false, false>, pg8::StaticOrder>(F.lds + RING_OFF, g, S, E);
        GRID_BAR(9);
    }
    if (IN(10)) {
        for (int m = F.vcu * NWAVES + F.wave; m < MR; m += G * NWAVES) p10_final_row(F, m);
    }

#if MK_STOP_AFTER < 10
    if (hi == N_PHASES) {
        for (int m = F.vcu * NWAVES + F.wave; m < MR; m += G * NWAVES) {
            for (int c = F.lane; c < D; c += 64) {
                float v;
                if (MK_STOP_AFTER == 0) v = bf2f(((const bf16*)(ws + WS_WIN))[(size_t)(m % NZ) * D + c]);
                else if (MK_STOP_AFTER == 3) { const bf16* gt = (const bf16*)(ws + WS_GATE) + (size_t)m * 3072; v = bf2f(gt[c]) + bf2f(gt[1024 + c]) + bf2f(gt[2048 + c]); }
                else if (MK_STOP_AFTER <= 5) { const bf16* oa = (const bf16*)(ws + WS_OALL) + (size_t)m * 1536; v = bf2f(oa[c]) + bf2f(oa[1024 + (c & 511)]); }
                else if (MK_STOP_AFTER == 6) v = bf2f(((const bf16*)(ws + WS_MB))[(size_t)m * D + c]);
                else if (MK_STOP_AFTER == 7) v = ((const float*)(ws + WS_H))[(size_t)m * D + c];
                else v = bf2f(((const bf16*)(ws + WS_G))[(size_t)m * FF + c]) + bf2f(((const bf16*)(ws + WS_G))[(size_t)m * FF + 1792 + c]);
                F.out[(size_t)m * D + c] = v;
            }
        }
    }
#endif
#undef IN
#undef GRID_BAR
}

extern "C" void kernel_launch(void* const* d_in, const int* in_sizes, int n_in, void* d_out, int out_size, void* d_ws, size_t ws_size, hipStream_t stream) {
    static int grid = 0;
    if (grid == 0) {
        if (n_in != 25 || (size_t)out_size != O_END || ws_size < WS_END) { fprintf(stderr, "kernel_launch: unexpected shapes: n_in %d out %d ws %zu (need %zu); nothing launched\n", n_in, out_size, ws_size, (size_t)WS_END); grid = -1; return; }
        int dev = 0, cus = 0, per_cu = 0;
        if (hipGetDevice(&dev) != hipSuccess || hipDeviceGetAttribute(&cus, hipDeviceAttributeMultiprocessorCount, dev) != hipSuccess) { grid = -1; return; }
        if (hipFuncSetAttribute((const void*)mk_fwd, hipFuncAttributeMaxDynamicSharedMemorySize, LDS_BYTES) != hipSuccess) { fprintf(stderr, "kernel_launch: hipFuncSetAttribute failed\n"); grid = -1; return; }
        if (hipOccupancyMaxActiveBlocksPerMultiprocessor(&per_cu, (const void*)mk_fwd, NWAVES * 64, LDS_BYTES) != hipSuccess || per_cu < 1) fprintf(stderr, "kernel_launch: occupancy query reports %d\n", per_cu);
        (void)hipGetLastError();
        grid = cus;
    }
    if (grid < 0) return;
    if (hipMemsetAsync((char*)d_ws + WS_CTL, 0, CTL_ZERO_BYTES, stream) != hipSuccess) return;
    Args a{};
    for (int i = 0; i < 25; ++i) a.in[i] = (const float*)d_in[i];
    a.out = (float*)d_out; a.ws = (unsigned char*)d_ws; a.pad = 0;
    for (int li = 0; li < MK_N_LAUNCHES; ++li) {
        a.ph_lo = (MK_N_LAUNCHES == 1) ? 0 : li; a.ph_hi = (MK_N_LAUNCHES == 1) ? N_PHASES : li + 1; a.li = li;
        hipLaunchKernelGGL(mk_fwd, dim3(grid), dim3(NWAVES * 64), LDS_BYTES, stream, a);
        const hipError_t le = hipPeekAtLastError();
        if (le != hipSuccess) { fprintf(stderr, "kernel_launch: launch %d failed: %s\n", li, hipGetErrorName(le)); break; }
    }
}
```

```cpp
#include <hip/hip_runtime.h>
#include <cstdio>
#include <cstdint>

#ifndef MK_N_LAUNCHES
#define MK_N_LAUNCHES 1
#endif

#ifndef MK_STOP_AFTER
#define MK_STOP_AFTER 10
#endif
#define GAS __attribute__((address_space(1)))
#define LAS __attribute__((address_space(3)))
typedef unsigned short bf16;
typedef unsigned v4u __attribute__((ext_vector_type(4)));
typedef unsigned v2u __attribute__((ext_vector_type(2)));
typedef float f32x4 __attribute__((ext_vector_type(4)));
typedef float f32x2 __attribute__((ext_vector_type(2)));
typedef short bf16x8 __attribute__((ext_vector_type(8)));
typedef short s16x4 __attribute__((ext_vector_type(4)));
typedef GAS unsigned gu32;

constexpr int D = 1024, NB = 32, SEQ = 2048, DECB = 128, DECT = 4, PAST = 8192, MEML = 256;
constexpr int MP = NB * SEQ;
constexpr int MS = DECB * DECT;
constexpr int MR = MP + MS;
constexpr int MM = NB * MEML;
constexpr int FF = 2816, NZ = 9984;
constexpr int DIN = 6672;
constexpr int NPOS = SEQ + DECT;
constexpr float EPS = 1e-6f;
constexpr float QSCALE = 0.08838834764831845f * 1.4426950408889634f;
constexpr float LN2 = 0.6931471805599453f;

constexpr size_t O_Y = 0, O_YS = (size_t)MP * D, O_SWA0P = O_YS + (size_t)MS * D, O_SWA1P = O_SWA0P + (size_t)NB * 128 * 1024, O_SWA2P = O_SWA1P + (size_t)NB * 512 * 1024,
                 O_MEMKV = O_SWA2P + (size_t)NB * 2048 * 1024, O_GLAP = O_MEMKV + (size_t)MM * 1024, O_SWA0S = O_GLAP + (size_t)NB * 4 * 64 * 128, O_SWA1S = O_SWA0S + (size_t)MS * 1024,
                 O_SWA2S = O_SWA1S + (size_t)MS * 1024, O_GLAS = O_SWA2S + (size_t)MS * 1024, O_END = O_GLAS + (size_t)DECB * 4 * 64 * 128;
static_assert(O_END == 170917888ull, "output size");

constexpr size_t MiB = 1u << 20;
constexpr size_t al(size_t x) { return (x + 2 * MiB - 1) / (2 * MiB) * (2 * MiB); }
constexpr size_t WS_CTL = 0, CTL_ZERO_BYTES = 1 * MiB;
constexpr size_t WS_ROPE = 2 * MiB;
constexpr size_t WS_PQ1 = WS_ROPE + al((size_t)NPOS * 64 * 4 * 2);
constexpr size_t WS_PQ2 = WS_PQ1 + al((size_t)MR * 16 * 4);
constexpr size_t WS_W1A = WS_PQ2 + al((size_t)MR * 16 * 4);
constexpr size_t WS_W1O = WS_W1A + al((size_t)2 * FF * D * 2);
constexpr size_t WS_WIN = WS_W1O + al((size_t)D * FF * 2);
constexpr size_t WS_WBR = WS_WIN + al((size_t)NZ * D * 2);
constexpr size_t WS_WOUT = WS_WBR + al((size_t)3 * D * 512 * 2);
constexpr size_t WS_W2A = WS_WOUT + al((size_t)D * D * 2);
constexpr size_t WS_W2O = WS_W2A + al((size_t)2 * FF * D * 2);
constexpr size_t WS_WMEM = WS_W2O + al((size_t)D * FF * 2);
constexpr size_t WS_XB = WS_WMEM + al((size_t)D * D * 2);
constexpr size_t WS_MEMB = WS_XB + al((size_t)MR * D * 2);
constexpr size_t WS_MKV = WS_MEMB + al((size_t)MM * D * 2);
constexpr size_t WS_G = WS_MKV + al((size_t)MM * D * 2);
constexpr size_t WS_H = WS_G + al((size_t)MR * FF * 2);
constexpr size_t WS_HB = WS_H + al((size_t)MR * D * 4);
constexpr size_t WS_QS = WS_HB + al((size_t)MR * D * 2);
constexpr size_t WS_KS = WS_QS + al((size_t)MR * 1536 * 2);
constexpr size_t WS_VS = WS_KS + al((size_t)MR * 1536 * 2);
constexpr size_t WS_GQ = WS_VS + al((size_t)MR * 1536 * 2);
constexpr size_t WS_GK = WS_GQ + al((size_t)MR * 256 * 2);
constexpr size_t WS_GV = WS_GK + al((size_t)MR * 256 * 2);
constexpr size_t WS_GRS = WS_GV + al((size_t)MR * 512 * 2);
constexpr size_t WS_GA = WS_GRS + al((size_t)MR * 512 * 2);
constexpr size_t WS_MQ = WS_GA + al((size_t)MR * 256 * 4);
constexpr size_t WS_GATE = WS_MQ + al((size_t)MR * 512 * 2);
constexpr size_t WS_OG = WS_GATE + al((size_t)MR * 3072 * 2);
constexpr size_t WS_LSE = WS_OG + al((size_t)MR * 1536 * 2);
constexpr size_t WS_GO = WS_LSE + al((size_t)MR * 12 * 4);
constexpr size_t WS_OALL = WS_GO + al((size_t)MR * 512 * 4);
constexpr size_t WS_END = WS_OALL + al((size_t)MR * 1536 * 2);
constexpr size_t WS_T = WS_G, WS_MB = WS_XB;
static_assert((size_t)MR * D * 4 <= (size_t)MR * FF * 2, "T fits in G");

constexpr int CW_TMO = 0, CW_CODE = 1, CW_BAR = 4096;

constexpr int RING_OFF = 0, RING_BYTES = 131072;
constexpr int LDSCTL_OFF = RING_BYTES, MISC_OFF = LDSCTL_OFF + 320;
constexpr int LDS_BYTES = 147456;
constexpr int NWAVES = 8;

#define RLX_AGENT __ATOMIC_RELAXED, __HIP_MEMORY_SCOPE_AGENT
#define LDS_WAIT() asm volatile("s_waitcnt lgkmcnt(0)" ::: "memory")
#define VM_WAIT() asm volatile("s_waitcnt vmcnt(0)" ::: "memory")
__device__ __forceinline__ unsigned f2bf(float f) { unsigned u = __builtin_bit_cast(unsigned, f); return (u + 0x7fffu + ((u >> 16) & 1u)) >> 16; }
__device__ __forceinline__ unsigned pk2(float lo, float hi) { return f2bf(lo) | (f2bf(hi) << 16); }
__device__ __forceinline__ float bf2f(unsigned b) { return __builtin_bit_cast(float, b << 16); }
__device__ __forceinline__ float bflo(unsigned w) { return __builtin_bit_cast(float, w << 16); }
__device__ __forceinline__ float bfhi(unsigned w) { return __builtin_bit_cast(float, w & 0xffff0000u); }
typedef __bf16 bf16x2_t __attribute__((ext_vector_type(2)));
__device__ __forceinline__ unsigned cvt_pk_bf16(float lo, float hi) { const f32x2 v = {lo, hi}; const bf16x2_t b = __builtin_convertvector(v, bf16x2_t); return __builtin_bit_cast(unsigned, b); }
__device__ __forceinline__ float fast_exp2(float x) { return __builtin_amdgcn_exp2f(x); }
__device__ __forceinline__ float fast_rcp(float x) { return __builtin_amdgcn_rcpf(x); }
__device__ __forceinline__ float fast_log2(float x) { return __builtin_amdgcn_logf(x); }
__device__ __forceinline__ float sigmoidf_(float x) { return fast_rcp(1.0f + fast_exp2(-1.4426950408889634f * x)); }
__device__ __forceinline__ float siluf_(float x) { return x * sigmoidf_(x); }
__device__ __forceinline__ int perm32(int rho) { return 8 * ((rho >> 2) & 3) + 4 * (rho >> 4) + (rho & 3); }
__device__ __forceinline__ int sig_plain(int r) { return (r & ~31) + perm32(r & 31); }
__device__ __forceinline__ int sig_rope(int r7) { return 64 * ((r7 >> 4) & 1) + 16 * (r7 >> 5) + 4 * ((r7 >> 2) & 3) + (r7 & 3); }

namespace pg8 {
constexpr int BM = 256, BK = 64, HALF = 128, HTB = HALF * BK * 2, STAGE_BYTES = 8 * HTB, NXCD = 8, WGM = 8;
__host__ __device__ __forceinline__ int lds_byte(int r, int c) { const int st = (r >> 4) * 2 + (c >> 5), rr = r & 15, cc = c & 31, ob = rr * 64 + cc * 2; return st * 1024 + (ob ^ (((ob >> 9) & 1) << 5)); }
__host__ __device__ __forceinline__ void stage_rc(int b, int& R, int& C) { const int st = b / 1024, sb = b % 1024, swz = sb ^ (((sb >> 9) & 1) << 5); R = (st >> 1) * 16 + swz / 64; C = (st & 1) * 32 + (swz % 64) / 2; }
struct Unit { int pm, pn; };
struct Gemm { const bf16* A; const bf16* Bt; int M, N, K, lda; };
struct StaticOrder {
    int nM, nN, nwg, G, c;
    __host__ __device__ void init(int M, int N, int G_, int c_) { nM = M / BM; nN = N / BM; nwg = nM * nN; G = G_; c = c_; }
    __host__ __device__ bool next(int i, Unit& u) const {
        const long L = (long)i * G + c; if (L >= nwg) return false;
        int wgid = (int)L; { const int q = nwg / NXCD, r = nwg % NXCD, xcd = wgid % NXCD, off = wgid / NXCD; wgid = (xcd < r ? xcd * (q + 1) : r * (q + 1) + (xcd - r) * q) + off; }
        const int nig = WGM * nN, gid = wgid / nig, fm = gid * WGM, gsz = (nM - fm) < WGM ? (nM - fm) : WGM;
        u.pm = fm + ((wgid % nig) % gsz); u.pn = (wgid % nig) / gsz; return true;
    }
};
template <class Epi, class Sched, bool ALIGN_EPI = true>
__device__ __forceinline__ void gemm_phase(LAS unsigned char* lds, const Gemm g, const Sched& S, const Epi& E) {
    const int tid = threadIdx.x, wid = __builtin_amdgcn_readfirstlane(tid >> 6), lane = tid & 63, wr = wid >> 2, wc = wid & 3, fr = lane & 15, fq = lane >> 4;
    const int K = g.K, nt = K / BK;
    unsigned voffA[2], voffB[2];
#pragma unroll
    for (int i = 0; i < 2; ++i) { int R, C; stage_rc(tid * 16 + i * 8192, R, C); voffA[i] = (unsigned)(R * g.lda + C) * 2u; voffB[i] = (unsigned)(R * K + C) * 2u; }
    const size_t kstep = (size_t)(BK * 2);
    const size_t hA = (size_t)HALF * g.lda * 2, tA = 2 * hA, hB = (size_t)HALF * K * 2, tB = 2 * hB;
    const unsigned ldsw = (unsigned)wid * 1024u;
    const int aoff = lds_byte(wr * 64 + fr, fq * 8), boff = lds_byte(wc * 32 + fr, fq * 8);
#define PG8_SA(b, h) (((b) * 2 + (h)) * HTB)
#define PG8_SB(b, h) ((4 + (b) * 2 + (h)) * HTB)
#define PG8_STAGE(bufoff, gbase, voff) do { _Pragma("unroll") for (int _i = 0; _i < 2; ++_i) \
        __builtin_amdgcn_global_load_lds((const unsigned*)((const char*)(gbase) + (voff)[_i]), (LAS unsigned*)(lds + (bufoff) + ldsw + _i * 8192), 16, 0, 0); } while (0)
#define PG8_LDA(dst, b, h) do { _Pragma("unroll") for (int m = 0; m < 4; ++m) _Pragma("unroll") for (int k = 0; k < 2; ++k) dst[m][k] = *(const LAS bf16x8*)(lds + PG8_SA(b, h) + aoff + m * 2048 + k * 1024); } while (0)
#define PG8_LDB(dst, b, h) do { _Pragma("unroll") for (int n = 0; n < 2; ++n) _Pragma("unroll") for (int k = 0; k < 2; ++k) dst[n][k] = *(const LAS bf16x8*)(lds + PG8_SB(b, h) + boff + n * 2048 + k * 1024); } while (0)
#define PG8_MMA(ai, bj, At, Bt) do { __builtin_amdgcn_s_setprio(1); _Pragma("unroll") for (int m = 0; m < 4; ++m) _Pragma("unroll") for (int n = 0; n < 2; ++n) _Pragma("unroll") for (int k = 0; k < 2; ++k) \
        acc[ai][bj][m][n] = __builtin_amdgcn_mfma_f32_16x16x32_bf16(Bt[n][k], At[m][k], acc[ai][bj][m][n], 0, 0, 0); __builtin_amdgcn_s_setprio(0); } while (0)
#define PG8_WAIT_V(n) asm volatile("s_waitcnt vmcnt(" #n ")" ::: "memory")
#define PG8_WAIT_L(n) asm volatile("s_waitcnt lgkmcnt(" #n ")" ::: "memory")
#define PG8_BAR __builtin_amdgcn_s_barrier()
#define PG8_SCHED __builtin_amdgcn_sched_barrier(0)
    Unit cur, nxt; int ui = 0;
    if (!S.next(0, cur)) return;
    f32x4 acc[2][2][4][2];
#pragma unroll
    for (int a = 0; a < 2; ++a)
#pragma unroll
        for (int b = 0; b < 2; ++b)
#pragma unroll
            for (int m = 0; m < 4; ++m)
#pragma unroll
                for (int n = 0; n < 2; ++n) acc[a][b][m][n] = (f32x4){0.f, 0.f, 0.f, 0.f};
    bf16x8 At[4][2], B0[2][2], B1[2][2];
    const char* cA = (const char*)g.A + (size_t)cur.pm * tA; const char* cB = (const char*)g.Bt + (size_t)cur.pn * tB;
    PG8_STAGE(PG8_SB(0, 0), cB, voffB); PG8_STAGE(PG8_SB(0, 1), cB + hB, voffB); PG8_STAGE(PG8_SA(0, 0), cA, voffA); PG8_STAGE(PG8_SA(0, 1), cA + hA, voffA);
    if (wr == 1) PG8_BAR;
    PG8_WAIT_V(2); PG8_BAR;
    PG8_STAGE(PG8_SB(1, 0), cB + kstep, voffB); PG8_STAGE(PG8_SA(1, 0), cA + kstep, voffA); PG8_STAGE(PG8_SB(1, 1), cB + hB + kstep, voffB);
    PG8_WAIT_V(6); PG8_BAR;
    for (;;) {
        const bool has_next = S.next(ui + 1, nxt);
        const char* nA = has_next ? (const char*)g.A + (size_t)nxt.pm * tA : cA; const char* nB = has_next ? (const char*)g.Bt + (size_t)nxt.pn * tB : cB;
        for (int t = 0; t < nt; t += 2) {
            const bool last = (t == nt - 2);
            const char* a1 = cA + (size_t)(t + 1) * kstep;
            const char* a2 = last ? nA : cA + (size_t)(t + 2) * kstep; const char* b2 = last ? nB : cB + (size_t)(t + 2) * kstep;
            const char* a3 = a2 + kstep; const char* b3 = b2 + kstep;
            PG8_LDB(B0, 0, 0); PG8_LDB(B1, 0, 1); PG8_SCHED; PG8_LDA(At, 0, 0); PG8_STAGE(PG8_SA(1, 1), a1 + hA, voffA);
            PG8_WAIT_V(8); PG8_WAIT_L(0); PG8_BAR; PG8_MMA(0, 0, At, B0); PG8_MMA(0, 1, At, B1); PG8_BAR; PG8_SCHED;
            PG8_LDA(At, 0, 1); PG8_STAGE(PG8_SB(0, 0), b2, voffB); PG8_STAGE(PG8_SB(0, 1), b2 + hB, voffB); PG8_STAGE(PG8_SA(0, 0), a2, voffA);
            PG8_WAIT_V(8); PG8_WAIT_L(0); PG8_BAR; PG8_MMA(1, 0, At, B0); PG8_MMA(1, 1, At, B1); PG8_BAR; PG8_SCHED;
            PG8_LDB(B0, 1, 0); PG8_LDB(B1, 1, 1); PG8_SCHED; PG8_LDA(At, 1, 0); PG8_STAGE(PG8_SA(0, 1), a2 + hA, voffA);
            PG8_WAIT_V(8); PG8_WAIT_L(0); PG8_BAR; PG8_MMA(0, 0, At, B0); PG8_MMA(0, 1, At, B1); PG8_BAR; PG8_SCHED;
            PG8_LDA(At, 1, 1); PG8_STAGE(PG8_SB(1, 0), b3, voffB); PG8_STAGE(PG8_SB(1, 1), b3 + hB, voffB); PG8_STAGE(PG8_SA(1, 0), a3, voffA);
            PG8_WAIT_V(8); PG8_WAIT_L(0); PG8_BAR; PG8_MMA(1, 0, At, B0); PG8_MMA(1, 1, At, B1); PG8_BAR; PG8_SCHED;
        }
        if constexpr (ALIGN_EPI) { if (wr == 0) PG8_BAR; }
        E(acc, cur, wr, wc, fr, fq);
        if (!has_next) break;
#pragma unroll
        for (int a = 0; a < 2; ++a)
#pragma unroll
            for (int b = 0; b < 2; ++b)
#pragma unroll
                for (int m = 0; m < 4; ++m)
#pragma unroll
                    for (int n = 0; n < 2; ++n) acc[a][b][m][n] = (f32x4){0.f, 0.f, 0.f, 0.f};
        cur = nxt; cA = nA; cB = nB; ++ui;
        if constexpr (ALIGN_EPI) { if (wr == 1) PG8_BAR; }
    }
    PG8_WAIT_V(0);
    if constexpr (!ALIGN_EPI) { if (wr == 0) PG8_BAR; }
    PG8_BAR;
#undef PG8_SA
#undef PG8_SB
#undef PG8_STAGE
#undef PG8_LDA
#undef PG8_LDB
#undef PG8_MMA
#undef PG8_WAIT_V
#undef PG8_WAIT_L
#undef PG8_BAR
#undef PG8_SCHED
}
}
using pg8::Unit;

typedef const f32x4 (&AccRef)[2][2][4][2];
struct EpiSwiglu {
    bf16* G; const float* pq;
    __device__ __forceinline__ void operator()(AccRef acc, const Unit& u, int wr, int wc, int fr, int fq) const {
        const int row0 = u.pm * 256 + wr * 64 + fr, j0 = u.pn * 128 + wc * 32 + 8 * fq;
#pragma unroll
        for (int ai = 0; ai < 2; ++ai)
#pragma unroll
            for (int m = 0; m < 4; ++m) {
                const int row = row0 + ai * 128 + m * 16; float s = 1.f;
                if (pq) { const f32x4 pv = *(const f32x4*)(pq + (size_t)row * 16 + 4 * fq); float t = (pv.x + pv.y) + (pv.z + pv.w); t += __shfl_xor(t, 16); t += __shfl_xor(t, 32); s = __builtin_amdgcn_rsqf(t * (1.f / D) + EPS); }
                float o[8];
#pragma unroll
                for (int n = 0; n < 2; ++n)
#pragma unroll
                    for (int i = 0; i < 4; ++i) { const float a = acc[ai][0][m][n][i] * s, b = acc[ai][1][m][n][i] * s; o[4 * n + i] = siluf_(a) * b; }
                v4u w; w.x = cvt_pk_bf16(o[0], o[1]); w.y = cvt_pk_bf16(o[2], o[3]); w.z = cvt_pk_bf16(o[4], o[5]); w.w = cvt_pk_bf16(o[6], o[7]);
                *(v4u*)(G + (size_t)row * FF + j0) = w;
            }
    }
};
template <bool WRITE_HB, bool WRITE_PQ> struct EpiResid {
    const float* baseP; const float* baseS; float* outP; float* outS; bf16* HB; float* pq; float scale;
    __device__ __forceinline__ void operator()(AccRef acc, const Unit& u, int wr, int wc, int fr, int fq) const {
        const int row0 = u.pm * 256 + wr * 64 + fr, c0 = u.pn * 256 + wc * 32 + 8 * fq; const bool smp = u.pm >= MP / 256;
#pragma unroll
        for (int ai = 0; ai < 2; ++ai)
#pragma unroll
            for (int m = 0; m < 4; ++m) {
                const int row = row0 + ai * 128 + m * 16; const size_t ro = smp ? (size_t)(row - MP) * D : (size_t)row * D;
                const float* bp = (smp ? baseS : baseP) + ro + c0; float* op = (smp ? outS : outP) + ro + c0; float ss = 0.f;
#pragma unroll
                for (int bj = 0; bj < 2; ++bj) {
                    const f32x4 b0 = *(const f32x4*)(bp + bj * 128), b1 = *(const f32x4*)(bp + bj * 128 + 4);
                    const f32x4 o0 = b0 + acc[ai][bj][m][0] * scale, o1 = b1 + acc[ai][bj][m][1] * scale;
                    *(f32x4*)(op + bj * 128) = o0; *(f32x4*)(op + bj * 128 + 4) = o1;
                    if (WRITE_HB) { v4u w; w.x = cvt_pk_bf16(o0.x, o0.y); w.y = cvt_pk_bf16(o0.z, o0.w); w.z = cvt_pk_bf16(o1.x, o1.y); w.w = cvt_pk_bf16(o1.z, o1.w); *(v4u*)(HB + (size_t)row * D + c0 + bj * 128) = w; }
                    if (WRITE_PQ) ss += (o0.x * o0.x + o0.y * o0.y) + (o0.z * o0.z + o0.w * o0.w) + (o1.x * o1.x + o1.y * o1.y) + (o1.z * o1.z + o1.w * o1.w);
                }
                if (WRITE_PQ) { ss += __shfl_xor(ss, 16); ss += __shfl_xor(ss, 32); if (fq == 0) pq[(size_t)row * 16 + u.pn * 4 + wc] = ss; }
            }
    }
};
struct EpiMemKV {
    float* out; bf16* MKV;
    __device__ __forceinline__ void operator()(AccRef acc, const Unit& u, int wr, int wc, int fr, int fq) const {
        const int row0 = u.pm * 256 + wr * 64 + fr, c0 = u.pn * 256 + wc * 32 + 8 * fq;
#pragma unroll
        for (int ai = 0; ai < 2; ++ai)
#pragma unroll
            for (int m = 0; m < 4; ++m) {
                const int row = row0 + ai * 128 + m * 16;
#pragma unroll
                for (int bj = 0; bj < 2; ++bj) { const f32x4 o0 = acc[ai][bj][m][0], o1 = acc[ai][bj][m][1]; float* op = out + (size_t)row * D + c0 + bj * 128;
                    *(f32x4*)op = o0; *(f32x4*)(op + 4) = o1;
                    v4u w; w.x = cvt_pk_bf16(o0.x, o0.y); w.y = cvt_pk_bf16(o0.z, o0.w); w.z = cvt_pk_bf16(o1.x, o1.y); w.w = cvt_pk_bf16(o1.z, o1.w); *(v4u*)(MKV + (size_t)row * D + c0 + bj * 128) = w; }
            }
    }
};
template <int BR> struct EpiMerge {
    const bf16* GATE; float* T; bf16* MB;
    __device__ __forceinline__ void operator()(AccRef acc, const Unit& u, int wr, int wc, int fr, int fq) const {
        const int row0 = u.pm * 256 + wr * 64 + fr, c0 = u.pn * 256 + wc * 32 + 8 * fq;
#pragma unroll
        for (int ai = 0; ai < 2; ++ai)
#pragma unroll
            for (int m = 0; m < 4; ++m) {
                const int row = row0 + ai * 128 + m * 16;
#pragma unroll
                for (int bj = 0; bj < 2; ++bj) {
                    const v4u gw = *(const v4u*)(GATE + (size_t)row * 3072 + BR * 1024 + c0 + bj * 128);
                    float* tp = T + (size_t)row * D + c0 + bj * 128;
                    f32x4 o0 = acc[ai][bj][m][0] * (f32x4){bflo(gw.x), bfhi(gw.x), bflo(gw.y), bfhi(gw.y)}, o1 = acc[ai][bj][m][1] * (f32x4){bflo(gw.z), bfhi(gw.z), bflo(gw.w), bfhi(gw.w)};
#ifndef MK_E3
                    if (BR > 0) { o0 += *(const f32x4*)tp; o1 += *(const f32x4*)(tp + 4); }
#endif
                    if (BR < 2) { *(f32x4*)tp = o0; *(f32x4*)(tp + 4) = o1; }
                    else { v4u w; w.x = cvt_pk_bf16(o0.x, o0.y); w.y = cvt_pk_bf16(o0.z, o0.w); w.z = cvt_pk_bf16(o1.x, o1.y); w.w = cvt_pk_bf16(o1.z, o1.w); *(v4u*)(MB + (size_t)row * D + c0 + bj * 128) = w; }
                }
            }
    }
};
struct EpiZ {
    const float* pq; const float* ropeC; const float* ropeS; const float* bga; float* out;
    bf16 *QS, *KS, *VS, *GQ, *GK, *GV, *GRS, *MQ, *GATE; float* GA;
    template <int ACT> __device__ __forceinline__ void plain(AccRef acc, const float (&rs)[2][4], int row0, bf16* dst, int ld, int col0, float scale) const {
#pragma unroll
        for (int ai = 0; ai < 2; ++ai)
#pragma unroll
            for (int m = 0; m < 4; ++m) { const int row = row0 + ai * 128 + m * 16; const float s = rs[ai][m];
#pragma unroll
                for (int bj = 0; bj < 2; ++bj) { float o[8];
#pragma unroll
                    for (int n = 0; n < 2; ++n)
#pragma unroll
                        for (int i = 0; i < 4; ++i) { const float x = acc[ai][bj][m][n][i] * s; o[4 * n + i] = ACT == 0 ? x * scale : (ACT == 1 ? siluf_(x) : sigmoidf_(x)); }
                    v4u w; w.x = cvt_pk_bf16(o[0], o[1]); w.y = cvt_pk_bf16(o[2], o[3]); w.z = cvt_pk_bf16(o[4], o[5]); w.w = cvt_pk_bf16(o[6], o[7]);
                    *(v4u*)(dst + (size_t)row * ld + col0 + bj * 128) = w; } }
    }
    __device__ __forceinline__ float* swa_dst(int row, int g, int kv, int h) const {
        if (row >= MP) return out + (g == 0 ? O_SWA0S : (g == 1 ? O_SWA1S : O_SWA2S)) + ((size_t)(row - MP) * 2 + kv) * 512 + h * 128;
        const int b = row >> 11, t = row & 2047, keep = 128 << (2 * g), t0 = SEQ - keep;
        if (t < t0) return nullptr;
        return out + (g == 0 ? O_SWA0P : (g == 1 ? O_SWA1P : O_SWA2P)) + (((size_t)b * keep + (t - t0)) * 2 + kv) * 512 + h * 128;
    }
    __device__ __forceinline__ void operator()(AccRef acc, const Unit& u, int wr, int wc, int fr, int fq) const {
        const int row0 = u.pm * 256 + wr * 64 + fr, pn = u.pn, cl = wc * 32 + 8 * fq;
        float rs[2][4];
#pragma unroll
        for (int ai = 0; ai < 2; ++ai)
#pragma unroll
            for (int m = 0; m < 4; ++m) { const int row = row0 + ai * 128 + m * 16;
                const f32x4 pv = *(const f32x4*)(pq + (size_t)row * 16 + 4 * fq); float t = (pv.x + pv.y) + (pv.z + pv.w); t += __shfl_xor(t, 16); t += __shfl_xor(t, 32); rs[ai][m] = __builtin_amdgcn_rsqf(t * (1.f / D) + EPS); }
        if (pn < 12) {
            const int isk = pn >= 6, g = (pn % 6) >> 1, hp = pn & 1, e0 = wc * 16 + 4 * fq;
#pragma unroll
            for (int ai = 0; ai < 2; ++ai)
#pragma unroll
                for (int m = 0; m < 4; ++m) { const int row = row0 + ai * 128 + m * 16; const float s = rs[ai][m];
                    const int pidx = row < MP ? (row & 2047) : SEQ + ((row - MP) & 3);
                    const f32x4 cs = *(const f32x4*)(ropeC + pidx * 64 + e0), sn = *(const f32x4*)(ropeS + pidx * 64 + e0);
#pragma unroll
                    for (int bj = 0; bj < 2; ++bj) { const int h = 2 * hp + bj;
                        const f32x4 x1 = acc[ai][bj][m][0] * s, x2 = acc[ai][bj][m][1] * s;
                        f32x4 r1 = x1 * cs - x2 * sn, r2 = x2 * cs + x1 * sn;
                        if (!isk) { r1 *= QSCALE; r2 *= QSCALE; }
                        bf16* dp = (isk ? KS : QS) + (size_t)row * 1536 + g * 512 + h * 128 + e0;
                        v2u w1, w2; w1.x = cvt_pk_bf16(r1.x, r1.y); w1.y = cvt_pk_bf16(r1.z, r1.w); w2.x = cvt_pk_bf16(r2.x, r2.y); w2.y = cvt_pk_bf16(r2.z, r2.w);
                        *(v2u*)dp = w1; *(v2u*)(dp + 64) = w2;
                        if (isk) { float* fo = swa_dst(row, g, 0, h); if (fo) { *(f32x4*)(fo + e0) = r1; *(f32x4*)(fo + 64 + e0) = r2; } }
                    } }
        } else if (pn < 18) {
            const int g = (pn - 12) >> 1, hp = pn & 1;
#pragma unroll
            for (int ai = 0; ai < 2; ++ai)
#pragma unroll
                for (int m = 0; m < 4; ++m) { const int row = row0 + ai * 128 + m * 16; const float s = rs[ai][m];
#pragma unroll
                    for (int bj = 0; bj < 2; ++bj) { const int h = 2 * hp + bj; const f32x4 o0 = acc[ai][bj][m][0] * s, o1 = acc[ai][bj][m][1] * s;
                        v4u w; w.x = cvt_pk_bf16(o0.x, o0.y); w.y = cvt_pk_bf16(o0.z, o0.w); w.z = cvt_pk_bf16(o1.x, o1.y); w.w = cvt_pk_bf16(o1.z, o1.w);
                        *(v4u*)(VS + (size_t)row * 1536 + g * 512 + h * 128 + cl) = w;
                        float* fo = swa_dst(row, g, 1, h); if (fo) { *(f32x4*)(fo + cl) = o0; *(f32x4*)(fo + cl + 4) = o1; } } }
        } else if (pn == 18) plain<0>(acc, rs, row0, GQ, 256, cl, 0.125f);
        else if (pn == 19) plain<0>(acc, rs, row0, GK, 256, cl, 1.f);
        else if (pn < 22) plain<0>(acc, rs, row0, GV, 512, (pn - 20) * 256 + cl, 1.f);
        else if (pn < 24) plain<1>(acc, rs, row0, GRS, 512, (pn - 22) * 256 + cl, 1.f);
        else if (pn == 24) {
#pragma unroll
            for (int ai = 0; ai < 2; ++ai)
#pragma unroll
                for (int m = 0; m < 4; ++m) { const int row = row0 + ai * 128 + m * 16; const float s = rs[ai][m];
#pragma unroll
                    for (int bj = 0; bj < 2; ++bj)
#pragma unroll
                        for (int n = 0; n < 2; ++n) { const int c = bj * 128 + cl + 4 * n; const f32x4 bv = *(const f32x4*)(bga + c); f32x4 o;
#pragma unroll
                            for (int i = 0; i < 4; ++i) { const float x = acc[ai][bj][m][n][i] * s + bv[i];
                                o[i] = (fminf(x, 0.f) - LN2 * fast_log2(1.f + fast_exp2(-1.4426950408889634f * fabsf(x)))) * (1.f / 16.f); }
                            *(f32x4*)(GA + (size_t)row * 256 + c) = o; } }
        } else if (pn < 27) plain<0>(acc, rs, row0, MQ, 512, (pn - 25) * 256 + cl, QSCALE);
        else plain<2>(acc, rs, row0, GATE, 3072, (pn - 27) * 256 + cl, 1.f);
    }
};

#define XB_TMO      128
#define XB_XCNT(j)  (256  + 64 * (j))
#define XB_XSUB(j)  (1280 + 64 * (j))
#define XB_XGEN(j)  (2304 + 64 * (j))
#define XB_TOP      3328
#define XB_TOPGEN   3392
#define XCD_BAR_WORDS 3456
#define XB_SPIN_CAP (1u << 18)
__device__ __forceinline__ unsigned xb_ld(unsigned* p)              { return __hip_atomic_load(p, __ATOMIC_RELAXED, __HIP_MEMORY_SCOPE_AGENT); }
__device__ __forceinline__ unsigned xb_add(unsigned* p, unsigned v) { return __hip_atomic_fetch_add(p, v, __ATOMIC_RELAXED, __HIP_MEMORY_SCOPE_AGENT); }
__device__ __forceinline__ unsigned xb_xcc_id() { return (unsigned)__builtin_amdgcn_s_getreg((3 << 11) | 20) & 0xFu; }
#define XB_SPIN(cond, bar) do { unsigned _sp = 0; while (cond) { __builtin_amdgcn_s_sleep(1); \
    if ((++_sp & 255u) == 0u) { if (xb_ld(&(bar)[XB_TMO])) break; if (_sp > XB_SPIN_CAP) { atomicAdd(&(bar)[XB_TMO], 1u); break; } } } } while (0)
struct XcdBarrier { unsigned* bar; unsigned x; volatile LAS unsigned* st; };
__device__ __forceinline__ XcdBarrier xcd_barrier_post(unsigned* bar, volatile LAS unsigned* st) {
    XcdBarrier b; b.bar = bar; b.x = xb_xcc_id(); b.st = st;
    if (threadIdx.x == 0) (void)xb_add(&bar[XB_XCNT(b.x)], 1u);
    return b;
}
__device__ __forceinline__ void xcd_barrier_complete(unsigned* bar, unsigned x, unsigned& nloc, unsigned& nx) {
    const unsigned G = gridDim.x * gridDim.y * gridDim.z;
    unsigned sum, cnt, mine, sp = 0u;
    for (;;) {
        sum = 0u; cnt = 0u; mine = 0u;
#pragma unroll
        for (unsigned j = 0; j < 16; ++j) { const unsigned c = xb_ld(&bar[XB_XCNT(j)]); sum += c; cnt += (c > 0u) ? 1u : 0u; mine = (j == x) ? c : mine; }
        if (sum == G) break;
        __builtin_amdgcn_s_sleep(1);
        if ((++sp & 255u) == 0u) { if (xb_ld(&bar[XB_TMO])) break; if (sp > XB_SPIN_CAP) { atomicAdd(&bar[XB_TMO], 1u); break; } }
    }
    nloc = mine > 0u ? mine : 1u; nx = cnt > 0u ? cnt : 1u;
}
__device__ __forceinline__ void xcd_barrier(const XcdBarrier& b) {
    asm volatile("s_waitcnt vmcnt(0)" ::: "memory");
    __syncthreads();
    if (threadIdx.x == 0) {
        unsigned* bar = b.bar;
        __builtin_amdgcn_s_waitcnt(0);
        unsigned nloc = b.st[0], nx = b.st[1];
        if (nloc == 0u) { xcd_barrier_complete(bar, b.x, nloc, nx); b.st[0] = nloc; b.st[1] = nx; }
        const unsigned old = xb_add(&bar[XB_XSUB(b.x)], 1u);
        const unsigned gen = old / nloc;
        if (old + 1u == (gen + 1u) * nloc) {
            __builtin_amdgcn_fence(__ATOMIC_RELEASE, "agent");
            asm volatile("s_waitcnt vmcnt(0)" ::: "memory");
            const unsigned og = xb_add(&bar[XB_TOP], 1u);
            const unsigned tg = og / nx;
            if (og + 1u == (tg + 1u) * nx) xb_add(&bar[XB_TOPGEN], 1u);
            else XB_SPIN(xb_ld(&bar[XB_TOPGEN]) == tg, bar);
            __builtin_amdgcn_fence(__ATOMIC_ACQUIRE, "agent");
            xb_add(&bar[XB_XGEN(b.x)], 1u);
            asm volatile("s_waitcnt vmcnt(0)" ::: "memory");
        } else {
            XB_SPIN(xb_ld(&bar[XB_XGEN(b.x)]) == gen, bar);
            __builtin_amdgcn_fence(__ATOMIC_ACQUIRE, "agent");
            asm volatile("s_waitcnt vmcnt(0)" ::: "memory");
        }
    }
    __syncthreads();
}

struct Args { const float* in[25]; float* out; unsigned char* ws; int ph_lo, ph_hi, li, pad; };
struct Frame {
    LAS unsigned char* lds; int tid, lane, wave, vcu, G;
    const float *i0, *i1, *i2, *i3, *i4, *i5, *i6, *i7, *i8, *i9, *i10, *i11, *i12, *i13, *i14, *i15, *i16, *i17, *i18, *i19, *i20, *i21, *i22, *i23, *i24;
    float* out; unsigned char* ws;
};
__device__ __forceinline__ float wave_sum(float v) {
#pragma unroll
    for (int o = 1; o < 64; o <<= 1) v += __shfl_xor(v, o);
    return v;
}

enum WKind { WK_PLAIN = 0, WK_SWIGLU = 1, WK_IN = 2 };
__device__ __forceinline__ int p0_win_col(int np) {
    const int pn = np >> 8, r = np & 255;
    if (pn < 18) { const int qkv = pn / 6, g = (pn % 6) >> 1, hp = pn & 1, h = 2 * hp + (r >> 7); const int d = qkv < 2 ? sig_rope(r & 127) : sig_plain(r & 127); return ((qkv * 3 + g) * 4 + h) * 128 + d; }
    const int c = sig_plain(r);
    if (pn == 18) return 4608 + c;
    if (pn == 19) return 4864 + c;
    if (pn < 22) return 5120 + (pn - 20) * 256 + c;
    if (pn < 24) return 5632 + (pn - 22) * 256 + c;
    if (pn == 24) return -1 - c;
    if (pn < 27) return 6160 + (pn - 25) * 256 + c;
    return DIN + (pn - 27) * 256 + c;
}
__device__ __forceinline__ void p0_item(const Frame& F, int kind, const float* W, int ldw, const float* W2, const float* gain, const float* a2, bf16* WT, int K, int kb, int nb, LAS float* scr) {
    const int lane = F.lane, k0 = 64 * kb, n0 = 32 * nb, np = n0 + (lane & 31);
    int sc; const float* Wp = W; int ld = ldw;
    if (kind == WK_PLAIN) sc = sig_plain(np);
    else if (kind == WK_SWIGLU) { const int r = np & 255; sc = (r >> 7) * FF + (np >> 8) * 128 + sig_plain(r & 127); }
    else { sc = p0_win_col(np); if (sc >= DIN) { sc -= DIN; Wp = W2; ld = 3072; } }
    if (sc >= 0) {
#pragma unroll 8
        for (int i = 0; i < 32; ++i) { const int kk = 2 * i + (lane >> 5); float v = Wp[(size_t)(k0 + kk) * ld + sc]; if (gain) v *= gain[k0 + kk]; scr[kk * 33 + (lane & 31)] = v; }
    } else {
        const int j = -1 - sc; float a2c[16];
#pragma unroll
        for (int r = 0; r < 16; ++r) a2c[r] = a2[r * 256 + j];
        for (int i = 0; i < 32; ++i) { const int kk = 2 * i + (lane >> 5); const float* wr_ = W + (size_t)(k0 + kk) * ldw + 6144; float v = 0.f;
#pragma unroll
            for (int r = 0; r < 16; ++r) v += wr_[r] * a2c[r];
            scr[kk * 33 + (lane & 31)] = v * gain[k0 + kk]; }
    }
    LDS_WAIT(); asm volatile("" ::: "memory");
    const int c = lane & 7;
#pragma unroll
    for (int j = 0; j < 4; ++j) { const int n = (lane >> 3) + 8 * j; const LAS float* s = scr + (8 * c) * 33 + n;
        v4u o; o.x = pk2(s[0 * 33], s[1 * 33]); o.y = pk2(s[2 * 33], s[3 * 33]); o.z = pk2(s[4 * 33], s[5 * 33]); o.w = pk2(s[6 * 33], s[7 * 33]);
        *(GAS v4u*)(WT + (size_t)(n0 + n) * K + k0 + 8 * c) = o; }
    LDS_WAIT(); asm volatile("" ::: "memory");
}
__device__ __forceinline__ void rms_row_to_bf16(int lane, const float* xrow, const float* gain, bf16* orow) {
    const GAS f32x4* xr = (const GAS f32x4*)xrow + lane; const GAS f32x4* gr = (const GAS f32x4*)gain + lane;
    f32x4 v[4]; float s = 0.f;
#pragma unroll
    for (int j = 0; j < 4; ++j) { v[j] = xr[64 * j]; s += (v[j].x * v[j].x + v[j].y * v[j].y) + (v[j].z * v[j].z + v[j].w * v[j].w); }
    const float rstd = 1.0f / sqrtf(wave_sum(s) * (1.f / D) + EPS);
    GAS v2u* o8 = (GAS v2u*)orow + lane;
#pragma unroll
    for (int j = 0; j < 4; ++j) { const f32x4 gg = gr[64 * j]; v2u w; w.x = pk2(v[j].x * rstd * gg.x, v[j].y * rstd * gg.y); w.y = pk2(v[j].z * rstd * gg.z, v[j].w * rstd * gg.w); o8[64 * j] = w; }
}
__device__ __forceinline__ void sincos_d(double x, double& s, double& c) {
    const double TWO_PI = 6.283185307179586476925286766559;
    const double n = __builtin_rint(x / TWO_PI); const double r = x - n * TWO_PI, r2 = r * r;
    double ts = 1.0, tc = 1.0;
#pragma unroll
    for (int k = 14; k >= 1; --k) { ts = 1.0 - ts * r2 / (double)((2 * k) * (2 * k + 1)); tc = 1.0 - tc * r2 / (double)((2 * k - 1) * (2 * k)); }
    s = ts * r; c = tc;
}
__device__ __forceinline__ void p0_prologue(Frame& F) {
    unsigned char* ws = F.ws;
    LAS float* scr = (LAS float*)(F.lds + RING_OFF + F.wave * 16384);
    const int gw = F.vcu * NWAVES + F.wave, NGW = F.G * NWAVES;
    constexpr int I_A = 16 * 176, I_O = 44 * 32, I_IN = 16 * 312, I_BR = 8 * 32, I_SQ = 16 * 32;
    constexpr int NITEMS = 2 * I_A + 2 * I_O + I_IN + 3 * I_BR + 2 * I_SQ;
    for (int it = gw; it < NITEMS; it += NGW) {
        int r = it;
        if (r < I_A) { p0_item(F, WK_SWIGLU, F.i9, 2 * FF, nullptr, nullptr, nullptr, (bf16*)(ws + WS_W1A), D, r / 176, r % 176, scr); continue; } r -= I_A;
        if (r < I_A) { p0_item(F, WK_SWIGLU, F.i22, 2 * FF, nullptr, F.i21, nullptr, (bf16*)(ws + WS_W2A), D, r / 176, r % 176, scr); continue; } r -= I_A;
        if (r < I_O) { p0_item(F, WK_PLAIN, F.i10, D, nullptr, nullptr, nullptr, (bf16*)(ws + WS_W1O), FF, r / 32, r % 32, scr); continue; } r -= I_O;
        if (r < I_O) { p0_item(F, WK_PLAIN, F.i23, D, nullptr, nullptr, nullptr, (bf16*)(ws + WS_W2O), FF, r / 32, r % 32, scr); continue; } r -= I_O;
        if (r < I_IN) { p0_item(F, WK_IN, F.i12, DIN, F.i16, F.i11, F.i13, (bf16*)(ws + WS_WIN), D, r / 312, r % 312, scr); continue; } r -= I_IN;
        if (r < 3 * I_BR) { const int br = r / I_BR, q = r % I_BR; p0_item(F, WK_PLAIN, F.i17 + (size_t)br * 512 * D, D, nullptr, nullptr, nullptr, (bf16*)(ws + WS_WBR) + (size_t)br * D * 512, 512, q / 32, q % 32, scr); continue; } r -= 3 * I_BR;
        if (r < I_SQ) { p0_item(F, WK_PLAIN, F.i18, D, nullptr, nullptr, nullptr, (bf16*)(ws + WS_WOUT), D, r / 32, r % 32, scr); continue; } r -= I_SQ;
        p0_item(F, WK_PLAIN, F.i20, D, nullptr, nullptr, nullptr, (bf16*)(ws + WS_WMEM), D, r / 32, r % 32, scr);
    }
    for (int m = gw; m < MR + MM; m += NGW) {
        if (m < MP) rms_row_to_bf16(F.lane, F.i0 + (size_t)m * D, F.i8, (bf16*)(ws + WS_XB) + (size_t)m * D);
        else if (m < MR) rms_row_to_bf16(F.lane, F.i1 + (size_t)(m - MP) * D, F.i8, (bf16*)(ws + WS_XB) + (size_t)m * D);
        else rms_row_to_bf16(F.lane, F.i2 + (size_t)(m - MR) * D, F.i19, (bf16*)(ws + WS_MEMB) + (size_t)(m - MR) * D);
    }
    float* rc = (float*)(ws + WS_ROPE); float* rsn = rc + NPOS * 64;
    for (int i = (F.vcu * NWAVES * 64) + F.tid; i < NPOS * 64; i += F.G * NWAVES * 64) {
        const int p = i >> 6, e = i & 63; const int pos = p < SEQ ? p : PAST + (p - SEQ);
        const double y = -(double)e * 9.210340371976182736 / 64.0 / 16.0; double ex = 1.0;
#pragma unroll
        for (int k = 14; k >= 1; --k) ex = 1.0 + ex * y / (double)k;
        ex *= ex; ex *= ex; ex *= ex; ex *= ex;
        const float inv = (float)ex; const float ang = (float)pos * inv;
        double s, c; sincos_d((double)ang, s, c); rc[i] = (float)c; rsn[i] = (float)s;
    }
}

__device__ __forceinline__ int koff(int row, int ch) { return 256 * row + 16 * (ch ^ (row & 15)); }
__device__ __forceinline__ int voff(int row, int ch) { return 256 * row + 16 * (ch ^ ((row & 7) << 1)); }
typedef short v4i16_t __attribute__((ext_vector_type(4)));
__device__ __forceinline__ s16x4 vtr(const LAS unsigned char* p) { return __builtin_bit_cast(s16x4, __builtin_amdgcn_ds_read_tr16_b64_v4i16((LAS v4i16_t*)p)); }
template <int MODE>
__device__ __forceinline__ void attn_unit(const Frame& F, const bf16* Qp, int qpitch, const bf16* Kp, const bf16* Vp, int kpitch, long qrow0, int qstride, long krow0, int kstride, int kmin,
                                          bf16* Op, int opitch, float* lsep) {
    LAS unsigned char* ldsK = F.lds + RING_OFF; LAS unsigned char* ldsV = F.lds + RING_OFF + 65536;
    const int tid = F.tid, lane = F.lane, w = F.wave, l15 = lane & 15, g4 = lane >> 4;
    __syncthreads();
    {   const int c = tid & 15, r0 = tid >> 4; v4u kv[8], vv[8];
#pragma unroll
        for (int i = 0; i < 8; ++i) { const int kj = r0 + 32 * i; const long row = krow0 + (long)(kj < kmin ? kmin : kj) * kstride;
            kv[i] = *(const v4u*)(Kp + row * kpitch + c * 8); vv[i] = *(const v4u*)(Vp + row * kpitch + c * 8); }
#pragma unroll
        for (int i = 0; i < 8; ++i) { const int kj = r0 + 32 * i; *(LAS v4u*)(ldsK + koff(kj, c)) = kv[i]; *(LAS v4u*)(ldsV + voff(kj, c)) = vv[i]; }
    }
    const long qrow = qrow0 + (long)(16 * w + l15) * qstride;
    bf16x8 qf[4];
#pragma unroll
    for (int s = 0; s < 4; ++s) qf[s] = *(const bf16x8*)(Qp + qrow * qpitch + 32 * s + 8 * g4);
    __syncthreads();
    constexpr int NF = MODE == 0 ? 9 : 16, NP = (NF + 1) / 2;
    const int f0 = MODE == 0 ? w : 0;
    f32x4 S[NF];
#pragma unroll
    for (int i = 0; i < NF; ++i) { S[i] = (f32x4){0.f, 0.f, 0.f, 0.f}; const int krow = 16 * (f0 + i) + l15;
#pragma unroll
        for (int s = 0; s < 4; ++s) { const bf16x8 kf = *(const LAS bf16x8*)(ldsK + koff(krow, 4 * s + g4)); S[i] = __builtin_amdgcn_mfma_f32_16x16x32_bf16(kf, qf[s], S[i], 0, 0, 0); } }
    float mx = -3.0e38f;
    const int iq = 16 * w + l15;
#pragma unroll
    for (int i = 0; i < NF; ++i)
#pragma unroll
        for (int r = 0; r < 4; ++r) { if (MODE == 0) { const int kj = 16 * (f0 + i) + 4 * g4 + r; const bool ok = kj >= iq && kj <= iq + 128 && kj >= kmin; S[i][r] = ok ? S[i][r] : -3.0e38f; } mx = fmaxf(mx, S[i][r]); }
    mx = fmaxf(mx, __shfl_xor(mx, 16)); mx = fmaxf(mx, __shfl_xor(mx, 32));
    float ls = 0.f;
#pragma unroll
    for (int i = 0; i < NF; ++i)
#pragma unroll
        for (int r = 0; r < 4; ++r) { const float p = fast_exp2(S[i][r] - mx); S[i][r] = p; ls += p; }
    ls += __shfl_xor(ls, 16); ls += __shfl_xor(ls, 32);
    f32x4 O[8];
#pragma unroll
    for (int df = 0; df < 8; ++df) O[df] = (f32x4){0.f, 0.f, 0.f, 0.f};
    const int q4 = l15 >> 2, p4 = lane & 3;
#pragma unroll
    for (int pr = 0; pr < NP; ++pr) {
        const f32x4 pa = S[2 * pr], pb = (2 * pr + 1 < NF) ? S[(2 * pr + 1 < NF) ? 2 * pr + 1 : 0] : (f32x4){0.f, 0.f, 0.f, 0.f};
        v4u pw; pw.x = cvt_pk_bf16(pa.x, pa.y); pw.y = cvt_pk_bf16(pa.z, pa.w); pw.z = cvt_pk_bf16(pb.x, pb.y); pw.w = cvt_pk_bf16(pb.z, pb.w);
        const bf16x8 pf = __builtin_bit_cast(bf16x8, pw);
        const int fa = f0 + 2 * pr, fb = (fa + 1 > 15) ? 15 : fa + 1;
        const int ra = 16 * fa + 4 * g4 + q4, rb = 16 * fb + 4 * g4 + q4;
#pragma unroll
        for (int df = 0; df < 8; ++df) {
            const s16x4 t1 = vtr(ldsV + voff(ra, 2 * df + (p4 >> 1)) + 8 * (p4 & 1)), t2 = vtr(ldsV + voff(rb, 2 * df + (p4 >> 1)) + 8 * (p4 & 1));
            const bf16x8 vf = {t1[0], t1[1], t1[2], t1[3], t2[0], t2[1], t2[2], t2[3]};
            O[df] = __builtin_amdgcn_mfma_f32_16x16x32_bf16(vf, pf, O[df], 0, 0, 0);
        }
    }
    const float inv = 1.0f / ls;
    bf16* op = Op + qrow * opitch + 4 * g4;
#pragma unroll
    for (int df = 0; df < 8; ++df) { const f32x4 o = O[df] * inv; v2u wv; wv.x = cvt_pk_bf16(o.x, o.y); wv.y = cvt_pk_bf16(o.z, o.w); *(v2u*)(op + 16 * df) = wv; }
    if (MODE == 0 && g4 == 0) lsep[qrow * 12] = (mx + fast_log2(ls)) * LN2;
}
__device__ __forceinline__ void p4_attn_unit(const Frame& F, int id) {
    unsigned char* ws = F.ws;
    if (id < 6144) {
        const int b = id / 192, rem = id % 192, gh = rem >> 4, u = rem & 15, g = gh >> 2;
        const int dil = g == 0 ? 1 : (g == 1 ? 4 : 16), r = g == 0 ? 0 : (g == 1 ? (u & 3) : u), n = g == 0 ? u : (g == 1 ? (u >> 2) : 0);
        const long base = (long)b * SEQ + r;
        attn_unit<0>(F, (const bf16*)(ws + WS_QS) + gh * 128, 1536, (const bf16*)(ws + WS_KS) + gh * 128, (const bf16*)(ws + WS_VS) + gh * 128, 1536,
                     base + (long)128 * n * dil, dil, base + (long)128 * (n - 1) * dil, dil, n == 0 ? 128 : 0, (bf16*)(ws + WS_OG) + gh * 128, 1536, (float*)(ws + WS_LSE) + gh);
    } else {
        const int j = id - 6144, b = j >> 6, h = (j >> 4) & 3, n = j & 15;
        attn_unit<1>(F, (const bf16*)(ws + WS_MQ) + h * 128, 512, (const bf16*)(ws + WS_MKV) + h * 128, (const bf16*)(ws + WS_MKV) + 512 + h * 128, 1024,
                     (long)b * SEQ + 128 * n, 1, (long)b * MEML, 1, 0, (bf16*)(ws + WS_OALL) + 1024 + h * 128, 1536, nullptr);
    }
}
__device__ __forceinline__ void p4_sample_attn(const Frame& F, int wt, const float* c0, const float* c1, const float* c2, const float* cm) {
    unsigned char* ws = F.ws; const int lane = F.lane, sub = lane & 15, t = lane >> 4;
    const int db = wt >> 4, h = (wt >> 2) & 3, src = wt & 3;
    const int row = MP + db * 4 + t;
    const bf16* qp = src < 3 ? (const bf16*)(ws + WS_QS) + (size_t)row * 1536 + src * 512 + h * 128 + 8 * sub : (const bf16*)(ws + WS_MQ) + (size_t)row * 512 + h * 128 + 8 * sub;
    float q[8]; { const v4u qw = *(const v4u*)qp; q[0] = bflo(qw.x); q[1] = bfhi(qw.x); q[2] = bflo(qw.y); q[3] = bfhi(qw.y); q[4] = bflo(qw.z); q[5] = bfhi(qw.z); q[6] = bflo(qw.w); q[7] = bfhi(qw.w); }
    float mx = -3.0e38f, ls = 0.f, o[8];
#pragma unroll
    for (int j = 0; j < 8; ++j) o[j] = 0.f;
#define SA_STEP(K0, K1, V0, V1) do { float s_ = (q[0] * K0.x + q[1] * K0.y) + (q[2] * K0.z + q[3] * K0.w) + (q[4] * K1.x + q[5] * K1.y) + (q[6] * K1.z + q[7] * K1.w); \
        s_ += __shfl_xor(s_, 1); s_ += __shfl_xor(s_, 2); s_ += __shfl_xor(s_, 4); s_ += __shfl_xor(s_, 8); \
        const float mn_ = fmaxf(mx, s_), sc_ = fast_exp2(mx - mn_), p_ = fast_exp2(s_ - mn_); mx = mn_; ls = ls * sc_ + p_; \
        o[0] = o[0] * sc_ + p_ * V0.x; o[1] = o[1] * sc_ + p_ * V0.y; o[2] = o[2] * sc_ + p_ * V0.z; o[3] = o[3] * sc_ + p_ * V0.w; \
        o[4] = o[4] * sc_ + p_ * V1.x; o[5] = o[5] * sc_ + p_ * V1.y; o[6] = o[6] * sc_ + p_ * V1.z; o[7] = o[7] * sc_ + p_ * V1.w; } while (0)
    int nstart = 0, NK; const float* cache; int L = 256, dil = 1;
    if (src == 3) { cache = cm; NK = 256; }
    else { cache = src == 0 ? c0 : (src == 1 ? c1 : c2); L = 128 << (2 * src); dil = src == 0 ? 1 : (src == 1 ? 4 : 16); NK = 129; nstart = 4;
        for (int n = 0; n < 4; ++n) {
            const int idx = L + t - dil * n; f32x4 k0, k1, v0, v1;
            if (idx >= L) { const size_t ro = (size_t)(MP + db * 4 + (idx - L)) * 1536 + src * 512 + h * 128 + 8 * sub;
                const v4u kw = *(const v4u*)((const bf16*)(ws + WS_KS) + ro), vw = *(const v4u*)((const bf16*)(ws + WS_VS) + ro);
                k0 = (f32x4){bflo(kw.x), bfhi(kw.x), bflo(kw.y), bfhi(kw.y)}; k1 = (f32x4){bflo(kw.z), bfhi(kw.z), bflo(kw.w), bfhi(kw.w)};
                v0 = (f32x4){bflo(vw.x), bfhi(vw.x), bflo(vw.y), bfhi(vw.y)}; v1 = (f32x4){bflo(vw.z), bfhi(vw.z), bflo(vw.w), bfhi(vw.w)};
            } else { const float* kp = cache + (((size_t)db * L + idx) * 2) * 512 + h * 128 + 8 * sub;
                k0 = *(const f32x4*)kp; k1 = *(const f32x4*)(kp + 4); v0 = *(const f32x4*)(kp + 512); v1 = *(const f32x4*)(kp + 516); }
            SA_STEP(k0, k1, v0, v1);
        }
    }
#pragma unroll 4
    for (int n = nstart; n < NK; ++n) {
        const int idx = src == 3 ? n : L + t - dil * n;
        const float* kp = cache + (((size_t)db * L + idx) * 2) * 512 + h * 128 + 8 * sub;
        const f32x4 k0 = *(const f32x4*)kp, k1 = *(const f32x4*)(kp + 4), v0 = *(const f32x4*)(kp + 512), v1 = *(const f32x4*)(kp + 516);
        SA_STEP(k0, k1, v0, v1);
    }
#undef SA_STEP
    const float inv = 1.0f / ls;
    v4u w; w.x = cvt_pk_bf16(o[0] * inv, o[1] * inv); w.y = cvt_pk_bf16(o[2] * inv, o[3] * inv); w.z = cvt_pk_bf16(o[4] * inv, o[5] * inv); w.w = cvt_pk_bf16(o[6] * inv, o[7] * inv);
    if (src < 3) { *(v4u*)((bf16*)(ws + WS_OG) + (size_t)row * 1536 + src * 512 + h * 128 + 8 * sub) = w; if (sub == 0) ((float*)(ws + WS_LSE))[(size_t)row * 12 + src * 4 + h] = (mx + fast_log2(ls)) * LN2; }
    else *(v4u*)((bf16*)(ws + WS_OALL) + (size_t)row * 1536 + 1024 + h * 128 + 8 * sub) = w;
}
__device__ __forceinline__ void p4_gla_chain(const Frame& F, int row0, int T, int h, const float* S0, float* Sout) {
    unsigned char* ws = F.ws; const int tid = F.tid, v = tid & 127, ks = __builtin_amdgcn_readfirstlane(tid >> 7);
    const float* GA = (const float*)(ws + WS_GA); const bf16* GQ = (const bf16*)(ws + WS_GQ); const bf16* GK = (const bf16*)(ws + WS_GK); const bf16* GV = (const bf16*)(ws + WS_GV); float* GO = (float*)(ws + WS_GO);
    LAS float* part = (LAS float*)(F.lds + RING_OFF);
    float S[16];
#pragma unroll
    for (int i = 0; i < 16; ++i) S[i] = S0 ? S0[(size_t)(16 * ks + i) * 128 + v] : 0.f;
    for (int t0 = 0; t0 < T; t0 += 16) {
        const int nb = (T - t0) < 16 ? (T - t0) : 16;
        __syncthreads();
        for (int tt = 0; tt < nb; ++tt) {
            const size_t row = (size_t)(row0 + t0 + tt);
            const float* ap = GA + row * 256 + h * 64 + 16 * ks; const v4u kw0 = *(const v4u*)(GK + row * 256 + h * 64 + 16 * ks), kw1 = *(const v4u*)(GK + row * 256 + h * 64 + 16 * ks + 8);
            const v4u qw0 = *(const v4u*)(GQ + row * 256 + h * 64 + 16 * ks), qw1 = *(const v4u*)(GQ + row * 256 + h * 64 + 16 * ks + 8);
            const float vv = bf2f(GV[row * 512 + h * 128 + v]);
            const f32x4 a0 = *(const f32x4*)ap, a1 = *(const f32x4*)(ap + 4), a2 = *(const f32x4*)(ap + 8), a3 = *(const f32x4*)(ap + 12);
            const float la[16] = {a0.x, a0.y, a0.z, a0.w, a1.x, a1.y, a1.z, a1.w, a2.x, a2.y, a2.z, a2.w, a3.x, a3.y, a3.z, a3.w};
            const float kk[16] = {bflo(kw0.x), bfhi(kw0.x), bflo(kw0.y), bfhi(kw0.y), bflo(kw0.z), bfhi(kw0.z), bflo(kw0.w), bfhi(kw0.w), bflo(kw1.x), bfhi(kw1.x), bflo(kw1.y), bfhi(kw1.y), bflo(kw1.z), bfhi(kw1.z), bflo(kw1.w), bfhi(kw1.w)};
            const float qq[16] = {bflo(qw0.x), bfhi(qw0.x), bflo(qw0.y), bfhi(qw0.y), bflo(qw0.z), bfhi(qw0.z), bflo(qw0.w), bfhi(qw0.w), bflo(qw1.x), bfhi(qw1.x), bflo(qw1.y), bfhi(qw1.y), bflo(qw1.z), bfhi(qw1.z), bflo(qw1.w), bfhi(qw1.w)};
            float o = 0.f;
#pragma unroll
            for (int i = 0; i < 16; ++i) { S[i] = fast_exp2(la[i] * 1.4426950408889634f) * S[i] + kk[i] * vv; o += qq[i] * S[i]; }
            part[(tt * 4 + ks) * 128 + v] = o;
        }
        __syncthreads();
        for (int e = tid; e < nb * 128; e += 512) { const int tt = e >> 7, vv_ = e & 127;
            GO[(size_t)(row0 + t0 + tt) * 512 + h * 128 + vv_] = (part[(tt * 4 + 0) * 128 + vv_] + part[(tt * 4 + 1) * 128 + vv_]) + (part[(tt * 4 + 2) * 128 + vv_] + part[(tt * 4 + 3) * 128 + vv_]); }
    }
#pragma unroll
    for (int i = 0; i < 16; ++i) Sout[(size_t)(16 * ks + i) * 128 + v] = S[i];
}
__device__ __forceinline__ void p5_combine_row(const Frame& F, int row) {
    unsigned char* ws = F.ws; const int lane = F.lane, hh = lane >> 4, sub = lane & 15, col = hh * 128 + 8 * sub;
    const float* lse = (const float*)(ws + WS_LSE) + (size_t)row * 12;
    const float l0 = lse[hh], l1 = lse[4 + hh], l2 = lse[8 + hh], mx = fmaxf(l0, fmaxf(l1, l2));
    float w0 = __expf(l0 - mx), w1 = __expf(l1 - mx), w2 = __expf(l2 - mx); const float wi = 1.0f / (w0 + w1 + w2); w0 *= wi; w1 *= wi; w2 *= wi;
    const bf16* og = (const bf16*)(ws + WS_OG) + (size_t)row * 1536 + col;
    const v4u a = *(const v4u*)og, b = *(const v4u*)(og + 512), c = *(const v4u*)(og + 1024);
    v4u o;
    o.x = cvt_pk_bf16(w0 * bflo(a.x) + w1 * bflo(b.x) + w2 * bflo(c.x), w0 * bfhi(a.x) + w1 * bfhi(b.x) + w2 * bfhi(c.x));
    o.y = cvt_pk_bf16(w0 * bflo(a.y) + w1 * bflo(b.y) + w2 * bflo(c.y), w0 * bfhi(a.y) + w1 * bfhi(b.y) + w2 * bfhi(c.y));
    o.z = cvt_pk_bf16(w0 * bflo(a.z) + w1 * bflo(b.z) + w2 * bflo(c.z), w0 * bfhi(a.z) + w1 * bfhi(b.z) + w2 * bfhi(c.z));
    o.w = cvt_pk_bf16(w0 * bflo(a.w) + w1 * bflo(b.w) + w2 * bflo(c.w), w0 * bfhi(a.w) + w1 * bfhi(b.w) + w2 * bfhi(c.w));
    bf16* oall = (bf16*)(ws + WS_OALL) + (size_t)row * 1536;
    *(v4u*)(oall + col) = o;
    const float* go = (const float*)(ws + WS_GO) + (size_t)row * 512 + col;
    const f32x4 x0 = *(const f32x4*)go, x1 = *(const f32x4*)(go + 4);
    float ss = (x0.x * x0.x + x0.y * x0.y) + (x0.z * x0.z + x0.w * x0.w) + (x1.x * x1.x + x1.y * x1.y) + (x1.z * x1.z + x1.w * x1.w);
    ss += __shfl_xor(ss, 1); ss += __shfl_xor(ss, 2); ss += __shfl_xor(ss, 4); ss += __shfl_xor(ss, 8);
    const float rstd = 1.0f / sqrtf(ss * (1.f / 128.f) + EPS);
    const float* gg = F.i15 + 8 * sub; const f32x4 g0 = *(const f32x4*)gg, g1 = *(const f32x4*)(gg + 4);
    const v4u gr = *(const v4u*)((const bf16*)(ws + WS_GRS) + (size_t)row * 512 + col);
    v4u y;
    y.x = cvt_pk_bf16(x0.x * rstd * g0.x * bflo(gr.x), x0.y * rstd * g0.y * bfhi(gr.x)); y.y = cvt_pk_bf16(x0.z * rstd * g0.z * bflo(gr.y), x0.w * rstd * g0.w * bfhi(gr.y));
    y.z = cvt_pk_bf16(x1.x * rstd * g1.x * bflo(gr.z), x1.y * rstd * g1.y * bfhi(gr.z)); y.w = cvt_pk_bf16(x1.z * rstd * g1.z * bflo(gr.w), x1.w * rstd * g1.w * bfhi(gr.w));
    *(v4u*)(oall + 512 + col) = y;
}
__device__ __forceinline__ void p10_final_row(const Frame& F, int row) {
    GAS f32x4* yr = (GAS f32x4*)(F.out + (size_t)row * D) + F.lane; const GAS f32x4* gr = (const GAS f32x4*)F.i24 + F.lane;
    f32x4 v[4]; float s = 0.f;
#pragma unroll
    for (int j = 0; j < 4; ++j) { v[j] = yr[64 * j]; s += (v[j].x * v[j].x + v[j].y * v[j].y) + (v[j].z * v[j].z + v[j].w * v[j].w); }
    const float rstd = 1.0f / sqrtf(wave_sum(s) * (1.f / D) + EPS);
#pragma unroll
    for (int j = 0; j < 4; ++j) yr[64 * j] = v[j] * rstd * gr[64 * j];
}

constexpr int N_PHASES = 11;
__global__ void __launch_bounds__(NWAVES * 64, 2) mk_fwd(Args args) {
    extern __shared__ __attribute__((aligned(16))) unsigned char lds[];
    Frame F;
    F.lds = (LAS unsigned char*)lds;
    F.tid = threadIdx.x; F.lane = F.tid & 63; F.wave = __builtin_amdgcn_readfirstlane(F.tid >> 6);
    F.G = gridDim.x; { const int bx = blockIdx.x; F.vcu = (F.G % 8 == 0) ? (bx % 8) * (F.G / 8) + bx / 8 : bx; }
    F.i0 = args.in[0]; F.i1 = args.in[1]; F.i2 = args.in[2]; F.i3 = args.in[3]; F.i4 = args.in[4]; F.i5 = args.in[5]; F.i6 = args.in[6]; F.i7 = args.in[7]; F.i8 = args.in[8]; F.i9 = args.in[9]; F.i10 = args.in[10]; F.i11 = args.in[11]; F.i12 = args.in[12]; F.i13 = args.in[13]; F.i14 = args.in[14]; F.i15 = args.in[15]; F.i16 = args.in[16]; F.i17 = args.in[17]; F.i18 = args.in[18]; F.i19 = args.in[19]; F.i20 = args.in[20]; F.i21 = args.in[21]; F.i22 = args.in[22]; F.i23 = args.in[23]; F.i24 = args.in[24];
    F.out = args.out; F.ws = args.ws;
    unsigned char* ws = args.ws; gu32* ctl = (gu32*)(ws + WS_CTL);
    volatile LAS unsigned* MISC = (volatile LAS unsigned*)(F.lds + MISC_OFF);
    for (int u = F.tid; u < (LDS_BYTES - LDSCTL_OFF) / 4; u += NWAVES * 64) ((LAS unsigned*)(F.lds + LDSCTL_OFF))[u] = 0u;
    __syncthreads();
    XcdBarrier bar; bar.bar = (unsigned*)(ctl + CW_BAR); bar.x = 0; bar.st = nullptr;
    if (MK_N_LAUNCHES == 1) bar = xcd_barrier_post((unsigned*)(ctl + CW_BAR), MISC + 8);
    const int lo = args.ph_lo, hi = args.ph_hi;
#define IN(k) (lo <= (k) && (k) < hi && (k) <= MK_STOP_AFTER)
#define GRID_BAR(k) do { if (IN((k) + 1)) xcd_barrier(bar); } while (0)
    const int G = F.G, bx = (int)blockIdx.x;

    if (IN(0)) { p0_prologue(F); GRID_BAR(0); }

    if (IN(1)) {
        { pg8::Gemm g{(const bf16*)(ws + WS_XB), (const bf16*)(ws + WS_W1A), MR, 2 * FF, D, D}; pg8::StaticOrder S; S.init(MR, 2 * FF, G, bx);
          EpiSwiglu E{(bf16*)(ws + WS_G), nullptr}; pg8::gemm_phase<EpiSwiglu, pg8::StaticOrder>(F.lds + RING_OFF, g, S, E); }
        { pg8::Gemm g{(const bf16*)(ws + WS_MEMB), (const bf16*)(ws + WS_WMEM), MM, D, D, D}; pg8::StaticOrder S; S.init(MM, D, G, (bx + G / 2) % G);
          EpiMemKV E{F.out + O_MEMKV, (bf16*)(ws + WS_MKV)}; pg8::gemm_phase<EpiMemKV, pg8::StaticOrder>(F.lds + RING_OFF, g, S, E); }
        GRID_BAR(1);
    }
    if (IN(2)) {
        pg8::Gemm g{(const bf16*)(ws + WS_G), (const bf16*)(ws + WS_W1O), MR, D, FF, FF}; pg8::StaticOrder S; S.init(MR, D, G, bx);
        EpiResid<true, true> E{F.i0, F.i1, (float*)(ws + WS_H), (float*)(ws + WS_H) + (size_t)MP * D, (bf16*)(ws + WS_HB), (float*)(ws + WS_PQ1), 0.5f};
        pg8::gemm_phase<EpiResid<true, true>, pg8::StaticOrder>(F.lds + RING_OFF, g, S, E);
        GRID_BAR(2);
    }
    if (IN(3)) {
        pg8::Gemm g{(const bf16*)(ws + WS_HB), (const bf16*)(ws + WS_WIN), MR, NZ, D, D}; pg8::StaticOrder S; S.init(MR, NZ, G, bx);
        EpiZ E{(const float*)(ws + WS_PQ1), (const float*)(ws + WS_ROPE), (const float*)(ws + WS_ROPE) + NPOS * 64, F.i14, F.out,
               (bf16*)(ws + WS_QS), (bf16*)(ws + WS_KS), (bf16*)(ws + WS_VS), (bf16*)(ws + WS_GQ), (bf16*)(ws + WS_GK), (bf16*)(ws + WS_GV), (bf16*)(ws + WS_GRS), (bf16*)(ws + WS_MQ), (bf16*)(ws + WS_GATE), (float*)(ws + WS_GA)};
        pg8::gemm_phase<EpiZ, pg8::StaticOrder>(F.lds + RING_OFF, g, S, E);
        GRID_BAR(3);
    }
    if (IN(4)) {
        const int half = G / 2;
        if (bx < half) {
            for (int c = bx; c < NB * 4; c += half) p4_gla_chain(F, (c >> 2) * SEQ, SEQ, c & 3, nullptr, F.out + O_GLAP + (size_t)c * 64 * 128);
            for (int c = bx; c < DECB * 4; c += half) p4_gla_chain(F, MP + (c >> 2) * DECT, DECT, c & 3, F.i7 + (size_t)c * 64 * 128, F.out + O_GLAS + (size_t)c * 64 * 128);
        } else {
            for (int id = bx - half; id < 8192; id += G - half) p4_attn_unit(F, id);
            for (int wt = (bx - half) * NWAVES + F.wave; wt < DECB * 16; wt += (G - half) * NWAVES) p4_sample_attn(F, wt, args.in[3], args.in[4], args.in[5], args.in[6]);
        }
        GRID_BAR(4);
    }
    if (IN(5)) {
        for (int m = F.vcu * NWAVES + F.wave; m < MR; m += G * NWAVES) p5_combine_row(F, m);
        GRID_BAR(5);
    }
    if (IN(6)) {
        pg8::StaticOrder S; S.init(MR, D, G, bx);
        { pg8::Gemm g{(const bf16*)(ws + WS_OALL), (const bf16*)(ws + WS_WBR), MR, D, 512, 1536}; EpiMerge<0> E{(const bf16*)(ws + WS_GATE), (float*)(ws + WS_T), (bf16*)(ws + WS_MB)}; pg8::gemm_phase<EpiMerge<0>, pg8::StaticOrder>(F.lds + RING_OFF, g, S, E); }
        { pg8::Gemm g{(const bf16*)(ws + WS_OALL) + 512, (const bf16*)(ws + WS_WBR) + (size_t)D * 512, MR, D, 512, 1536}; EpiMerge<1> E{(const bf16*)(ws + WS_GATE), (float*)(ws + WS_T), (bf16*)(ws + WS_MB)}; pg8::gemm_phase<EpiMerge<1>, pg8::StaticOrder>(F.lds + RING_OFF, g, S, E); }
        { pg8::Gemm g{(const bf16*)(ws + WS_OALL) + 1024, (const bf16*)(ws + WS_WBR) + (size_t)2 * D * 512, MR, D, 512, 1536}; EpiMerge<2> E{(const bf16*)(ws + WS_GATE), (float*)(ws + WS_T), (bf16*)(ws + WS_MB)}; pg8::gemm_phase<EpiMerge<2>, pg8::StaticOrder>(F.lds + RING_OFF, g, S, E); }
        GRID_BAR(6);
    }
    if (IN(7)) {
        pg8::Gemm g{(const bf16*)(ws + WS_MB), (const bf16*)(ws + WS_WOUT), MR, D, D, D}; pg8::StaticOrder S; S.init(MR, D, G, bx);
        float* H = (float*)(ws + WS_H);
        EpiResid<true, true> E{H, H + (size_t)MP * D, H, H + (size_t)MP * D, (bf16*)(ws + WS_HB), (float*)(ws + WS_PQ2), 1.0f};
        pg8::gemm_phase<EpiResid<true, true>, pg8::StaticOrder>(F.lds + RING_OFF, g, S, E);
        GRID_BAR(7);
    }
    if (IN(8)) {
        pg8::Gemm g{(const bf16*)(ws + WS_HB), (const bf16*)(ws + WS_W2A), MR, 2 * FF, D, D}; pg8::StaticOrder S; S.init(MR, 2 * FF, G, bx);
        EpiSwiglu E{(bf16*)(ws + WS_G), (const float*)(ws + WS_PQ2)}; pg8::gemm_phase<EpiSwiglu, pg8::StaticOrder>(F.lds + RING_OFF, g, S, E);
        GRID_BAR(8);
    }
    if (IN(9)) {
        pg8::Gemm g{(const bf16*)(ws + WS_G), (const bf16*)(ws + WS_W2O), MR, D, FF, FF}; pg8::StaticOrder S; S.init(MR, D, G, bx);
        float* H = (float*)(ws + WS_H);
        EpiResid<false, false> E{H, H + (size_t)MP * D, F.out + O_Y, F.out + O_YS, nullptr, nullptr, 0.5f};
        pg8::gemm_phase<EpiResid<false, false>, pg8::StaticOrder>(F.lds + RING_OFF, g, S, E);
        GRID_BAR(9);
    }
    if (IN(10)) {
        for (int m = F.vcu * NWAVES + F.wave; m < MR; m += G * NWAVES) p10_final_row(F, m);
    }

#if MK_STOP_AFTER < 10
    if (hi == N_PHASES) {
        for (int m = F.vcu * NWAVES + F.wave; m < MR; m += G * NWAVES) {
            for (int c = F.lane; c < D; c += 64) {
                float v;
                if (MK_STOP_AFTER == 0) v = bf2f(((const bf16*)(ws + WS_WIN))[(size_t)(m % NZ) * D + c]);
                else if (MK_STOP_AFTER == 3) { const bf16* gt = (const bf16*)(ws + WS_GATE) + (size_t)m * 3072; v = bf2f(gt[c]) + bf2f(gt[1024 + c]) + bf2f(gt[2048 + c]); }
                else if (MK_STOP_AFTER <= 5) { const bf16* oa = (const bf16*)(ws + WS_OALL) + (size_t)m * 1536; v = bf2f(oa[c]) + bf2f(oa[1024 + (c & 511)]); }
                else if (MK_STOP_AFTER == 6) v = bf2f(((const bf16*)(ws + WS_MB))[(size_t)m * D + c]);
                else if (MK_STOP_AFTER == 7) v = ((const float*)(ws + WS_H))[(size_t)m * D + c];
                else v = bf2f(((const bf16*)(ws + WS_G))[(size_t)m * FF + c]) + bf2f(((const bf16*)(ws + WS_G))[(size_t)m * FF + 1792 + c]);
                F.out[(size_t)m * D + c] = v;
            }
        }
    }
#endif
#undef IN
#undef GRID_BAR
}

extern "C" void kernel_launch(void* const* d_in, const int* in_sizes, int n_in, void* d_out, int out_size, void* d_ws, size_t ws_size, hipStream_t stream) {
    static int grid = 0;
    if (grid == 0) {
        if (n_in != 25 || (size_t)out_size != O_END || ws_size < WS_END) { fprintf(stderr, "kernel_launch: unexpected shapes: n_in %d out %d ws %zu (need %zu); nothing launched\n", n_in, out_size, ws_size, (size_t)WS_END); grid = -1; return; }
        int dev = 0, cus = 0, per_cu = 0;
        if (hipGetDevice(&dev) != hipSuccess || hipDeviceGetAttribute(&cus, hipDeviceAttributeMultiprocessorCount, dev) != hipSuccess) { grid = -1; return; }
        if (hipFuncSetAttribute((const void*)mk_fwd, hipFuncAttributeMaxDynamicSharedMemorySize, LDS_BYTES) != hipSuccess) { fprintf(stderr, "kernel_launch: hipFuncSetAttribute failed\n"); grid = -1; return; }
        if (hipOccupancyMaxActiveBlocksPerMultiprocessor(&per_cu, (const void*)mk_fwd, NWAVES * 64, LDS_BYTES) != hipSuccess || per_cu < 1) fprintf(stderr, "kernel_launch: occupancy query reports %d\n", per_cu);
        (void)hipGetLastError();
        grid = cus;
    }
    if (grid < 0) return;
    if (hipMemsetAsync((char*)d_ws + WS_CTL, 0, CTL_ZERO_BYTES, stream) != hipSuccess) return;
    Args a{};
    for (int i = 0; i < 25; ++i) a.in[i] = (const float*)d_in[i];
    a.out = (float*)d_out; a.ws = (unsigned char*)d_ws; a.pad = 0;
    for (int li = 0; li < MK_N_LAUNCHES; ++li) {
        a.ph_lo = (MK_N_LAUNCHES == 1) ? 0 : li; a.ph_hi = (MK_N_LAUNCHES == 1) ? N_PHASES : li + 1; a.li = li;
        hipLaunchKernelGGL(mk_fwd, dim3(grid), dim3(NWAVES * 64), LDS_BYTES, stream, a);
        const hipError_t le = hipPeekAtLastError();
        if (le != hipSuccess) { fprintf(stderr, "kernel_launch: launch %d failed: %s\n", li, hipGetErrorName(le)); break; }
    }
}
```

```cpp
#include <hip/hip_runtime.h>
#include <cstdio>
#include <cstdint>

#ifndef MK_N_LAUNCHES
#define MK_N_LAUNCHES 1
#endif

#ifndef MK_REPEAT_PHASE
#define MK_REPEAT_PHASE -1
#endif
#ifndef MK_STOP_AFTER
#define MK_STOP_AFTER 10
#endif
#define GAS __attribute__((address_space(1)))
#define LAS __attribute__((address_space(3)))
typedef unsigned short bf16;
typedef unsigned v4u __attribute__((ext_vector_type(4)));
typedef unsigned v2u __attribute__((ext_vector_type(2)));
typedef float f32x4 __attribute__((ext_vector_type(4)));
typedef float f32x2 __attribute__((ext_vector_type(2)));
typedef short bf16x8 __attribute__((ext_vector_type(8)));
typedef short s16x4 __attribute__((ext_vector_type(4)));
typedef GAS unsigned gu32;

constexpr int D = 1024, NB = 32, SEQ = 2048, DECB = 128, DECT = 4, PAST = 8192, MEML = 256;
constexpr int MP = NB * SEQ;
constexpr int MS = DECB * DECT;
constexpr int MR = MP + MS;
constexpr int MM = NB * MEML;
constexpr int FF = 2816, NZ = 9984;
constexpr int DIN = 6672;
constexpr int NPOS = SEQ + DECT;
constexpr float EPS = 1e-6f;
constexpr float QSCALE = 0.08838834764831845f * 1.4426950408889634f;
constexpr float LN2 = 0.6931471805599453f;

constexpr size_t O_Y = 0, O_YS = (size_t)MP * D, O_SWA0P = O_YS + (size_t)MS * D, O_SWA1P = O_SWA0P + (size_t)NB * 128 * 1024, O_SWA2P = O_SWA1P + (size_t)NB * 512 * 1024,
                 O_MEMKV = O_SWA2P + (size_t)NB * 2048 * 1024, O_GLAP = O_MEMKV + (size_t)MM * 1024, O_SWA0S = O_GLAP + (size_t)NB * 4 * 64 * 128, O_SWA1S = O_SWA0S + (size_t)MS * 1024,
                 O_SWA2S = O_SWA1S + (size_t)MS * 1024, O_GLAS = O_SWA2S + (size_t)MS * 1024, O_END = O_GLAS + (size_t)DECB * 4 * 64 * 128;
static_assert(O_END == 170917888ull, "output size");

constexpr size_t MiB = 1u << 20;
constexpr size_t al(size_t x) { return (x + 2 * MiB - 1) / (2 * MiB) * (2 * MiB); }
constexpr size_t WS_CTL = 0, CTL_ZERO_BYTES = 1 * MiB;
constexpr size_t WS_ROPE = 2 * MiB;
constexpr size_t WS_PQ1 = WS_ROPE + al((size_t)NPOS * 64 * 4 * 2);
constexpr size_t WS_PQ2 = WS_PQ1 + al((size_t)MR * 16 * 4);
constexpr size_t WS_W1A = WS_PQ2 + al((size_t)MR * 16 * 4);
constexpr size_t WS_W1O = WS_W1A + al((size_t)2 * FF * D * 2);
constexpr size_t WS_WIN = WS_W1O + al((size_t)D * FF * 2);
constexpr size_t WS_WBR = WS_WIN + al((size_t)NZ * D * 2);
constexpr size_t WS_WOUT = WS_WBR + al((size_t)3 * D * 512 * 2);
constexpr size_t WS_W2A = WS_WOUT + al((size_t)D * D * 2);
constexpr size_t WS_W2O = WS_W2A + al((size_t)2 * FF * D * 2);
constexpr size_t WS_WMEM = WS_W2O + al((size_t)D * FF * 2);
constexpr size_t WS_XB = WS_WMEM + al((size_t)D * D * 2);
constexpr size_t WS_MEMB = WS_XB + al((size_t)MR * D * 2);
constexpr size_t WS_MKV = WS_MEMB + al((size_t)MM * D * 2);
constexpr size_t WS_G = WS_MKV + al((size_t)MM * D * 2);
constexpr size_t WS_H = WS_G + al((size_t)MR * FF * 2);
constexpr size_t WS_HB = WS_H + al((size_t)MR * D * 4);
constexpr size_t WS_QS = WS_HB + al((size_t)MR * D * 2);
constexpr size_t WS_KS = WS_QS + al((size_t)MR * 1536 * 2);
constexpr size_t WS_VS = WS_KS + al((size_t)MR * 1536 * 2);
constexpr size_t WS_GQ = WS_VS + al((size_t)MR * 1536 * 2);
constexpr size_t WS_GK = WS_GQ + al((size_t)MR * 256 * 2);
constexpr size_t WS_GV = WS_GK + al((size_t)MR * 256 * 2);
constexpr size_t WS_GRS = WS_GV + al((size_t)MR * 512 * 2);
constexpr size_t WS_GA = WS_GRS + al((size_t)MR * 512 * 2);
constexpr size_t WS_MQ = WS_GA + al((size_t)MR * 256 * 4);
constexpr size_t WS_GATE = WS_MQ + al((size_t)MR * 512 * 2);
constexpr size_t WS_OG = WS_GATE + al((size_t)MR * 3072 * 2);
constexpr size_t WS_LSE = WS_OG + al((size_t)MR * 1536 * 2);
constexpr size_t WS_GO = WS_LSE + al((size_t)MR * 12 * 4);
constexpr size_t WS_OALL = WS_GO + al((size_t)MR * 512 * 4);
constexpr size_t WS_END = WS_OALL + al((size_t)MR * 1536 * 2);
constexpr size_t WS_T = WS_G, WS_MB = WS_XB;
static_assert((size_t)MR * D * 4 <= (size_t)MR * FF * 2, "T fits in G");

constexpr int CW_TMO = 0, CW_CODE = 1, CW_BAR = 4096;

constexpr int RING_OFF = 0, RING_BYTES = 131072;
constexpr int LDSCTL_OFF = RING_BYTES, MISC_OFF = LDSCTL_OFF + 320;
constexpr int LDS_BYTES = 147456;
constexpr int NWAVES = 8;

#define RLX_AGENT __ATOMIC_RELAXED, __HIP_MEMORY_SCOPE_AGENT
#define LDS_WAIT() asm volatile("s_waitcnt lgkmcnt(0)" ::: "memory")
#define VM_WAIT() asm volatile("s_waitcnt vmcnt(0)" ::: "memory")
__device__ __forceinline__ unsigned f2bf(float f) { unsigned u = __builtin_bit_cast(unsigned, f); return (u + 0x7fffu + ((u >> 16) & 1u)) >> 16; }
__device__ __forceinline__ unsigned pk2(float lo, float hi) { return f2bf(lo) | (f2bf(hi) << 16); }
__device__ __forceinline__ float bf2f(unsigned b) { return __builtin_bit_cast(float, b << 16); }
__device__ __forceinline__ float bflo(unsigned w) { return __builtin_bit_cast(float, w << 16); }
__device__ __forceinline__ float bfhi(unsigned w) { return __builtin_bit_cast(float, w & 0xffff0000u); }
typedef __bf16 bf16x2_t __attribute__((ext_vector_type(2)));
__device__ __forceinline__ unsigned cvt_pk_bf16(float lo, float hi) { const f32x2 v = {lo, hi}; const bf16x2_t b = __builtin_convertvector(v, bf16x2_t); return __builtin_bit_cast(unsigned, b); }
__device__ __forceinline__ float fast_exp2(float x) { return __builtin_amdgcn_exp2f(x); }
__device__ __forceinline__ float fast_rcp(float x) { return __builtin_amdgcn_rcpf(x); }
__device__ __forceinline__ float fast_log2(float x) { return __builtin_amdgcn_logf(x); }
__device__ __forceinline__ float sigmoidf_(float x) { return fast_rcp(1.0f + fast_exp2(-1.4426950408889634f * x)); }
__device__ __forceinline__ float siluf_(float x) { return x * sigmoidf_(x); }
__device__ __forceinline__ int perm32(int rho) { return 8 * ((rho >> 2) & 3) + 4 * (rho >> 4) + (rho & 3); }
__device__ __forceinline__ int sig_plain(int r) { return (r & ~31) + perm32(r & 31); }
__device__ __forceinline__ int sig_rope(int r7) { return 64 * ((r7 >> 4) & 1) + 16 * (r7 >> 5) + 4 * ((r7 >> 2) & 3) + (r7 & 3); }

namespace pg8 {
constexpr int BM = 256, BK = 64, HALF = 128, HTB = HALF * BK * 2, STAGE_BYTES = 8 * HTB, NXCD = 8, WGM = 8;
__host__ __device__ __forceinline__ int lds_byte(int r, int c) { const int st = (r >> 4) * 2 + (c >> 5), rr = r & 15, cc = c & 31, ob = rr * 64 + cc * 2; return st * 1024 + (ob ^ (((ob >> 9) & 1) << 5)); }
__host__ __device__ __forceinline__ void stage_rc(int b, int& R, int& C) { const int st = b / 1024, sb = b % 1024, swz = sb ^ (((sb >> 9) & 1) << 5); R = (st >> 1) * 16 + swz / 64; C = (st & 1) * 32 + (swz % 64) / 2; }
struct Unit { int pm, pn; };
struct Gemm { const bf16* A; const bf16* Bt; int M, N, K, lda; };
struct StaticOrder {
    int nM, nN, nwg, G, c;
    __host__ __device__ void init(int M, int N, int G_, int c_) { nM = M / BM; nN = N / BM; nwg = nM * nN; G = G_; c = c_; }
    __host__ __device__ bool next(int i, Unit& u) const {
        const long L = (long)i * G + c; if (L >= nwg) return false;
        int wgid = (int)L; { const int q = nwg / NXCD, r = nwg % NXCD, xcd = wgid % NXCD, off = wgid / NXCD; wgid = (xcd < r ? xcd * (q + 1) : r * (q + 1) + (xcd - r) * q) + off; }
        const int nig = WGM * nN, gid = wgid / nig, fm = gid * WGM, gsz = (nM - fm) < WGM ? (nM - fm) : WGM;
        u.pm = fm + ((wgid % nig) % gsz); u.pn = (wgid % nig) / gsz; return true;
    }
};
template <class Epi, class Sched, bool ALIGN_EPI = true>
__device__ __forceinline__ void gemm_phase(LAS unsigned char* lds, const Gemm g, const Sched& S, const Epi& E) {
    const int tid = threadIdx.x, wid = __builtin_amdgcn_readfirstlane(tid >> 6), lane = tid & 63, wr = wid >> 2, wc = wid & 3, fr = lane & 15, fq = lane >> 4;
    const int K = g.K, nt = K / BK;
    unsigned voffA[2], voffB[2];
#pragma unroll
    for (int i = 0; i < 2; ++i) { int R, C; stage_rc(tid * 16 + i * 8192, R, C); voffA[i] = (unsigned)(R * g.lda + C) * 2u; voffB[i] = (unsigned)(R * K + C) * 2u; }
    const size_t kstep = (size_t)(BK * 2);
    const size_t hA = (size_t)HALF * g.lda * 2, tA = 2 * hA, hB = (size_t)HALF * K * 2, tB = 2 * hB;
    const unsigned ldsw = (unsigned)wid * 1024u;
    const int aoff = lds_byte(wr * 64 + fr, fq * 8), boff = lds_byte(wc * 32 + fr, fq * 8);
#define PG8_SA(b, h) (((b) * 2 + (h)) * HTB)
#define PG8_SB(b, h) ((4 + (b) * 2 + (h)) * HTB)
#define PG8_STAGE(bufoff, gbase, voff) do { _Pragma("unroll") for (int _i = 0; _i < 2; ++_i) \
        __builtin_amdgcn_global_load_lds((const unsigned*)((const char*)(gbase) + (voff)[_i]), (LAS unsigned*)(lds + (bufoff) + ldsw + _i * 8192), 16, 0, 0); } while (0)
#define PG8_LDA(dst, b, h) do { _Pragma("unroll") for (int m = 0; m < 4; ++m) _Pragma("unroll") for (int k = 0; k < 2; ++k) dst[m][k] = *(const LAS bf16x8*)(lds + PG8_SA(b, h) + aoff + m * 2048 + k * 1024); } while (0)
#define PG8_LDB(dst, b, h) do { _Pragma("unroll") for (int n = 0; n < 2; ++n) _Pragma("unroll") for (int k = 0; k < 2; ++k) dst[n][k] = *(const LAS bf16x8*)(lds + PG8_SB(b, h) + boff + n * 2048 + k * 1024); } while (0)
#define PG8_MMA(ai, bj, At, Bt) do { __builtin_amdgcn_s_setprio(1); _Pragma("unroll") for (int m = 0; m < 4; ++m) _Pragma("unroll") for (int n = 0; n < 2; ++n) _Pragma("unroll") for (int k = 0; k < 2; ++k) \
        acc[ai][bj][m][n] = __builtin_amdgcn_mfma_f32_16x16x32_bf16(Bt[n][k], At[m][k], acc[ai][bj][m][n], 0, 0, 0); __builtin_amdgcn_s_setprio(0); } while (0)
#define PG8_WAIT_V(n) asm volatile("s_waitcnt vmcnt(" #n ")" ::: "memory")
#define PG8_WAIT_L(n) asm volatile("s_waitcnt lgkmcnt(" #n ")" ::: "memory")
#define PG8_BAR __builtin_amdgcn_s_barrier()
#define PG8_SCHED __builtin_amdgcn_sched_barrier(0)
    Unit cur, nxt; int ui = 0;
    if (!S.next(0, cur)) return;
    f32x4 acc[2][2][4][2];
#pragma unroll
    for (int a = 0; a < 2; ++a)
#pragma unroll
        for (int b = 0; b < 2; ++b)
#pragma unroll
            for (int m = 0; m < 4; ++m)
#pragma unroll
                for (int n = 0; n < 2; ++n) acc[a][b][m][n] = (f32x4){0.f, 0.f, 0.f, 0.f};
    bf16x8 At[4][2], B0[2][2], B1[2][2];
    const char* cA = (const char*)g.A + (size_t)cur.pm * tA; const char* cB = (const char*)g.Bt + (size_t)cur.pn * tB;
    PG8_STAGE(PG8_SB(0, 0), cB, voffB); PG8_STAGE(PG8_SB(0, 1), cB + hB, voffB); PG8_STAGE(PG8_SA(0, 0), cA, voffA); PG8_STAGE(PG8_SA(0, 1), cA + hA, voffA);
    if (wr == 1) PG8_BAR;
    PG8_WAIT_V(2); PG8_BAR;
    PG8_STAGE(PG8_SB(1, 0), cB + kstep, voffB); PG8_STAGE(PG8_SA(1, 0), cA + kstep, voffA); PG8_STAGE(PG8_SB(1, 1), cB + hB + kstep, voffB);
    PG8_WAIT_V(6); PG8_BAR;
    for (;;) {
        const bool has_next = S.next(ui + 1, nxt);
        const char* nA = has_next ? (const char*)g.A + (size_t)nxt.pm * tA : cA; const char* nB = has_next ? (const char*)g.Bt + (size_t)nxt.pn * tB : cB;
        for (int t = 0; t < nt; t += 2) {
            const bool last = (t == nt - 2);
            const char* a1 = cA + (size_t)(t + 1) * kstep;
            const char* a2 = last ? nA : cA + (size_t)(t + 2) * kstep; const char* b2 = last ? nB : cB + (size_t)(t + 2) * kstep;
            const char* a3 = a2 + kstep; const char* b3 = b2 + kstep;
            PG8_LDB(B0, 0, 0); PG8_LDB(B1, 0, 1); PG8_SCHED; PG8_LDA(At, 0, 0); PG8_STAGE(PG8_SA(1, 1), a1 + hA, voffA);
            PG8_WAIT_V(8); PG8_WAIT_L(0); PG8_BAR; PG8_MMA(0, 0, At, B0); PG8_MMA(0, 1, At, B1); PG8_BAR; PG8_SCHED;
            PG8_LDA(At, 0, 1); PG8_STAGE(PG8_SB(0, 0), b2, voffB); PG8_STAGE(PG8_SB(0, 1), b2 + hB, voffB); PG8_STAGE(PG8_SA(0, 0), a2, voffA);
            PG8_WAIT_V(8); PG8_WAIT_L(0); PG8_BAR; PG8_MMA(1, 0, At, B0); PG8_MMA(1, 1, At, B1); PG8_BAR; PG8_SCHED;
            PG8_LDB(B0, 1, 0); PG8_LDB(B1, 1, 1); PG8_SCHED; PG8_LDA(At, 1, 0); PG8_STAGE(PG8_SA(0, 1), a2 + hA, voffA);
            PG8_WAIT_V(8); PG8_WAIT_L(0); PG8_BAR; PG8_MMA(0, 0, At, B0); PG8_MMA(0, 1, At, B1); PG8_BAR; PG8_SCHED;
            PG8_LDA(At, 1, 1); PG8_STAGE(PG8_SB(1, 0), b3, voffB); PG8_STAGE(PG8_SB(1, 1), b3 + hB, voffB); PG8_STAGE(PG8_SA(1, 0), a3, voffA);
            PG8_WAIT_V(8); PG8_WAIT_L(0); PG8_BAR; PG8_MMA(1, 0, At, B0); PG8_MMA(1, 1, At, B1); PG8_BAR; PG8_SCHED;
        }
        if constexpr (ALIGN_EPI) { if (wr == 0) PG8_BAR; }
        E(acc, cur, wr, wc, fr, fq);
        if (!has_next) break;
#pragma unroll
        for (int a = 0; a < 2; ++a)
#pragma unroll
            for (int b = 0; b < 2; ++b)
#pragma unroll
                for (int m = 0; m < 4; ++m)
#pragma unroll
                    for (int n = 0; n < 2; ++n) acc[a][b][m][n] = (f32x4){0.f, 0.f, 0.f, 0.f};
        cur = nxt; cA = nA; cB = nB; ++ui;
        if constexpr (ALIGN_EPI) { if (wr == 1) PG8_BAR; }
    }
    PG8_WAIT_V(0);
    if constexpr (!ALIGN_EPI) { if (wr == 0) PG8_BAR; }
    PG8_BAR;
#undef PG8_SA
#undef PG8_SB
#undef PG8_STAGE
#undef PG8_LDA
#undef PG8_LDB
#undef PG8_MMA
#undef PG8_WAIT_V
#undef PG8_WAIT_L
#undef PG8_BAR
#undef PG8_SCHED
}
}
using pg8::Unit;

typedef const f32x4 (&AccRef)[2][2][4][2];
struct EpiSwiglu {
    bf16* G; const float* pq;
    __device__ __forceinline__ void operator()(AccRef acc, const Unit& u, int wr, int wc, int fr, int fq) const {
        const int row0 = u.pm * 256 + wr * 64 + fr, j0 = u.pn * 128 + wc * 32 + 8 * fq;
#pragma unroll
        for (int ai = 0; ai < 2; ++ai)
#pragma unroll
            for (int m = 0; m < 4; ++m) {
                const int row = row0 + ai * 128 + m * 16; float s = 1.f;
                if (pq) { const f32x4 pv = *(const f32x4*)(pq + (size_t)row * 16 + 4 * fq); float t = (pv.x + pv.y) + (pv.z + pv.w); t += __shfl_xor(t, 16); t += __shfl_xor(t, 32); s = __builtin_amdgcn_rsqf(t * (1.f / D) + EPS); }
                float o[8];
#pragma unroll
                for (int n = 0; n < 2; ++n)
#pragma unroll
                    for (int i = 0; i < 4; ++i) { const float a = acc[ai][0][m][n][i] * s, b = acc[ai][1][m][n][i] * s; o[4 * n + i] = siluf_(a) * b; }
                v4u w; w.x = cvt_pk_bf16(o[0], o[1]); w.y = cvt_pk_bf16(o[2], o[3]); w.z = cvt_pk_bf16(o[4], o[5]); w.w = cvt_pk_bf16(o[6], o[7]);
                *(v4u*)(G + (size_t)row * FF + j0) = w;
            }
    }
};
template <bool WRITE_HB, bool WRITE_PQ> struct EpiResid {
    const float* baseP; const float* baseS; float* outP; float* outS; bf16* HB; float* pq; float scale;
    __device__ __forceinline__ void operator()(AccRef acc, const Unit& u, int wr, int wc, int fr, int fq) const {
        const int row0 = u.pm * 256 + wr * 64 + fr, c0 = u.pn * 256 + wc * 32 + 8 * fq; const bool smp = u.pm >= MP / 256;
#pragma unroll
        for (int ai = 0; ai < 2; ++ai)
#pragma unroll
            for (int m = 0; m < 4; ++m) {
                const int row = row0 + ai * 128 + m * 16; const size_t ro = smp ? (size_t)(row - MP) * D : (size_t)row * D;
                const float* bp = (smp ? baseS : baseP) + ro + c0; float* op = (smp ? outS : outP) + ro + c0; float ss = 0.f;
#pragma unroll
                for (int bj = 0; bj < 2; ++bj) {
                    const f32x4 b0 = *(const f32x4*)(bp + bj * 128), b1 = *(const f32x4*)(bp + bj * 128 + 4);
                    const f32x4 o0 = b0 + acc[ai][bj][m][0] * scale, o1 = b1 + acc[ai][bj][m][1] * scale;
                    *(f32x4*)(op + bj * 128) = o0; *(f32x4*)(op + bj * 128 + 4) = o1;
                    if (WRITE_HB) { v4u w; w.x = cvt_pk_bf16(o0.x, o0.y); w.y = cvt_pk_bf16(o0.z, o0.w); w.z = cvt_pk_bf16(o1.x, o1.y); w.w = cvt_pk_bf16(o1.z, o1.w); *(v4u*)(HB + (size_t)row * D + c0 + bj * 128) = w; }
                    if (WRITE_PQ) ss += (o0.x * o0.x + o0.y * o0.y) + (o0.z * o0.z + o0.w * o0.w) + (o1.x * o1.x + o1.y * o1.y) + (o1.z * o1.z + o1.w * o1.w);
                }
                if (WRITE_PQ) { ss += __shfl_xor(ss, 16); ss += __shfl_xor(ss, 32); if (fq == 0) pq[(size_t)row * 16 + u.pn * 4 + wc] = ss; }
            }
    }
};
struct EpiMemKV {
    float* out; bf16* MKV;
    __device__ __forceinline__ void operator()(AccRef acc, const Unit& u, int wr, int wc, int fr, int fq) const {
        const int row0 = u.pm * 256 + wr * 64 + fr, c0 = u.pn * 256 + wc * 32 + 8 * fq;
#pragma unroll
        for (int ai = 0; ai < 2; ++ai)
#pragma unroll
            for (int m = 0; m < 4; ++m) {
                const int row = row0 + ai * 128 + m * 16;
#pragma unroll
                for (int bj = 0; bj < 2; ++bj) { const f32x4 o0 = acc[ai][bj][m][0], o1 = acc[ai][bj][m][1]; float* op = out + (size_t)row * D + c0 + bj * 128;
                    *(f32x4*)op = o0; *(f32x4*)(op + 4) = o1;
                    v4u w; w.x = cvt_pk_bf16(o0.x, o0.y); w.y = cvt_pk_bf16(o0.z, o0.w); w.z = cvt_pk_bf16(o1.x, o1.y); w.w = cvt_pk_bf16(o1.z, o1.w); *(v4u*)(MKV + (size_t)row * D + c0 + bj * 128) = w; }
            }
    }
};
template <int BR> struct EpiMerge {
    const bf16* GATE; float* T; bf16* MB;
    __device__ __forceinline__ void operator()(AccRef acc, const Unit& u, int wr, int wc, int fr, int fq) const {
        const int row0 = u.pm * 256 + wr * 64 + fr, c0 = u.pn * 256 + wc * 32 + 8 * fq;
#pragma unroll
        for (int ai = 0; ai < 2; ++ai)
#pragma unroll
            for (int m = 0; m < 4; ++m) {
                const int row = row0 + ai * 128 + m * 16;
#pragma unroll
                for (int bj = 0; bj < 2; ++bj) {
                    const v4u gw = *(const v4u*)(GATE + (size_t)row * 3072 + BR * 1024 + c0 + bj * 128);
                    float* tp = T + (size_t)row * D + c0 + bj * 128;
                    f32x4 o0 = acc[ai][bj][m][0] * (f32x4){bflo(gw.x), bfhi(gw.x), bflo(gw.y), bfhi(gw.y)}, o1 = acc[ai][bj][m][1] * (f32x4){bflo(gw.z), bfhi(gw.z), bflo(gw.w), bfhi(gw.w)};
#ifndef MK_E3
                    if (BR > 0) { o0 += *(const f32x4*)tp; o1 += *(const f32x4*)(tp + 4); }
#endif
                    if (BR < 2) { *(f32x4*)tp = o0; *(f32x4*)(tp + 4) = o1; }
                    else { v4u w; w.x = cvt_pk_bf16(o0.x, o0.y); w.y = cvt_pk_bf16(o0.z, o0.w); w.z = cvt_pk_bf16(o1.x, o1.y); w.w = cvt_pk_bf16(o1.z, o1.w); *(v4u*)(MB + (size_t)row * D + c0 + bj * 128) = w; }
                }
            }
    }
};
struct EpiZ {
    const float* pq; const float* ropeC; const float* ropeS; const float* bga; float* out;
    bf16 *QS, *KS, *VS, *GQ, *GK, *GV, *GRS, *MQ, *GATE; float* GA;
    template <int ACT> __device__ __forceinline__ void plain(AccRef acc, const float (&rs)[2][4], int row0, bf16* dst, int ld, int col0, float scale) const {
#pragma unroll
        for (int ai = 0; ai < 2; ++ai)
#pragma unroll
            for (int m = 0; m < 4; ++m) { const int row = row0 + ai * 128 + m * 16; const float s = rs[ai][m];
#pragma unroll
                for (int bj = 0; bj < 2; ++bj) { float o[8];
#pragma unroll
                    for (int n = 0; n < 2; ++n)
#pragma unroll
                        for (int i = 0; i < 4; ++i) { const float x = acc[ai][bj][m][n][i] * s; o[4 * n + i] = ACT == 0 ? x * scale : (ACT == 1 ? siluf_(x) : sigmoidf_(x)); }
                    v4u w; w.x = cvt_pk_bf16(o[0], o[1]); w.y = cvt_pk_bf16(o[2], o[3]); w.z = cvt_pk_bf16(o[4], o[5]); w.w = cvt_pk_bf16(o[6], o[7]);
                    *(v4u*)(dst + (size_t)row * ld + col0 + bj * 128) = w; } }
    }
    __device__ __forceinline__ float* swa_dst(int row, int g, int kv, int h) const {
        if (row >= MP) return out + (g == 0 ? O_SWA0S : (g == 1 ? O_SWA1S : O_SWA2S)) + ((size_t)(row - MP) * 2 + kv) * 512 + h * 128;
        const int b = row >> 11, t = row & 2047, keep = 128 << (2 * g), t0 = SEQ - keep;
        if (t < t0) return nullptr;
        return out + (g == 0 ? O_SWA0P : (g == 1 ? O_SWA1P : O_SWA2P)) + (((size_t)b * keep + (t - t0)) * 2 + kv) * 512 + h * 128;
    }
    __device__ __forceinline__ void operator()(AccRef acc, const Unit& u, int wr, int wc, int fr, int fq) const {
        const int row0 = u.pm * 256 + wr * 64 + fr, pn = u.pn, cl = wc * 32 + 8 * fq;
        float rs[2][4];
#pragma unroll
        for (int ai = 0; ai < 2; ++ai)
#pragma unroll
            for (int m = 0; m < 4; ++m) { const int row = row0 + ai * 128 + m * 16;
                const f32x4 pv = *(const f32x4*)(pq + (size_t)row * 16 + 4 * fq); float t = (pv.x + pv.y) + (pv.z + pv.w); t += __shfl_xor(t, 16); t += __shfl_xor(t, 32); rs[ai][m] = __builtin_amdgcn_rsqf(t * (1.f / D) + EPS); }
        if (pn < 12) {
            const int isk = pn >= 6, g = (pn % 6) >> 1, hp = pn & 1, e0 = wc * 16 + 4 * fq;
#pragma unroll
            for (int ai = 0; ai < 2; ++ai)
#pragma unroll
                for (int m = 0; m < 4; ++m) { const int row = row0 + ai * 128 + m * 16; const float s = rs[ai][m];
                    const int pidx = row < MP ? (row & 2047) : SEQ + ((row - MP) & 3);
                    const f32x4 cs = *(const f32x4*)(ropeC + pidx * 64 + e0), sn = *(const f32x4*)(ropeS + pidx * 64 + e0);
#pragma unroll
                    for (int bj = 0; bj < 2; ++bj) { const int h = 2 * hp + bj;
                        const f32x4 x1 = acc[ai][bj][m][0] * s, x2 = acc[ai][bj][m][1] * s;
                        f32x4 r1 = x1 * cs - x2 * sn, r2 = x2 * cs + x1 * sn;
                        if (!isk) { r1 *= QSCALE; r2 *= QSCALE; }
                        bf16* dp = (isk ? KS : QS) + (size_t)row * 1536 + g * 512 + h * 128 + e0;
                        v2u w1, w2; w1.x = cvt_pk_bf16(r1.x, r1.y); w1.y = cvt_pk_bf16(r1.z, r1.w); w2.x = cvt_pk_bf16(r2.x, r2.y); w2.y = cvt_pk_bf16(r2.z, r2.w);
                        *(v2u*)dp = w1; *(v2u*)(dp + 64) = w2;
                        if (isk) { float* fo = swa_dst(row, g, 0, h); if (fo) { *(f32x4*)(fo + e0) = r1; *(f32x4*)(fo + 64 + e0) = r2; } }
                    } }
        } else if (pn < 18) {
            const int g = (pn - 12) >> 1, hp = pn & 1;
#pragma unroll
            for (int ai = 0; ai < 2; ++ai)
#pragma unroll
                for (int m = 0; m < 4; ++m) { const int row = row0 + ai * 128 + m * 16; const float s = rs[ai][m];
#pragma unroll
                    for (int bj = 0; bj < 2; ++bj) { const int h = 2 * hp + bj; const f32x4 o0 = acc[ai][bj][m][0] * s, o1 = acc[ai][bj][m][1] * s;
                        v4u w; w.x = cvt_pk_bf16(o0.x, o0.y); w.y = cvt_pk_bf16(o0.z, o0.w); w.z = cvt_pk_bf16(o1.x, o1.y); w.w = cvt_pk_bf16(o1.z, o1.w);
                        *(v4u*)(VS + (size_t)row * 1536 + g * 512 + h * 128 + cl) = w;
                        float* fo = swa_dst(row, g, 1, h); if (fo) { *(f32x4*)(fo + cl) = o0; *(f32x4*)(fo + cl + 4) = o1; } } }
        } else if (pn == 18) plain<0>(acc, rs, row0, GQ, 256, cl, 0.125f);
        else if (pn == 19) plain<0>(acc, rs, row0, GK, 256, cl, 1.f);
        else if (pn < 22) plain<0>(acc, rs, row0, GV, 512, (pn - 20) * 256 + cl, 1.f);
        else if (pn < 24) plain<1>(acc, rs, row0, GRS, 512, (pn - 22) * 256 + cl, 1.f);
        else if (pn == 24) {
#pragma unroll
            for (int ai = 0; ai < 2; ++ai)
#pragma unroll
                for (int m = 0; m < 4; ++m) { const int row = row0 + ai * 128 + m * 16; const float s = rs[ai][m];
#pragma unroll
                    for (int bj = 0; bj < 2; ++bj)
#pragma unroll
                        for (int n = 0; n < 2; ++n) { const int c = bj * 128 + cl + 4 * n; const f32x4 bv = *(const f32x4*)(bga + c); f32x4 o;
#pragma unroll
                            for (int i = 0; i < 4; ++i) { const float x = acc[ai][bj][m][n][i] * s + bv[i];
                                o[i] = (fminf(x, 0.f) - LN2 * fast_log2(1.f + fast_exp2(-1.4426950408889634f * fabsf(x)))) * (1.f / 16.f); }
                            *(f32x4*)(GA + (size_t)row * 256 + c) = o; } }
        } else if (pn < 27) plain<0>(acc, rs, row0, MQ, 512, (pn - 25) * 256 + cl, QSCALE);
        else plain<2>(acc, rs, row0, GATE, 3072, (pn - 27) * 256 + cl, 1.f);
    }
};

#define XB_TMO      128
#define XB_XCNT(j)  (256  + 64 * (j))
#define XB_XSUB(j)  (1280 + 64 * (j))
#define XB_XGEN(j)  (2304 + 64 * (j))
#define XB_TOP      3328
#define XB_TOPGEN   3392
#define XCD_BAR_WORDS 3456
#define XB_SPIN_CAP (1u << 18)
__device__ __forceinline__ unsigned xb_ld(unsigned* p)              { return __hip_atomic_load(p, __ATOMIC_RELAXED, __HIP_MEMORY_SCOPE_AGENT); }
__device__ __forceinline__ unsigned xb_add(unsigned* p, unsigned v) { return __hip_atomic_fetch_add(p, v, __ATOMIC_RELAXED, __HIP_MEMORY_SCOPE_AGENT); }
__device__ __forceinline__ unsigned xb_xcc_id() { return (unsigned)__builtin_amdgcn_s_getreg((3 << 11) | 20) & 0xFu; }
#define XB_SPIN(cond, bar) do { unsigned _sp = 0; while (cond) { __builtin_amdgcn_s_sleep(1); \
    if ((++_sp & 255u) == 0u) { if (xb_ld(&(bar)[XB_TMO])) break; if (_sp > XB_SPIN_CAP) { atomicAdd(&(bar)[XB_TMO], 1u); break; } } } } while (0)
struct XcdBarrier { unsigned* bar; unsigned x; volatile LAS unsigned* st; };
__device__ __forceinline__ XcdBarrier xcd_barrier_post(unsigned* bar, volatile LAS unsigned* st) {
    XcdBarrier b; b.bar = bar; b.x = xb_xcc_id(); b.st = st;
    if (threadIdx.x == 0) (void)xb_add(&bar[XB_XCNT(b.x)], 1u);
    return b;
}
__device__ __forceinline__ void xcd_barrier_complete(unsigned* bar, unsigned x, unsigned& nloc, unsigned& nx) {
    const unsigned G = gridDim.x * gridDim.y * gridDim.z;
    unsigned sum, cnt, mine, sp = 0u;
    for (;;) {
        sum = 0u; cnt = 0u; mine = 0u;
#pragma unroll
        for (unsigned j = 0; j < 16; ++j) { const unsigned c = xb_ld(&bar[XB_XCNT(j)]); sum += c; cnt += (c > 0u) ? 1u : 0u; mine = (j == x) ? c : mine; }
        if (sum == G) break;
        __builtin_amdgcn_s_sleep(1);
        if ((++sp & 255u) == 0u) { if (xb_ld(&bar[XB_TMO])) break; if (sp > XB_SPIN_CAP) { atomicAdd(&bar[XB_TMO], 1u); break; } }
    }
    nloc = mine > 0u ? mine : 1u; nx = cnt > 0u ? cnt : 1u;
}
__device__ __forceinline__ void xcd_barrier(const XcdBarrier& b) {
    asm volatile("s_waitcnt vmcnt(0)" ::: "memory");
    __syncthreads();
    if (threadIdx.x == 0) {
        unsigned* bar = b.bar;
        __builtin_amdgcn_s_waitcnt(0);
        unsigned nloc = b.st[0], nx = b.st[1];
        if (nloc == 0u) { xcd_barrier_complete(bar, b.x, nloc, nx); b.st[0] = nloc; b.st[1] = nx; }
        const unsigned old = xb_add(&bar[XB_XSUB(b.x)], 1u);
        const unsigned gen = old / nloc;
        if (old + 1u == (gen + 1u) * nloc) {
            __builtin_amdgcn_fence(__ATOMIC_RELEASE, "agent");
            asm volatile("s_waitcnt vmcnt(0)" ::: "memory");
            const unsigned og = xb_add(&bar[XB_TOP], 1u);
            const unsigned tg = og / nx;
            if (og + 1u == (tg + 1u) * nx) xb_add(&bar[XB_TOPGEN], 1u);
            else XB_SPIN(xb_ld(&bar[XB_TOPGEN]) == tg, bar);
            __builtin_amdgcn_fence(__ATOMIC_ACQUIRE, "agent");
            xb_add(&bar[XB_XGEN(b.x)], 1u);
            asm volatile("s_waitcnt vmcnt(0)" ::: "memory");
        } else {
            XB_SPIN(xb_ld(&bar[XB_XGEN(b.x)]) == gen, bar);
            __builtin_amdgcn_fence(__ATOMIC_ACQUIRE, "agent");
            asm volatile("s_waitcnt vmcnt(0)" ::: "memory");
        }
    }
    __syncthreads();
}

struct Args { const float* in[25]; float* out; unsigned char* ws; int ph_lo, ph_hi, li, pad; };
struct Frame {
    LAS unsigned char* lds; int tid, lane, wave, vcu, G;
    const float *i0, *i1, *i2, *i3, *i4, *i5, *i6, *i7, *i8, *i9, *i10, *i11, *i12, *i13, *i14, *i15, *i16, *i17, *i18, *i19, *i20, *i21, *i22, *i23, *i24;
    float* out; unsigned char* ws;
};
__device__ __forceinline__ float wave_sum(float v) {
#pragma unroll
    for (int o = 1; o < 64; o <<= 1) v += __shfl_xor(v, o);
    return v;
}

enum WKind { WK_PLAIN = 0, WK_SWIGLU = 1, WK_IN = 2 };
__device__ __forceinline__ int p0_win_col(int np) {
    const int pn = np >> 8, r = np & 255;
    if (pn < 18) { const int qkv = pn / 6, g = (pn % 6) >> 1, hp = pn & 1, h = 2 * hp + (r >> 7); const int d = qkv < 2 ? sig_rope(r & 127) : sig_plain(r & 127); return ((qkv * 3 + g) * 4 + h) * 128 + d; }
    const int c = sig_plain(r);
    if (pn == 18) return 4608 + c;
    if (pn == 19) return 4864 + c;
    if (pn < 22) return 5120 + (pn - 20) * 256 + c;
    if (pn < 24) return 5632 + (pn - 22) * 256 + c;
    if (pn == 24) return -1 - c;
    if (pn < 27) return 6160 + (pn - 25) * 256 + c;
    return DIN + (pn - 27) * 256 + c;
}
__device__ __forceinline__ void p0_item(const Frame& F, int kind, const float* W, int ldw, const float* W2, const float* gain, const float* a2, bf16* WT, int K, int kb, int nb, LAS float* scr) {
    const int lane = F.lane, k0 = 64 * kb, n0 = 32 * nb, np = n0 + (lane & 31);
    int sc; const float* Wp = W; int ld = ldw;
    if (kind == WK_PLAIN) sc = sig_plain(np);
    else if (kind == WK_SWIGLU) { const int r = np & 255; sc = (r >> 7) * FF + (np >> 8) * 128 + sig_plain(r & 127); }
    else { sc = p0_win_col(np); if (sc >= DIN) { sc -= DIN; Wp = W2; ld = 3072; } }
    if (sc >= 0) {
#pragma unroll 8
        for (int i = 0; i < 32; ++i) { const int kk = 2 * i + (lane >> 5); float v = Wp[(size_t)(k0 + kk) * ld + sc]; if (gain) v *= gain[k0 + kk]; scr[kk * 33 + (lane & 31)] = v; }
    } else {
        const int j = -1 - sc; float a2c[16];
#pragma unroll
        for (int r = 0; r < 16; ++r) a2c[r] = a2[r * 256 + j];
        for (int i = 0; i < 32; ++i) { const int kk = 2 * i + (lane >> 5); const float* wr_ = W + (size_t)(k0 + kk) * ldw + 6144; float v = 0.f;
#pragma unroll
            for (int r = 0; r < 16; ++r) v += wr_[r] * a2c[r];
            scr[kk * 33 + (lane & 31)] = v * gain[k0 + kk]; }
    }
    LDS_WAIT(); asm volatile("" ::: "memory");
    const int c = lane & 7;
#pragma unroll
    for (int j = 0; j < 4; ++j) { const int n = (lane >> 3) + 8 * j; const LAS float* s = scr + (8 * c) * 33 + n;
        v4u o; o.x = pk2(s[0 * 33], s[1 * 33]); o.y = pk2(s[2 * 33], s[3 * 33]); o.z = pk2(s[4 * 33], s[5 * 33]); o.w = pk2(s[6 * 33], s[7 * 33]);
        *(GAS v4u*)(WT + (size_t)(n0 + n) * K + k0 + 8 * c) = o; }
    LDS_WAIT(); asm volatile("" ::: "memory");
}
__device__ __forceinline__ void rms_row_to_bf16(int lane, const float* xrow, const float* gain, bf16* orow) {
    const GAS f32x4* xr = (const GAS f32x4*)xrow + lane; const GAS f32x4* gr = (const GAS f32x4*)gain + lane;
    f32x4 v[4]; float s = 0.f;
#pragma unroll
    for (int j = 0; j < 4; ++j) { v[j] = xr[64 * j]; s += (v[j].x * v[j].x + v[j].y * v[j].y) + (v[j].z * v[j].z + v[j].w * v[j].w); }
    const float rstd = 1.0f / sqrtf(wave_sum(s) * (1.f / D) + EPS);
    GAS v2u* o8 = (GAS v2u*)orow + lane;
#pragma unroll
    for (int j = 0; j < 4; ++j) { const f32x4 gg = gr[64 * j]; v2u w; w.x = pk2(v[j].x * rstd * gg.x, v[j].y * rstd * gg.y); w.y = pk2(v[j].z * rstd * gg.z, v[j].w * rstd * gg.w); o8[64 * j] = w; }
}
__device__ __forceinline__ void sincos_d(double x, double& s, double& c) {
    const double TWO_PI = 6.283185307179586476925286766559;
    const double n = __builtin_rint(x / TWO_PI); const double r = x - n * TWO_PI, r2 = r * r;
    double ts = 1.0, tc = 1.0;
#pragma unroll
    for (int k = 14; k >= 1; --k) { ts = 1.0 - ts * r2 / (double)((2 * k) * (2 * k + 1)); tc = 1.0 - tc * r2 / (double)((2 * k - 1) * (2 * k)); }
    s = ts * r; c = tc;
}
__device__ __forceinline__ void p0_prologue(Frame& F) {
    unsigned char* ws = F.ws;
    LAS float* scr = (LAS float*)(F.lds + RING_OFF + F.wave * 16384);
    const int gw = F.vcu * NWAVES + F.wave, NGW = F.G * NWAVES;
    constexpr int I_A = 16 * 176, I_O = 44 * 32, I_IN = 16 * 312, I_BR = 8 * 32, I_SQ = 16 * 32;
    constexpr int NITEMS = 2 * I_A + 2 * I_O + I_IN + 3 * I_BR + 2 * I_SQ;
    for (int it = gw; it < NITEMS; it += NGW) {
        int r = it;
        if (r < I_A) { p0_item(F, WK_SWIGLU, F.i9, 2 * FF, nullptr, nullptr, nullptr, (bf16*)(ws + WS_W1A), D, r / 176, r % 176, scr); continue; } r -= I_A;
        if (r < I_A) { p0_item(F, WK_SWIGLU, F.i22, 2 * FF, nullptr, F.i21, nullptr, (bf16*)(ws + WS_W2A), D, r / 176, r % 176, scr); continue; } r -= I_A;
        if (r < I_O) { p0_item(F, WK_PLAIN, F.i10, D, nullptr, nullptr, nullptr, (bf16*)(ws + WS_W1O), FF, r / 32, r % 32, scr); continue; } r -= I_O;
        if (r < I_O) { p0_item(F, WK_PLAIN, F.i23, D, nullptr, nullptr, nullptr, (bf16*)(ws + WS_W2O), FF, r / 32, r % 32, scr); continue; } r -= I_O;
        if (r < I_IN) { p0_item(F, WK_IN, F.i12, DIN, F.i16, F.i11, F.i13, (bf16*)(ws + WS_WIN), D, r / 312, r % 312, scr); continue; } r -= I_IN;
        if (r < 3 * I_BR) { const int br = r / I_BR, q = r % I_BR; p0_item(F, WK_PLAIN, F.i17 + (size_t)br * 512 * D, D, nullptr, nullptr, nullptr, (bf16*)(ws + WS_WBR) + (size_t)br * D * 512, 512, q / 32, q % 32, scr); continue; } r -= 3 * I_BR;
        if (r < I_SQ) { p0_item(F, WK_PLAIN, F.i18, D, nullptr, nullptr, nullptr, (bf16*)(ws + WS_WOUT), D, r / 32, r % 32, scr); continue; } r -= I_SQ;
        p0_item(F, WK_PLAIN, F.i20, D, nullptr, nullptr, nullptr, (bf16*)(ws + WS_WMEM), D, r / 32, r % 32, scr);
    }
    for (int m = gw; m < MR + MM; m += NGW) {
        if (m < MP) rms_row_to_bf16(F.lane, F.i0 + (size_t)m * D, F.i8, (bf16*)(ws + WS_XB) + (size_t)m * D);
        else if (m < MR) rms_row_to_bf16(F.lane, F.i1 + (size_t)(m - MP) * D, F.i8, (bf16*)(ws + WS_XB) + (size_t)m * D);
        else rms_row_to_bf16(F.lane, F.i2 + (size_t)(m - MR) * D, F.i19, (bf16*)(ws + WS_MEMB) + (size_t)(m - MR) * D);
    }
    float* rc = (float*)(ws + WS_ROPE); float* rsn = rc + NPOS * 64;
    for (int i = (F.vcu * NWAVES * 64) + F.tid; i < NPOS * 64; i += F.G * NWAVES * 64) {
        const int p = i >> 6, e = i & 63; const int pos = p < SEQ ? p : PAST + (p - SEQ);
        const double y = -(double)e * 9.210340371976182736 / 64.0 / 16.0; double ex = 1.0;
#pragma unroll
        for (int k = 14; k >= 1; --k) ex = 1.0 + ex * y / (double)k;
        ex *= ex; ex *= ex; ex *= ex; ex *= ex;
        const float inv = (float)ex; const float ang = (float)pos * inv;
        double s, c; sincos_d((double)ang, s, c); rc[i] = (float)c; rsn[i] = (float)s;
    }
}

__device__ __forceinline__ int koff(int row, int ch) { return 256 * row + 16 * (ch ^ (row & 15)); }
__device__ __forceinline__ int voff(int row, int ch) { return 256 * row + 16 * (ch ^ ((row & 7) << 1)); }
typedef short v4i16_t __attribute__((ext_vector_type(4)));
__device__ __forceinline__ s16x4 vtr(const LAS unsigned char* p) { return __builtin_bit_cast(s16x4, __builtin_amdgcn_ds_read_tr16_b64_v4i16((LAS v4i16_t*)p)); }
struct AttnDesc { const bf16* Qp; const bf16* Kp; const bf16* Vp; bf16* Op; float* lsep; long qrow0, krow0; int qpitch, kpitch, opitch, qstride, kstride, kmin; };
template <int MODE> __device__ __forceinline__ AttnDesc attn_desc(const Frame& F, int id) {
    unsigned char* ws = F.ws; AttnDesc d;
    if (MODE == 0) {
        const int b = id / 192, rem = id % 192, gh = rem >> 4, u = rem & 15, g = gh >> 2;
        const int dil = g == 0 ? 1 : (g == 1 ? 4 : 16), r = g == 0 ? 0 : (g == 1 ? (u & 3) : u), n = g == 0 ? u : (g == 1 ? (u >> 2) : 0);
        const long base = (long)b * SEQ + r;
        d.Qp = (const bf16*)(ws + WS_QS) + gh * 128; d.Kp = (const bf16*)(ws + WS_KS) + gh * 128; d.Vp = (const bf16*)(ws + WS_VS) + gh * 128; d.Op = (bf16*)(ws + WS_OG) + gh * 128; d.lsep = (float*)(ws + WS_LSE) + gh;
        d.qrow0 = base + (long)128 * n * dil; d.krow0 = base + (long)128 * (n - 1) * dil; d.qpitch = 1536; d.kpitch = 1536; d.opitch = 1536; d.qstride = dil; d.kstride = dil; d.kmin = n == 0 ? 128 : 0;
    } else {
        const int j = id - 6144, b = j >> 6, h = (j >> 4) & 3, n = j & 15;
        d.Qp = (const bf16*)(ws + WS_MQ) + h * 128; d.Kp = (const bf16*)(ws + WS_MKV) + h * 128; d.Vp = (const bf16*)(ws + WS_MKV) + 512 + h * 128; d.Op = (bf16*)(ws + WS_OALL) + 1024 + h * 128; d.lsep = nullptr;
        d.qrow0 = (long)b * SEQ + 128 * n; d.krow0 = (long)b * MEML; d.qpitch = 512; d.kpitch = 1024; d.opitch = 1536; d.qstride = 1; d.kstride = 1; d.kmin = 0;
    }
    return d;
}
__device__ __forceinline__ void attn_issue(const Frame& F, const AttnDesc& d, v4u (&kv)[8], v4u (&vv)[8], bf16x8 (&qf)[4]) {
    const int c = F.tid & 15, r0 = F.tid >> 4, l15 = F.lane & 15, g4 = F.lane >> 4;
#pragma unroll
    for (int i = 0; i < 8; ++i) { const int kj = r0 + 32 * i; const long row = d.krow0 + (long)(kj < d.kmin ? d.kmin : kj) * d.kstride;
        kv[i] = *(const v4u*)(d.Kp + row * d.kpitch + c * 8); vv[i] = *(const v4u*)(d.Vp + row * d.kpitch + c * 8); }
    const long qrow = d.qrow0 + (long)(16 * F.wave + l15) * d.qstride;
#pragma unroll
    for (int s = 0; s < 4; ++s) qf[s] = *(const bf16x8*)(d.Qp + qrow * d.qpitch + 32 * s + 8 * g4);
}
__device__ __forceinline__ void attn_fill(const Frame& F, const v4u (&kv)[8], const v4u (&vv)[8]) {
    LAS unsigned char* ldsK = F.lds + RING_OFF; LAS unsigned char* ldsV = F.lds + RING_OFF + 65536;
    const int c = F.tid & 15, r0 = F.tid >> 4;
#pragma unroll
    for (int i = 0; i < 8; ++i) { const int kj = r0 + 32 * i; *(LAS v4u*)(ldsK + koff(kj, c)) = kv[i]; *(LAS v4u*)(ldsV + voff(kj, c)) = vv[i]; }
}
template <int MODE> __device__ __forceinline__ void attn_compute(const Frame& F, const AttnDesc& d, const bf16x8 (&qf)[4]) {
    const LAS unsigned char* ldsK = F.lds + RING_OFF; const LAS unsigned char* ldsV = F.lds + RING_OFF + 65536;
    const int lane = F.lane, w = F.wave, l15 = lane & 15, g4 = lane >> 4;
    constexpr int NF = MODE == 0 ? 9 : 16, NP = (NF + 1) / 2;
    const int f0 = MODE == 0 ? w : 0; const bool half = MODE == 0 && d.kmin != 0;
    f32x4 S[NF];
#pragma unroll
    for (int i = 0; i < NF; ++i) { S[i] = (f32x4){0.f, 0.f, 0.f, 0.f};
        if (!(half && f0 + i < 8)) { const int krow = 16 * (f0 + i) + l15;
#pragma unroll
            for (int s = 0; s < 4; ++s) { const bf16x8 kf = *(const LAS bf16x8*)(ldsK + koff(krow, 4 * s + g4)); S[i] = __builtin_amdgcn_mfma_f32_16x16x32_bf16(kf, qf[s], S[i], 0, 0, 0); } } }
    float mx = -3.0e38f; const int iq = 16 * w + l15;
#pragma unroll
    for (int i = 0; i < NF; ++i)
#pragma unroll
        for (int r = 0; r < 4; ++r) { if (MODE == 0) { const int kj = 16 * (f0 + i) + 4 * g4 + r; const bool ok = kj >= iq && kj <= iq + 128 && kj >= d.kmin; S[i][r] = ok ? S[i][r] : -3.0e38f; } mx = fmaxf(mx, S[i][r]); }
    mx = fmaxf(mx, __shfl_xor(mx, 16)); mx = fmaxf(mx, __shfl_xor(mx, 32));
    float ls = 0.f;
#pragma unroll
    for (int i = 0; i < NF; ++i)
#pragma unroll
        for (int r = 0; r < 4; ++r) { const float p = fast_exp2(S[i][r] - mx); S[i][r] = p; ls += p; }
    ls += __shfl_xor(ls, 16); ls += __shfl_xor(ls, 32);
    f32x4 O[8];
#pragma unroll
    for (int df = 0; df < 8; ++df) O[df] = (f32x4){0.f, 0.f, 0.f, 0.f};
    const int q4 = l15 >> 2, p4 = lane & 3;
#pragma unroll
    for (int pr = 0; pr < NP; ++pr) {
        int fa = f0 + 2 * pr, fb = fa + 1; if (fb > 15) fb = 15;
        if (half && fb < 8) continue;
        if (half && fa < 8) fa = 8;
        const f32x4 pa = S[2 * pr], pb = (2 * pr + 1 < NF) ? S[(2 * pr + 1 < NF) ? 2 * pr + 1 : 0] : (f32x4){0.f, 0.f, 0.f, 0.f};
        v4u pw; pw.x = cvt_pk_bf16(pa.x, pa.y); pw.y = cvt_pk_bf16(pa.z, pa.w); pw.z = cvt_pk_bf16(pb.x, pb.y); pw.w = cvt_pk_bf16(pb.z, pb.w);
        const bf16x8 pf = __builtin_bit_cast(bf16x8, pw);
        const int ra = 16 * fa + 4 * g4 + q4, rb = 16 * fb + 4 * g4 + q4;
#pragma unroll
        for (int df = 0; df < 8; ++df) {
            const s16x4 t1 = vtr(ldsV + voff(ra, 2 * df + (p4 >> 1)) + 8 * (p4 & 1)), t2 = vtr(ldsV + voff(rb, 2 * df + (p4 >> 1)) + 8 * (p4 & 1));
            const bf16x8 vf = {t1[0], t1[1], t1[2], t1[3], t2[0], t2[1], t2[2], t2[3]};
            O[df] = __builtin_amdgcn_mfma_f32_16x16x32_bf16(vf, pf, O[df], 0, 0, 0);
        }
    }
    const float inv = 1.0f / ls;
    const long qrow = d.qrow0 + (long)(16 * w + l15) * d.qstride;
    bf16* op = d.Op + qrow * d.opitch + 4 * g4;
#pragma unroll
    for (int df = 0; df < 8; ++df) { const f32x4 o = O[df] * inv; v2u wv; wv.x = cvt_pk_bf16(o.x, o.y); wv.y = cvt_pk_bf16(o.z, o.w); *(v2u*)(op + 16 * df) = wv; }
    if (MODE == 0 && g4 == 0) d.lsep[qrow * 12] = (mx + fast_log2(ls)) * LN2;
}
template <int MODE> __device__ __forceinline__ void attn_batch(const Frame& F, int id0) {
#pragma unroll 1
    for (int u = 0; u < 4; ++u) {
        const AttnDesc d = attn_desc<MODE>(F, id0 + u);
        bf16x8 qf[4];
        __syncthreads();
        { v4u kv[8], vv[8]; attn_issue(F, d, kv, vv, qf); attn_fill(F, kv, vv); }
        __syncthreads();
        attn_compute<MODE>(F, d, qf);
    }
}
__device__ __forceinline__ void p4_sample_attn(const Frame& F, int wt, const float* c0, const float* c1, const float* c2, const float* cm) {
    unsigned char* ws = F.ws; const int lane = F.lane, sub = lane & 15, t = lane >> 4;
    const int db = wt >> 4, h = (wt >> 2) & 3, src = wt & 3;
    const int row = MP + db * 4 + t;
    const bf16* qp = src < 3 ? (const bf16*)(ws + WS_QS) + (size_t)row * 1536 + src * 512 + h * 128 + 8 * sub : (const bf16*)(ws + WS_MQ) + (size_t)row * 512 + h * 128 + 8 * sub;
    float q[8]; { const v4u qw = *(const v4u*)qp; q[0] = bflo(qw.x); q[1] = bfhi(qw.x); q[2] = bflo(qw.y); q[3] = bfhi(qw.y); q[4] = bflo(qw.z); q[5] = bfhi(qw.z); q[6] = bflo(qw.w); q[7] = bfhi(qw.w); }
    float mx = -3.0e38f, ls = 0.f, o[8];
#pragma unroll
    for (int j = 0; j < 8; ++j) o[j] = 0.f;
#define SA_STEP(K0, K1, V0, V1) do { float s_ = (q[0] * K0.x + q[1] * K0.y) + (q[2] * K0.z + q[3] * K0.w) + (q[4] * K1.x + q[5] * K1.y) + (q[6] * K1.z + q[7] * K1.w); \
        s_ += __shfl_xor(s_, 1); s_ += __shfl_xor(s_, 2); s_ += __shfl_xor(s_, 4); s_ += __shfl_xor(s_, 8); \
        const float mn_ = fmaxf(mx, s_), sc_ = fast_exp2(mx - mn_), p_ = fast_exp2(s_ - mn_); mx = mn_; ls = ls * sc_ + p_; \
        o[0] = o[0] * sc_ + p_ * V0.x; o[1] = o[1] * sc_ + p_ * V0.y; o[2] = o[2] * sc_ + p_ * V0.z; o[3] = o[3] * sc_ + p_ * V0.w; \
        o[4] = o[4] * sc_ + p_ * V1.x; o[5] = o[5] * sc_ + p_ * V1.y; o[6] = o[6] * sc_ + p_ * V1.z; o[7] = o[7] * sc_ + p_ * V1.w; } while (0)
    int nstart = 0, NK; const float* cache; int L = 256, dil = 1;
    if (src == 3) { cache = cm; NK = 256; }
    else { cache = src == 0 ? c0 : (src == 1 ? c1 : c2); L = 128 << (2 * src); dil = src == 0 ? 1 : (src == 1 ? 4 : 16); NK = 129; nstart = 4;
        for (int n = 0; n < 4; ++n) {
            const int idx = L + t - dil * n; f32x4 k0, k1, v0, v1;
            if (idx >= L) { const size_t ro = (size_t)(MP + db * 4 + (idx - L)) * 1536 + src * 512 + h * 128 + 8 * sub;
                const v4u kw = *(const v4u*)((const bf16*)(ws + WS_KS) + ro), vw = *(const v4u*)((const bf16*)(ws + WS_VS) + ro);
                k0 = (f32x4){bflo(kw.x), bfhi(kw.x), bflo(kw.y), bfhi(kw.y)}; k1 = (f32x4){bflo(kw.z), bfhi(kw.z), bflo(kw.w), bfhi(kw.w)};
                v0 = (f32x4){bflo(vw.x), bfhi(vw.x), bflo(vw.y), bfhi(vw.y)}; v1 = (f32x4){bflo(vw.z), bfhi(vw.z), bflo(vw.w), bfhi(vw.w)};
            } else { const float* kp = cache + (((size_t)db * L + idx) * 2) * 512 + h * 128 + 8 * sub;
                k0 = *(const f32x4*)kp; k1 = *(const f32x4*)(kp + 4); v0 = *(const f32x4*)(kp + 512); v1 = *(const f32x4*)(kp + 516); }
            SA_STEP(k0, k1, v0, v1);
        }
    }
    const float* kbase = cache + ((size_t)db * L * 2) * 512 + h * 128 + 8 * sub;
    const long kstep = src == 3 ? 1024 : -(long)dil * 1024; const long kfirst = src == 3 ? 0 : (long)(L + t) * 1024;
    int n = nstart;
    for (; n + 4 <= NK; n += 4) {
        f32x4 kk[4][2], vv[4][2];
#pragma unroll
        for (int j = 0; j < 4; ++j) { const float* kp = kbase + kfirst + (long)(n + j) * kstep; kk[j][0] = *(const f32x4*)kp; kk[j][1] = *(const f32x4*)(kp + 4); vv[j][0] = *(const f32x4*)(kp + 512); vv[j][1] = *(const f32x4*)(kp + 516); }
#pragma unroll
        for (int j = 0; j < 4; ++j) SA_STEP(kk[j][0], kk[j][1], vv[j][0], vv[j][1]);
    }
    for (; n < NK; ++n) { const float* kp = kbase + kfirst + (long)n * kstep; const f32x4 k0 = *(const f32x4*)kp, k1 = *(const f32x4*)(kp + 4), v0 = *(const f32x4*)(kp + 512), v1 = *(const f32x4*)(kp + 516); SA_STEP(k0, k1, v0, v1); }
#undef SA_STEP
    const float inv = 1.0f / ls;
    v4u w; w.x = cvt_pk_bf16(o[0] * inv, o[1] * inv); w.y = cvt_pk_bf16(o[2] * inv, o[3] * inv); w.z = cvt_pk_bf16(o[4] * inv, o[5] * inv); w.w = cvt_pk_bf16(o[6] * inv, o[7] * inv);
    if (src < 3) { *(v4u*)((bf16*)(ws + WS_OG) + (size_t)row * 1536 + src * 512 + h * 128 + 8 * sub) = w; if (sub == 0) ((float*)(ws + WS_LSE))[(size_t)row * 12 + src * 4 + h] = (mx + fast_log2(ls)) * LN2; }
    else *(v4u*)((bf16*)(ws + WS_OALL) + (size_t)row * 1536 + 1024 + h * 128 + 8 * sub) = w;
}
__device__ __forceinline__ void p4_gla_chain(const Frame& F, int row0, int T, int h, const float* S0, float* Sout) {
    unsigned char* ws = F.ws; const int tid = F.tid, v = tid & 127, ks = __builtin_amdgcn_readfirstlane(tid >> 7);
    const float* GA = (const float*)(ws + WS_GA); const bf16* GQ = (const bf16*)(ws + WS_GQ); const bf16* GK = (const bf16*)(ws + WS_GK); const bf16* GV = (const bf16*)(ws + WS_GV); float* GO = (float*)(ws + WS_GO);
    LAS float* part = (LAS float*)(F.lds + RING_OFF);
    float S[16];
#pragma unroll
    for (int i = 0; i < 16; ++i) S[i] = S0 ? S0[(size_t)(16 * ks + i) * 128 + v] : 0.f;
    for (int t0 = 0; t0 < T; t0 += 16) {
        const int nb = (T - t0) < 16 ? (T - t0) : 16;
        __syncthreads();
        for (int tt = 0; tt < nb; ++tt) {
            const size_t row = (size_t)(row0 + t0 + tt);
            const float* ap = GA + row * 256 + h * 64 + 16 * ks; const v4u kw0 = *(const v4u*)(GK + row * 256 + h * 64 + 16 * ks), kw1 = *(const v4u*)(GK + row * 256 + h * 64 + 16 * ks + 8);
            const v4u qw0 = *(const v4u*)(GQ + row * 256 + h * 64 + 16 * ks), qw1 = *(const v4u*)(GQ + row * 256 + h * 64 + 16 * ks + 8);
            const float vv = bf2f(GV[row * 512 + h * 128 + v]);
            const f32x4 a0 = *(const f32x4*)ap, a1 = *(const f32x4*)(ap + 4), a2 = *(const f32x4*)(ap + 8), a3 = *(const f32x4*)(ap + 12);
            const float la[16] = {a0.x, a0.y, a0.z, a0.w, a1.x, a1.y, a1.z, a1.w, a2.x, a2.y, a2.z, a2.w, a3.x, a3.y, a3.z, a3.w};
            const float kk[16] = {bflo(kw0.x), bfhi(kw0.x), bflo(kw0.y), bfhi(kw0.y), bflo(kw0.z), bfhi(kw0.z), bflo(kw0.w), bfhi(kw0.w), bflo(kw1.x), bfhi(kw1.x), bflo(kw1.y), bfhi(kw1.y), bflo(kw1.z), bfhi(kw1.z), bflo(kw1.w), bfhi(kw1.w)};
            const float qq[16] = {bflo(qw0.x), bfhi(qw0.x), bflo(qw0.y), bfhi(qw0.y), bflo(qw0.z), bfhi(qw0.z), bflo(qw0.w), bfhi(qw0.w), bflo(qw1.x), bfhi(qw1.x), bflo(qw1.y), bfhi(qw1.y), bflo(qw1.z), bfhi(qw1.z), bflo(qw1.w), bfhi(qw1.w)};
            float o = 0.f;
#pragma unroll
            for (int i = 0; i < 16; ++i) { S[i] = fast_exp2(la[i] * 1.4426950408889634f) * S[i] + kk[i] * vv; o += qq[i] * S[i]; }
            part[(tt * 4 + ks) * 128 + v] = o;
        }
        __syncthreads();
        for (int e = tid; e < nb * 128; e += 512) { const int tt = e >> 7, vv_ = e & 127;
            GO[(size_t)(row0 + t0 + tt) * 512 + h * 128 + vv_] = (part[(tt * 4 + 0) * 128 + vv_] + part[(tt * 4 + 1) * 128 + vv_]) + (part[(tt * 4 + 2) * 128 + vv_] + part[(tt * 4 + 3) * 128 + vv_]); }
    }
#pragma unroll
    for (int i = 0; i < 16; ++i) Sout[(size_t)(16 * ks + i) * 128 + v] = S[i];
}
constexpr int GL_QE = 0, GL_KE = 8192, GL_KDT = 16384, GL_VV = 24576, GL_EB = 40960, GL_TOT = 41216, GL_SET = 43264;
__device__ __forceinline__ int goff(int r, int c) { return 128 * r + 16 * (c ^ ((r >> 1) & 7)); }
__device__ __forceinline__ int gvoff(int row, int ch) { return 256 * row + 16 * (ch ^ (((row & 3) | ((((row >> 2) ^ (row >> 3)) & 1) << 2)) << 1)); }
__device__ __forceinline__ void p4_gla_chain_mfma(const Frame& F, int c) {
    unsigned char* ws = F.ws; const int tid = F.tid, lane = F.lane, w = F.wave, l15 = lane & 15, g4 = lane >> 4, q4 = l15 >> 2, p4 = lane & 3;
    const int b = c >> 2, h = c & 3; const size_t row0 = (size_t)b * SEQ;
    const float* GA = (const float*)(ws + WS_GA) + h * 64 + lane; const bf16* GQ = (const bf16*)(ws + WS_GQ) + h * 64 + lane; const bf16* GK = (const bf16*)(ws + WS_GK) + h * 64 + lane;
    const bf16* GV = (const bf16*)(ws + WS_GV) + h * 128 + (tid & 15) * 8; float* GO = (float*)(ws + WS_GO) + h * 128 + 16 * w + 4 * g4;
    constexpr float L2E = 1.4426950408889634f;
    f32x4 S[4];
#pragma unroll
    for (int K = 0; K < 4; ++K) S[K] = (f32x4){0.f, 0.f, 0.f, 0.f};
    float la[8]; unsigned short qh[8], kh[8]; v4u vr[2];
#define GLA_LOAD(ch) do { const size_t r_ = row0 + 64 * (size_t)(ch); \
        _Pragma("unroll") for (int t = 0; t < 8; ++t) { const size_t rr_ = (r_ + 8 * w + t) * 256; la[t] = GA[rr_]; qh[t] = GQ[rr_]; kh[t] = GK[rr_]; } \
        _Pragma("unroll") for (int e = 0; e < 2; ++e) vr[e] = *(const v4u*)(GV + (r_ + (tid >> 4) + 32 * e) * 512); } while (0)
    GLA_LOAD(0);
#pragma unroll 1
    for (int ch = 0; ch < SEQ / 64; ++ch) {
        LAS unsigned char* B = F.lds + RING_OFF + (ch & 1) * GL_SET;
        LAS float* TOT = (LAS float*)(B + GL_TOT); LAS float* EB = (LAS float*)(B + GL_EB);
        float cs[8], qv[8], kvv[8];
        cs[0] = la[0];
#pragma unroll
        for (int t = 1; t < 8; ++t) cs[t] = cs[t - 1] + la[t];
#pragma unroll
        for (int t = 0; t < 8; ++t) { qv[t] = bf2f(qh[t]); kvv[t] = bf2f(kh[t]); }
        TOT[w * 64 + lane] = cs[7];
#pragma unroll
        for (int e = 0; e < 2; ++e) *(LAS v4u*)(B + GL_VV + gvoff((tid >> 4) + 32 * e, tid & 15)) = vr[e];
        __syncthreads();
        float offs = 0.f, total = 0.f;
#pragma unroll
        for (int g = 0; g < 8; ++g) { const float tg = TOT[g * 64 + lane]; total += tg; offs += (g < w) ? tg : 0.f; }
        unsigned kd[8];
#pragma unroll
        for (int t = 0; t < 8; ++t) { const float bt = offs + cs[t]; const int i = 8 * w + t;
            const float e1 = fast_exp2(bt * L2E), e2 = fast_exp2(-bt * L2E), e3 = fast_exp2((total - bt) * L2E);
            *(LAS unsigned short*)(B + GL_QE + goff(i, lane >> 3) + 2 * (lane & 7)) = (unsigned short)f2bf(qv[t] * e1);
            *(LAS unsigned short*)(B + GL_KE + goff(i, lane >> 3) + 2 * (lane & 7)) = (unsigned short)f2bf(kvv[t] * e2);
            kd[t] = f2bf(kvv[t] * e3); }
        { v4u kw; kw.x = kd[0] | (kd[1] << 16); kw.y = kd[2] | (kd[3] << 16); kw.z = kd[4] | (kd[5] << 16); kw.w = kd[6] | (kd[7] << 16); *(LAS v4u*)(B + GL_KDT + goff(lane, w)) = kw; }
        if (w == 0) EB[lane] = fast_exp2(total * L2E);
        if (ch + 1 < SEQ / 64) GLA_LOAD(ch + 1);
        __syncthreads();
        const LAS unsigned char* QE = B + GL_QE; const LAS unsigned char* KE = B + GL_KE; const LAS unsigned char* KDT = B + GL_KDT; const LAS unsigned char* VV = B + GL_VV;
        bf16x8 kef[4][2];
#pragma unroll
        for (int J = 0; J < 4; ++J)
#pragma unroll
            for (int s = 0; s < 2; ++s) kef[J][s] = *(const LAS bf16x8*)(KE + goff(16 * J + l15, 4 * s + g4));
        bf16x8 vpr[2], vnat[2];
#pragma unroll
        for (int pp = 0; pp < 2; ++pp) { const int ra = 32 * pp + 4 * g4 + q4, rb = ra + 16;
            const s16x4 t1 = vtr(VV + gvoff(ra, 2 * w + (p4 >> 1)) + 8 * (p4 & 1)), t2 = vtr(VV + gvoff(rb, 2 * w + (p4 >> 1)) + 8 * (p4 & 1));
            vpr[pp] = (bf16x8){t1[0], t1[1], t1[2], t1[3], t2[0], t2[1], t2[2], t2[3]}; }
#pragma unroll
        for (int s = 0; s < 2; ++s) { const int r1 = 32 * s + 8 * g4 + q4, r2 = r1 + 4;
            const s16x4 t1 = vtr(VV + gvoff(r1, 2 * w + (p4 >> 1)) + 8 * (p4 & 1)), t2 = vtr(VV + gvoff(r2, 2 * w + (p4 >> 1)) + 8 * (p4 & 1));
            vnat[s] = (bf16x8){t1[0], t1[1], t1[2], t1[3], t2[0], t2[1], t2[2], t2[3]}; }
        bf16x8 sfr[2];
#pragma unroll
        for (int p = 0; p < 2; ++p) { v4u sw; sw.x = cvt_pk_bf16(S[2 * p].x, S[2 * p].y); sw.y = cvt_pk_bf16(S[2 * p].z, S[2 * p].w); sw.z = cvt_pk_bf16(S[2 * p + 1].x, S[2 * p + 1].y); sw.w = cvt_pk_bf16(S[2 * p + 1].z, S[2 * p + 1].w); sfr[p] = __builtin_bit_cast(bf16x8, sw); }
#pragma unroll
        for (int I = 0; I < 4; ++I) {
            f32x4 oT = (f32x4){0.f, 0.f, 0.f, 0.f};
#pragma unroll
            for (int p = 0; p < 2; ++p) {
                const v2u lo = *(const LAS v2u*)(QE + goff(16 * I + l15, 4 * p + (g4 >> 1)) + 8 * (g4 & 1)), hi = *(const LAS v2u*)(QE + goff(16 * I + l15, 4 * p + 2 + (g4 >> 1)) + 8 * (g4 & 1));
                const v4u bw = {lo.x, lo.y, hi.x, hi.y};
                oT = __builtin_amdgcn_mfma_f32_16x16x32_bf16(sfr[p], __builtin_bit_cast(bf16x8, bw), oT, 0, 0, 0); }
            bf16x8 qef[2];
#pragma unroll
            for (int s = 0; s < 2; ++s) qef[s] = *(const LAS bf16x8*)(QE + goff(16 * I + l15, 4 * s + g4));
            f32x4 d1[4];
#pragma unroll
            for (int J = 0; J < 4; ++J) { d1[J] = (f32x4){0.f, 0.f, 0.f, 0.f};
                if (J <= I) {
#pragma unroll
                    for (int s = 0; s < 2; ++s) d1[J] = __builtin_amdgcn_mfma_f32_16x16x32_bf16(kef[J][s], qef[s], d1[J], 0, 0, 0);
                    if (J == I) {
#pragma unroll
                        for (int r = 0; r < 4; ++r) d1[J][r] = (4 * g4 + r <= l15) ? d1[J][r] : 0.f; } } }
#pragma unroll
            for (int pp = 0; pp < 2; ++pp) if (2 * pp <= I) {
                const f32x4 pa = d1[2 * pp], pb = d1[2 * pp + 1];
                v4u pw; pw.x = cvt_pk_bf16(pa.x, pa.y); pw.y = cvt_pk_bf16(pa.z, pa.w); pw.z = cvt_pk_bf16(pb.x, pb.y); pw.w = cvt_pk_bf16(pb.z, pb.w);
                oT = __builtin_amdgcn_mfma_f32_16x16x32_bf16(vpr[pp], __builtin_bit_cast(bf16x8, pw), oT, 0, 0, 0); }
            *(f32x4*)(GO + (row0 + 64 * (size_t)ch + 16 * I + l15) * 512) = oT;
        }
#pragma unroll
        for (int K = 0; K < 4; ++K) {
            const f32x4 ebv = *(const LAS f32x4*)(EB + 16 * K + 4 * g4); S[K] *= ebv;
#pragma unroll
            for (int s = 0; s < 2; ++s) { const bf16x8 kdf = *(const LAS bf16x8*)(KDT + goff(16 * K + l15, 4 * s + g4)); S[K] = __builtin_amdgcn_mfma_f32_16x16x32_bf16(kdf, vnat[s], S[K], 0, 0, 0); } }
    }
#undef GLA_LOAD
    float* so = F.out + O_GLAP + (size_t)c * 64 * 128 + 16 * w + l15;
#pragma unroll
    for (int K = 0; K < 4; ++K)
#pragma unroll
        for (int r = 0; r < 4; ++r) so[(size_t)(16 * K + 4 * g4 + r) * 128] = S[K][r];
}
__device__ __forceinline__ void p5_combine_row(const Frame& F, int row) {
    unsigned char* ws = F.ws; const int lane = F.lane, hh = lane >> 4, sub = lane & 15, col = hh * 128 + 8 * sub;
    const float* lse = (const float*)(ws + WS_LSE) + (size_t)row * 12;
    const float l0 = lse[hh], l1 = lse[4 + hh], l2 = lse[8 + hh], mx = fmaxf(l0, fmaxf(l1, l2));
    float w0 = __expf(l0 - mx), w1 = __expf(l1 - mx), w2 = __expf(l2 - mx); const float wi = 1.0f / (w0 + w1 + w2); w0 *= wi; w1 *= wi; w2 *= wi;
    const bf16* og = (const bf16*)(ws + WS_OG) + (size_t)row * 1536 + col;
    const v4u a = *(const v4u*)og, b = *(const v4u*)(og + 512), c = *(const v4u*)(og + 1024);
    v4u o;
    o.x = cvt_pk_bf16(w0 * bflo(a.x) + w1 * bflo(b.x) + w2 * bflo(c.x), w0 * bfhi(a.x) + w1 * bfhi(b.x) + w2 * bfhi(c.x));
    o.y = cvt_pk_bf16(w0 * bflo(a.y) + w1 * bflo(b.y) + w2 * bflo(c.y), w0 * bfhi(a.y) + w1 * bfhi(b.y) + w2 * bfhi(c.y));
    o.z = cvt_pk_bf16(w0 * bflo(a.z) + w1 * bflo(b.z) + w2 * bflo(c.z), w0 * bfhi(a.z) + w1 * bfhi(b.z) + w2 * bfhi(c.z));
    o.w = cvt_pk_bf16(w0 * bflo(a.w) + w1 * bflo(b.w) + w2 * bflo(c.w), w0 * bfhi(a.w) + w1 * bfhi(b.w) + w2 * bfhi(c.w));
    bf16* oall = (bf16*)(ws + WS_OALL) + (size_t)row * 1536;
    *(v4u*)(oall + col) = o;
    const float* go = (const float*)(ws + WS_GO) + (size_t)row * 512 + col;
    const f32x4 x0 = *(const f32x4*)go, x1 = *(const f32x4*)(go + 4);
    float ss = (x0.x * x0.x + x0.y * x0.y) + (x0.z * x0.z + x0.w * x0.w) + (x1.x * x1.x + x1.y * x1.y) + (x1.z * x1.z + x1.w * x1.w);
    ss += __shfl_xor(ss, 1); ss += __shfl_xor(ss, 2); ss += __shfl_xor(ss, 4); ss += __shfl_xor(ss, 8);
    const float rstd = 1.0f / sqrtf(ss * (1.f / 128.f) + EPS);
    const float* gg = F.i15 + 8 * sub; const f32x4 g0 = *(const f32x4*)gg, g1 = *(const f32x4*)(gg + 4);
    const v4u gr = *(const v4u*)((const bf16*)(ws + WS_GRS) + (size_t)row * 512 + col);
    v4u y;
    y.x = cvt_pk_bf16(x0.x * rstd * g0.x * bflo(gr.x), x0.y * rstd * g0.y * bfhi(gr.x)); y.y = cvt_pk_bf16(x0.z * rstd * g0.z * bflo(gr.y), x0.w * rstd * g0.w * bfhi(gr.y));
    y.z = cvt_pk_bf16(x1.x * rstd * g1.x * bflo(gr.z), x1.y * rstd * g1.y * bfhi(gr.z)); y.w = cvt_pk_bf16(x1.z * rstd * g1.z * bflo(gr.w), x1.w * rstd * g1.w * bfhi(gr.w));
    *(v4u*)(oall + 512 + col) = y;
}
__device__ __forceinline__ void p10_final_row(const Frame& F, int row) {
    GAS f32x4* yr = (GAS f32x4*)(F.out + (size_t)row * D) + F.lane; const GAS f32x4* gr = (const GAS f32x4*)F.i24 + F.lane;
    f32x4 v[4]; float s = 0.f;
#pragma unroll
    for (int j = 0; j < 4; ++j) { v[j] = yr[64 * j]; s += (v[j].x * v[j].x + v[j].y * v[j].y) + (v[j].z * v[j].z + v[j].w * v[j].w); }
    const float rstd = 1.0f / sqrtf(wave_sum(s) * (1.f / D) + EPS);
#pragma unroll
    for (int j = 0; j < 4; ++j) yr[64 * j] = v[j] * rstd * gr[64 * j];
}


__device__ __forceinline__ void phase1(Frame& F) {
    unsigned char* ws = F.ws; const int G = F.G, bx = (int)blockIdx.x;
    { pg8::Gemm g{(const bf16*)(ws + WS_XB), (const bf16*)(ws + WS_W1A), MR, 2 * FF, D, D}; pg8::StaticOrder S; S.init(MR, 2 * FF, G, bx);
      EpiSwiglu E{(bf16*)(ws + WS_G), nullptr}; pg8::gemm_phase<EpiSwiglu, pg8::StaticOrder>(F.lds + RING_OFF, g, S, E); }
    { pg8::Gemm g{(const bf16*)(ws + WS_MEMB), (const bf16*)(ws + WS_WMEM), MM, D, D, D}; pg8::StaticOrder S; S.init(MM, D, G, (bx + G / 2) % G);
      EpiMemKV E{F.out + O_MEMKV, (bf16*)(ws + WS_MKV)}; pg8::gemm_phase<EpiMemKV, pg8::StaticOrder>(F.lds + RING_OFF, g, S, E); }
}
__device__ __forceinline__ void phase2(Frame& F) {
    unsigned char* ws = F.ws; const int G = F.G, bx = (int)blockIdx.x;
    pg8::Gemm g{(const bf16*)(ws + WS_G), (const bf16*)(ws + WS_W1O), MR, D, FF, FF}; pg8::StaticOrder S; S.init(MR, D, G, bx);
    EpiResid<true, true> E{F.i0, F.i1, (float*)(ws + WS_H), (float*)(ws + WS_H) + (size_t)MP * D, (bf16*)(ws + WS_HB), (float*)(ws + WS_PQ1), 0.5f};
    pg8::gemm_phase<EpiResid<true, true>, pg8::StaticOrder>(F.lds + RING_OFF, g, S, E);
}
__device__ __forceinline__ void phase3(Frame& F) {
    unsigned char* ws = F.ws; const int G = F.G, bx = (int)blockIdx.x;
    pg8::Gemm g{(const bf16*)(ws + WS_HB), (const bf16*)(ws + WS_WIN), MR, NZ, D, D}; pg8::StaticOrder S; S.init(MR, NZ, G, bx);
    EpiZ E{(const float*)(ws + WS_PQ1), (const float*)(ws + WS_ROPE), (const float*)(ws + WS_ROPE) + NPOS * 64, F.i14, F.out,
           (bf16*)(ws + WS_QS), (bf16*)(ws + WS_KS), (bf16*)(ws + WS_VS), (bf16*)(ws + WS_GQ), (bf16*)(ws + WS_GK), (bf16*)(ws + WS_GV), (bf16*)(ws + WS_GRS), (bf16*)(ws + WS_MQ), (bf16*)(ws + WS_GATE), (float*)(ws + WS_GA)};
    pg8::gemm_phase<EpiZ, pg8::StaticOrder>(F.lds + RING_OFF, g, S, E);
}
constexpr int CW_Q = 64;
__device__ __forceinline__ int q_pull(const Frame& F, int q) {
    gu32* qw = (gu32*)(F.ws + WS_CTL) + CW_Q + 64 * q;
    volatile LAS unsigned* slot = (volatile LAS unsigned*)(F.lds + MISC_OFF) + 16;
    __syncthreads();
    if (F.tid == 0) *slot = __hip_atomic_fetch_add(qw, 1u, RLX_AGENT);
    __syncthreads();
    return (int)*slot;
}
__device__ __forceinline__ void phase4(Frame& F, const float* c0, const float* c1, const float* c2, const float* cm) {
    const int bx = (int)blockIdx.x;
    if (bx < NB * 4) p4_gla_chain_mfma(F, bx);
    else { for (;;) { const int it = q_pull(F, 0); if (it >= DECB * 2) break; p4_sample_attn(F, it * 8 + F.wave, c0, c1, c2, cm); } }
    for (;;) { const int it = q_pull(F, 1); if (it >= 1536) break; attn_batch<0>(F, 4 * it); }
    for (;;) { const int it = q_pull(F, 2); if (it >= 512) break; attn_batch<1>(F, 6144 + 4 * it); }
    for (;;) { const int it = q_pull(F, 0); if (it >= DECB * 2) break; p4_sample_attn(F, it * 8 + F.wave, c0, c1, c2, cm); }
    for (;;) { const int c = q_pull(F, 3); if (c >= DECB * 4) break; p4_gla_chain(F, MP + (c >> 2) * DECT, DECT, c & 3, F.i7 + (size_t)c * 64 * 128, F.out + O_GLAS + (size_t)c * 64 * 128); }
    if (F.G < NB * 4) { for (int c = F.G + bx; c < NB * 4; c += F.G) p4_gla_chain_mfma(F, c); }
}
__device__ __forceinline__ void phase5(Frame& F) {
    for (int m = F.vcu * NWAVES + F.wave; m < MR; m += F.G * NWAVES) p5_combine_row(F, m);
}
__device__ __forceinline__ void phase6(Frame& F) {
    unsigned char* ws = F.ws; const int G = F.G, bx = (int)blockIdx.x;
    pg8::StaticOrder S; S.init(MR, D, G, bx);
    { pg8::Gemm g{(const bf16*)(ws + WS_OALL), (const bf16*)(ws + WS_WBR), MR, D, 512, 1536}; EpiMerge<0> E{(const bf16*)(ws + WS_GATE), (float*)(ws + WS_T), (bf16*)(ws + WS_MB)}; pg8::gemm_phase<EpiMerge<0>, pg8::StaticOrder>(F.lds + RING_OFF, g, S, E); }
    { pg8::Gemm g{(const bf16*)(ws + WS_OALL) + 512, (const bf16*)(ws + WS_WBR) + (size_t)D * 512, MR, D, 512, 1536}; EpiMerge<1> E{(const bf16*)(ws + WS_GATE), (float*)(ws + WS_T), (bf16*)(ws + WS_MB)}; pg8::gemm_phase<EpiMerge<1>, pg8::StaticOrder>(F.lds + RING_OFF, g, S, E); }
    { pg8::Gemm g{(const bf16*)(ws + WS_OALL) + 1024, (const bf16*)(ws + WS_WBR) + (size_t)2 * D * 512, MR, D, 512, 1536}; EpiMerge<2> E{(const bf16*)(ws + WS_GATE), (float*)(ws + WS_T), (bf16*)(ws + WS_MB)}; pg8::gemm_phase<EpiMerge<2>, pg8::StaticOrder>(F.lds + RING_OFF, g, S, E); }
}
__device__ __forceinline__ void phase7(Frame& F) {
    unsigned char* ws = F.ws; const int G = F.G, bx = (int)blockIdx.x;
    pg8::Gemm g{(const bf16*)(ws + WS_MB), (const bf16*)(ws + WS_WOUT), MR, D, D, D}; pg8::StaticOrder S; S.init(MR, D, G, bx);
    float* H = (float*)(ws + WS_H);
    EpiResid<true, true> E{H, H + (size_t)MP * D, H, H + (size_t)MP * D, (bf16*)(ws + WS_HB), (float*)(ws + WS_PQ2), 1.0f};
    pg8::gemm_phase<EpiResid<true, true>, pg8::StaticOrder>(F.lds + RING_OFF, g, S, E);
}
__device__ __forceinline__ void phase8(Frame& F) {
    unsigned char* ws = F.ws; const int G = F.G, bx = (int)blockIdx.x;
    pg8::Gemm g{(const bf16*)(ws + WS_HB), (const bf16*)(ws + WS_W2A), MR, 2 * FF, D, D}; pg8::StaticOrder S; S.init(MR, 2 * FF, G, bx);
    EpiSwiglu E{(bf16*)(ws + WS_G), (const float*)(ws + WS_PQ2)}; pg8::gemm_phase<EpiSwiglu, pg8::StaticOrder>(F.lds + RING_OFF, g, S, E);
}
__device__ __forceinline__ void phase9(Frame& F) {
    unsigned char* ws = F.ws; const int G = F.G, bx = (int)blockIdx.x;
    pg8::Gemm g{(const bf16*)(ws + WS_G), (const bf16*)(ws + WS_W2O), MR, D, FF, FF}; pg8::StaticOrder S; S.init(MR, D, G, bx);
    float* H = (float*)(ws + WS_H);
    EpiResid<false, false> E{H, H + (size_t)MP * D, F.out + O_Y, F.out + O_YS, nullptr, nullptr, 0.5f};
    pg8::gemm_phase<EpiResid<false, false>, pg8::StaticOrder>(F.lds + RING_OFF, g, S, E);
}
__device__ __forceinline__ void phase10(Frame& F) {
    for (int m = F.vcu * NWAVES + F.wave; m < MR; m += F.G * NWAVES) p10_final_row(F, m);
}
__device__ __forceinline__ void xcd_barrier_or_skip(const XcdBarrier& b, bool on) { if (on) xcd_barrier(b); }
constexpr int N_PHASES = 11;
__global__ void __launch_bounds__(NWAVES * 64, 2) mk_fwd(Args args) {
    extern __shared__ __attribute__((aligned(16))) unsigned char lds[];
    Frame F;
    F.lds = (LAS unsigned char*)lds;
    F.tid = threadIdx.x; F.lane = F.tid & 63; F.wave = __builtin_amdgcn_readfirstlane(F.tid >> 6);
    F.G = gridDim.x; { const int bx = blockIdx.x; F.vcu = (F.G % 8 == 0) ? (bx % 8) * (F.G / 8) + bx / 8 : bx; }
    F.i0 = args.in[0]; F.i1 = args.in[1]; F.i2 = args.in[2]; F.i3 = args.in[3]; F.i4 = args.in[4]; F.i5 = args.in[5]; F.i6 = args.in[6]; F.i7 = args.in[7]; F.i8 = args.in[8]; F.i9 = args.in[9]; F.i10 = args.in[10]; F.i11 = args.in[11]; F.i12 = args.in[12]; F.i13 = args.in[13]; F.i14 = args.in[14]; F.i15 = args.in[15]; F.i16 = args.in[16]; F.i17 = args.in[17]; F.i18 = args.in[18]; F.i19 = args.in[19]; F.i20 = args.in[20]; F.i21 = args.in[21]; F.i22 = args.in[22]; F.i23 = args.in[23]; F.i24 = args.in[24];
    F.out = args.out; F.ws = args.ws;
    unsigned char* ws = args.ws; gu32* ctl = (gu32*)(ws + WS_CTL);
    volatile LAS unsigned* MISC = (volatile LAS unsigned*)(F.lds + MISC_OFF);
    for (int u = F.tid; u < (LDS_BYTES - LDSCTL_OFF) / 4; u += NWAVES * 64) ((LAS unsigned*)(F.lds + LDSCTL_OFF))[u] = 0u;
    __syncthreads();
    XcdBarrier bar; bar.bar = (unsigned*)(ctl + CW_BAR); bar.x = 0; bar.st = nullptr;
    if (MK_N_LAUNCHES == 1) bar = xcd_barrier_post((unsigned*)(ctl + CW_BAR), MISC + 8);
    const int lo = args.ph_lo, hi = args.ph_hi;
#define IN(k) (lo <= (k) && (k) < hi && (k) <= MK_STOP_AFTER)
#define GRID_BAR(k) do { if (IN((k) + 1)) xcd_barrier(bar); } while (0)

#define RUN(k, call) do { if (IN(k)) { call; if (MK_REPEAT_PHASE == (k)) { xcd_barrier_or_skip(bar, MK_N_LAUNCHES == 1); call; } GRID_BAR(k); } } while (0)
    RUN(0, p0_prologue(F));
    RUN(1, phase1(F));
    RUN(2, phase2(F));
    RUN(3, phase3(F));
    RUN(4, phase4(F, args.in[3], args.in[4], args.in[5], args.in[6]));
    RUN(5, phase5(F));
    RUN(6, phase6(F));
    RUN(7, phase7(F));
    RUN(8, phase8(F));
    RUN(9, phase9(F));
    if (IN(10)) phase10(F);
#undef RUN
#if MK_STOP_AFTER < 10
    if (hi == N_PHASES) {
        for (int m = F.vcu * NWAVES + F.wave; m < MR; m += G * NWAVES) {
            for (int c = F.lane; c < D; c += 64) {
                float v;
                if (MK_STOP_AFTER == 0) v = bf2f(((const bf16*)(ws + WS_WIN))[(size_t)(m % NZ) * D + c]);
                else if (MK_STOP_AFTER == 3) { const bf16* gt = (const bf16*)(ws + WS_GATE) + (size_t)m * 3072; v = bf2f(gt[c]) + bf2f(gt[1024 + c]) + bf2f(gt[2048 + c]); }
                else if (MK_STOP_AFTER <= 5) { const bf16* oa = (const bf16*)(ws + WS_OALL) + (size_t)m * 1536; v = bf2f(oa[c]) + bf2f(oa[1024 + (c & 511)]); }
                else if (MK_STOP_AFTER == 6) v = bf2f(((const bf16*)(ws + WS_MB))[(size_t)m * D + c]);
                else if (MK_STOP_AFTER == 7) v = ((const float*)(ws + WS_H))[(size_t)m * D + c];
                else v = bf2f(((const bf16*)(ws + WS_G))[(size_t)m * FF + c]) + bf2f(((const bf16*)(ws + WS_G))[(size_t)m * FF + 1792 + c]);
                F.out[(size_t)m * D + c] = v;
            }
        }
    }
#endif
#undef IN
#undef GRID_BAR
}

extern "C" void kernel_launch(void* const* d_in, const int* in_sizes, int n_in, void* d_out, int out_size, void* d_ws, size_t ws_size, hipStream_t stream) {
    static int grid = 0;
    if (grid == 0) {
        if (n_in != 25 || (size_t)out_size != O_END || ws_size < WS_END) { fprintf(stderr, "kernel_launch: unexpected shapes: n_in %d out %d ws %zu (need %zu); nothing launched\n", n_in, out_size, ws_size, (size_t)WS_END); grid = -1; return; }
        int dev = 0, cus = 0, per_cu = 0;
        if (hipGetDevice(&dev) != hipSuccess || hipDeviceGetAttribute(&cus, hipDeviceAttributeMultiprocessorCount, dev) != hipSuccess) { grid = -1; return; }
        if (hipFuncSetAttribute((const void*)mk_fwd, hipFuncAttributeMaxDynamicSharedMemorySize, LDS_BYTES) != hipSuccess) { fprintf(stderr, "kernel_launch: hipFuncSetAttribute failed\n"); grid = -1; return; }
        if (hipOccupancyMaxActiveBlocksPerMultiprocessor(&per_cu, (const void*)mk_fwd, NWAVES * 64, LDS_BYTES) != hipSuccess || per_cu < 1) fprintf(stderr, "kernel_launch: occupancy query reports %d\n", per_cu);
        (void)hipGetLastError();
        grid = cus;
    }
    if (grid < 0) return;
    if (hipMemsetAsync((char*)d_ws + WS_CTL, 0, CTL_ZERO_BYTES, stream) != hipSuccess) return;
    Args a{};
    for (int i = 0; i < 25; ++i) a.in[i] = (const float*)d_in[i];
    a.out = (float*)d_out; a.ws = (unsigned char*)d_ws; a.pad = 0;
    for (int li = 0; li < MK_N_LAUNCHES; ++li) {
        a.ph_lo = (MK_N_LAUNCHES == 1) ? 0 : li; a.ph_hi = (MK_N_LAUNCHES == 1) ? N_PHASES : li + 1; a.li = li;
        hipLaunchKernelGGL(mk_fwd, dim3(grid), dim3(NWAVES * 64), LDS_BYTES, stream, a);
        const hipError_t le = hipPeekAtLastError();
        if (le != hipSuccess) { fprintf(stderr, "kernel_launch: launch %d failed: %s\n", li, hipGetErrorName(le)); break; }
    }
}
```

```cpp
#include <hip/hip_runtime.h>
#include <cstdio>
#include <cstdint>

#ifndef MK_N_LAUNCHES
#define MK_N_LAUNCHES 1
#endif

#ifndef MK_REPEAT_PHASE
#define MK_REPEAT_PHASE -1
#endif
#ifndef MK_P4_REPEAT
#define MK_P4_REPEAT 0
#endif
#ifndef MK_STAGGER_A
#define MK_P0_ITW 4
#define MK_STAGGER_A 0
#endif
#ifndef MK_STAGGER_Z
#define MK_STAGGER_Z 0
#endif
#ifndef MK_STOP_AFTER
#define MK_STOP_AFTER 10
#endif
#define GAS __attribute__((address_space(1)))
#define LAS __attribute__((address_space(3)))
typedef unsigned short bf16;
typedef unsigned v4u __attribute__((ext_vector_type(4)));
typedef unsigned v2u __attribute__((ext_vector_type(2)));
typedef float f32x4 __attribute__((ext_vector_type(4)));
typedef float f32x2 __attribute__((ext_vector_type(2)));
typedef short bf16x8 __attribute__((ext_vector_type(8)));
typedef short s16x4 __attribute__((ext_vector_type(4)));
typedef GAS unsigned gu32;

__device__ __forceinline__ int lane_id() { return (int)__builtin_amdgcn_mbcnt_hi(~0u, __builtin_amdgcn_mbcnt_lo(~0u, 0u)); }
constexpr int D = 1024, NB = 32, SEQ = 2048, DECB = 128, DECT = 4, PAST = 8192, MEML = 256;
constexpr int MP = NB * SEQ;
constexpr int MS = DECB * DECT;
constexpr int MR = MP + MS;
constexpr int MM = NB * MEML;
constexpr int FF = 2816, NZ = 9984;
constexpr int DIN = 6672;
constexpr int NPOS = SEQ + DECT;
constexpr float EPS = 1e-6f;
constexpr float QSCALE = 0.08838834764831845f * 1.4426950408889634f;
constexpr float LN2 = 0.6931471805599453f;

constexpr size_t O_Y = 0, O_YS = (size_t)MP * D, O_SWA0P = O_YS + (size_t)MS * D, O_SWA1P = O_SWA0P + (size_t)NB * 128 * 1024, O_SWA2P = O_SWA1P + (size_t)NB * 512 * 1024,
                 O_MEMKV = O_SWA2P + (size_t)NB * 2048 * 1024, O_GLAP = O_MEMKV + (size_t)MM * 1024, O_SWA0S = O_GLAP + (size_t)NB * 4 * 64 * 128, O_SWA1S = O_SWA0S + (size_t)MS * 1024,
                 O_SWA2S = O_SWA1S + (size_t)MS * 1024, O_GLAS = O_SWA2S + (size_t)MS * 1024, O_END = O_GLAS + (size_t)DECB * 4 * 64 * 128;
static_assert(O_END == 170917888ull, "output size");

constexpr size_t MiB = 1u << 20;
constexpr size_t al(size_t x) { return (x + 2 * MiB - 1) / (2 * MiB) * (2 * MiB); }
constexpr size_t WS_CTL = 0, CTL_ZERO_BYTES = 1 * MiB;
constexpr size_t WS_ROPE = 2 * MiB;
constexpr size_t WS_PQ1 = WS_ROPE + al((size_t)NPOS * 64 * 4 * 2);
constexpr size_t WS_PQ2 = WS_PQ1 + al((size_t)MR * 16 * 4);
constexpr size_t WS_W1A = WS_PQ2 + al((size_t)MR * 16 * 4);
constexpr size_t WS_W1O = WS_W1A + al((size_t)2 * FF * D * 2);
constexpr size_t WS_WIN = WS_W1O + al((size_t)D * FF * 2);
constexpr size_t WS_WBR = WS_WIN + al((size_t)NZ * D * 2);
constexpr size_t WS_WOUT = WS_WBR + al((size_t)3 * D * 512 * 2);
constexpr size_t WS_W2A = WS_WOUT + al((size_t)D * D * 2);
constexpr size_t WS_W2O = WS_W2A + al((size_t)2 * FF * D * 2);
constexpr size_t WS_WMEM = WS_W2O + al((size_t)D * FF * 2);
constexpr size_t WS_XB = WS_WMEM + al((size_t)D * D * 2);
constexpr size_t WS_MEMB = WS_XB + al((size_t)MR * D * 2);
constexpr size_t WS_MKV = WS_MEMB + al((size_t)MM * D * 2);
constexpr size_t WS_G = WS_MKV + al((size_t)MM * D * 2);
constexpr size_t WS_H = WS_G + al((size_t)MR * FF * 2);
constexpr size_t WS_HB = WS_H + al((size_t)MR * D * 4);
constexpr size_t WS_QS = WS_HB + al((size_t)MR * D * 2);
constexpr size_t WS_KS = WS_QS + al((size_t)MR * 1536 * 2);
constexpr size_t WS_VS = WS_KS + al((size_t)MR * 1536 * 2);
constexpr size_t WS_GQ = WS_VS + al((size_t)MR * 1536 * 2);
constexpr size_t WS_GK = WS_GQ + al((size_t)MR * 256 * 2);
constexpr size_t WS_GV = WS_GK + al((size_t)MR * 256 * 2);
constexpr size_t WS_GRS = WS_GV + al((size_t)MR * 512 * 2);
constexpr size_t WS_GA = WS_GRS + al((size_t)MR * 512 * 2);
constexpr size_t WS_MQ = WS_GA + al((size_t)MR * 256 * 4);
constexpr size_t WS_GATE = WS_MQ + al((size_t)MR * 512 * 2);
constexpr size_t WS_OG = WS_GATE + al((size_t)MR * 3072 * 2);
constexpr size_t WS_LSE = WS_OG + al((size_t)MR * 1536 * 2);
constexpr size_t WS_GO = WS_LSE + al((size_t)MR * 12 * 4);
constexpr size_t WS_OALL = WS_GO + al((size_t)MR * 512 * 4);
constexpr size_t WS_END = WS_OALL + al((size_t)MR * 1536 * 2);
constexpr size_t WS_SLAB = WS_END; constexpr size_t WS_END2 = WS_SLAB + al((size_t)8 * 4 * 4 * 8 * 2048 * 4);
constexpr size_t WS_T = WS_G, WS_MB = WS_XB, WS_Y16 = WS_XB;
static_assert((size_t)MR * D * 4 <= (size_t)MR * FF * 2, "T fits in G");

constexpr int CW_TMO = 0, CW_CODE = 1, CW_BAR = 4096, CW_TAIL = 8192;

constexpr int RING_OFF = 0, RING_BYTES = 131072;
constexpr int LDSCTL_OFF = RING_BYTES, MISC_OFF = LDSCTL_OFF + 320;
constexpr int LDS_BYTES = 147456;
constexpr int NWAVES = 8;

#define RLX_AGENT __ATOMIC_RELAXED, __HIP_MEMORY_SCOPE_AGENT
#define LDS_WAIT() asm volatile("s_waitcnt lgkmcnt(0)" ::: "memory")
#define VM_WAIT() asm volatile("s_waitcnt vmcnt(0)" ::: "memory")
__device__ __forceinline__ unsigned f2bf(float f) { unsigned u = __builtin_bit_cast(unsigned, f); return (u + 0x7fffu + ((u >> 16) & 1u)) >> 16; }
__device__ __forceinline__ unsigned pk2(float lo, float hi) { return f2bf(lo) | (f2bf(hi) << 16); }
__device__ __forceinline__ float bf2f(unsigned b) { return __builtin_bit_cast(float, b << 16); }
__device__ __forceinline__ float bflo(unsigned w) { return __builtin_bit_cast(float, w << 16); }
__device__ __forceinline__ float bfhi(unsigned w) { return __builtin_bit_cast(float, w & 0xffff0000u); }
typedef __bf16 bf16x2_t __attribute__((ext_vector_type(2)));
__device__ __forceinline__ unsigned cvt_pk_bf16(float lo, float hi) { const f32x2 v = {lo, hi}; const bf16x2_t b = __builtin_convertvector(v, bf16x2_t); return __builtin_bit_cast(unsigned, b); }
__device__ __forceinline__ float fast_exp2(float x) { return __builtin_amdgcn_exp2f(x); }
__device__ __forceinline__ float fast_rcp(float x) { return __builtin_amdgcn_rcpf(x); }
__device__ __forceinline__ float fast_log2(float x) { return __builtin_amdgcn_logf(x); }
__device__ __forceinline__ float sigmoidf_(float x) { return fast_rcp(1.0f + fast_exp2(-1.4426950408889634f * x)); }
__device__ __forceinline__ float siluf_(float x) { return x * sigmoidf_(x); }
__device__ __forceinline__ int perm32(int rho) { return 8 * ((rho >> 2) & 3) + 4 * (rho >> 4) + (rho & 3); }
__device__ __forceinline__ int sig_plain(int r) { return (r & ~31) + perm32(r & 31); }
__device__ __forceinline__ int sig_rope(int r7) { return 64 * ((r7 >> 4) & 1) + 16 * (r7 >> 5) + 4 * ((r7 >> 2) & 3) + (r7 & 3); }

namespace pg8 {
constexpr int BM = 256, BK = 64, HALF = 128, HTB = HALF * BK * 2, STAGE_BYTES = 8 * HTB, NXCD = 8, WGM = 4;
__host__ __device__ __forceinline__ int lds_byte(int r, int c) { const int st = (r >> 4) * 2 + (c >> 5), rr = r & 15, cc = c & 31, ob = rr * 64 + cc * 2; return st * 1024 + (ob ^ (((ob >> 9) & 1) << 5)); }
__host__ __device__ __forceinline__ void stage_rc(int b, int& R, int& C) { const int st = b / 1024, sb = b % 1024, swz = sb ^ (((sb >> 9) & 1) << 5); R = (st >> 1) * 16 + swz / 64; C = (st & 1) * 32 + (swz % 64) / 2; }
struct Unit { int pm, pn; };
struct Gemm { const bf16* A; const bf16* Bt; int M, N, K, lda, ldb; };
constexpr size_t TILED_KS = (size_t)256 * 64 * 2, TILED_PANEL = (size_t)(2816 / 64) * TILED_KS;
template <int NM, int NN> struct StaticOrderT {
    int G, c, lim, rev;
    __host__ __device__ void init(int, int, int G_, int c_) { G = G_; c = c_; lim = NM * NN; rev = 0; }
    __host__ __device__ static __forceinline__ void unit_of(int L, Unit& u) {
        constexpr int nwg = NM * NN, q = nwg / NXCD, r = nwg % NXCD, nig = WGM * NN;
        const int xcd = L & (NXCD - 1), off = L >> 3;
        const int wgid = (xcd < r ? xcd * (q + 1) : r * (q + 1) + (xcd - r) * q) + off;
        const int gid = wgid / nig, x = wgid - gid * nig, fm = gid * WGM;
        if (NM % WGM == 0 || fm + WGM <= NM) { u.pm = fm + (x & (WGM - 1)); u.pn = x / WGM; }
        else { constexpr int gl = (NM % WGM) ? (NM % WGM) : WGM; u.pm = fm + x % gl; u.pn = x / gl; }
    }
    __host__ __device__ __forceinline__ bool next(int i, Unit& u) const { const int L = i * G + c; if (L >= lim) return false; unit_of(rev ? lim - 1 - L : L, u); return true; }
};
struct OneUnit { Unit u; int c; __host__ __device__ __forceinline__ bool next(int i, Unit& o) const { if (i) return false; o = u; return true; } };
template <class Epi, class Sched, bool ALIGN_EPI = true, bool ATILED = false>
__device__ __forceinline__ void gemm_phase(LAS unsigned char* lds, const Gemm g, const Sched& S, const Epi& E, const int wid, const int stagger_ticks = 0) {
    if (stagger_ticks > 0) { const unsigned long long t0 = __builtin_amdgcn_s_memrealtime(); const unsigned long long dl = (unsigned long long)(((S.c * 37) & 255) * stagger_ticks) >> 8;
        while (__builtin_amdgcn_s_memrealtime() - t0 < dl) __builtin_amdgcn_s_sleep(8); }
    const int lane = lane_id(), tid = wid * 64 + lane, wr = wid >> 2, wc = wid & 3, fr = lane & 15, fq = lane >> 4;
    const int K = g.K, nt = K / BK;
    unsigned voffA[2], voffB[2];
#pragma unroll
    for (int i = 0; i < 2; ++i) { int R, C; stage_rc(tid * 16 + i * 8192, R, C); voffA[i] = (unsigned)(R * g.lda + C) * 2u; voffB[i] = (unsigned)(R * g.ldb + C) * 2u; }
    const size_t kstep = (size_t)(BK * 2), kstepA = ATILED ? TILED_KS : kstep;
    const size_t hA = (size_t)HALF * g.lda * 2, tA = ATILED ? TILED_PANEL : 2 * hA, hB = (size_t)HALF * g.ldb * 2, tB = 2 * hB;
    const unsigned ldsw = (unsigned)wid * 1024u;
    const int aoff = lds_byte(wr * 64 + fr, fq * 8), boff = lds_byte(wc * 32 + fr, fq * 8);
#define PG8_SA(b, h) (((b) * 2 + (h)) * HTB)
#define PG8_SB(b, h) ((4 + (b) * 2 + (h)) * HTB)
#define PG8_STAGE(bufoff, gbase, voff) do { _Pragma("unroll") for (int _i = 0; _i < 2; ++_i) \
        __builtin_amdgcn_global_load_lds((const unsigned*)((const char*)(gbase) + (voff)[_i]), (LAS unsigned*)(lds + (bufoff) + ldsw + _i * 8192), 16, 0, 0); } while (0)
#define PG8_LDA(dst, b, h) do { _Pragma("unroll") for (int m = 0; m < 4; ++m) _Pragma("unroll") for (int k = 0; k < 2; ++k) dst[m][k] = *(const LAS bf16x8*)(lds + PG8_SA(b, h) + aoff + m * 2048 + k * 1024); } while (0)
#define PG8_LDB(dst, b, h) do { _Pragma("unroll") for (int n = 0; n < 2; ++n) _Pragma("unroll") for (int k = 0; k < 2; ++k) dst[n][k] = *(const LAS bf16x8*)(lds + PG8_SB(b, h) + boff + n * 2048 + k * 1024); } while (0)
#define PG8_MMA(ai, bj, At, Bt) do { __builtin_amdgcn_s_setprio(1); _Pragma("unroll") for (int m = 0; m < 4; ++m) _Pragma("unroll") for (int n = 0; n < 2; ++n) _Pragma("unroll") for (int k = 0; k < 2; ++k) \
        acc[ai][bj][m][n] = __builtin_amdgcn_mfma_f32_16x16x32_bf16(Bt[n][k], At[m][k], acc[ai][bj][m][n], 0, 0, 0); __builtin_amdgcn_s_setprio(0); } while (0)
#define PG8_WAIT_V(n) asm volatile("s_waitcnt vmcnt(" #n ")" ::: "memory")
#define PG8_WAIT_L(n) asm volatile("s_waitcnt lgkmcnt(" #n ")" ::: "memory")
#define PG8_BAR __builtin_amdgcn_s_barrier()
#define PG8_SCHED __builtin_amdgcn_sched_barrier(0)
    Unit cur, nxt; int ui = 0;
    if (!S.next(0, cur)) return;
    f32x4 acc[2][2][4][2];
#pragma unroll
    for (int a = 0; a < 2; ++a)
#pragma unroll
        for (int b = 0; b < 2; ++b)
#pragma unroll
            for (int m = 0; m < 4; ++m)
#pragma unroll
                for (int n = 0; n < 2; ++n) acc[a][b][m][n] = (f32x4){0.f, 0.f, 0.f, 0.f};
    bf16x8 At[4][2], B0[2][2], B1[2][2];
    const char* cA = (const char*)g.A + (size_t)cur.pm * tA; const char* cB = (const char*)g.Bt + (size_t)cur.pn * tB;
    PG8_STAGE(PG8_SB(0, 0), cB, voffB); PG8_STAGE(PG8_SB(0, 1), cB + hB, voffB); PG8_STAGE(PG8_SA(0, 0), cA, voffA); PG8_STAGE(PG8_SA(0, 1), cA + hA, voffA);
    if (wr == 1) PG8_BAR;
    PG8_WAIT_V(2); PG8_BAR;
    PG8_STAGE(PG8_SB(1, 0), cB + kstep, voffB); PG8_STAGE(PG8_SA(1, 0), cA + kstepA, voffA); PG8_STAGE(PG8_SB(1, 1), cB + hB + kstep, voffB);
    PG8_WAIT_V(6); PG8_BAR;
    for (;;) {
        const bool has_next = S.next(ui + 1, nxt);
        const char* nA = has_next ? (const char*)g.A + (size_t)nxt.pm * tA : cA; const char* nB = has_next ? (const char*)g.Bt + (size_t)nxt.pn * tB : cB;
        const int seg = Epi::HAS_MID ? 8 : nt;
        for (int t0 = 0; t0 < nt; t0 += seg) {
        if constexpr (Epi::HAS_MID) { if (t0) { PG8_SCHED; E.mid(acc, cur, t0, wr, wc, fr, fq); PG8_SCHED; } }
#pragma unroll 1
        for (int t = t0; t < t0 + seg; t += 2) {
            const bool last = (t == nt - 2);
            const char* a1 = cA + (size_t)(t + 1) * kstepA;
            const char* a2 = last ? nA : cA + (size_t)(t + 2) * kstepA; const char* b2 = last ? nB : cB + (size_t)(t + 2) * kstep;
            const char* a3 = a2 + kstepA; const char* b3 = b2 + kstep;
            PG8_LDB(B0, 0, 0); PG8_LDB(B1, 0, 1); PG8_SCHED; PG8_LDA(At, 0, 0); PG8_STAGE(PG8_SA(1, 1), a1 + hA, voffA);
            PG8_WAIT_V(8); PG8_WAIT_L(0); PG8_BAR; PG8_MMA(0, 0, At, B0); PG8_MMA(0, 1, At, B1); PG8_BAR; PG8_SCHED;
            PG8_LDA(At, 0, 1); PG8_STAGE(PG8_SB(0, 0), b2, voffB); PG8_STAGE(PG8_SB(0, 1), b2 + hB, voffB); PG8_STAGE(PG8_SA(0, 0), a2, voffA);
            PG8_WAIT_V(8); PG8_WAIT_L(0); PG8_BAR; PG8_MMA(1, 0, At, B0); PG8_MMA(1, 1, At, B1); PG8_BAR; PG8_SCHED;
            PG8_LDB(B0, 1, 0); PG8_LDB(B1, 1, 1); PG8_SCHED; PG8_LDA(At, 1, 0); PG8_STAGE(PG8_SA(0, 1), a2 + hA, voffA);
            PG8_WAIT_V(8); PG8_WAIT_L(0); PG8_BAR; PG8_MMA(0, 0, At, B0); PG8_MMA(0, 1, At, B1); PG8_BAR; PG8_SCHED;
            PG8_LDA(At, 1, 1); PG8_STAGE(PG8_SB(1, 0), b3, voffB); PG8_STAGE(PG8_SB(1, 1), b3 + hB, voffB); PG8_STAGE(PG8_SA(1, 0), a3, voffA);
            PG8_WAIT_V(8); PG8_WAIT_L(0); PG8_BAR; PG8_MMA(1, 0, At, B0); PG8_MMA(1, 1, At, B1); PG8_BAR; PG8_SCHED;
        }
        }
        if constexpr (ALIGN_EPI) { if (wr == 0) PG8_BAR; }
        E(acc, cur, wr, wc, fr, fq);
        if (!has_next) break;
#pragma unroll
        for (int a = 0; a < 2; ++a)
#pragma unroll
            for (int b = 0; b < 2; ++b)
#pragma unroll
                for (int m = 0; m < 4; ++m)
#pragma unroll
                    for (int n = 0; n < 2; ++n) acc[a][b][m][n] = (f32x4){0.f, 0.f, 0.f, 0.f};
        cur = nxt; cA = nA; cB = nB; ++ui;
        if constexpr (ALIGN_EPI) { if (wr == 1) PG8_BAR; }
    }
    PG8_WAIT_V(0);
    if constexpr (!ALIGN_EPI) { if (wr == 0) PG8_BAR; }
    PG8_BAR;
#undef PG8_SA
#undef PG8_SB
#undef PG8_STAGE
#undef PG8_LDA
#undef PG8_LDB
#undef PG8_MMA
#undef PG8_WAIT_V
#undef PG8_WAIT_L
#undef PG8_BAR
#undef PG8_SCHED
}
}
using pg8::Unit;

typedef const f32x4 (&AccRef)[2][2][4][2];
constexpr size_t G_KT = (size_t)256 * 64, G_PANEL = (FF / 64) * G_KT;
__device__ __forceinline__ size_t g_off(int row, int j) { return (size_t)(row >> 8) * G_PANEL + (size_t)(j >> 6) * G_KT + (size_t)(row & 255) * 64 + (j & 63); }
struct EpiSwiglu {
    static constexpr bool HAS_MID = false;
    bf16* G; const float* pq;
    __device__ __forceinline__ void operator()(AccRef acc, const Unit& u, int wr, int wc, int fr, int fq) const {
        const int row0 = u.pm * 256 + wr * 64 + fr;
        bf16* gb = G + ((size_t)u.pm * (FF / 64) + 2 * u.pn + (wc >> 1)) * G_KT + (size_t)((wr * 64 + fr) * 64 + (wc & 1) * 32 + 8 * fq);
        float sc[2][4];
#pragma unroll
        for (int ai = 0; ai < 2; ++ai)
#pragma unroll
            for (int m = 0; m < 4; ++m) { sc[ai][m] = 1.f;
                if (pq) { const f32x4 pv = *(const f32x4*)(pq + (size_t)(row0 + ai * 128 + m * 16) * 16 + 4 * fq); float t = (pv.x + pv.y) + (pv.z + pv.w); t += __shfl_xor(t, 16); t += __shfl_xor(t, 32); sc[ai][m] = __builtin_amdgcn_rsqf(t * (1.f / D) + EPS); } }
#pragma unroll
        for (int ai = 0; ai < 2; ++ai)
#pragma unroll
            for (int m = 0; m < 4; ++m) {
                const float s = sc[ai][m];
                float o[8];
#pragma unroll
                for (int n = 0; n < 2; ++n)
#pragma unroll
                    for (int i = 0; i < 4; ++i) { const float a = acc[ai][0][m][n][i] * s, b = acc[ai][1][m][n][i] * s; o[4 * n + i] = siluf_(a) * b; }
                v4u w; w.x = cvt_pk_bf16(o[0], o[1]); w.y = cvt_pk_bf16(o[2], o[3]); w.z = cvt_pk_bf16(o[4], o[5]); w.w = cvt_pk_bf16(o[6], o[7]);
                *(v4u*)(gb + (ai * 128 + m * 16) * 64) = w;
            }
    }
};
template <bool WRITE_PQ> struct EpiResidX {
    static constexpr bool HAS_MID = false;
    const float* baseP; const float* baseS; bf16* HB; float* pq; float scale;
    __device__ __forceinline__ void operator()(AccRef acc, const Unit& u, int wr, int wc, int fr, int fq) const {
        const int row0 = u.pm * 256 + wr * 64 + fr, c0 = u.pn * 256 + wc * 32 + 8 * fq; const bool smp = u.pm >= MP / 256;
        const float* bbase = (smp ? baseS : baseP) + (smp ? (size_t)(row0 - MP) * D : (size_t)row0 * D) + c0;
#pragma unroll
        for (int ai = 0; ai < 2; ++ai) {
            f32x4 bb[4][2][2];
#pragma unroll
            for (int m = 0; m < 4; ++m)
#pragma unroll
                for (int bj = 0; bj < 2; ++bj) { const float* bp = bbase + (size_t)(ai * 128 + m * 16) * D + bj * 128; bb[m][bj][0] = *(const f32x4*)bp; bb[m][bj][1] = *(const f32x4*)(bp + 4); }
#pragma unroll
            for (int m = 0; m < 4; ++m) {
                const int row = row0 + ai * 128 + m * 16; float ss = 0.f;
#pragma unroll
                for (int bj = 0; bj < 2; ++bj) {
                    const f32x4 o0 = bb[m][bj][0] + acc[ai][bj][m][0] * scale, o1 = bb[m][bj][1] + acc[ai][bj][m][1] * scale;
                    v4u w; w.x = cvt_pk_bf16(o0.x, o0.y); w.y = cvt_pk_bf16(o0.z, o0.w); w.z = cvt_pk_bf16(o1.x, o1.y); w.w = cvt_pk_bf16(o1.z, o1.w); *(v4u*)(HB + (size_t)row * D + c0 + bj * 128) = w;
                    if (WRITE_PQ) ss += (o0.x * o0.x + o0.y * o0.y) + (o0.z * o0.z + o0.w * o0.w) + (o1.x * o1.x + o1.y * o1.y) + (o1.z * o1.z + o1.w * o1.w);
                }
                if (WRITE_PQ) { ss += __shfl_xor(ss, 16); ss += __shfl_xor(ss, 32); if (fq == 0) pq[(size_t)row * 16 + u.pn * 4 + wc] = ss; }
            }
        }
    }
    template <int O> __device__ __forceinline__ void group(const f32x4 (&v)[8], const Unit& u, int wr, int wc, int fr, int fq) const {
        const int row0 = u.pm * 256 + wr * 64 + fr, c0 = u.pn * 256 + wc * 32 + 8 * fq; const bool smp = u.pm >= MP / 256;
        const float* bbase = (smp ? baseS : baseP) + (smp ? (size_t)(row0 - MP) * D : (size_t)row0 * D) + c0;
        f32x4 bb[2][2][2];
#pragma unroll
        for (int mm = 0; mm < 2; ++mm)
#pragma unroll
            for (int bj = 0; bj < 2; ++bj) { const float* bp = bbase + (size_t)((O >> 1) * 128 + (2 * (O & 1) + mm) * 16) * D + bj * 128; bb[mm][bj][0] = *(const f32x4*)bp; bb[mm][bj][1] = *(const f32x4*)(bp + 4); }
#pragma unroll
        for (int mm = 0; mm < 2; ++mm) { const int row = row0 + (O >> 1) * 128 + (2 * (O & 1) + mm) * 16; float ss = 0.f;
#pragma unroll
            for (int bj = 0; bj < 2; ++bj) {
                const f32x4 o0 = bb[mm][bj][0] + v[bj * 4 + mm * 2] * scale, o1 = bb[mm][bj][1] + v[bj * 4 + mm * 2 + 1] * scale;
                v4u w; w.x = cvt_pk_bf16(o0.x, o0.y); w.y = cvt_pk_bf16(o0.z, o0.w); w.z = cvt_pk_bf16(o1.x, o1.y); w.w = cvt_pk_bf16(o1.z, o1.w); *(v4u*)(HB + (size_t)row * D + c0 + bj * 128) = w;
                if (WRITE_PQ) ss += (o0.x * o0.x + o0.y * o0.y) + (o0.z * o0.z + o0.w * o0.w) + (o1.x * o1.x + o1.y * o1.y) + (o1.z * o1.z + o1.w * o1.w); }
            if (WRITE_PQ) { ss += __shfl_xor(ss, 16); ss += __shfl_xor(ss, 32); if (fq == 0) pq[(size_t)row * 16 + u.pn * 4 + wc] = ss; } }
    }
};
template <bool WRITE_PQ> struct EpiResidB {
    static constexpr bool HAS_MID = false;
    const bf16* base; bf16* out; float* pq; float scale;
    __device__ __forceinline__ void operator()(AccRef acc, const Unit& u, int wr, int wc, int fr, int fq) const {
        const int row0 = u.pm * 256 + wr * 64 + fr, c0 = u.pn * 256 + wc * 32 + 8 * fq;
#pragma unroll
        for (int ai = 0; ai < 2; ++ai) {
            v4u bb[4][2];
#pragma unroll
            for (int m = 0; m < 4; ++m)
#pragma unroll
                for (int bj = 0; bj < 2; ++bj) bb[m][bj] = *(const v4u*)(base + (size_t)(row0 + ai * 128 + m * 16) * D + c0 + bj * 128);
#pragma unroll
            for (int m = 0; m < 4; ++m) {
                const int row = row0 + ai * 128 + m * 16; float ss = 0.f;
#pragma unroll
                for (int bj = 0; bj < 2; ++bj) { const v4u g = bb[m][bj];
                    const f32x4 o0 = (f32x4){bflo(g.x), bfhi(g.x), bflo(g.y), bfhi(g.y)} + acc[ai][bj][m][0] * scale, o1 = (f32x4){bflo(g.z), bfhi(g.z), bflo(g.w), bfhi(g.w)} + acc[ai][bj][m][1] * scale;
                    v4u w; w.x = cvt_pk_bf16(o0.x, o0.y); w.y = cvt_pk_bf16(o0.z, o0.w); w.z = cvt_pk_bf16(o1.x, o1.y); w.w = cvt_pk_bf16(o1.z, o1.w); *(v4u*)(out + (size_t)row * D + c0 + bj * 128) = w;
                    if (WRITE_PQ) ss += (o0.x * o0.x + o0.y * o0.y) + (o0.z * o0.z + o0.w * o0.w) + (o1.x * o1.x + o1.y * o1.y) + (o1.z * o1.z + o1.w * o1.w);
                }
                if (WRITE_PQ) { ss += __shfl_xor(ss, 16); ss += __shfl_xor(ss, 32); if (fq == 0) pq[(size_t)row * 16 + u.pn * 4 + wc] = ss; }
            }
        }
    }
    template <int O> __device__ __forceinline__ void group(const f32x4 (&v)[8], const Unit& u, int wr, int wc, int fr, int fq) const {
        const int row0 = u.pm * 256 + wr * 64 + fr, c0 = u.pn * 256 + wc * 32 + 8 * fq;
        v4u bb[2][2];
#pragma unroll
        for (int mm = 0; mm < 2; ++mm)
#pragma unroll
            for (int bj = 0; bj < 2; ++bj) bb[mm][bj] = *(const v4u*)(base + (size_t)(row0 + (O >> 1) * 128 + (2 * (O & 1) + mm) * 16) * D + c0 + bj * 128);
#pragma unroll
        for (int mm = 0; mm < 2; ++mm) { const int row = row0 + (O >> 1) * 128 + (2 * (O & 1) + mm) * 16; float ss = 0.f;
#pragma unroll
            for (int bj = 0; bj < 2; ++bj) { const v4u g = bb[mm][bj];
                const f32x4 o0 = (f32x4){bflo(g.x), bfhi(g.x), bflo(g.y), bfhi(g.y)} + v[bj * 4 + mm * 2] * scale, o1 = (f32x4){bflo(g.z), bfhi(g.z), bflo(g.w), bfhi(g.w)} + v[bj * 4 + mm * 2 + 1] * scale;
                v4u w; w.x = cvt_pk_bf16(o0.x, o0.y); w.y = cvt_pk_bf16(o0.z, o0.w); w.z = cvt_pk_bf16(o1.x, o1.y); w.w = cvt_pk_bf16(o1.z, o1.w); *(v4u*)(out + (size_t)row * D + c0 + bj * 128) = w;
                if (WRITE_PQ) ss += (o0.x * o0.x + o0.y * o0.y) + (o0.z * o0.z + o0.w * o0.w) + (o1.x * o1.x + o1.y * o1.y) + (o1.z * o1.z + o1.w * o1.w); }
            if (WRITE_PQ) { ss += __shfl_xor(ss, 16); ss += __shfl_xor(ss, 32); if (fq == 0) pq[(size_t)row * 16 + u.pn * 4 + wc] = ss; } }
    }
};
struct EpiMemKV {
    static constexpr bool HAS_MID = false;
    float* out; bf16* MKV;
    __device__ __forceinline__ void operator()(AccRef acc, const Unit& u, int wr, int wc, int fr, int fq) const {
        const int row0 = u.pm * 256 + wr * 64 + fr, c0 = u.pn * 256 + wc * 32 + 8 * fq;
#pragma unroll
        for (int ai = 0; ai < 2; ++ai)
#pragma unroll
            for (int m = 0; m < 4; ++m) {
                const int row = row0 + ai * 128 + m * 16;
#pragma unroll
                for (int bj = 0; bj < 2; ++bj) { const f32x4 o0 = acc[ai][bj][m][0], o1 = acc[ai][bj][m][1]; float* op = out + (size_t)row * D + c0 + bj * 128;
                    *(f32x4*)op = o0; *(f32x4*)(op + 4) = o1;
                    v4u w; w.x = cvt_pk_bf16(o0.x, o0.y); w.y = cvt_pk_bf16(o0.z, o0.w); w.z = cvt_pk_bf16(o1.x, o1.y); w.w = cvt_pk_bf16(o1.z, o1.w); *(v4u*)(MKV + (size_t)row * D + c0 + bj * 128) = w; }
            }
    }
};
struct EpiMerge1 {
    static constexpr bool HAS_MID = true;
    const bf16* GATE; bf16* MB;
    __device__ __forceinline__ void mid(f32x4 (&acc)[2][2][4][2], const Unit& u, int t, int wr, int wc, int fr, int fq) const {
        const unsigned lo = (unsigned)(((wr * 64 + fr) * 3072 + wc * 32 + 8 * fq) * 2);
        const char* ub = (const char*)GATE + ((size_t)u.pm * 256 * 3072 + (size_t)((t >> 3) - 1) * 1024 + (size_t)u.pn * 256) * 2;
#pragma unroll
        for (int ai = 0; ai < 2; ++ai) {
            v4u gn[4][2], gd[4][2];
#pragma unroll
            for (int m = 0; m < 4; ++m)
#pragma unroll
                for (int bj = 0; bj < 2; ++bj) { const char* fb = ub + (size_t)((ai * 128 + m * 16) * 3072 + bj * 128) * 2; gn[m][bj] = *(const v4u*)(fb + lo); gd[m][bj] = *(const v4u*)(fb + 2048 + lo); }
#pragma unroll
            for (int m = 0; m < 4; ++m)
#pragma unroll
                for (int bj = 0; bj < 2; ++bj) { const v4u n_ = gn[m][bj], d_ = gd[m][bj];
                    const f32x4 r0 = {bflo(n_.x) * fast_rcp(fmaxf(bflo(d_.x), 1e-30f)), bfhi(n_.x) * fast_rcp(fmaxf(bfhi(d_.x), 1e-30f)), bflo(n_.y) * fast_rcp(fmaxf(bflo(d_.y), 1e-30f)), bfhi(n_.y) * fast_rcp(fmaxf(bfhi(d_.y), 1e-30f))};
                    const f32x4 r1 = {bflo(n_.z) * fast_rcp(fmaxf(bflo(d_.z), 1e-30f)), bfhi(n_.z) * fast_rcp(fmaxf(bfhi(d_.z), 1e-30f)), bflo(n_.w) * fast_rcp(fmaxf(bflo(d_.w), 1e-30f)), bfhi(n_.w) * fast_rcp(fmaxf(bfhi(d_.w), 1e-30f))};
                    acc[ai][bj][m][0] *= r0; acc[ai][bj][m][1] *= r1; }
            asm volatile("" ::: "memory");
        }
    }
    __device__ __forceinline__ void operator()(AccRef acc, const Unit& u, int wr, int wc, int fr, int fq) const {
        const int row0 = u.pm * 256 + wr * 64 + fr, c0 = u.pn * 256 + wc * 32 + 8 * fq;
        v4u gw[2][4][2];
#pragma unroll
        for (int ai = 0; ai < 2; ++ai)
#pragma unroll
            for (int m = 0; m < 4; ++m)
#pragma unroll
                for (int bj = 0; bj < 2; ++bj) gw[ai][m][bj] = *(const v4u*)(GATE + (size_t)(row0 + ai * 128 + m * 16) * 3072 + 2048 + c0 + bj * 128);
#pragma unroll
        for (int ai = 0; ai < 2; ++ai)
#pragma unroll
            for (int m = 0; m < 4; ++m) { const int row = row0 + ai * 128 + m * 16;
#pragma unroll
                for (int bj = 0; bj < 2; ++bj) { const v4u g = gw[ai][m][bj];
                    const f32x4 o0 = acc[ai][bj][m][0] * (f32x4){bflo(g.x), bfhi(g.x), bflo(g.y), bfhi(g.y)}, o1 = acc[ai][bj][m][1] * (f32x4){bflo(g.z), bfhi(g.z), bflo(g.w), bfhi(g.w)};
                    v4u w; w.x = cvt_pk_bf16(o0.x, o0.y); w.y = cvt_pk_bf16(o0.z, o0.w); w.z = cvt_pk_bf16(o1.x, o1.y); w.w = cvt_pk_bf16(o1.z, o1.w); *(v4u*)(MB + (size_t)row * D + c0 + bj * 128) = w;
                } }
    }
};
__device__ __forceinline__ size_t qkv_off(int row, int g, int h) {
    if (row >= MP) return (size_t)row * 1536 + g * 512 + h * 128;
    const int b = row >> 11, t = row & 2047, sh = 2 * g, p = ((t & ((1 << sh) - 1)) << (11 - sh)) + (t >> sh);
    return ((size_t)((g * NB + b) * 4 + h) * SEQ + p) * 128;
}
struct EpiZ {
    static constexpr bool HAS_MID = false;
    const float* pq; const float* ropeC; const float* ropeS; const float* bga; float* out;
    bf16 *QS, *KS, *VS, *GQ, *GK, *GV, *GRS, *MQ, *GATE; float* GA;
    template <int ACT> __device__ __forceinline__ void plain(AccRef acc, const float (&rs)[2][4], int row0, bf16* dst, int ld, int col0, float scale) const {
#pragma unroll
        for (int ai = 0; ai < 2; ++ai)
#pragma unroll
            for (int m = 0; m < 4; ++m) { const int row = row0 + ai * 128 + m * 16; const float s = rs[ai][m];
#pragma unroll
                for (int bj = 0; bj < 2; ++bj) { float o[8];
#pragma unroll
                    for (int n = 0; n < 2; ++n)
#pragma unroll
                        for (int i = 0; i < 4; ++i) { const float x = acc[ai][bj][m][n][i] * s; o[4 * n + i] = ACT == 0 ? x * scale : (ACT == 1 ? siluf_(x) : sigmoidf_(x)); }
                    v4u w; w.x = cvt_pk_bf16(o[0], o[1]); w.y = cvt_pk_bf16(o[2], o[3]); w.z = cvt_pk_bf16(o[4], o[5]); w.w = cvt_pk_bf16(o[6], o[7]);
                    *(v4u*)(dst + (size_t)row * ld + col0 + bj * 128) = w; } }
    }
    __device__ __forceinline__ float* swa_dst(int row, int g, int kv, int h) const {
        if (row >= MP) return out + (g == 0 ? O_SWA0S : (g == 1 ? O_SWA1S : O_SWA2S)) + ((size_t)(row - MP) * 2 + kv) * 512 + h * 128;
        const int b = row >> 11, t = row & 2047, keep = 128 << (2 * g), t0 = SEQ - keep;
        if (t < t0) return nullptr;
        return out + (g == 0 ? O_SWA0P : (g == 1 ? O_SWA1P : O_SWA2P)) + (((size_t)b * keep + (t - t0)) * 2 + kv) * 512 + h * 128;
    }
    __device__ __forceinline__ void operator()(AccRef acc, const Unit& u, int wr, int wc, int fr, int fq) const {
        const int row0 = u.pm * 256 + wr * 64 + fr, pn = u.pn, cl = wc * 32 + 8 * fq;
        float rs[2][4];
#pragma unroll
        for (int ai = 0; ai < 2; ++ai)
#pragma unroll
            for (int m = 0; m < 4; ++m) { const int row = row0 + ai * 128 + m * 16;
                const f32x4 pv = *(const f32x4*)(pq + (size_t)row * 16 + 4 * fq); float t = (pv.x + pv.y) + (pv.z + pv.w); t += __shfl_xor(t, 16); t += __shfl_xor(t, 32); rs[ai][m] = __builtin_amdgcn_rsqf(t * (1.f / D) + EPS); }
        if (pn < 12) {
            const int isk = pn >= 6, g = (pn % 6) >> 1, hp = pn & 1, e0 = wc * 16 + 4 * fq;
#pragma unroll
            for (int ai = 0; ai < 2; ++ai) {
                f32x4 cs[4], sn[4];
#pragma unroll
                for (int m = 0; m < 4; ++m) { const int row = row0 + ai * 128 + m * 16; const int pidx = row < MP ? (row & 2047) : SEQ + ((row - MP) & 3);
                    cs[m] = *(const f32x4*)(ropeC + pidx * 64 + e0); sn[m] = *(const f32x4*)(ropeS + pidx * 64 + e0); }
#pragma unroll
                for (int m = 0; m < 4; ++m) { const int row = row0 + ai * 128 + m * 16; const float s = rs[ai][m];
#pragma unroll
                    for (int bj = 0; bj < 2; ++bj) { const int h = 2 * hp + bj;
                        const f32x4 x1 = acc[ai][bj][m][0] * s, x2 = acc[ai][bj][m][1] * s;
                        f32x4 r1 = x1 * cs[m] - x2 * sn[m], r2 = x2 * cs[m] + x1 * sn[m];
                        if (!isk) { r1 *= QSCALE; r2 *= QSCALE; }
                        bf16* dp = (isk ? KS : QS) + qkv_off(row, g, h) + e0;
                        v2u w1, w2; w1.x = cvt_pk_bf16(r1.x, r1.y); w1.y = cvt_pk_bf16(r1.z, r1.w); w2.x = cvt_pk_bf16(r2.x, r2.y); w2.y = cvt_pk_bf16(r2.z, r2.w);
                        *(v2u*)dp = w1; *(v2u*)(dp + 64) = w2;
                        if (isk) { float* fo = swa_dst(row, g, 0, h); if (fo) { *(f32x4*)(fo + e0) = r1; *(f32x4*)(fo + 64 + e0) = r2; } }
                    } }
            }
        } else if (pn < 18) {
            const int g = (pn - 12) >> 1, hp = pn & 1;
#pragma unroll
            for (int ai = 0; ai < 2; ++ai)
#pragma unroll
                for (int m = 0; m < 4; ++m) { const int row = row0 + ai * 128 + m * 16; const float s = rs[ai][m];
#pragma unroll
                    for (int bj = 0; bj < 2; ++bj) { const int h = 2 * hp + bj; const f32x4 o0 = acc[ai][bj][m][0] * s, o1 = acc[ai][bj][m][1] * s;
                        v4u w; w.x = cvt_pk_bf16(o0.x, o0.y); w.y = cvt_pk_bf16(o0.z, o0.w); w.z = cvt_pk_bf16(o1.x, o1.y); w.w = cvt_pk_bf16(o1.z, o1.w);
                        *(v4u*)(VS + qkv_off(row, g, h) + cl) = w;
                        float* fo = swa_dst(row, g, 1, h); if (fo) { *(f32x4*)(fo + cl) = o0; *(f32x4*)(fo + cl + 4) = o1; } } }
        } else if (pn == 18) plain<0>(acc, rs, row0, GQ, 256, cl, 0.125f);
        else if (pn == 19) plain<0>(acc, rs, row0, GK, 256, cl, 1.f);
        else if (pn < 22) plain<0>(acc, rs, row0, GV, 512, (pn - 20) * 256 + cl, 1.f);
        else if (pn < 24) plain<1>(acc, rs, row0, GRS, 512, (pn - 22) * 256 + cl, 1.f);
        else if (pn == 24) {
            f32x4 bv[2][2];
#pragma unroll
            for (int bj = 0; bj < 2; ++bj)
#pragma unroll
                for (int n = 0; n < 2; ++n) bv[bj][n] = *(const f32x4*)(bga + bj * 128 + cl + 4 * n);
#pragma unroll
            for (int ai = 0; ai < 2; ++ai)
#pragma unroll
                for (int m = 0; m < 4; ++m) { const int row = row0 + ai * 128 + m * 16; const float s = rs[ai][m];
#pragma unroll
                    for (int bj = 0; bj < 2; ++bj)
#pragma unroll
                        for (int n = 0; n < 2; ++n) { const int c = bj * 128 + cl + 4 * n; f32x4 o;
#pragma unroll
                            for (int i = 0; i < 4; ++i) { const float x = acc[ai][bj][m][n][i] * s + bv[bj][n][i];
                                o[i] = (fminf(x, 0.f) - LN2 * fast_log2(1.f + fast_exp2(-1.4426950408889634f * fabsf(x)))) * (1.f / 16.f); }
                            *(f32x4*)(GA + (size_t)row * 256 + c) = o; } }
        } else if (pn < 27) plain<0>(acc, rs, row0, MQ, 512, (pn - 25) * 256 + cl, QSCALE);
        else plain<2>(acc, rs, row0, GATE, 3072, (pn - 27) * 256 + cl, 1.f);
    }
};


constexpr int TS = 4;
template <int O> __device__ __forceinline__ void tail_store_group(const f32x4 (&acc)[2][2][4][2], float* dst) {
#pragma unroll
    for (int e = 0; e < 8; ++e) *(f32x4*)(dst + (size_t)e * 2048) = acc[O >> 1][e >> 2][2 * (O & 1) + ((e >> 1) & 1)][e & 1];
}
template <class Base> struct EpiTail {
    static constexpr bool HAS_MID = false;
    Base E0; float* slab  ; gu32* flag; int s, wave;
    __device__ __forceinline__ void operator()(const f32x4 (&acc)[2][2][4][2], const Unit& u, int wr, int wc, int fr, int fq) const {
        const int lane = fq * 16 + fr; float* lb = slab + (size_t)(wave * 64 + lane) * 4;
        tail_store_group<0>(acc, lb + (size_t)((0 * TS + s) * 8) * 2048); tail_store_group<1>(acc, lb + (size_t)((1 * TS + s) * 8) * 2048);
        tail_store_group<2>(acc, lb + (size_t)((2 * TS + s) * 8) * 2048); tail_store_group<3>(acc, lb + (size_t)((3 * TS + s) * 8) * 2048);
        asm volatile("s_waitcnt vmcnt(0)" ::: "memory");
        asm volatile("s_waitcnt lgkmcnt(0)" ::: "memory"); __builtin_amdgcn_s_barrier(); asm volatile("" ::: "memory");
        if (wave == 0) {
            if (lane == 0) { __builtin_amdgcn_fence(__ATOMIC_RELEASE, "agent"); asm volatile("s_waitcnt vmcnt(0)" ::: "memory"); __hip_atomic_fetch_add(flag, 1u, RLX_AGENT); }
            unsigned spins = 0;
            while ((unsigned)__builtin_amdgcn_readfirstlane((int)__hip_atomic_load(flag, RLX_AGENT)) < (unsigned)TS) { __builtin_amdgcn_s_sleep(4); if (++spins > (1u << 22)) break; }
            __builtin_amdgcn_fence(__ATOMIC_ACQUIRE, "agent"); asm volatile("s_waitcnt vmcnt(0)" ::: "memory"); }
        asm volatile("s_waitcnt lgkmcnt(0)" ::: "memory"); __builtin_amdgcn_s_barrier(); asm volatile("" ::: "memory");
        const float* src = lb + (size_t)(s * TS * 8) * 2048;
        f32x4 t[TS][8];
#pragma unroll
        for (int ci = 0; ci < TS; ++ci)
#pragma unroll
            for (int e = 0; e < 8; ++e) t[ci][e] = *(const f32x4*)(src + (size_t)(ci * 8 + e) * 2048);
        f32x4 own[8];
#pragma unroll
        for (int e = 0; e < 8; ++e) own[e] = (t[0][e] + t[1][e]) + (t[2][e] + t[3][e]);
        if (s == 0) E0.template group<0>(own, u, wr, wc, fr, fq); else if (s == 1) E0.template group<1>(own, u, wr, wc, fr, fq);
        else if (s == 2) E0.template group<2>(own, u, wr, wc, fr, fq); else E0.template group<3>(own, u, wr, wc, fr, fq);
    }
};
#define XB_TMO      128
#define XB_XCNT(j)  (256  + 64 * (j))
#define XB_XSUB(j)  (1280 + 64 * (j))
#define XB_XGEN(j)  (2304 + 64 * (j))
#define XB_TOP      3328
#define XB_TOPGEN   3392
#define XCD_BAR_WORDS 3456
#define XB_SPIN_CAP (1u << 18)
__device__ __forceinline__ unsigned xb_ld(unsigned* p)              { return __hip_atomic_load(p, __ATOMIC_RELAXED, __HIP_MEMORY_SCOPE_AGENT); }
__device__ __forceinline__ unsigned xb_add(unsigned* p, unsigned v) { return __hip_atomic_fetch_add(p, v, __ATOMIC_RELAXED, __HIP_MEMORY_SCOPE_AGENT); }
__device__ __forceinline__ unsigned xb_xcc_id() { return (unsigned)__builtin_amdgcn_s_getreg((3 << 11) | 20) & 0xFu; }
#define XB_SPIN(cond, bar) do { unsigned _sp = 0; while (cond) { __builtin_amdgcn_s_sleep(1); \
    if ((++_sp & 255u) == 0u) { if (xb_ld(&(bar)[XB_TMO])) break; if (_sp > XB_SPIN_CAP) { atomicAdd(&(bar)[XB_TMO], 1u); break; } } } } while (0)
struct XcdBarrier { unsigned* bar; unsigned x; volatile LAS unsigned* st; };
__device__ __forceinline__ XcdBarrier xcd_barrier_post(unsigned* bar, volatile LAS unsigned* st, int wave) {
    XcdBarrier b; b.bar = bar; b.x = xb_xcc_id(); b.st = st;
    if (wave == 0 && lane_id() == 0) (void)xb_add(&bar[XB_XCNT(b.x)], 1u);
    return b;
}
__device__ __forceinline__ void xcd_barrier_complete(unsigned* bar, unsigned x, unsigned& nloc, unsigned& nx) {
    const unsigned G = gridDim.x * gridDim.y * gridDim.z;
    unsigned sum, cnt, mine, sp = 0u;
    for (;;) {
        sum = 0u; cnt = 0u; mine = 0u;
#pragma unroll
        for (unsigned j = 0; j < 16; ++j) { const unsigned c = xb_ld(&bar[XB_XCNT(j)]); sum += c; cnt += (c > 0u) ? 1u : 0u; mine = (j == x) ? c : mine; }
        if (sum == G) break;
        __builtin_amdgcn_s_sleep(1);
        if ((++sp & 255u) == 0u) { if (xb_ld(&bar[XB_TMO])) break; if (sp > XB_SPIN_CAP) { atomicAdd(&bar[XB_TMO], 1u); break; } }
    }
    nloc = mine > 0u ? mine : 1u; nx = cnt > 0u ? cnt : 1u;
}
__device__ __forceinline__ void xcd_barrier(const XcdBarrier& b, int wave) {
    asm volatile("s_waitcnt vmcnt(0)" ::: "memory");
    __syncthreads();
    if (wave == 0 && lane_id() == 0) {
        unsigned* bar = b.bar;
        __builtin_amdgcn_s_waitcnt(0);
        unsigned nloc = b.st[0], nx = b.st[1];
        if (nloc == 0u) { xcd_barrier_complete(bar, b.x, nloc, nx); b.st[0] = nloc; b.st[1] = nx; }
        const unsigned old = xb_add(&bar[XB_XSUB(b.x)], 1u);
        const unsigned gen = old / nloc;
        if (old + 1u == (gen + 1u) * nloc) {
            __builtin_amdgcn_fence(__ATOMIC_RELEASE, "agent");
            asm volatile("s_waitcnt vmcnt(0)" ::: "memory");
            const unsigned og = xb_add(&bar[XB_TOP], 1u);
            const unsigned tg = og / nx;
            if (og + 1u == (tg + 1u) * nx) xb_add(&bar[XB_TOPGEN], 1u);
            else XB_SPIN(xb_ld(&bar[XB_TOPGEN]) == tg, bar);
            __builtin_amdgcn_fence(__ATOMIC_ACQUIRE, "agent");
            xb_add(&bar[XB_XGEN(b.x)], 1u);
            asm volatile("s_waitcnt vmcnt(0)" ::: "memory");
        } else {
            XB_SPIN(xb_ld(&bar[XB_XGEN(b.x)]) == gen, bar);
            __builtin_amdgcn_fence(__ATOMIC_ACQUIRE, "agent");
            asm volatile("s_waitcnt vmcnt(0)" ::: "memory");
        }
    }
    __syncthreads();
}

struct Args { const float* in[25]; float* out; unsigned char* ws; int ph_lo, ph_hi, li, pad; };
struct Frame {
    LAS unsigned char* lds; int tid, lane, wave, vcu, G;
    const float *i0, *i1, *i2, *i3, *i4, *i5, *i6, *i7, *i8, *i9, *i10, *i11, *i12, *i13, *i14, *i15, *i16, *i17, *i18, *i19, *i20, *i21, *i22, *i23, *i24;
    float* out; unsigned char* ws;
};
__device__ __forceinline__ float wave_sum(float v) {
#pragma unroll
    for (int o = 1; o < 64; o <<= 1) v += __shfl_xor(v, o);
    return v;
}

template <class Base, bool ATILED = false> __device__ __forceinline__ void tail_phase(Frame& F, const bf16* A, int lda, const bf16* Bt, int ldb, int K, const Base& E0, int ps) {
    const int c = (int)blockIdx.x; if (c >= 8 * TS) return;
    const int j = c / TS, s = c % TS, nch = K / 128, c0 = (s * nch) / TS, c1 = ((s + 1) * nch) / TS;
    pg8::OneUnit S; S.c = c; pg8::StaticOrderT<MR / 256, D / 256>::unit_of(1024 + j, S.u);
    pg8::Gemm g{A + (ATILED ? (size_t)c0 * 2 * (pg8::TILED_KS / 2) : (size_t)c0 * 128), Bt + c0 * 128, MR, D, (c1 - c0) * 128, lda, ldb};
    EpiTail<Base> E{E0, (float*)(F.ws + WS_SLAB) + (size_t)j * (TS * TS * 8 * 2048), (gu32*)(F.ws + WS_CTL) + CW_TAIL + (ps * 8 + j) * 64, s, F.wave};
    pg8::gemm_phase<EpiTail<Base>, pg8::OneUnit, true, ATILED>(F.lds + RING_OFF, g, S, E, F.wave);
}
enum WKind { WK_PLAIN = 0, WK_SWIGLU = 1, WK_IN = 2 };
__device__ __forceinline__ int p0_win_col(int np) {
    const int pn = np >> 8, r = np & 255;
    if (pn < 18) { const int qkv = pn / 6, g = (pn % 6) >> 1, hp = pn & 1, h = 2 * hp + (r >> 7); const int d = qkv < 2 ? sig_rope(r & 127) : sig_plain(r & 127); return ((qkv * 3 + g) * 4 + h) * 128 + d; }
    const int c = sig_plain(r);
    if (pn == 18) return 4608 + c;
    if (pn == 19) return 4864 + c;
    if (pn < 22) return 5120 + (pn - 20) * 256 + c;
    if (pn < 24) return 5632 + (pn - 22) * 256 + c;
    if (pn == 24) return -1 - c;
    if (pn < 27) return 6160 + (pn - 25) * 256 + c;
    return DIN + (pn - 27) * 256 + c;
}
__device__ __forceinline__ void p0_item(const Frame& F, int kind, const float* W, int ldw, const float* W2, const float* gain, const float* a2, bf16* WT, int K, int kb, int nb, LAS float* scr) {
    const int lane = F.lane, k0 = 64 * kb, n0 = 32 * nb, np = n0 + (lane & 31);
    int sc; const float* Wp = W; int ld = ldw;
    if (kind == WK_PLAIN) sc = sig_plain(np);
    else if (kind == WK_SWIGLU) { const int r = np & 255; sc = (r >> 7) * FF + (np >> 8) * 128 + sig_plain(r & 127); }
    else { sc = p0_win_col(np); if (sc >= DIN) { sc -= DIN; Wp = W2; ld = 3072; } }
    if (sc >= 0) {
        float wv[32];
#pragma unroll
        for (int i = 0; i < 32; ++i) { const int kk = 2 * i + (lane >> 5); wv[i] = Wp[(size_t)(k0 + kk) * ld + sc]; if (gain) wv[i] *= gain[k0 + kk]; }
#pragma unroll
        for (int i = 0; i < 32; ++i) { const int kk = 2 * i + (lane >> 5); scr[kk * 33 + (lane & 31)] = wv[i]; }
    } else {
        const int j = -1 - sc; float a2c[16];
#pragma unroll
        for (int r = 0; r < 16; ++r) a2c[r] = a2[r * 256 + j];
        for (int i = 0; i < 32; ++i) { const int kk = 2 * i + (lane >> 5); const float* wr_ = W + (size_t)(k0 + kk) * ldw + 6144; float v = 0.f;
#pragma unroll
            for (int r = 0; r < 16; ++r) v += wr_[r] * a2c[r];
            scr[kk * 33 + (lane & 31)] = v * gain[k0 + kk]; }
    }
    LDS_WAIT(); asm volatile("" ::: "memory");
    const int c = lane & 7;
#pragma unroll
    for (int j = 0; j < 4; ++j) { const int n = (lane >> 3) + 8 * j; const LAS float* s = scr + (8 * c) * 33 + n;
        v4u o; o.x = pk2(s[0 * 33], s[1 * 33]); o.y = pk2(s[2 * 33], s[3 * 33]); o.z = pk2(s[4 * 33], s[5 * 33]); o.w = pk2(s[6 * 33], s[7 * 33]);
        *(GAS v4u*)(WT + (size_t)(n0 + n) * K + k0 + 8 * c) = o; }
    LDS_WAIT(); asm volatile("" ::: "memory");
}
template <int NR> __device__ __forceinline__ void rms_rows_to_bf16(int lane, const float* const (&xrow)[NR], const float* const (&gain)[NR], bf16* const (&orow)[NR]) {
    f32x4 v[NR][4]; float rstd[NR];
#pragma unroll
    for (int r = 0; r < NR; ++r)
#pragma unroll
        for (int j = 0; j < 4; ++j) v[r][j] = ((const GAS f32x4*)xrow[r] + lane)[64 * j];
#pragma unroll
    for (int r = 0; r < NR; ++r) { float s = 0.f;
#pragma unroll
        for (int j = 0; j < 4; ++j) s += (v[r][j].x * v[r][j].x + v[r][j].y * v[r][j].y) + (v[r][j].z * v[r][j].z + v[r][j].w * v[r][j].w);
        rstd[r] = 1.0f / sqrtf(wave_sum(s) * (1.f / D) + EPS); }
#pragma unroll
    for (int r = 0; r < NR; ++r) { GAS v2u* o8 = (GAS v2u*)orow[r] + lane; const GAS f32x4* gr = (const GAS f32x4*)gain[r] + lane;
#pragma unroll
        for (int j = 0; j < 4; ++j) { const f32x4 gg = gr[64 * j]; v2u w; w.x = pk2(v[r][j].x * rstd[r] * gg.x, v[r][j].y * rstd[r] * gg.y); w.y = pk2(v[r][j].z * rstd[r] * gg.z, v[r][j].w * rstd[r] * gg.w); o8[64 * j] = w; } }
}
__device__ __forceinline__ void sincos_d(double x, double& s, double& c) {
    const double TWO_PI = 6.283185307179586476925286766559;
    const double n = __builtin_rint(x / TWO_PI); const double r = x - n * TWO_PI, r2 = r * r;
    double ts = 1.0, tc = 1.0;
#pragma unroll
    for (int k = 14; k >= 1; --k) { ts = 1.0 - ts * r2 / (double)((2 * k) * (2 * k + 1)); tc = 1.0 - tc * r2 / (double)((2 * k - 1) * (2 * k)); }
    s = ts * r; c = tc;
}
__device__ __forceinline__ void p0_prologue(Frame& F) {
    unsigned char* ws = F.ws;
    LAS float* scr = (LAS float*)(F.lds + RING_OFF + F.wave * 16384);
    constexpr int P0_ITW = MK_P0_ITW; const bool itw = F.wave < P0_ITW;
    const int gw = itw ? F.vcu * P0_ITW + F.wave : F.vcu * (NWAVES - P0_ITW) + (F.wave - P0_ITW), NGW = itw ? F.G * P0_ITW : F.G * (NWAVES - P0_ITW);
    constexpr int I_A = 16 * 176, I_O = 44 * 32, I_IN = 16 * 312, I_BR = 8 * 32, I_SQ = 16 * 32;
    constexpr int NITEMS = 2 * I_A + 2 * I_O + I_IN + 3 * I_BR + 2 * I_SQ;
    if (itw) for (int it = gw; it < NITEMS; it += NGW) {
        int r = it;
        if (r < I_A) { p0_item(F, WK_SWIGLU, F.i9, 2 * FF, nullptr, nullptr, nullptr, (bf16*)(ws + WS_W1A), D, r / 176, r % 176, scr); continue; } r -= I_A;
        if (r < I_A) { p0_item(F, WK_SWIGLU, F.i22, 2 * FF, nullptr, F.i21, nullptr, (bf16*)(ws + WS_W2A), D, r / 176, r % 176, scr); continue; } r -= I_A;
        if (r < I_O) { p0_item(F, WK_PLAIN, F.i10, D, nullptr, nullptr, nullptr, (bf16*)(ws + WS_W1O), FF, r / 32, r % 32, scr); continue; } r -= I_O;
        if (r < I_O) { p0_item(F, WK_PLAIN, F.i23, D, nullptr, nullptr, nullptr, (bf16*)(ws + WS_W2O), FF, r / 32, r % 32, scr); continue; } r -= I_O;
        if (r < I_IN) { p0_item(F, WK_IN, F.i12, DIN, F.i16, F.i11, F.i13, (bf16*)(ws + WS_WIN), D, r / 312, r % 312, scr); continue; } r -= I_IN;
        if (r < 3 * I_BR) { const int br = r / I_BR, q = r % I_BR; p0_item(F, WK_PLAIN, F.i17 + (size_t)br * 512 * D, D, nullptr, nullptr, nullptr, (bf16*)(ws + WS_WBR) + br * 512, 1536, q / 32, q % 32, scr); continue; } r -= 3 * I_BR;
        if (r < I_SQ) { p0_item(F, WK_PLAIN, F.i18, D, nullptr, nullptr, nullptr, (bf16*)(ws + WS_WOUT), D, r / 32, r % 32, scr); continue; } r -= I_SQ;
        p0_item(F, WK_PLAIN, F.i20, D, nullptr, nullptr, nullptr, (bf16*)(ws + WS_WMEM), D, r / 32, r % 32, scr);
    }
#define P0_ROW(m_, x_, g_, o_) do { const int mm_ = (m_); if (mm_ < MP) { x_ = F.i0 + (size_t)mm_ * D; g_ = F.i8; o_ = (bf16*)(ws + WS_XB) + (size_t)mm_ * D; } \
        else if (mm_ < MR) { x_ = F.i1 + (size_t)(mm_ - MP) * D; g_ = F.i8; o_ = (bf16*)(ws + WS_XB) + (size_t)mm_ * D; } \
        else { x_ = F.i2 + (size_t)(mm_ - MR) * D; g_ = F.i19; o_ = (bf16*)(ws + WS_MEMB) + (size_t)(mm_ - MR) * D; } } while (0)
    if (!itw) { int m = gw;
      for (; m + 3 * NGW < MR + MM; m += 4 * NGW) { const float* x[4]; const float* g[4]; bf16* o[4];
#pragma unroll
          for (int r = 0; r < 4; ++r) P0_ROW(m + r * NGW, x[r], g[r], o[r]);
          rms_rows_to_bf16<4>(F.lane, x, g, o); }
      for (; m < MR + MM; m += NGW) { const float* x[1]; const float* g[1]; bf16* o[1]; P0_ROW(m, x[0], g[0], o[0]); rms_rows_to_bf16<1>(F.lane, x, g, o); } }
#undef P0_ROW
    float* rc = (float*)(ws + WS_ROPE); float* rsn = rc + NPOS * 64;
    for (int i = (F.vcu * NWAVES * 64) + F.tid; i < NPOS * 64; i += F.G * NWAVES * 64) {
        const int p = i >> 6, e = i & 63; const int pos = p < SEQ ? p : PAST + (p - SEQ);
        const double y = -(double)e * 9.210340371976182736 / 64.0 / 16.0; double ex = 1.0;
#pragma unroll
        for (int k = 14; k >= 1; --k) ex = 1.0 + ex * y / (double)k;
        ex *= ex; ex *= ex; ex *= ex; ex *= ex;
        const float inv = (float)ex; const float ang = (float)pos * inv;
        double s, c; sincos_d((double)ang, s, c); rc[i] = (float)c; rsn[i] = (float)s;
    }
}

__device__ __forceinline__ int koff(int row, int ch) { return 256 * row + 16 * (ch ^ (row & 15)); }
__device__ __forceinline__ int voff(int row, int ch) { return 256 * row + 16 * (ch ^ ((row & 7) << 1)); }
typedef short v4i16_t __attribute__((ext_vector_type(4)));
__device__ __forceinline__ s16x4 vtr(const LAS unsigned char* p) { return __builtin_bit_cast(s16x4, __builtin_amdgcn_ds_read_tr16_b64_v4i16((LAS v4i16_t*)p)); }
struct AttnDesc { const bf16* Qp; const bf16* Kp; const bf16* Vp; bf16* Op; float* lsep; long qrow0, krow0, orow0; int qpitch, kpitch, opitch, qstride, kstride, ostride, kmin; };
template <int MODE> __device__ __forceinline__ AttnDesc attn_desc(const Frame& F, int id) {
    unsigned char* ws = F.ws; AttnDesc d;
    if (MODE == 0) {
        const int b = id / 192, rem = id % 192, gh = rem >> 4, u = rem & 15, g = gh >> 2;
        const int dil = g == 0 ? 1 : (g == 1 ? 4 : 16), r = g == 0 ? 0 : (g == 1 ? (u & 3) : u), n = g == 0 ? u : (g == 1 ? (u >> 2) : 0);
        const size_t hb = (size_t)((g * NB + b) * 4 + (gh & 3)) * SEQ * 128; const long pr = (long)r * (SEQ / dil);
        d.Qp = (const bf16*)(ws + WS_QS) + hb; d.Kp = (const bf16*)(ws + WS_KS) + hb; d.Vp = (const bf16*)(ws + WS_VS) + hb; d.Op = (bf16*)(ws + WS_OG) + gh * 128; d.lsep = (float*)(ws + WS_LSE) + gh;
        d.qrow0 = pr + 128 * n; d.krow0 = pr + 128 * (n - 1); d.orow0 = (long)b * SEQ + r + (long)128 * n * dil; d.qpitch = 128; d.kpitch = 128; d.opitch = 1536; d.qstride = 1; d.kstride = 1; d.ostride = dil; d.kmin = n == 0 ? 128 : 0;
    } else {
        const int j = id - 6144, b = j >> 6, h = (j >> 4) & 3, n = j & 15;
        d.Qp = (const bf16*)(ws + WS_MQ) + h * 128; d.Kp = (const bf16*)(ws + WS_MKV) + h * 128; d.Vp = (const bf16*)(ws + WS_MKV) + 512 + h * 128; d.Op = (bf16*)(ws + WS_OALL) + 1024 + h * 128; d.lsep = nullptr;
        d.qrow0 = (long)b * SEQ + 128 * n; d.orow0 = d.qrow0; d.ostride = 1; d.krow0 = (long)b * MEML; d.qpitch = 512; d.kpitch = 1024; d.opitch = 1536; d.qstride = 1; d.kstride = 1; d.kmin = 0;
    }
    return d;
}
template <int MODE> __device__ __forceinline__ void attn_scores(const Frame& F, const AttnDesc& d, const bf16x8 (&qf)[4], f32x4 (&S)[MODE == 0 ? 9 : 16], float& mx_out, float& ls_out) {
    const LAS unsigned char* ldsK = F.lds + RING_OFF;
    const int lane = F.lane, w = F.wave, l15 = lane & 15, g4 = lane >> 4;
    constexpr int NF = MODE == 0 ? 9 : 16;
    const int f0 = MODE == 0 ? w : 0; const bool half = MODE == 0 && d.kmin != 0;
#pragma unroll
    for (int i = 0; i < NF; ++i) { S[i] = (f32x4){0.f, 0.f, 0.f, 0.f};
        if (!(half && f0 + i < 8)) { const int krow = 16 * (f0 + i) + l15;
#pragma unroll
            for (int s = 0; s < 4; ++s) { const bf16x8 kf = *(const LAS bf16x8*)(ldsK + koff(krow, 4 * s + g4)); S[i] = __builtin_amdgcn_mfma_f32_16x16x32_bf16(kf, qf[s], S[i], 0, 0, 0); } } }
    float mx = -3.0e38f; const int iq = 16 * w + l15;
#pragma unroll
    for (int i = 0; i < NF; ++i)
#pragma unroll
        for (int r = 0; r < 4; ++r) { if (MODE == 0) { const int kj = 16 * (f0 + i) + 4 * g4 + r; const bool ok = kj >= iq && kj <= iq + 128 && kj >= d.kmin; S[i][r] = ok ? S[i][r] : -3.0e38f; } mx = fmaxf(mx, S[i][r]); }
    mx = fmaxf(mx, __shfl_xor(mx, 16)); mx = fmaxf(mx, __shfl_xor(mx, 32));
    float ls = 0.f;
#pragma unroll
    for (int i = 0; i < NF; ++i)
#pragma unroll
        for (int r = 0; r < 4; ++r) { const float p = fast_exp2(S[i][r] - mx); S[i][r] = p; ls += p; }
    ls += __shfl_xor(ls, 16); ls += __shfl_xor(ls, 32);
    mx_out = mx; ls_out = ls;
}
template <int MODE> __device__ __forceinline__ void attn_pv(const Frame& F, const AttnDesc& d, const f32x4 (&S)[MODE == 0 ? 9 : 16], float mx, float ls) {
    const LAS unsigned char* ldsV = F.lds + RING_OFF + 65536;
    const int lane = F.lane, w = F.wave, l15 = lane & 15, g4 = lane >> 4;
    constexpr int NF = MODE == 0 ? 9 : 16, NP = (NF + 1) / 2;
    const int f0 = MODE == 0 ? w : 0; const bool half = MODE == 0 && d.kmin != 0;
    f32x4 O[8];
#pragma unroll
    for (int df = 0; df < 8; ++df) O[df] = (f32x4){0.f, 0.f, 0.f, 0.f};
    const int q4 = l15 >> 2, p4 = lane & 3;
#pragma unroll
    for (int pr = 0; pr < NP; ++pr) {
        int fa = f0 + 2 * pr, fb = fa + 1; if (fb > 15) fb = 15;
        if (half && fb < 8) continue;
        if (half && fa < 8) fa = 8;
        const f32x4 pa = S[2 * pr], pb = (2 * pr + 1 < NF) ? S[(2 * pr + 1 < NF) ? 2 * pr + 1 : 0] : (f32x4){0.f, 0.f, 0.f, 0.f};
        v4u pw; pw.x = cvt_pk_bf16(pa.x, pa.y); pw.y = cvt_pk_bf16(pa.z, pa.w); pw.z = cvt_pk_bf16(pb.x, pb.y); pw.w = cvt_pk_bf16(pb.z, pb.w);
        const bf16x8 pf = __builtin_bit_cast(bf16x8, pw);
        const int ra = 16 * fa + 4 * g4 + q4, rb = 16 * fb + 4 * g4 + q4;
#pragma unroll
        for (int df = 0; df < 8; ++df) {
            const s16x4 t1 = vtr(ldsV + voff(ra, 2 * df + (p4 >> 1)) + 8 * (p4 & 1)), t2 = vtr(ldsV + voff(rb, 2 * df + (p4 >> 1)) + 8 * (p4 & 1));
            const bf16x8 vf = {t1[0], t1[1], t1[2], t1[3], t2[0], t2[1], t2[2], t2[3]};
            O[df] = __builtin_amdgcn_mfma_f32_16x16x32_bf16(vf, pf, O[df], 0, 0, 0);
        }
    }
    const float inv = 1.0f / ls;
    const long qrow = d.orow0 + (long)(16 * w + l15) * d.ostride;
    bf16* op = d.Op + qrow * d.opitch + 4 * g4;
#pragma unroll
    for (int df = 0; df < 8; ++df) { const f32x4 o = O[df] * inv; v2u wv; wv.x = cvt_pk_bf16(o.x, o.y); wv.y = cvt_pk_bf16(o.z, o.w); *(v2u*)(op + 16 * df) = wv; }
    if (MODE == 0 && g4 == 0) d.lsep[qrow * 12] = (mx + fast_log2(ls)) * LN2;
}
__device__ __forceinline__ void glds16(const void* gsrc, unsigned lds_dst) { unsigned keep;
    asm volatile("s_mov_b32 %0, m0\n\ts_mov_b32 m0, %2\n\ts_nop 0\n\tglobal_load_lds_dwordx4 %1, off\n\ts_mov_b32 m0, %0" : "=&s"(keep) : "v"(gsrc), "s"(lds_dst) : "memory"); }
__device__ __forceinline__ void attn_dma(const Frame& F, const AttnDesc& d, const bool isV) {
    const bf16* P = isV ? d.Vp : d.Kp;
    const unsigned base = (unsigned)__builtin_amdgcn_readfirstlane((int)(unsigned)(size_t)(F.lds + RING_OFF) + (isV ? 65536 : 0) + F.wave * 8192);
    if (d.kmin != 0 && F.wave < 4) return;
    const int slot = F.lane & 15, rsub = F.lane >> 4;
#pragma unroll
    for (int i = 0; i < 8; ++i) { const int row = 32 * F.wave + 4 * i + rsub, ch = isV ? (slot ^ ((row & 7) << 1)) : (slot ^ (row & 15));
        const bf16* gp = P + (d.krow0 + (long)row * d.kstride) * d.kpitch + ch * 8;
        glds16(gp, base + i * 1024); }
}
__device__ __forceinline__ void attn_loadq(const Frame& F, const AttnDesc& d, bf16x8 (&qf)[4]) {
    const long qrow = d.qrow0 + (long)(16 * F.wave + (F.lane & 15)) * d.qstride;
#pragma unroll
    for (int s = 0; s < 4; ++s) qf[s] = *(const bf16x8*)(d.Qp + qrow * d.qpitch + 32 * s + 8 * (F.lane >> 4));
}
#define ATT_BAR() do { asm volatile("s_waitcnt lgkmcnt(0)" ::: "memory"); __builtin_amdgcn_s_barrier(); asm volatile("" ::: "memory"); } while (0)
template <int MODE, int NU> __device__ __forceinline__ void attn_batch(const Frame& F, int id0) {
    AttnDesc d = attn_desc<MODE>(F, id0);
    bf16x8 qn[4], qc[4];
    attn_dma(F, d, false); attn_loadq(F, d, qn);
#pragma unroll
    for (int s = 0; s < 4; ++s) qc[s] = qn[s];
    attn_dma(F, d, true);
#pragma unroll 1
    for (int u = 0; u < NU; ++u) {
        asm volatile("s_waitcnt vmcnt(8)" ::: "memory"); ATT_BAR();
        f32x4 S[MODE == 0 ? 9 : 16]; float mx, ls;
        attn_scores<MODE>(F, d, qc, S, mx, ls);
        asm volatile("s_waitcnt vmcnt(0)" ::: "memory"); ATT_BAR();
        const bool more = u + 1 < NU;
        const AttnDesc dn = attn_desc<MODE>(F, id0 + (more ? u + 1 : u));
        if (more) { attn_dma(F, dn, false); if (MODE == 0) attn_loadq(F, dn, qn); }
        attn_pv<MODE>(F, d, S, mx, ls);
        ATT_BAR();
        if (more) {
            if (MODE != 0) attn_loadq(F, dn, qn);
#pragma unroll
            for (int s = 0; s < 4; ++s) qc[s] = qn[s];
            asm volatile("" : "+v"(qc[0]), "+v"(qc[1]), "+v"(qc[2]), "+v"(qc[3]));
            attn_dma(F, dn, true); }
        d = dn;
    }
    asm volatile("s_waitcnt vmcnt(0)" ::: "memory");
}
__device__ __forceinline__ void p4_sample_attn(const Frame& F, int wt, const float* c0, const float* c1, const float* c2, const float* cm) {
    unsigned char* ws = F.ws; const int lane = F.lane, sub = lane & 15, t = lane >> 4;
    const int db = wt >> 4, h = (wt >> 2) & 3, src = wt & 3;
    const int row = MP + db * 4 + t;
    const bf16* qp = src < 3 ? (const bf16*)(ws + WS_QS) + (size_t)row * 1536 + src * 512 + h * 128 + 8 * sub : (const bf16*)(ws + WS_MQ) + (size_t)row * 512 + h * 128 + 8 * sub;
    float q[8]; { const v4u qw = *(const v4u*)qp; q[0] = bflo(qw.x); q[1] = bfhi(qw.x); q[2] = bflo(qw.y); q[3] = bfhi(qw.y); q[4] = bflo(qw.z); q[5] = bfhi(qw.z); q[6] = bflo(qw.w); q[7] = bfhi(qw.w); }
    float mx = -3.0e38f, ls = 0.f, o[8];
#pragma unroll
    for (int j = 0; j < 8; ++j) o[j] = 0.f;
#define SA_STEP(K0, K1, V0, V1) do { float s_ = (q[0] * K0.x + q[1] * K0.y) + (q[2] * K0.z + q[3] * K0.w) + (q[4] * K1.x + q[5] * K1.y) + (q[6] * K1.z + q[7] * K1.w); \
        s_ += __shfl_xor(s_, 1); s_ += __shfl_xor(s_, 2); s_ += __shfl_xor(s_, 4); s_ += __shfl_xor(s_, 8); \
        const float mn_ = fmaxf(mx, s_), sc_ = fast_exp2(mx - mn_), p_ = fast_exp2(s_ - mn_); mx = mn_; ls = ls * sc_ + p_; \
        o[0] = o[0] * sc_ + p_ * V0.x; o[1] = o[1] * sc_ + p_ * V0.y; o[2] = o[2] * sc_ + p_ * V0.z; o[3] = o[3] * sc_ + p_ * V0.w; \
        o[4] = o[4] * sc_ + p_ * V1.x; o[5] = o[5] * sc_ + p_ * V1.y; o[6] = o[6] * sc_ + p_ * V1.z; o[7] = o[7] * sc_ + p_ * V1.w; } while (0)
    int nstart = 0, NK; const float* cache; int L = 256, dil = 1;
    if (src == 3) { cache = cm; NK = 256; }
    else { cache = src == 0 ? c0 : (src == 1 ? c1 : c2); L = 128 << (2 * src); dil = src == 0 ? 1 : (src == 1 ? 4 : 16); NK = 129; nstart = 4;
        for (int n = 0; n < 4; ++n) {
            const int idx = L + t - dil * n; f32x4 k0, k1, v0, v1;
            if (idx >= L) { const size_t ro = (size_t)(MP + db * 4 + (idx - L)) * 1536 + src * 512 + h * 128 + 8 * sub;
                const v4u kw = *(const v4u*)((const bf16*)(ws + WS_KS) + ro), vw = *(const v4u*)((const bf16*)(ws + WS_VS) + ro);
                k0 = (f32x4){bflo(kw.x), bfhi(kw.x), bflo(kw.y), bfhi(kw.y)}; k1 = (f32x4){bflo(kw.z), bfhi(kw.z), bflo(kw.w), bfhi(kw.w)};
                v0 = (f32x4){bflo(vw.x), bfhi(vw.x), bflo(vw.y), bfhi(vw.y)}; v1 = (f32x4){bflo(vw.z), bfhi(vw.z), bflo(vw.w), bfhi(vw.w)};
            } else { const float* kp = cache + (((size_t)db * L + idx) * 2) * 512 + h * 128 + 8 * sub;
                k0 = *(const f32x4*)kp; k1 = *(const f32x4*)(kp + 4); v0 = *(const f32x4*)(kp + 512); v1 = *(const f32x4*)(kp + 516); }
            SA_STEP(k0, k1, v0, v1);
        }
    }
    const float* kbase = cache + ((size_t)db * L * 2) * 512 + h * 128 + 8 * sub;
    const long kstep = src == 3 ? 1024 : -(long)dil * 1024; const long kfirst = src == 3 ? 0 : (long)(L + t) * 1024;
    int n = nstart;
    for (; n + 4 <= NK; n += 4) {
        f32x4 kk[4][2], vv[4][2];
#pragma unroll
        for (int j = 0; j < 4; ++j) { const float* kp = kbase + kfirst + (long)(n + j) * kstep; kk[j][0] = *(const f32x4*)kp; kk[j][1] = *(const f32x4*)(kp + 4); vv[j][0] = *(const f32x4*)(kp + 512); vv[j][1] = *(const f32x4*)(kp + 516); }
#pragma unroll
        for (int j = 0; j < 4; ++j) SA_STEP(kk[j][0], kk[j][1], vv[j][0], vv[j][1]);
    }
    for (; n < NK; ++n) { const float* kp = kbase + kfirst + (long)n * kstep; const f32x4 k0 = *(const f32x4*)kp, k1 = *(const f32x4*)(kp + 4), v0 = *(const f32x4*)(kp + 512), v1 = *(const f32x4*)(kp + 516); SA_STEP(k0, k1, v0, v1); }
#undef SA_STEP
    const float inv = 1.0f / ls;
    v4u w; w.x = cvt_pk_bf16(o[0] * inv, o[1] * inv); w.y = cvt_pk_bf16(o[2] * inv, o[3] * inv); w.z = cvt_pk_bf16(o[4] * inv, o[5] * inv); w.w = cvt_pk_bf16(o[6] * inv, o[7] * inv);
    if (src < 3) { *(v4u*)((bf16*)(ws + WS_OG) + (size_t)row * 1536 + src * 512 + h * 128 + 8 * sub) = w; if (sub == 0) ((float*)(ws + WS_LSE))[(size_t)row * 12 + src * 4 + h] = (mx + fast_log2(ls)) * LN2; }
    else *(v4u*)((bf16*)(ws + WS_OALL) + (size_t)row * 1536 + 1024 + h * 128 + 8 * sub) = w;
}
__device__ __forceinline__ void p4_sample_attn_shared(const Frame& F, int db, int h, const bool is_mem, const float* cache) {
    unsigned char* ws = F.ws; const int lane = F.lane, sub = lane & 15, gk = lane >> 4; const int rowq0 = MP + db * 4;
    float qv[4][8];
#pragma unroll
    for (int t = 0; t < 4; ++t) { const bf16* qp = is_mem ? (const bf16*)(ws + WS_MQ) + (size_t)(rowq0 + t) * 512 + h * 128 + 8 * sub : (const bf16*)(ws + WS_QS) + (size_t)(rowq0 + t) * 1536 + h * 128 + 8 * sub;
        const v4u qw = *(const v4u*)qp; qv[t][0] = bflo(qw.x); qv[t][1] = bfhi(qw.x); qv[t][2] = bflo(qw.y); qv[t][3] = bfhi(qw.y); qv[t][4] = bflo(qw.z); qv[t][5] = bfhi(qw.z); qv[t][6] = bflo(qw.w); qv[t][7] = bfhi(qw.w); }
    float m[4], l[4], o[4][8];
#pragma unroll
    for (int t = 0; t < 4; ++t) { m[t] = -3.0e38f; l[t] = 0.f;
#pragma unroll
        for (int j = 0; j < 8; ++j) o[t][j] = 0.f; }
#define SS_STEP(P, K0, K1, V0, V1) do { _Pragma("unroll") for (int t = 0; t < 4; ++t) { \
        float s_ = (qv[t][0] * K0.x + qv[t][1] * K0.y) + (qv[t][2] * K0.z + qv[t][3] * K0.w) + (qv[t][4] * K1.x + qv[t][5] * K1.y) + (qv[t][6] * K1.z + qv[t][7] * K1.w); \
        s_ += __shfl_xor(s_, 1); s_ += __shfl_xor(s_, 2); s_ += __shfl_xor(s_, 4); s_ += __shfl_xor(s_, 8); \
        const bool ok_ = is_mem || ((P) >= t && (P) <= 128 + t); \
        const float mn_ = ok_ ? fmaxf(m[t], s_) : m[t], sc_ = fast_exp2(m[t] - mn_), p_ = ok_ ? fast_exp2(s_ - mn_) : 0.f; m[t] = mn_; l[t] = l[t] * sc_ + p_; \
        o[t][0] = o[t][0] * sc_ + p_ * V0.x; o[t][1] = o[t][1] * sc_ + p_ * V0.y; o[t][2] = o[t][2] * sc_ + p_ * V0.z; o[t][3] = o[t][3] * sc_ + p_ * V0.w; \
        o[t][4] = o[t][4] * sc_ + p_ * V1.x; o[t][5] = o[t][5] * sc_ + p_ * V1.y; o[t][6] = o[t][6] * sc_ + p_ * V1.z; o[t][7] = o[t][7] * sc_ + p_ * V1.w; } } while (0)
    const int L = is_mem ? 256 : 128;
    const float* kbase = cache + ((size_t)db * L * 2) * 512 + h * 128 + 8 * sub + (size_t)gk * 1024;
    for (int j = 0; j < L / 4; j += 4) {
        f32x4 kk[4][2], vv[4][2];
#pragma unroll
        for (int e = 0; e < 4; ++e) { const float* kp = kbase + (size_t)(j + e) * 4096; kk[e][0] = *(const f32x4*)kp; kk[e][1] = *(const f32x4*)(kp + 4); vv[e][0] = *(const f32x4*)(kp + 512); vv[e][1] = *(const f32x4*)(kp + 516); }
#pragma unroll
        for (int e = 0; e < 4; ++e) SS_STEP(4 * (j + e) + gk, kk[e][0], kk[e][1], vv[e][0], vv[e][1]);
    }
    if (!is_mem) {
        const size_t ro = (size_t)(rowq0 + gk) * 1536 + h * 128 + 8 * sub;
        const v4u kw = *(const v4u*)((const bf16*)(ws + WS_KS) + ro), vw = *(const v4u*)((const bf16*)(ws + WS_VS) + ro);
        const f32x4 k0 = {bflo(kw.x), bfhi(kw.x), bflo(kw.y), bfhi(kw.y)}, k1 = {bflo(kw.z), bfhi(kw.z), bflo(kw.w), bfhi(kw.w)};
        const f32x4 v0 = {bflo(vw.x), bfhi(vw.x), bflo(vw.y), bfhi(vw.y)}, v1 = {bflo(vw.z), bfhi(vw.z), bflo(vw.w), bfhi(vw.w)};
        SS_STEP(128 + gk, k0, k1, v0, v1);
    }
#undef SS_STEP
    float mo = 0.f, lo = 1.f, oo[8];
#pragma unroll
    for (int j = 0; j < 8; ++j) oo[j] = 0.f;
#pragma unroll
    for (int t = 0; t < 4; ++t) {
        float mm = fmaxf(m[t], __shfl_xor(m[t], 16)); mm = fmaxf(mm, __shfl_xor(mm, 32));
        const float f = fast_exp2(m[t] - mm); float lt = l[t] * f; lt += __shfl_xor(lt, 16); lt += __shfl_xor(lt, 32);
        if (gk == t) { mo = mm; lo = lt; }
#pragma unroll
        for (int j = 0; j < 8; ++j) { float x = o[t][j] * f; x += __shfl_xor(x, 16); x += __shfl_xor(x, 32); if (gk == t) oo[j] = x; }
    }
    const float inv = 1.0f / lo; const int row = rowq0 + gk;
    v4u w; w.x = cvt_pk_bf16(oo[0] * inv, oo[1] * inv); w.y = cvt_pk_bf16(oo[2] * inv, oo[3] * inv); w.z = cvt_pk_bf16(oo[4] * inv, oo[5] * inv); w.w = cvt_pk_bf16(oo[6] * inv, oo[7] * inv);
    if (is_mem) *(v4u*)((bf16*)(ws + WS_OALL) + (size_t)row * 1536 + 1024 + h * 128 + 8 * sub) = w;
    else { *(v4u*)((bf16*)(ws + WS_OG) + (size_t)row * 1536 + h * 128 + 8 * sub) = w; if (sub == 0) ((float*)(ws + WS_LSE))[(size_t)row * 12 + h] = (mo + fast_log2(lo)) * LN2; }
}
__device__ __forceinline__ void p4_sample_task(const Frame& F, int it, const float* c0, const float* c1, const float* c2, const float* cm) {
    const int kind = it >> 9, idx = it & 511, db = idx >> 2, h = idx & 3;
    if (kind == 0) p4_sample_attn(F, db * 16 + h * 4 + 2, c0, c1, c2, cm);
    else if (kind == 1) p4_sample_attn(F, db * 16 + h * 4 + 1, c0, c1, c2, cm);
    else if (kind == 2) p4_sample_attn_shared(F, db, h, true, cm);
    else p4_sample_attn_shared(F, db, h, false, c0);
}
__device__ __forceinline__ void p4_sample_loop(const Frame& F, const float* c0, const float* c1, const float* c2, const float* cm, int q = 0) {
    gu32* qw = (gu32*)(F.ws + WS_CTL) + 64 + 64 * q;
    for (;;) { unsigned v = 0; if (F.lane == 0) v = __hip_atomic_fetch_add(qw, 1u, RLX_AGENT); const int it = (int)__builtin_amdgcn_readfirstlane(v);
        if (it >= 2048) break; p4_sample_task(F, it, c0, c1, c2, cm); }
}
__device__ __forceinline__ void p4_gla_chain(const Frame& F, int row0, int T, int h, const float* S0, float* Sout) {
    unsigned char* ws = F.ws; const int tid = F.tid, v = tid & 127, ks = __builtin_amdgcn_readfirstlane(tid >> 7);
    const float* GA = (const float*)(ws + WS_GA); const bf16* GQ = (const bf16*)(ws + WS_GQ); const bf16* GK = (const bf16*)(ws + WS_GK); const bf16* GV = (const bf16*)(ws + WS_GV); bf16* GO = (bf16*)(ws + WS_GO);
    LAS float* part = (LAS float*)(F.lds + RING_OFF);
    float S[16];
#pragma unroll
    for (int i = 0; i < 16; ++i) S[i] = S0 ? S0[(size_t)(16 * ks + i) * 128 + v] : 0.f;
    for (int t0 = 0; t0 < T; t0 += 16) {
        const int nb = (T - t0) < 16 ? (T - t0) : 16;
        __syncthreads();
        for (int tt = 0; tt < nb; ++tt) {
            const size_t row = (size_t)(row0 + t0 + tt);
            const float* ap = GA + row * 256 + h * 64 + 16 * ks; const v4u kw0 = *(const v4u*)(GK + row * 256 + h * 64 + 16 * ks), kw1 = *(const v4u*)(GK + row * 256 + h * 64 + 16 * ks + 8);
            const v4u qw0 = *(const v4u*)(GQ + row * 256 + h * 64 + 16 * ks), qw1 = *(const v4u*)(GQ + row * 256 + h * 64 + 16 * ks + 8);
            const float vv = bf2f(GV[row * 512 + h * 128 + v]);
            const f32x4 a0 = *(const f32x4*)ap, a1 = *(const f32x4*)(ap + 4), a2 = *(const f32x4*)(ap + 8), a3 = *(const f32x4*)(ap + 12);
            const float la[16] = {a0.x, a0.y, a0.z, a0.w, a1.x, a1.y, a1.z, a1.w, a2.x, a2.y, a2.z, a2.w, a3.x, a3.y, a3.z, a3.w};
            const float kk[16] = {bflo(kw0.x), bfhi(kw0.x), bflo(kw0.y), bfhi(kw0.y), bflo(kw0.z), bfhi(kw0.z), bflo(kw0.w), bfhi(kw0.w), bflo(kw1.x), bfhi(kw1.x), bflo(kw1.y), bfhi(kw1.y), bflo(kw1.z), bfhi(kw1.z), bflo(kw1.w), bfhi(kw1.w)};
            const float qq[16] = {bflo(qw0.x), bfhi(qw0.x), bflo(qw0.y), bfhi(qw0.y), bflo(qw0.z), bfhi(qw0.z), bflo(qw0.w), bfhi(qw0.w), bflo(qw1.x), bfhi(qw1.x), bflo(qw1.y), bfhi(qw1.y), bflo(qw1.z), bfhi(qw1.z), bflo(qw1.w), bfhi(qw1.w)};
            float o = 0.f;
#pragma unroll
            for (int i = 0; i < 16; ++i) { S[i] = fast_exp2(la[i] * 1.4426950408889634f) * S[i] + kk[i] * vv; o += qq[i] * S[i]; }
            part[(tt * 4 + ks) * 128 + v] = o;
        }
        __syncthreads();
        for (int e = tid; e < nb * 128; e += 512) { const int tt = e >> 7, vv_ = e & 127;
            GO[(size_t)(row0 + t0 + tt) * 512 + h * 128 + vv_] = (bf16)f2bf((part[(tt * 4 + 0) * 128 + vv_] + part[(tt * 4 + 1) * 128 + vv_]) + (part[(tt * 4 + 2) * 128 + vv_] + part[(tt * 4 + 3) * 128 + vv_])); }
    }
#pragma unroll
    for (int i = 0; i < 16; ++i) Sout[(size_t)(16 * ks + i) * 128 + v] = S[i];
}
constexpr int GL_QE = 0, GL_KE = 8192, GL_KDT = 16384, GL_VV = 24576, GL_EB = 40960, GL_TOT = 41216, GL_SET = 43264;
__device__ __forceinline__ int goff(int r, int c) { return 128 * r + 16 * (c ^ ((r >> 1) & 7)); }
__device__ __forceinline__ int gvoff(int row, int ch) { return 256 * row + 16 * (ch ^ (((row & 3) | ((((row >> 2) ^ (row >> 3)) & 1) << 2)) << 1)); }
__device__ __forceinline__ void p4_gla_chain_mfma(const Frame& F, int c) {
    unsigned char* ws = F.ws; const int tid = F.tid, lane = F.lane, w = F.wave, l15 = lane & 15, g4 = lane >> 4, q4 = l15 >> 2, p4 = lane & 3;
    const int b = c >> 2, h = c & 3; const size_t row0 = (size_t)b * SEQ;
    const float* GA = (const float*)(ws + WS_GA) + h * 64 + lane; const bf16* GQ = (const bf16*)(ws + WS_GQ) + h * 64 + lane; const bf16* GK = (const bf16*)(ws + WS_GK) + h * 64 + lane;
    const bf16* GV = (const bf16*)(ws + WS_GV) + h * 128 + (tid & 15) * 8; bf16* GO = (bf16*)(ws + WS_GO) + h * 128 + 16 * w + 4 * g4;
    constexpr float L2E = 1.4426950408889634f;
    f32x4 S[4];
#pragma unroll
    for (int K = 0; K < 4; ++K) S[K] = (f32x4){0.f, 0.f, 0.f, 0.f};
    float la[8]; unsigned short qh[8], kh[8]; v4u vr[2];
#define GLA_LOAD(ch) do { const size_t r_ = row0 + 64 * (size_t)(ch); \
        _Pragma("unroll") for (int t = 0; t < 8; ++t) { const size_t rr_ = (r_ + 8 * w + t) * 256; la[t] = GA[rr_]; qh[t] = GQ[rr_]; kh[t] = GK[rr_]; } \
        _Pragma("unroll") for (int e = 0; e < 2; ++e) vr[e] = *(const v4u*)(GV + (r_ + (tid >> 4) + 32 * e) * 512); } while (0)
    GLA_LOAD(0);
#pragma unroll 1
    for (int ch = 0; ch < SEQ / 64; ++ch) {
        LAS unsigned char* B = F.lds + RING_OFF + (ch & 1) * GL_SET;
        LAS float* TOT = (LAS float*)(B + GL_TOT); LAS float* EB = (LAS float*)(B + GL_EB);
        float cs[8], qv[8], kvv[8];
        cs[0] = la[0];
#pragma unroll
        for (int t = 1; t < 8; ++t) cs[t] = cs[t - 1] + la[t];
#pragma unroll
        for (int t = 0; t < 8; ++t) { qv[t] = bf2f(qh[t]); kvv[t] = bf2f(kh[t]); }
        TOT[w * 64 + lane] = cs[7];
#pragma unroll
        for (int e = 0; e < 2; ++e) *(LAS v4u*)(B + GL_VV + gvoff((tid >> 4) + 32 * e, tid & 15)) = vr[e];
        __syncthreads();
        float offs = 0.f, total = 0.f;
#pragma unroll
        for (int g = 0; g < 8; ++g) { const float tg = TOT[g * 64 + lane]; total += tg; offs += (g < w) ? tg : 0.f; }
        unsigned kd[8];
#pragma unroll
        for (int t = 0; t < 8; ++t) { const float bt = offs + cs[t]; const int i = 8 * w + t;
            const float e1 = fast_exp2(bt * L2E), e2 = fast_exp2(-bt * L2E), e3 = fast_exp2((total - bt) * L2E);
            *(LAS unsigned short*)(B + GL_QE + goff(i, lane >> 3) + 2 * (lane & 7)) = (unsigned short)f2bf(qv[t] * e1);
            *(LAS unsigned short*)(B + GL_KE + goff(i, lane >> 3) + 2 * (lane & 7)) = (unsigned short)f2bf(kvv[t] * e2);
            kd[t] = f2bf(kvv[t] * e3); }
        { v4u kw; kw.x = kd[0] | (kd[1] << 16); kw.y = kd[2] | (kd[3] << 16); kw.z = kd[4] | (kd[5] << 16); kw.w = kd[6] | (kd[7] << 16); *(LAS v4u*)(B + GL_KDT + goff(lane, w)) = kw; }
        if (w == 0) EB[lane] = fast_exp2(total * L2E);
        if (ch + 1 < SEQ / 64) GLA_LOAD(ch + 1);
        __syncthreads();
        const LAS unsigned char* QE = B + GL_QE; const LAS unsigned char* KE = B + GL_KE; const LAS unsigned char* KDT = B + GL_KDT; const LAS unsigned char* VV = B + GL_VV;
        bf16x8 kef[4][2];
#pragma unroll
        for (int J = 0; J < 4; ++J)
#pragma unroll
            for (int s = 0; s < 2; ++s) kef[J][s] = *(const LAS bf16x8*)(KE + goff(16 * J + l15, 4 * s + g4));
        bf16x8 vpr[2], vnat[2];
#pragma unroll
        for (int pp = 0; pp < 2; ++pp) { const int ra = 32 * pp + 4 * g4 + q4, rb = ra + 16;
            const s16x4 t1 = vtr(VV + gvoff(ra, 2 * w + (p4 >> 1)) + 8 * (p4 & 1)), t2 = vtr(VV + gvoff(rb, 2 * w + (p4 >> 1)) + 8 * (p4 & 1));
            vpr[pp] = (bf16x8){t1[0], t1[1], t1[2], t1[3], t2[0], t2[1], t2[2], t2[3]}; }
#pragma unroll
        for (int s = 0; s < 2; ++s) { const int r1 = 32 * s + 8 * g4 + q4, r2 = r1 + 4;
            const s16x4 t1 = vtr(VV + gvoff(r1, 2 * w + (p4 >> 1)) + 8 * (p4 & 1)), t2 = vtr(VV + gvoff(r2, 2 * w + (p4 >> 1)) + 8 * (p4 & 1));
            vnat[s] = (bf16x8){t1[0], t1[1], t1[2], t1[3], t2[0], t2[1], t2[2], t2[3]}; }
        bf16x8 sfr[2];
#pragma unroll
        for (int p = 0; p < 2; ++p) { v4u sw; sw.x = cvt_pk_bf16(S[2 * p].x, S[2 * p].y); sw.y = cvt_pk_bf16(S[2 * p].z, S[2 * p].w); sw.z = cvt_pk_bf16(S[2 * p + 1].x, S[2 * p + 1].y); sw.w = cvt_pk_bf16(S[2 * p + 1].z, S[2 * p + 1].w); sfr[p] = __builtin_bit_cast(bf16x8, sw); }
#pragma unroll
        for (int I = 0; I < 4; ++I) {
            f32x4 oT = (f32x4){0.f, 0.f, 0.f, 0.f};
#pragma unroll
            for (int p = 0; p < 2; ++p) {
                const v2u lo = *(const LAS v2u*)(QE + goff(16 * I + l15, 4 * p + (g4 >> 1)) + 8 * (g4 & 1)), hi = *(const LAS v2u*)(QE + goff(16 * I + l15, 4 * p + 2 + (g4 >> 1)) + 8 * (g4 & 1));
                const v4u bw = {lo.x, lo.y, hi.x, hi.y};
                oT = __builtin_amdgcn_mfma_f32_16x16x32_bf16(sfr[p], __builtin_bit_cast(bf16x8, bw), oT, 0, 0, 0); }
            bf16x8 qef[2];
#pragma unroll
            for (int s = 0; s < 2; ++s) qef[s] = *(const LAS bf16x8*)(QE + goff(16 * I + l15, 4 * s + g4));
            f32x4 d1[4];
#pragma unroll
            for (int J = 0; J < 4; ++J) { d1[J] = (f32x4){0.f, 0.f, 0.f, 0.f};
                if (J <= I) {
#pragma unroll
                    for (int s = 0; s < 2; ++s) d1[J] = __builtin_amdgcn_mfma_f32_16x16x32_bf16(kef[J][s], qef[s], d1[J], 0, 0, 0);
                    if (J == I) {
#pragma unroll
                        for (int r = 0; r < 4; ++r) d1[J][r] = (4 * g4 + r <= l15) ? d1[J][r] : 0.f; } } }
#pragma unroll
            for (int pp = 0; pp < 2; ++pp) if (2 * pp <= I) {
                const f32x4 pa = d1[2 * pp], pb = d1[2 * pp + 1];
                v4u pw; pw.x = cvt_pk_bf16(pa.x, pa.y); pw.y = cvt_pk_bf16(pa.z, pa.w); pw.z = cvt_pk_bf16(pb.x, pb.y); pw.w = cvt_pk_bf16(pb.z, pb.w);
                oT = __builtin_amdgcn_mfma_f32_16x16x32_bf16(vpr[pp], __builtin_bit_cast(bf16x8, pw), oT, 0, 0, 0); }
            { v2u ow; ow.x = cvt_pk_bf16(oT.x, oT.y); ow.y = cvt_pk_bf16(oT.z, oT.w); *(v2u*)(GO + (row0 + 64 * (size_t)ch + 16 * I + l15) * 512) = ow; }
        }
#pragma unroll
        for (int K = 0; K < 4; ++K) {
            const f32x4 ebv = *(const LAS f32x4*)(EB + 16 * K + 4 * g4); S[K] *= ebv;
#pragma unroll
            for (int s = 0; s < 2; ++s) { const bf16x8 kdf = *(const LAS bf16x8*)(KDT + goff(16 * K + l15, 4 * s + g4)); S[K] = __builtin_amdgcn_mfma_f32_16x16x32_bf16(kdf, vnat[s], S[K], 0, 0, 0); } }
    }
#undef GLA_LOAD
    float* so = F.out + O_GLAP + (size_t)c * 64 * 128 + 16 * w + l15;
#pragma unroll
    for (int K = 0; K < 4; ++K)
#pragma unroll
        for (int r = 0; r < 4; ++r) so[(size_t)(16 * K + 4 * g4 + r) * 128] = S[K][r];
}
template <int NR> __device__ __forceinline__ void p5_combine_rows(const Frame& F, int row0, int rstride) {
    unsigned char* ws = F.ws; const int lane = F.lane, hh = lane >> 4, sub = lane & 15, col = hh * 128 + 8 * sub;
    float l0[NR], l1[NR], l2[NR]; v4u a[NR], b[NR], c[NR], gow[NR], gr[NR];
    const float* gg = F.i15 + 8 * sub; const f32x4 g0 = *(const f32x4*)gg, g1 = *(const f32x4*)(gg + 4);
#pragma unroll
    for (int r = 0; r < NR; ++r) { const int row = row0 + r * rstride;
        const float* lse = (const float*)(ws + WS_LSE) + (size_t)row * 12; l0[r] = lse[hh]; l1[r] = lse[4 + hh]; l2[r] = lse[8 + hh];
        const bf16* og = (const bf16*)(ws + WS_OG) + (size_t)row * 1536 + col; a[r] = *(const v4u*)og; b[r] = *(const v4u*)(og + 512); c[r] = *(const v4u*)(og + 1024);
        gow[r] = *(const v4u*)((const bf16*)(ws + WS_GO) + (size_t)row * 512 + col); gr[r] = *(const v4u*)((const bf16*)(ws + WS_GRS) + (size_t)row * 512 + col); }
#pragma unroll
    for (int r = 0; r < NR; ++r) { const int row = row0 + r * rstride;
        const float mx = fmaxf(l0[r], fmaxf(l1[r], l2[r]));
        float w0 = __expf(l0[r] - mx), w1 = __expf(l1[r] - mx), w2 = __expf(l2[r] - mx); const float wi = 1.0f / (w0 + w1 + w2); w0 *= wi; w1 *= wi; w2 *= wi;
        v4u o;
        o.x = cvt_pk_bf16(w0 * bflo(a[r].x) + w1 * bflo(b[r].x) + w2 * bflo(c[r].x), w0 * bfhi(a[r].x) + w1 * bfhi(b[r].x) + w2 * bfhi(c[r].x));
        o.y = cvt_pk_bf16(w0 * bflo(a[r].y) + w1 * bflo(b[r].y) + w2 * bflo(c[r].y), w0 * bfhi(a[r].y) + w1 * bfhi(b[r].y) + w2 * bfhi(c[r].y));
        o.z = cvt_pk_bf16(w0 * bflo(a[r].z) + w1 * bflo(b[r].z) + w2 * bflo(c[r].z), w0 * bfhi(a[r].z) + w1 * bfhi(b[r].z) + w2 * bfhi(c[r].z));
        o.w = cvt_pk_bf16(w0 * bflo(a[r].w) + w1 * bflo(b[r].w) + w2 * bflo(c[r].w), w0 * bfhi(a[r].w) + w1 * bfhi(b[r].w) + w2 * bfhi(c[r].w));
        bf16* oall = (bf16*)(ws + WS_OALL) + (size_t)row * 1536;
        *(v4u*)(oall + col) = o;
        const f32x4 x0 = {bflo(gow[r].x), bfhi(gow[r].x), bflo(gow[r].y), bfhi(gow[r].y)}, x1 = {bflo(gow[r].z), bfhi(gow[r].z), bflo(gow[r].w), bfhi(gow[r].w)};
        float ss = (x0.x * x0.x + x0.y * x0.y) + (x0.z * x0.z + x0.w * x0.w) + (x1.x * x1.x + x1.y * x1.y) + (x1.z * x1.z + x1.w * x1.w);
        ss += __shfl_xor(ss, 1); ss += __shfl_xor(ss, 2); ss += __shfl_xor(ss, 4); ss += __shfl_xor(ss, 8);
        const float rstd = 1.0f / sqrtf(ss * (1.f / 128.f) + EPS);
        v4u y;
        y.x = cvt_pk_bf16(x0.x * rstd * g0.x * bflo(gr[r].x), x0.y * rstd * g0.y * bfhi(gr[r].x)); y.y = cvt_pk_bf16(x0.z * rstd * g0.z * bflo(gr[r].y), x0.w * rstd * g0.w * bfhi(gr[r].y));
        y.z = cvt_pk_bf16(x1.x * rstd * g1.x * bflo(gr[r].z), x1.y * rstd * g1.y * bfhi(gr[r].z)); y.w = cvt_pk_bf16(x1.z * rstd * g1.z * bflo(gr[r].w), x1.w * rstd * g1.w * bfhi(gr[r].w));
        *(v4u*)(oall + 512 + col) = y; }
}
template <int NR> __device__ __forceinline__ void p10_final_rows(const Frame& F, int row0, int rstride) {
    const GAS f32x4* gr = (const GAS f32x4*)F.i24 + 2 * F.lane; const f32x4 g00 = gr[0], g01 = gr[1], g10 = gr[128], g11 = gr[129];
    v4u v[NR][2];
#pragma unroll
    for (int r = 0; r < NR; ++r) { const GAS v4u* xr = (const GAS v4u*)((const bf16*)(F.ws + WS_Y16) + (size_t)(row0 + r * rstride) * D) + F.lane; v[r][0] = xr[0]; v[r][1] = xr[64]; }
#pragma unroll
    for (int r = 0; r < NR; ++r) { float x[2][8]; float s = 0.f;
#pragma unroll
        for (int j = 0; j < 2; ++j) { x[j][0] = bflo(v[r][j].x); x[j][1] = bfhi(v[r][j].x); x[j][2] = bflo(v[r][j].y); x[j][3] = bfhi(v[r][j].y); x[j][4] = bflo(v[r][j].z); x[j][5] = bfhi(v[r][j].z); x[j][6] = bflo(v[r][j].w); x[j][7] = bfhi(v[r][j].w);
#pragma unroll
            for (int e = 0; e < 8; ++e) s += x[j][e] * x[j][e]; }
        const float rstd = 1.0f / sqrtf(wave_sum(s) * (1.f / D) + EPS);
        GAS f32x4* yr = (GAS f32x4*)(F.out + (size_t)(row0 + r * rstride) * D) + 2 * F.lane;
        yr[0] = (f32x4){x[0][0] * rstd * g00.x, x[0][1] * rstd * g00.y, x[0][2] * rstd * g00.z, x[0][3] * rstd * g00.w};
        yr[1] = (f32x4){x[0][4] * rstd * g01.x, x[0][5] * rstd * g01.y, x[0][6] * rstd * g01.z, x[0][7] * rstd * g01.w};
        yr[128] = (f32x4){x[1][0] * rstd * g10.x, x[1][1] * rstd * g10.y, x[1][2] * rstd * g10.z, x[1][3] * rstd * g10.w};
        yr[129] = (f32x4){x[1][4] * rstd * g11.x, x[1][5] * rstd * g11.y, x[1][6] * rstd * g11.z, x[1][7] * rstd * g11.w}; }
}
__device__ __forceinline__ void phase1(Frame& F) {
    unsigned char* ws = F.ws; const int G = F.G, bx = (int)blockIdx.x;
    { pg8::Gemm g{(const bf16*)(ws + WS_XB), (const bf16*)(ws + WS_W1A), MR, 2 * FF, D, D, D}; typedef pg8::StaticOrderT<MR / 256, 2 * FF / 256> SO; SO S; S.init(MR, 2 * FF, G, bx);
      EpiSwiglu E{(bf16*)(ws + WS_G), nullptr}; pg8::gemm_phase<EpiSwiglu, SO>(F.lds + RING_OFF, g, S, E, F.wave, MK_STAGGER_A); }
    { pg8::Gemm g{(const bf16*)(ws + WS_MEMB), (const bf16*)(ws + WS_WMEM), MM, D, D, D, D}; typedef pg8::StaticOrderT<MM / 256, D / 256> SO; SO S; S.init(MM, D, G, (bx + G / 2) % G);
      EpiMemKV E{F.out + O_MEMKV, (bf16*)(ws + WS_MKV)}; pg8::gemm_phase<EpiMemKV, SO>(F.lds + RING_OFF, g, S, E, F.wave); }
}
__device__ __forceinline__ void phase2(Frame& F) {
    unsigned char* ws = F.ws; const int G = F.G, bx = (int)blockIdx.x;
    pg8::Gemm g{(const bf16*)(ws + WS_G), (const bf16*)(ws + WS_W1O), MR, D, FF, 64, FF};   typedef pg8::StaticOrderT<MR / 256, D / 256> SO; SO S; S.init(MR, D, G, bx);
    EpiResidX<true> E{F.i0, F.i1, (bf16*)(ws + WS_HB), (float*)(ws + WS_PQ1), 0.5f};
    S.lim = 1024; S.rev = 1; pg8::gemm_phase<EpiResidX<true>, SO, true, true>(F.lds + RING_OFF, g, S, E, F.wave);
    tail_phase<EpiResidX<true>, true>(F, g.A, 64, g.Bt, FF, FF, E, 0);
}
__device__ __forceinline__ void phase3(Frame& F) {
    unsigned char* ws = F.ws; const int G = F.G, bx = (int)blockIdx.x;
    pg8::Gemm g{(const bf16*)(ws + WS_HB), (const bf16*)(ws + WS_WIN), MR, NZ, D, D, D}; typedef pg8::StaticOrderT<MR / 256, NZ / 256> SO; SO S; S.init(MR, NZ, G, bx);
    EpiZ E{(const float*)(ws + WS_PQ1), (const float*)(ws + WS_ROPE), (const float*)(ws + WS_ROPE) + NPOS * 64, F.i14, F.out,
           (bf16*)(ws + WS_QS), (bf16*)(ws + WS_KS), (bf16*)(ws + WS_VS), (bf16*)(ws + WS_GQ), (bf16*)(ws + WS_GK), (bf16*)(ws + WS_GV), (bf16*)(ws + WS_GRS), (bf16*)(ws + WS_MQ), (bf16*)(ws + WS_GATE), (float*)(ws + WS_GA)};
    pg8::gemm_phase<EpiZ, SO>(F.lds + RING_OFF, g, S, E, F.wave, MK_STAGGER_Z);
}
constexpr int CW_Q = 64;
__device__ __forceinline__ int q_pull(const Frame& F, int q) {
    gu32* qw = (gu32*)(F.ws + WS_CTL) + CW_Q + 64 * q;
    volatile LAS unsigned* slot = (volatile LAS unsigned*)(F.lds + MISC_OFF) + 16;
    __syncthreads();
    if (F.tid == 0) *slot = __hip_atomic_fetch_add(qw, 1u, RLX_AGENT);
    __syncthreads();
    return (int)*slot;
}
__device__ __forceinline__ void phase4(Frame& F, const float* c0, const float* c1, const float* c2, const float* cm) {
    const int bx = (int)blockIdx.x;
    if (bx < NB * 4) p4_gla_chain_mfma(F, bx);
    else p4_sample_loop(F, c0, c1, c2, cm);
#pragma unroll 1
    for (int rep = 0; rep < (MK_P4_REPEAT == 2 ? 2 : 1); ++rep) for (;;) { const int it = q_pull(F, 1 + 4 * rep); if (it >= 768) break; attn_batch<0, 8>(F, 8 * (767 - it)); }
#pragma unroll 1
    for (int rep = 0; rep < (MK_P4_REPEAT == 3 ? 2 : 1); ++rep) for (;;) { const int it = q_pull(F, 2 + 4 * rep); if (it >= 256) break; attn_batch<1, 8>(F, 6144 + 8 * (255 - it)); }
    p4_sample_loop(F, c0, c1, c2, cm);
    if (MK_P4_REPEAT == 1) { __syncthreads(); p4_sample_loop(F, c0, c1, c2, cm, 4); }
    if (MK_P4_REPEAT == 4) { __syncthreads(); if (bx < NB * 4) p4_gla_chain_mfma(F, bx); }
    if (MK_P4_REPEAT == 5) { for (;;) { const int c = q_pull(F, 7); if (c >= DECB * 4) break; p4_gla_chain(F, MP + (c >> 2) * DECT, DECT, c & 3, F.i7 + (size_t)c * 64 * 128, F.out + O_GLAS + (size_t)c * 64 * 128); } }
    for (;;) { const int c = q_pull(F, 3); if (c >= DECB * 4) break; p4_gla_chain(F, MP + (c >> 2) * DECT, DECT, c & 3, F.i7 + (size_t)c * 64 * 128, F.out + O_GLAS + (size_t)c * 64 * 128); }
    if (F.G < NB * 4) { for (int c = F.G + bx; c < NB * 4; c += F.G) p4_gla_chain_mfma(F, c); }
}
__device__ __forceinline__ void phase5(Frame& F) {
    { const int st = F.G * NWAVES; int m = F.vcu * NWAVES + F.wave;
      for (; m + 3 * st < MR; m += 4 * st) p5_combine_rows<4>(F, m, st);
      for (; m < MR; m += st) p5_combine_rows<1>(F, m, st); }
}
__device__ __forceinline__ void phase6(Frame& F) {
    unsigned char* ws = F.ws; const int G = F.G, bx = (int)blockIdx.x;
    pg8::Gemm g{(const bf16*)(ws + WS_OALL), (const bf16*)(ws + WS_WBR), MR, D, 1536, 1536, 1536}; typedef pg8::StaticOrderT<MR / 256, D / 256> SO; SO S; S.init(MR, D, G, bx);
    S.rev = 1; EpiMerge1 E{(const bf16*)(ws + WS_GATE), (bf16*)(ws + WS_MB)}; pg8::gemm_phase<EpiMerge1, SO>(F.lds + RING_OFF, g, S, E, F.wave);
}
__device__ __forceinline__ void phase7(Frame& F) {
    unsigned char* ws = F.ws; const int G = F.G, bx = (int)blockIdx.x;
    pg8::Gemm g{(const bf16*)(ws + WS_MB), (const bf16*)(ws + WS_WOUT), MR, D, D, D, D}; typedef pg8::StaticOrderT<MR / 256, D / 256> SO; SO S; S.init(MR, D, G, bx);
    EpiResidB<true> E{(const bf16*)(ws + WS_HB), (bf16*)(ws + WS_HB), (float*)(ws + WS_PQ2), 1.0f};
    S.lim = 1024; pg8::gemm_phase<EpiResidB<true>, SO>(F.lds + RING_OFF, g, S, E, F.wave);
    tail_phase<EpiResidB<true>>(F, g.A, D, g.Bt, D, D, E, 1);
}
__device__ __forceinline__ void phase8(Frame& F) {
    unsigned char* ws = F.ws; const int G = F.G, bx = (int)blockIdx.x;
    pg8::Gemm g{(const bf16*)(ws + WS_HB), (const bf16*)(ws + WS_W2A), MR, 2 * FF, D, D, D}; typedef pg8::StaticOrderT<MR / 256, 2 * FF / 256> SO; SO S; S.init(MR, 2 * FF, G, bx);
    EpiSwiglu E{(bf16*)(ws + WS_G), (const float*)(ws + WS_PQ2)}; pg8::gemm_phase<EpiSwiglu, SO>(F.lds + RING_OFF, g, S, E, F.wave, MK_STAGGER_A);
}
__device__ __forceinline__ void phase9(Frame& F) {
    unsigned char* ws = F.ws; const int G = F.G, bx = (int)blockIdx.x;
    pg8::Gemm g{(const bf16*)(ws + WS_G), (const bf16*)(ws + WS_W2O), MR, D, FF, 64, FF};   typedef pg8::StaticOrderT<MR / 256, D / 256> SO; SO S; S.init(MR, D, G, bx);
    EpiResidB<false> E{(const bf16*)(ws + WS_HB), (bf16*)(ws + WS_Y16), nullptr, 0.5f};
    S.lim = 1024; S.rev = 1; pg8::gemm_phase<EpiResidB<false>, SO, true, true>(F.lds + RING_OFF, g, S, E, F.wave);
    tail_phase<EpiResidB<false>, true>(F, g.A, 64, g.Bt, FF, FF, E, 2);
}
__device__ __forceinline__ void phase10(Frame& F) {
    { const int st = F.G * NWAVES; int m = F.vcu * NWAVES + F.wave;
      for (; m + 3 * st < MR; m += 4 * st) p10_final_rows<4>(F, m, st);
      for (; m < MR; m += st) p10_final_rows<1>(F, m, st); }
}
__device__ __forceinline__ void xcd_barrier_or_skip(const XcdBarrier& b, bool on, int wave) { if (on) xcd_barrier(b, wave); }
constexpr int N_PHASES = 11;
__global__ void __launch_bounds__(NWAVES * 64, 2) mk_fwd(Args args) {
    extern __shared__ __attribute__((aligned(16))) unsigned char lds[];
    Frame F;
    F.lds = (LAS unsigned char*)lds;
    F.wave = __builtin_amdgcn_readfirstlane((int)(threadIdx.x >> 6)); F.lane = lane_id(); F.tid = F.wave * 64 + F.lane;
    F.G = gridDim.x; { const int bx = blockIdx.x; F.vcu = (F.G % 8 == 0) ? (bx % 8) * (F.G / 8) + bx / 8 : bx; }
    F.i0 = args.in[0]; F.i1 = args.in[1]; F.i2 = args.in[2]; F.i3 = args.in[3]; F.i4 = args.in[4]; F.i5 = args.in[5]; F.i6 = args.in[6]; F.i7 = args.in[7]; F.i8 = args.in[8]; F.i9 = args.in[9]; F.i10 = args.in[10]; F.i11 = args.in[11]; F.i12 = args.in[12]; F.i13 = args.in[13]; F.i14 = args.in[14]; F.i15 = args.in[15]; F.i16 = args.in[16]; F.i17 = args.in[17]; F.i18 = args.in[18]; F.i19 = args.in[19]; F.i20 = args.in[20]; F.i21 = args.in[21]; F.i22 = args.in[22]; F.i23 = args.in[23]; F.i24 = args.in[24];
    F.out = args.out; F.ws = args.ws;
    unsigned char* ws = args.ws; gu32* ctl = (gu32*)(ws + WS_CTL);
    volatile LAS unsigned* MISC = (volatile LAS unsigned*)(F.lds + MISC_OFF);
    for (int u = F.tid; u < (LDS_BYTES - LDSCTL_OFF) / 4; u += NWAVES * 64) ((LAS unsigned*)(F.lds + LDSCTL_OFF))[u] = 0u;
    __syncthreads();
    XcdBarrier bar; bar.bar = (unsigned*)(ctl + CW_BAR); bar.x = 0; bar.st = nullptr;
    if (MK_N_LAUNCHES == 1) bar = xcd_barrier_post((unsigned*)(ctl + CW_BAR), MISC + 8, F.wave);
    const int lo = args.ph_lo, hi = args.ph_hi;
#define IN(k) (lo <= (k) && (k) < hi && (k) <= MK_STOP_AFTER)
#define GRID_BAR(k) do { if (IN((k) + 1)) xcd_barrier(bar, F.wave); } while (0)

#define RUN(k, call) do { if (IN(k)) { F.lane = lane_id(); F.tid = F.wave * 64 + F.lane; call; if (MK_REPEAT_PHASE == (k)) { xcd_barrier_or_skip(bar, MK_N_LAUNCHES == 1, F.wave); call; } GRID_BAR(k); } } while (0)
    RUN(0, p0_prologue(F));
    RUN(1, phase1(F));
    RUN(2, phase2(F));
    RUN(3, phase3(F));
    RUN(4, phase4(F, args.in[3], args.in[4], args.in[5], args.in[6]));
    RUN(5, phase5(F));
    RUN(6, phase6(F));
    RUN(7, phase7(F));
    RUN(8, phase8(F));
    RUN(9, phase9(F));
    if (IN(10)) { F.lane = lane_id(); F.tid = F.wave * 64 + F.lane; phase10(F); }
#undef RUN
#if MK_STOP_AFTER < 10
    if (hi == N_PHASES) {
        for (int m = F.vcu * NWAVES + F.wave; m < MR; m += G * NWAVES) {
            for (int c = F.lane; c < D; c += 64) {
                float v;
                if (MK_STOP_AFTER == 0) v = bf2f(((const bf16*)(ws + WS_WIN))[(size_t)(m % NZ) * D + c]);
                else if (MK_STOP_AFTER == 3) { const bf16* gt = (const bf16*)(ws + WS_GATE) + (size_t)m * 3072; v = bf2f(gt[c]) + bf2f(gt[1024 + c]) + bf2f(gt[2048 + c]); }
                else if (MK_STOP_AFTER <= 5) { const bf16* oa = (const bf16*)(ws + WS_OALL) + (size_t)m * 1536; v = bf2f(oa[c]) + bf2f(oa[1024 + (c & 511)]); }
                else if (MK_STOP_AFTER == 6) v = bf2f(((const bf16*)(ws + WS_MB))[(size_t)m * D + c]);
                else if (MK_STOP_AFTER == 7) v = ((const float*)(ws + WS_H))[(size_t)m * D + c];
                else v = bf2f(((const bf16*)(ws + WS_G))[(size_t)m * FF + c]) + bf2f(((const bf16*)(ws + WS_G))[(size_t)m * FF + 1792 + c]);
                F.out[(size_t)m * D + c] = v;
            }
        }
    }
#endif
#undef IN
#undef GRID_BAR
}

extern "C" void kernel_launch(void* const* d_in, const int* in_sizes, int n_in, void* d_out, int out_size, void* d_ws, size_t ws_size, hipStream_t stream) {
    static int grid = 0;
    if (grid == 0) {
        if (n_in != 25 || (size_t)out_size != O_END || ws_size < WS_END2) { fprintf(stderr, "kernel_launch: unexpected shapes: n_in %d out %d ws %zu (need %zu); nothing launched\n", n_in, out_size, ws_size, (size_t)WS_END2); grid = -1; return; }
        int dev = 0, cus = 0, per_cu = 0;
        if (hipGetDevice(&dev) != hipSuccess || hipDeviceGetAttribute(&cus, hipDeviceAttributeMultiprocessorCount, dev) != hipSuccess) { grid = -1; return; }
        if (hipFuncSetAttribute((const void*)mk_fwd, hipFuncAttributeMaxDynamicSharedMemorySize, LDS_BYTES) != hipSuccess) { fprintf(stderr, "kernel_launch: hipFuncSetAttribute failed\n"); grid = -1; return; }
        if (hipOccupancyMaxActiveBlocksPerMultiprocessor(&per_cu, (const void*)mk_fwd, NWAVES * 64, LDS_BYTES) != hipSuccess || per_cu < 1) fprintf(stderr, "kernel_launch: occupancy query reports %d\n", per_cu);
        (void)hipGetLastError();
        grid = cus;
    }
    if (grid < 0) return;
    if (hipMemsetAsync((char*)d_ws + WS_CTL, 0, CTL_ZERO_BYTES, stream) != hipSuccess) return;
    Args a{};
    for (int i = 0; i < 25; ++i) a.in[i] = (const float*)d_in[i];
    a.out = (float*)d_out; a.ws = (unsigned char*)d_ws; a.pad = 0;
    for (int li = 0; li < MK_N_LAUNCHES; ++li) {
        a.ph_lo = (MK_N_LAUNCHES == 1) ? 0 : li; a.ph_hi = (MK_N_LAUNCHES == 1) ? N_PHASES : li + 1; a.li = li;
        hipLaunchKernelGGL(mk_fwd, dim3(grid), dim3(NWAVES * 64), LDS_BYTES, stream, a);
        const hipError_t le = hipPeekAtLastError();
        if (le != hipSuccess) { fprintf(stderr, "kernel_launch: launch %d failed: %s\n", li, hipGetErrorName(le)); break; }
    }
}
```

```cpp
#include <hip/hip_runtime.h>
#include <cstdio>
#include <cstdint>

#ifndef MK_N_LAUNCHES
#define MK_N_LAUNCHES 1
#endif

#ifndef MK_REPEAT_PHASE
#define MK_REPEAT_PHASE -1
#endif
#ifndef MK_P4_REPEAT
#define MK_P4_REPEAT 0
#endif
#ifndef MK_STAGGER_A
#define MK_STAGGER_A 0
#endif
#ifndef MK_STAGGER_Z
#define MK_STAGGER_Z 0
#endif
#ifndef MK_STOP_AFTER
#define MK_STOP_AFTER 10
#endif
#define GAS __attribute__((address_space(1)))
#define LAS __attribute__((address_space(3)))
typedef unsigned short bf16;
typedef unsigned v4u __attribute__((ext_vector_type(4)));
typedef unsigned v2u __attribute__((ext_vector_type(2)));
typedef float f32x4 __attribute__((ext_vector_type(4)));
typedef float f32x2 __attribute__((ext_vector_type(2)));
typedef short bf16x8 __attribute__((ext_vector_type(8)));
typedef short s16x4 __attribute__((ext_vector_type(4)));
typedef GAS unsigned gu32;

__device__ __forceinline__ int lane_id() { return (int)__builtin_amdgcn_mbcnt_hi(~0u, __builtin_amdgcn_mbcnt_lo(~0u, 0u)); }
constexpr int D = 1024, NB = 32, SEQ = 2048, DECB = 128, DECT = 4, PAST = 8192, MEML = 256;
constexpr int MP = NB * SEQ;
constexpr int MS = DECB * DECT;
constexpr int MR = MP + MS;
constexpr int MM = NB * MEML;
constexpr int FF = 2816, NZ = 9984;
constexpr int DIN = 6672;
constexpr int NPOS = SEQ + DECT;
constexpr float EPS = 1e-6f;
constexpr float QSCALE = 0.08838834764831845f * 1.4426950408889634f;
constexpr float LN2 = 0.6931471805599453f;

constexpr size_t O_Y = 0, O_YS = (size_t)MP * D, O_SWA0P = O_YS + (size_t)MS * D, O_SWA1P = O_SWA0P + (size_t)NB * 128 * 1024, O_SWA2P = O_SWA1P + (size_t)NB * 512 * 1024,
                 O_MEMKV = O_SWA2P + (size_t)NB * 2048 * 1024, O_GLAP = O_MEMKV + (size_t)MM * 1024, O_SWA0S = O_GLAP + (size_t)NB * 4 * 64 * 128, O_SWA1S = O_SWA0S + (size_t)MS * 1024,
                 O_SWA2S = O_SWA1S + (size_t)MS * 1024, O_GLAS = O_SWA2S + (size_t)MS * 1024, O_END = O_GLAS + (size_t)DECB * 4 * 64 * 128;
static_assert(O_END == 170917888ull, "output size");

constexpr size_t MiB = 1u << 20;
constexpr size_t al(size_t x) { return (x + 2 * MiB - 1) / (2 * MiB) * (2 * MiB); }
constexpr size_t WS_CTL = 0, CTL_ZERO_BYTES = 1 * MiB;
constexpr size_t WS_ROPE = 2 * MiB;
constexpr size_t WS_PQ1 = WS_ROPE + al((size_t)NPOS * 64 * 4 * 2);
constexpr size_t WS_PQ2 = WS_PQ1 + al((size_t)MR * 16 * 4);
constexpr size_t WS_W1A = WS_PQ2 + al((size_t)MR * 16 * 4);
constexpr size_t WS_W1O = WS_W1A + al((size_t)2 * FF * D * 2);
constexpr size_t WS_WIN = WS_W1O + al((size_t)D * FF * 2);
constexpr size_t WS_WBR = WS_WIN + al((size_t)NZ * D * 2);
constexpr size_t WS_WOUT = WS_WBR + al((size_t)3 * D * 512 * 2);
constexpr size_t WS_W2A = WS_WOUT + al((size_t)D * D * 2);
constexpr size_t WS_W2O = WS_W2A + al((size_t)2 * FF * D * 2);
constexpr size_t WS_WMEM = WS_W2O + al((size_t)D * FF * 2);
constexpr size_t WS_XB = WS_WMEM + al((size_t)D * D * 2);
constexpr size_t WS_MEMB = WS_XB + al((size_t)MR * D * 2);
constexpr size_t WS_MKV = WS_MEMB + al((size_t)MM * D * 2);
constexpr size_t WS_G = WS_MKV + al((size_t)MM * D * 2);
constexpr size_t WS_H = WS_G + al((size_t)MR * FF * 2);
constexpr size_t WS_HB = WS_H + al((size_t)MR * D * 4);
constexpr size_t WS_QS = WS_HB + al((size_t)MR * D * 2);
constexpr size_t WS_KS = WS_QS + al((size_t)MR * 1536 * 2);
constexpr size_t WS_VS = WS_KS + al((size_t)MR * 1536 * 2);
constexpr size_t WS_GQ = WS_VS + al((size_t)MR * 1536 * 2);
constexpr size_t WS_GK = WS_GQ + al((size_t)MR * 256 * 2);
constexpr size_t WS_GV = WS_GK + al((size_t)MR * 256 * 2);
constexpr size_t WS_GRS = WS_GV + al((size_t)MR * 512 * 2);
constexpr size_t WS_GA = WS_GRS + al((size_t)MR * 512 * 2);
constexpr size_t WS_MQ = WS_GA + al((size_t)MR * 256 * 4);
constexpr size_t WS_GATE = WS_MQ + al((size_t)MR * 512 * 2);
constexpr size_t WS_OG = WS_GATE + al((size_t)MR * 3072 * 2);
constexpr size_t WS_LSE = WS_OG + al((size_t)MR * 1536 * 2);
constexpr size_t WS_GO = WS_LSE + al((size_t)MR * 12 * 4);
constexpr size_t WS_OALL = WS_GO + al((size_t)MR * 512 * 4);
constexpr size_t WS_END = WS_OALL + al((size_t)MR * 1536 * 2);
constexpr size_t WS_SLAB = WS_END; constexpr size_t WS_END2 = WS_SLAB + al((size_t)8 * 4 * 4 * 8 * 2048 * 4);
constexpr size_t WS_T = WS_G, WS_MB = WS_XB, WS_Y16 = WS_XB;
static_assert((size_t)MR * D * 4 <= (size_t)MR * FF * 2, "T fits in G");

constexpr int CW_TMO = 0, CW_CODE = 1, CW_BAR = 4096, CW_TAIL = 8192;

constexpr int RING_OFF = 0, RING_BYTES = 131072;
constexpr int LDSCTL_OFF = RING_BYTES, MISC_OFF = LDSCTL_OFF + 320;
constexpr int LDS_BYTES = 147456;
constexpr int NWAVES = 8;

#define RLX_AGENT __ATOMIC_RELAXED, __HIP_MEMORY_SCOPE_AGENT
#define LDS_WAIT() asm volatile("s_waitcnt lgkmcnt(0)" ::: "memory")
#define VM_WAIT() asm volatile("s_waitcnt vmcnt(0)" ::: "memory")
__device__ __forceinline__ unsigned f2bf(float f) { unsigned u = __builtin_bit_cast(unsigned, f); return (u + 0x7fffu + ((u >> 16) & 1u)) >> 16; }
__device__ __forceinline__ unsigned pk2(float lo, float hi) { return f2bf(lo) | (f2bf(hi) << 16); }
__device__ __forceinline__ float bf2f(unsigned b) { return __builtin_bit_cast(float, b << 16); }
__device__ __forceinline__ float bflo(unsigned w) { return __builtin_bit_cast(float, w << 16); }
__device__ __forceinline__ float bfhi(unsigned w) { return __builtin_bit_cast(float, w & 0xffff0000u); }
typedef __bf16 bf16x2_t __attribute__((ext_vector_type(2)));
__device__ __forceinline__ unsigned cvt_pk_bf16(float lo, float hi) { const f32x2 v = {lo, hi}; const bf16x2_t b = __builtin_convertvector(v, bf16x2_t); return __builtin_bit_cast(unsigned, b); }
__device__ __forceinline__ float fast_exp2(float x) { return __builtin_amdgcn_exp2f(x); }
__device__ __forceinline__ float fast_rcp(float x) { return __builtin_amdgcn_rcpf(x); }
__device__ __forceinline__ float fast_log2(float x) { return __builtin_amdgcn_logf(x); }
__device__ __forceinline__ float sigmoidf_(float x) { return fast_rcp(1.0f + fast_exp2(-1.4426950408889634f * x)); }
__device__ __forceinline__ float siluf_(float x) { return x * sigmoidf_(x); }
__device__ __forceinline__ int perm32(int rho) { return 8 * ((rho >> 2) & 3) + 4 * (rho >> 4) + (rho & 3); }
__device__ __forceinline__ int sig_plain(int r) { return (r & ~31) + perm32(r & 31); }
__device__ __forceinline__ int sig_rope(int r7) { return 64 * ((r7 >> 4) & 1) + 16 * (r7 >> 5) + 4 * ((r7 >> 2) & 3) + (r7 & 3); }

namespace pg8 {
constexpr int BM = 256, BK = 64, HALF = 128, HTB = HALF * BK * 2, STAGE_BYTES = 8 * HTB, NXCD = 8, WGM = 4;
__host__ __device__ __forceinline__ int lds_byte(int r, int c) { const int st = (r >> 4) * 2 + (c >> 5), rr = r & 15, cc = c & 31, ob = rr * 64 + cc * 2; return st * 1024 + (ob ^ (((ob >> 9) & 1) << 5)); }
__host__ __device__ __forceinline__ void stage_rc(int b, int& R, int& C) { const int st = b / 1024, sb = b % 1024, swz = sb ^ (((sb >> 9) & 1) << 5); R = (st >> 1) * 16 + swz / 64; C = (st & 1) * 32 + (swz % 64) / 2; }
struct Unit { int pm, pn; };
struct Gemm { const bf16* A; const bf16* Bt; int M, N, K, lda, ldb; };
constexpr size_t TILED_KS = (size_t)256 * 64 * 2, TILED_PANEL = (size_t)(2816 / 64) * TILED_KS;
template <int NM, int NN> struct StaticOrderT {
    int G, c, lim, rev;
    __host__ __device__ void init(int, int, int G_, int c_) { G = G_; c = c_; lim = NM * NN; rev = 0; }
    __host__ __device__ static __forceinline__ void unit_of(int L, Unit& u) {
        constexpr int nwg = NM * NN, q = nwg / NXCD, r = nwg % NXCD, nig = WGM * NN;
        const int xcd = L & (NXCD - 1), off = L >> 3;
        const int wgid = (xcd < r ? xcd * (q + 1) : r * (q + 1) + (xcd - r) * q) + off;
        const int gid = wgid / nig, x = wgid - gid * nig, fm = gid * WGM;
        if (NM % WGM == 0 || fm + WGM <= NM) { u.pm = fm + (x & (WGM - 1)); u.pn = x / WGM; }
        else { constexpr int gl = (NM % WGM) ? (NM % WGM) : WGM; u.pm = fm + x % gl; u.pn = x / gl; }
    }
    __host__ __device__ __forceinline__ bool next(int i, Unit& u) const { const int L = i * G + c; if (L >= lim) return false; unit_of(rev ? lim - 1 - L : L, u); return true; }
};
struct OneUnit { Unit u; int c; __host__ __device__ __forceinline__ bool next(int i, Unit& o) const { if (i) return false; o = u; return true; } };
template <class Epi, class Sched, bool ALIGN_EPI = true, bool ATILED = false>
__device__ __forceinline__ void gemm_phase(LAS unsigned char* lds, const Gemm g, const Sched& S, const Epi& E, const int wid, const int stagger_ticks = 0) {
    if (stagger_ticks > 0) { const unsigned long long t0 = __builtin_amdgcn_s_memrealtime(); const unsigned long long dl = (unsigned long long)(((S.c * 37) & 255) * stagger_ticks) >> 8;
        while (__builtin_amdgcn_s_memrealtime() - t0 < dl) __builtin_amdgcn_s_sleep(8); }
    const int lane = lane_id(), tid = wid * 64 + lane, wr = wid >> 2, wc = wid & 3, fr = lane & 15, fq = lane >> 4;
    const int K = g.K, nt = K / BK;
    unsigned voffA[2], voffB[2];
#pragma unroll
    for (int i = 0; i < 2; ++i) { int R, C; stage_rc(tid * 16 + i * 8192, R, C); voffA[i] = (unsigned)(R * g.lda + C) * 2u; voffB[i] = (unsigned)(R * g.ldb + C) * 2u; }
    const size_t kstep = (size_t)(BK * 2), kstepA = ATILED ? TILED_KS : kstep;
    const size_t hA = (size_t)HALF * g.lda * 2, tA = ATILED ? TILED_PANEL : 2 * hA, hB = (size_t)HALF * g.ldb * 2, tB = 2 * hB;
    const unsigned ldsw = (unsigned)wid * 1024u;
    const int aoff = lds_byte(wr * 64 + fr, fq * 8), boff = lds_byte(wc * 32 + fr, fq * 8);
#define PG8_SA(b, h) (((b) * 2 + (h)) * HTB)
#define PG8_SB(b, h) ((4 + (b) * 2 + (h)) * HTB)
#define PG8_STAGE(bufoff, gbase, voff) do { _Pragma("unroll") for (int _i = 0; _i < 2; ++_i) \
        __builtin_amdgcn_global_load_lds((const unsigned*)((const char*)(gbase) + (voff)[_i]), (LAS unsigned*)(lds + (bufoff) + ldsw + _i * 8192), 16, 0, 0); } while (0)
#define PG8_LDA(dst, b, h) do { _Pragma("unroll") for (int m = 0; m < 4; ++m) _Pragma("unroll") for (int k = 0; k < 2; ++k) dst[m][k] = *(const LAS bf16x8*)(lds + PG8_SA(b, h) + aoff + m * 2048 + k * 1024); } while (0)
#define PG8_LDB(dst, b, h) do { _Pragma("unroll") for (int n = 0; n < 2; ++n) _Pragma("unroll") for (int k = 0; k < 2; ++k) dst[n][k] = *(const LAS bf16x8*)(lds + PG8_SB(b, h) + boff + n * 2048 + k * 1024); } while (0)
#define PG8_MMA(ai, bj, At, Bt) do { __builtin_amdgcn_s_setprio(1); _Pragma("unroll") for (int m = 0; m < 4; ++m) _Pragma("unroll") for (int n = 0; n < 2; ++n) _Pragma("unroll") for (int k = 0; k < 2; ++k) \
        acc[ai][bj][m][n] = __builtin_amdgcn_mfma_f32_16x16x32_bf16(Bt[n][k], At[m][k], acc[ai][bj][m][n], 0, 0, 0); __builtin_amdgcn_s_setprio(0); } while (0)
#define PG8_WAIT_V(n) asm volatile("s_waitcnt vmcnt(" #n ")" ::: "memory")
#define PG8_WAIT_L(n) asm volatile("s_waitcnt lgkmcnt(" #n ")" ::: "memory")
#define PG8_BAR __builtin_amdgcn_s_barrier()
#define PG8_SCHED __builtin_amdgcn_sched_barrier(0)
    Unit cur, nxt; int ui = 0;
    if (!S.next(0, cur)) return;
    f32x4 acc[2][2][4][2];
#pragma unroll
    for (int a = 0; a < 2; ++a)
#pragma unroll
        for (int b = 0; b < 2; ++b)
#pragma unroll
            for (int m = 0; m < 4; ++m)
#pragma unroll
                for (int n = 0; n < 2; ++n) acc[a][b][m][n] = (f32x4){0.f, 0.f, 0.f, 0.f};
    bf16x8 At[4][2], B0[2][2], B1[2][2];
    const char* cA = (const char*)g.A + (size_t)cur.pm * tA; const char* cB = (const char*)g.Bt + (size_t)cur.pn * tB;
    PG8_STAGE(PG8_SB(0, 0), cB, voffB); PG8_STAGE(PG8_SB(0, 1), cB + hB, voffB); PG8_STAGE(PG8_SA(0, 0), cA, voffA); PG8_STAGE(PG8_SA(0, 1), cA + hA, voffA);
    if (wr == 1) PG8_BAR;
    PG8_WAIT_V(2); PG8_BAR;
    PG8_STAGE(PG8_SB(1, 0), cB + kstep, voffB); PG8_STAGE(PG8_SA(1, 0), cA + kstepA, voffA); PG8_STAGE(PG8_SB(1, 1), cB + hB + kstep, voffB);
    PG8_WAIT_V(6); PG8_BAR;
    for (;;) {
        const bool has_next = S.next(ui + 1, nxt);
        const char* nA = has_next ? (const char*)g.A + (size_t)nxt.pm * tA : cA; const char* nB = has_next ? (const char*)g.Bt + (size_t)nxt.pn * tB : cB;
        const int seg = Epi::HAS_MID ? 8 : nt;
        for (int t0 = 0; t0 < nt; t0 += seg) {
        if constexpr (Epi::HAS_MID) { if (t0) { PG8_SCHED; E.mid(acc, cur, t0, wr, wc, fr, fq); PG8_SCHED; } }
#pragma unroll 1
        for (int t = t0; t < t0 + seg; t += 2) {
            const bool last = (t == nt - 2);
            const char* a1 = cA + (size_t)(t + 1) * kstepA;
            const char* a2 = last ? nA : cA + (size_t)(t + 2) * kstepA; const char* b2 = last ? nB : cB + (size_t)(t + 2) * kstep;
            const char* a3 = a2 + kstepA; const char* b3 = b2 + kstep;
            PG8_LDB(B0, 0, 0); PG8_LDB(B1, 0, 1); PG8_SCHED; PG8_LDA(At, 0, 0); PG8_STAGE(PG8_SA(1, 1), a1 + hA, voffA);
            PG8_WAIT_V(8); PG8_WAIT_L(0); PG8_BAR; PG8_MMA(0, 0, At, B0); PG8_MMA(0, 1, At, B1); PG8_BAR; PG8_SCHED;
            PG8_LDA(At, 0, 1); PG8_STAGE(PG8_SB(0, 0), b2, voffB); PG8_STAGE(PG8_SB(0, 1), b2 + hB, voffB); PG8_STAGE(PG8_SA(0, 0), a2, voffA);
            PG8_WAIT_V(8); PG8_WAIT_L(0); PG8_BAR; PG8_MMA(1, 0, At, B0); PG8_MMA(1, 1, At, B1); PG8_BAR; PG8_SCHED;
            PG8_LDB(B0, 1, 0); PG8_LDB(B1, 1, 1); PG8_SCHED; PG8_LDA(At, 1, 0); PG8_STAGE(PG8_SA(0, 1), a2 + hA, voffA);
            PG8_WAIT_V(8); PG8_WAIT_L(0); PG8_BAR; PG8_MMA(0, 0, At, B0); PG8_MMA(0, 1, At, B1); PG8_BAR; PG8_SCHED;
            PG8_LDA(At, 1, 1); PG8_STAGE(PG8_SB(1, 0), b3, voffB); PG8_STAGE(PG8_SB(1, 1), b3 + hB, voffB); PG8_STAGE(PG8_SA(1, 0), a3, voffA);
            PG8_WAIT_V(8); PG8_WAIT_L(0); PG8_BAR; PG8_MMA(1, 0, At, B0); PG8_MMA(1, 1, At, B1); PG8_BAR; PG8_SCHED;
        }
        }
        if constexpr (ALIGN_EPI) { if (wr == 0) PG8_BAR; }
        E(acc, cur, wr, wc, fr, fq);
        if (!has_next) break;
#pragma unroll
        for (int a = 0; a < 2; ++a)
#pragma unroll
            for (int b = 0; b < 2; ++b)
#pragma unroll
                for (int m = 0; m < 4; ++m)
#pragma unroll
                    for (int n = 0; n < 2; ++n) acc[a][b][m][n] = (f32x4){0.f, 0.f, 0.f, 0.f};
        cur = nxt; cA = nA; cB = nB; ++ui;
        if constexpr (ALIGN_EPI) { if (wr == 1) PG8_BAR; }
    }
    PG8_WAIT_V(0);
    if constexpr (!ALIGN_EPI) { if (wr == 0) PG8_BAR; }
    PG8_BAR;
#undef PG8_SA
#undef PG8_SB
#undef PG8_STAGE
#undef PG8_LDA
#undef PG8_LDB
#undef PG8_MMA
#undef PG8_WAIT_V
#undef PG8_WAIT_L
#undef PG8_BAR
#undef PG8_SCHED
}
}
using pg8::Unit;

typedef const f32x4 (&AccRef)[2][2][4][2];
constexpr size_t G_KT = (size_t)256 * 64, G_PANEL = (FF / 64) * G_KT;
__device__ __forceinline__ size_t g_off(int row, int j) { return (size_t)(row >> 8) * G_PANEL + (size_t)(j >> 6) * G_KT + (size_t)(row & 255) * 64 + (j & 63); }
struct EpiSwiglu {
    static constexpr bool HAS_MID = false;
    bf16* G; const float* pq;
    __device__ __forceinline__ void operator()(AccRef acc, const Unit& u, int wr, int wc, int fr, int fq) const {
        const int row0 = u.pm * 256 + wr * 64 + fr;
        bf16* gb = G + ((size_t)u.pm * (FF / 64) + 2 * u.pn + (wc >> 1)) * G_KT + (size_t)((wr * 64 + fr) * 64 + (wc & 1) * 32 + 8 * fq);
        float sc[2][4];
#pragma unroll
        for (int ai = 0; ai < 2; ++ai)
#pragma unroll
            for (int m = 0; m < 4; ++m) { sc[ai][m] = 1.f;
                if (pq) { const f32x4 pv = *(const f32x4*)(pq + (size_t)(row0 + ai * 128 + m * 16) * 16 + 4 * fq); float t = (pv.x + pv.y) + (pv.z + pv.w); t += __shfl_xor(t, 16); t += __shfl_xor(t, 32); sc[ai][m] = __builtin_amdgcn_rsqf(t * (1.f / D) + EPS); } }
#pragma unroll
        for (int ai = 0; ai < 2; ++ai)
#pragma unroll
            for (int m = 0; m < 4; ++m) {
                const float s = sc[ai][m];
                float o[8];
#pragma unroll
                for (int n = 0; n < 2; ++n)
#pragma unroll
                    for (int i = 0; i < 4; ++i) { const float a = acc[ai][0][m][n][i] * s, b = acc[ai][1][m][n][i] * s; o[4 * n + i] = siluf_(a) * b; }
                v4u w; w.x = cvt_pk_bf16(o[0], o[1]); w.y = cvt_pk_bf16(o[2], o[3]); w.z = cvt_pk_bf16(o[4], o[5]); w.w = cvt_pk_bf16(o[6], o[7]);
                *(v4u*)(gb + (ai * 128 + m * 16) * 64) = w;
            }
    }
};
template <bool WRITE_PQ> struct EpiResidX {
    static constexpr bool HAS_MID = false;
    const float* baseP; const float* baseS; bf16* HB; float* pq; float scale;
    __device__ __forceinline__ void operator()(AccRef acc, const Unit& u, int wr, int wc, int fr, int fq) const {
        const int row0 = u.pm * 256 + wr * 64 + fr, c0 = u.pn * 256 + wc * 32 + 8 * fq; const bool smp = u.pm >= MP / 256;
        const float* bbase = (smp ? baseS : baseP) + (smp ? (size_t)(row0 - MP) * D : (size_t)row0 * D) + c0;
#pragma unroll
        for (int ai = 0; ai < 2; ++ai) {
            f32x4 bb[4][2][2];
#pragma unroll
            for (int m = 0; m < 4; ++m)
#pragma unroll
                for (int bj = 0; bj < 2; ++bj) { const float* bp = bbase + (size_t)(ai * 128 + m * 16) * D + bj * 128; bb[m][bj][0] = *(const f32x4*)bp; bb[m][bj][1] = *(const f32x4*)(bp + 4); }
#pragma unroll
            for (int m = 0; m < 4; ++m) {
                const int row = row0 + ai * 128 + m * 16; float ss = 0.f;
#pragma unroll
                for (int bj = 0; bj < 2; ++bj) {
                    const f32x4 o0 = bb[m][bj][0] + acc[ai][bj][m][0] * scale, o1 = bb[m][bj][1] + acc[ai][bj][m][1] * scale;
                    v4u w; w.x = cvt_pk_bf16(o0.x, o0.y); w.y = cvt_pk_bf16(o0.z, o0.w); w.z = cvt_pk_bf16(o1.x, o1.y); w.w = cvt_pk_bf16(o1.z, o1.w); *(v4u*)(HB + (size_t)row * D + c0 + bj * 128) = w;
                    if (WRITE_PQ) ss += (o0.x * o0.x + o0.y * o0.y) + (o0.z * o0.z + o0.w * o0.w) + (o1.x * o1.x + o1.y * o1.y) + (o1.z * o1.z + o1.w * o1.w);
                }
                if (WRITE_PQ) { ss += __shfl_xor(ss, 16); ss += __shfl_xor(ss, 32); if (fq == 0) pq[(size_t)row * 16 + u.pn * 4 + wc] = ss; }
            }
        }
    }
    template <int O> __device__ __forceinline__ void group(const f32x4 (&v)[8], const Unit& u, int wr, int wc, int fr, int fq) const {
        const int row0 = u.pm * 256 + wr * 64 + fr, c0 = u.pn * 256 + wc * 32 + 8 * fq; const bool smp = u.pm >= MP / 256;
        const float* bbase = (smp ? baseS : baseP) + (smp ? (size_t)(row0 - MP) * D : (size_t)row0 * D) + c0;
        f32x4 bb[2][2][2];
#pragma unroll
        for (int mm = 0; mm < 2; ++mm)
#pragma unroll
            for (int bj = 0; bj < 2; ++bj) { const float* bp = bbase + (size_t)((O >> 1) * 128 + (2 * (O & 1) + mm) * 16) * D + bj * 128; bb[mm][bj][0] = *(const f32x4*)bp; bb[mm][bj][1] = *(const f32x4*)(bp + 4); }
#pragma unroll
        for (int mm = 0; mm < 2; ++mm) { const int row = row0 + (O >> 1) * 128 + (2 * (O & 1) + mm) * 16; float ss = 0.f;
#pragma unroll
            for (int bj = 0; bj < 2; ++bj) {
                const f32x4 o0 = bb[mm][bj][0] + v[bj * 4 + mm * 2] * scale, o1 = bb[mm][bj][1] + v[bj * 4 + mm * 2 + 1] * scale;
                v4u w; w.x = cvt_pk_bf16(o0.x, o0.y); w.y = cvt_pk_bf16(o0.z, o0.w); w.z = cvt_pk_bf16(o1.x, o1.y); w.w = cvt_pk_bf16(o1.z, o1.w); *(v4u*)(HB + (size_t)row * D + c0 + bj * 128) = w;
                if (WRITE_PQ) ss += (o0.x * o0.x + o0.y * o0.y) + (o0.z * o0.z + o0.w * o0.w) + (o1.x * o1.x + o1.y * o1.y) + (o1.z * o1.z + o1.w * o1.w); }
            if (WRITE_PQ) { ss += __shfl_xor(ss, 16); ss += __shfl_xor(ss, 32); if (fq == 0) pq[(size_t)row * 16 + u.pn * 4 + wc] = ss; } }
    }
};
template <bool WRITE_PQ> struct EpiResidB {
    static constexpr bool HAS_MID = false;
    const bf16* base; bf16* out; float* pq; float scale;
    __device__ __forceinline__ void operator()(AccRef acc, const Unit& u, int wr, int wc, int fr, int fq) const {
        const int row0 = u.pm * 256 + wr * 64 + fr, c0 = u.pn * 256 + wc * 32 + 8 * fq;
#pragma unroll
        for (int ai = 0; ai < 2; ++ai) {
            v4u bb[4][2];
#pragma unroll
            for (int m = 0; m < 4; ++m)
#pragma unroll
                for (int bj = 0; bj < 2; ++bj) bb[m][bj] = *(const v4u*)(base + (size_t)(row0 + ai * 128 + m * 16) * D + c0 + bj * 128);
#pragma unroll
            for (int m = 0; m < 4; ++m) {
                const int row = row0 + ai * 128 + m * 16; float ss = 0.f;
#pragma unroll
                for (int bj = 0; bj < 2; ++bj) { const v4u g = bb[m][bj];
                    const f32x4 o0 = (f32x4){bflo(g.x), bfhi(g.x), bflo(g.y), bfhi(g.y)} + acc[ai][bj][m][0] * scale, o1 = (f32x4){bflo(g.z), bfhi(g.z), bflo(g.w), bfhi(g.w)} + acc[ai][bj][m][1] * scale;
                    v4u w; w.x = cvt_pk_bf16(o0.x, o0.y); w.y = cvt_pk_bf16(o0.z, o0.w); w.z = cvt_pk_bf16(o1.x, o1.y); w.w = cvt_pk_bf16(o1.z, o1.w); *(v4u*)(out + (size_t)row * D + c0 + bj * 128) = w;
                    if (WRITE_PQ) ss += (o0.x * o0.x + o0.y * o0.y) + (o0.z * o0.z + o0.w * o0.w) + (o1.x * o1.x + o1.y * o1.y) + (o1.z * o1.z + o1.w * o1.w);
                }
                if (WRITE_PQ) { ss += __shfl_xor(ss, 16); ss += __shfl_xor(ss, 32); if (fq == 0) pq[(size_t)row * 16 + u.pn * 4 + wc] = ss; }
            }
        }
    }
    template <int O> __device__ __forceinline__ void group(const f32x4 (&v)[8], const Unit& u, int wr, int wc, int fr, int fq) const {
        const int row0 = u.pm * 256 + wr * 64 + fr, c0 = u.pn * 256 + wc * 32 + 8 * fq;
        v4u bb[2][2];
#pragma unroll
        for (int mm = 0; mm < 2; ++mm)
#pragma unroll
            for (int bj = 0; bj < 2; ++bj) bb[mm][bj] = *(const v4u*)(base + (size_t)(row0 + (O >> 1) * 128 + (2 * (O & 1) + mm) * 16) * D + c0 + bj * 128);
#pragma unroll
        for (int mm = 0; mm < 2; ++mm) { const int row = row0 + (O >> 1) * 128 + (2 * (O & 1) + mm) * 16; float ss = 0.f;
#pragma unroll
            for (int bj = 0; bj < 2; ++bj) { const v4u g = bb[mm][bj];
                const f32x4 o0 = (f32x4){bflo(g.x), bfhi(g.x), bflo(g.y), bfhi(g.y)} + v[bj * 4 + mm * 2] * scale, o1 = (f32x4){bflo(g.z), bfhi(g.z), bflo(g.w), bfhi(g.w)} + v[bj * 4 + mm * 2 + 1] * scale;
                v4u w; w.x = cvt_pk_bf16(o0.x, o0.y); w.y = cvt_pk_bf16(o0.z, o0.w); w.z = cvt_pk_bf16(o1.x, o1.y); w.w = cvt_pk_bf16(o1.z, o1.w); *(v4u*)(out + (size_t)row * D + c0 + bj * 128) = w;
                if (WRITE_PQ) ss += (o0.x * o0.x + o0.y * o0.y) + (o0.z * o0.z + o0.w * o0.w) + (o1.x * o1.x + o1.y * o1.y) + (o1.z * o1.z + o1.w * o1.w); }
            if (WRITE_PQ) { ss += __shfl_xor(ss, 16); ss += __shfl_xor(ss, 32); if (fq == 0) pq[(size_t)row * 16 + u.pn * 4 + wc] = ss; } }
    }
};
struct EpiMemKV {
    static constexpr bool HAS_MID = false;
    float* out; bf16* MKV;
    __device__ __forceinline__ void operator()(AccRef acc, const Unit& u, int wr, int wc, int fr, int fq) const {
        const int row0 = u.pm * 256 + wr * 64 + fr, c0 = u.pn * 256 + wc * 32 + 8 * fq;
#pragma unroll
        for (int ai = 0; ai < 2; ++ai)
#pragma unroll
            for (int m = 0; m < 4; ++m) {
                const int row = row0 + ai * 128 + m * 16;
#pragma unroll
                for (int bj = 0; bj < 2; ++bj) { const f32x4 o0 = acc[ai][bj][m][0], o1 = acc[ai][bj][m][1]; float* op = out + (size_t)row * D + c0 + bj * 128;
                    *(f32x4*)op = o0; *(f32x4*)(op + 4) = o1;
                    v4u w; w.x = cvt_pk_bf16(o0.x, o0.y); w.y = cvt_pk_bf16(o0.z, o0.w); w.z = cvt_pk_bf16(o1.x, o1.y); w.w = cvt_pk_bf16(o1.z, o1.w); *(v4u*)(MKV + (size_t)row * D + c0 + bj * 128) = w; }
            }
    }
};
struct EpiMerge1 {
    static constexpr bool HAS_MID = true;
    const bf16* GATE; bf16* MB;
    __device__ __forceinline__ void mid(f32x4 (&acc)[2][2][4][2], const Unit& u, int t, int wr, int wc, int fr, int fq) const {
        const unsigned lo = (unsigned)(((wr * 64 + fr) * 3072 + wc * 32 + 8 * fq) * 2);
        const char* ub = (const char*)GATE + ((size_t)u.pm * 256 * 3072 + (size_t)((t >> 3) - 1) * 1024 + (size_t)u.pn * 256) * 2;
#pragma unroll
        for (int ai = 0; ai < 2; ++ai) {
            v4u gn[4][2], gd[4][2];
#pragma unroll
            for (int m = 0; m < 4; ++m)
#pragma unroll
                for (int bj = 0; bj < 2; ++bj) { const char* fb = ub + (size_t)((ai * 128 + m * 16) * 3072 + bj * 128) * 2; gn[m][bj] = *(const v4u*)(fb + lo); gd[m][bj] = *(const v4u*)(fb + 2048 + lo); }
#pragma unroll
            for (int m = 0; m < 4; ++m)
#pragma unroll
                for (int bj = 0; bj < 2; ++bj) { const v4u n_ = gn[m][bj], d_ = gd[m][bj];
                    const f32x4 r0 = {bflo(n_.x) * fast_rcp(fmaxf(bflo(d_.x), 1e-30f)), bfhi(n_.x) * fast_rcp(fmaxf(bfhi(d_.x), 1e-30f)), bflo(n_.y) * fast_rcp(fmaxf(bflo(d_.y), 1e-30f)), bfhi(n_.y) * fast_rcp(fmaxf(bfhi(d_.y), 1e-30f))};
                    const f32x4 r1 = {bflo(n_.z) * fast_rcp(fmaxf(bflo(d_.z), 1e-30f)), bfhi(n_.z) * fast_rcp(fmaxf(bfhi(d_.z), 1e-30f)), bflo(n_.w) * fast_rcp(fmaxf(bflo(d_.w), 1e-30f)), bfhi(n_.w) * fast_rcp(fmaxf(bfhi(d_.w), 1e-30f))};
                    acc[ai][bj][m][0] *= r0; acc[ai][bj][m][1] *= r1; }
            asm volatile("" ::: "memory");
        }
    }
    __device__ __forceinline__ void operator()(AccRef acc, const Unit& u, int wr, int wc, int fr, int fq) const {
        const int row0 = u.pm * 256 + wr * 64 + fr, c0 = u.pn * 256 + wc * 32 + 8 * fq;
        v4u gw[2][4][2];
#pragma unroll
        for (int ai = 0; ai < 2; ++ai)
#pragma unroll
            for (int m = 0; m < 4; ++m)
#pragma unroll
                for (int bj = 0; bj < 2; ++bj) gw[ai][m][bj] = *(const v4u*)(GATE + (size_t)(row0 + ai * 128 + m * 16) * 3072 + 2048 + c0 + bj * 128);
#pragma unroll
        for (int ai = 0; ai < 2; ++ai)
#pragma unroll
            for (int m = 0; m < 4; ++m) { const int row = row0 + ai * 128 + m * 16;
#pragma unroll
                for (int bj = 0; bj < 2; ++bj) { const v4u g = gw[ai][m][bj];
                    const f32x4 o0 = acc[ai][bj][m][0] * (f32x4){bflo(g.x), bfhi(g.x), bflo(g.y), bfhi(g.y)}, o1 = acc[ai][bj][m][1] * (f32x4){bflo(g.z), bfhi(g.z), bflo(g.w), bfhi(g.w)};
                    v4u w; w.x = cvt_pk_bf16(o0.x, o0.y); w.y = cvt_pk_bf16(o0.z, o0.w); w.z = cvt_pk_bf16(o1.x, o1.y); w.w = cvt_pk_bf16(o1.z, o1.w); *(v4u*)(MB + (size_t)row * D + c0 + bj * 128) = w;
                } }
    }
    template <int O> __device__ __forceinline__ void group(const f32x4 (&v)[8], const Unit& u, int wr, int wc, int fr, int fq) const {
        const int row0 = u.pm * 256 + wr * 64 + fr, c0 = u.pn * 256 + wc * 32 + 8 * fq;
#pragma unroll
        for (int mm = 0; mm < 2; ++mm) { const int row = row0 + (O >> 1) * 128 + (2 * (O & 1) + mm) * 16;
#pragma unroll
            for (int bj = 0; bj < 2; ++bj) { const f32x4 o0 = v[bj * 4 + mm * 2], o1 = v[bj * 4 + mm * 2 + 1];
                v4u w; w.x = cvt_pk_bf16(o0.x, o0.y); w.y = cvt_pk_bf16(o0.z, o0.w); w.z = cvt_pk_bf16(o1.x, o1.y); w.w = cvt_pk_bf16(o1.z, o1.w); *(v4u*)(MB + (size_t)row * D + c0 + bj * 128) = w; } }
    }
};
__device__ __forceinline__ size_t qkv_off(int row, int g, int h) {
    if (row >= MP) return (size_t)row * 1536 + g * 512 + h * 128;
    const int b = row >> 11, t = row & 2047, sh = 2 * g, p = ((t & ((1 << sh) - 1)) << (11 - sh)) + (t >> sh);
    return ((size_t)((g * NB + b) * 4 + h) * SEQ + p) * 128;
}
struct EpiZ {
    static constexpr bool HAS_MID = false;
    const float* pq; const float* ropeC; const float* ropeS; const float* bga; float* out;
    bf16 *QS, *KS, *VS, *GQ, *GK, *GV, *GRS, *MQ, *GATE; float* GA;
    template <int ACT> __device__ __forceinline__ void plain(AccRef acc, const float (&rs)[2][4], int row0, bf16* dst, int ld, int col0, float scale) const {
#pragma unroll
        for (int ai = 0; ai < 2; ++ai)
#pragma unroll
            for (int m = 0; m < 4; ++m) { const int row = row0 + ai * 128 + m * 16; const float s = rs[ai][m];
#pragma unroll
                for (int bj = 0; bj < 2; ++bj) { float o[8];
#pragma unroll
                    for (int n = 0; n < 2; ++n)
#pragma unroll
                        for (int i = 0; i < 4; ++i) { const float x = acc[ai][bj][m][n][i] * s; o[4 * n + i] = ACT == 0 ? x * scale : (ACT == 1 ? siluf_(x) : sigmoidf_(x)); }
                    v4u w; w.x = cvt_pk_bf16(o[0], o[1]); w.y = cvt_pk_bf16(o[2], o[3]); w.z = cvt_pk_bf16(o[4], o[5]); w.w = cvt_pk_bf16(o[6], o[7]);
                    *(v4u*)(dst + (size_t)row * ld + col0 + bj * 128) = w; } }
    }
    __device__ __forceinline__ float* swa_dst(int row, int g, int kv, int h) const {
        if (row >= MP) return out + (g == 0 ? O_SWA0S : (g == 1 ? O_SWA1S : O_SWA2S)) + ((size_t)(row - MP) * 2 + kv) * 512 + h * 128;
        const int b = row >> 11, t = row & 2047, keep = 128 << (2 * g), t0 = SEQ - keep;
        if (t < t0) return nullptr;
        return out + (g == 0 ? O_SWA0P : (g == 1 ? O_SWA1P : O_SWA2P)) + (((size_t)b * keep + (t - t0)) * 2 + kv) * 512 + h * 128;
    }
    __device__ __forceinline__ void operator()(AccRef acc, const Unit& u, int wr, int wc, int fr, int fq) const {
        const int row0 = u.pm * 256 + wr * 64 + fr, pn = u.pn, cl = wc * 32 + 8 * fq;
        float rs[2][4];
#pragma unroll
        for (int ai = 0; ai < 2; ++ai)
#pragma unroll
            for (int m = 0; m < 4; ++m) { const int row = row0 + ai * 128 + m * 16;
                const f32x4 pv = *(const f32x4*)(pq + (size_t)row * 16 + 4 * fq); float t = (pv.x + pv.y) + (pv.z + pv.w); t += __shfl_xor(t, 16); t += __shfl_xor(t, 32); rs[ai][m] = __builtin_amdgcn_rsqf(t * (1.f / D) + EPS); }
        if (pn < 12) {
            const int isk = pn >= 6, g = (pn % 6) >> 1, hp = pn & 1, e0 = wc * 16 + 4 * fq;
#pragma unroll
            for (int ai = 0; ai < 2; ++ai) {
                f32x4 cs[4], sn[4];
#pragma unroll
                for (int m = 0; m < 4; ++m) { const int row = row0 + ai * 128 + m * 16; const int pidx = row < MP ? (row & 2047) : SEQ + ((row - MP) & 3);
                    cs[m] = *(const f32x4*)(ropeC + pidx * 64 + e0); sn[m] = *(const f32x4*)(ropeS + pidx * 64 + e0); }
#pragma unroll
                for (int m = 0; m < 4; ++m) { const int row = row0 + ai * 128 + m * 16; const float s = rs[ai][m];
#pragma unroll
                    for (int bj = 0; bj < 2; ++bj) { const int h = 2 * hp + bj;
                        const f32x4 x1 = acc[ai][bj][m][0] * s, x2 = acc[ai][bj][m][1] * s;
                        f32x4 r1 = x1 * cs[m] - x2 * sn[m], r2 = x2 * cs[m] + x1 * sn[m];
                        if (!isk) { r1 *= QSCALE; r2 *= QSCALE; }
                        bf16* dp = (isk ? KS : QS) + qkv_off(row, g, h) + e0;
                        v2u w1, w2; w1.x = cvt_pk_bf16(r1.x, r1.y); w1.y = cvt_pk_bf16(r1.z, r1.w); w2.x = cvt_pk_bf16(r2.x, r2.y); w2.y = cvt_pk_bf16(r2.z, r2.w);
                        *(v2u*)dp = w1; *(v2u*)(dp + 64) = w2;
                        if (isk) { float* fo = swa_dst(row, g, 0, h); if (fo) { *(f32x4*)(fo + e0) = r1; *(f32x4*)(fo + 64 + e0) = r2; } }
                    } }
            }
        } else if (pn < 18) {
            const int g = (pn - 12) >> 1, hp = pn & 1;
#pragma unroll
            for (int ai = 0; ai < 2; ++ai)
#pragma unroll
                for (int m = 0; m < 4; ++m) { const int row = row0 + ai * 128 + m * 16; const float s = rs[ai][m];
#pragma unroll
                    for (int bj = 0; bj < 2; ++bj) { const int h = 2 * hp + bj; const f32x4 o0 = acc[ai][bj][m][0] * s, o1 = acc[ai][bj][m][1] * s;
                        v4u w; w.x = cvt_pk_bf16(o0.x, o0.y); w.y = cvt_pk_bf16(o0.z, o0.w); w.z = cvt_pk_bf16(o1.x, o1.y); w.w = cvt_pk_bf16(o1.z, o1.w);
                        *(v4u*)(VS + qkv_off(row, g, h) + cl) = w;
                        float* fo = swa_dst(row, g, 1, h); if (fo) { *(f32x4*)(fo + cl) = o0; *(f32x4*)(fo + cl + 4) = o1; } } }
        } else if (pn == 18) plain<0>(acc, rs, row0, GQ, 256, cl, 0.125f);
        else if (pn == 19) plain<0>(acc, rs, row0, GK, 256, cl, 1.f);
        else if (pn < 22) plain<0>(acc, rs, row0, GV, 512, (pn - 20) * 256 + cl, 1.f);
        else if (pn < 24) plain<1>(acc, rs, row0, GRS, 512, (pn - 22) * 256 + cl, 1.f);
        else if (pn == 24) {
            f32x4 bv[2][2];
#pragma unroll
            for (int bj = 0; bj < 2; ++bj)
#pragma unroll
                for (int n = 0; n < 2; ++n) bv[bj][n] = *(const f32x4*)(bga + bj * 128 + cl + 4 * n);
#pragma unroll
            for (int ai = 0; ai < 2; ++ai)
#pragma unroll
                for (int m = 0; m < 4; ++m) { const int row = row0 + ai * 128 + m * 16; const float s = rs[ai][m];
#pragma unroll
                    for (int bj = 0; bj < 2; ++bj)
#pragma unroll
                        for (int n = 0; n < 2; ++n) { const int c = bj * 128 + cl + 4 * n; f32x4 o;
#pragma unroll
                            for (int i = 0; i < 4; ++i) { const float x = acc[ai][bj][m][n][i] * s + bv[bj][n][i];
                                o[i] = (fminf(x, 0.f) - LN2 * fast_log2(1.f + fast_exp2(-1.4426950408889634f * fabsf(x)))) * (1.f / 16.f); }
                            *(f32x4*)(GA + (size_t)row * 256 + c) = o; } }
        } else if (pn < 27) plain<0>(acc, rs, row0, MQ, 512, (pn - 25) * 256 + cl, QSCALE);
        else plain<2>(acc, rs, row0, GATE, 3072, (pn - 27) * 256 + cl, 1.f);
    }
};


constexpr int TS = 4;
template <int O> __device__ __forceinline__ void tail_store_group(const f32x4 (&acc)[2][2][4][2], float* dst) {
#pragma unroll
    for (int e = 0; e < 8; ++e) *(f32x4*)(dst + (size_t)e * 2048) = acc[O >> 1][e >> 2][2 * (O & 1) + ((e >> 1) & 1)][e & 1];
}
template <int O> __device__ __forceinline__ void tail_store_gated(const f32x4 (&acc)[2][2][4][2], const bf16* gp, float* dst) {
    v4u g[2][2];
#pragma unroll
    for (int mm = 0; mm < 2; ++mm)
#pragma unroll
        for (int bj = 0; bj < 2; ++bj) g[mm][bj] = *(const v4u*)(gp + (size_t)((O >> 1) * 128 + (2 * (O & 1) + mm) * 16) * 3072 + bj * 128);
#pragma unroll
    for (int e = 0; e < 8; ++e) { const v4u gv = g[(e >> 1) & 1][e >> 2];
        const f32x4 gg = (e & 1) ? (f32x4){bflo(gv.z), bfhi(gv.z), bflo(gv.w), bfhi(gv.w)} : (f32x4){bflo(gv.x), bfhi(gv.x), bflo(gv.y), bfhi(gv.y)};
        *(f32x4*)(dst + (size_t)e * 2048) = acc[O >> 1][e >> 2][2 * (O & 1) + ((e >> 1) & 1)][e & 1] * gg; }
}
template <class Base, bool GATED = false> struct EpiTail {
    static constexpr bool HAS_MID = false;
    Base E0; float* slab  ; gu32* flag; int s, wave; const bf16* gate  ;
    __device__ __forceinline__ void operator()(const f32x4 (&acc)[2][2][4][2], const Unit& u, int wr, int wc, int fr, int fq) const {
        const int lane = fq * 16 + fr; float* lb = slab + (size_t)(wave * 64 + lane) * 4;
        if (GATED) { const bf16* gp = gate + (size_t)(u.pm * 256 + wr * 64 + fr) * 3072 + u.pn * 256 + wc * 32 + 8 * fq;
            tail_store_gated<0>(acc, gp, lb + (size_t)((0 * TS + s) * 8) * 2048); tail_store_gated<1>(acc, gp, lb + (size_t)((1 * TS + s) * 8) * 2048);
            tail_store_gated<2>(acc, gp, lb + (size_t)((2 * TS + s) * 8) * 2048); tail_store_gated<3>(acc, gp, lb + (size_t)((3 * TS + s) * 8) * 2048); }
        else {
        tail_store_group<0>(acc, lb + (size_t)((0 * TS + s) * 8) * 2048); tail_store_group<1>(acc, lb + (size_t)((1 * TS + s) * 8) * 2048);
        tail_store_group<2>(acc, lb + (size_t)((2 * TS + s) * 8) * 2048); tail_store_group<3>(acc, lb + (size_t)((3 * TS + s) * 8) * 2048); }
        asm volatile("s_waitcnt vmcnt(0)" ::: "memory");
        asm volatile("s_waitcnt lgkmcnt(0)" ::: "memory"); __builtin_amdgcn_s_barrier(); asm volatile("" ::: "memory");
        if (wave == 0) {
            if (lane == 0) { __builtin_amdgcn_fence(__ATOMIC_RELEASE, "agent"); asm volatile("s_waitcnt vmcnt(0)" ::: "memory"); __hip_atomic_fetch_add(flag, 1u, RLX_AGENT); }
            unsigned spins = 0;
            while ((unsigned)__builtin_amdgcn_readfirstlane((int)__hip_atomic_load(flag, RLX_AGENT)) < (unsigned)TS) { __builtin_amdgcn_s_sleep(4); if (++spins > (1u << 22)) break; }
            __builtin_amdgcn_fence(__ATOMIC_ACQUIRE, "agent"); asm volatile("s_waitcnt vmcnt(0)" ::: "memory"); }
        asm volatile("s_waitcnt lgkmcnt(0)" ::: "memory"); __builtin_amdgcn_s_barrier(); asm volatile("" ::: "memory");
        const float* src = lb + (size_t)(s * TS * 8) * 2048;
        f32x4 t[TS][8];
#pragma unroll
        for (int ci = 0; ci < TS; ++ci)
#pragma unroll
            for (int e = 0; e < 8; ++e) t[ci][e] = *(const f32x4*)(src + (size_t)(ci * 8 + e) * 2048);
        f32x4 own[8];
#pragma unroll
        for (int e = 0; e < 8; ++e) own[e] = (t[0][e] + t[1][e]) + (t[2][e] + t[3][e]);
        if (s == 0) E0.template group<0>(own, u, wr, wc, fr, fq); else if (s == 1) E0.template group<1>(own, u, wr, wc, fr, fq);
        else if (s == 2) E0.template group<2>(own, u, wr, wc, fr, fq); else E0.template group<3>(own, u, wr, wc, fr, fq);
    }
};
#define XB_TMO      128
#define XB_XCNT(j)  (256  + 64 * (j))
#define XB_XSUB(j)  (1280 + 64 * (j))
#define XB_XGEN(j)  (2304 + 64 * (j))
#define XB_TOP      3328
#define XB_TOPGEN   3392
#define XCD_BAR_WORDS 3456
#define XB_SPIN_CAP (1u << 18)
__device__ __forceinline__ unsigned xb_ld(unsigned* p)              { return __hip_atomic_load(p, __ATOMIC_RELAXED, __HIP_MEMORY_SCOPE_AGENT); }
__device__ __forceinline__ unsigned xb_add(unsigned* p, unsigned v) { return __hip_atomic_fetch_add(p, v, __ATOMIC_RELAXED, __HIP_MEMORY_SCOPE_AGENT); }
__device__ __forceinline__ unsigned xb_xcc_id() { return (unsigned)__builtin_amdgcn_s_getreg((3 << 11) | 20) & 0xFu; }
#define XB_SPIN(cond, bar) do { unsigned _sp = 0; while (cond) { __builtin_amdgcn_s_sleep(1); \
    if ((++_sp & 255u) == 0u) { if (xb_ld(&(bar)[XB_TMO])) break; if (_sp > XB_SPIN_CAP) { atomicAdd(&(bar)[XB_TMO], 1u); break; } } } } while (0)
struct XcdBarrier { unsigned* bar; unsigned x; volatile LAS unsigned* st; };
__device__ __forceinline__ XcdBarrier xcd_barrier_post(unsigned* bar, volatile LAS unsigned* st, int wave) {
    XcdBarrier b; b.bar = bar; b.x = xb_xcc_id(); b.st = st;
    if (wave == 0 && lane_id() == 0) (void)xb_add(&bar[XB_XCNT(b.x)], 1u);
    return b;
}
__device__ __forceinline__ void xcd_barrier_complete(unsigned* bar, unsigned x, unsigned& nloc, unsigned& nx) {
    const unsigned G = gridDim.x * gridDim.y * gridDim.z;
    unsigned sum, cnt, mine, sp = 0u;
    for (;;) {
        sum = 0u; cnt = 0u; mine = 0u;
#pragma unroll
        for (unsigned j = 0; j < 16; ++j) { const unsigned c = xb_ld(&bar[XB_XCNT(j)]); sum += c; cnt += (c > 0u) ? 1u : 0u; mine = (j == x) ? c : mine; }
        if (sum == G) break;
        __builtin_amdgcn_s_sleep(1);
        if ((++sp & 255u) == 0u) { if (xb_ld(&bar[XB_TMO])) break; if (sp > XB_SPIN_CAP) { atomicAdd(&bar[XB_TMO], 1u); break; } }
    }
    nloc = mine > 0u ? mine : 1u; nx = cnt > 0u ? cnt : 1u;
}
__device__ __forceinline__ void xcd_barrier(const XcdBarrier& b, int wave) {
    asm volatile("s_waitcnt vmcnt(0)" ::: "memory");
    __syncthreads();
    if (wave == 0 && lane_id() == 0) {
        unsigned* bar = b.bar;
        __builtin_amdgcn_s_waitcnt(0);
        unsigned nloc = b.st[0], nx = b.st[1];
        if (nloc == 0u) { xcd_barrier_complete(bar, b.x, nloc, nx); b.st[0] = nloc; b.st[1] = nx; }
        const unsigned old = xb_add(&bar[XB_XSUB(b.x)], 1u);
        const unsigned gen = old / nloc;
        if (old + 1u == (gen + 1u) * nloc) {
            __builtin_amdgcn_fence(__ATOMIC_RELEASE, "agent");
            asm volatile("s_waitcnt vmcnt(0)" ::: "memory");
            const unsigned og = xb_add(&bar[XB_TOP], 1u);
            const unsigned tg = og / nx;
            if (og + 1u == (tg + 1u) * nx) xb_add(&bar[XB_TOPGEN], 1u);
            else XB_SPIN(xb_ld(&bar[XB_TOPGEN]) == tg, bar);
            __builtin_amdgcn_fence(__ATOMIC_ACQUIRE, "agent");
            xb_add(&bar[XB_XGEN(b.x)], 1u);
            asm volatile("s_waitcnt vmcnt(0)" ::: "memory");
        } else {
            XB_SPIN(xb_ld(&bar[XB_XGEN(b.x)]) == gen, bar);
            __builtin_amdgcn_fence(__ATOMIC_ACQUIRE, "agent");
            asm volatile("s_waitcnt vmcnt(0)" ::: "memory");
        }
    }
    __syncthreads();
}

struct Args { const float* in[25]; float* out; unsigned char* ws; int ph_lo, ph_hi, li, pad; };
struct Frame {
    LAS unsigned char* lds; int tid, lane, wave, vcu, G;
    const float *i0, *i1, *i2, *i3, *i4, *i5, *i6, *i7, *i8, *i9, *i10, *i11, *i12, *i13, *i14, *i15, *i16, *i17, *i18, *i19, *i20, *i21, *i22, *i23, *i24;
    float* out; unsigned char* ws;
};
__device__ __forceinline__ float wave_sum(float v) {
#pragma unroll
    for (int o = 1; o < 64; o <<= 1) v += __shfl_xor(v, o);
    return v;
}

template <class Base, bool ATILED = false> __device__ __forceinline__ void tail_phase(Frame& F, const bf16* A, int lda, const bf16* Bt, int ldb, int K, const Base& E0, int ps) {
    const int c = (int)blockIdx.x; if (c >= 8 * TS) return;
    const int j = c / TS, s = c % TS, nch = K / 128, c0 = (s * nch) / TS, c1 = ((s + 1) * nch) / TS;
    pg8::OneUnit S; S.c = c; pg8::StaticOrderT<MR / 256, D / 256>::unit_of(1024 + j, S.u);
    pg8::Gemm g{A + (ATILED ? (size_t)c0 * 2 * (pg8::TILED_KS / 2) : (size_t)c0 * 128), Bt + c0 * 128, MR, D, (c1 - c0) * 128, lda, ldb};
    EpiTail<Base> E{E0, (float*)(F.ws + WS_SLAB) + (size_t)j * (TS * TS * 8 * 2048), (gu32*)(F.ws + WS_CTL) + CW_TAIL + (ps * 8 + j) * 64, s, F.wave};
    pg8::gemm_phase<EpiTail<Base>, pg8::OneUnit, true, ATILED>(F.lds + RING_OFF, g, S, E, F.wave);
}
__device__ __forceinline__ void tail_phase_merge(Frame& F, const bf16* A, const bf16* Bt, const EpiMerge1& E0, int ps) {
    const int c = (int)blockIdx.x; if (c >= 8 * TS) return;
    const int j = c / TS, s = c % TS, k0 = s < 2 ? 512 * s : 1024 + 256 * (s - 2), kl = s < 2 ? 512 : 256, br = s < 2 ? s : 2;
    pg8::OneUnit S; S.c = c; pg8::StaticOrderT<MR / 256, D / 256>::unit_of(1024 + j, S.u);
    pg8::Gemm g{A + k0, Bt + k0, MR, D, kl, 1536, 1536};
    EpiTail<EpiMerge1, true> E{E0, (float*)(F.ws + WS_SLAB) + (size_t)j * (TS * TS * 8 * 2048), (gu32*)(F.ws + WS_CTL) + CW_TAIL + (ps * 8 + j) * 64, s, F.wave, E0.GATE + br * 1024};
    pg8::gemm_phase<EpiTail<EpiMerge1, true>, pg8::OneUnit>(F.lds + RING_OFF, g, S, E, F.wave);
}
enum WKind { WK_PLAIN = 0, WK_SWIGLU = 1, WK_IN = 2 };
__device__ __forceinline__ int p0_win_col(int np) {
    const int pn = np >> 8, r = np & 255;
    if (pn < 18) { const int qkv = pn / 6, g = (pn % 6) >> 1, hp = pn & 1, h = 2 * hp + (r >> 7); const int d = qkv < 2 ? sig_rope(r & 127) : sig_plain(r & 127); return ((qkv * 3 + g) * 4 + h) * 128 + d; }
    const int c = sig_plain(r);
    if (pn == 18) return 4608 + c;
    if (pn == 19) return 4864 + c;
    if (pn < 22) return 5120 + (pn - 20) * 256 + c;
    if (pn < 24) return 5632 + (pn - 22) * 256 + c;
    if (pn == 24) return -1 - c;
    if (pn < 27) return 6160 + (pn - 25) * 256 + c;
    return DIN + (pn - 27) * 256 + c;
}
__device__ __forceinline__ void p0_item(const Frame& F, int kind, const float* W, int ldw, const float* W2, const float* gain, const float* a2, bf16* WT, int K, int kb, int nb, LAS float* scr) {
    const int lane = F.lane, k0 = 64 * kb, n0 = 32 * nb, np = n0 + (lane & 31);
    int sc; const float* Wp = W; int ld = ldw;
    if (kind == WK_PLAIN) sc = sig_plain(np);
    else if (kind == WK_SWIGLU) { const int r = np & 255; sc = (r >> 7) * FF + (np >> 8) * 128 + sig_plain(r & 127); }
    else { sc = p0_win_col(np); if (sc >= DIN) { sc -= DIN; Wp = W2; ld = 3072; } }
    if (sc >= 0) {
#pragma unroll 8
        for (int i = 0; i < 32; ++i) { const int kk = 2 * i + (lane >> 5); float v = Wp[(size_t)(k0 + kk) * ld + sc]; if (gain) v *= gain[k0 + kk]; scr[kk * 33 + (lane & 31)] = v; }
    } else {
        const int j = -1 - sc; float a2c[16];
#pragma unroll
        for (int r = 0; r < 16; ++r) a2c[r] = a2[r * 256 + j];
        for (int i = 0; i < 32; ++i) { const int kk = 2 * i + (lane >> 5); const float* wr_ = W + (size_t)(k0 + kk) * ldw + 6144; float v = 0.f;
#pragma unroll
            for (int r = 0; r < 16; ++r) v += wr_[r] * a2c[r];
            scr[kk * 33 + (lane & 31)] = v * gain[k0 + kk]; }
    }
    LDS_WAIT(); asm volatile("" ::: "memory");
    const int c = lane & 7;
#pragma unroll
    for (int j = 0; j < 4; ++j) { const int n = (lane >> 3) + 8 * j; const LAS float* s = scr + (8 * c) * 33 + n;
        v4u o; o.x = pk2(s[0 * 33], s[1 * 33]); o.y = pk2(s[2 * 33], s[3 * 33]); o.z = pk2(s[4 * 33], s[5 * 33]); o.w = pk2(s[6 * 33], s[7 * 33]);
        *(GAS v4u*)(WT + (size_t)(n0 + n) * K + k0 + 8 * c) = o; }
    LDS_WAIT(); asm volatile("" ::: "memory");
}
template <int NR> __device__ __forceinline__ void rms_rows_to_bf16(int lane, const float* const (&xrow)[NR], const float* const (&gain)[NR], bf16* const (&orow)[NR]) {
    f32x4 v[NR][4]; float rstd[NR];
#pragma unroll
    for (int r = 0; r < NR; ++r)
#pragma unroll
        for (int j = 0; j < 4; ++j) v[r][j] = ((const GAS f32x4*)xrow[r] + lane)[64 * j];
#pragma unroll
    for (int r = 0; r < NR; ++r) { float s = 0.f;
#pragma unroll
        for (int j = 0; j < 4; ++j) s += (v[r][j].x * v[r][j].x + v[r][j].y * v[r][j].y) + (v[r][j].z * v[r][j].z + v[r][j].w * v[r][j].w);
        rstd[r] = 1.0f / sqrtf(wave_sum(s) * (1.f / D) + EPS); }
#pragma unroll
    for (int r = 0; r < NR; ++r) { GAS v2u* o8 = (GAS v2u*)orow[r] + lane; const GAS f32x4* gr = (const GAS f32x4*)gain[r] + lane;
#pragma unroll
        for (int j = 0; j < 4; ++j) { const f32x4 gg = gr[64 * j]; v2u w; w.x = pk2(v[r][j].x * rstd[r] * gg.x, v[r][j].y * rstd[r] * gg.y); w.y = pk2(v[r][j].z * rstd[r] * gg.z, v[r][j].w * rstd[r] * gg.w); o8[64 * j] = w; } }
}
__device__ __forceinline__ void sincos_d(double x, double& s, double& c) {
    const double TWO_PI = 6.283185307179586476925286766559;
    const double n = __builtin_rint(x / TWO_PI); const double r = x - n * TWO_PI, r2 = r * r;
    double ts = 1.0, tc = 1.0;
#pragma unroll
    for (int k = 14; k >= 1; --k) { ts = 1.0 - ts * r2 / (double)((2 * k) * (2 * k + 1)); tc = 1.0 - tc * r2 / (double)((2 * k - 1) * (2 * k)); }
    s = ts * r; c = tc;
}
__device__ __forceinline__ void p0_prologue(Frame& F) {
    unsigned char* ws = F.ws;
    LAS float* scr = (LAS float*)(F.lds + RING_OFF + F.wave * 16384);
    const int gw = F.vcu * NWAVES + F.wave, NGW = F.G * NWAVES;
    constexpr int I_A = 16 * 176, I_O = 44 * 32, I_IN = 16 * 312, I_BR = 8 * 32, I_SQ = 16 * 32;
    constexpr int NITEMS = 2 * I_A + 2 * I_O + I_IN + 3 * I_BR + 2 * I_SQ;
    for (int it = gw; it < NITEMS; it += NGW) {
        int r = it;
        if (r < I_A) { p0_item(F, WK_SWIGLU, F.i9, 2 * FF, nullptr, nullptr, nullptr, (bf16*)(ws + WS_W1A), D, r / 176, r % 176, scr); continue; } r -= I_A;
        if (r < I_A) { p0_item(F, WK_SWIGLU, F.i22, 2 * FF, nullptr, F.i21, nullptr, (bf16*)(ws + WS_W2A), D, r / 176, r % 176, scr); continue; } r -= I_A;
        if (r < I_O) { p0_item(F, WK_PLAIN, F.i10, D, nullptr, nullptr, nullptr, (bf16*)(ws + WS_W1O), FF, r / 32, r % 32, scr); continue; } r -= I_O;
        if (r < I_O) { p0_item(F, WK_PLAIN, F.i23, D, nullptr, nullptr, nullptr, (bf16*)(ws + WS_W2O), FF, r / 32, r % 32, scr); continue; } r -= I_O;
        if (r < I_IN) { p0_item(F, WK_IN, F.i12, DIN, F.i16, F.i11, F.i13, (bf16*)(ws + WS_WIN), D, r / 312, r % 312, scr); continue; } r -= I_IN;
        if (r < 3 * I_BR) { const int br = r / I_BR, q = r % I_BR; p0_item(F, WK_PLAIN, F.i17 + (size_t)br * 512 * D, D, nullptr, nullptr, nullptr, (bf16*)(ws + WS_WBR) + br * 512, 1536, q / 32, q % 32, scr); continue; } r -= 3 * I_BR;
        if (r < I_SQ) { p0_item(F, WK_PLAIN, F.i18, D, nullptr, nullptr, nullptr, (bf16*)(ws + WS_WOUT), D, r / 32, r % 32, scr); continue; } r -= I_SQ;
        p0_item(F, WK_PLAIN, F.i20, D, nullptr, nullptr, nullptr, (bf16*)(ws + WS_WMEM), D, r / 32, r % 32, scr);
    }
#define P0_ROW(m_, x_, g_, o_) do { const int mm_ = (m_); if (mm_ < MP) { x_ = F.i0 + (size_t)mm_ * D; g_ = F.i8; o_ = (bf16*)(ws + WS_XB) + (size_t)mm_ * D; } \
        else if (mm_ < MR) { x_ = F.i1 + (size_t)(mm_ - MP) * D; g_ = F.i8; o_ = (bf16*)(ws + WS_XB) + (size_t)mm_ * D; } \
        else { x_ = F.i2 + (size_t)(mm_ - MR) * D; g_ = F.i19; o_ = (bf16*)(ws + WS_MEMB) + (size_t)(mm_ - MR) * D; } } while (0)
    { int m = gw;
      for (; m + 3 * NGW < MR + MM; m += 4 * NGW) { const float* x[4]; const float* g[4]; bf16* o[4];
#pragma unroll
          for (int r = 0; r < 4; ++r) P0_ROW(m + r * NGW, x[r], g[r], o[r]);
          rms_rows_to_bf16<4>(F.lane, x, g, o); }
      for (; m < MR + MM; m += NGW) { const float* x[1]; const float* g[1]; bf16* o[1]; P0_ROW(m, x[0], g[0], o[0]); rms_rows_to_bf16<1>(F.lane, x, g, o); } }
#undef P0_ROW
    float* rc = (float*)(ws + WS_ROPE); float* rsn = rc + NPOS * 64;
    for (int i = (F.vcu * NWAVES * 64) + F.tid; i < NPOS * 64; i += F.G * NWAVES * 64) {
        const int p = i >> 6, e = i & 63; const int pos = p < SEQ ? p : PAST + (p - SEQ);
        const double y = -(double)e * 9.210340371976182736 / 64.0 / 16.0; double ex = 1.0;
#pragma unroll
        for (int k = 14; k >= 1; --k) ex = 1.0 + ex * y / (double)k;
        ex *= ex; ex *= ex; ex *= ex; ex *= ex;
        const float inv = (float)ex; const float ang = (float)pos * inv;
        double s, c; sincos_d((double)ang, s, c); rc[i] = (float)c; rsn[i] = (float)s;
    }
}

__device__ __forceinline__ int koff(int row, int ch) { return 256 * row + 16 * (ch ^ (row & 15)); }
__device__ __forceinline__ int voff(int row, int ch) { return 256 * row + 16 * (ch ^ ((row & 7) << 1)); }
typedef short v4i16_t __attribute__((ext_vector_type(4)));
__device__ __forceinline__ s16x4 vtr(const LAS unsigned char* p) { return __builtin_bit_cast(s16x4, __builtin_amdgcn_ds_read_tr16_b64_v4i16((LAS v4i16_t*)p)); }
struct AttnDesc { const bf16* Qp; const bf16* Kp; const bf16* Vp; bf16* Op; float* lsep; long qrow0, krow0, orow0; int qpitch, kpitch, opitch, qstride, kstride, ostride, kmin; };
template <int MODE> __device__ __forceinline__ AttnDesc attn_desc(const Frame& F, int id) {
    unsigned char* ws = F.ws; AttnDesc d;
    if (MODE == 0) {
        const int b = id / 192, rem = id % 192, gh = rem >> 4, u = rem & 15, g = gh >> 2;
        const int dil = g == 0 ? 1 : (g == 1 ? 4 : 16), r = g == 0 ? 0 : (g == 1 ? (u & 3) : u), n = g == 0 ? u : (g == 1 ? (u >> 2) : 0);
        const size_t hb = (size_t)((g * NB + b) * 4 + (gh & 3)) * SEQ * 128; const long pr = (long)r * (SEQ / dil);
        d.Qp = (const bf16*)(ws + WS_QS) + hb; d.Kp = (const bf16*)(ws + WS_KS) + hb; d.Vp = (const bf16*)(ws + WS_VS) + hb; d.Op = (bf16*)(ws + WS_OG) + gh * 128; d.lsep = (float*)(ws + WS_LSE) + gh;
        d.qrow0 = pr + 128 * n; d.krow0 = pr + 128 * (n - 1); d.orow0 = (long)b * SEQ + r + (long)128 * n * dil; d.qpitch = 128; d.kpitch = 128; d.opitch = 1536; d.qstride = 1; d.kstride = 1; d.ostride = dil; d.kmin = n == 0 ? 128 : 0;
    } else {
        const int j = id - 6144, b = j >> 6, h = (j >> 4) & 3, n = j & 15;
        d.Qp = (const bf16*)(ws + WS_MQ) + h * 128; d.Kp = (const bf16*)(ws + WS_MKV) + h * 128; d.Vp = (const bf16*)(ws + WS_MKV) + 512 + h * 128; d.Op = (bf16*)(ws + WS_OALL) + 1024 + h * 128; d.lsep = nullptr;
        d.qrow0 = (long)b * SEQ + 128 * n; d.orow0 = d.qrow0; d.ostride = 1; d.krow0 = (long)b * MEML; d.qpitch = 512; d.kpitch = 1024; d.opitch = 1536; d.qstride = 1; d.kstride = 1; d.kmin = 0;
    }
    return d;
}
template <int MODE> __device__ __forceinline__ void attn_scores(const Frame& F, const AttnDesc& d, const bf16x8 (&qf)[4], f32x4 (&S)[MODE == 0 ? 9 : 16], float& mx_out, float& ls_out) {
    const LAS unsigned char* ldsK = F.lds + RING_OFF;
    const int lane = F.lane, w = F.wave, l15 = lane & 15, g4 = lane >> 4;
    constexpr int NF = MODE == 0 ? 9 : 16;
    const int f0 = MODE == 0 ? w : 0; const bool half = MODE == 0 && d.kmin != 0;
#pragma unroll
    for (int i = 0; i < NF; ++i) { S[i] = (f32x4){0.f, 0.f, 0.f, 0.f};
        if (!(half && f0 + i < 8)) { const int krow = 16 * (f0 + i) + l15;
#pragma unroll
            for (int s = 0; s < 4; ++s) { const bf16x8 kf = *(const LAS bf16x8*)(ldsK + koff(krow, 4 * s + g4)); S[i] = __builtin_amdgcn_mfma_f32_16x16x32_bf16(kf, qf[s], S[i], 0, 0, 0); } } }
    float mx = -3.0e38f; const int iq = 16 * w + l15;
#pragma unroll
    for (int i = 0; i < NF; ++i)
#pragma unroll
        for (int r = 0; r < 4; ++r) { if (MODE == 0) { const int kj = 16 * (f0 + i) + 4 * g4 + r; const bool ok = kj >= iq && kj <= iq + 128 && kj >= d.kmin; S[i][r] = ok ? S[i][r] : -3.0e38f; } mx = fmaxf(mx, S[i][r]); }
    mx = fmaxf(mx, __shfl_xor(mx, 16)); mx = fmaxf(mx, __shfl_xor(mx, 32));
    float ls = 0.f;
#pragma unroll
    for (int i = 0; i < NF; ++i)
#pragma unroll
        for (int r = 0; r < 4; ++r) { const float p = fast_exp2(S[i][r] - mx); S[i][r] = p; ls += p; }
    ls += __shfl_xor(ls, 16); ls += __shfl_xor(ls, 32);
    mx_out = mx; ls_out = ls;
}
template <int MODE> __device__ __forceinline__ void attn_pv(const Frame& F, const AttnDesc& d, const f32x4 (&S)[MODE == 0 ? 9 : 16], float mx, float ls) {
    const LAS unsigned char* ldsV = F.lds + RING_OFF + 65536;
    const int lane = F.lane, w = F.wave, l15 = lane & 15, g4 = lane >> 4;
    constexpr int NF = MODE == 0 ? 9 : 16, NP = (NF + 1) / 2;
    const int f0 = MODE == 0 ? w : 0; const bool half = MODE == 0 && d.kmin != 0;
    f32x4 O[8];
#pragma unroll
    for (int df = 0; df < 8; ++df) O[df] = (f32x4){0.f, 0.f, 0.f, 0.f};
    const int q4 = l15 >> 2, p4 = lane & 3;
#pragma unroll
    for (int pr = 0; pr < NP; ++pr) {
        int fa = f0 + 2 * pr, fb = fa + 1; if (fb > 15) fb = 15;
        if (half && fb < 8) continue;
        if (half && fa < 8) fa = 8;
        const f32x4 pa = S[2 * pr], pb = (2 * pr + 1 < NF) ? S[(2 * pr + 1 < NF) ? 2 * pr + 1 : 0] : (f32x4){0.f, 0.f, 0.f, 0.f};
        v4u pw; pw.x = cvt_pk_bf16(pa.x, pa.y); pw.y = cvt_pk_bf16(pa.z, pa.w); pw.z = cvt_pk_bf16(pb.x, pb.y); pw.w = cvt_pk_bf16(pb.z, pb.w);
        const bf16x8 pf = __builtin_bit_cast(bf16x8, pw);
        const int ra = 16 * fa + 4 * g4 + q4, rb = 16 * fb + 4 * g4 + q4;
#pragma unroll
        for (int df = 0; df < 8; ++df) {
            const s16x4 t1 = vtr(ldsV + voff(ra, 2 * df + (p4 >> 1)) + 8 * (p4 & 1)), t2 = vtr(ldsV + voff(rb, 2 * df + (p4 >> 1)) + 8 * (p4 & 1));
            const bf16x8 vf = {t1[0], t1[1], t1[2], t1[3], t2[0], t2[1], t2[2], t2[3]};
            O[df] = __builtin_amdgcn_mfma_f32_16x16x32_bf16(vf, pf, O[df], 0, 0, 0);
        }
    }
    const float inv = 1.0f / ls;
    const long qrow = d.orow0 + (long)(16 * w + l15) * d.ostride;
    bf16* op = d.Op + qrow * d.opitch + 4 * g4;
#pragma unroll
    for (int df = 0; df < 8; ++df) { const f32x4 o = O[df] * inv; v2u wv; wv.x = cvt_pk_bf16(o.x, o.y); wv.y = cvt_pk_bf16(o.z, o.w); *(v2u*)(op + 16 * df) = wv; }
    if (MODE == 0 && g4 == 0) d.lsep[qrow * 12] = (mx + fast_log2(ls)) * LN2;
}
__device__ __forceinline__ void glds16(const void* gsrc, unsigned lds_dst) { unsigned keep;
    asm volatile("s_mov_b32 %0, m0\n\ts_mov_b32 m0, %2\n\ts_nop 0\n\tglobal_load_lds_dwordx4 %1, off\n\ts_mov_b32 m0, %0" : "=&s"(keep) : "v"(gsrc), "s"(lds_dst) : "memory"); }
__device__ __forceinline__ void attn_dma(const Frame& F, const AttnDesc& d, const bool isV) {
    const bf16* P = isV ? d.Vp : d.Kp;
    const unsigned base = (unsigned)__builtin_amdgcn_readfirstlane((int)(unsigned)(size_t)(F.lds + RING_OFF) + (isV ? 65536 : 0) + F.wave * 8192);
    if (d.kmin != 0 && F.wave < 4) return;
    const int slot = F.lane & 15, rsub = F.lane >> 4;
#pragma unroll
    for (int i = 0; i < 8; ++i) { const int row = 32 * F.wave + 4 * i + rsub, ch = isV ? (slot ^ ((row & 7) << 1)) : (slot ^ (row & 15));
        const bf16* gp = P + (d.krow0 + (long)row * d.kstride) * d.kpitch + ch * 8;
        glds16(gp, base + i * 1024); }
}
__device__ __forceinline__ void attn_loadq(const Frame& F, const AttnDesc& d, bf16x8 (&qf)[4]) {
    const long qrow = d.qrow0 + (long)(16 * F.wave + (F.lane & 15)) * d.qstride;
#pragma unroll
    for (int s = 0; s < 4; ++s) qf[s] = *(const bf16x8*)(d.Qp + qrow * d.qpitch + 32 * s + 8 * (F.lane >> 4));
}
#define ATT_BAR() do { asm volatile("s_waitcnt lgkmcnt(0)" ::: "memory"); __builtin_amdgcn_s_barrier(); asm volatile("" ::: "memory"); } while (0)
template <int MODE, int NU> __device__ __forceinline__ void attn_batch(const Frame& F, int id0) {
    AttnDesc d = attn_desc<MODE>(F, id0);
    bf16x8 qn[4], qc[4];
    attn_dma(F, d, false); attn_loadq(F, d, qn);
#pragma unroll
    for (int s = 0; s < 4; ++s) qc[s] = qn[s];
    attn_dma(F, d, true);
#pragma unroll 1
    for (int u = 0; u < NU; ++u) {
        asm volatile("s_waitcnt vmcnt(8)" ::: "memory"); ATT_BAR();
        f32x4 S[MODE == 0 ? 9 : 16]; float mx, ls;
        attn_scores<MODE>(F, d, qc, S, mx, ls);
        asm volatile("s_waitcnt vmcnt(0)" ::: "memory"); ATT_BAR();
        const bool more = u + 1 < NU;
        const AttnDesc dn = attn_desc<MODE>(F, id0 + (more ? u + 1 : u));
        if (more) { attn_dma(F, dn, false); if (MODE == 0) attn_loadq(F, dn, qn); }
        attn_pv<MODE>(F, d, S, mx, ls);
        ATT_BAR();
        if (more) {
            if (MODE != 0) attn_loadq(F, dn, qn);
#pragma unroll
            for (int s = 0; s < 4; ++s) qc[s] = qn[s];
            asm volatile("" : "+v"(qc[0]), "+v"(qc[1]), "+v"(qc[2]), "+v"(qc[3]));
            attn_dma(F, dn, true); }
        d = dn;
    }
    asm volatile("s_waitcnt vmcnt(0)" ::: "memory");
}
__device__ __forceinline__ void p4_sample_attn(const Frame& F, int wt, const float* c0, const float* c1, const float* c2, const float* cm) {
    unsigned char* ws = F.ws; const int lane = F.lane, sub = lane & 15, t = lane >> 4;
    const int db = wt >> 4, h = (wt >> 2) & 3, src = wt & 3;
    const int row = MP + db * 4 + t;
    const bf16* qp = src < 3 ? (const bf16*)(ws + WS_QS) + (size_t)row * 1536 + src * 512 + h * 128 + 8 * sub : (const bf16*)(ws + WS_MQ) + (size_t)row * 512 + h * 128 + 8 * sub;
    float q[8]; { const v4u qw = *(const v4u*)qp; q[0] = bflo(qw.x); q[1] = bfhi(qw.x); q[2] = bflo(qw.y); q[3] = bfhi(qw.y); q[4] = bflo(qw.z); q[5] = bfhi(qw.z); q[6] = bflo(qw.w); q[7] = bfhi(qw.w); }
    float mx = -3.0e38f, ls = 0.f, o[8];
#pragma unroll
    for (int j = 0; j < 8; ++j) o[j] = 0.f;
#define SA_STEP(K0, K1, V0, V1) do { float s_ = (q[0] * K0.x + q[1] * K0.y) + (q[2] * K0.z + q[3] * K0.w) + (q[4] * K1.x + q[5] * K1.y) + (q[6] * K1.z + q[7] * K1.w); \
        s_ += __shfl_xor(s_, 1); s_ += __shfl_xor(s_, 2); s_ += __shfl_xor(s_, 4); s_ += __shfl_xor(s_, 8); \
        const float mn_ = fmaxf(mx, s_), sc_ = fast_exp2(mx - mn_), p_ = fast_exp2(s_ - mn_); mx = mn_; ls = ls * sc_ + p_; \
        o[0] = o[0] * sc_ + p_ * V0.x; o[1] = o[1] * sc_ + p_ * V0.y; o[2] = o[2] * sc_ + p_ * V0.z; o[3] = o[3] * sc_ + p_ * V0.w; \
        o[4] = o[4] * sc_ + p_ * V1.x; o[5] = o[5] * sc_ + p_ * V1.y; o[6] = o[6] * sc_ + p_ * V1.z; o[7] = o[7] * sc_ + p_ * V1.w; } while (0)
    int nstart = 0, NK; const float* cache; int L = 256, dil = 1;
    if (src == 3) { cache = cm; NK = 256; }
    else { cache = src == 0 ? c0 : (src == 1 ? c1 : c2); L = 128 << (2 * src); dil = src == 0 ? 1 : (src == 1 ? 4 : 16); NK = 129; nstart = 4;
        for (int n = 0; n < 4; ++n) {
            const int idx = L + t - dil * n; f32x4 k0, k1, v0, v1;
            if (idx >= L) { const size_t ro = (size_t)(MP + db * 4 + (idx - L)) * 1536 + src * 512 + h * 128 + 8 * sub;
                const v4u kw = *(const v4u*)((const bf16*)(ws + WS_KS) + ro), vw = *(const v4u*)((const bf16*)(ws + WS_VS) + ro);
                k0 = (f32x4){bflo(kw.x), bfhi(kw.x), bflo(kw.y), bfhi(kw.y)}; k1 = (f32x4){bflo(kw.z), bfhi(kw.z), bflo(kw.w), bfhi(kw.w)};
                v0 = (f32x4){bflo(vw.x), bfhi(vw.x), bflo(vw.y), bfhi(vw.y)}; v1 = (f32x4){bflo(vw.z), bfhi(vw.z), bflo(vw.w), bfhi(vw.w)};
            } else { const float* kp = cache + (((size_t)db * L + idx) * 2) * 512 + h * 128 + 8 * sub;
                k0 = *(const f32x4*)kp; k1 = *(const f32x4*)(kp + 4); v0 = *(const f32x4*)(kp + 512); v1 = *(const f32x4*)(kp + 516); }
            SA_STEP(k0, k1, v0, v1);
        }
    }
    const float* kbase = cache + ((size_t)db * L * 2) * 512 + h * 128 + 8 * sub;
    const long kstep = src == 3 ? 1024 : -(long)dil * 1024; const long kfirst = src == 3 ? 0 : (long)(L + t) * 1024;
    int n = nstart;
    for (; n + 4 <= NK; n += 4) {
        f32x4 kk[4][2], vv[4][2];
#pragma unroll
        for (int j = 0; j < 4; ++j) { const float* kp = kbase + kfirst + (long)(n + j) * kstep; kk[j][0] = *(const f32x4*)kp; kk[j][1] = *(const f32x4*)(kp + 4); vv[j][0] = *(const f32x4*)(kp + 512); vv[j][1] = *(const f32x4*)(kp + 516); }
#pragma unroll
        for (int j = 0; j < 4; ++j) SA_STEP(kk[j][0], kk[j][1], vv[j][0], vv[j][1]);
    }
    for (; n < NK; ++n) { const float* kp = kbase + kfirst + (long)n * kstep; const f32x4 k0 = *(const f32x4*)kp, k1 = *(const f32x4*)(kp + 4), v0 = *(const f32x4*)(kp + 512), v1 = *(const f32x4*)(kp + 516); SA_STEP(k0, k1, v0, v1); }
#undef SA_STEP
    const float inv = 1.0f / ls;
    v4u w; w.x = cvt_pk_bf16(o[0] * inv, o[1] * inv); w.y = cvt_pk_bf16(o[2] * inv, o[3] * inv); w.z = cvt_pk_bf16(o[4] * inv, o[5] * inv); w.w = cvt_pk_bf16(o[6] * inv, o[7] * inv);
    if (src < 3) { *(v4u*)((bf16*)(ws + WS_OG) + (size_t)row * 1536 + src * 512 + h * 128 + 8 * sub) = w; if (sub == 0) ((float*)(ws + WS_LSE))[(size_t)row * 12 + src * 4 + h] = (mx + fast_log2(ls)) * LN2; }
    else *(v4u*)((bf16*)(ws + WS_OALL) + (size_t)row * 1536 + 1024 + h * 128 + 8 * sub) = w;
}
__device__ __forceinline__ void p4_sample_attn_shared(const Frame& F, int db, int h, const bool is_mem, const float* cache) {
    unsigned char* ws = F.ws; const int lane = F.lane, sub = lane & 15, gk = lane >> 4; const int rowq0 = MP + db * 4;
    float qv[4][8];
#pragma unroll
    for (int t = 0; t < 4; ++t) { const bf16* qp = is_mem ? (const bf16*)(ws + WS_MQ) + (size_t)(rowq0 + t) * 512 + h * 128 + 8 * sub : (const bf16*)(ws + WS_QS) + (size_t)(rowq0 + t) * 1536 + h * 128 + 8 * sub;
        const v4u qw = *(const v4u*)qp; qv[t][0] = bflo(qw.x); qv[t][1] = bfhi(qw.x); qv[t][2] = bflo(qw.y); qv[t][3] = bfhi(qw.y); qv[t][4] = bflo(qw.z); qv[t][5] = bfhi(qw.z); qv[t][6] = bflo(qw.w); qv[t][7] = bfhi(qw.w); }
    float m[4], l[4], o[4][8];
#pragma unroll
    for (int t = 0; t < 4; ++t) { m[t] = -3.0e38f; l[t] = 0.f;
#pragma unroll
        for (int j = 0; j < 8; ++j) o[t][j] = 0.f; }
#define SS_STEP(P, K0, K1, V0, V1) do { _Pragma("unroll") for (int t = 0; t < 4; ++t) { \
        float s_ = (qv[t][0] * K0.x + qv[t][1] * K0.y) + (qv[t][2] * K0.z + qv[t][3] * K0.w) + (qv[t][4] * K1.x + qv[t][5] * K1.y) + (qv[t][6] * K1.z + qv[t][7] * K1.w); \
        s_ += __shfl_xor(s_, 1); s_ += __shfl_xor(s_, 2); s_ += __shfl_xor(s_, 4); s_ += __shfl_xor(s_, 8); \
        const bool ok_ = is_mem || ((P) >= t && (P) <= 128 + t); \
        const float mn_ = ok_ ? fmaxf(m[t], s_) : m[t], sc_ = fast_exp2(m[t] - mn_), p_ = ok_ ? fast_exp2(s_ - mn_) : 0.f; m[t] = mn_; l[t] = l[t] * sc_ + p_; \
        o[t][0] = o[t][0] * sc_ + p_ * V0.x; o[t][1] = o[t][1] * sc_ + p_ * V0.y; o[t][2] = o[t][2] * sc_ + p_ * V0.z; o[t][3] = o[t][3] * sc_ + p_ * V0.w; \
        o[t][4] = o[t][4] * sc_ + p_ * V1.x; o[t][5] = o[t][5] * sc_ + p_ * V1.y; o[t][6] = o[t][6] * sc_ + p_ * V1.z; o[t][7] = o[t][7] * sc_ + p_ * V1.w; } } while (0)
    const int L = is_mem ? 256 : 128;
    const float* kbase = cache + ((size_t)db * L * 2) * 512 + h * 128 + 8 * sub + (size_t)gk * 1024;
    for (int j = 0; j < L / 4; j += 4) {
        f32x4 kk[4][2], vv[4][2];
#pragma unroll
        for (int e = 0; e < 4; ++e) { const float* kp = kbase + (size_t)(j + e) * 4096; kk[e][0] = *(const f32x4*)kp; kk[e][1] = *(const f32x4*)(kp + 4); vv[e][0] = *(const f32x4*)(kp + 512); vv[e][1] = *(const f32x4*)(kp + 516); }
#pragma unroll
        for (int e = 0; e < 4; ++e) SS_STEP(4 * (j + e) + gk, kk[e][0], kk[e][1], vv[e][0], vv[e][1]);
    }
    if (!is_mem) {
        const size_t ro = (size_t)(rowq0 + gk) * 1536 + h * 128 + 8 * sub;
        const v4u kw = *(const v4u*)((const bf16*)(ws + WS_KS) + ro), vw = *(const v4u*)((const bf16*)(ws + WS_VS) + ro);
        const f32x4 k0 = {bflo(kw.x), bfhi(kw.x), bflo(kw.y), bfhi(kw.y)}, k1 = {bflo(kw.z), bfhi(kw.z), bflo(kw.w), bfhi(kw.w)};
        const f32x4 v0 = {bflo(vw.x), bfhi(vw.x), bflo(vw.y), bfhi(vw.y)}, v1 = {bflo(vw.z), bfhi(vw.z), bflo(vw.w), bfhi(vw.w)};
        SS_STEP(128 + gk, k0, k1, v0, v1);
    }
#undef SS_STEP
    float mo = 0.f, lo = 1.f, oo[8];
#pragma unroll
    for (int j = 0; j < 8; ++j) oo[j] = 0.f;
#pragma unroll
    for (int t = 0; t < 4; ++t) {
        float mm = fmaxf(m[t], __shfl_xor(m[t], 16)); mm = fmaxf(mm, __shfl_xor(mm, 32));
        const float f = fast_exp2(m[t] - mm); float lt = l[t] * f; lt += __shfl_xor(lt, 16); lt += __shfl_xor(lt, 32);
        if (gk == t) { mo = mm; lo = lt; }
#pragma unroll
        for (int j = 0; j < 8; ++j) { float x = o[t][j] * f; x += __shfl_xor(x, 16); x += __shfl_xor(x, 32); if (gk == t) oo[j] = x; }
    }
    const float inv = 1.0f / lo; const int row = rowq0 + gk;
    v4u w; w.x = cvt_pk_bf16(oo[0] * inv, oo[1] * inv); w.y = cvt_pk_bf16(oo[2] * inv, oo[3] * inv); w.z = cvt_pk_bf16(oo[4] * inv, oo[5] * inv); w.w = cvt_pk_bf16(oo[6] * inv, oo[7] * inv);
    if (is_mem) *(v4u*)((bf16*)(ws + WS_OALL) + (size_t)row * 1536 + 1024 + h * 128 + 8 * sub) = w;
    else { *(v4u*)((bf16*)(ws + WS_OG) + (size_t)row * 1536 + h * 128 + 8 * sub) = w; if (sub == 0) ((float*)(ws + WS_LSE))[(size_t)row * 12 + h] = (mo + fast_log2(lo)) * LN2; }
}
__device__ __forceinline__ void p4_sample_task(const Frame& F, int it, const float* c0, const float* c1, const float* c2, const float* cm) {
    const int kind = it >> 9, idx = it & 511, db = idx >> 2, h = idx & 3;
    if (kind == 0) p4_sample_attn(F, db * 16 + h * 4 + 2, c0, c1, c2, cm);
    else if (kind == 1) p4_sample_attn(F, db * 16 + h * 4 + 1, c0, c1, c2, cm);
    else if (kind == 2) p4_sample_attn_shared(F, db, h, true, cm);
    else p4_sample_attn_shared(F, db, h, false, c0);
}
__device__ __forceinline__ void p4_sample_loop(const Frame& F, const float* c0, const float* c1, const float* c2, const float* cm, int q = 0) {
    gu32* qw = (gu32*)(F.ws + WS_CTL) + 64 + 64 * q;
    for (;;) { unsigned v = 0; if (F.lane == 0) v = __hip_atomic_fetch_add(qw, 1u, RLX_AGENT); const int it = (int)__builtin_amdgcn_readfirstlane(v);
        if (it >= 2048) break; p4_sample_task(F, it, c0, c1, c2, cm); }
}
__device__ __forceinline__ void p4_gla_chain(const Frame& F, int row0, int T, int h, const float* S0, float* Sout) {
    unsigned char* ws = F.ws; const int tid = F.tid, v = tid & 127, ks = __builtin_amdgcn_readfirstlane(tid >> 7);
    const float* GA = (const float*)(ws + WS_GA); const bf16* GQ = (const bf16*)(ws + WS_GQ); const bf16* GK = (const bf16*)(ws + WS_GK); const bf16* GV = (const bf16*)(ws + WS_GV); bf16* GO = (bf16*)(ws + WS_GO);
    LAS float* part = (LAS float*)(F.lds + RING_OFF);
    float S[16];
#pragma unroll
    for (int i = 0; i < 16; ++i) S[i] = S0 ? S0[(size_t)(16 * ks + i) * 128 + v] : 0.f;
    for (int t0 = 0; t0 < T; t0 += 16) {
        const int nb = (T - t0) < 16 ? (T - t0) : 16;
        __syncthreads();
        for (int tt = 0; tt < nb; ++tt) {
            const size_t row = (size_t)(row0 + t0 + tt);
            const float* ap = GA + row * 256 + h * 64 + 16 * ks; const v4u kw0 = *(const v4u*)(GK + row * 256 + h * 64 + 16 * ks), kw1 = *(const v4u*)(GK + row * 256 + h * 64 + 16 * ks + 8);
            const v4u qw0 = *(const v4u*)(GQ + row * 256 + h * 64 + 16 * ks), qw1 = *(const v4u*)(GQ + row * 256 + h * 64 + 16 * ks + 8);
            const float vv = bf2f(GV[row * 512 + h * 128 + v]);
            const f32x4 a0 = *(const f32x4*)ap, a1 = *(const f32x4*)(ap + 4), a2 = *(const f32x4*)(ap + 8), a3 = *(const f32x4*)(ap + 12);
            const float la[16] = {a0.x, a0.y, a0.z, a0.w, a1.x, a1.y, a1.z, a1.w, a2.x, a2.y, a2.z, a2.w, a3.x, a3.y, a3.z, a3.w};
            const float kk[16] = {bflo(kw0.x), bfhi(kw0.x), bflo(kw0.y), bfhi(kw0.y), bflo(kw0.z), bfhi(kw0.z), bflo(kw0.w), bfhi(kw0.w), bflo(kw1.x), bfhi(kw1.x), bflo(kw1.y), bfhi(kw1.y), bflo(kw1.z), bfhi(kw1.z), bflo(kw1.w), bfhi(kw1.w)};
            const float qq[16] = {bflo(qw0.x), bfhi(qw0.x), bflo(qw0.y), bfhi(qw0.y), bflo(qw0.z), bfhi(qw0.z), bflo(qw0.w), bfhi(qw0.w), bflo(qw1.x), bfhi(qw1.x), bflo(qw1.y), bfhi(qw1.y), bflo(qw1.z), bfhi(qw1.z), bflo(qw1.w), bfhi(qw1.w)};
            float o = 0.f;
#pragma unroll
            for (int i = 0; i < 16; ++i) { S[i] = fast_exp2(la[i] * 1.4426950408889634f) * S[i] + kk[i] * vv; o += qq[i] * S[i]; }
            part[(tt * 4 + ks) * 128 + v] = o;
        }
        __syncthreads();
        for (int e = tid; e < nb * 128; e += 512) { const int tt = e >> 7, vv_ = e & 127;
            GO[(size_t)(row0 + t0 + tt) * 512 + h * 128 + vv_] = (bf16)f2bf((part[(tt * 4 + 0) * 128 + vv_] + part[(tt * 4 + 1) * 128 + vv_]) + (part[(tt * 4 + 2) * 128 + vv_] + part[(tt * 4 + 3) * 128 + vv_])); }
    }
#pragma unroll
    for (int i = 0; i < 16; ++i) Sout[(size_t)(16 * ks + i) * 128 + v] = S[i];
}
constexpr int GL_QE = 0, GL_KE = 8192, GL_KDT = 16384, GL_VV = 24576, GL_EB = 40960, GL_TOT = 41216, GL_SET = 43264;
__device__ __forceinline__ int goff(int r, int c) { return 128 * r + 16 * (c ^ ((r >> 1) & 7)); }
__device__ __forceinline__ int gvoff(int row, int ch) { return 256 * row + 16 * (ch ^ (((row & 3) | ((((row >> 2) ^ (row >> 3)) & 1) << 2)) << 1)); }
__device__ __forceinline__ void p4_gla_chain_mfma(const Frame& F, int c) {
    unsigned char* ws = F.ws; const int tid = F.tid, lane = F.lane, w = F.wave, l15 = lane & 15, g4 = lane >> 4, q4 = l15 >> 2, p4 = lane & 3;
    const int b = c >> 2, h = c & 3; const size_t row0 = (size_t)b * SEQ;
    const float* GA = (const float*)(ws + WS_GA) + h * 64 + lane; const bf16* GQ = (const bf16*)(ws + WS_GQ) + h * 64 + lane; const bf16* GK = (const bf16*)(ws + WS_GK) + h * 64 + lane;
    const bf16* GV = (const bf16*)(ws + WS_GV) + h * 128 + (tid & 15) * 8; bf16* GO = (bf16*)(ws + WS_GO) + h * 128 + 16 * w + 4 * g4;
    constexpr float L2E = 1.4426950408889634f;
    f32x4 S[4];
#pragma unroll
    for (int K = 0; K < 4; ++K) S[K] = (f32x4){0.f, 0.f, 0.f, 0.f};
    float la[8]; unsigned short qh[8], kh[8]; v4u vr[2];
#define GLA_LOAD(ch) do { const size_t r_ = row0 + 64 * (size_t)(ch); \
        _Pragma("unroll") for (int t = 0; t < 8; ++t) { const size_t rr_ = (r_ + 8 * w + t) * 256; la[t] = GA[rr_]; qh[t] = GQ[rr_]; kh[t] = GK[rr_]; } \
        _Pragma("unroll") for (int e = 0; e < 2; ++e) vr[e] = *(const v4u*)(GV + (r_ + (tid >> 4) + 32 * e) * 512); } while (0)
    GLA_LOAD(0);
#pragma unroll 1
    for (int ch = 0; ch < SEQ / 64; ++ch) {
        LAS unsigned char* B = F.lds + RING_OFF + (ch & 1) * GL_SET;
        LAS float* TOT = (LAS float*)(B + GL_TOT); LAS float* EB = (LAS float*)(B + GL_EB);
        float cs[8], qv[8], kvv[8];
        cs[0] = la[0];
#pragma unroll
        for (int t = 1; t < 8; ++t) cs[t] = cs[t - 1] + la[t];
#pragma unroll
        for (int t = 0; t < 8; ++t) { qv[t] = bf2f(qh[t]); kvv[t] = bf2f(kh[t]); }
        TOT[w * 64 + lane] = cs[7];
#pragma unroll
        for (int e = 0; e < 2; ++e) *(LAS v4u*)(B + GL_VV + gvoff((tid >> 4) + 32 * e, tid & 15)) = vr[e];
        __syncthreads();
        float offs = 0.f, total = 0.f;
#pragma unroll
        for (int g = 0; g < 8; ++g) { const float tg = TOT[g * 64 + lane]; total += tg; offs += (g < w) ? tg : 0.f; }
        unsigned kd[8];
#pragma unroll
        for (int t = 0; t < 8; ++t) { const float bt = offs + cs[t]; const int i = 8 * w + t;
            const float e1 = fast_exp2(bt * L2E), e2 = fast_exp2(-bt * L2E), e3 = fast_exp2((total - bt) * L2E);
            *(LAS unsigned short*)(B + GL_QE + goff(i, lane >> 3) + 2 * (lane & 7)) = (unsigned short)f2bf(qv[t] * e1);
            *(LAS unsigned short*)(B + GL_KE + goff(i, lane >> 3) + 2 * (lane & 7)) = (unsigned short)f2bf(kvv[t] * e2);
            kd[t] = f2bf(kvv[t] * e3); }
        { v4u kw; kw.x = kd[0] | (kd[1] << 16); kw.y = kd[2] | (kd[3] << 16); kw.z = kd[4] | (kd[5] << 16); kw.w = kd[6] | (kd[7] << 16); *(LAS v4u*)(B + GL_KDT + goff(lane, w)) = kw; }
        if (w == 0) EB[lane] = fast_exp2(total * L2E);
        if (ch + 1 < SEQ / 64) GLA_LOAD(ch + 1);
        __syncthreads();
        const LAS unsigned char* QE = B + GL_QE; const LAS unsigned char* KE = B + GL_KE; const LAS unsigned char* KDT = B + GL_KDT; const LAS unsigned char* VV = B + GL_VV;
        bf16x8 kef[4][2];
#pragma unroll
        for (int J = 0; J < 4; ++J)
#pragma unroll
            for (int s = 0; s < 2; ++s) kef[J][s] = *(const LAS bf16x8*)(KE + goff(16 * J + l15, 4 * s + g4));
        bf16x8 vpr[2], vnat[2];
#pragma unroll
        for (int pp = 0; pp < 2; ++pp) { const int ra = 32 * pp + 4 * g4 + q4, rb = ra + 16;
            const s16x4 t1 = vtr(VV + gvoff(ra, 2 * w + (p4 >> 1)) + 8 * (p4 & 1)), t2 = vtr(VV + gvoff(rb, 2 * w + (p4 >> 1)) + 8 * (p4 & 1));
            vpr[pp] = (bf16x8){t1[0], t1[1], t1[2], t1[3], t2[0], t2[1], t2[2], t2[3]}; }
#pragma unroll
        for (int s = 0; s < 2; ++s) { const int r1 = 32 * s + 8 * g4 + q4, r2 = r1 + 4;
            const s16x4 t1 = vtr(VV + gvoff(r1, 2 * w + (p4 >> 1)) + 8 * (p4 & 1)), t2 = vtr(VV + gvoff(r2, 2 * w + (p4 >> 1)) + 8 * (p4 & 1));
            vnat[s] = (bf16x8){t1[0], t1[1], t1[2], t1[3], t2[0], t2[1], t2[2], t2[3]}; }
        bf16x8 sfr[2];
#pragma unroll
        for (int p = 0; p < 2; ++p) { v4u sw; sw.x = cvt_pk_bf16(S[2 * p].x, S[2 * p].y); sw.y = cvt_pk_bf16(S[2 * p].z, S[2 * p].w); sw.z = cvt_pk_bf16(S[2 * p + 1].x, S[2 * p + 1].y); sw.w = cvt_pk_bf16(S[2 * p + 1].z, S[2 * p + 1].w); sfr[p] = __builtin_bit_cast(bf16x8, sw); }
#pragma unroll
        for (int I = 0; I < 4; ++I) {
            f32x4 oT = (f32x4){0.f, 0.f, 0.f, 0.f};
#pragma unroll
            for (int p = 0; p < 2; ++p) {
                const v2u lo = *(const LAS v2u*)(QE + goff(16 * I + l15, 4 * p + (g4 >> 1)) + 8 * (g4 & 1)), hi = *(const LAS v2u*)(QE + goff(16 * I + l15, 4 * p + 2 + (g4 >> 1)) + 8 * (g4 & 1));
                const v4u bw = {lo.x, lo.y, hi.x, hi.y};
                oT = __builtin_amdgcn_mfma_f32_16x16x32_bf16(sfr[p], __builtin_bit_cast(bf16x8, bw), oT, 0, 0, 0); }
            bf16x8 qef[2];
#pragma unroll
            for (int s = 0; s < 2; ++s) qef[s] = *(const LAS bf16x8*)(QE + goff(16 * I + l15, 4 * s + g4));
            f32x4 d1[4];
#pragma unroll
            for (int J = 0; J < 4; ++J) { d1[J] = (f32x4){0.f, 0.f, 0.f, 0.f};
                if (J <= I) {
#pragma unroll
                    for (int s = 0; s < 2; ++s) d1[J] = __builtin_amdgcn_mfma_f32_16x16x32_bf16(kef[J][s], qef[s], d1[J], 0, 0, 0);
                    if (J == I) {
#pragma unroll
                        for (int r = 0; r < 4; ++r) d1[J][r] = (4 * g4 + r <= l15) ? d1[J][r] : 0.f; } } }
#pragma unroll
            for (int pp = 0; pp < 2; ++pp) if (2 * pp <= I) {
                const f32x4 pa = d1[2 * pp], pb = d1[2 * pp + 1];
                v4u pw; pw.x = cvt_pk_bf16(pa.x, pa.y); pw.y = cvt_pk_bf16(pa.z, pa.w); pw.z = cvt_pk_bf16(pb.x, pb.y); pw.w = cvt_pk_bf16(pb.z, pb.w);
                oT = __builtin_amdgcn_mfma_f32_16x16x32_bf16(vpr[pp], __builtin_bit_cast(bf16x8, pw), oT, 0, 0, 0); }
            { v2u ow; ow.x = cvt_pk_bf16(oT.x, oT.y); ow.y = cvt_pk_bf16(oT.z, oT.w); *(v2u*)(GO + (row0 + 64 * (size_t)ch + 16 * I + l15) * 512) = ow; }
        }
#pragma unroll
        for (int K = 0; K < 4; ++K) {
            const f32x4 ebv = *(const LAS f32x4*)(EB + 16 * K + 4 * g4); S[K] *= ebv;
#pragma unroll
            for (int s = 0; s < 2; ++s) { const bf16x8 kdf = *(const LAS bf16x8*)(KDT + goff(16 * K + l15, 4 * s + g4)); S[K] = __builtin_amdgcn_mfma_f32_16x16x32_bf16(kdf, vnat[s], S[K], 0, 0, 0); } }
    }
#undef GLA_LOAD
    float* so = F.out + O_GLAP + (size_t)c * 64 * 128 + 16 * w + l15;
#pragma unroll
    for (int K = 0; K < 4; ++K)
#pragma unroll
        for (int r = 0; r < 4; ++r) so[(size_t)(16 * K + 4 * g4 + r) * 128] = S[K][r];
}
template <int NR> __device__ __forceinline__ void p5_combine_rows(const Frame& F, int row0, int rstride) {
    unsigned char* ws = F.ws; const int lane = F.lane, hh = lane >> 4, sub = lane & 15, col = hh * 128 + 8 * sub;
    float l0[NR], l1[NR], l2[NR]; v4u a[NR], b[NR], c[NR], gow[NR], gr[NR];
    const float* gg = F.i15 + 8 * sub; const f32x4 g0 = *(const f32x4*)gg, g1 = *(const f32x4*)(gg + 4);
#pragma unroll
    for (int r = 0; r < NR; ++r) { const int row = row0 + r * rstride;
        const float* lse = (const float*)(ws + WS_LSE) + (size_t)row * 12; l0[r] = lse[hh]; l1[r] = lse[4 + hh]; l2[r] = lse[8 + hh];
        const bf16* og = (const bf16*)(ws + WS_OG) + (size_t)row * 1536 + col; a[r] = *(const v4u*)og; b[r] = *(const v4u*)(og + 512); c[r] = *(const v4u*)(og + 1024);
        gow[r] = *(const v4u*)((const bf16*)(ws + WS_GO) + (size_t)row * 512 + col); gr[r] = *(const v4u*)((const bf16*)(ws + WS_GRS) + (size_t)row * 512 + col); }
#pragma unroll
    for (int r = 0; r < NR; ++r) { const int row = row0 + r * rstride;
        const float mx = fmaxf(l0[r], fmaxf(l1[r], l2[r]));
        float w0 = __expf(l0[r] - mx), w1 = __expf(l1[r] - mx), w2 = __expf(l2[r] - mx); const float wi = 1.0f / (w0 + w1 + w2); w0 *= wi; w1 *= wi; w2 *= wi;
        v4u o;
        o.x = cvt_pk_bf16(w0 * bflo(a[r].x) + w1 * bflo(b[r].x) + w2 * bflo(c[r].x), w0 * bfhi(a[r].x) + w1 * bfhi(b[r].x) + w2 * bfhi(c[r].x));
        o.y = cvt_pk_bf16(w0 * bflo(a[r].y) + w1 * bflo(b[r].y) + w2 * bflo(c[r].y), w0 * bfhi(a[r].y) + w1 * bfhi(b[r].y) + w2 * bfhi(c[r].y));
        o.z = cvt_pk_bf16(w0 * bflo(a[r].z) + w1 * bflo(b[r].z) + w2 * bflo(c[r].z), w0 * bfhi(a[r].z) + w1 * bfhi(b[r].z) + w2 * bfhi(c[r].z));
        o.w = cvt_pk_bf16(w0 * bflo(a[r].w) + w1 * bflo(b[r].w) + w2 * bflo(c[r].w), w0 * bfhi(a[r].w) + w1 * bfhi(b[r].w) + w2 * bfhi(c[r].w));
        bf16* oall = (bf16*)(ws + WS_OALL) + (size_t)row * 1536;
        *(v4u*)(oall + col) = o;
        const f32x4 x0 = {bflo(gow[r].x), bfhi(gow[r].x), bflo(gow[r].y), bfhi(gow[r].y)}, x1 = {bflo(gow[r].z), bfhi(gow[r].z), bflo(gow[r].w), bfhi(gow[r].w)};
        float ss = (x0.x * x0.x + x0.y * x0.y) + (x0.z * x0.z + x0.w * x0.w) + (x1.x * x1.x + x1.y * x1.y) + (x1.z * x1.z + x1.w * x1.w);
        ss += __shfl_xor(ss, 1); ss += __shfl_xor(ss, 2); ss += __shfl_xor(ss, 4); ss += __shfl_xor(ss, 8);
        const float rstd = 1.0f / sqrtf(ss * (1.f / 128.f) + EPS);
        v4u y;
        y.x = cvt_pk_bf16(x0.x * rstd * g0.x * bflo(gr[r].x), x0.y * rstd * g0.y * bfhi(gr[r].x)); y.y = cvt_pk_bf16(x0.z * rstd * g0.z * bflo(gr[r].y), x0.w * rstd * g0.w * bfhi(gr[r].y));
        y.z = cvt_pk_bf16(x1.x * rstd * g1.x * bflo(gr[r].z), x1.y * rstd * g1.y * bfhi(gr[r].z)); y.w = cvt_pk_bf16(x1.z * rstd * g1.z * bflo(gr[r].w), x1.w * rstd * g1.w * bfhi(gr[r].w));
        *(v4u*)(oall + 512 + col) = y; }
}
template <int NR> __device__ __forceinline__ void p10_final_rows(const Frame& F, int row0, int rstride) {
    const GAS f32x4* gr = (const GAS f32x4*)F.i24 + 2 * F.lane; const f32x4 g00 = gr[0], g01 = gr[1], g10 = gr[128], g11 = gr[129];
    v4u v[NR][2];
#pragma unroll
    for (int r = 0; r < NR; ++r) { const GAS v4u* xr = (const GAS v4u*)((const bf16*)(F.ws + WS_Y16) + (size_t)(row0 + r * rstride) * D) + F.lane; v[r][0] = xr[0]; v[r][1] = xr[64]; }
#pragma unroll
    for (int r = 0; r < NR; ++r) { float x[2][8]; float s = 0.f;
#pragma unroll
        for (int j = 0; j < 2; ++j) { x[j][0] = bflo(v[r][j].x); x[j][1] = bfhi(v[r][j].x); x[j][2] = bflo(v[r][j].y); x[j][3] = bfhi(v[r][j].y); x[j][4] = bflo(v[r][j].z); x[j][5] = bfhi(v[r][j].z); x[j][6] = bflo(v[r][j].w); x[j][7] = bfhi(v[r][j].w);
#pragma unroll
            for (int e = 0; e < 8; ++e) s += x[j][e] * x[j][e]; }
        const float rstd = 1.0f / sqrtf(wave_sum(s) * (1.f / D) + EPS);
        GAS f32x4* yr = (GAS f32x4*)(F.out + (size_t)(row0 + r * rstride) * D) + 2 * F.lane;
        yr[0] = (f32x4){x[0][0] * rstd * g00.x, x[0][1] * rstd * g00.y, x[0][2] * rstd * g00.z, x[0][3] * rstd * g00.w};
        yr[1] = (f32x4){x[0][4] * rstd * g01.x, x[0][5] * rstd * g01.y, x[0][6] * rstd * g01.z, x[0][7] * rstd * g01.w};
        yr[128] = (f32x4){x[1][0] * rstd * g10.x, x[1][1] * rstd * g10.y, x[1][2] * rstd * g10.z, x[1][3] * rstd * g10.w};
        yr[129] = (f32x4){x[1][4] * rstd * g11.x, x[1][5] * rstd * g11.y, x[1][6] * rstd * g11.z, x[1][7] * rstd * g11.w}; }
}
__device__ __forceinline__ void phase1(Frame& F) {
    unsigned char* ws = F.ws; const int G = F.G, bx = (int)blockIdx.x;
    { pg8::Gemm g{(const bf16*)(ws + WS_XB), (const bf16*)(ws + WS_W1A), MR, 2 * FF, D, D, D}; typedef pg8::StaticOrderT<MR / 256, 2 * FF / 256> SO; SO S; S.init(MR, 2 * FF, G, bx);
      EpiSwiglu E{(bf16*)(ws + WS_G), nullptr}; pg8::gemm_phase<EpiSwiglu, SO>(F.lds + RING_OFF, g, S, E, F.wave, MK_STAGGER_A); }
    { pg8::Gemm g{(const bf16*)(ws + WS_MEMB), (const bf16*)(ws + WS_WMEM), MM, D, D, D, D}; typedef pg8::StaticOrderT<MM / 256, D / 256> SO; SO S; S.init(MM, D, G, (bx + G / 2) % G);
      EpiMemKV E{F.out + O_MEMKV, (bf16*)(ws + WS_MKV)}; pg8::gemm_phase<EpiMemKV, SO>(F.lds + RING_OFF, g, S, E, F.wave); }
}
__device__ __forceinline__ void phase2(Frame& F) {
    unsigned char* ws = F.ws; const int G = F.G, bx = (int)blockIdx.x;
    pg8::Gemm g{(const bf16*)(ws + WS_G), (const bf16*)(ws + WS_W1O), MR, D, FF, 64, FF};   typedef pg8::StaticOrderT<MR / 256, D / 256> SO; SO S; S.init(MR, D, G, bx);
    EpiResidX<true> E{F.i0, F.i1, (bf16*)(ws + WS_HB), (float*)(ws + WS_PQ1), 0.5f};
    S.lim = 1024; S.rev = 1; pg8::gemm_phase<EpiResidX<true>, SO, true, true>(F.lds + RING_OFF, g, S, E, F.wave);
    tail_phase<EpiResidX<true>, true>(F, g.A, 64, g.Bt, FF, FF, E, 0);
}
__device__ __forceinline__ void phase3(Frame& F) {
    unsigned char* ws = F.ws; const int G = F.G, bx = (int)blockIdx.x;
    pg8::Gemm g{(const bf16*)(ws + WS_HB), (const bf16*)(ws + WS_WIN), MR, NZ, D, D, D}; typedef pg8::StaticOrderT<MR / 256, NZ / 256> SO; SO S; S.init(MR, NZ, G, bx);
    EpiZ E{(const float*)(ws + WS_PQ1), (const float*)(ws + WS_ROPE), (const float*)(ws + WS_ROPE) + NPOS * 64, F.i14, F.out,
           (bf16*)(ws + WS_QS), (bf16*)(ws + WS_KS), (bf16*)(ws + WS_VS), (bf16*)(ws + WS_GQ), (bf16*)(ws + WS_GK), (bf16*)(ws + WS_GV), (bf16*)(ws + WS_GRS), (bf16*)(ws + WS_MQ), (bf16*)(ws + WS_GATE), (float*)(ws + WS_GA)};
    pg8::gemm_phase<EpiZ, SO>(F.lds + RING_OFF, g, S, E, F.wave, MK_STAGGER_Z);
}
constexpr int CW_Q = 64;
__device__ __forceinline__ int q_pull(const Frame& F, int q) {
    gu32* qw = (gu32*)(F.ws + WS_CTL) + CW_Q + 64 * q;
    volatile LAS unsigned* slot = (volatile LAS unsigned*)(F.lds + MISC_OFF) + 16;
    __syncthreads();
    if (F.tid == 0) *slot = __hip_atomic_fetch_add(qw, 1u, RLX_AGENT);
    __syncthreads();
    return (int)*slot;
}
__device__ __forceinline__ void phase4(Frame& F, const float* c0, const float* c1, const float* c2, const float* cm) {
    const int bx = (int)blockIdx.x;
    if (bx < NB * 4) p4_gla_chain_mfma(F, bx);
    else p4_sample_loop(F, c0, c1, c2, cm);
#pragma unroll 1
    for (int rep = 0; rep < (MK_P4_REPEAT == 2 ? 2 : 1); ++rep) for (;;) { const int it = q_pull(F, 1 + 4 * rep); if (it >= 768) break; attn_batch<0, 8>(F, 8 * (767 - it)); }
#pragma unroll 1
    for (int rep = 0; rep < (MK_P4_REPEAT == 3 ? 2 : 1); ++rep) for (;;) { const int it = q_pull(F, 2 + 4 * rep); if (it >= 256) break; attn_batch<1, 8>(F, 6144 + 8 * (255 - it)); }
    p4_sample_loop(F, c0, c1, c2, cm);
    if (MK_P4_REPEAT == 1) { __syncthreads(); p4_sample_loop(F, c0, c1, c2, cm, 4); }
    if (MK_P4_REPEAT == 4) { __syncthreads(); if (bx < NB * 4) p4_gla_chain_mfma(F, bx); }
    if (MK_P4_REPEAT == 5) { for (;;) { const int c = q_pull(F, 7); if (c >= DECB * 4) break; p4_gla_chain(F, MP + (c >> 2) * DECT, DECT, c & 3, F.i7 + (size_t)c * 64 * 128, F.out + O_GLAS + (size_t)c * 64 * 128); } }
    for (;;) { const int c = q_pull(F, 3); if (c >= DECB * 4) break; p4_gla_chain(F, MP + (c >> 2) * DECT, DECT, c & 3, F.i7 + (size_t)c * 64 * 128, F.out + O_GLAS + (size_t)c * 64 * 128); }
    if (F.G < NB * 4) { for (int c = F.G + bx; c < NB * 4; c += F.G) p4_gla_chain_mfma(F, c); }
}
__device__ __forceinline__ void phase5(Frame& F) {
    { const int st = F.G * NWAVES; int m = F.vcu * NWAVES + F.wave;
      for (; m + 3 * st < MR; m += 4 * st) p5_combine_rows<4>(F, m, st);
      for (; m < MR; m += st) p5_combine_rows<1>(F, m, st); }
}
__device__ __forceinline__ void phase6(Frame& F) {
    unsigned char* ws = F.ws; const int G = F.G, bx = (int)blockIdx.x;
    pg8::Gemm g{(const bf16*)(ws + WS_OALL), (const bf16*)(ws + WS_WBR), MR, D, 1536, 1536, 1536}; typedef pg8::StaticOrderT<MR / 256, D / 256> SO; SO S; S.init(MR, D, G, bx);
    S.lim = 1024; S.rev = 1; EpiMerge1 E{(const bf16*)(ws + WS_GATE), (bf16*)(ws + WS_MB)}; pg8::gemm_phase<EpiMerge1, SO>(F.lds + RING_OFF, g, S, E, F.wave);
    tail_phase_merge(F, g.A, g.Bt, E, 3);
}
__device__ __forceinline__ void phase7(Frame& F) {
    unsigned char* ws = F.ws; const int G = F.G, bx = (int)blockIdx.x;
    pg8::Gemm g{(const bf16*)(ws + WS_MB), (const bf16*)(ws + WS_WOUT), MR, D, D, D, D}; typedef pg8::StaticOrderT<MR / 256, D / 256> SO; SO S; S.init(MR, D, G, bx);
    EpiResidB<true> E{(const bf16*)(ws + WS_HB), (bf16*)(ws + WS_HB), (float*)(ws + WS_PQ2), 1.0f};
    S.lim = 1024; pg8::gemm_phase<EpiResidB<true>, SO>(F.lds + RING_OFF, g, S, E, F.wave);
    tail_phase<EpiResidB<true>>(F, g.A, D, g.Bt, D, D, E, 1);
}
__device__ __forceinline__ void phase8(Frame& F) {
    unsigned char* ws = F.ws; const int G = F.G, bx = (int)blockIdx.x;
    pg8::Gemm g{(const bf16*)(ws + WS_HB), (const bf16*)(ws + WS_W2A), MR, 2 * FF, D, D, D}; typedef pg8::StaticOrderT<MR / 256, 2 * FF / 256> SO; SO S; S.init(MR, 2 * FF, G, bx);
    EpiSwiglu E{(bf16*)(ws + WS_G), (const float*)(ws + WS_PQ2)}; pg8::gemm_phase<EpiSwiglu, SO>(F.lds + RING_OFF, g, S, E, F.wave, MK_STAGGER_A);
}
__device__ __forceinline__ void phase9(Frame& F) {
    unsigned char* ws = F.ws; const int G = F.G, bx = (int)blockIdx.x;
    pg8::Gemm g{(const bf16*)(ws + WS_G), (const bf16*)(ws + WS_W2O), MR, D, FF, 64, FF};   typedef pg8::StaticOrderT<MR / 256, D / 256> SO; SO S; S.init(MR, D, G, bx);
    EpiResidB<false> E{(const bf16*)(ws + WS_HB), (bf16*)(ws + WS_Y16), nullptr, 0.5f};
    S.lim = 1024; S.rev = 1; pg8::gemm_phase<EpiResidB<false>, SO, true, true>(F.lds + RING_OFF, g, S, E, F.wave);
    tail_phase<EpiResidB<false>, true>(F, g.A, 64, g.Bt, FF, FF, E, 2);
}
__device__ __forceinline__ void phase10(Frame& F) {
    { const int st = F.G * NWAVES; int m = F.vcu * NWAVES + F.wave;
      for (; m + 3 * st < MR; m += 4 * st) p10_final_rows<4>(F, m, st);
      for (; m < MR; m += st) p10_final_rows<1>(F, m, st); }
}
__device__ __forceinline__ void xcd_barrier_or_skip(const XcdBarrier& b, bool on, int wave) { if (on) xcd_barrier(b, wave); }
constexpr int N_PHASES = 11;
__global__ void __launch_bounds__(NWAVES * 64, 2) mk_fwd(Args args) {
    extern __shared__ __attribute__((aligned(16))) unsigned char lds[];
    Frame F;
    F.lds = (LAS unsigned char*)lds;
    F.wave = __builtin_amdgcn_readfirstlane((int)(threadIdx.x >> 6)); F.lane = lane_id(); F.tid = F.wave * 64 + F.lane;
    F.G = gridDim.x; { const int bx = blockIdx.x; F.vcu = (F.G % 8 == 0) ? (bx % 8) * (F.G / 8) + bx / 8 : bx; }
    F.i0 = args.in[0]; F.i1 = args.in[1]; F.i2 = args.in[2]; F.i3 = args.in[3]; F.i4 = args.in[4]; F.i5 = args.in[5]; F.i6 = args.in[6]; F.i7 = args.in[7]; F.i8 = args.in[8]; F.i9 = args.in[9]; F.i10 = args.in[10]; F.i11 = args.in[11]; F.i12 = args.in[12]; F.i13 = args.in[13]; F.i14 = args.in[14]; F.i15 = args.in[15]; F.i16 = args.in[16]; F.i17 = args.in[17]; F.i18 = args.in[18]; F.i19 = args.in[19]; F.i20 = args.in[20]; F.i21 = args.in[21]; F.i22 = args.in[22]; F.i23 = args.in[23]; F.i24 = args.in[24];
    F.out = args.out; F.ws = args.ws;
    unsigned char* ws = args.ws; gu32* ctl = (gu32*)(ws + WS_CTL);
    volatile LAS unsigned* MISC = (volatile LAS unsigned*)(F.lds + MISC_OFF);
    for (int u = F.tid; u < (LDS_BYTES - LDSCTL_OFF) / 4; u += NWAVES * 64) ((LAS unsigned*)(F.lds + LDSCTL_OFF))[u] = 0u;
    __syncthreads();
    XcdBarrier bar; bar.bar = (unsigned*)(ctl + CW_BAR); bar.x = 0; bar.st = nullptr;
    if (MK_N_LAUNCHES == 1) bar = xcd_barrier_post((unsigned*)(ctl + CW_BAR), MISC + 8, F.wave);
    const int lo = args.ph_lo, hi = args.ph_hi;
#define IN(k) (lo <= (k) && (k) < hi && (k) <= MK_STOP_AFTER)
#define GRID_BAR(k) do { if (IN((k) + 1)) xcd_barrier(bar, F.wave); } while (0)

#define RUN(k, call) do { if (IN(k)) { F.lane = lane_id(); F.tid = F.wave * 64 + F.lane; call; if (MK_REPEAT_PHASE == (k)) { xcd_barrier_or_skip(bar, MK_N_LAUNCHES == 1, F.wave); call; } GRID_BAR(k); } } while (0)
    RUN(0, p0_prologue(F));
    RUN(1, phase1(F));
    RUN(2, phase2(F));
    RUN(3, phase3(F));
    RUN(4, phase4(F, args.in[3], args.in[4], args.in[5], args.in[6]));
    RUN(5, phase5(F));
    RUN(6, phase6(F));
    RUN(7, phase7(F));
    RUN(8, phase8(F));
    RUN(9, phase9(F));
    if (IN(10)) { F.lane = lane_id(); F.tid = F.wave * 64 + F.lane; phase10(F); }
#undef RUN
#if MK_STOP_AFTER < 10
    if (hi == N_PHASES) {
        for (int m = F.vcu * NWAVES + F.wave; m < MR; m += G * NWAVES) {
            for (int c = F.lane; c < D; c += 64) {
                float v;
                if (MK_STOP_AFTER == 0) v = bf2f(((const bf16*)(ws + WS_WIN))[(size_t)(m % NZ) * D + c]);
                else if (MK_STOP_AFTER == 3) { const bf16* gt = (const bf16*)(ws + WS_GATE) + (size_t)m * 3072; v = bf2f(gt[c]) + bf2f(gt[1024 + c]) + bf2f(gt[2048 + c]); }
                else if (MK_STOP_AFTER <= 5) { const bf16* oa = (const bf16*)(ws + WS_OALL) + (size_t)m * 1536; v = bf2f(oa[c]) + bf2f(oa[1024 + (c & 511)]); }
                else if (MK_STOP_AFTER == 6) v = bf2f(((const bf16*)(ws + WS_MB))[(size_t)m * D + c]);
                else if (MK_STOP_AFTER == 7) v = ((const float*)(ws + WS_H))[(size_t)m * D + c];
                else v = bf2f(((const bf16*)(ws + WS_G))[(size_t)m * FF + c]) + bf2f(((const bf16*)(ws + WS_G))[(size_t)m * FF + 1792 + c]);
                F.out[(size_t)m * D + c] = v;
            }
        }
    }
#endif
#undef IN
#undef GRID_BAR
}

extern "C" void kernel_launch(void* const* d_in, const int* in_sizes, int n_in, void* d_out, int out_size, void* d_ws, size_t ws_size, hipStream_t stream) {
    static int grid = 0;
    if (grid == 0) {
        if (n_in != 25 || (size_t)out_size != O_END || ws_size < WS_END2) { fprintf(stderr, "kernel_launch: unexpected shapes: n_in %d out %d ws %zu (need %zu); nothing launched\n", n_in, out_size, ws_size, (size_t)WS_END2); grid = -1; return; }
        int dev = 0, cus = 0, per_cu = 0;
        if (hipGetDevice(&dev) != hipSuccess || hipDeviceGetAttribute(&cus, hipDeviceAttributeMultiprocessorCount, dev) != hipSuccess) { grid = -1; return; }
        if (hipFuncSetAttribute((const void*)mk_fwd, hipFuncAttributeMaxDynamicSharedMemorySize, LDS_BYTES) != hipSuccess) { fprintf(stderr, "kernel_launch: hipFuncSetAttribute failed\n"); grid = -1; return; }
        if (hipOccupancyMaxActiveBlocksPerMultiprocessor(&per_cu, (const void*)mk_fwd, NWAVES * 64, LDS_BYTES) != hipSuccess || per_cu < 1) fprintf(stderr, "kernel_launch: occupancy query reports %d\n", per_cu);
        (void)hipGetLastError();
        grid = cus;
    }
    if (grid < 0) return;
    if (hipMemsetAsync((char*)d_ws + WS_CTL, 0, CTL_ZERO_BYTES, stream) != hipSuccess) return;
    Args a{};
    for (int i = 0; i < 25; ++i) a.in[i] = (const float*)d_in[i];
    a.out = (float*)d_out; a.ws = (unsigned char*)d_ws; a.pad = 0;
    for (int li = 0; li < MK_N_LAUNCHES; ++li) {
        a.ph_lo = (MK_N_LAUNCHES == 1) ? 0 : li; a.ph_hi = (MK_N_LAUNCHES == 1) ? N_PHASES : li + 1; a.li = li;
        hipLaunchKernelGGL(mk_fwd, dim3(grid), dim3(NWAVES * 64), LDS_BYTES, stream, a);
        const hipError_t le = hipPeekAtLastError();
        if (le != hipSuccess) { fprintf(stderr, "kernel_launch: launch %d failed: %s\n", li, hipGetErrorName(le)); break; }
    }
}
```

```cpp
#include <hip/hip_runtime.h>
#include <cstdio>
#include <cstdint>

#ifndef MK_N_LAUNCHES
#define MK_N_LAUNCHES 1
#endif

#ifndef MK_REPEAT_PHASE
#define MK_REPEAT_PHASE -1
#endif
#ifndef MK_P4_REPEAT
#define MK_P4_REPEAT 0
#endif
#ifndef MK_STAGGER_A
#define MK_STAGGER_A 0
#endif
#ifndef MK_STAGGER_Z
#define MK_STAGGER_Z 0
#endif
#ifndef MK_STOP_AFTER
#define MK_STOP_AFTER 10
#endif
#define GAS __attribute__((address_space(1)))
#define LAS __attribute__((address_space(3)))
typedef unsigned short bf16;
typedef unsigned v4u __attribute__((ext_vector_type(4)));
typedef unsigned v2u __attribute__((ext_vector_type(2)));
typedef float f32x4 __attribute__((ext_vector_type(4)));
typedef float f32x2 __attribute__((ext_vector_type(2)));
typedef short bf16x8 __attribute__((ext_vector_type(8)));
typedef short s16x4 __attribute__((ext_vector_type(4)));
typedef GAS unsigned gu32;

__device__ __forceinline__ int lane_id() { return (int)__builtin_amdgcn_mbcnt_hi(~0u, __builtin_amdgcn_mbcnt_lo(~0u, 0u)); }
constexpr int D = 1024, NB = 32, SEQ = 2048, DECB = 128, DECT = 4, PAST = 8192, MEML = 256;
constexpr int MP = NB * SEQ;
constexpr int MS = DECB * DECT;
constexpr int MR = MP + MS;
constexpr int MM = NB * MEML;
constexpr int FF = 2816, NZ = 9984;
constexpr int DIN = 6672;
constexpr int NPOS = SEQ + DECT;
constexpr float EPS = 1e-6f;
constexpr float QSCALE = 0.08838834764831845f * 1.4426950408889634f;
constexpr float LN2 = 0.6931471805599453f;

constexpr size_t O_Y = 0, O_YS = (size_t)MP * D, O_SWA0P = O_YS + (size_t)MS * D, O_SWA1P = O_SWA0P + (size_t)NB * 128 * 1024, O_SWA2P = O_SWA1P + (size_t)NB * 512 * 1024,
                 O_MEMKV = O_SWA2P + (size_t)NB * 2048 * 1024, O_GLAP = O_MEMKV + (size_t)MM * 1024, O_SWA0S = O_GLAP + (size_t)NB * 4 * 64 * 128, O_SWA1S = O_SWA0S + (size_t)MS * 1024,
                 O_SWA2S = O_SWA1S + (size_t)MS * 1024, O_GLAS = O_SWA2S + (size_t)MS * 1024, O_END = O_GLAS + (size_t)DECB * 4 * 64 * 128;
static_assert(O_END == 170917888ull, "output size");

constexpr size_t MiB = 1u << 20;
constexpr size_t al(size_t x) { return (x + 2 * MiB - 1) / (2 * MiB) * (2 * MiB); }
constexpr size_t WS_CTL = 0, CTL_ZERO_BYTES = 1 * MiB;
constexpr size_t WS_ROPE = 2 * MiB;
constexpr size_t WS_PQ1 = WS_ROPE + al((size_t)NPOS * 64 * 4 * 2);
constexpr size_t WS_PQ2 = WS_PQ1 + al((size_t)MR * 16 * 4);
constexpr size_t WS_W1A = WS_PQ2 + al((size_t)MR * 16 * 4);
constexpr size_t WS_W1O = WS_W1A + al((size_t)2 * FF * D * 2);
constexpr size_t WS_WIN = WS_W1O + al((size_t)D * FF * 2);
constexpr size_t WS_WBR = WS_WIN + al((size_t)NZ * D * 2);
constexpr size_t WS_WOUT = WS_WBR + al((size_t)3 * D * 512 * 2);
constexpr size_t WS_W2A = WS_WOUT + al((size_t)D * D * 2);
constexpr size_t WS_W2O = WS_W2A + al((size_t)2 * FF * D * 2);
constexpr size_t WS_WMEM = WS_W2O + al((size_t)D * FF * 2);
constexpr size_t WS_XB = WS_WMEM + al((size_t)D * D * 2);
constexpr size_t WS_MEMB = WS_XB + al((size_t)MR * D * 2);
constexpr size_t WS_MKV = WS_MEMB + al((size_t)MM * D * 2);
constexpr size_t WS_G = WS_MKV + al((size_t)MM * D * 2);
constexpr size_t WS_H = WS_G + al((size_t)MR * FF * 2);
constexpr size_t WS_HB = WS_H + al((size_t)MR * D * 4);
constexpr size_t WS_QS = WS_HB + al((size_t)MR * D * 2);
constexpr size_t WS_KS = WS_QS + al((size_t)MR * 1536 * 2);
constexpr size_t WS_VS = WS_KS + al((size_t)MR * 1536 * 2);
constexpr size_t WS_GQ = WS_VS + al((size_t)MR * 1536 * 2);
constexpr size_t WS_GK = WS_GQ + al((size_t)MR * 256 * 2);
constexpr size_t WS_GV = WS_GK + al((size_t)MR * 256 * 2);
constexpr size_t WS_GRS = WS_GV + al((size_t)MR * 512 * 2);
constexpr size_t WS_GA = WS_GRS + al((size_t)MR * 512 * 2);
constexpr size_t WS_MQ = WS_GA + al((size_t)MR * 256 * 4);
constexpr size_t WS_GATE = WS_MQ + al((size_t)MR * 512 * 2);
constexpr size_t WS_OG = WS_GATE + al((size_t)MR * 3072 * 2);
constexpr size_t WS_LSE = WS_OG + al((size_t)MR * 1536 * 2);
constexpr size_t WS_GO = WS_LSE + al((size_t)MR * 12 * 4);
constexpr size_t WS_OALL = WS_GO + al((size_t)MR * 512 * 4);
constexpr size_t WS_END = WS_OALL + al((size_t)MR * 1536 * 2);
constexpr size_t WS_SLAB = WS_END; constexpr size_t WS_END2 = WS_SLAB + al((size_t)8 * 4 * 4 * 8 * 2048 * 4);
constexpr size_t WS_T = WS_G, WS_MB = WS_XB, WS_Y16 = WS_XB;
static_assert((size_t)MR * D * 4 <= (size_t)MR * FF * 2, "T fits in G");

constexpr int CW_TMO = 0, CW_CODE = 1, CW_BAR = 4096, CW_TAIL = 8192;

constexpr int RING_OFF = 0, RING_BYTES = 131072;
constexpr int LDSCTL_OFF = RING_BYTES, MISC_OFF = LDSCTL_OFF + 320;
constexpr int LDS_BYTES = 147456;
constexpr int NWAVES = 8;

#define RLX_AGENT __ATOMIC_RELAXED, __HIP_MEMORY_SCOPE_AGENT
#define LDS_WAIT() asm volatile("s_waitcnt lgkmcnt(0)" ::: "memory")
#define VM_WAIT() asm volatile("s_waitcnt vmcnt(0)" ::: "memory")
__device__ __forceinline__ unsigned f2bf(float f) { unsigned u = __builtin_bit_cast(unsigned, f); return (u + 0x7fffu + ((u >> 16) & 1u)) >> 16; }
__device__ __forceinline__ unsigned pk2(float lo, float hi) { return f2bf(lo) | (f2bf(hi) << 16); }
__device__ __forceinline__ float bf2f(unsigned b) { return __builtin_bit_cast(float, b << 16); }
__device__ __forceinline__ float bflo(unsigned w) { return __builtin_bit_cast(float, w << 16); }
__device__ __forceinline__ float bfhi(unsigned w) { return __builtin_bit_cast(float, w & 0xffff0000u); }
typedef __bf16 bf16x2_t __attribute__((ext_vector_type(2)));
__device__ __forceinline__ unsigned cvt_pk_bf16(float lo, float hi) { const f32x2 v = {lo, hi}; const bf16x2_t b = __builtin_convertvector(v, bf16x2_t); return __builtin_bit_cast(unsigned, b); }
__device__ __forceinline__ float fast_exp2(float x) { return __builtin_amdgcn_exp2f(x); }
__device__ __forceinline__ float fast_rcp(float x) { return __builtin_amdgcn_rcpf(x); }
__device__ __forceinline__ float fast_log2(float x) { return __builtin_amdgcn_logf(x); }
__device__ __forceinline__ float sigmoidf_(float x) { return fast_rcp(1.0f + fast_exp2(-1.4426950408889634f * x)); }
__device__ __forceinline__ float siluf_(float x) { return x * sigmoidf_(x); }
__device__ __forceinline__ int perm32(int rho) { return 8 * ((rho >> 2) & 3) + 4 * (rho >> 4) + (rho & 3); }
__device__ __forceinline__ int sig_plain(int r) { return (r & ~31) + perm32(r & 31); }
__device__ __forceinline__ int sig_rope(int r7) { return 64 * ((r7 >> 4) & 1) + 16 * (r7 >> 5) + 4 * ((r7 >> 2) & 3) + (r7 & 3); }

namespace pg8 {
constexpr int BM = 256, BK = 64, HALF = 128, HTB = HALF * BK * 2, STAGE_BYTES = 8 * HTB, NXCD = 8, WGM = 2;
__host__ __device__ __forceinline__ int lds_byte(int r, int c) { const int st = (r >> 4) * 2 + (c >> 5), rr = r & 15, cc = c & 31, ob = rr * 64 + cc * 2; return st * 1024 + (ob ^ (((ob >> 9) & 1) << 5)); }
__host__ __device__ __forceinline__ void stage_rc(int b, int& R, int& C) { const int st = b / 1024, sb = b % 1024, swz = sb ^ (((sb >> 9) & 1) << 5); R = (st >> 1) * 16 + swz / 64; C = (st & 1) * 32 + (swz % 64) / 2; }
struct Unit { int pm, pn; };
struct Gemm { const bf16* A; const bf16* Bt; int M, N, K, lda, ldb; };
constexpr size_t TILED_KS = (size_t)256 * 64 * 2, TILED_PANEL = (size_t)(2816 / 64) * TILED_KS;
template <int NM, int NN> struct StaticOrderT {
    int G, c, lim, rev;
    __host__ __device__ void init(int, int, int G_, int c_) { G = G_; c = c_; lim = NM * NN; rev = 0; }
    __host__ __device__ static __forceinline__ void unit_of(int L, Unit& u) {
        constexpr int nwg = NM * NN, q = nwg / NXCD, r = nwg % NXCD, nig = WGM * NN;
        const int xcd = L & (NXCD - 1), off = L >> 3;
        const int wgid = (xcd < r ? xcd * (q + 1) : r * (q + 1) + (xcd - r) * q) + off;
        const int gid = wgid / nig, x = wgid - gid * nig, fm = gid * WGM;
        if (NM % WGM == 0 || fm + WGM <= NM) { u.pm = fm + (x & (WGM - 1)); u.pn = x / WGM; }
        else { constexpr int gl = (NM % WGM) ? (NM % WGM) : WGM; u.pm = fm + x % gl; u.pn = x / gl; }
    }
    __host__ __device__ __forceinline__ bool next(int i, Unit& u) const { const int L = i * G + c; if (L >= lim) return false; unit_of(rev ? lim - 1 - L : L, u); return true; }
};
struct OneUnit { Unit u; int c; __host__ __device__ __forceinline__ bool next(int i, Unit& o) const { if (i) return false; o = u; return true; } };
template <class Epi, class Sched, bool ALIGN_EPI = true, bool ATILED = false>
__device__ __forceinline__ void gemm_phase(LAS unsigned char* lds, const Gemm g, const Sched& S, const Epi& E, const int wid, const int stagger_ticks = 0) {
    if (stagger_ticks > 0) { const unsigned long long t0 = __builtin_amdgcn_s_memrealtime(); const unsigned long long dl = (unsigned long long)(((S.c * 37) & 255) * stagger_ticks) >> 8;
        while (__builtin_amdgcn_s_memrealtime() - t0 < dl) __builtin_amdgcn_s_sleep(8); }
    const int lane = lane_id(), tid = wid * 64 + lane, wr = wid >> 2, wc = wid & 3, fr = lane & 15, fq = lane >> 4;
    const int K = g.K, nt = K / BK;
    unsigned voffA[2], voffB[2];
#pragma unroll
    for (int i = 0; i < 2; ++i) { int R, C; stage_rc(tid * 16 + i * 8192, R, C); voffA[i] = (unsigned)(R * g.lda + C) * 2u; voffB[i] = (unsigned)(R * g.ldb + C) * 2u; }
    const size_t kstep = (size_t)(BK * 2), kstepA = ATILED ? TILED_KS : kstep;
    const size_t hA = (size_t)HALF * g.lda * 2, tA = ATILED ? TILED_PANEL : 2 * hA, hB = (size_t)HALF * g.ldb * 2, tB = 2 * hB;
    const unsigned ldsw = (unsigned)wid * 1024u;
    const int aoff = lds_byte(wr * 64 + fr, fq * 8), boff = lds_byte(wc * 32 + fr, fq * 8);
#define PG8_SA(b, h) (((b) * 2 + (h)) * HTB)
#define PG8_SB(b, h) ((4 + (b) * 2 + (h)) * HTB)
#define PG8_STAGE(bufoff, gbase, voff) do { _Pragma("unroll") for (int _i = 0; _i < 2; ++_i) \
        __builtin_amdgcn_global_load_lds((const unsigned*)((const char*)(gbase) + (voff)[_i]), (LAS unsigned*)(lds + (bufoff) + ldsw + _i * 8192), 16, 0, 0); } while (0)
#define PG8_LDA(dst, b, h) do { _Pragma("unroll") for (int m = 0; m < 4; ++m) _Pragma("unroll") for (int k = 0; k < 2; ++k) dst[m][k] = *(const LAS bf16x8*)(lds + PG8_SA(b, h) + aoff + m * 2048 + k * 1024); } while (0)
#define PG8_LDB(dst, b, h) do { _Pragma("unroll") for (int n = 0; n < 2; ++n) _Pragma("unroll") for (int k = 0; k < 2; ++k) dst[n][k] = *(const LAS bf16x8*)(lds + PG8_SB(b, h) + boff + n * 2048 + k * 1024); } while (0)
#define PG8_MMA(ai, bj, At, Bt) do { __builtin_amdgcn_s_setprio(1); _Pragma("unroll") for (int m = 0; m < 4; ++m) _Pragma("unroll") for (int n = 0; n < 2; ++n) _Pragma("unroll") for (int k = 0; k < 2; ++k) \
        acc[ai][bj][m][n] = __builtin_amdgcn_mfma_f32_16x16x32_bf16(Bt[n][k], At[m][k], acc[ai][bj][m][n], 0, 0, 0); __builtin_amdgcn_s_setprio(0); } while (0)
#define PG8_WAIT_V(n) asm volatile("s_waitcnt vmcnt(" #n ")" ::: "memory")
#define PG8_WAIT_L(n) asm volatile("s_waitcnt lgkmcnt(" #n ")" ::: "memory")
#define PG8_BAR __builtin_amdgcn_s_barrier()
#define PG8_SCHED __builtin_amdgcn_sched_barrier(0)
    Unit cur, nxt; int ui = 0;
    if (!S.next(0, cur)) return;
    f32x4 acc[2][2][4][2];
#pragma unroll
    for (int a = 0; a < 2; ++a)
#pragma unroll
        for (int b = 0; b < 2; ++b)
#pragma unroll
            for (int m = 0; m < 4; ++m)
#pragma unroll
                for (int n = 0; n < 2; ++n) acc[a][b][m][n] = (f32x4){0.f, 0.f, 0.f, 0.f};
    bf16x8 At[4][2], B0[2][2], B1[2][2];
    const char* cA = (const char*)g.A + (size_t)cur.pm * tA; const char* cB = (const char*)g.Bt + (size_t)cur.pn * tB;
    PG8_STAGE(PG8_SB(0, 0), cB, voffB); PG8_STAGE(PG8_SB(0, 1), cB + hB, voffB); PG8_STAGE(PG8_SA(0, 0), cA, voffA); PG8_STAGE(PG8_SA(0, 1), cA + hA, voffA);
    if (wr == 1) PG8_BAR;
    PG8_WAIT_V(2); PG8_BAR;
    PG8_STAGE(PG8_SB(1, 0), cB + kstep, voffB); PG8_STAGE(PG8_SA(1, 0), cA + kstepA, voffA); PG8_STAGE(PG8_SB(1, 1), cB + hB + kstep, voffB);
    PG8_WAIT_V(6); PG8_BAR;
    for (;;) {
        const bool has_next = S.next(ui + 1, nxt);
        const char* nA = has_next ? (const char*)g.A + (size_t)nxt.pm * tA : cA; const char* nB = has_next ? (const char*)g.Bt + (size_t)nxt.pn * tB : cB;
        const int seg = Epi::HAS_MID ? 8 : nt;
        for (int t0 = 0; t0 < nt; t0 += seg) {
        if constexpr (Epi::HAS_MID) { if (t0) { PG8_SCHED; E.mid(acc, cur, t0, wr, wc, fr, fq); PG8_SCHED; } }
#pragma unroll 1
        for (int t = t0; t < t0 + seg; t += 2) {
            const bool last = (t == nt - 2);
            const char* a1 = cA + (size_t)(t + 1) * kstepA;
            const char* a2 = last ? nA : cA + (size_t)(t + 2) * kstepA; const char* b2 = last ? nB : cB + (size_t)(t + 2) * kstep;
            const char* a3 = a2 + kstepA; const char* b3 = b2 + kstep;
            PG8_LDB(B0, 0, 0); PG8_LDB(B1, 0, 1); PG8_SCHED; PG8_LDA(At, 0, 0); PG8_STAGE(PG8_SA(1, 1), a1 + hA, voffA);
            PG8_WAIT_V(8); PG8_WAIT_L(0); PG8_BAR; PG8_MMA(0, 0, At, B0); PG8_MMA(0, 1, At, B1); PG8_BAR; PG8_SCHED;
            PG8_LDA(At, 0, 1); PG8_STAGE(PG8_SB(0, 0), b2, voffB); PG8_STAGE(PG8_SB(0, 1), b2 + hB, voffB); PG8_STAGE(PG8_SA(0, 0), a2, voffA);
            PG8_WAIT_V(8); PG8_WAIT_L(0); PG8_BAR; PG8_MMA(1, 0, At, B0); PG8_MMA(1, 1, At, B1); PG8_BAR; PG8_SCHED;
            PG8_LDB(B0, 1, 0); PG8_LDB(B1, 1, 1); PG8_SCHED; PG8_LDA(At, 1, 0); PG8_STAGE(PG8_SA(0, 1), a2 + hA, voffA);
            PG8_WAIT_V(8); PG8_WAIT_L(0); PG8_BAR; PG8_MMA(0, 0, At, B0); PG8_MMA(0, 1, At, B1); PG8_BAR; PG8_SCHED;
            PG8_LDA(At, 1, 1); PG8_STAGE(PG8_SB(1, 0), b3, voffB); PG8_STAGE(PG8_SB(1, 1), b3 + hB, voffB); PG8_STAGE(PG8_SA(1, 0), a3, voffA);
            PG8_WAIT_V(8); PG8_WAIT_L(0); PG8_BAR; PG8_MMA(1, 0, At, B0); PG8_MMA(1, 1, At, B1); PG8_BAR; PG8_SCHED;
        }
        }
        if constexpr (ALIGN_EPI) { if (wr == 0) PG8_BAR; }
        E(acc, cur, wr, wc, fr, fq);
        if (!has_next) break;
#pragma unroll
        for (int a = 0; a < 2; ++a)
#pragma unroll
            for (int b = 0; b < 2; ++b)
#pragma unroll
                for (int m = 0; m < 4; ++m)
#pragma unroll
                    for (int n = 0; n < 2; ++n) acc[a][b][m][n] = (f32x4){0.f, 0.f, 0.f, 0.f};
        cur = nxt; cA = nA; cB = nB; ++ui;
        if constexpr (ALIGN_EPI) { if (wr == 1) PG8_BAR; }
    }
    PG8_WAIT_V(0);
    if constexpr (!ALIGN_EPI) { if (wr == 0) PG8_BAR; }
    PG8_BAR;
#undef PG8_SA
#undef PG8_SB
#undef PG8_STAGE
#undef PG8_LDA
#undef PG8_LDB
#undef PG8_MMA
#undef PG8_WAIT_V
#undef PG8_WAIT_L
#undef PG8_BAR
#undef PG8_SCHED
}
}
using pg8::Unit;

typedef const f32x4 (&AccRef)[2][2][4][2];
constexpr size_t G_KT = (size_t)256 * 64, G_PANEL = (FF / 64) * G_KT;
__device__ __forceinline__ size_t g_off(int row, int j) { return (size_t)(row >> 8) * G_PANEL + (size_t)(j >> 6) * G_KT + (size_t)(row & 255) * 64 + (j & 63); }
struct EpiSwiglu {
    static constexpr bool HAS_MID = false;
    bf16* G; const float* pq;
    __device__ __forceinline__ void operator()(AccRef acc, const Unit& u, int wr, int wc, int fr, int fq) const {
        const int row0 = u.pm * 256 + wr * 64 + fr;
        bf16* gb = G + ((size_t)u.pm * (FF / 64) + 2 * u.pn + (wc >> 1)) * G_KT + (size_t)((wr * 64 + fr) * 64 + (wc & 1) * 32 + 8 * fq);
        float sc[2][4];
#pragma unroll
        for (int ai = 0; ai < 2; ++ai)
#pragma unroll
            for (int m = 0; m < 4; ++m) { sc[ai][m] = 1.f;
                if (pq) { const f32x4 pv = *(const f32x4*)(pq + (size_t)(row0 + ai * 128 + m * 16) * 16 + 4 * fq); float t = (pv.x + pv.y) + (pv.z + pv.w); t += __shfl_xor(t, 16); t += __shfl_xor(t, 32); sc[ai][m] = __builtin_amdgcn_rsqf(t * (1.f / D) + EPS); } }
#pragma unroll
        for (int ai = 0; ai < 2; ++ai)
#pragma unroll
            for (int m = 0; m < 4; ++m) {
                const float s = sc[ai][m];
                float o[8];
#pragma unroll
                for (int n = 0; n < 2; ++n)
#pragma unroll
                    for (int i = 0; i < 4; ++i) { const float a = acc[ai][0][m][n][i] * s, b = acc[ai][1][m][n][i] * s; o[4 * n + i] = siluf_(a) * b; }
                v4u w; w.x = cvt_pk_bf16(o[0], o[1]); w.y = cvt_pk_bf16(o[2], o[3]); w.z = cvt_pk_bf16(o[4], o[5]); w.w = cvt_pk_bf16(o[6], o[7]);
                *(v4u*)(gb + (ai * 128 + m * 16) * 64) = w;
            }
    }
};
template <bool WRITE_PQ> struct EpiResidX {
    static constexpr bool HAS_MID = false;
    const float* baseP; const float* baseS; bf16* HB; float* pq; float scale;
    __device__ __forceinline__ void operator()(AccRef acc, const Unit& u, int wr, int wc, int fr, int fq) const {
        const int row0 = u.pm * 256 + wr * 64 + fr, c0 = u.pn * 256 + wc * 32 + 8 * fq; const bool smp = u.pm >= MP / 256;
        const float* bbase = (smp ? baseS : baseP) + (smp ? (size_t)(row0 - MP) * D : (size_t)row0 * D) + c0;
#pragma unroll
        for (int ai = 0; ai < 2; ++ai) {
            f32x4 bb[4][2][2];
#pragma unroll
            for (int m = 0; m < 4; ++m)
#pragma unroll
                for (int bj = 0; bj < 2; ++bj) { const float* bp = bbase + (size_t)(ai * 128 + m * 16) * D + bj * 128; bb[m][bj][0] = *(const f32x4*)bp; bb[m][bj][1] = *(const f32x4*)(bp + 4); }
#pragma unroll
            for (int m = 0; m < 4; ++m) {
                const int row = row0 + ai * 128 + m * 16; float ss = 0.f;
#pragma unroll
                for (int bj = 0; bj < 2; ++bj) {
                    const f32x4 o0 = bb[m][bj][0] + acc[ai][bj][m][0] * scale, o1 = bb[m][bj][1] + acc[ai][bj][m][1] * scale;
                    v4u w; w.x = cvt_pk_bf16(o0.x, o0.y); w.y = cvt_pk_bf16(o0.z, o0.w); w.z = cvt_pk_bf16(o1.x, o1.y); w.w = cvt_pk_bf16(o1.z, o1.w); *(v4u*)(HB + (size_t)row * D + c0 + bj * 128) = w;
                    if (WRITE_PQ) ss += (o0.x * o0.x + o0.y * o0.y) + (o0.z * o0.z + o0.w * o0.w) + (o1.x * o1.x + o1.y * o1.y) + (o1.z * o1.z + o1.w * o1.w);
                }
                if (WRITE_PQ) { ss += __shfl_xor(ss, 16); ss += __shfl_xor(ss, 32); if (fq == 0) pq[(size_t)row * 16 + u.pn * 4 + wc] = ss; }
            }
        }
    }
    template <int O> __device__ __forceinline__ void group(const f32x4 (&v)[8], const Unit& u, int wr, int wc, int fr, int fq) const {
        const int row0 = u.pm * 256 + wr * 64 + fr, c0 = u.pn * 256 + wc * 32 + 8 * fq; const bool smp = u.pm >= MP / 256;
        const float* bbase = (smp ? baseS : baseP) + (smp ? (size_t)(row0 - MP) * D : (size_t)row0 * D) + c0;
        f32x4 bb[2][2][2];
#pragma unroll
        for (int mm = 0; mm < 2; ++mm)
#pragma unroll
            for (int bj = 0; bj < 2; ++bj) { const float* bp = bbase + (size_t)((O >> 1) * 128 + (2 * (O & 1) + mm) * 16) * D + bj * 128; bb[mm][bj][0] = *(const f32x4*)bp; bb[mm][bj][1] = *(const f32x4*)(bp + 4); }
#pragma unroll
        for (int mm = 0; mm < 2; ++mm) { const int row = row0 + (O >> 1) * 128 + (2 * (O & 1) + mm) * 16; float ss = 0.f;
#pragma unroll
            for (int bj = 0; bj < 2; ++bj) {
                const f32x4 o0 = bb[mm][bj][0] + v[bj * 4 + mm * 2] * scale, o1 = bb[mm][bj][1] + v[bj * 4 + mm * 2 + 1] * scale;
                v4u w; w.x = cvt_pk_bf16(o0.x, o0.y); w.y = cvt_pk_bf16(o0.z, o0.w); w.z = cvt_pk_bf16(o1.x, o1.y); w.w = cvt_pk_bf16(o1.z, o1.w); *(v4u*)(HB + (size_t)row * D + c0 + bj * 128) = w;
                if (WRITE_PQ) ss += (o0.x * o0.x + o0.y * o0.y) + (o0.z * o0.z + o0.w * o0.w) + (o1.x * o1.x + o1.y * o1.y) + (o1.z * o1.z + o1.w * o1.w); }
            if (WRITE_PQ) { ss += __shfl_xor(ss, 16); ss += __shfl_xor(ss, 32); if (fq == 0) pq[(size_t)row * 16 + u.pn * 4 + wc] = ss; } }
    }
};
template <bool WRITE_PQ> struct EpiResidB {
    static constexpr bool HAS_MID = false;
    const bf16* base; bf16* out; float* pq; float scale;
    __device__ __forceinline__ void operator()(AccRef acc, const Unit& u, int wr, int wc, int fr, int fq) const {
        const int row0 = u.pm * 256 + wr * 64 + fr, c0 = u.pn * 256 + wc * 32 + 8 * fq;
#pragma unroll
        for (int ai = 0; ai < 2; ++ai) {
            v4u bb[4][2];
#pragma unroll
            for (int m = 0; m < 4; ++m)
#pragma unroll
                for (int bj = 0; bj < 2; ++bj) bb[m][bj] = *(const v4u*)(base + (size_t)(row0 + ai * 128 + m * 16) * D + c0 + bj * 128);
#pragma unroll
            for (int m = 0; m < 4; ++m) {
                const int row = row0 + ai * 128 + m * 16; float ss = 0.f;
#pragma unroll
                for (int bj = 0; bj < 2; ++bj) { const v4u g = bb[m][bj];
                    const f32x4 o0 = (f32x4){bflo(g.x), bfhi(g.x), bflo(g.y), bfhi(g.y)} + acc[ai][bj][m][0] * scale, o1 = (f32x4){bflo(g.z), bfhi(g.z), bflo(g.w), bfhi(g.w)} + acc[ai][bj][m][1] * scale;
                    v4u w; w.x = cvt_pk_bf16(o0.x, o0.y); w.y = cvt_pk_bf16(o0.z, o0.w); w.z = cvt_pk_bf16(o1.x, o1.y); w.w = cvt_pk_bf16(o1.z, o1.w); *(v4u*)(out + (size_t)row * D + c0 + bj * 128) = w;
                    if (WRITE_PQ) ss += (o0.x * o0.x + o0.y * o0.y) + (o0.z * o0.z + o0.w * o0.w) + (o1.x * o1.x + o1.y * o1.y) + (o1.z * o1.z + o1.w * o1.w);
                }
                if (WRITE_PQ) { ss += __shfl_xor(ss, 16); ss += __shfl_xor(ss, 32); if (fq == 0) pq[(size_t)row * 16 + u.pn * 4 + wc] = ss; }
            }
        }
    }
    template <int O> __device__ __forceinline__ void group(const f32x4 (&v)[8], const Unit& u, int wr, int wc, int fr, int fq) const {
        const int row0 = u.pm * 256 + wr * 64 + fr, c0 = u.pn * 256 + wc * 32 + 8 * fq;
        v4u bb[2][2];
#pragma unroll
        for (int mm = 0; mm < 2; ++mm)
#pragma unroll
            for (int bj = 0; bj < 2; ++bj) bb[mm][bj] = *(const v4u*)(base + (size_t)(row0 + (O >> 1) * 128 + (2 * (O & 1) + mm) * 16) * D + c0 + bj * 128);
#pragma unroll
        for (int mm = 0; mm < 2; ++mm) { const int row = row0 + (O >> 1) * 128 + (2 * (O & 1) + mm) * 16; float ss = 0.f;
#pragma unroll
            for (int bj = 0; bj < 2; ++bj) { const v4u g = bb[mm][bj];
                const f32x4 o0 = (f32x4){bflo(g.x), bfhi(g.x), bflo(g.y), bfhi(g.y)} + v[bj * 4 + mm * 2] * scale, o1 = (f32x4){bflo(g.z), bfhi(g.z), bflo(g.w), bfhi(g.w)} + v[bj * 4 + mm * 2 + 1] * scale;
                v4u w; w.x = cvt_pk_bf16(o0.x, o0.y); w.y = cvt_pk_bf16(o0.z, o0.w); w.z = cvt_pk_bf16(o1.x, o1.y); w.w = cvt_pk_bf16(o1.z, o1.w); *(v4u*)(out + (size_t)row * D + c0 + bj * 128) = w;
                if (WRITE_PQ) ss += (o0.x * o0.x + o0.y * o0.y) + (o0.z * o0.z + o0.w * o0.w) + (o1.x * o1.x + o1.y * o1.y) + (o1.z * o1.z + o1.w * o1.w); }
            if (WRITE_PQ) { ss += __shfl_xor(ss, 16); ss += __shfl_xor(ss, 32); if (fq == 0) pq[(size_t)row * 16 + u.pn * 4 + wc] = ss; } }
    }
};
struct EpiMemKV {
    static constexpr bool HAS_MID = false;
    float* out; bf16* MKV;
    __device__ __forceinline__ void operator()(AccRef acc, const Unit& u, int wr, int wc, int fr, int fq) const {
        const int row0 = u.pm * 256 + wr * 64 + fr, c0 = u.pn * 256 + wc * 32 + 8 * fq;
#pragma unroll
        for (int ai = 0; ai < 2; ++ai)
#pragma unroll
            for (int m = 0; m < 4; ++m) {
                const int row = row0 + ai * 128 + m * 16;
#pragma unroll
                for (int bj = 0; bj < 2; ++bj) { const f32x4 o0 = acc[ai][bj][m][0], o1 = acc[ai][bj][m][1]; float* op = out + (size_t)row * D + c0 + bj * 128;
                    *(f32x4*)op = o0; *(f32x4*)(op + 4) = o1;
                    v4u w; w.x = cvt_pk_bf16(o0.x, o0.y); w.y = cvt_pk_bf16(o0.z, o0.w); w.z = cvt_pk_bf16(o1.x, o1.y); w.w = cvt_pk_bf16(o1.z, o1.w); *(v4u*)(MKV + (size_t)row * D + c0 + bj * 128) = w; }
            }
    }
};
struct EpiMerge1 {
    static constexpr bool HAS_MID = true;
    const bf16* GATE; bf16* MB;
    __device__ __forceinline__ void mid(f32x4 (&acc)[2][2][4][2], const Unit& u, int t, int wr, int wc, int fr, int fq) const {
        const unsigned lo = (unsigned)(((wr * 64 + fr) * 3072 + wc * 32 + 8 * fq) * 2);
        const char* ub = (const char*)GATE + ((size_t)u.pm * 256 * 3072 + (size_t)((t >> 3) - 1) * 1024 + (size_t)u.pn * 256) * 2;
#pragma unroll
        for (int ai = 0; ai < 2; ++ai) {
            v4u gn[4][2], gd[4][2];
#pragma unroll
            for (int m = 0; m < 4; ++m)
#pragma unroll
                for (int bj = 0; bj < 2; ++bj) { const char* fb = ub + (size_t)((ai * 128 + m * 16) * 3072 + bj * 128) * 2; gn[m][bj] = *(const v4u*)(fb + lo); gd[m][bj] = *(const v4u*)(fb + 2048 + lo); }
#pragma unroll
            for (int m = 0; m < 4; ++m)
#pragma unroll
                for (int bj = 0; bj < 2; ++bj) { const v4u n_ = gn[m][bj], d_ = gd[m][bj];
                    const f32x4 r0 = {bflo(n_.x) * fast_rcp(fmaxf(bflo(d_.x), 1e-30f)), bfhi(n_.x) * fast_rcp(fmaxf(bfhi(d_.x), 1e-30f)), bflo(n_.y) * fast_rcp(fmaxf(bflo(d_.y), 1e-30f)), bfhi(n_.y) * fast_rcp(fmaxf(bfhi(d_.y), 1e-30f))};
                    const f32x4 r1 = {bflo(n_.z) * fast_rcp(fmaxf(bflo(d_.z), 1e-30f)), bfhi(n_.z) * fast_rcp(fmaxf(bfhi(d_.z), 1e-30f)), bflo(n_.w) * fast_rcp(fmaxf(bflo(d_.w), 1e-30f)), bfhi(n_.w) * fast_rcp(fmaxf(bfhi(d_.w), 1e-30f))};
                    acc[ai][bj][m][0] *= r0; acc[ai][bj][m][1] *= r1; }
            asm volatile("" ::: "memory");
        }
    }
    __device__ __forceinline__ void operator()(AccRef acc, const Unit& u, int wr, int wc, int fr, int fq) const {
        const int row0 = u.pm * 256 + wr * 64 + fr, c0 = u.pn * 256 + wc * 32 + 8 * fq;
        v4u gw[2][4][2];
#pragma unroll
        for (int ai = 0; ai < 2; ++ai)
#pragma unroll
            for (int m = 0; m < 4; ++m)
#pragma unroll
                for (int bj = 0; bj < 2; ++bj) gw[ai][m][bj] = *(const v4u*)(GATE + (size_t)(row0 + ai * 128 + m * 16) * 3072 + 2048 + c0 + bj * 128);
#pragma unroll
        for (int ai = 0; ai < 2; ++ai)
#pragma unroll
            for (int m = 0; m < 4; ++m) { const int row = row0 + ai * 128 + m * 16;
#pragma unroll
                for (int bj = 0; bj < 2; ++bj) { const v4u g = gw[ai][m][bj];
                    const f32x4 o0 = acc[ai][bj][m][0] * (f32x4){bflo(g.x), bfhi(g.x), bflo(g.y), bfhi(g.y)}, o1 = acc[ai][bj][m][1] * (f32x4){bflo(g.z), bfhi(g.z), bflo(g.w), bfhi(g.w)};
                    v4u w; w.x = cvt_pk_bf16(o0.x, o0.y); w.y = cvt_pk_bf16(o0.z, o0.w); w.z = cvt_pk_bf16(o1.x, o1.y); w.w = cvt_pk_bf16(o1.z, o1.w); *(v4u*)(MB + (size_t)row * D + c0 + bj * 128) = w;
                } }
    }
    template <int O> __device__ __forceinline__ void group(const f32x4 (&v)[8], const Unit& u, int wr, int wc, int fr, int fq) const {
        const int row0 = u.pm * 256 + wr * 64 + fr, c0 = u.pn * 256 + wc * 32 + 8 * fq;
#pragma unroll
        for (int mm = 0; mm < 2; ++mm) { const int row = row0 + (O >> 1) * 128 + (2 * (O & 1) + mm) * 16;
#pragma unroll
            for (int bj = 0; bj < 2; ++bj) { const f32x4 o0 = v[bj * 4 + mm * 2], o1 = v[bj * 4 + mm * 2 + 1];
                v4u w; w.x = cvt_pk_bf16(o0.x, o0.y); w.y = cvt_pk_bf16(o0.z, o0.w); w.z = cvt_pk_bf16(o1.x, o1.y); w.w = cvt_pk_bf16(o1.z, o1.w); *(v4u*)(MB + (size_t)row * D + c0 + bj * 128) = w; } }
    }
};
__device__ __forceinline__ size_t qkv_off(int row, int g, int h) {
    if (row >= MP) return (size_t)row * 1536 + g * 512 + h * 128;
    const int b = row >> 11, t = row & 2047, sh = 2 * g, p = ((t & ((1 << sh) - 1)) << (11 - sh)) + (t >> sh);
    return ((size_t)((g * NB + b) * 4 + h) * SEQ + p) * 128;
}
struct EpiZ {
    static constexpr bool HAS_MID = false;
    const float* pq; const float* ropeC; const float* ropeS; const float* bga; float* out;
    bf16 *QS, *KS, *VS, *GQ, *GK, *GV, *GRS, *MQ, *GATE; float* GA;
    template <int ACT> __device__ __forceinline__ void plain(AccRef acc, const float (&rs)[2][4], int row0, bf16* dst, int ld, int col0, float scale) const {
#pragma unroll
        for (int ai = 0; ai < 2; ++ai)
#pragma unroll
            for (int m = 0; m < 4; ++m) { const int row = row0 + ai * 128 + m * 16; const float s = rs[ai][m];
#pragma unroll
                for (int bj = 0; bj < 2; ++bj) { float o[8];
#pragma unroll
                    for (int n = 0; n < 2; ++n)
#pragma unroll
                        for (int i = 0; i < 4; ++i) { const float x = acc[ai][bj][m][n][i] * s; o[4 * n + i] = ACT == 0 ? x * scale : (ACT == 1 ? siluf_(x) : sigmoidf_(x)); }
                    v4u w; w.x = cvt_pk_bf16(o[0], o[1]); w.y = cvt_pk_bf16(o[2], o[3]); w.z = cvt_pk_bf16(o[4], o[5]); w.w = cvt_pk_bf16(o[6], o[7]);
                    *(v4u*)(dst + (size_t)row * ld + col0 + bj * 128) = w; } }
    }
    __device__ __forceinline__ float* swa_dst(int row, int g, int kv, int h) const {
        if (row >= MP) return out + (g == 0 ? O_SWA0S : (g == 1 ? O_SWA1S : O_SWA2S)) + ((size_t)(row - MP) * 2 + kv) * 512 + h * 128;
        const int b = row >> 11, t = row & 2047, keep = 128 << (2 * g), t0 = SEQ - keep;
        if (t < t0) return nullptr;
        return out + (g == 0 ? O_SWA0P : (g == 1 ? O_SWA1P : O_SWA2P)) + (((size_t)b * keep + (t - t0)) * 2 + kv) * 512 + h * 128;
    }
    __device__ __forceinline__ void operator()(AccRef acc, const Unit& u, int wr, int wc, int fr, int fq) const {
        const int row0 = u.pm * 256 + wr * 64 + fr, pn = u.pn, cl = wc * 32 + 8 * fq;
        float rs[2][4];
#pragma unroll
        for (int ai = 0; ai < 2; ++ai)
#pragma unroll
            for (int m = 0; m < 4; ++m) { const int row = row0 + ai * 128 + m * 16;
                const f32x4 pv = *(const f32x4*)(pq + (size_t)row * 16 + 4 * fq); float t = (pv.x + pv.y) + (pv.z + pv.w); t += __shfl_xor(t, 16); t += __shfl_xor(t, 32); rs[ai][m] = __builtin_amdgcn_rsqf(t * (1.f / D) + EPS); }
        if (pn < 12) {
            const int isk = pn >= 6, g = (pn % 6) >> 1, hp = pn & 1, e0 = wc * 16 + 4 * fq;
#pragma unroll
            for (int ai = 0; ai < 2; ++ai) {
                f32x4 cs[4], sn[4];
#pragma unroll
                for (int m = 0; m < 4; ++m) { const int row = row0 + ai * 128 + m * 16; const int pidx = row < MP ? (row & 2047) : SEQ + ((row - MP) & 3);
                    cs[m] = *(const f32x4*)(ropeC + pidx * 64 + e0); sn[m] = *(const f32x4*)(ropeS + pidx * 64 + e0); }
#pragma unroll
                for (int m = 0; m < 4; ++m) { const int row = row0 + ai * 128 + m * 16; const float s = rs[ai][m];
#pragma unroll
                    for (int bj = 0; bj < 2; ++bj) { const int h = 2 * hp + bj;
                        const f32x4 x1 = acc[ai][bj][m][0] * s, x2 = acc[ai][bj][m][1] * s;
                        f32x4 r1 = x1 * cs[m] - x2 * sn[m], r2 = x2 * cs[m] + x1 * sn[m];
                        if (!isk) { r1 *= QSCALE; r2 *= QSCALE; }
                        bf16* dp = (isk ? KS : QS) + qkv_off(row, g, h) + e0;
                        v2u w1, w2; w1.x = cvt_pk_bf16(r1.x, r1.y); w1.y = cvt_pk_bf16(r1.z, r1.w); w2.x = cvt_pk_bf16(r2.x, r2.y); w2.y = cvt_pk_bf16(r2.z, r2.w);
                        *(v2u*)dp = w1; *(v2u*)(dp + 64) = w2;
                        if (isk) { float* fo = swa_dst(row, g, 0, h); if (fo) { *(f32x4*)(fo + e0) = r1; *(f32x4*)(fo + 64 + e0) = r2; } }
                    } }
            }
        } else if (pn < 18) {
            const int g = (pn - 12) >> 1, hp = pn & 1;
#pragma unroll
            for (int ai = 0; ai < 2; ++ai)
#pragma unroll
                for (int m = 0; m < 4; ++m) { const int row = row0 + ai * 128 + m * 16; const float s = rs[ai][m];
#pragma unroll
                    for (int bj = 0; bj < 2; ++bj) { const int h = 2 * hp + bj; const f32x4 o0 = acc[ai][bj][m][0] * s, o1 = acc[ai][bj][m][1] * s;
                        v4u w; w.x = cvt_pk_bf16(o0.x, o0.y); w.y = cvt_pk_bf16(o0.z, o0.w); w.z = cvt_pk_bf16(o1.x, o1.y); w.w = cvt_pk_bf16(o1.z, o1.w);
                        *(v4u*)(VS + qkv_off(row, g, h) + cl) = w;
                        float* fo = swa_dst(row, g, 1, h); if (fo) { *(f32x4*)(fo + cl) = o0; *(f32x4*)(fo + cl + 4) = o1; } } }
        } else if (pn == 18) plain<0>(acc, rs, row0, GQ, 256, cl, 0.125f);
        else if (pn == 19) plain<0>(acc, rs, row0, GK, 256, cl, 1.f);
        else if (pn < 22) plain<0>(acc, rs, row0, GV, 512, (pn - 20) * 256 + cl, 1.f);
        else if (pn < 24) plain<1>(acc, rs, row0, GRS, 512, (pn - 22) * 256 + cl, 1.f);
        else if (pn == 24) {
            f32x4 bv[2][2];
#pragma unroll
            for (int bj = 0; bj < 2; ++bj)
#pragma unroll
                for (int n = 0; n < 2; ++n) bv[bj][n] = *(const f32x4*)(bga + bj * 128 + cl + 4 * n);
#pragma unroll
            for (int ai = 0; ai < 2; ++ai)
#pragma unroll
                for (int m = 0; m < 4; ++m) { const int row = row0 + ai * 128 + m * 16; const float s = rs[ai][m];
#pragma unroll
                    for (int bj = 0; bj < 2; ++bj)
#pragma unroll
                        for (int n = 0; n < 2; ++n) { const int c = bj * 128 + cl + 4 * n; f32x4 o;
#pragma unroll
                            for (int i = 0; i < 4; ++i) { const float x = acc[ai][bj][m][n][i] * s + bv[bj][n][i];
                                o[i] = (fminf(x, 0.f) - LN2 * fast_log2(1.f + fast_exp2(-1.4426950408889634f * fabsf(x)))) * (1.f / 16.f); }
                            *(f32x4*)(GA + (size_t)row * 256 + c) = o; } }
        } else if (pn < 27) plain<0>(acc, rs, row0, MQ, 512, (pn - 25) * 256 + cl, QSCALE);
        else plain<2>(acc, rs, row0, GATE, 3072, (pn - 27) * 256 + cl, 1.f);
    }
};


constexpr int TS = 4;
template <int O> __device__ __forceinline__ void tail_store_group(const f32x4 (&acc)[2][2][4][2], float* dst) {
#pragma unroll
    for (int e = 0; e < 8; ++e) *(f32x4*)(dst + (size_t)e * 2048) = acc[O >> 1][e >> 2][2 * (O & 1) + ((e >> 1) & 1)][e & 1];
}
template <int O> __device__ __forceinline__ void tail_store_gated(const f32x4 (&acc)[2][2][4][2], const bf16* gp, float* dst) {
    v4u g[2][2];
#pragma unroll
    for (int mm = 0; mm < 2; ++mm)
#pragma unroll
        for (int bj = 0; bj < 2; ++bj) g[mm][bj] = *(const v4u*)(gp + (size_t)((O >> 1) * 128 + (2 * (O & 1) + mm) * 16) * 3072 + bj * 128);
#pragma unroll
    for (int e = 0; e < 8; ++e) { const v4u gv = g[(e >> 1) & 1][e >> 2];
        const f32x4 gg = (e & 1) ? (f32x4){bflo(gv.z), bfhi(gv.z), bflo(gv.w), bfhi(gv.w)} : (f32x4){bflo(gv.x), bfhi(gv.x), bflo(gv.y), bfhi(gv.y)};
        *(f32x4*)(dst + (size_t)e * 2048) = acc[O >> 1][e >> 2][2 * (O & 1) + ((e >> 1) & 1)][e & 1] * gg; }
}
template <class Base, bool GATED = false> struct EpiTail {
    static constexpr bool HAS_MID = false;
    Base E0; float* slab  ; gu32* flag; int s, wave; const bf16* gate  ;
    __device__ __forceinline__ void operator()(const f32x4 (&acc)[2][2][4][2], const Unit& u, int wr, int wc, int fr, int fq) const {
        const int lane = fq * 16 + fr; float* lb = slab + (size_t)(wave * 64 + lane) * 4;
        if (GATED) { const bf16* gp = gate + (size_t)(u.pm * 256 + wr * 64 + fr) * 3072 + u.pn * 256 + wc * 32 + 8 * fq;
            tail_store_gated<0>(acc, gp, lb + (size_t)((0 * TS + s) * 8) * 2048); tail_store_gated<1>(acc, gp, lb + (size_t)((1 * TS + s) * 8) * 2048);
            tail_store_gated<2>(acc, gp, lb + (size_t)((2 * TS + s) * 8) * 2048); tail_store_gated<3>(acc, gp, lb + (size_t)((3 * TS + s) * 8) * 2048); }
        else {
        tail_store_group<0>(acc, lb + (size_t)((0 * TS + s) * 8) * 2048); tail_store_group<1>(acc, lb + (size_t)((1 * TS + s) * 8) * 2048);
        tail_store_group<2>(acc, lb + (size_t)((2 * TS + s) * 8) * 2048); tail_store_group<3>(acc, lb + (size_t)((3 * TS + s) * 8) * 2048); }
        asm volatile("s_waitcnt vmcnt(0)" ::: "memory");
        asm volatile("s_waitcnt lgkmcnt(0)" ::: "memory"); __builtin_amdgcn_s_barrier(); asm volatile("" ::: "memory");
        if (wave == 0) {
            if (lane == 0) { __builtin_amdgcn_fence(__ATOMIC_RELEASE, "agent"); asm volatile("s_waitcnt vmcnt(0)" ::: "memory"); __hip_atomic_fetch_add(flag, 1u, RLX_AGENT); }
            unsigned spins = 0;
            while ((unsigned)__builtin_amdgcn_readfirstlane((int)__hip_atomic_load(flag, RLX_AGENT)) < (unsigned)TS) { __builtin_amdgcn_s_sleep(4); if (++spins > (1u << 22)) break; }
            __builtin_amdgcn_fence(__ATOMIC_ACQUIRE, "agent"); asm volatile("s_waitcnt vmcnt(0)" ::: "memory"); }
        asm volatile("s_waitcnt lgkmcnt(0)" ::: "memory"); __builtin_amdgcn_s_barrier(); asm volatile("" ::: "memory");
        const float* src = lb + (size_t)(s * TS * 8) * 2048;
        f32x4 t[TS][8];
#pragma unroll
        for (int ci = 0; ci < TS; ++ci)
#pragma unroll
            for (int e = 0; e < 8; ++e) t[ci][e] = *(const f32x4*)(src + (size_t)(ci * 8 + e) * 2048);
        f32x4 own[8];
#pragma unroll
        for (int e = 0; e < 8; ++e) own[e] = (t[0][e] + t[1][e]) + (t[2][e] + t[3][e]);
        if (s == 0) E0.template group<0>(own, u, wr, wc, fr, fq); else if (s == 1) E0.template group<1>(own, u, wr, wc, fr, fq);
        else if (s == 2) E0.template group<2>(own, u, wr, wc, fr, fq); else E0.template group<3>(own, u, wr, wc, fr, fq);
    }
};
#define XB_TMO      128
#define XB_XCNT(j)  (256  + 64 * (j))
#define XB_XSUB(j)  (1280 + 64 * (j))
#define XB_XGEN(j)  (2304 + 64 * (j))
#define XB_TOP      3328
#define XB_TOPGEN   3392
#define XCD_BAR_WORDS 3456
#define XB_SPIN_CAP (1u << 18)
__device__ __forceinline__ unsigned xb_ld(unsigned* p)              { return __hip_atomic_load(p, __ATOMIC_RELAXED, __HIP_MEMORY_SCOPE_AGENT); }
__device__ __forceinline__ unsigned xb_add(unsigned* p, unsigned v) { return __hip_atomic_fetch_add(p, v, __ATOMIC_RELAXED, __HIP_MEMORY_SCOPE_AGENT); }
__device__ __forceinline__ unsigned xb_xcc_id() { return (unsigned)__builtin_amdgcn_s_getreg((3 << 11) | 20) & 0xFu; }
#define XB_SPIN(cond, bar) do { unsigned _sp = 0; while (cond) { __builtin_amdgcn_s_sleep(1); \
    if ((++_sp & 255u) == 0u) { if (xb_ld(&(bar)[XB_TMO])) break; if (_sp > XB_SPIN_CAP) { atomicAdd(&(bar)[XB_TMO], 1u); break; } } } } while (0)
struct XcdBarrier { unsigned* bar; unsigned x; volatile LAS unsigned* st; };
__device__ __forceinline__ XcdBarrier xcd_barrier_post(unsigned* bar, volatile LAS unsigned* st, int wave) {
    XcdBarrier b; b.bar = bar; b.x = xb_xcc_id(); b.st = st;
    if (wave == 0 && lane_id() == 0) (void)xb_add(&bar[XB_XCNT(b.x)], 1u);
    return b;
}
__device__ __forceinline__ void xcd_barrier_complete(unsigned* bar, unsigned x, unsigned& nloc, unsigned& nx) {
    const unsigned G = gridDim.x * gridDim.y * gridDim.z;
    unsigned sum, cnt, mine, sp = 0u;
    for (;;) {
        sum = 0u; cnt = 0u; mine = 0u;
#pragma unroll
        for (unsigned j = 0; j < 16; ++j) { const unsigned c = xb_ld(&bar[XB_XCNT(j)]); sum += c; cnt += (c > 0u) ? 1u : 0u; mine = (j == x) ? c : mine; }
        if (sum == G) break;
        __builtin_amdgcn_s_sleep(1);
        if ((++sp & 255u) == 0u) { if (xb_ld(&bar[XB_TMO])) break; if (sp > XB_SPIN_CAP) { atomicAdd(&bar[XB_TMO], 1u); break; } }
    }
    nloc = mine > 0u ? mine : 1u; nx = cnt > 0u ? cnt : 1u;
}
__device__ __forceinline__ void xcd_barrier(const XcdBarrier& b, int wave) {
    asm volatile("s_waitcnt vmcnt(0)" ::: "memory");
    __syncthreads();
    if (wave == 0 && lane_id() == 0) {
        unsigned* bar = b.bar;
        __builtin_amdgcn_s_waitcnt(0);
        unsigned nloc = b.st[0], nx = b.st[1];
        if (nloc == 0u) { xcd_barrier_complete(bar, b.x, nloc, nx); b.st[0] = nloc; b.st[1] = nx; }
        const unsigned old = xb_add(&bar[XB_XSUB(b.x)], 1u);
        const unsigned gen = old / nloc;
        if (old + 1u == (gen + 1u) * nloc) {
            __builtin_amdgcn_fence(__ATOMIC_RELEASE, "agent");
            asm volatile("s_waitcnt vmcnt(0)" ::: "memory");
            const unsigned og = xb_add(&bar[XB_TOP], 1u);
            const unsigned tg = og / nx;
            if (og + 1u == (tg + 1u) * nx) xb_add(&bar[XB_TOPGEN], 1u);
            else XB_SPIN(xb_ld(&bar[XB_TOPGEN]) == tg, bar);
            __builtin_amdgcn_fence(__ATOMIC_ACQUIRE, "agent");
            xb_add(&bar[XB_XGEN(b.x)], 1u);
            asm volatile("s_waitcnt vmcnt(0)" ::: "memory");
        } else {
            XB_SPIN(xb_ld(&bar[XB_XGEN(b.x)]) == gen, bar);
            __builtin_amdgcn_fence(__ATOMIC_ACQUIRE, "agent");
            asm volatile("s_waitcnt vmcnt(0)" ::: "memory");
        }
    }
    __syncthreads();
}

struct Args { const float* in[25]; float* out; unsigned char* ws; int ph_lo, ph_hi, li, pad; };
struct Frame {
    LAS unsigned char* lds; int tid, lane, wave, vcu, G;
    const float *i0, *i1, *i2, *i3, *i4, *i5, *i6, *i7, *i8, *i9, *i10, *i11, *i12, *i13, *i14, *i15, *i16, *i17, *i18, *i19, *i20, *i21, *i22, *i23, *i24;
    float* out; unsigned char* ws;
};
__device__ __forceinline__ float wave_sum(float v) {
#pragma unroll
    for (int o = 1; o < 64; o <<= 1) v += __shfl_xor(v, o);
    return v;
}

template <class Base, bool ATILED = false> __device__ __forceinline__ void tail_phase(Frame& F, const bf16* A, int lda, const bf16* Bt, int ldb, int K, const Base& E0, int ps) {
    const int c = (int)blockIdx.x; if (c >= 8 * TS) return;
    const int j = c / TS, s = c % TS, nch = K / 128, c0 = (s * nch) / TS, c1 = ((s + 1) * nch) / TS;
    pg8::OneUnit S; S.c = c; pg8::StaticOrderT<MR / 256, D / 256>::unit_of(1024 + j, S.u);
    pg8::Gemm g{A + (ATILED ? (size_t)c0 * 2 * (pg8::TILED_KS / 2) : (size_t)c0 * 128), Bt + c0 * 128, MR, D, (c1 - c0) * 128, lda, ldb};
    EpiTail<Base> E{E0, (float*)(F.ws + WS_SLAB) + (size_t)j * (TS * TS * 8 * 2048), (gu32*)(F.ws + WS_CTL) + CW_TAIL + (ps * 8 + j) * 64, s, F.wave};
    pg8::gemm_phase<EpiTail<Base>, pg8::OneUnit, true, ATILED>(F.lds + RING_OFF, g, S, E, F.wave);
}
__device__ __forceinline__ void tail_phase_merge(Frame& F, const bf16* A, const bf16* Bt, const EpiMerge1& E0, int ps) {
    const int c = (int)blockIdx.x; if (c >= 8 * TS) return;
    const int j = c / TS, s = c % TS, k0 = s < 2 ? 512 * s : 1024 + 256 * (s - 2), kl = s < 2 ? 512 : 256, br = s < 2 ? s : 2;
    pg8::OneUnit S; S.c = c; pg8::StaticOrderT<MR / 256, D / 256>::unit_of(1024 + j, S.u);
    pg8::Gemm g{A + k0, Bt + k0, MR, D, kl, 1536, 1536};
    EpiTail<EpiMerge1, true> E{E0, (float*)(F.ws + WS_SLAB) + (size_t)j * (TS * TS * 8 * 2048), (gu32*)(F.ws + WS_CTL) + CW_TAIL + (ps * 8 + j) * 64, s, F.wave, E0.GATE + br * 1024};
    pg8::gemm_phase<EpiTail<EpiMerge1, true>, pg8::OneUnit>(F.lds + RING_OFF, g, S, E, F.wave);
}
enum WKind { WK_PLAIN = 0, WK_SWIGLU = 1, WK_IN = 2 };
__device__ __forceinline__ int p0_win_col(int np) {
    const int pn = np >> 8, r = np & 255;
    if (pn < 18) { const int qkv = pn / 6, g = (pn % 6) >> 1, hp = pn & 1, h = 2 * hp + (r >> 7); const int d = qkv < 2 ? sig_rope(r & 127) : sig_plain(r & 127); return ((qkv * 3 + g) * 4 + h) * 128 + d; }
    const int c = sig_plain(r);
    if (pn == 18) return 4608 + c;
    if (pn == 19) return 4864 + c;
    if (pn < 22) return 5120 + (pn - 20) * 256 + c;
    if (pn < 24) return 5632 + (pn - 22) * 256 + c;
    if (pn == 24) return -1 - c;
    if (pn < 27) return 6160 + (pn - 25) * 256 + c;
    return DIN + (pn - 27) * 256 + c;
}
__device__ __forceinline__ void p0_item(const Frame& F, int kind, const float* W, int ldw, const float* W2, const float* gain, const float* a2, bf16* WT, int K, int kb, int nb, LAS float* scr) {
    const int lane = F.lane, k0 = 64 * kb, n0 = 32 * nb, np = n0 + (lane & 31);
    int sc; const float* Wp = W; int ld = ldw;
    if (kind == WK_PLAIN) sc = sig_plain(np);
    else if (kind == WK_SWIGLU) { const int r = np & 255; sc = (r >> 7) * FF + (np >> 8) * 128 + sig_plain(r & 127); }
    else { sc = p0_win_col(np); if (sc >= DIN) { sc -= DIN; Wp = W2; ld = 3072; } }
    if (sc >= 0) {
#pragma unroll 8
        for (int i = 0; i < 32; ++i) { const int kk = 2 * i + (lane >> 5); float v = Wp[(size_t)(k0 + kk) * ld + sc]; if (gain) v *= gain[k0 + kk]; scr[kk * 33 + (lane & 31)] = v; }
    } else {
        const int j = -1 - sc; float a2c[16];
#pragma unroll
        for (int r = 0; r < 16; ++r) a2c[r] = a2[r * 256 + j];
        for (int i = 0; i < 32; ++i) { const int kk = 2 * i + (lane >> 5); const float* wr_ = W + (size_t)(k0 + kk) * ldw + 6144; float v = 0.f;
#pragma unroll
            for (int r = 0; r < 16; ++r) v += wr_[r] * a2c[r];
            scr[kk * 33 + (lane & 31)] = v * gain[k0 + kk]; }
    }
    LDS_WAIT(); asm volatile("" ::: "memory");
    const int c = lane & 7;
#pragma unroll
    for (int j = 0; j < 4; ++j) { const int n = (lane >> 3) + 8 * j; const LAS float* s = scr + (8 * c) * 33 + n;
        v4u o; o.x = pk2(s[0 * 33], s[1 * 33]); o.y = pk2(s[2 * 33], s[3 * 33]); o.z = pk2(s[4 * 33], s[5 * 33]); o.w = pk2(s[6 * 33], s[7 * 33]);
        *(GAS v4u*)(WT + (size_t)(n0 + n) * K + k0 + 8 * c) = o; }
    LDS_WAIT(); asm volatile("" ::: "memory");
}
template <int NR> __device__ __forceinline__ void rms_rows_to_bf16(int lane, const float* const (&xrow)[NR], const float* const (&gain)[NR], bf16* const (&orow)[NR]) {
    f32x4 v[NR][4]; float rstd[NR];
#pragma unroll
    for (int r = 0; r < NR; ++r)
#pragma unroll
        for (int j = 0; j < 4; ++j) v[r][j] = ((const GAS f32x4*)xrow[r] + lane)[64 * j];
#pragma unroll
    for (int r = 0; r < NR; ++r) { float s = 0.f;
#pragma unroll
        for (int j = 0; j < 4; ++j) s += (v[r][j].x * v[r][j].x + v[r][j].y * v[r][j].y) + (v[r][j].z * v[r][j].z + v[r][j].w * v[r][j].w);
        rstd[r] = 1.0f / sqrtf(wave_sum(s) * (1.f / D) + EPS); }
#pragma unroll
    for (int r = 0; r < NR; ++r) { GAS v2u* o8 = (GAS v2u*)orow[r] + lane; const GAS f32x4* gr = (const GAS f32x4*)gain[r] + lane;
#pragma unroll
        for (int j = 0; j < 4; ++j) { const f32x4 gg = gr[64 * j]; v2u w; w.x = pk2(v[r][j].x * rstd[r] * gg.x, v[r][j].y * rstd[r] * gg.y); w.y = pk2(v[r][j].z * rstd[r] * gg.z, v[r][j].w * rstd[r] * gg.w); o8[64 * j] = w; } }
}
__device__ __forceinline__ void sincos_d(double x, double& s, double& c) {
    const double TWO_PI = 6.283185307179586476925286766559;
    const double n = __builtin_rint(x / TWO_PI); const double r = x - n * TWO_PI, r2 = r * r;
    double ts = 1.0, tc = 1.0;
#pragma unroll
    for (int k = 14; k >= 1; --k) { ts = 1.0 - ts * r2 / (double)((2 * k) * (2 * k + 1)); tc = 1.0 - tc * r2 / (double)((2 * k - 1) * (2 * k)); }
    s = ts * r; c = tc;
}
__device__ __forceinline__ void p0_prologue(Frame& F) {
    unsigned char* ws = F.ws;
    LAS float* scr = (LAS float*)(F.lds + RING_OFF + F.wave * 16384);
    const int gw = F.vcu * NWAVES + F.wave, NGW = F.G * NWAVES;
    constexpr int I_A = 16 * 176, I_O = 44 * 32, I_IN = 16 * 312, I_BR = 8 * 32, I_SQ = 16 * 32;
    constexpr int NITEMS = 2 * I_A + 2 * I_O + I_IN + 3 * I_BR + 2 * I_SQ;
    for (int it = gw; it < NITEMS; it += NGW) {
        int r = it;
        if (r < I_A) { p0_item(F, WK_SWIGLU, F.i9, 2 * FF, nullptr, nullptr, nullptr, (bf16*)(ws + WS_W1A), D, r / 176, r % 176, scr); continue; } r -= I_A;
        if (r < I_A) { p0_item(F, WK_SWIGLU, F.i22, 2 * FF, nullptr, F.i21, nullptr, (bf16*)(ws + WS_W2A), D, r / 176, r % 176, scr); continue; } r -= I_A;
        if (r < I_O) { p0_item(F, WK_PLAIN, F.i10, D, nullptr, nullptr, nullptr, (bf16*)(ws + WS_W1O), FF, r / 32, r % 32, scr); continue; } r -= I_O;
        if (r < I_O) { p0_item(F, WK_PLAIN, F.i23, D, nullptr, nullptr, nullptr, (bf16*)(ws + WS_W2O), FF, r / 32, r % 32, scr); continue; } r -= I_O;
        if (r < I_IN) { p0_item(F, WK_IN, F.i12, DIN, F.i16, F.i11, F.i13, (bf16*)(ws + WS_WIN), D, r / 312, r % 312, scr); continue; } r -= I_IN;
        if (r < 3 * I_BR) { const int br = r / I_BR, q = r % I_BR; p0_item(F, WK_PLAIN, F.i17 + (size_t)br * 512 * D, D, nullptr, nullptr, nullptr, (bf16*)(ws + WS_WBR) + br * 512, 1536, q / 32, q % 32, scr); continue; } r -= 3 * I_BR;
        if (r < I_SQ) { p0_item(F, WK_PLAIN, F.i18, D, nullptr, nullptr, nullptr, (bf16*)(ws + WS_WOUT), D, r / 32, r % 32, scr); continue; } r -= I_SQ;
        p0_item(F, WK_PLAIN, F.i20, D, nullptr, nullptr, nullptr, (bf16*)(ws + WS_WMEM), D, r / 32, r % 32, scr);
    }
#define P0_ROW(m_, x_, g_, o_) do { const int mm_ = (m_); if (mm_ < MP) { x_ = F.i0 + (size_t)mm_ * D; g_ = F.i8; o_ = (bf16*)(ws + WS_XB) + (size_t)mm_ * D; } \
        else if (mm_ < MR) { x_ = F.i1 + (size_t)(mm_ - MP) * D; g_ = F.i8; o_ = (bf16*)(ws + WS_XB) + (size_t)mm_ * D; } \
        else { x_ = F.i2 + (size_t)(mm_ - MR) * D; g_ = F.i19; o_ = (bf16*)(ws + WS_MEMB) + (size_t)(mm_ - MR) * D; } } while (0)
    { int m = gw;
      for (; m + 3 * NGW < MR + MM; m += 4 * NGW) { const float* x[4]; const float* g[4]; bf16* o[4];
#pragma unroll
          for (int r = 0; r < 4; ++r) P0_ROW(m + r * NGW, x[r], g[r], o[r]);
          rms_rows_to_bf16<4>(F.lane, x, g, o); }
      for (; m < MR + MM; m += NGW) { const float* x[1]; const float* g[1]; bf16* o[1]; P0_ROW(m, x[0], g[0], o[0]); rms_rows_to_bf16<1>(F.lane, x, g, o); } }
#undef P0_ROW
    float* rc = (float*)(ws + WS_ROPE); float* rsn = rc + NPOS * 64;
    for (int i = (F.vcu * NWAVES * 64) + F.tid; i < NPOS * 64; i += F.G * NWAVES * 64) {
        const int p = i >> 6, e = i & 63; const int pos = p < SEQ ? p : PAST + (p - SEQ);
        const double y = -(double)e * 9.210340371976182736 / 64.0 / 16.0; double ex = 1.0;
#pragma unroll
        for (int k = 14; k >= 1; --k) ex = 1.0 + ex * y / (double)k;
        ex *= ex; ex *= ex; ex *= ex; ex *= ex;
        const float inv = (float)ex; const float ang = (float)pos * inv;
        double s, c; sincos_d((double)ang, s, c); rc[i] = (float)c; rsn[i] = (float)s;
    }
}

__device__ __forceinline__ int koff(int row, int ch) { return 256 * row + 16 * (ch ^ (row & 15)); }
__device__ __forceinline__ int voff(int row, int ch) { return 256 * row + 16 * (ch ^ ((row & 7) << 1)); }
typedef short v4i16_t __attribute__((ext_vector_type(4)));
__device__ __forceinline__ s16x4 vtr(const LAS unsigned char* p) { return __builtin_bit_cast(s16x4, __builtin_amdgcn_ds_read_tr16_b64_v4i16((LAS v4i16_t*)p)); }
struct AttnDesc { const bf16* Qp; const bf16* Kp; const bf16* Vp; bf16* Op; float* lsep; long qrow0, krow0, orow0; int qpitch, kpitch, opitch, qstride, kstride, ostride, kmin; };
template <int MODE> __device__ __forceinline__ AttnDesc attn_desc(const Frame& F, int id) {
    unsigned char* ws = F.ws; AttnDesc d;
    if (MODE == 0) {
        const int b = id / 192, rem = id % 192, gh = rem >> 4, u = rem & 15, g = gh >> 2;
        const int dil = g == 0 ? 1 : (g == 1 ? 4 : 16), r = g == 0 ? 0 : (g == 1 ? (u & 3) : u), n = g == 0 ? u : (g == 1 ? (u >> 2) : 0);
        const size_t hb = (size_t)((g * NB + b) * 4 + (gh & 3)) * SEQ * 128; const long pr = (long)r * (SEQ / dil);
        d.Qp = (const bf16*)(ws + WS_QS) + hb; d.Kp = (const bf16*)(ws + WS_KS) + hb; d.Vp = (const bf16*)(ws + WS_VS) + hb; d.Op = (bf16*)(ws + WS_OG) + gh * 128; d.lsep = (float*)(ws + WS_LSE) + gh;
        d.qrow0 = pr + 128 * n; d.krow0 = pr + 128 * (n - 1); d.orow0 = (long)b * SEQ + r + (long)128 * n * dil; d.qpitch = 128; d.kpitch = 128; d.opitch = 1536; d.qstride = 1; d.kstride = 1; d.ostride = dil; d.kmin = n == 0 ? 128 : 0;
    } else {
        const int j = id - 6144, b = j >> 6, h = (j >> 4) & 3, n = j & 15;
        d.Qp = (const bf16*)(ws + WS_MQ) + h * 128; d.Kp = (const bf16*)(ws + WS_MKV) + h * 128; d.Vp = (const bf16*)(ws + WS_MKV) + 512 + h * 128; d.Op = (bf16*)(ws + WS_OALL) + 1024 + h * 128; d.lsep = nullptr;
        d.qrow0 = (long)b * SEQ + 128 * n; d.orow0 = d.qrow0; d.ostride = 1; d.krow0 = (long)b * MEML; d.qpitch = 512; d.kpitch = 1024; d.opitch = 1536; d.qstride = 1; d.kstride = 1; d.kmin = 0;
    }
    return d;
}
template <int MODE> __device__ __forceinline__ void attn_scores(const Frame& F, const AttnDesc& d, const bf16x8 (&qf)[4], f32x4 (&S)[MODE == 0 ? 9 : 16], float& mx_out, float& ls_out) {
    const LAS unsigned char* ldsK = F.lds + RING_OFF;
    const int lane = F.lane, w = F.wave, l15 = lane & 15, g4 = lane >> 4;
    constexpr int NF = MODE == 0 ? 9 : 16;
    const int f0 = MODE == 0 ? w : 0; const bool half = MODE == 0 && d.kmin != 0;
#pragma unroll
    for (int i = 0; i < NF; ++i) { S[i] = (f32x4){0.f, 0.f, 0.f, 0.f};
        if (!(half && f0 + i < 8)) { const int krow = 16 * (f0 + i) + l15;
#pragma unroll
            for (int s = 0; s < 4; ++s) { const bf16x8 kf = *(const LAS bf16x8*)(ldsK + koff(krow, 4 * s + g4)); S[i] = __builtin_amdgcn_mfma_f32_16x16x32_bf16(kf, qf[s], S[i], 0, 0, 0); } } }
    float mx = -3.0e38f; const int iq = 16 * w + l15;
#pragma unroll
    for (int i = 0; i < NF; ++i)
#pragma unroll
        for (int r = 0; r < 4; ++r) { if (MODE == 0) { const int kj = 16 * (f0 + i) + 4 * g4 + r; const bool ok = kj >= iq && kj <= iq + 128 && kj >= d.kmin; S[i][r] = ok ? S[i][r] : -3.0e38f; } mx = fmaxf(mx, S[i][r]); }
    mx = fmaxf(mx, __shfl_xor(mx, 16)); mx = fmaxf(mx, __shfl_xor(mx, 32));
    float ls = 0.f;
#pragma unroll
    for (int i = 0; i < NF; ++i)
#pragma unroll
        for (int r = 0; r < 4; ++r) { const float p = fast_exp2(S[i][r] - mx); S[i][r] = p; ls += p; }
    ls += __shfl_xor(ls, 16); ls += __shfl_xor(ls, 32);
    mx_out = mx; ls_out = ls;
}
template <int MODE> __device__ __forceinline__ void attn_pv(const Frame& F, const AttnDesc& d, const f32x4 (&S)[MODE == 0 ? 9 : 16], float mx, float ls) {
    const LAS unsigned char* ldsV = F.lds + RING_OFF + 65536;
    const int lane = F.lane, w = F.wave, l15 = lane & 15, g4 = lane >> 4;
    constexpr int NF = MODE == 0 ? 9 : 16, NP = (NF + 1) / 2;
    const int f0 = MODE == 0 ? w : 0; const bool half = MODE == 0 && d.kmin != 0;
    f32x4 O[8];
#pragma unroll
    for (int df = 0; df < 8; ++df) O[df] = (f32x4){0.f, 0.f, 0.f, 0.f};
    const int q4 = l15 >> 2, p4 = lane & 3;
#pragma unroll
    for (int pr = 0; pr < NP; ++pr) {
        int fa = f0 + 2 * pr, fb = fa + 1; if (fb > 15) fb = 15;
        if (half && fb < 8) continue;
        if (half && fa < 8) fa = 8;
        const f32x4 pa = S[2 * pr], pb = (2 * pr + 1 < NF) ? S[(2 * pr + 1 < NF) ? 2 * pr + 1 : 0] : (f32x4){0.f, 0.f, 0.f, 0.f};
        v4u pw; pw.x = cvt_pk_bf16(pa.x, pa.y); pw.y = cvt_pk_bf16(pa.z, pa.w); pw.z = cvt_pk_bf16(pb.x, pb.y); pw.w = cvt_pk_bf16(pb.z, pb.w);
        const bf16x8 pf = __builtin_bit_cast(bf16x8, pw);
        const int ra = 16 * fa + 4 * g4 + q4, rb = 16 * fb + 4 * g4 + q4;
#pragma unroll
        for (int df = 0; df < 8; ++df) {
            const s16x4 t1 = vtr(ldsV + voff(ra, 2 * df + (p4 >> 1)) + 8 * (p4 & 1)), t2 = vtr(ldsV + voff(rb, 2 * df + (p4 >> 1)) + 8 * (p4 & 1));
            const bf16x8 vf = {t1[0], t1[1], t1[2], t1[3], t2[0], t2[1], t2[2], t2[3]};
            O[df] = __builtin_amdgcn_mfma_f32_16x16x32_bf16(vf, pf, O[df], 0, 0, 0);
        }
    }
    const float inv = 1.0f / ls;
    const long qrow = d.orow0 + (long)(16 * w + l15) * d.ostride;
    bf16* op = d.Op + qrow * d.opitch + 4 * g4;
#pragma unroll
    for (int df = 0; df < 8; ++df) { const f32x4 o = O[df] * inv; v2u wv; wv.x = cvt_pk_bf16(o.x, o.y); wv.y = cvt_pk_bf16(o.z, o.w); *(v2u*)(op + 16 * df) = wv; }
    if (MODE == 0 && g4 == 0) d.lsep[qrow * 12] = (mx + fast_log2(ls)) * LN2;
}
__device__ __forceinline__ void glds16(const void* gsrc, unsigned lds_dst) { unsigned keep;
    asm volatile("s_mov_b32 %0, m0\n\ts_mov_b32 m0, %2\n\ts_nop 0\n\tglobal_load_lds_dwordx4 %1, off\n\ts_mov_b32 m0, %0" : "=&s"(keep) : "v"(gsrc), "s"(lds_dst) : "memory"); }
__device__ __forceinline__ void attn_dma(const Frame& F, const AttnDesc& d, const bool isV) {
    const bf16* P = isV ? d.Vp : d.Kp;
    const unsigned base = (unsigned)__builtin_amdgcn_readfirstlane((int)(unsigned)(size_t)(F.lds + RING_OFF) + (isV ? 65536 : 0) + F.wave * 8192);
    if (d.kmin != 0 && F.wave < 4) return;
    const int slot = F.lane & 15, rsub = F.lane >> 4;
#pragma unroll
    for (int i = 0; i < 8; ++i) { const int row = 32 * F.wave + 4 * i + rsub, ch = isV ? (slot ^ ((row & 7) << 1)) : (slot ^ (row & 15));
        const bf16* gp = P + (d.krow0 + (long)row * d.kstride) * d.kpitch + ch * 8;
        glds16(gp, base + i * 1024); }
}
__device__ __forceinline__ void attn_loadq(const Frame& F, const AttnDesc& d, bf16x8 (&qf)[4]) {
    const long qrow = d.qrow0 + (long)(16 * F.wave + (F.lane & 15)) * d.qstride;
#pragma unroll
    for (int s = 0; s < 4; ++s) qf[s] = *(const bf16x8*)(d.Qp + qrow * d.qpitch + 32 * s + 8 * (F.lane >> 4));
}
#define ATT_BAR() do { asm volatile("s_waitcnt lgkmcnt(0)" ::: "memory"); __builtin_amdgcn_s_barrier(); asm volatile("" ::: "memory"); } while (0)
template <int MODE, int NU> __device__ __forceinline__ void attn_batch(const Frame& F, int id0) {
    AttnDesc d = attn_desc<MODE>(F, id0);
    bf16x8 qn[4], qc[4];
    attn_dma(F, d, false); attn_loadq(F, d, qn);
#pragma unroll
    for (int s = 0; s < 4; ++s) qc[s] = qn[s];
    attn_dma(F, d, true);
#pragma unroll 1
    for (int u = 0; u < NU; ++u) {
        asm volatile("s_waitcnt vmcnt(8)" ::: "memory"); ATT_BAR();
        f32x4 S[MODE == 0 ? 9 : 16]; float mx, ls;
        attn_scores<MODE>(F, d, qc, S, mx, ls);
        asm volatile("s_waitcnt vmcnt(0)" ::: "memory"); ATT_BAR();
        const bool more = u + 1 < NU;
        const AttnDesc dn = attn_desc<MODE>(F, id0 + (more ? u + 1 : u));
        if (more) { attn_dma(F, dn, false); if (MODE == 0) attn_loadq(F, dn, qn); }
        attn_pv<MODE>(F, d, S, mx, ls);
        ATT_BAR();
        if (more) {
            if (MODE != 0) attn_loadq(F, dn, qn);
#pragma unroll
            for (int s = 0; s < 4; ++s) qc[s] = qn[s];
            asm volatile("" : "+v"(qc[0]), "+v"(qc[1]), "+v"(qc[2]), "+v"(qc[3]));
            attn_dma(F, dn, true); }
        d = dn;
    }
    asm volatile("s_waitcnt vmcnt(0)" ::: "memory");
}
__device__ __forceinline__ void p4_sample_attn(const Frame& F, int wt, const float* c0, const float* c1, const float* c2, const float* cm) {
    unsigned char* ws = F.ws; const int lane = F.lane, sub = lane & 15, t = lane >> 4;
    const int db = wt >> 4, h = (wt >> 2) & 3, src = wt & 3;
    const int row = MP + db * 4 + t;
    const bf16* qp = src < 3 ? (const bf16*)(ws + WS_QS) + (size_t)row * 1536 + src * 512 + h * 128 + 8 * sub : (const bf16*)(ws + WS_MQ) + (size_t)row * 512 + h * 128 + 8 * sub;
    float q[8]; { const v4u qw = *(const v4u*)qp; q[0] = bflo(qw.x); q[1] = bfhi(qw.x); q[2] = bflo(qw.y); q[3] = bfhi(qw.y); q[4] = bflo(qw.z); q[5] = bfhi(qw.z); q[6] = bflo(qw.w); q[7] = bfhi(qw.w); }
    float mx = -3.0e38f, ls = 0.f, o[8];
#pragma unroll
    for (int j = 0; j < 8; ++j) o[j] = 0.f;
#define SA_STEP(K0, K1, V0, V1) do { float s_ = (q[0] * K0.x + q[1] * K0.y) + (q[2] * K0.z + q[3] * K0.w) + (q[4] * K1.x + q[5] * K1.y) + (q[6] * K1.z + q[7] * K1.w); \
        s_ += __shfl_xor(s_, 1); s_ += __shfl_xor(s_, 2); s_ += __shfl_xor(s_, 4); s_ += __shfl_xor(s_, 8); \
        const float mn_ = fmaxf(mx, s_), sc_ = fast_exp2(mx - mn_), p_ = fast_exp2(s_ - mn_); mx = mn_; ls = ls * sc_ + p_; \
        o[0] = o[0] * sc_ + p_ * V0.x; o[1] = o[1] * sc_ + p_ * V0.y; o[2] = o[2] * sc_ + p_ * V0.z; o[3] = o[3] * sc_ + p_ * V0.w; \
        o[4] = o[4] * sc_ + p_ * V1.x; o[5] = o[5] * sc_ + p_ * V1.y; o[6] = o[6] * sc_ + p_ * V1.z; o[7] = o[7] * sc_ + p_ * V1.w; } while (0)
    int nstart = 0, NK; const float* cache; int L = 256, dil = 1;
    if (src == 3) { cache = cm; NK = 256; }
    else { cache = src == 0 ? c0 : (src == 1 ? c1 : c2); L = 128 << (2 * src); dil = src == 0 ? 1 : (src == 1 ? 4 : 16); NK = 129; nstart = 4;
        for (int n = 0; n < 4; ++n) {
            const int idx = L + t - dil * n; f32x4 k0, k1, v0, v1;
            if (idx >= L) { const size_t ro = (size_t)(MP + db * 4 + (idx - L)) * 1536 + src * 512 + h * 128 + 8 * sub;
                const v4u kw = *(const v4u*)((const bf16*)(ws + WS_KS) + ro), vw = *(const v4u*)((const bf16*)(ws + WS_VS) + ro);
                k0 = (f32x4){bflo(kw.x), bfhi(kw.x), bflo(kw.y), bfhi(kw.y)}; k1 = (f32x4){bflo(kw.z), bfhi(kw.z), bflo(kw.w), bfhi(kw.w)};
                v0 = (f32x4){bflo(vw.x), bfhi(vw.x), bflo(vw.y), bfhi(vw.y)}; v1 = (f32x4){bflo(vw.z), bfhi(vw.z), bflo(vw.w), bfhi(vw.w)};
            } else { const float* kp = cache + (((size_t)db * L + idx) * 2) * 512 + h * 128 + 8 * sub;
                k0 = *(const f32x4*)kp; k1 = *(const f32x4*)(kp + 4); v0 = *(const f32x4*)(kp + 512); v1 = *(const f32x4*)(kp + 516); }
            SA_STEP(k0, k1, v0, v1);
        }
    }
    const float* kbase = cache + ((size_t)db * L * 2) * 512 + h * 128 + 8 * sub;
    const long kstep = src == 3 ? 1024 : -(long)dil * 1024; const long kfirst = src == 3 ? 0 : (long)(L + t) * 1024;
    int n = nstart;
    for (; n + 4 <= NK; n += 4) {
        f32x4 kk[4][2], vv[4][2];
#pragma unroll
        for (int j = 0; j < 4; ++j) { const float* kp = kbase + kfirst + (long)(n + j) * kstep; kk[j][0] = *(const f32x4*)kp; kk[j][1] = *(const f32x4*)(kp + 4); vv[j][0] = *(const f32x4*)(kp + 512); vv[j][1] = *(const f32x4*)(kp + 516); }
#pragma unroll
        for (int j = 0; j < 4; ++j) SA_STEP(kk[j][0], kk[j][1], vv[j][0], vv[j][1]);
    }
    for (; n < NK; ++n) { const float* kp = kbase + kfirst + (long)n * kstep; const f32x4 k0 = *(const f32x4*)kp, k1 = *(const f32x4*)(kp + 4), v0 = *(const f32x4*)(kp + 512), v1 = *(const f32x4*)(kp + 516); SA_STEP(k0, k1, v0, v1); }
#undef SA_STEP
    const float inv = 1.0f / ls;
    v4u w; w.x = cvt_pk_bf16(o[0] * inv, o[1] * inv); w.y = cvt_pk_bf16(o[2] * inv, o[3] * inv); w.z = cvt_pk_bf16(o[4] * inv, o[5] * inv); w.w = cvt_pk_bf16(o[6] * inv, o[7] * inv);
    if (src < 3) { *(v4u*)((bf16*)(ws + WS_OG) + (size_t)row * 1536 + src * 512 + h * 128 + 8 * sub) = w; if (sub == 0) ((float*)(ws + WS_LSE))[(size_t)row * 12 + src * 4 + h] = (mx + fast_log2(ls)) * LN2; }
    else *(v4u*)((bf16*)(ws + WS_OALL) + (size_t)row * 1536 + 1024 + h * 128 + 8 * sub) = w;
}
__device__ __forceinline__ void p4_sample_attn_shared(const Frame& F, int db, int h, const bool is_mem, const float* cache) {
    unsigned char* ws = F.ws; const int lane = F.lane, sub = lane & 15, gk = lane >> 4; const int rowq0 = MP + db * 4;
    float qv[4][8];
#pragma unroll
    for (int t = 0; t < 4; ++t) { const bf16* qp = is_mem ? (const bf16*)(ws + WS_MQ) + (size_t)(rowq0 + t) * 512 + h * 128 + 8 * sub : (const bf16*)(ws + WS_QS) + (size_t)(rowq0 + t) * 1536 + h * 128 + 8 * sub;
        const v4u qw = *(const v4u*)qp; qv[t][0] = bflo(qw.x); qv[t][1] = bfhi(qw.x); qv[t][2] = bflo(qw.y); qv[t][3] = bfhi(qw.y); qv[t][4] = bflo(qw.z); qv[t][5] = bfhi(qw.z); qv[t][6] = bflo(qw.w); qv[t][7] = bfhi(qw.w); }
    float m[4], l[4], o[4][8];
#pragma unroll
    for (int t = 0; t < 4; ++t) { m[t] = -3.0e38f; l[t] = 0.f;
#pragma unroll
        for (int j = 0; j < 8; ++j) o[t][j] = 0.f; }
#define SS_STEP(P, K0, K1, V0, V1) do { _Pragma("unroll") for (int t = 0; t < 4; ++t) { \
        float s_ = (qv[t][0] * K0.x + qv[t][1] * K0.y) + (qv[t][2] * K0.z + qv[t][3] * K0.w) + (qv[t][4] * K1.x + qv[t][5] * K1.y) + (qv[t][6] * K1.z + qv[t][7] * K1.w); \
        s_ += __shfl_xor(s_, 1); s_ += __shfl_xor(s_, 2); s_ += __shfl_xor(s_, 4); s_ += __shfl_xor(s_, 8); \
        const bool ok_ = is_mem || ((P) >= t && (P) <= 128 + t); \
        const float mn_ = ok_ ? fmaxf(m[t], s_) : m[t], sc_ = fast_exp2(m[t] - mn_), p_ = ok_ ? fast_exp2(s_ - mn_) : 0.f; m[t] = mn_; l[t] = l[t] * sc_ + p_; \
        o[t][0] = o[t][0] * sc_ + p_ * V0.x; o[t][1] = o[t][1] * sc_ + p_ * V0.y; o[t][2] = o[t][2] * sc_ + p_ * V0.z; o[t][3] = o[t][3] * sc_ + p_ * V0.w; \
        o[t][4] = o[t][4] * sc_ + p_ * V1.x; o[t][5] = o[t][5] * sc_ + p_ * V1.y; o[t][6] = o[t][6] * sc_ + p_ * V1.z; o[t][7] = o[t][7] * sc_ + p_ * V1.w; } } while (0)
    const int L = is_mem ? 256 : 128;
    const float* kbase = cache + ((size_t)db * L * 2) * 512 + h * 128 + 8 * sub + (size_t)gk * 1024;
    for (int j = 0; j < L / 4; j += 4) {
        f32x4 kk[4][2], vv[4][2];
#pragma unroll
        for (int e = 0; e < 4; ++e) { const float* kp = kbase + (size_t)(j + e) * 4096; kk[e][0] = *(const f32x4*)kp; kk[e][1] = *(const f32x4*)(kp + 4); vv[e][0] = *(const f32x4*)(kp + 512); vv[e][1] = *(const f32x4*)(kp + 516); }
#pragma unroll
        for (int e = 0; e < 4; ++e) SS_STEP(4 * (j + e) + gk, kk[e][0], kk[e][1], vv[e][0], vv[e][1]);
    }
    if (!is_mem) {
        const size_t ro = (size_t)(rowq0 + gk) * 1536 + h * 128 + 8 * sub;
        const v4u kw = *(const v4u*)((const bf16*)(ws + WS_KS) + ro), vw = *(const v4u*)((const bf16*)(ws + WS_VS) + ro);
        const f32x4 k0 = {bflo(kw.x), bfhi(kw.x), bflo(kw.y), bfhi(kw.y)}, k1 = {bflo(kw.z), bfhi(kw.z), bflo(kw.w), bfhi(kw.w)};
        const f32x4 v0 = {bflo(vw.x), bfhi(vw.x), bflo(vw.y), bfhi(vw.y)}, v1 = {bflo(vw.z), bfhi(vw.z), bflo(vw.w), bfhi(vw.w)};
        SS_STEP(128 + gk, k0, k1, v0, v1);
    }
#undef SS_STEP
    float mo = 0.f, lo = 1.f, oo[8];
#pragma unroll
    for (int j = 0; j < 8; ++j) oo[j] = 0.f;
#pragma unroll
    for (int t = 0; t < 4; ++t) {
        float mm = fmaxf(m[t], __shfl_xor(m[t], 16)); mm = fmaxf(mm, __shfl_xor(mm, 32));
        const float f = fast_exp2(m[t] - mm); float lt = l[t] * f; lt += __shfl_xor(lt, 16); lt += __shfl_xor(lt, 32);
        if (gk == t) { mo = mm; lo = lt; }
#pragma unroll
        for (int j = 0; j < 8; ++j) { float x = o[t][j] * f; x += __shfl_xor(x, 16); x += __shfl_xor(x, 32); if (gk == t) oo[j] = x; }
    }
    const float inv = 1.0f / lo; const int row = rowq0 + gk;
    v4u w; w.x = cvt_pk_bf16(oo[0] * inv, oo[1] * inv); w.y = cvt_pk_bf16(oo[2] * inv, oo[3] * inv); w.z = cvt_pk_bf16(oo[4] * inv, oo[5] * inv); w.w = cvt_pk_bf16(oo[6] * inv, oo[7] * inv);
    if (is_mem) *(v4u*)((bf16*)(ws + WS_OALL) + (size_t)row * 1536 + 1024 + h * 128 + 8 * sub) = w;
    else { *(v4u*)((bf16*)(ws + WS_OG) + (size_t)row * 1536 + h * 128 + 8 * sub) = w; if (sub == 0) ((float*)(ws + WS_LSE))[(size_t)row * 12 + h] = (mo + fast_log2(lo)) * LN2; }
}
__device__ __forceinline__ void p4_sample_task(const Frame& F, int it, const float* c0, const float* c1, const float* c2, const float* cm) {
    const int kind = it >> 9, idx = it & 511, db = idx >> 2, h = idx & 3;
    if (kind == 0) p4_sample_attn(F, db * 16 + h * 4 + 2, c0, c1, c2, cm);
    else if (kind == 1) p4_sample_attn(F, db * 16 + h * 4 + 1, c0, c1, c2, cm);
    else if (kind == 2) p4_sample_attn_shared(F, db, h, true, cm);
    else p4_sample_attn_shared(F, db, h, false, c0);
}
__device__ __forceinline__ void p4_sample_loop(const Frame& F, const float* c0, const float* c1, const float* c2, const float* cm, int q = 0) {
    gu32* qw = (gu32*)(F.ws + WS_CTL) + 64 + 64 * q;
    for (;;) { unsigned v = 0; if (F.lane == 0) v = __hip_atomic_fetch_add(qw, 1u, RLX_AGENT); const int it = (int)__builtin_amdgcn_readfirstlane(v);
        if (it >= 2048) break; p4_sample_task(F, it, c0, c1, c2, cm); }
}
__device__ __forceinline__ void p4_gla_chain(const Frame& F, int row0, int T, int h, const float* S0, float* Sout) {
    unsigned char* ws = F.ws; const int tid = F.tid, v = tid & 127, ks = __builtin_amdgcn_readfirstlane(tid >> 7);
    const float* GA = (const float*)(ws + WS_GA); const bf16* GQ = (const bf16*)(ws + WS_GQ); const bf16* GK = (const bf16*)(ws + WS_GK); const bf16* GV = (const bf16*)(ws + WS_GV); bf16* GO = (bf16*)(ws + WS_GO);
    LAS float* part = (LAS float*)(F.lds + RING_OFF);
    float S[16];
#pragma unroll
    for (int i = 0; i < 16; ++i) S[i] = S0 ? S0[(size_t)(16 * ks + i) * 128 + v] : 0.f;
    for (int t0 = 0; t0 < T; t0 += 16) {
        const int nb = (T - t0) < 16 ? (T - t0) : 16;
        __syncthreads();
        for (int tt = 0; tt < nb; ++tt) {
            const size_t row = (size_t)(row0 + t0 + tt);
            const float* ap = GA + row * 256 + h * 64 + 16 * ks; const v4u kw0 = *(const v4u*)(GK + row * 256 + h * 64 + 16 * ks), kw1 = *(const v4u*)(GK + row * 256 + h * 64 + 16 * ks + 8);
            const v4u qw0 = *(const v4u*)(GQ + row * 256 + h * 64 + 16 * ks), qw1 = *(const v4u*)(GQ + row * 256 + h * 64 + 16 * ks + 8);
            const float vv = bf2f(GV[row * 512 + h * 128 + v]);
            const f32x4 a0 = *(const f32x4*)ap, a1 = *(const f32x4*)(ap + 4), a2 = *(const f32x4*)(ap + 8), a3 = *(const f32x4*)(ap + 12);
            const float la[16] = {a0.x, a0.y, a0.z, a0.w, a1.x, a1.y, a1.z, a1.w, a2.x, a2.y, a2.z, a2.w, a3.x, a3.y, a3.z, a3.w};
            const float kk[16] = {bflo(kw0.x), bfhi(kw0.x), bflo(kw0.y), bfhi(kw0.y), bflo(kw0.z), bfhi(kw0.z), bflo(kw0.w), bfhi(kw0.w), bflo(kw1.x), bfhi(kw1.x), bflo(kw1.y), bfhi(kw1.y), bflo(kw1.z), bfhi(kw1.z), bflo(kw1.w), bfhi(kw1.w)};
            const float qq[16] = {bflo(qw0.x), bfhi(qw0.x), bflo(qw0.y), bfhi(qw0.y), bflo(qw0.z), bfhi(qw0.z), bflo(qw0.w), bfhi(qw0.w), bflo(qw1.x), bfhi(qw1.x), bflo(qw1.y), bfhi(qw1.y), bflo(qw1.z), bfhi(qw1.z), bflo(qw1.w), bfhi(qw1.w)};
            float o = 0.f;
#pragma unroll
            for (int i = 0; i < 16; ++i) { S[i] = fast_exp2(la[i] * 1.4426950408889634f) * S[i] + kk[i] * vv; o += qq[i] * S[i]; }
            part[(tt * 4 + ks) * 128 + v] = o;
        }
        __syncthreads();
        for (int e = tid; e < nb * 128; e += 512) { const int tt = e >> 7, vv_ = e & 127;
            GO[(size_t)(row0 + t0 + tt) * 512 + h * 128 + vv_] = (bf16)f2bf((part[(tt * 4 + 0) * 128 + vv_] + part[(tt * 4 + 1) * 128 + vv_]) + (part[(tt * 4 + 2) * 128 + vv_] + part[(tt * 4 + 3) * 128 + vv_])); }
    }
#pragma unroll
    for (int i = 0; i < 16; ++i) Sout[(size_t)(16 * ks + i) * 128 + v] = S[i];
}
constexpr int GL_QE = 0, GL_KE = 8192, GL_KDT = 16384, GL_VV = 24576, GL_EB = 40960, GL_TOT = 41216, GL_SET = 43264;
__device__ __forceinline__ int goff(int r, int c) { return 128 * r + 16 * (c ^ ((r >> 1) & 7)); }
__device__ __forceinline__ int gvoff(int row, int ch) { return 256 * row + 16 * (ch ^ (((row & 3) | ((((row >> 2) ^ (row >> 3)) & 1) << 2)) << 1)); }
__device__ __forceinline__ void p4_gla_chain_mfma(const Frame& F, int c) {
    unsigned char* ws = F.ws; const int tid = F.tid, lane = F.lane, w = F.wave, l15 = lane & 15, g4 = lane >> 4, q4 = l15 >> 2, p4 = lane & 3;
    const int b = c >> 2, h = c & 3; const size_t row0 = (size_t)b * SEQ;
    const float* GA = (const float*)(ws + WS_GA) + h * 64 + lane; const bf16* GQ = (const bf16*)(ws + WS_GQ) + h * 64 + lane; const bf16* GK = (const bf16*)(ws + WS_GK) + h * 64 + lane;
    const bf16* GV = (const bf16*)(ws + WS_GV) + h * 128 + (tid & 15) * 8; bf16* GO = (bf16*)(ws + WS_GO) + h * 128 + 16 * w + 4 * g4;
    constexpr float L2E = 1.4426950408889634f;
    f32x4 S[4];
#pragma unroll
    for (int K = 0; K < 4; ++K) S[K] = (f32x4){0.f, 0.f, 0.f, 0.f};
    float la[8]; unsigned short qh[8], kh[8]; v4u vr[2];
#define GLA_LOAD(ch) do { const size_t r_ = row0 + 64 * (size_t)(ch); \
        _Pragma("unroll") for (int t = 0; t < 8; ++t) { const size_t rr_ = (r_ + 8 * w + t) * 256; la[t] = GA[rr_]; qh[t] = GQ[rr_]; kh[t] = GK[rr_]; } \
        _Pragma("unroll") for (int e = 0; e < 2; ++e) vr[e] = *(const v4u*)(GV + (r_ + (tid >> 4) + 32 * e) * 512); } while (0)
    GLA_LOAD(0);
#pragma unroll 1
    for (int ch = 0; ch < SEQ / 64; ++ch) {
        LAS unsigned char* B = F.lds + RING_OFF + (ch & 1) * GL_SET;
        LAS float* TOT = (LAS float*)(B + GL_TOT); LAS float* EB = (LAS float*)(B + GL_EB);
        float cs[8], qv[8], kvv[8];
        cs[0] = la[0];
#pragma unroll
        for (int t = 1; t < 8; ++t) cs[t] = cs[t - 1] + la[t];
#pragma unroll
        for (int t = 0; t < 8; ++t) { qv[t] = bf2f(qh[t]); kvv[t] = bf2f(kh[t]); }
        TOT[w * 64 + lane] = cs[7];
#pragma unroll
        for (int e = 0; e < 2; ++e) *(LAS v4u*)(B + GL_VV + gvoff((tid >> 4) + 32 * e, tid & 15)) = vr[e];
        __syncthreads();
        float offs = 0.f, total = 0.f;
#pragma unroll
        for (int g = 0; g < 8; ++g) { const float tg = TOT[g * 64 + lane]; total += tg; offs += (g < w) ? tg : 0.f; }
        unsigned kd[8];
#pragma unroll
        for (int t = 0; t < 8; ++t) { const float bt = offs + cs[t]; const int i = 8 * w + t;
            const float e1 = fast_exp2(bt * L2E), e2 = fast_exp2(-bt * L2E), e3 = fast_exp2((total - bt) * L2E);
            *(LAS unsigned short*)(B + GL_QE + goff(i, lane >> 3) + 2 * (lane & 7)) = (unsigned short)f2bf(qv[t] * e1);
            *(LAS unsigned short*)(B + GL_KE + goff(i, lane >> 3) + 2 * (lane & 7)) = (unsigned short)f2bf(kvv[t] * e2);
            kd[t] = f2bf(kvv[t] * e3); }
        { v4u kw; kw.x = kd[0] | (kd[1] << 16); kw.y = kd[2] | (kd[3] << 16); kw.z = kd[4] | (kd[5] << 16); kw.w = kd[6] | (kd[7] << 16); *(LAS v4u*)(B + GL_KDT + goff(lane, w)) = kw; }
        if (w == 0) EB[lane] = fast_exp2(total * L2E);
        if (ch + 1 < SEQ / 64) GLA_LOAD(ch + 1);
        __syncthreads();
        const LAS unsigned char* QE = B + GL_QE; const LAS unsigned char* KE = B + GL_KE; const LAS unsigned char* KDT = B + GL_KDT; const LAS unsigned char* VV = B + GL_VV;
        bf16x8 kef[4][2];
#pragma unroll
        for (int J = 0; J < 4; ++J)
#pragma unroll
            for (int s = 0; s < 2; ++s) kef[J][s] = *(const LAS bf16x8*)(KE + goff(16 * J + l15, 4 * s + g4));
        bf16x8 vpr[2], vnat[2];
#pragma unroll
        for (int pp = 0; pp < 2; ++pp) { const int ra = 32 * pp + 4 * g4 + q4, rb = ra + 16;
            const s16x4 t1 = vtr(VV + gvoff(ra, 2 * w + (p4 >> 1)) + 8 * (p4 & 1)), t2 = vtr(VV + gvoff(rb, 2 * w + (p4 >> 1)) + 8 * (p4 & 1));
            vpr[pp] = (bf16x8){t1[0], t1[1], t1[2], t1[3], t2[0], t2[1], t2[2], t2[3]}; }
#pragma unroll
        for (int s = 0; s < 2; ++s) { const int r1 = 32 * s + 8 * g4 + q4, r2 = r1 + 4;
            const s16x4 t1 = vtr(VV + gvoff(r1, 2 * w + (p4 >> 1)) + 8 * (p4 & 1)), t2 = vtr(VV + gvoff(r2, 2 * w + (p4 >> 1)) + 8 * (p4 & 1));
            vnat[s] = (bf16x8){t1[0], t1[1], t1[2], t1[3], t2[0], t2[1], t2[2], t2[3]}; }
        bf16x8 sfr[2];
#pragma unroll
        for (int p = 0; p < 2; ++p) { v4u sw; sw.x = cvt_pk_bf16(S[2 * p].x, S[2 * p].y); sw.y = cvt_pk_bf16(S[2 * p].z, S[2 * p].w); sw.z = cvt_pk_bf16(S[2 * p + 1].x, S[2 * p + 1].y); sw.w = cvt_pk_bf16(S[2 * p + 1].z, S[2 * p + 1].w); sfr[p] = __builtin_bit_cast(bf16x8, sw); }
#pragma unroll
        for (int I = 0; I < 4; ++I) {
            f32x4 oT = (f32x4){0.f, 0.f, 0.f, 0.f};
#pragma unroll
            for (int p = 0; p < 2; ++p) {
                const v2u lo = *(const LAS v2u*)(QE + goff(16 * I + l15, 4 * p + (g4 >> 1)) + 8 * (g4 & 1)), hi = *(const LAS v2u*)(QE + goff(16 * I + l15, 4 * p + 2 + (g4 >> 1)) + 8 * (g4 & 1));
                const v4u bw = {lo.x, lo.y, hi.x, hi.y};
                oT = __builtin_amdgcn_mfma_f32_16x16x32_bf16(sfr[p], __builtin_bit_cast(bf16x8, bw), oT, 0, 0, 0); }
            bf16x8 qef[2];
#pragma unroll
            for (int s = 0; s < 2; ++s) qef[s] = *(const LAS bf16x8*)(QE + goff(16 * I + l15, 4 * s + g4));
            f32x4 d1[4];
#pragma unroll
            for (int J = 0; J < 4; ++J) { d1[J] = (f32x4){0.f, 0.f, 0.f, 0.f};
                if (J <= I) {
#pragma unroll
                    for (int s = 0; s < 2; ++s) d1[J] = __builtin_amdgcn_mfma_f32_16x16x32_bf16(kef[J][s], qef[s], d1[J], 0, 0, 0);
                    if (J == I) {
#pragma unroll
                        for (int r = 0; r < 4; ++r) d1[J][r] = (4 * g4 + r <= l15) ? d1[J][r] : 0.f; } } }
#pragma unroll
            for (int pp = 0; pp < 2; ++pp) if (2 * pp <= I) {
                const f32x4 pa = d1[2 * pp], pb = d1[2 * pp + 1];
                v4u pw; pw.x = cvt_pk_bf16(pa.x, pa.y); pw.y = cvt_pk_bf16(pa.z, pa.w); pw.z = cvt_pk_bf16(pb.x, pb.y); pw.w = cvt_pk_bf16(pb.z, pb.w);
                oT = __builtin_amdgcn_mfma_f32_16x16x32_bf16(vpr[pp], __builtin_bit_cast(bf16x8, pw), oT, 0, 0, 0); }
            { v2u ow; ow.x = cvt_pk_bf16(oT.x, oT.y); ow.y = cvt_pk_bf16(oT.z, oT.w); *(v2u*)(GO + (row0 + 64 * (size_t)ch + 16 * I + l15) * 512) = ow; }
        }
#pragma unroll
        for (int K = 0; K < 4; ++K) {
            const f32x4 ebv = *(const LAS f32x4*)(EB + 16 * K + 4 * g4); S[K] *= ebv;
#pragma unroll
            for (int s = 0; s < 2; ++s) { const bf16x8 kdf = *(const LAS bf16x8*)(KDT + goff(16 * K + l15, 4 * s + g4)); S[K] = __builtin_amdgcn_mfma_f32_16x16x32_bf16(kdf, vnat[s], S[K], 0, 0, 0); } }
    }
#undef GLA_LOAD
    float* so = F.out + O_GLAP + (size_t)c * 64 * 128 + 16 * w + l15;
#pragma unroll
    for (int K = 0; K < 4; ++K)
#pragma unroll
        for (int r = 0; r < 4; ++r) so[(size_t)(16 * K + 4 * g4 + r) * 128] = S[K][r];
}
template <int NR> __device__ __forceinline__ void p5_combine_rows(const Frame& F, int row0, int rstride) {
    unsigned char* ws = F.ws; const int lane = F.lane, hh = lane >> 4, sub = lane & 15, col = hh * 128 + 8 * sub;
    float l0[NR], l1[NR], l2[NR]; v4u a[NR], b[NR], c[NR], gow[NR], gr[NR];
    const float* gg = F.i15 + 8 * sub; const f32x4 g0 = *(const f32x4*)gg, g1 = *(const f32x4*)(gg + 4);
#pragma unroll
    for (int r = 0; r < NR; ++r) { const int row = row0 + r * rstride;
        const float* lse = (const float*)(ws + WS_LSE) + (size_t)row * 12; l0[r] = lse[hh]; l1[r] = lse[4 + hh]; l2[r] = lse[8 + hh];
        const bf16* og = (const bf16*)(ws + WS_OG) + (size_t)row * 1536 + col; a[r] = *(const v4u*)og; b[r] = *(const v4u*)(og + 512); c[r] = *(const v4u*)(og + 1024);
        gow[r] = *(const v4u*)((const bf16*)(ws + WS_GO) + (size_t)row * 512 + col); gr[r] = *(const v4u*)((const bf16*)(ws + WS_GRS) + (size_t)row * 512 + col); }
#pragma unroll
    for (int r = 0; r < NR; ++r) { const int row = row0 + r * rstride;
        const float mx = fmaxf(l0[r], fmaxf(l1[r], l2[r]));
        float w0 = __expf(l0[r] - mx), w1 = __expf(l1[r] - mx), w2 = __expf(l2[r] - mx); const float wi = 1.0f / (w0 + w1 + w2); w0 *= wi; w1 *= wi; w2 *= wi;
        v4u o;
        o.x = cvt_pk_bf16(w0 * bflo(a[r].x) + w1 * bflo(b[r].x) + w2 * bflo(c[r].x), w0 * bfhi(a[r].x) + w1 * bfhi(b[r].x) + w2 * bfhi(c[r].x));
        o.y = cvt_pk_bf16(w0 * bflo(a[r].y) + w1 * bflo(b[r].y) + w2 * bflo(c[r].y), w0 * bfhi(a[r].y) + w1 * bfhi(b[r].y) + w2 * bfhi(c[r].y));
        o.z = cvt_pk_bf16(w0 * bflo(a[r].z) + w1 * bflo(b[r].z) + w2 * bflo(c[r].z), w0 * bfhi(a[r].z) + w1 * bfhi(b[r].z) + w2 * bfhi(c[r].z));
        o.w = cvt_pk_bf16(w0 * bflo(a[r].w) + w1 * bflo(b[r].w) + w2 * bflo(c[r].w), w0 * bfhi(a[r].w) + w1 * bfhi(b[r].w) + w2 * bfhi(c[r].w));
        bf16* oall = (bf16*)(ws + WS_OALL) + (size_t)row * 1536;
        *(v4u*)(oall + col) = o;
        const f32x4 x0 = {bflo(gow[r].x), bfhi(gow[r].x), bflo(gow[r].y), bfhi(gow[r].y)}, x1 = {bflo(gow[r].z), bfhi(gow[r].z), bflo(gow[r].w), bfhi(gow[r].w)};
        float ss = (x0.x * x0.x + x0.y * x0.y) + (x0.z * x0.z + x0.w * x0.w) + (x1.x * x1.x + x1.y * x1.y) + (x1.z * x1.z + x1.w * x1.w);
        ss += __shfl_xor(ss, 1); ss += __shfl_xor(ss, 2); ss += __shfl_xor(ss, 4); ss += __shfl_xor(ss, 8);
        const float rstd = 1.0f / sqrtf(ss * (1.f / 128.f) + EPS);
        v4u y;
        y.x = cvt_pk_bf16(x0.x * rstd * g0.x * bflo(gr[r].x), x0.y * rstd * g0.y * bfhi(gr[r].x)); y.y = cvt_pk_bf16(x0.z * rstd * g0.z * bflo(gr[r].y), x0.w * rstd * g0.w * bfhi(gr[r].y));
        y.z = cvt_pk_bf16(x1.x * rstd * g1.x * bflo(gr[r].z), x1.y * rstd * g1.y * bfhi(gr[r].z)); y.w = cvt_pk_bf16(x1.z * rstd * g1.z * bflo(gr[r].w), x1.w * rstd * g1.w * bfhi(gr[r].w));
        *(v4u*)(oall + 512 + col) = y; }
}
template <int NR> __device__ __forceinline__ void p10_final_rows(const Frame& F, int row0, int rstride) {
    const GAS f32x4* gr = (const GAS f32x4*)F.i24 + 2 * F.lane; const f32x4 g00 = gr[0], g01 = gr[1], g10 = gr[128], g11 = gr[129];
    v4u v[NR][2];
#pragma unroll
    for (int r = 0; r < NR; ++r) { const GAS v4u* xr = (const GAS v4u*)((const bf16*)(F.ws + WS_Y16) + (size_t)(row0 + r * rstride) * D) + F.lane; v[r][0] = xr[0]; v[r][1] = xr[64]; }
#pragma unroll
    for (int r = 0; r < NR; ++r) { float x[2][8]; float s = 0.f;
#pragma unroll
        for (int j = 0; j < 2; ++j) { x[j][0] = bflo(v[r][j].x); x[j][1] = bfhi(v[r][j].x); x[j][2] = bflo(v[r][j].y); x[j][3] = bfhi(v[r][j].y); x[j][4] = bflo(v[r][j].z); x[j][5] = bfhi(v[r][j].z); x[j][6] = bflo(v[r][j].w); x[j][7] = bfhi(v[r][j].w);
#pragma unroll
            for (int e = 0; e < 8; ++e) s += x[j][e] * x[j][e]; }
        const float rstd = 1.0f / sqrtf(wave_sum(s) * (1.f / D) + EPS);
        GAS f32x4* yr = (GAS f32x4*)(F.out + (size_t)(row0 + r * rstride) * D) + 2 * F.lane;
        yr[0] = (f32x4){x[0][0] * rstd * g00.x, x[0][1] * rstd * g00.y, x[0][2] * rstd * g00.z, x[0][3] * rstd * g00.w};
        yr[1] = (f32x4){x[0][4] * rstd * g01.x, x[0][5] * rstd * g01.y, x[0][6] * rstd * g01.z, x[0][7] * rstd * g01.w};
        yr[128] = (f32x4){x[1][0] * rstd * g10.x, x[1][1] * rstd * g10.y, x[1][2] * rstd * g10.z, x[1][3] * rstd * g10.w};
        yr[129] = (f32x4){x[1][4] * rstd * g11.x, x[1][5] * rstd * g11.y, x[1][6] * rstd * g11.z, x[1][7] * rstd * g11.w}; }
}
__device__ __forceinline__ void phase1(Frame& F) {
    unsigned char* ws = F.ws; const int G = F.G, bx = (int)blockIdx.x;
    { pg8::Gemm g{(const bf16*)(ws + WS_XB), (const bf16*)(ws + WS_W1A), MR, 2 * FF, D, D, D}; typedef pg8::StaticOrderT<MR / 256, 2 * FF / 256> SO; SO S; S.init(MR, 2 * FF, G, bx);
      EpiSwiglu E{(bf16*)(ws + WS_G), nullptr}; pg8::gemm_phase<EpiSwiglu, SO>(F.lds + RING_OFF, g, S, E, F.wave, MK_STAGGER_A); }
    { pg8::Gemm g{(const bf16*)(ws + WS_MEMB), (const bf16*)(ws + WS_WMEM), MM, D, D, D, D}; typedef pg8::StaticOrderT<MM / 256, D / 256> SO; SO S; S.init(MM, D, G, (bx + G / 2) % G);
      EpiMemKV E{F.out + O_MEMKV, (bf16*)(ws + WS_MKV)}; pg8::gemm_phase<EpiMemKV, SO>(F.lds + RING_OFF, g, S, E, F.wave); }
}
__device__ __forceinline__ void phase2(Frame& F) {
    unsigned char* ws = F.ws; const int G = F.G, bx = (int)blockIdx.x;
    pg8::Gemm g{(const bf16*)(ws + WS_G), (const bf16*)(ws + WS_W1O), MR, D, FF, 64, FF};   typedef pg8::StaticOrderT<MR / 256, D / 256> SO; SO S; S.init(MR, D, G, bx);
    EpiResidX<true> E{F.i0, F.i1, (bf16*)(ws + WS_HB), (float*)(ws + WS_PQ1), 0.5f};
    S.lim = 1024; S.rev = 1; pg8::gemm_phase<EpiResidX<true>, SO, true, true>(F.lds + RING_OFF, g, S, E, F.wave);
    tail_phase<EpiResidX<true>, true>(F, g.A, 64, g.Bt, FF, FF, E, 0);
}
__device__ __forceinline__ void phase3(Frame& F) {
    unsigned char* ws = F.ws; const int G = F.G, bx = (int)blockIdx.x;
    pg8::Gemm g{(const bf16*)(ws + WS_HB), (const bf16*)(ws + WS_WIN), MR, NZ, D, D, D}; typedef pg8::StaticOrderT<MR / 256, NZ / 256> SO; SO S; S.init(MR, NZ, G, bx);
    EpiZ E{(const float*)(ws + WS_PQ1), (const float*)(ws + WS_ROPE), (const float*)(ws + WS_ROPE) + NPOS * 64, F.i14, F.out,
           (bf16*)(ws + WS_QS), (bf16*)(ws + WS_KS), (bf16*)(ws + WS_VS), (bf16*)(ws + WS_GQ), (bf16*)(ws + WS_GK), (bf16*)(ws + WS_GV), (bf16*)(ws + WS_GRS), (bf16*)(ws + WS_MQ), (bf16*)(ws + WS_GATE), (float*)(ws + WS_GA)};
    pg8::gemm_phase<EpiZ, SO>(F.lds + RING_OFF, g, S, E, F.wave, MK_STAGGER_Z);
}
constexpr int CW_Q = 64;
__device__ __forceinline__ int q_pull(const Frame& F, int q) {
    gu32* qw = (gu32*)(F.ws + WS_CTL) + CW_Q + 64 * q;
    volatile LAS unsigned* slot = (volatile LAS unsigned*)(F.lds + MISC_OFF) + 16;
    __syncthreads();
    if (F.tid == 0) *slot = __hip_atomic_fetch_add(qw, 1u, RLX_AGENT);
    __syncthreads();
    return (int)*slot;
}
__device__ __forceinline__ void phase4(Frame& F, const float* c0, const float* c1, const float* c2, const float* cm) {
    const int bx = (int)blockIdx.x;
    if (bx < NB * 4) p4_gla_chain_mfma(F, bx);
    else p4_sample_loop(F, c0, c1, c2, cm);
#pragma unroll 1
    for (int rep = 0; rep < (MK_P4_REPEAT == 2 ? 2 : 1); ++rep) for (;;) { const int it = q_pull(F, 1 + 4 * rep); if (it >= 768) break; attn_batch<0, 8>(F, 8 * (767 - it)); }
#pragma unroll 1
    for (int rep = 0; rep < (MK_P4_REPEAT == 3 ? 2 : 1); ++rep) for (;;) { const int it = q_pull(F, 2 + 4 * rep); if (it >= 256) break; attn_batch<1, 8>(F, 6144 + 8 * (255 - it)); }
    p4_sample_loop(F, c0, c1, c2, cm);
    if (MK_P4_REPEAT == 1) { __syncthreads(); p4_sample_loop(F, c0, c1, c2, cm, 4); }
    if (MK_P4_REPEAT == 4) { __syncthreads(); if (bx < NB * 4) p4_gla_chain_mfma(F, bx); }
    if (MK_P4_REPEAT == 5) { for (;;) { const int c = q_pull(F, 7); if (c >= DECB * 4) break; p4_gla_chain(F, MP + (c >> 2) * DECT, DECT, c & 3, F.i7 + (size_t)c * 64 * 128, F.out + O_GLAS + (size_t)c * 64 * 128); } }
    for (;;) { const int c = q_pull(F, 3); if (c >= DECB * 4) break; p4_gla_chain(F, MP + (c >> 2) * DECT, DECT, c & 3, F.i7 + (size_t)c * 64 * 128, F.out + O_GLAS + (size_t)c * 64 * 128); }
    if (F.G < NB * 4) { for (int c = F.G + bx; c < NB * 4; c += F.G) p4_gla_chain_mfma(F, c); }
}
__device__ __forceinline__ void phase5(Frame& F) {
    { const int st = F.G * NWAVES; int m = F.vcu * NWAVES + F.wave;
      for (; m + 3 * st < MR; m += 4 * st) p5_combine_rows<4>(F, m, st);
      for (; m < MR; m += st) p5_combine_rows<1>(F, m, st); }
}
__device__ __forceinline__ void phase6(Frame& F) {
    unsigned char* ws = F.ws; const int G = F.G, bx = (int)blockIdx.x;
    pg8::Gemm g{(const bf16*)(ws + WS_OALL), (const bf16*)(ws + WS_WBR), MR, D, 1536, 1536, 1536}; typedef pg8::StaticOrderT<MR / 256, D / 256> SO; SO S; S.init(MR, D, G, bx);
    S.lim = 1024; S.rev = 1; EpiMerge1 E{(const bf16*)(ws + WS_GATE), (bf16*)(ws + WS_MB)}; pg8::gemm_phase<EpiMerge1, SO>(F.lds + RING_OFF, g, S, E, F.wave);
    tail_phase_merge(F, g.A, g.Bt, E, 3);
}
__device__ __forceinline__ void phase7(Frame& F) {
    unsigned char* ws = F.ws; const int G = F.G, bx = (int)blockIdx.x;
    pg8::Gemm g{(const bf16*)(ws + WS_MB), (const bf16*)(ws + WS_WOUT), MR, D, D, D, D}; typedef pg8::StaticOrderT<MR / 256, D / 256> SO; SO S; S.init(MR, D, G, bx);
    EpiResidB<true> E{(const bf16*)(ws + WS_HB), (bf16*)(ws + WS_HB), (float*)(ws + WS_PQ2), 1.0f};
    S.lim = 1024; pg8::gemm_phase<EpiResidB<true>, SO>(F.lds + RING_OFF, g, S, E, F.wave);
    tail_phase<EpiResidB<true>>(F, g.A, D, g.Bt, D, D, E, 1);
}
__device__ __forceinline__ void phase8(Frame& F) {
    unsigned char* ws = F.ws; const int G = F.G, bx = (int)blockIdx.x;
    pg8::Gemm g{(const bf16*)(ws + WS_HB), (const bf16*)(ws + WS_W2A), MR, 2 * FF, D, D, D}; typedef pg8::StaticOrderT<MR / 256, 2 * FF / 256> SO; SO S; S.init(MR, 2 * FF, G, bx);
    EpiSwiglu E{(bf16*)(ws + WS_G), (const float*)(ws + WS_PQ2)}; pg8::gemm_phase<EpiSwiglu, SO>(F.lds + RING_OFF, g, S, E, F.wave, MK_STAGGER_A);
}
__device__ __forceinline__ void phase9(Frame& F) {
    unsigned char* ws = F.ws; const int G = F.G, bx = (int)blockIdx.x;
    pg8::Gemm g{(const bf16*)(ws + WS_G), (const bf16*)(ws + WS_W2O), MR, D, FF, 64, FF};   typedef pg8::StaticOrderT<MR / 256, D / 256> SO; SO S; S.init(MR, D, G, bx);
    EpiResidB<false> E{(const bf16*)(ws + WS_HB), (bf16*)(ws + WS_Y16), nullptr, 0.5f};
    S.lim = 1024; S.rev = 1; pg8::gemm_phase<EpiResidB<false>, SO, true, true>(F.lds + RING_OFF, g, S, E, F.wave);
    tail_phase<EpiResidB<false>, true>(F, g.A, 64, g.Bt, FF, FF, E, 2);
}
__device__ __forceinline__ void phase10(Frame& F) {
    { const int st = F.G * NWAVES; int m = F.vcu * NWAVES + F.wave;
      for (; m + 3 * st < MR; m += 4 * st) p10_final_rows<4>(F, m, st);
      for (; m < MR; m += st) p10_final_rows<1>(F, m, st); }
}
__device__ __forceinline__ void xcd_barrier_or_skip(const XcdBarrier& b, bool on, int wave) { if (on) xcd_barrier(b, wave); }
constexpr int N_PHASES = 11;
__global__ void __launch_bounds__(NWAVES * 64, 2) mk_fwd(Args args) {
    extern __shared__ __attribute__((aligned(16))) unsigned char lds[];
    Frame F;
    F.lds = (LAS unsigned char*)lds;
    F.wave = __builtin_amdgcn_readfirstlane((int)(threadIdx.x >> 6)); F.lane = lane_id(); F.tid = F.wave * 64 + F.lane;
    F.G = gridDim.x; { const int bx = blockIdx.x; F.vcu = (F.G % 8 == 0) ? (bx % 8) * (F.G / 8) + bx / 8 : bx; }
    F.i0 = args.in[0]; F.i1 = args.in[1]; F.i2 = args.in[2]; F.i3 = args.in[3]; F.i4 = args.in[4]; F.i5 = args.in[5]; F.i6 = args.in[6]; F.i7 = args.in[7]; F.i8 = args.in[8]; F.i9 = args.in[9]; F.i10 = args.in[10]; F.i11 = args.in[11]; F.i12 = args.in[12]; F.i13 = args.in[13]; F.i14 = args.in[14]; F.i15 = args.in[15]; F.i16 = args.in[16]; F.i17 = args.in[17]; F.i18 = args.in[18]; F.i19 = args.in[19]; F.i20 = args.in[20]; F.i21 = args.in[21]; F.i22 = args.in[22]; F.i23 = args.in[23]; F.i24 = args.in[24];
    F.out = args.out; F.ws = args.ws;
    unsigned char* ws = args.ws; gu32* ctl = (gu32*)(ws + WS_CTL);
    volatile LAS unsigned* MISC = (volatile LAS unsigned*)(F.lds + MISC_OFF);
    for (int u = F.tid; u < (LDS_BYTES - LDSCTL_OFF) / 4; u += NWAVES * 64) ((LAS unsigned*)(F.lds + LDSCTL_OFF))[u] = 0u;
    __syncthreads();
    XcdBarrier bar; bar.bar = (unsigned*)(ctl + CW_BAR); bar.x = 0; bar.st = nullptr;
    if (MK_N_LAUNCHES == 1) bar = xcd_barrier_post((unsigned*)(ctl + CW_BAR), MISC + 8, F.wave);
    const int lo = args.ph_lo, hi = args.ph_hi;
#define IN(k) (lo <= (k) && (k) < hi && (k) <= MK_STOP_AFTER)
#define GRID_BAR(k) do { if (IN((k) + 1)) xcd_barrier(bar, F.wave); } while (0)

#define RUN(k, call) do { if (IN(k)) { F.lane = lane_id(); F.tid = F.wave * 64 + F.lane; call; if (MK_REPEAT_PHASE == (k)) { xcd_barrier_or_skip(bar, MK_N_LAUNCHES == 1, F.wave); call; } GRID_BAR(k); } } while (0)
    RUN(0, p0_prologue(F));
    RUN(1, phase1(F));
    RUN(2, phase2(F));
    RUN(3, phase3(F));
    RUN(4, phase4(F, args.in[3], args.in[4], args.in[5], args.in[6]));
    RUN(5, phase5(F));
    RUN(6, phase6(F));
    RUN(7, phase7(F));
    RUN(8, phase8(F));
    RUN(9, phase9(F));
    if (IN(10)) { F.lane = lane_id(); F.tid = F.wave * 64 + F.lane; phase10(F); }
#undef RUN
#if MK_STOP_AFTER < 10
    if (hi == N_PHASES) {
        for (int m = F.vcu * NWAVES + F.wave; m < MR; m += G * NWAVES) {
            for (int c = F.lane; c < D; c += 64) {
                float v;
                if (MK_STOP_AFTER == 0) v = bf2f(((const bf16*)(ws + WS_WIN))[(size_t)(m % NZ) * D + c]);
                else if (MK_STOP_AFTER == 3) { const bf16* gt = (const bf16*)(ws + WS_GATE) + (size_t)m * 3072; v = bf2f(gt[c]) + bf2f(gt[1024 + c]) + bf2f(gt[2048 + c]); }
                else if (MK_STOP_AFTER <= 5) { const bf16* oa = (const bf16*)(ws + WS_OALL) + (size_t)m * 1536; v = bf2f(oa[c]) + bf2f(oa[1024 + (c & 511)]); }
                else if (MK_STOP_AFTER == 6) v = bf2f(((const bf16*)(ws + WS_MB))[(size_t)m * D + c]);
                else if (MK_STOP_AFTER == 7) v = ((const float*)(ws + WS_H))[(size_t)m * D + c];
                else v = bf2f(((const bf16*)(ws + WS_G))[(size_t)m * FF + c]) + bf2f(((const bf16*)(ws + WS_G))[(size_t)m * FF + 1792 + c]);
                F.out[(size_t)m * D + c] = v;
            }
        }
    }
#endif
#undef IN
#undef GRID_BAR
}

extern "C" void kernel_launch(void* const* d_in, const int* in_sizes, int n_in, void* d_out, int out_size, void* d_ws, size_t ws_size, hipStream_t stream) {
    static int grid = 0;
    if (grid == 0) {
        if (n_in != 25 || (size_t)out_size != O_END || ws_size < WS_END2) { fprintf(stderr, "kernel_launch: unexpected shapes: n_in %d out %d ws %zu (need %zu); nothing launched\n", n_in, out_size, ws_size, (size_t)WS_END2); grid = -1; return; }
        int dev = 0, cus = 0, per_cu = 0;
        if (hipGetDevice(&dev) != hipSuccess || hipDeviceGetAttribute(&cus, hipDeviceAttributeMultiprocessorCount, dev) != hipSuccess) { grid = -1; return; }
        if (hipFuncSetAttribute((const void*)mk_fwd, hipFuncAttributeMaxDynamicSharedMemorySize, LDS_BYTES) != hipSuccess) { fprintf(stderr, "kernel_launch: hipFuncSetAttribute failed\n"); grid = -1; return; }
        if (hipOccupancyMaxActiveBlocksPerMultiprocessor(&per_cu, (const void*)mk_fwd, NWAVES * 64, LDS_BYTES) != hipSuccess || per_cu < 1) fprintf(stderr, "kernel_launch: occupancy query reports %d\n", per_cu);
        (void)hipGetLastError();
        grid = cus;
    }
    if (grid < 0) return;
    if (hipMemsetAsync((char*)d_ws + WS_CTL, 0, CTL_ZERO_BYTES, stream) != hipSuccess) return;
    Args a{};
    for (int i = 0; i < 25; ++i) a.in[i] = (const float*)d_in[i];
    a.out = (float*)d_out; a.ws = (unsigned char*)d_ws; a.pad = 0;
    for (int li = 0; li < MK_N_LAUNCHES; ++li) {
        a.ph_lo = (MK_N_LAUNCHES == 1) ? 0 : li; a.ph_hi = (MK_N_LAUNCHES == 1) ? N_PHASES : li + 1; a.li = li;
        hipLaunchKernelGGL(mk_fwd, dim3(grid), dim3(NWAVES * 64), LDS_BYTES, stream, a);
        const hipError_t le = hipPeekAtLastError();
        if (le != hipSuccess) { fprintf(stderr, "kernel_launch: launch %d failed: %s\n", li, hipGetErrorName(le)); break; }
    }
}
```

```cpp
#include <hip/hip_runtime.h>
#include <cstdio>
#include <cstdint>

#ifndef MK_N_LAUNCHES
#define MK_N_LAUNCHES 1
#endif

#ifndef MK_REPEAT_PHASE
#define MK_REPEAT_PHASE -1
#endif
#ifndef MK_P4_REPEAT
#define MK_P4_REPEAT 0
#endif
#ifndef MK_STAGGER_A
#ifndef MK_WGM_N
#define MK_WGM_N 2
#endif
#ifndef MK_WGM_A
#define MK_WGM_A 4
#endif
#ifndef MK_WGM_Z
#define MK_WGM_Z 2
#endif
#define MK_STAGGER_A 0
#endif
#ifndef MK_STAGGER_Z
#define MK_STAGGER_Z 0
#endif
#ifndef MK_STOP_AFTER
#define MK_STOP_AFTER 10
#endif
#define GAS __attribute__((address_space(1)))
#define LAS __attribute__((address_space(3)))
typedef unsigned short bf16;
typedef unsigned v4u __attribute__((ext_vector_type(4)));
typedef unsigned v2u __attribute__((ext_vector_type(2)));
typedef float f32x4 __attribute__((ext_vector_type(4)));
typedef float f32x2 __attribute__((ext_vector_type(2)));
typedef short bf16x8 __attribute__((ext_vector_type(8)));
typedef short s16x4 __attribute__((ext_vector_type(4)));
typedef GAS unsigned gu32;

__device__ __forceinline__ int lane_id() { return (int)__builtin_amdgcn_mbcnt_hi(~0u, __builtin_amdgcn_mbcnt_lo(~0u, 0u)); }
constexpr int D = 1024, NB = 32, SEQ = 2048, DECB = 128, DECT = 4, PAST = 8192, MEML = 256;
constexpr int MP = NB * SEQ;
constexpr int MS = DECB * DECT;
constexpr int MR = MP + MS;
constexpr int MM = NB * MEML;
constexpr int FF = 2816, NZ = 9984;
constexpr int DIN = 6672;
constexpr int NPOS = SEQ + DECT;
constexpr float EPS = 1e-6f;
constexpr float QSCALE = 0.08838834764831845f * 1.4426950408889634f;
constexpr float LN2 = 0.6931471805599453f;

constexpr size_t O_Y = 0, O_YS = (size_t)MP * D, O_SWA0P = O_YS + (size_t)MS * D, O_SWA1P = O_SWA0P + (size_t)NB * 128 * 1024, O_SWA2P = O_SWA1P + (size_t)NB * 512 * 1024,
                 O_MEMKV = O_SWA2P + (size_t)NB * 2048 * 1024, O_GLAP = O_MEMKV + (size_t)MM * 1024, O_SWA0S = O_GLAP + (size_t)NB * 4 * 64 * 128, O_SWA1S = O_SWA0S + (size_t)MS * 1024,
                 O_SWA2S = O_SWA1S + (size_t)MS * 1024, O_GLAS = O_SWA2S + (size_t)MS * 1024, O_END = O_GLAS + (size_t)DECB * 4 * 64 * 128;
static_assert(O_END == 170917888ull, "output size");

constexpr size_t MiB = 1u << 20;
constexpr size_t al(size_t x) { return (x + 2 * MiB - 1) / (2 * MiB) * (2 * MiB); }
constexpr size_t WS_CTL = 0, CTL_ZERO_BYTES = 1 * MiB;
constexpr size_t WS_ROPE = 2 * MiB;
constexpr size_t WS_PQ1 = WS_ROPE + al((size_t)NPOS * 64 * 4 * 2);
constexpr size_t WS_PQ2 = WS_PQ1 + al((size_t)MR * 16 * 4);
constexpr size_t WS_W1A = WS_PQ2 + al((size_t)MR * 16 * 4);
constexpr size_t WS_W1O = WS_W1A + al((size_t)2 * FF * D * 2);
constexpr size_t WS_WIN = WS_W1O + al((size_t)D * FF * 2);
constexpr size_t WS_WBR = WS_WIN + al((size_t)NZ * D * 2);
constexpr size_t WS_WOUT = WS_WBR + al((size_t)3 * D * 512 * 2);
constexpr size_t WS_W2A = WS_WOUT + al((size_t)D * D * 2);
constexpr size_t WS_W2O = WS_W2A + al((size_t)2 * FF * D * 2);
constexpr size_t WS_WMEM = WS_W2O + al((size_t)D * FF * 2);
constexpr size_t WS_XB = WS_WMEM + al((size_t)D * D * 2);
constexpr size_t WS_MEMB = WS_XB + al((size_t)MR * D * 2);
constexpr size_t WS_MKV = WS_MEMB + al((size_t)MM * D * 2);
constexpr size_t WS_G = WS_MKV + al((size_t)MM * D * 2);
constexpr size_t WS_H = WS_G + al((size_t)MR * FF * 2);
constexpr size_t WS_HB = WS_H + al((size_t)MR * D * 4);
constexpr size_t WS_QS = WS_HB + al((size_t)MR * D * 2);
constexpr size_t WS_KS = WS_QS + al((size_t)MR * 1536 * 2);
constexpr size_t WS_VS = WS_KS + al((size_t)MR * 1536 * 2);
constexpr size_t WS_GQ = WS_VS + al((size_t)MR * 1536 * 2);
constexpr size_t WS_GK = WS_GQ + al((size_t)MR * 256 * 2);
constexpr size_t WS_GV = WS_GK + al((size_t)MR * 256 * 2);
constexpr size_t WS_GRS = WS_GV + al((size_t)MR * 512 * 2);
constexpr size_t WS_GA = WS_GRS + al((size_t)MR * 512 * 2);
constexpr size_t WS_MQ = WS_GA + al((size_t)MR * 256 * 4);
constexpr size_t WS_GATE = WS_MQ + al((size_t)MR * 512 * 2);
constexpr size_t WS_OG = WS_GATE + al((size_t)MR * 3072 * 2);
constexpr size_t WS_LSE = WS_OG + al((size_t)MR * 1536 * 2);
constexpr size_t WS_GO = WS_LSE + al((size_t)MR * 12 * 4);
constexpr size_t WS_OALL = WS_GO + al((size_t)MR * 512 * 4);
constexpr size_t WS_END = WS_OALL + al((size_t)MR * 1536 * 2);
constexpr size_t WS_SLAB = WS_END; constexpr size_t WS_END2 = WS_SLAB + al((size_t)8 * 4 * 4 * 8 * 2048 * 4);
constexpr size_t WS_T = WS_G, WS_MB = WS_XB, WS_Y16 = WS_XB;
static_assert((size_t)MR * D * 4 <= (size_t)MR * FF * 2, "T fits in G");

constexpr int CW_TMO = 0, CW_CODE = 1, CW_BAR = 4096, CW_TAIL = 8192;

constexpr int RING_OFF = 0, RING_BYTES = 131072;
constexpr int LDSCTL_OFF = RING_BYTES, MISC_OFF = LDSCTL_OFF + 320;
constexpr int LDS_BYTES = 147456;
constexpr int NWAVES = 8;

#define RLX_AGENT __ATOMIC_RELAXED, __HIP_MEMORY_SCOPE_AGENT
#define LDS_WAIT() asm volatile("s_waitcnt lgkmcnt(0)" ::: "memory")
#define VM_WAIT() asm volatile("s_waitcnt vmcnt(0)" ::: "memory")
__device__ __forceinline__ unsigned f2bf(float f) { unsigned u = __builtin_bit_cast(unsigned, f); return (u + 0x7fffu + ((u >> 16) & 1u)) >> 16; }
__device__ __forceinline__ unsigned pk2(float lo, float hi) { return f2bf(lo) | (f2bf(hi) << 16); }
__device__ __forceinline__ float bf2f(unsigned b) { return __builtin_bit_cast(float, b << 16); }
__device__ __forceinline__ float bflo(unsigned w) { return __builtin_bit_cast(float, w << 16); }
__device__ __forceinline__ float bfhi(unsigned w) { return __builtin_bit_cast(float, w & 0xffff0000u); }
typedef __bf16 bf16x2_t __attribute__((ext_vector_type(2)));
__device__ __forceinline__ unsigned cvt_pk_bf16(float lo, float hi) { const f32x2 v = {lo, hi}; const bf16x2_t b = __builtin_convertvector(v, bf16x2_t); return __builtin_bit_cast(unsigned, b); }
__device__ __forceinline__ float fast_exp2(float x) { return __builtin_amdgcn_exp2f(x); }
__device__ __forceinline__ float fast_rcp(float x) { return __builtin_amdgcn_rcpf(x); }
__device__ __forceinline__ float fast_log2(float x) { return __builtin_amdgcn_logf(x); }
__device__ __forceinline__ float sigmoidf_(float x) { return fast_rcp(1.0f + fast_exp2(-1.4426950408889634f * x)); }
__device__ __forceinline__ float siluf_(float x) { return x * sigmoidf_(x); }
__device__ __forceinline__ int perm32(int rho) { return 8 * ((rho >> 2) & 3) + 4 * (rho >> 4) + (rho & 3); }
__device__ __forceinline__ int sig_plain(int r) { return (r & ~31) + perm32(r & 31); }
__device__ __forceinline__ int sig_rope(int r7) { return 64 * ((r7 >> 4) & 1) + 16 * (r7 >> 5) + 4 * ((r7 >> 2) & 3) + (r7 & 3); }

namespace pg8 {
constexpr int BM = 256, BK = 64, HALF = 128, HTB = HALF * BK * 2, STAGE_BYTES = 8 * HTB, NXCD = 8, WGM = 2;
__host__ __device__ __forceinline__ int lds_byte(int r, int c) { const int st = (r >> 4) * 2 + (c >> 5), rr = r & 15, cc = c & 31, ob = rr * 64 + cc * 2; return st * 1024 + (ob ^ (((ob >> 9) & 1) << 5)); }
__host__ __device__ __forceinline__ void stage_rc(int b, int& R, int& C) { const int st = b / 1024, sb = b % 1024, swz = sb ^ (((sb >> 9) & 1) << 5); R = (st >> 1) * 16 + swz / 64; C = (st & 1) * 32 + (swz % 64) / 2; }
struct Unit { int pm, pn; };
struct Gemm { const bf16* A; const bf16* Bt; int M, N, K, lda, ldb; };
constexpr size_t TILED_KS = (size_t)256 * 64 * 2, TILED_PANEL = (size_t)(2816 / 64) * TILED_KS;
template <int NM, int NN> struct StaticOrderT {
    static constexpr int WGM = NN == 4 ? MK_WGM_N : (NN == 22 ? MK_WGM_A : MK_WGM_Z);
    int G, c, lim, rev;
    __host__ __device__ void init(int, int, int G_, int c_) { G = G_; c = c_; lim = NM * NN; rev = 0; }
    __host__ __device__ static __forceinline__ void unit_of(int L, Unit& u) {
        constexpr int nwg = NM * NN, q = nwg / NXCD, r = nwg % NXCD, nig = WGM * NN;
        const int xcd = L & (NXCD - 1), off = L >> 3;
        const int wgid = (xcd < r ? xcd * (q + 1) : r * (q + 1) + (xcd - r) * q) + off;
        const int gid = wgid / nig, x = wgid - gid * nig, fm = gid * WGM;
        if (NM % WGM == 0 || fm + WGM <= NM) { u.pm = fm + (x & (WGM - 1)); u.pn = x / WGM; }
        else { constexpr int gl = (NM % WGM) ? (NM % WGM) : WGM; u.pm = fm + x % gl; u.pn = x / gl; }
    }
    __host__ __device__ __forceinline__ bool next(int i, Unit& u) const { const int L = i * G + c; if (L >= lim) return false; unit_of(rev ? lim - 1 - L : L, u); return true; }
};
struct OneUnit { Unit u; int c; __host__ __device__ __forceinline__ bool next(int i, Unit& o) const { if (i) return false; o = u; return true; } };
template <class Epi, class Sched, bool ALIGN_EPI = true, bool ATILED = false>
__device__ __forceinline__ void gemm_phase(LAS unsigned char* lds, const Gemm g, const Sched& S, const Epi& E, const int wid, const int stagger_ticks = 0) {
    if (stagger_ticks > 0) { const unsigned long long t0 = __builtin_amdgcn_s_memrealtime(); const unsigned long long dl = (unsigned long long)(((S.c * 37) & 255) * stagger_ticks) >> 8;
        while (__builtin_amdgcn_s_memrealtime() - t0 < dl) __builtin_amdgcn_s_sleep(8); }
    const int lane = lane_id(), tid = wid * 64 + lane, wr = wid >> 2, wc = wid & 3, fr = lane & 15, fq = lane >> 4;
    const int K = g.K, nt = K / BK;
    unsigned voffA[2], voffB[2];
#pragma unroll
    for (int i = 0; i < 2; ++i) { int R, C; stage_rc(tid * 16 + i * 8192, R, C); voffA[i] = (unsigned)(R * g.lda + C) * 2u; voffB[i] = (unsigned)(R * g.ldb + C) * 2u; }
    const size_t kstep = (size_t)(BK * 2), kstepA = ATILED ? TILED_KS : kstep;
    const size_t hA = (size_t)HALF * g.lda * 2, tA = ATILED ? TILED_PANEL : 2 * hA, hB = (size_t)HALF * g.ldb * 2, tB = 2 * hB;
    const unsigned ldsw = (unsigned)wid * 1024u;
    const int aoff = lds_byte(wr * 64 + fr, fq * 8), boff = lds_byte(wc * 32 + fr, fq * 8);
#define PG8_SA(b, h) (((b) * 2 + (h)) * HTB)
#define PG8_SB(b, h) ((4 + (b) * 2 + (h)) * HTB)
#define PG8_STAGE(bufoff, gbase, voff) do { _Pragma("unroll") for (int _i = 0; _i < 2; ++_i) \
        __builtin_amdgcn_global_load_lds((const unsigned*)((const char*)(gbase) + (voff)[_i]), (LAS unsigned*)(lds + (bufoff) + ldsw + _i * 8192), 16, 0, 0); } while (0)
#define PG8_LDA(dst, b, h) do { _Pragma("unroll") for (int m = 0; m < 4; ++m) _Pragma("unroll") for (int k = 0; k < 2; ++k) dst[m][k] = *(const LAS bf16x8*)(lds + PG8_SA(b, h) + aoff + m * 2048 + k * 1024); } while (0)
#define PG8_LDB(dst, b, h) do { _Pragma("unroll") for (int n = 0; n < 2; ++n) _Pragma("unroll") for (int k = 0; k < 2; ++k) dst[n][k] = *(const LAS bf16x8*)(lds + PG8_SB(b, h) + boff + n * 2048 + k * 1024); } while (0)
#define PG8_MMA(ai, bj, At, Bt) do { __builtin_amdgcn_s_setprio(1); _Pragma("unroll") for (int m = 0; m < 4; ++m) _Pragma("unroll") for (int n = 0; n < 2; ++n) _Pragma("unroll") for (int k = 0; k < 2; ++k) \
        acc[ai][bj][m][n] = __builtin_amdgcn_mfma_f32_16x16x32_bf16(Bt[n][k], At[m][k], acc[ai][bj][m][n], 0, 0, 0); __builtin_amdgcn_s_setprio(0); } while (0)
#define PG8_WAIT_V(n) asm volatile("s_waitcnt vmcnt(" #n ")" ::: "memory")
#define PG8_WAIT_L(n) asm volatile("s_waitcnt lgkmcnt(" #n ")" ::: "memory")
#define PG8_BAR __builtin_amdgcn_s_barrier()
#define PG8_SCHED __builtin_amdgcn_sched_barrier(0)
    Unit cur, nxt; int ui = 0;
    if (!S.next(0, cur)) return;
    f32x4 acc[2][2][4][2];
#pragma unroll
    for (int a = 0; a < 2; ++a)
#pragma unroll
        for (int b = 0; b < 2; ++b)
#pragma unroll
            for (int m = 0; m < 4; ++m)
#pragma unroll
                for (int n = 0; n < 2; ++n) acc[a][b][m][n] = (f32x4){0.f, 0.f, 0.f, 0.f};
    bf16x8 At[4][2], B0[2][2], B1[2][2];
    const char* cA = (const char*)g.A + (size_t)cur.pm * tA; const char* cB = (const char*)g.Bt + (size_t)cur.pn * tB;
    PG8_STAGE(PG8_SB(0, 0), cB, voffB); PG8_STAGE(PG8_SB(0, 1), cB + hB, voffB); PG8_STAGE(PG8_SA(0, 0), cA, voffA); PG8_STAGE(PG8_SA(0, 1), cA + hA, voffA);
    if (wr == 1) PG8_BAR;
    PG8_WAIT_V(2); PG8_BAR;
    PG8_STAGE(PG8_SB(1, 0), cB + kstep, voffB); PG8_STAGE(PG8_SA(1, 0), cA + kstepA, voffA); PG8_STAGE(PG8_SB(1, 1), cB + hB + kstep, voffB);
    PG8_WAIT_V(6); PG8_BAR;
    for (;;) {
        const bool has_next = S.next(ui + 1, nxt);
        const char* nA = has_next ? (const char*)g.A + (size_t)nxt.pm * tA : cA; const char* nB = has_next ? (const char*)g.Bt + (size_t)nxt.pn * tB : cB;
        const int seg = Epi::HAS_MID ? 8 : nt;
        for (int t0 = 0; t0 < nt; t0 += seg) {
        if constexpr (Epi::HAS_MID) { if (t0) { PG8_SCHED; E.mid(acc, cur, t0, wr, wc, fr, fq); PG8_SCHED; } }
#pragma unroll 1
        for (int t = t0; t < t0 + seg; t += 2) {
            const bool last = (t == nt - 2);
            const char* a1 = cA + (size_t)(t + 1) * kstepA;
            const char* a2 = last ? nA : cA + (size_t)(t + 2) * kstepA; const char* b2 = last ? nB : cB + (size_t)(t + 2) * kstep;
            const char* a3 = a2 + kstepA; const char* b3 = b2 + kstep;
            PG8_LDB(B0, 0, 0); PG8_LDB(B1, 0, 1); PG8_SCHED; PG8_LDA(At, 0, 0); PG8_STAGE(PG8_SA(1, 1), a1 + hA, voffA);
            PG8_WAIT_V(8); PG8_WAIT_L(0); PG8_BAR; PG8_MMA(0, 0, At, B0); PG8_MMA(0, 1, At, B1); PG8_BAR; PG8_SCHED;
            PG8_LDA(At, 0, 1); PG8_STAGE(PG8_SB(0, 0), b2, voffB); PG8_STAGE(PG8_SB(0, 1), b2 + hB, voffB); PG8_STAGE(PG8_SA(0, 0), a2, voffA);
            PG8_WAIT_V(8); PG8_WAIT_L(0); PG8_BAR; PG8_MMA(1, 0, At, B0); PG8_MMA(1, 1, At, B1); PG8_BAR; PG8_SCHED;
            PG8_LDB(B0, 1, 0); PG8_LDB(B1, 1, 1); PG8_SCHED; PG8_LDA(At, 1, 0); PG8_STAGE(PG8_SA(0, 1), a2 + hA, voffA);
            PG8_WAIT_V(8); PG8_WAIT_L(0); PG8_BAR; PG8_MMA(0, 0, At, B0); PG8_MMA(0, 1, At, B1); PG8_BAR; PG8_SCHED;
            PG8_LDA(At, 1, 1); PG8_STAGE(PG8_SB(1, 0), b3, voffB); PG8_STAGE(PG8_SB(1, 1), b3 + hB, voffB); PG8_STAGE(PG8_SA(1, 0), a3, voffA);
            PG8_WAIT_V(8); PG8_WAIT_L(0); PG8_BAR; PG8_MMA(1, 0, At, B0); PG8_MMA(1, 1, At, B1); PG8_BAR; PG8_SCHED;
        }
        }
        if constexpr (ALIGN_EPI) { if (wr == 0) PG8_BAR; }
        E(acc, cur, wr, wc, fr, fq);
        if (!has_next) break;
#pragma unroll
        for (int a = 0; a < 2; ++a)
#pragma unroll
            for (int b = 0; b < 2; ++b)
#pragma unroll
                for (int m = 0; m < 4; ++m)
#pragma unroll
                    for (int n = 0; n < 2; ++n) acc[a][b][m][n] = (f32x4){0.f, 0.f, 0.f, 0.f};
        cur = nxt; cA = nA; cB = nB; ++ui;
        if constexpr (ALIGN_EPI) { if (wr == 1) PG8_BAR; }
    }
    PG8_WAIT_V(0);
    if constexpr (!ALIGN_EPI) { if (wr == 0) PG8_BAR; }
    PG8_BAR;
#undef PG8_SA
#undef PG8_SB
#undef PG8_STAGE
#undef PG8_LDA
#undef PG8_LDB
#undef PG8_MMA
#undef PG8_WAIT_V
#undef PG8_WAIT_L
#undef PG8_BAR
#undef PG8_SCHED
}
}
using pg8::Unit;

typedef const f32x4 (&AccRef)[2][2][4][2];
constexpr size_t G_KT = (size_t)256 * 64, G_PANEL = (FF / 64) * G_KT;
__device__ __forceinline__ size_t g_off(int row, int j) { return (size_t)(row >> 8) * G_PANEL + (size_t)(j >> 6) * G_KT + (size_t)(row & 255) * 64 + (j & 63); }
struct EpiSwiglu {
    static constexpr bool HAS_MID = false;
    bf16* G; const float* pq;
    __device__ __forceinline__ void operator()(AccRef acc, const Unit& u, int wr, int wc, int fr, int fq) const {
        const int row0 = u.pm * 256 + wr * 64 + fr;
        bf16* gb = G + ((size_t)u.pm * (FF / 64) + 2 * u.pn + (wc >> 1)) * G_KT + (size_t)((wr * 64 + fr) * 64 + (wc & 1) * 32 + 8 * fq);
        float sc[2][4];
#pragma unroll
        for (int ai = 0; ai < 2; ++ai)
#pragma unroll
            for (int m = 0; m < 4; ++m) { sc[ai][m] = 1.f;
                if (pq) { const f32x4 pv = *(const f32x4*)(pq + (size_t)(row0 + ai * 128 + m * 16) * 16 + 4 * fq); float t = (pv.x + pv.y) + (pv.z + pv.w); t += __shfl_xor(t, 16); t += __shfl_xor(t, 32); sc[ai][m] = __builtin_amdgcn_rsqf(t * (1.f / D) + EPS); } }
#pragma unroll
        for (int ai = 0; ai < 2; ++ai)
#pragma unroll
            for (int m = 0; m < 4; ++m) {
                const float s = sc[ai][m];
                float o[8];
#pragma unroll
                for (int n = 0; n < 2; ++n)
#pragma unroll
                    for (int i = 0; i < 4; ++i) { const float a = acc[ai][0][m][n][i] * s, b = acc[ai][1][m][n][i] * s; o[4 * n + i] = siluf_(a) * b; }
                v4u w; w.x = cvt_pk_bf16(o[0], o[1]); w.y = cvt_pk_bf16(o[2], o[3]); w.z = cvt_pk_bf16(o[4], o[5]); w.w = cvt_pk_bf16(o[6], o[7]);
                *(v4u*)(gb + (ai * 128 + m * 16) * 64) = w;
            }
    }
};
template <bool WRITE_PQ> struct EpiResidX {
    static constexpr bool HAS_MID = false;
    const float* baseP; const float* baseS; bf16* HB; float* pq; float scale;
    __device__ __forceinline__ void operator()(AccRef acc, const Unit& u, int wr, int wc, int fr, int fq) const {
        const int row0 = u.pm * 256 + wr * 64 + fr, c0 = u.pn * 256 + wc * 32 + 8 * fq; const bool smp = u.pm >= MP / 256;
        const float* bbase = (smp ? baseS : baseP) + (smp ? (size_t)(row0 - MP) * D : (size_t)row0 * D) + c0;
#pragma unroll
        for (int ai = 0; ai < 2; ++ai) {
            f32x4 bb[4][2][2];
#pragma unroll
            for (int m = 0; m < 4; ++m)
#pragma unroll
                for (int bj = 0; bj < 2; ++bj) { const float* bp = bbase + (size_t)(ai * 128 + m * 16) * D + bj * 128; bb[m][bj][0] = *(const f32x4*)bp; bb[m][bj][1] = *(const f32x4*)(bp + 4); }
#pragma unroll
            for (int m = 0; m < 4; ++m) {
                const int row = row0 + ai * 128 + m * 16; float ss = 0.f;
#pragma unroll
                for (int bj = 0; bj < 2; ++bj) {
                    const f32x4 o0 = bb[m][bj][0] + acc[ai][bj][m][0] * scale, o1 = bb[m][bj][1] + acc[ai][bj][m][1] * scale;
                    v4u w; w.x = cvt_pk_bf16(o0.x, o0.y); w.y = cvt_pk_bf16(o0.z, o0.w); w.z = cvt_pk_bf16(o1.x, o1.y); w.w = cvt_pk_bf16(o1.z, o1.w); *(v4u*)(HB + (size_t)row * D + c0 + bj * 128) = w;
                    if (WRITE_PQ) ss += (o0.x * o0.x + o0.y * o0.y) + (o0.z * o0.z + o0.w * o0.w) + (o1.x * o1.x + o1.y * o1.y) + (o1.z * o1.z + o1.w * o1.w);
                }
                if (WRITE_PQ) { ss += __shfl_xor(ss, 16); ss += __shfl_xor(ss, 32); if (fq == 0) pq[(size_t)row * 16 + u.pn * 4 + wc] = ss; }
            }
        }
    }
    template <int O> __device__ __forceinline__ void group(const f32x4 (&v)[8], const Unit& u, int wr, int wc, int fr, int fq) const {
        const int row0 = u.pm * 256 + wr * 64 + fr, c0 = u.pn * 256 + wc * 32 + 8 * fq; const bool smp = u.pm >= MP / 256;
        const float* bbase = (smp ? baseS : baseP) + (smp ? (size_t)(row0 - MP) * D : (size_t)row0 * D) + c0;
        f32x4 bb[2][2][2];
#pragma unroll
        for (int mm = 0; mm < 2; ++mm)
#pragma unroll
            for (int bj = 0; bj < 2; ++bj) { const float* bp = bbase + (size_t)((O >> 1) * 128 + (2 * (O & 1) + mm) * 16) * D + bj * 128; bb[mm][bj][0] = *(const f32x4*)bp; bb[mm][bj][1] = *(const f32x4*)(bp + 4); }
#pragma unroll
        for (int mm = 0; mm < 2; ++mm) { const int row = row0 + (O >> 1) * 128 + (2 * (O & 1) + mm) * 16; float ss = 0.f;
#pragma unroll
            for (int bj = 0; bj < 2; ++bj) {
                const f32x4 o0 = bb[mm][bj][0] + v[bj * 4 + mm * 2] * scale, o1 = bb[mm][bj][1] + v[bj * 4 + mm * 2 + 1] * scale;
                v4u w; w.x = cvt_pk_bf16(o0.x, o0.y); w.y = cvt_pk_bf16(o0.z, o0.w); w.z = cvt_pk_bf16(o1.x, o1.y); w.w = cvt_pk_bf16(o1.z, o1.w); *(v4u*)(HB + (size_t)row * D + c0 + bj * 128) = w;
                if (WRITE_PQ) ss += (o0.x * o0.x + o0.y * o0.y) + (o0.z * o0.z + o0.w * o0.w) + (o1.x * o1.x + o1.y * o1.y) + (o1.z * o1.z + o1.w * o1.w); }
            if (WRITE_PQ) { ss += __shfl_xor(ss, 16); ss += __shfl_xor(ss, 32); if (fq == 0) pq[(size_t)row * 16 + u.pn * 4 + wc] = ss; } }
    }
};
template <bool WRITE_PQ> struct EpiResidB {
    static constexpr bool HAS_MID = false;
    const bf16* base; bf16* out; float* pq; float scale;
    __device__ __forceinline__ void operator()(AccRef acc, const Unit& u, int wr, int wc, int fr, int fq) const {
        const int row0 = u.pm * 256 + wr * 64 + fr, c0 = u.pn * 256 + wc * 32 + 8 * fq;
#pragma unroll
        for (int ai = 0; ai < 2; ++ai) {
            v4u bb[4][2];
#pragma unroll
            for (int m = 0; m < 4; ++m)
#pragma unroll
                for (int bj = 0; bj < 2; ++bj) bb[m][bj] = *(const v4u*)(base + (size_t)(row0 + ai * 128 + m * 16) * D + c0 + bj * 128);
#pragma unroll
            for (int m = 0; m < 4; ++m) {
                const int row = row0 + ai * 128 + m * 16; float ss = 0.f;
#pragma unroll
                for (int bj = 0; bj < 2; ++bj) { const v4u g = bb[m][bj];
                    const f32x4 o0 = (f32x4){bflo(g.x), bfhi(g.x), bflo(g.y), bfhi(g.y)} + acc[ai][bj][m][0] * scale, o1 = (f32x4){bflo(g.z), bfhi(g.z), bflo(g.w), bfhi(g.w)} + acc[ai][bj][m][1] * scale;
                    v4u w; w.x = cvt_pk_bf16(o0.x, o0.y); w.y = cvt_pk_bf16(o0.z, o0.w); w.z = cvt_pk_bf16(o1.x, o1.y); w.w = cvt_pk_bf16(o1.z, o1.w); *(v4u*)(out + (size_t)row * D + c0 + bj * 128) = w;
                    if (WRITE_PQ) ss += (o0.x * o0.x + o0.y * o0.y) + (o0.z * o0.z + o0.w * o0.w) + (o1.x * o1.x + o1.y * o1.y) + (o1.z * o1.z + o1.w * o1.w);
                }
                if (WRITE_PQ) { ss += __shfl_xor(ss, 16); ss += __shfl_xor(ss, 32); if (fq == 0) pq[(size_t)row * 16 + u.pn * 4 + wc] = ss; }
            }
        }
    }
    template <int O> __device__ __forceinline__ void group(const f32x4 (&v)[8], const Unit& u, int wr, int wc, int fr, int fq) const {
        const int row0 = u.pm * 256 + wr * 64 + fr, c0 = u.pn * 256 + wc * 32 + 8 * fq;
        v4u bb[2][2];
#pragma unroll
        for (int mm = 0; mm < 2; ++mm)
#pragma unroll
            for (int bj = 0; bj < 2; ++bj) bb[mm][bj] = *(const v4u*)(base + (size_t)(row0 + (O >> 1) * 128 + (2 * (O & 1) + mm) * 16) * D + c0 + bj * 128);
#pragma unroll
        for (int mm = 0; mm < 2; ++mm) { const int row = row0 + (O >> 1) * 128 + (2 * (O & 1) + mm) * 16; float ss = 0.f;
#pragma unroll
            for (int bj = 0; bj < 2; ++bj) { const v4u g = bb[mm][bj];
                const f32x4 o0 = (f32x4){bflo(g.x), bfhi(g.x), bflo(g.y), bfhi(g.y)} + v[bj * 4 + mm * 2] * scale, o1 = (f32x4){bflo(g.z), bfhi(g.z), bflo(g.w), bfhi(g.w)} + v[bj * 4 + mm * 2 + 1] * scale;
                v4u w; w.x = cvt_pk_bf16(o0.x, o0.y); w.y = cvt_pk_bf16(o0.z, o0.w); w.z = cvt_pk_bf16(o1.x, o1.y); w.w = cvt_pk_bf16(o1.z, o1.w); *(v4u*)(out + (size_t)row * D + c0 + bj * 128) = w;
                if (WRITE_PQ) ss += (o0.x * o0.x + o0.y * o0.y) + (o0.z * o0.z + o0.w * o0.w) + (o1.x * o1.x + o1.y * o1.y) + (o1.z * o1.z + o1.w * o1.w); }
            if (WRITE_PQ) { ss += __shfl_xor(ss, 16); ss += __shfl_xor(ss, 32); if (fq == 0) pq[(size_t)row * 16 + u.pn * 4 + wc] = ss; } }
    }
};
struct EpiMemKV {
    static constexpr bool HAS_MID = false;
    float* out; bf16* MKV;
    __device__ __forceinline__ void operator()(AccRef acc, const Unit& u, int wr, int wc, int fr, int fq) const {
        const int row0 = u.pm * 256 + wr * 64 + fr, c0 = u.pn * 256 + wc * 32 + 8 * fq;
#pragma unroll
        for (int ai = 0; ai < 2; ++ai)
#pragma unroll
            for (int m = 0; m < 4; ++m) {
                const int row = row0 + ai * 128 + m * 16;
#pragma unroll
                for (int bj = 0; bj < 2; ++bj) { const f32x4 o0 = acc[ai][bj][m][0], o1 = acc[ai][bj][m][1]; float* op = out + (size_t)row * D + c0 + bj * 128;
                    *(f32x4*)op = o0; *(f32x4*)(op + 4) = o1;
                    v4u w; w.x = cvt_pk_bf16(o0.x, o0.y); w.y = cvt_pk_bf16(o0.z, o0.w); w.z = cvt_pk_bf16(o1.x, o1.y); w.w = cvt_pk_bf16(o1.z, o1.w); *(v4u*)(MKV + (size_t)row * D + c0 + bj * 128) = w; }
            }
    }
};
struct EpiMerge1 {
    static constexpr bool HAS_MID = true;
    const bf16* GATE; bf16* MB;
    __device__ __forceinline__ void mid(f32x4 (&acc)[2][2][4][2], const Unit& u, int t, int wr, int wc, int fr, int fq) const {
        const unsigned lo = (unsigned)(((wr * 64 + fr) * 3072 + wc * 32 + 8 * fq) * 2);
        const char* ub = (const char*)GATE + ((size_t)u.pm * 256 * 3072 + (size_t)((t >> 3) - 1) * 1024 + (size_t)u.pn * 256) * 2;
#pragma unroll
        for (int ai = 0; ai < 2; ++ai) {
            v4u gn[4][2], gd[4][2];
#pragma unroll
            for (int m = 0; m < 4; ++m)
#pragma unroll
                for (int bj = 0; bj < 2; ++bj) { const char* fb = ub + (size_t)((ai * 128 + m * 16) * 3072 + bj * 128) * 2; gn[m][bj] = *(const v4u*)(fb + lo); gd[m][bj] = *(const v4u*)(fb + 2048 + lo); }
#pragma unroll
            for (int m = 0; m < 4; ++m)
#pragma unroll
                for (int bj = 0; bj < 2; ++bj) { const v4u n_ = gn[m][bj], d_ = gd[m][bj];
                    const f32x4 r0 = {bflo(n_.x) * fast_rcp(fmaxf(bflo(d_.x), 1e-30f)), bfhi(n_.x) * fast_rcp(fmaxf(bfhi(d_.x), 1e-30f)), bflo(n_.y) * fast_rcp(fmaxf(bflo(d_.y), 1e-30f)), bfhi(n_.y) * fast_rcp(fmaxf(bfhi(d_.y), 1e-30f))};
                    const f32x4 r1 = {bflo(n_.z) * fast_rcp(fmaxf(bflo(d_.z), 1e-30f)), bfhi(n_.z) * fast_rcp(fmaxf(bfhi(d_.z), 1e-30f)), bflo(n_.w) * fast_rcp(fmaxf(bflo(d_.w), 1e-30f)), bfhi(n_.w) * fast_rcp(fmaxf(bfhi(d_.w), 1e-30f))};
                    acc[ai][bj][m][0] *= r0; acc[ai][bj][m][1] *= r1; }
            asm volatile("" ::: "memory");
        }
    }
    __device__ __forceinline__ void operator()(AccRef acc, const Unit& u, int wr, int wc, int fr, int fq) const {
        const int row0 = u.pm * 256 + wr * 64 + fr, c0 = u.pn * 256 + wc * 32 + 8 * fq;
        v4u gw[2][4][2];
#pragma unroll
        for (int ai = 0; ai < 2; ++ai)
#pragma unroll
            for (int m = 0; m < 4; ++m)
#pragma unroll
                for (int bj = 0; bj < 2; ++bj) gw[ai][m][bj] = *(const v4u*)(GATE + (size_t)(row0 + ai * 128 + m * 16) * 3072 + 2048 + c0 + bj * 128);
#pragma unroll
        for (int ai = 0; ai < 2; ++ai)
#pragma unroll
            for (int m = 0; m < 4; ++m) { const int row = row0 + ai * 128 + m * 16;
#pragma unroll
                for (int bj = 0; bj < 2; ++bj) { const v4u g = gw[ai][m][bj];
                    const f32x4 o0 = acc[ai][bj][m][0] * (f32x4){bflo(g.x), bfhi(g.x), bflo(g.y), bfhi(g.y)}, o1 = acc[ai][bj][m][1] * (f32x4){bflo(g.z), bfhi(g.z), bflo(g.w), bfhi(g.w)};
                    v4u w; w.x = cvt_pk_bf16(o0.x, o0.y); w.y = cvt_pk_bf16(o0.z, o0.w); w.z = cvt_pk_bf16(o1.x, o1.y); w.w = cvt_pk_bf16(o1.z, o1.w); *(v4u*)(MB + (size_t)row * D + c0 + bj * 128) = w;
                } }
    }
    template <int O> __device__ __forceinline__ void group(const f32x4 (&v)[8], const Unit& u, int wr, int wc, int fr, int fq) const {
        const int row0 = u.pm * 256 + wr * 64 + fr, c0 = u.pn * 256 + wc * 32 + 8 * fq;
#pragma unroll
        for (int mm = 0; mm < 2; ++mm) { const int row = row0 + (O >> 1) * 128 + (2 * (O & 1) + mm) * 16;
#pragma unroll
            for (int bj = 0; bj < 2; ++bj) { const f32x4 o0 = v[bj * 4 + mm * 2], o1 = v[bj * 4 + mm * 2 + 1];
                v4u w; w.x = cvt_pk_bf16(o0.x, o0.y); w.y = cvt_pk_bf16(o0.z, o0.w); w.z = cvt_pk_bf16(o1.x, o1.y); w.w = cvt_pk_bf16(o1.z, o1.w); *(v4u*)(MB + (size_t)row * D + c0 + bj * 128) = w; } }
    }
};
__device__ __forceinline__ size_t qkv_off(int row, int g, int h) {
    if (row >= MP) return (size_t)row * 1536 + g * 512 + h * 128;
    const int b = row >> 11, t = row & 2047, sh = 2 * g, p = ((t & ((1 << sh) - 1)) << (11 - sh)) + (t >> sh);
    return ((size_t)((g * NB + b) * 4 + h) * SEQ + p) * 128;
}
struct EpiZ {
    static constexpr bool HAS_MID = false;
    const float* pq; const float* ropeC; const float* ropeS; const float* bga; float* out;
    bf16 *QS, *KS, *VS, *GQ, *GK, *GV, *GRS, *MQ, *GATE; float* GA;
    template <int ACT> __device__ __forceinline__ void plain(AccRef acc, const float (&rs)[2][4], int row0, bf16* dst, int ld, int col0, float scale) const {
#pragma unroll
        for (int ai = 0; ai < 2; ++ai)
#pragma unroll
            for (int m = 0; m < 4; ++m) { const int row = row0 + ai * 128 + m * 16; const float s = rs[ai][m];
#pragma unroll
                for (int bj = 0; bj < 2; ++bj) { float o[8];
#pragma unroll
                    for (int n = 0; n < 2; ++n)
#pragma unroll
                        for (int i = 0; i < 4; ++i) { const float x = acc[ai][bj][m][n][i] * s; o[4 * n + i] = ACT == 0 ? x * scale : (ACT == 1 ? siluf_(x) : sigmoidf_(x)); }
                    v4u w; w.x = cvt_pk_bf16(o[0], o[1]); w.y = cvt_pk_bf16(o[2], o[3]); w.z = cvt_pk_bf16(o[4], o[5]); w.w = cvt_pk_bf16(o[6], o[7]);
                    *(v4u*)(dst + (size_t)row * ld + col0 + bj * 128) = w; } }
    }
    __device__ __forceinline__ float* swa_dst(int row, int g, int kv, int h) const {
        if (row >= MP) return out + (g == 0 ? O_SWA0S : (g == 1 ? O_SWA1S : O_SWA2S)) + ((size_t)(row - MP) * 2 + kv) * 512 + h * 128;
        const int b = row >> 11, t = row & 2047, keep = 128 << (2 * g), t0 = SEQ - keep;
        if (t < t0) return nullptr;
        return out + (g == 0 ? O_SWA0P : (g == 1 ? O_SWA1P : O_SWA2P)) + (((size_t)b * keep + (t - t0)) * 2 + kv) * 512 + h * 128;
    }
    __device__ __forceinline__ void operator()(AccRef acc, const Unit& u, int wr, int wc, int fr, int fq) const {
        const int row0 = u.pm * 256 + wr * 64 + fr, pn = u.pn, cl = wc * 32 + 8 * fq;
        float rs[2][4];
#pragma unroll
        for (int ai = 0; ai < 2; ++ai)
#pragma unroll
            for (int m = 0; m < 4; ++m) { const int row = row0 + ai * 128 + m * 16;
                const f32x4 pv = *(const f32x4*)(pq + (size_t)row * 16 + 4 * fq); float t = (pv.x + pv.y) + (pv.z + pv.w); t += __shfl_xor(t, 16); t += __shfl_xor(t, 32); rs[ai][m] = __builtin_amdgcn_rsqf(t * (1.f / D) + EPS); }
        if (pn < 12) {
            const int isk = pn >= 6, g = (pn % 6) >> 1, hp = pn & 1, e0 = wc * 16 + 4 * fq;
#pragma unroll
            for (int ai = 0; ai < 2; ++ai) {
                f32x4 cs[4], sn[4];
#pragma unroll
                for (int m = 0; m < 4; ++m) { const int row = row0 + ai * 128 + m * 16; const int pidx = row < MP ? (row & 2047) : SEQ + ((row - MP) & 3);
                    cs[m] = *(const f32x4*)(ropeC + pidx * 64 + e0); sn[m] = *(const f32x4*)(ropeS + pidx * 64 + e0); }
#pragma unroll
                for (int m = 0; m < 4; ++m) { const int row = row0 + ai * 128 + m * 16; const float s = rs[ai][m];
#pragma unroll
                    for (int bj = 0; bj < 2; ++bj) { const int h = 2 * hp + bj;
                        const f32x4 x1 = acc[ai][bj][m][0] * s, x2 = acc[ai][bj][m][1] * s;
                        f32x4 r1 = x1 * cs[m] - x2 * sn[m], r2 = x2 * cs[m] + x1 * sn[m];
                        if (!isk) { r1 *= QSCALE; r2 *= QSCALE; }
                        bf16* dp = (isk ? KS : QS) + qkv_off(row, g, h) + e0;
                        v2u w1, w2; w1.x = cvt_pk_bf16(r1.x, r1.y); w1.y = cvt_pk_bf16(r1.z, r1.w); w2.x = cvt_pk_bf16(r2.x, r2.y); w2.y = cvt_pk_bf16(r2.z, r2.w);
                        *(v2u*)dp = w1; *(v2u*)(dp + 64) = w2;
                        if (isk) { float* fo = swa_dst(row, g, 0, h); if (fo) { *(f32x4*)(fo + e0) = r1; *(f32x4*)(fo + 64 + e0) = r2; } }
                    } }
            }
        } else if (pn < 18) {
            const int g = (pn - 12) >> 1, hp = pn & 1;
#pragma unroll
            for (int ai = 0; ai < 2; ++ai)
#pragma unroll
                for (int m = 0; m < 4; ++m) { const int row = row0 + ai * 128 + m * 16; const float s = rs[ai][m];
#pragma unroll
                    for (int bj = 0; bj < 2; ++bj) { const int h = 2 * hp + bj; const f32x4 o0 = acc[ai][bj][m][0] * s, o1 = acc[ai][bj][m][1] * s;
                        v4u w; w.x = cvt_pk_bf16(o0.x, o0.y); w.y = cvt_pk_bf16(o0.z, o0.w); w.z = cvt_pk_bf16(o1.x, o1.y); w.w = cvt_pk_bf16(o1.z, o1.w);
                        *(v4u*)(VS + qkv_off(row, g, h) + cl) = w;
                        float* fo = swa_dst(row, g, 1, h); if (fo) { *(f32x4*)(fo + cl) = o0; *(f32x4*)(fo + cl + 4) = o1; } } }
        } else if (pn == 18) plain<0>(acc, rs, row0, GQ, 256, cl, 0.125f);
        else if (pn == 19) plain<0>(acc, rs, row0, GK, 256, cl, 1.f);
        else if (pn < 22) plain<0>(acc, rs, row0, GV, 512, (pn - 20) * 256 + cl, 1.f);
        else if (pn < 24) plain<1>(acc, rs, row0, GRS, 512, (pn - 22) * 256 + cl, 1.f);
        else if (pn == 24) {
            f32x4 bv[2][2];
#pragma unroll
            for (int bj = 0; bj < 2; ++bj)
#pragma unroll
                for (int n = 0; n < 2; ++n) bv[bj][n] = *(const f32x4*)(bga + bj * 128 + cl + 4 * n);
#pragma unroll
            for (int ai = 0; ai < 2; ++ai)
#pragma unroll
                for (int m = 0; m < 4; ++m) { const int row = row0 + ai * 128 + m * 16; const float s = rs[ai][m];
#pragma unroll
                    for (int bj = 0; bj < 2; ++bj)
#pragma unroll
                        for (int n = 0; n < 2; ++n) { const int c = bj * 128 + cl + 4 * n; f32x4 o;
#pragma unroll
                            for (int i = 0; i < 4; ++i) { const float x = acc[ai][bj][m][n][i] * s + bv[bj][n][i];
                                o[i] = (fminf(x, 0.f) - LN2 * fast_log2(1.f + fast_exp2(-1.4426950408889634f * fabsf(x)))) * (1.f / 16.f); }
                            *(f32x4*)(GA + (size_t)row * 256 + c) = o; } }
        } else if (pn < 27) plain<0>(acc, rs, row0, MQ, 512, (pn - 25) * 256 + cl, QSCALE);
        else plain<2>(acc, rs, row0, GATE, 3072, (pn - 27) * 256 + cl, 1.f);
    }
};


constexpr int TS = 4;
template <int O> __device__ __forceinline__ void tail_store_group(const f32x4 (&acc)[2][2][4][2], float* dst) {
#pragma unroll
    for (int e = 0; e < 8; ++e) *(f32x4*)(dst + (size_t)e * 2048) = acc[O >> 1][e >> 2][2 * (O & 1) + ((e >> 1) & 1)][e & 1];
}
template <int O> __device__ __forceinline__ void tail_store_gated(const f32x4 (&acc)[2][2][4][2], const bf16* gp, float* dst) {
    v4u g[2][2];
#pragma unroll
    for (int mm = 0; mm < 2; ++mm)
#pragma unroll
        for (int bj = 0; bj < 2; ++bj) g[mm][bj] = *(const v4u*)(gp + (size_t)((O >> 1) * 128 + (2 * (O & 1) + mm) * 16) * 3072 + bj * 128);
#pragma unroll
    for (int e = 0; e < 8; ++e) { const v4u gv = g[(e >> 1) & 1][e >> 2];
        const f32x4 gg = (e & 1) ? (f32x4){bflo(gv.z), bfhi(gv.z), bflo(gv.w), bfhi(gv.w)} : (f32x4){bflo(gv.x), bfhi(gv.x), bflo(gv.y), bfhi(gv.y)};
        *(f32x4*)(dst + (size_t)e * 2048) = acc[O >> 1][e >> 2][2 * (O & 1) + ((e >> 1) & 1)][e & 1] * gg; }
}
template <class Base, bool GATED = false> struct EpiTail {
    static constexpr bool HAS_MID = false;
    Base E0; float* slab  ; gu32* flag; int s, wave; const bf16* gate  ;
    __device__ __forceinline__ void operator()(const f32x4 (&acc)[2][2][4][2], const Unit& u, int wr, int wc, int fr, int fq) const {
        const int lane = fq * 16 + fr; float* lb = slab + (size_t)(wave * 64 + lane) * 4;
        if (GATED) { const bf16* gp = gate + (size_t)(u.pm * 256 + wr * 64 + fr) * 3072 + u.pn * 256 + wc * 32 + 8 * fq;
            tail_store_gated<0>(acc, gp, lb + (size_t)((0 * TS + s) * 8) * 2048); tail_store_gated<1>(acc, gp, lb + (size_t)((1 * TS + s) * 8) * 2048);
            tail_store_gated<2>(acc, gp, lb + (size_t)((2 * TS + s) * 8) * 2048); tail_store_gated<3>(acc, gp, lb + (size_t)((3 * TS + s) * 8) * 2048); }
        else {
        tail_store_group<0>(acc, lb + (size_t)((0 * TS + s) * 8) * 2048); tail_store_group<1>(acc, lb + (size_t)((1 * TS + s) * 8) * 2048);
        tail_store_group<2>(acc, lb + (size_t)((2 * TS + s) * 8) * 2048); tail_store_group<3>(acc, lb + (size_t)((3 * TS + s) * 8) * 2048); }
        asm volatile("s_waitcnt vmcnt(0)" ::: "memory");
        asm volatile("s_waitcnt lgkmcnt(0)" ::: "memory"); __builtin_amdgcn_s_barrier(); asm volatile("" ::: "memory");
        if (wave == 0) {
            if (lane == 0) { __builtin_amdgcn_fence(__ATOMIC_RELEASE, "agent"); asm volatile("s_waitcnt vmcnt(0)" ::: "memory"); __hip_atomic_fetch_add(flag, 1u, RLX_AGENT); }
            unsigned spins = 0;
            while ((unsigned)__builtin_amdgcn_readfirstlane((int)__hip_atomic_load(flag, RLX_AGENT)) < (unsigned)TS) { __builtin_amdgcn_s_sleep(4); if (++spins > (1u << 22)) break; }
            __builtin_amdgcn_fence(__ATOMIC_ACQUIRE, "agent"); asm volatile("s_waitcnt vmcnt(0)" ::: "memory"); }
        asm volatile("s_waitcnt lgkmcnt(0)" ::: "memory"); __builtin_amdgcn_s_barrier(); asm volatile("" ::: "memory");
        const float* src = lb + (size_t)(s * TS * 8) * 2048;
        f32x4 t[TS][8];
#pragma unroll
        for (int ci = 0; ci < TS; ++ci)
#pragma unroll
            for (int e = 0; e < 8; ++e) t[ci][e] = *(const f32x4*)(src + (size_t)(ci * 8 + e) * 2048);
        f32x4 own[8];
#pragma unroll
        for (int e = 0; e < 8; ++e) own[e] = (t[0][e] + t[1][e]) + (t[2][e] + t[3][e]);
        if (s == 0) E0.template group<0>(own, u, wr, wc, fr, fq); else if (s == 1) E0.template group<1>(own, u, wr, wc, fr, fq);
        else if (s == 2) E0.template group<2>(own, u, wr, wc, fr, fq); else E0.template group<3>(own, u, wr, wc, fr, fq);
    }
};
#define XB_TMO      128
#define XB_XCNT(j)  (256  + 64 * (j))
#define XB_XSUB(j)  (1280 + 64 * (j))
#define XB_XGEN(j)  (2304 + 64 * (j))
#define XB_TOP      3328
#define XB_TOPGEN   3392
#define XCD_BAR_WORDS 3456
#define XB_SPIN_CAP (1u << 18)
__device__ __forceinline__ unsigned xb_ld(unsigned* p)              { return __hip_atomic_load(p, __ATOMIC_RELAXED, __HIP_MEMORY_SCOPE_AGENT); }
__device__ __forceinline__ unsigned xb_add(unsigned* p, unsigned v) { return __hip_atomic_fetch_add(p, v, __ATOMIC_RELAXED, __HIP_MEMORY_SCOPE_AGENT); }
__device__ __forceinline__ unsigned xb_xcc_id() { return (unsigned)__builtin_amdgcn_s_getreg((3 << 11) | 20) & 0xFu; }
#define XB_SPIN(cond, bar) do { unsigned _sp = 0; while (cond) { __builtin_amdgcn_s_sleep(1); \
    if ((++_sp & 255u) == 0u) { if (xb_ld(&(bar)[XB_TMO])) break; if (_sp > XB_SPIN_CAP) { atomicAdd(&(bar)[XB_TMO], 1u); break; } } } } while (0)
struct XcdBarrier { unsigned* bar; unsigned x; volatile LAS unsigned* st; };
__device__ __forceinline__ XcdBarrier xcd_barrier_post(unsigned* bar, volatile LAS unsigned* st, int wave) {
    XcdBarrier b; b.bar = bar; b.x = xb_xcc_id(); b.st = st;
    if (wave == 0 && lane_id() == 0) (void)xb_add(&bar[XB_XCNT(b.x)], 1u);
    return b;
}
__device__ __forceinline__ void xcd_barrier_complete(unsigned* bar, unsigned x, unsigned& nloc, unsigned& nx) {
    const unsigned G = gridDim.x * gridDim.y * gridDim.z;
    unsigned sum, cnt, mine, sp = 0u;
    for (;;) {
        sum = 0u; cnt = 0u; mine = 0u;
#pragma unroll
        for (unsigned j = 0; j < 16; ++j) { const unsigned c = xb_ld(&bar[XB_XCNT(j)]); sum += c; cnt += (c > 0u) ? 1u : 0u; mine = (j == x) ? c : mine; }
        if (sum == G) break;
        __builtin_amdgcn_s_sleep(1);
        if ((++sp & 255u) == 0u) { if (xb_ld(&bar[XB_TMO])) break; if (sp > XB_SPIN_CAP) { atomicAdd(&bar[XB_TMO], 1u); break; } }
    }
    nloc = mine > 0u ? mine : 1u; nx = cnt > 0u ? cnt : 1u;
}
__device__ __forceinline__ void xcd_barrier(const XcdBarrier& b, int wave) {
    asm volatile("s_waitcnt vmcnt(0)" ::: "memory");
    __syncthreads();
    if (wave == 0 && lane_id() == 0) {
        unsigned* bar = b.bar;
        __builtin_amdgcn_s_waitcnt(0);
        unsigned nloc = b.st[0], nx = b.st[1];
        if (nloc == 0u) { xcd_barrier_complete(bar, b.x, nloc, nx); b.st[0] = nloc; b.st[1] = nx; }
        const unsigned old = xb_add(&bar[XB_XSUB(b.x)], 1u);
        const unsigned gen = old / nloc;
        if (old + 1u == (gen + 1u) * nloc) {
            __builtin_amdgcn_fence(__ATOMIC_RELEASE, "agent");
            asm volatile("s_waitcnt vmcnt(0)" ::: "memory");
            const unsigned og = xb_add(&bar[XB_TOP], 1u);
            const unsigned tg = og / nx;
            if (og + 1u == (tg + 1u) * nx) xb_add(&bar[XB_TOPGEN], 1u);
            else XB_SPIN(xb_ld(&bar[XB_TOPGEN]) == tg, bar);
            __builtin_amdgcn_fence(__ATOMIC_ACQUIRE, "agent");
            xb_add(&bar[XB_XGEN(b.x)], 1u);
            asm volatile("s_waitcnt vmcnt(0)" ::: "memory");
        } else {
            XB_SPIN(xb_ld(&bar[XB_XGEN(b.x)]) == gen, bar);
            __builtin_amdgcn_fence(__ATOMIC_ACQUIRE, "agent");
            asm volatile("s_waitcnt vmcnt(0)" ::: "memory");
        }
    }
    __syncthreads();
}

struct Args { const float* in[25]; float* out; unsigned char* ws; int ph_lo, ph_hi, li, pad; };
struct Frame {
    LAS unsigned char* lds; int tid, lane, wave, vcu, G;
    const float *i0, *i1, *i2, *i3, *i4, *i5, *i6, *i7, *i8, *i9, *i10, *i11, *i12, *i13, *i14, *i15, *i16, *i17, *i18, *i19, *i20, *i21, *i22, *i23, *i24;
    float* out; unsigned char* ws;
};
__device__ __forceinline__ float wave_sum(float v) {
#pragma unroll
    for (int o = 1; o < 64; o <<= 1) v += __shfl_xor(v, o);
    return v;
}

template <class Base, bool ATILED = false> __device__ __forceinline__ void tail_phase(Frame& F, const bf16* A, int lda, const bf16* Bt, int ldb, int K, const Base& E0, int ps) {
    const int c = (int)blockIdx.x; if (c >= 8 * TS) return;
    const int j = c / TS, s = c % TS, nch = K / 128, c0 = (s * nch) / TS, c1 = ((s + 1) * nch) / TS;
    pg8::OneUnit S; S.c = c; pg8::StaticOrderT<MR / 256, D / 256>::unit_of(1024 + j, S.u);
    pg8::Gemm g{A + (ATILED ? (size_t)c0 * 2 * (pg8::TILED_KS / 2) : (size_t)c0 * 128), Bt + c0 * 128, MR, D, (c1 - c0) * 128, lda, ldb};
    EpiTail<Base> E{E0, (float*)(F.ws + WS_SLAB) + (size_t)j * (TS * TS * 8 * 2048), (gu32*)(F.ws + WS_CTL) + CW_TAIL + (ps * 8 + j) * 64, s, F.wave};
    pg8::gemm_phase<EpiTail<Base>, pg8::OneUnit, true, ATILED>(F.lds + RING_OFF, g, S, E, F.wave);
}
__device__ __forceinline__ void tail_phase_merge(Frame& F, const bf16* A, const bf16* Bt, const EpiMerge1& E0, int ps) {
    const int c = (int)blockIdx.x; if (c >= 8 * TS) return;
    const int j = c / TS, s = c % TS, k0 = s < 2 ? 512 * s : 1024 + 256 * (s - 2), kl = s < 2 ? 512 : 256, br = s < 2 ? s : 2;
    pg8::OneUnit S; S.c = c; pg8::StaticOrderT<MR / 256, D / 256>::unit_of(1024 + j, S.u);
    pg8::Gemm g{A + k0, Bt + k0, MR, D, kl, 1536, 1536};
    EpiTail<EpiMerge1, true> E{E0, (float*)(F.ws + WS_SLAB) + (size_t)j * (TS * TS * 8 * 2048), (gu32*)(F.ws + WS_CTL) + CW_TAIL + (ps * 8 + j) * 64, s, F.wave, E0.GATE + br * 1024};
    pg8::gemm_phase<EpiTail<EpiMerge1, true>, pg8::OneUnit>(F.lds + RING_OFF, g, S, E, F.wave);
}
enum WKind { WK_PLAIN = 0, WK_SWIGLU = 1, WK_IN = 2 };
__device__ __forceinline__ int p0_win_col(int np) {
    const int pn = np >> 8, r = np & 255;
    if (pn < 18) { const int qkv = pn / 6, g = (pn % 6) >> 1, hp = pn & 1, h = 2 * hp + (r >> 7); const int d = qkv < 2 ? sig_rope(r & 127) : sig_plain(r & 127); return ((qkv * 3 + g) * 4 + h) * 128 + d; }
    const int c = sig_plain(r);
    if (pn == 18) return 4608 + c;
    if (pn == 19) return 4864 + c;
    if (pn < 22) return 5120 + (pn - 20) * 256 + c;
    if (pn < 24) return 5632 + (pn - 22) * 256 + c;
    if (pn == 24) return -1 - c;
    if (pn < 27) return 6160 + (pn - 25) * 256 + c;
    return DIN + (pn - 27) * 256 + c;
}
__device__ __forceinline__ void p0_item(const Frame& F, int kind, const float* W, int ldw, const float* W2, const float* gain, const float* a2, bf16* WT, int K, int kb, int nb, LAS float* scr) {
    const int lane = F.lane, k0 = 64 * kb, n0 = 32 * nb, np = n0 + (lane & 31);
    int sc; const float* Wp = W; int ld = ldw;
    if (kind == WK_PLAIN) sc = sig_plain(np);
    else if (kind == WK_SWIGLU) { const int r = np & 255; sc = (r >> 7) * FF + (np >> 8) * 128 + sig_plain(r & 127); }
    else { sc = p0_win_col(np); if (sc >= DIN) { sc -= DIN; Wp = W2; ld = 3072; } }
    if (sc >= 0) {
#pragma unroll 8
        for (int i = 0; i < 32; ++i) { const int kk = 2 * i + (lane >> 5); float v = Wp[(size_t)(k0 + kk) * ld + sc]; if (gain) v *= gain[k0 + kk]; scr[kk * 33 + (lane & 31)] = v; }
    } else {
        const int j = -1 - sc; float a2c[16];
#pragma unroll
        for (int r = 0; r < 16; ++r) a2c[r] = a2[r * 256 + j];
        for (int i = 0; i < 32; ++i) { const int kk = 2 * i + (lane >> 5); const float* wr_ = W + (size_t)(k0 + kk) * ldw + 6144; float v = 0.f;
#pragma unroll
            for (int r = 0; r < 16; ++r) v += wr_[r] * a2c[r];
            scr[kk * 33 + (lane & 31)] = v * gain[k0 + kk]; }
    }
    LDS_WAIT(); asm volatile("" ::: "memory");
    const int c = lane & 7;
#pragma unroll
    for (int j = 0; j < 4; ++j) { const int n = (lane >> 3) + 8 * j; const LAS float* s = scr + (8 * c) * 33 + n;
        v4u o; o.x = pk2(s[0 * 33], s[1 * 33]); o.y = pk2(s[2 * 33], s[3 * 33]); o.z = pk2(s[4 * 33], s[5 * 33]); o.w = pk2(s[6 * 33], s[7 * 33]);
        *(GAS v4u*)(WT + (size_t)(n0 + n) * K + k0 + 8 * c) = o; }
    LDS_WAIT(); asm volatile("" ::: "memory");
}
template <int NR> __device__ __forceinline__ void rms_rows_to_bf16(int lane, const float* const (&xrow)[NR], const float* const (&gain)[NR], bf16* const (&orow)[NR]) {
    f32x4 v[NR][4]; float rstd[NR];
#pragma unroll
    for (int r = 0; r < NR; ++r)
#pragma unroll
        for (int j = 0; j < 4; ++j) v[r][j] = ((const GAS f32x4*)xrow[r] + lane)[64 * j];
#pragma unroll
    for (int r = 0; r < NR; ++r) { float s = 0.f;
#pragma unroll
        for (int j = 0; j < 4; ++j) s += (v[r][j].x * v[r][j].x + v[r][j].y * v[r][j].y) + (v[r][j].z * v[r][j].z + v[r][j].w * v[r][j].w);
        rstd[r] = 1.0f / sqrtf(wave_sum(s) * (1.f / D) + EPS); }
#pragma unroll
    for (int r = 0; r < NR; ++r) { GAS v2u* o8 = (GAS v2u*)orow[r] + lane; const GAS f32x4* gr = (const GAS f32x4*)gain[r] + lane;
#pragma unroll
        for (int j = 0; j < 4; ++j) { const f32x4 gg = gr[64 * j]; v2u w; w.x = pk2(v[r][j].x * rstd[r] * gg.x, v[r][j].y * rstd[r] * gg.y); w.y = pk2(v[r][j].z * rstd[r] * gg.z, v[r][j].w * rstd[r] * gg.w); o8[64 * j] = w; } }
}
__device__ __forceinline__ void sincos_d(double x, double& s, double& c) {
    const double TWO_PI = 6.283185307179586476925286766559;
    const double n = __builtin_rint(x / TWO_PI); const double r = x - n * TWO_PI, r2 = r * r;
    double ts = 1.0, tc = 1.0;
#pragma unroll
    for (int k = 14; k >= 1; --k) { ts = 1.0 - ts * r2 / (double)((2 * k) * (2 * k + 1)); tc = 1.0 - tc * r2 / (double)((2 * k - 1) * (2 * k)); }
    s = ts * r; c = tc;
}
__device__ __forceinline__ void p0_prologue(Frame& F) {
    unsigned char* ws = F.ws;
    LAS float* scr = (LAS float*)(F.lds + RING_OFF + F.wave * 16384);
    const int gw = F.vcu * NWAVES + F.wave, NGW = F.G * NWAVES;
    constexpr int I_A = 16 * 176, I_O = 44 * 32, I_IN = 16 * 312, I_BR = 8 * 32, I_SQ = 16 * 32;
    constexpr int NITEMS = 2 * I_A + 2 * I_O + I_IN + 3 * I_BR + 2 * I_SQ;
    for (int it = gw; it < NITEMS; it += NGW) {
        int r = it;
        if (r < I_A) { p0_item(F, WK_SWIGLU, F.i9, 2 * FF, nullptr, nullptr, nullptr, (bf16*)(ws + WS_W1A), D, r / 176, r % 176, scr); continue; } r -= I_A;
        if (r < I_A) { p0_item(F, WK_SWIGLU, F.i22, 2 * FF, nullptr, F.i21, nullptr, (bf16*)(ws + WS_W2A), D, r / 176, r % 176, scr); continue; } r -= I_A;
        if (r < I_O) { p0_item(F, WK_PLAIN, F.i10, D, nullptr, nullptr, nullptr, (bf16*)(ws + WS_W1O), FF, r / 32, r % 32, scr); continue; } r -= I_O;
        if (r < I_O) { p0_item(F, WK_PLAIN, F.i23, D, nullptr, nullptr, nullptr, (bf16*)(ws + WS_W2O), FF, r / 32, r % 32, scr); continue; } r -= I_O;
        if (r < I_IN) { p0_item(F, WK_IN, F.i12, DIN, F.i16, F.i11, F.i13, (bf16*)(ws + WS_WIN), D, r / 312, r % 312, scr); continue; } r -= I_IN;
        if (r < 3 * I_BR) { const int br = r / I_BR, q = r % I_BR; p0_item(F, WK_PLAIN, F.i17 + (size_t)br * 512 * D, D, nullptr, nullptr, nullptr, (bf16*)(ws + WS_WBR) + br * 512, 1536, q / 32, q % 32, scr); continue; } r -= 3 * I_BR;
        if (r < I_SQ) { p0_item(F, WK_PLAIN, F.i18, D, nullptr, nullptr, nullptr, (bf16*)(ws + WS_WOUT), D, r / 32, r % 32, scr); continue; } r -= I_SQ;
        p0_item(F, WK_PLAIN, F.i20, D, nullptr, nullptr, nullptr, (bf16*)(ws + WS_WMEM), D, r / 32, r % 32, scr);
    }
#define P0_ROW(m_, x_, g_, o_) do { const int mm_ = (m_); if (mm_ < MP) { x_ = F.i0 + (size_t)mm_ * D; g_ = F.i8; o_ = (bf16*)(ws + WS_XB) + (size_t)mm_ * D; } \
        else if (mm_ < MR) { x_ = F.i1 + (size_t)(mm_ - MP) * D; g_ = F.i8; o_ = (bf16*)(ws + WS_XB) + (size_t)mm_ * D; } \
        else { x_ = F.i2 + (size_t)(mm_ - MR) * D; g_ = F.i19; o_ = (bf16*)(ws + WS_MEMB) + (size_t)(mm_ - MR) * D; } } while (0)
    { int m = gw;
      for (; m + 3 * NGW < MR + MM; m += 4 * NGW) { const float* x[4]; const float* g[4]; bf16* o[4];
#pragma unroll
          for (int r = 0; r < 4; ++r) P0_ROW(m + r * NGW, x[r], g[r], o[r]);
          rms_rows_to_bf16<4>(F.lane, x, g, o); }
      for (; m < MR + MM; m += NGW) { const float* x[1]; const float* g[1]; bf16* o[1]; P0_ROW(m, x[0], g[0], o[0]); rms_rows_to_bf16<1>(F.lane, x, g, o); } }
#undef P0_ROW
    float* rc = (float*)(ws + WS_ROPE); float* rsn = rc + NPOS * 64;
    for (int i = (F.vcu * NWAVES * 64) + F.tid; i < NPOS * 64; i += F.G * NWAVES * 64) {
        const int p = i >> 6, e = i & 63; const int pos = p < SEQ ? p : PAST + (p - SEQ);
        const double y = -(double)e * 9.210340371976182736 / 64.0 / 16.0; double ex = 1.0;
#pragma unroll
        for (int k = 14; k >= 1; --k) ex = 1.0 + ex * y / (double)k;
        ex *= ex; ex *= ex; ex *= ex; ex *= ex;
        const float inv = (float)ex; const float ang = (float)pos * inv;
        double s, c; sincos_d((double)ang, s, c); rc[i] = (float)c; rsn[i] = (float)s;
    }
}

__device__ __forceinline__ int koff(int row, int ch) { return 256 * row + 16 * (ch ^ (row & 15)); }
__device__ __forceinline__ int voff(int row, int ch) { return 256 * row + 16 * (ch ^ ((row & 7) << 1)); }
typedef short v4i16_t __attribute__((ext_vector_type(4)));
__device__ __forceinline__ s16x4 vtr(const LAS unsigned char* p) { return __builtin_bit_cast(s16x4, __builtin_amdgcn_ds_read_tr16_b64_v4i16((LAS v4i16_t*)p)); }
struct AttnDesc { const bf16* Qp; const bf16* Kp; const bf16* Vp; bf16* Op; float* lsep; long qrow0, krow0, orow0; int qpitch, kpitch, opitch, qstride, kstride, ostride, kmin; };
template <int MODE> __device__ __forceinline__ AttnDesc attn_desc(const Frame& F, int id) {
    unsigned char* ws = F.ws; AttnDesc d;
    if (MODE == 0) {
        const int b = id / 192, rem = id % 192, gh = rem >> 4, u = rem & 15, g = gh >> 2;
        const int dil = g == 0 ? 1 : (g == 1 ? 4 : 16), r = g == 0 ? 0 : (g == 1 ? (u & 3) : u), n = g == 0 ? u : (g == 1 ? (u >> 2) : 0);
        const size_t hb = (size_t)((g * NB + b) * 4 + (gh & 3)) * SEQ * 128; const long pr = (long)r * (SEQ / dil);
        d.Qp = (const bf16*)(ws + WS_QS) + hb; d.Kp = (const bf16*)(ws + WS_KS) + hb; d.Vp = (const bf16*)(ws + WS_VS) + hb; d.Op = (bf16*)(ws + WS_OG) + gh * 128; d.lsep = (float*)(ws + WS_LSE) + gh;
        d.qrow0 = pr + 128 * n; d.krow0 = pr + 128 * (n - 1); d.orow0 = (long)b * SEQ + r + (long)128 * n * dil; d.qpitch = 128; d.kpitch = 128; d.opitch = 1536; d.qstride = 1; d.kstride = 1; d.ostride = dil; d.kmin = n == 0 ? 128 : 0;
    } else {
        const int j = id - 6144, b = j >> 6, h = (j >> 4) & 3, n = j & 15;
        d.Qp = (const bf16*)(ws + WS_MQ) + h * 128; d.Kp = (const bf16*)(ws + WS_MKV) + h * 128; d.Vp = (const bf16*)(ws + WS_MKV) + 512 + h * 128; d.Op = (bf16*)(ws + WS_OALL) + 1024 + h * 128; d.lsep = nullptr;
        d.qrow0 = (long)b * SEQ + 128 * n; d.orow0 = d.qrow0; d.ostride = 1; d.krow0 = (long)b * MEML; d.qpitch = 512; d.kpitch = 1024; d.opitch = 1536; d.qstride = 1; d.kstride = 1; d.kmin = 0;
    }
    return d;
}
template <int MODE> __device__ __forceinline__ void attn_scores(const Frame& F, const AttnDesc& d, const bf16x8 (&qf)[4], f32x4 (&S)[MODE == 0 ? 9 : 16], float& mx_out, float& ls_out) {
    const LAS unsigned char* ldsK = F.lds + RING_OFF;
    const int lane = F.lane, w = F.wave, l15 = lane & 15, g4 = lane >> 4;
    constexpr int NF = MODE == 0 ? 9 : 16;
    const int f0 = MODE == 0 ? w : 0; const bool half = MODE == 0 && d.kmin != 0;
#pragma unroll
    for (int i = 0; i < NF; ++i) { S[i] = (f32x4){0.f, 0.f, 0.f, 0.f};
        if (!(half && f0 + i < 8)) { const int krow = 16 * (f0 + i) + l15;
#pragma unroll
            for (int s = 0; s < 4; ++s) { const bf16x8 kf = *(const LAS bf16x8*)(ldsK + koff(krow, 4 * s + g4)); S[i] = __builtin_amdgcn_mfma_f32_16x16x32_bf16(kf, qf[s], S[i], 0, 0, 0); } } }
    float mx = -3.0e38f; const int iq = 16 * w + l15;
#pragma unroll
    for (int i = 0; i < NF; ++i)
#pragma unroll
        for (int r = 0; r < 4; ++r) { if (MODE == 0) { const int kj = 16 * (f0 + i) + 4 * g4 + r; const bool ok = kj >= iq && kj <= iq + 128 && kj >= d.kmin; S[i][r] = ok ? S[i][r] : -3.0e38f; } mx = fmaxf(mx, S[i][r]); }
    mx = fmaxf(mx, __shfl_xor(mx, 16)); mx = fmaxf(mx, __shfl_xor(mx, 32));
    float ls = 0.f;
#pragma unroll
    for (int i = 0; i < NF; ++i)
#pragma unroll
        for (int r = 0; r < 4; ++r) { const float p = fast_exp2(S[i][r] - mx); S[i][r] = p; ls += p; }
    ls += __shfl_xor(ls, 16); ls += __shfl_xor(ls, 32);
    mx_out = mx; ls_out = ls;
}
template <int MODE> __device__ __forceinline__ void attn_pv(const Frame& F, const AttnDesc& d, const f32x4 (&S)[MODE == 0 ? 9 : 16], float mx, float ls) {
    const LAS unsigned char* ldsV = F.lds + RING_OFF + 65536;
    const int lane = F.lane, w = F.wave, l15 = lane & 15, g4 = lane >> 4;
    constexpr int NF = MODE == 0 ? 9 : 16, NP = (NF + 1) / 2;
    const int f0 = MODE == 0 ? w : 0; const bool half = MODE == 0 && d.kmin != 0;
    f32x4 O[8];
#pragma unroll
    for (int df = 0; df < 8; ++df) O[df] = (f32x4){0.f, 0.f, 0.f, 0.f};
    const int q4 = l15 >> 2, p4 = lane & 3;
#pragma unroll
    for (int pr = 0; pr < NP; ++pr) {
        int fa = f0 + 2 * pr, fb = fa + 1; if (fb > 15) fb = 15;
        if (half && fb < 8) continue;
        if (half && fa < 8) fa = 8;
        const f32x4 pa = S[2 * pr], pb = (2 * pr + 1 < NF) ? S[(2 * pr + 1 < NF) ? 2 * pr + 1 : 0] : (f32x4){0.f, 0.f, 0.f, 0.f};
        v4u pw; pw.x = cvt_pk_bf16(pa.x, pa.y); pw.y = cvt_pk_bf16(pa.z, pa.w); pw.z = cvt_pk_bf16(pb.x, pb.y); pw.w = cvt_pk_bf16(pb.z, pb.w);
        const bf16x8 pf = __builtin_bit_cast(bf16x8, pw);
        const int ra = 16 * fa + 4 * g4 + q4, rb = 16 * fb + 4 * g4 + q4;
#pragma unroll
        for (int df = 0; df < 8; ++df) {
            const s16x4 t1 = vtr(ldsV + voff(ra, 2 * df + (p4 >> 1)) + 8 * (p4 & 1)), t2 = vtr(ldsV + voff(rb, 2 * df + (p4 >> 1)) + 8 * (p4 & 1));
            const bf16x8 vf = {t1[0], t1[1], t1[2], t1[3], t2[0], t2[1], t2[2], t2[3]};
            O[df] = __builtin_amdgcn_mfma_f32_16x16x32_bf16(vf, pf, O[df], 0, 0, 0);
        }
    }
    const float inv = 1.0f / ls;
    const long qrow = d.orow0 + (long)(16 * w + l15) * d.ostride;
    bf16* op = d.Op + qrow * d.opitch + 4 * g4;
#pragma unroll
    for (int df = 0; df < 8; ++df) { const f32x4 o = O[df] * inv; v2u wv; wv.x = cvt_pk_bf16(o.x, o.y); wv.y = cvt_pk_bf16(o.z, o.w); *(v2u*)(op + 16 * df) = wv; }
    if (MODE == 0 && g4 == 0) d.lsep[qrow * 12] = (mx + fast_log2(ls)) * LN2;
}
__device__ __forceinline__ void glds16(const void* gsrc, unsigned lds_dst) { unsigned keep;
    asm volatile("s_mov_b32 %0, m0\n\ts_mov_b32 m0, %2\n\ts_nop 0\n\tglobal_load_lds_dwordx4 %1, off\n\ts_mov_b32 m0, %0" : "=&s"(keep) : "v"(gsrc), "s"(lds_dst) : "memory"); }
__device__ __forceinline__ void attn_dma(const Frame& F, const AttnDesc& d, const bool isV) {
    const bf16* P = isV ? d.Vp : d.Kp;
    const unsigned base = (unsigned)__builtin_amdgcn_readfirstlane((int)(unsigned)(size_t)(F.lds + RING_OFF) + (isV ? 65536 : 0) + F.wave * 8192);
    if (d.kmin != 0 && F.wave < 4) return;
    const int slot = F.lane & 15, rsub = F.lane >> 4;
#pragma unroll
    for (int i = 0; i < 8; ++i) { const int row = 32 * F.wave + 4 * i + rsub, ch = isV ? (slot ^ ((row & 7) << 1)) : (slot ^ (row & 15));
        const bf16* gp = P + (d.krow0 + (long)row * d.kstride) * d.kpitch + ch * 8;
        glds16(gp, base + i * 1024); }
}
__device__ __forceinline__ void attn_loadq(const Frame& F, const AttnDesc& d, bf16x8 (&qf)[4]) {
    const long qrow = d.qrow0 + (long)(16 * F.wave + (F.lane & 15)) * d.qstride;
#pragma unroll
    for (int s = 0; s < 4; ++s) qf[s] = *(const bf16x8*)(d.Qp + qrow * d.qpitch + 32 * s + 8 * (F.lane >> 4));
}
#define ATT_BAR() do { asm volatile("s_waitcnt lgkmcnt(0)" ::: "memory"); __builtin_amdgcn_s_barrier(); asm volatile("" ::: "memory"); } while (0)
template <int MODE, int NU> __device__ __forceinline__ void attn_batch(const Frame& F, int id0) {
    AttnDesc d = attn_desc<MODE>(F, id0);
    bf16x8 qn[4], qc[4];
    attn_dma(F, d, false); attn_loadq(F, d, qn);
#pragma unroll
    for (int s = 0; s < 4; ++s) qc[s] = qn[s];
    attn_dma(F, d, true);
#pragma unroll 1
    for (int u = 0; u < NU; ++u) {
        asm volatile("s_waitcnt vmcnt(8)" ::: "memory"); ATT_BAR();
        f32x4 S[MODE == 0 ? 9 : 16]; float mx, ls;
        attn_scores<MODE>(F, d, qc, S, mx, ls);
        asm volatile("s_waitcnt vmcnt(0)" ::: "memory"); ATT_BAR();
        const bool more = u + 1 < NU;
        const AttnDesc dn = attn_desc<MODE>(F, id0 + (more ? u + 1 : u));
        if (more) { attn_dma(F, dn, false); if (MODE == 0) attn_loadq(F, dn, qn); }
        attn_pv<MODE>(F, d, S, mx, ls);
        ATT_BAR();
        if (more) {
            if (MODE != 0) attn_loadq(F, dn, qn);
#pragma unroll
            for (int s = 0; s < 4; ++s) qc[s] = qn[s];
            asm volatile("" : "+v"(qc[0]), "+v"(qc[1]), "+v"(qc[2]), "+v"(qc[3]));
            attn_dma(F, dn, true); }
        d = dn;
    }
    asm volatile("s_waitcnt vmcnt(0)" ::: "memory");
}
__device__ __forceinline__ void p4_sample_attn(const Frame& F, int wt, const float* c0, const float* c1, const float* c2, const float* cm) {
    unsigned char* ws = F.ws; const int lane = F.lane, sub = lane & 15, t = lane >> 4;
    const int db = wt >> 4, h = (wt >> 2) & 3, src = wt & 3;
    const int row = MP + db * 4 + t;
    const bf16* qp = src < 3 ? (const bf16*)(ws + WS_QS) + (size_t)row * 1536 + src * 512 + h * 128 + 8 * sub : (const bf16*)(ws + WS_MQ) + (size_t)row * 512 + h * 128 + 8 * sub;
    float q[8]; { const v4u qw = *(const v4u*)qp; q[0] = bflo(qw.x); q[1] = bfhi(qw.x); q[2] = bflo(qw.y); q[3] = bfhi(qw.y); q[4] = bflo(qw.z); q[5] = bfhi(qw.z); q[6] = bflo(qw.w); q[7] = bfhi(qw.w); }
    float mx = -3.0e38f, ls = 0.f, o[8];
#pragma unroll
    for (int j = 0; j < 8; ++j) o[j] = 0.f;
#define SA_STEP(K0, K1, V0, V1) do { float s_ = (q[0] * K0.x + q[1] * K0.y) + (q[2] * K0.z + q[3] * K0.w) + (q[4] * K1.x + q[5] * K1.y) + (q[6] * K1.z + q[7] * K1.w); \
        s_ += __shfl_xor(s_, 1); s_ += __shfl_xor(s_, 2); s_ += __shfl_xor(s_, 4); s_ += __shfl_xor(s_, 8); \
        const float mn_ = fmaxf(mx, s_), sc_ = fast_exp2(mx - mn_), p_ = fast_exp2(s_ - mn_); mx = mn_; ls = ls * sc_ + p_; \
        o[0] = o[0] * sc_ + p_ * V0.x; o[1] = o[1] * sc_ + p_ * V0.y; o[2] = o[2] * sc_ + p_ * V0.z; o[3] = o[3] * sc_ + p_ * V0.w; \
        o[4] = o[4] * sc_ + p_ * V1.x; o[5] = o[5] * sc_ + p_ * V1.y; o[6] = o[6] * sc_ + p_ * V1.z; o[7] = o[7] * sc_ + p_ * V1.w; } while (0)
    int nstart = 0, NK; const float* cache; int L = 256, dil = 1;
    if (src == 3) { cache = cm; NK = 256; }
    else { cache = src == 0 ? c0 : (src == 1 ? c1 : c2); L = 128 << (2 * src); dil = src == 0 ? 1 : (src == 1 ? 4 : 16); NK = 129; nstart = 4;
        for (int n = 0; n < 4; ++n) {
            const int idx = L + t - dil * n; f32x4 k0, k1, v0, v1;
            if (idx >= L) { const size_t ro = (size_t)(MP + db * 4 + (idx - L)) * 1536 + src * 512 + h * 128 + 8 * sub;
                const v4u kw = *(const v4u*)((const bf16*)(ws + WS_KS) + ro), vw = *(const v4u*)((const bf16*)(ws + WS_VS) + ro);
                k0 = (f32x4){bflo(kw.x), bfhi(kw.x), bflo(kw.y), bfhi(kw.y)}; k1 = (f32x4){bflo(kw.z), bfhi(kw.z), bflo(kw.w), bfhi(kw.w)};
                v0 = (f32x4){bflo(vw.x), bfhi(vw.x), bflo(vw.y), bfhi(vw.y)}; v1 = (f32x4){bflo(vw.z), bfhi(vw.z), bflo(vw.w), bfhi(vw.w)};
            } else { const float* kp = cache + (((size_t)db * L + idx) * 2) * 512 + h * 128 + 8 * sub;
                k0 = *(const f32x4*)kp; k1 = *(const f32x4*)(kp + 4); v0 = *(const f32x4*)(kp + 512); v1 = *(const f32x4*)(kp + 516); }
            SA_STEP(k0, k1, v0, v1);
        }
    }
    const float* kbase = cache + ((size_t)db * L * 2) * 512 + h * 128 + 8 * sub;
    const long kstep = src == 3 ? 1024 : -(long)dil * 1024; const long kfirst = src == 3 ? 0 : (long)(L + t) * 1024;
    int n = nstart;
    for (; n + 4 <= NK; n += 4) {
        f32x4 kk[4][2], vv[4][2];
#pragma unroll
        for (int j = 0; j < 4; ++j) { const float* kp = kbase + kfirst + (long)(n + j) * kstep; kk[j][0] = *(const f32x4*)kp; kk[j][1] = *(const f32x4*)(kp + 4); vv[j][0] = *(const f32x4*)(kp + 512); vv[j][1] = *(const f32x4*)(kp + 516); }
#pragma unroll
        for (int j = 0; j < 4; ++j) SA_STEP(kk[j][0], kk[j][1], vv[j][0], vv[j][1]);
    }
    for (; n < NK; ++n) { const float* kp = kbase + kfirst + (long)n * kstep; const f32x4 k0 = *(const f32x4*)kp, k1 = *(const f32x4*)(kp + 4), v0 = *(const f32x4*)(kp + 512), v1 = *(const f32x4*)(kp + 516); SA_STEP(k0, k1, v0, v1); }
#undef SA_STEP
    const float inv = 1.0f / ls;
    v4u w; w.x = cvt_pk_bf16(o[0] * inv, o[1] * inv); w.y = cvt_pk_bf16(o[2] * inv, o[3] * inv); w.z = cvt_pk_bf16(o[4] * inv, o[5] * inv); w.w = cvt_pk_bf16(o[6] * inv, o[7] * inv);
    if (src < 3) { *(v4u*)((bf16*)(ws + WS_OG) + (size_t)row * 1536 + src * 512 + h * 128 + 8 * sub) = w; if (sub == 0) ((float*)(ws + WS_LSE))[(size_t)row * 12 + src * 4 + h] = (mx + fast_log2(ls)) * LN2; }
    else *(v4u*)((bf16*)(ws + WS_OALL) + (size_t)row * 1536 + 1024 + h * 128 + 8 * sub) = w;
}
__device__ __forceinline__ void p4_sample_attn_shared(const Frame& F, int db, int h, const bool is_mem, const float* cache) {
    unsigned char* ws = F.ws; const int lane = F.lane, sub = lane & 15, gk = lane >> 4; const int rowq0 = MP + db * 4;
    float qv[4][8];
#pragma unroll
    for (int t = 0; t < 4; ++t) { const bf16* qp = is_mem ? (const bf16*)(ws + WS_MQ) + (size_t)(rowq0 + t) * 512 + h * 128 + 8 * sub : (const bf16*)(ws + WS_QS) + (size_t)(rowq0 + t) * 1536 + h * 128 + 8 * sub;
        const v4u qw = *(const v4u*)qp; qv[t][0] = bflo(qw.x); qv[t][1] = bfhi(qw.x); qv[t][2] = bflo(qw.y); qv[t][3] = bfhi(qw.y); qv[t][4] = bflo(qw.z); qv[t][5] = bfhi(qw.z); qv[t][6] = bflo(qw.w); qv[t][7] = bfhi(qw.w); }
    float m[4], l[4], o[4][8];
#pragma unroll
    for (int t = 0; t < 4; ++t) { m[t] = -3.0e38f; l[t] = 0.f;
#pragma unroll
        for (int j = 0; j < 8; ++j) o[t][j] = 0.f; }
#define SS_STEP(P, K0, K1, V0, V1) do { _Pragma("unroll") for (int t = 0; t < 4; ++t) { \
        float s_ = (qv[t][0] * K0.x + qv[t][1] * K0.y) + (qv[t][2] * K0.z + qv[t][3] * K0.w) + (qv[t][4] * K1.x + qv[t][5] * K1.y) + (qv[t][6] * K1.z + qv[t][7] * K1.w); \
        s_ += __shfl_xor(s_, 1); s_ += __shfl_xor(s_, 2); s_ += __shfl_xor(s_, 4); s_ += __shfl_xor(s_, 8); \
        const bool ok_ = is_mem || ((P) >= t && (P) <= 128 + t); \
        const float mn_ = ok_ ? fmaxf(m[t], s_) : m[t], sc_ = fast_exp2(m[t] - mn_), p_ = ok_ ? fast_exp2(s_ - mn_) : 0.f; m[t] = mn_; l[t] = l[t] * sc_ + p_; \
        o[t][0] = o[t][0] * sc_ + p_ * V0.x; o[t][1] = o[t][1] * sc_ + p_ * V0.y; o[t][2] = o[t][2] * sc_ + p_ * V0.z; o[t][3] = o[t][3] * sc_ + p_ * V0.w; \
        o[t][4] = o[t][4] * sc_ + p_ * V1.x; o[t][5] = o[t][5] * sc_ + p_ * V1.y; o[t][6] = o[t][6] * sc_ + p_ * V1.z; o[t][7] = o[t][7] * sc_ + p_ * V1.w; } } while (0)
    const int L = is_mem ? 256 : 128;
    const float* kbase = cache + ((size_t)db * L * 2) * 512 + h * 128 + 8 * sub + (size_t)gk * 1024;
    for (int j = 0; j < L / 4; j += 4) {
        f32x4 kk[4][2], vv[4][2];
#pragma unroll
        for (int e = 0; e < 4; ++e) { const float* kp = kbase + (size_t)(j + e) * 4096; kk[e][0] = *(const f32x4*)kp; kk[e][1] = *(const f32x4*)(kp + 4); vv[e][0] = *(const f32x4*)(kp + 512); vv[e][1] = *(const f32x4*)(kp + 516); }
#pragma unroll
        for (int e = 0; e < 4; ++e) SS_STEP(4 * (j + e) + gk, kk[e][0], kk[e][1], vv[e][0], vv[e][1]);
    }
    if (!is_mem) {
        const size_t ro = (size_t)(rowq0 + gk) * 1536 + h * 128 + 8 * sub;
        const v4u kw = *(const v4u*)((const bf16*)(ws + WS_KS) + ro), vw = *(const v4u*)((const bf16*)(ws + WS_VS) + ro);
        const f32x4 k0 = {bflo(kw.x), bfhi(kw.x), bflo(kw.y), bfhi(kw.y)}, k1 = {bflo(kw.z), bfhi(kw.z), bflo(kw.w), bfhi(kw.w)};
        const f32x4 v0 = {bflo(vw.x), bfhi(vw.x), bflo(vw.y), bfhi(vw.y)}, v1 = {bflo(vw.z), bfhi(vw.z), bflo(vw.w), bfhi(vw.w)};
        SS_STEP(128 + gk, k0, k1, v0, v1);
    }
#undef SS_STEP
    float mo = 0.f, lo = 1.f, oo[8];
#pragma unroll
    for (int j = 0; j < 8; ++j) oo[j] = 0.f;
#pragma unroll
    for (int t = 0; t < 4; ++t) {
        float mm = fmaxf(m[t], __shfl_xor(m[t], 16)); mm = fmaxf(mm, __shfl_xor(mm, 32));
        const float f = fast_exp2(m[t] - mm); float lt = l[t] * f; lt += __shfl_xor(lt, 16); lt += __shfl_xor(lt, 32);
        if (gk == t) { mo = mm; lo = lt; }
#pragma unroll
        for (int j = 0; j < 8; ++j) { float x = o[t][j] * f; x += __shfl_xor(x, 16); x += __shfl_xor(x, 32); if (gk == t) oo[j] = x; }
    }
    const float inv = 1.0f / lo; const int row = rowq0 + gk;
    v4u w; w.x = cvt_pk_bf16(oo[0] * inv, oo[1] * inv); w.y = cvt_pk_bf16(oo[2] * inv, oo[3] * inv); w.z = cvt_pk_bf16(oo[4] * inv, oo[5] * inv); w.w = cvt_pk_bf16(oo[6] * inv, oo[7] * inv);
    if (is_mem) *(v4u*)((bf16*)(ws + WS_OALL) + (size_t)row * 1536 + 1024 + h * 128 + 8 * sub) = w;
    else { *(v4u*)((bf16*)(ws + WS_OG) + (size_t)row * 1536 + h * 128 + 8 * sub) = w; if (sub == 0) ((float*)(ws + WS_LSE))[(size_t)row * 12 + h] = (mo + fast_log2(lo)) * LN2; }
}
__device__ __forceinline__ void p4_sample_task(const Frame& F, int it, const float* c0, const float* c1, const float* c2, const float* cm) {
    const int kind = it >> 9, idx = it & 511, db = idx >> 2, h = idx & 3;
    if (kind == 0) p4_sample_attn(F, db * 16 + h * 4 + 2, c0, c1, c2, cm);
    else if (kind == 1) p4_sample_attn(F, db * 16 + h * 4 + 1, c0, c1, c2, cm);
    else if (kind == 2) p4_sample_attn_shared(F, db, h, true, cm);
    else p4_sample_attn_shared(F, db, h, false, c0);
}
__device__ __forceinline__ void p4_sample_loop(const Frame& F, const float* c0, const float* c1, const float* c2, const float* cm, int q = 0) {
    gu32* qw = (gu32*)(F.ws + WS_CTL) + 64 + 64 * q;
    for (;;) { unsigned v = 0; if (F.lane == 0) v = __hip_atomic_fetch_add(qw, 1u, RLX_AGENT); const int it = (int)__builtin_amdgcn_readfirstlane(v);
        if (it >= 2048) break; p4_sample_task(F, it, c0, c1, c2, cm); }
}
__device__ __forceinline__ void p4_gla_chain(const Frame& F, int row0, int T, int h, const float* S0, float* Sout) {
    unsigned char* ws = F.ws; const int tid = F.tid, v = tid & 127, ks = __builtin_amdgcn_readfirstlane(tid >> 7);
    const float* GA = (const float*)(ws + WS_GA); const bf16* GQ = (const bf16*)(ws + WS_GQ); const bf16* GK = (const bf16*)(ws + WS_GK); const bf16* GV = (const bf16*)(ws + WS_GV); bf16* GO = (bf16*)(ws + WS_GO);
    LAS float* part = (LAS float*)(F.lds + RING_OFF);
    float S[16];
#pragma unroll
    for (int i = 0; i < 16; ++i) S[i] = S0 ? S0[(size_t)(16 * ks + i) * 128 + v] : 0.f;
    for (int t0 = 0; t0 < T; t0 += 16) {
        const int nb = (T - t0) < 16 ? (T - t0) : 16;
        __syncthreads();
        for (int tt = 0; tt < nb; ++tt) {
            const size_t row = (size_t)(row0 + t0 + tt);
            const float* ap = GA + row * 256 + h * 64 + 16 * ks; const v4u kw0 = *(const v4u*)(GK + row * 256 + h * 64 + 16 * ks), kw1 = *(const v4u*)(GK + row * 256 + h * 64 + 16 * ks + 8);
            const v4u qw0 = *(const v4u*)(GQ + row * 256 + h * 64 + 16 * ks), qw1 = *(const v4u*)(GQ + row * 256 + h * 64 + 16 * ks + 8);
            const float vv = bf2f(GV[row * 512 + h * 128 + v]);
            const f32x4 a0 = *(const f32x4*)ap, a1 = *(const f32x4*)(ap + 4), a2 = *(const f32x4*)(ap + 8), a3 = *(const f32x4*)(ap + 12);
            const float la[16] = {a0.x, a0.y, a0.z, a0.w, a1.x, a1.y, a1.z, a1.w, a2.x, a2.y, a2.z, a2.w, a3.x, a3.y, a3.z, a3.w};
            const float kk[16] = {bflo(kw0.x), bfhi(kw0.x), bflo(kw0.y), bfhi(kw0.y), bflo(kw0.z), bfhi(kw0.z), bflo(kw0.w), bfhi(kw0.w), bflo(kw1.x), bfhi(kw1.x), bflo(kw1.y), bfhi(kw1.y), bflo(kw1.z), bfhi(kw1.z), bflo(kw1.w), bfhi(kw1.w)};
            const float qq[16] = {bflo(qw0.x), bfhi(qw0.x), bflo(qw0.y), bfhi(qw0.y), bflo(qw0.z), bfhi(qw0.z), bflo(qw0.w), bfhi(qw0.w), bflo(qw1.x), bfhi(qw1.x), bflo(qw1.y), bfhi(qw1.y), bflo(qw1.z), bfhi(qw1.z), bflo(qw1.w), bfhi(qw1.w)};
            float o = 0.f;
#pragma unroll
            for (int i = 0; i < 16; ++i) { S[i] = fast_exp2(la[i] * 1.4426950408889634f) * S[i] + kk[i] * vv; o += qq[i] * S[i]; }
            part[(tt * 4 + ks) * 128 + v] = o;
        }
        __syncthreads();
        for (int e = tid; e < nb * 128; e += 512) { const int tt = e >> 7, vv_ = e & 127;
            GO[(size_t)(row0 + t0 + tt) * 512 + h * 128 + vv_] = (bf16)f2bf((part[(tt * 4 + 0) * 128 + vv_] + part[(tt * 4 + 1) * 128 + vv_]) + (part[(tt * 4 + 2) * 128 + vv_] + part[(tt * 4 + 3) * 128 + vv_])); }
    }
#pragma unroll
    for (int i = 0; i < 16; ++i) Sout[(size_t)(16 * ks + i) * 128 + v] = S[i];
}
constexpr int GL_QE = 0, GL_KE = 8192, GL_KDT = 16384, GL_VV = 24576, GL_EB = 40960, GL_TOT = 41216, GL_SET = 43264;
__device__ __forceinline__ int goff(int r, int c) { return 128 * r + 16 * (c ^ ((r >> 1) & 7)); }
__device__ __forceinline__ int gvoff(int row, int ch) { return 256 * row + 16 * (ch ^ (((row & 3) | ((((row >> 2) ^ (row >> 3)) & 1) << 2)) << 1)); }
__device__ __forceinline__ void p4_gla_chain_mfma(const Frame& F, int c) {
    unsigned char* ws = F.ws; const int tid = F.tid, lane = F.lane, w = F.wave, l15 = lane & 15, g4 = lane >> 4, q4 = l15 >> 2, p4 = lane & 3;
    const int b = c >> 2, h = c & 3; const size_t row0 = (size_t)b * SEQ;
    const float* GA = (const float*)(ws + WS_GA) + h * 64 + lane; const bf16* GQ = (const bf16*)(ws + WS_GQ) + h * 64 + lane; const bf16* GK = (const bf16*)(ws + WS_GK) + h * 64 + lane;
    const bf16* GV = (const bf16*)(ws + WS_GV) + h * 128 + (tid & 15) * 8; bf16* GO = (bf16*)(ws + WS_GO) + h * 128 + 16 * w + 4 * g4;
    constexpr float L2E = 1.4426950408889634f;
    f32x4 S[4];
#pragma unroll
    for (int K = 0; K < 4; ++K) S[K] = (f32x4){0.f, 0.f, 0.f, 0.f};
    float la[8]; unsigned short qh[8], kh[8]; v4u vr[2];
#define GLA_LOAD(ch) do { const size_t r_ = row0 + 64 * (size_t)(ch); \
        _Pragma("unroll") for (int t = 0; t < 8; ++t) { const size_t rr_ = (r_ + 8 * w + t) * 256; la[t] = GA[rr_]; qh[t] = GQ[rr_]; kh[t] = GK[rr_]; } \
        _Pragma("unroll") for (int e = 0; e < 2; ++e) vr[e] = *(const v4u*)(GV + (r_ + (tid >> 4) + 32 * e) * 512); } while (0)
    GLA_LOAD(0);
#pragma unroll 1
    for (int ch = 0; ch < SEQ / 64; ++ch) {
        LAS unsigned char* B = F.lds + RING_OFF + (ch & 1) * GL_SET;
        LAS float* TOT = (LAS float*)(B + GL_TOT); LAS float* EB = (LAS float*)(B + GL_EB);
        float cs[8], qv[8], kvv[8];
        cs[0] = la[0];
#pragma unroll
        for (int t = 1; t < 8; ++t) cs[t] = cs[t - 1] + la[t];
#pragma unroll
        for (int t = 0; t < 8; ++t) { qv[t] = bf2f(qh[t]); kvv[t] = bf2f(kh[t]); }
        TOT[w * 64 + lane] = cs[7];
#pragma unroll
        for (int e = 0; e < 2; ++e) *(LAS v4u*)(B + GL_VV + gvoff((tid >> 4) + 32 * e, tid & 15)) = vr[e];
        __syncthreads();
        float offs = 0.f, total = 0.f;
#pragma unroll
        for (int g = 0; g < 8; ++g) { const float tg = TOT[g * 64 + lane]; total += tg; offs += (g < w) ? tg : 0.f; }
        unsigned kd[8];
#pragma unroll
        for (int t = 0; t < 8; ++t) { const float bt = offs + cs[t]; const int i = 8 * w + t;
            const float e1 = fast_exp2(bt * L2E), e2 = fast_exp2(-bt * L2E), e3 = fast_exp2((total - bt) * L2E);
            *(LAS unsigned short*)(B + GL_QE + goff(i, lane >> 3) + 2 * (lane & 7)) = (unsigned short)f2bf(qv[t] * e1);
            *(LAS unsigned short*)(B + GL_KE + goff(i, lane >> 3) + 2 * (lane & 7)) = (unsigned short)f2bf(kvv[t] * e2);
            kd[t] = f2bf(kvv[t] * e3); }
        { v4u kw; kw.x = kd[0] | (kd[1] << 16); kw.y = kd[2] | (kd[3] << 16); kw.z = kd[4] | (kd[5] << 16); kw.w = kd[6] | (kd[7] << 16); *(LAS v4u*)(B + GL_KDT + goff(lane, w)) = kw; }
        if (w == 0) EB[lane] = fast_exp2(total * L2E);
        if (ch + 1 < SEQ / 64) GLA_LOAD(ch + 1);
        __syncthreads();
        const LAS unsigned char* QE = B + GL_QE; const LAS unsigned char* KE = B + GL_KE; const LAS unsigned char* KDT = B + GL_KDT; const LAS unsigned char* VV = B + GL_VV;
        bf16x8 kef[4][2];
#pragma unroll
        for (int J = 0; J < 4; ++J)
#pragma unroll
            for (int s = 0; s < 2; ++s) kef[J][s] = *(const LAS bf16x8*)(KE + goff(16 * J + l15, 4 * s + g4));
        bf16x8 vpr[2], vnat[2];
#pragma unroll
        for (int pp = 0; pp < 2; ++pp) { const int ra = 32 * pp + 4 * g4 + q4, rb = ra + 16;
            const s16x4 t1 = vtr(VV + gvoff(ra, 2 * w + (p4 >> 1)) + 8 * (p4 & 1)), t2 = vtr(VV + gvoff(rb, 2 * w + (p4 >> 1)) + 8 * (p4 & 1));
            vpr[pp] = (bf16x8){t1[0], t1[1], t1[2], t1[3], t2[0], t2[1], t2[2], t2[3]}; }
#pragma unroll
        for (int s = 0; s < 2; ++s) { const int r1 = 32 * s + 8 * g4 + q4, r2 = r1 + 4;
            const s16x4 t1 = vtr(VV + gvoff(r1, 2 * w + (p4 >> 1)) + 8 * (p4 & 1)), t2 = vtr(VV + gvoff(r2, 2 * w + (p4 >> 1)) + 8 * (p4 & 1));
            vnat[s] = (bf16x8){t1[0], t1[1], t1[2], t1[3], t2[0], t2[1], t2[2], t2[3]}; }
        bf16x8 sfr[2];
#pragma unroll
        for (int p = 0; p < 2; ++p) { v4u sw; sw.x = cvt_pk_bf16(S[2 * p].x, S[2 * p].y); sw.y = cvt_pk_bf16(S[2 * p].z, S[2 * p].w); sw.z = cvt_pk_bf16(S[2 * p + 1].x, S[2 * p + 1].y); sw.w = cvt_pk_bf16(S[2 * p + 1].z, S[2 * p + 1].w); sfr[p] = __builtin_bit_cast(bf16x8, sw); }
#pragma unroll
        for (int I = 0; I < 4; ++I) {
            f32x4 oT = (f32x4){0.f, 0.f, 0.f, 0.f};
#pragma unroll
            for (int p = 0; p < 2; ++p) {
                const v2u lo = *(const LAS v2u*)(QE + goff(16 * I + l15, 4 * p + (g4 >> 1)) + 8 * (g4 & 1)), hi = *(const LAS v2u*)(QE + goff(16 * I + l15, 4 * p + 2 + (g4 >> 1)) + 8 * (g4 & 1));
                const v4u bw = {lo.x, lo.y, hi.x, hi.y};
                oT = __builtin_amdgcn_mfma_f32_16x16x32_bf16(sfr[p], __builtin_bit_cast(bf16x8, bw), oT, 0, 0, 0); }
            bf16x8 qef[2];
#pragma unroll
            for (int s = 0; s < 2; ++s) qef[s] = *(const LAS bf16x8*)(QE + goff(16 * I + l15, 4 * s + g4));
            f32x4 d1[4];
#pragma unroll
            for (int J = 0; J < 4; ++J) { d1[J] = (f32x4){0.f, 0.f, 0.f, 0.f};
                if (J <= I) {
#pragma unroll
                    for (int s = 0; s < 2; ++s) d1[J] = __builtin_amdgcn_mfma_f32_16x16x32_bf16(kef[J][s], qef[s], d1[J], 0, 0, 0);
                    if (J == I) {
#pragma unroll
                        for (int r = 0; r < 4; ++r) d1[J][r] = (4 * g4 + r <= l15) ? d1[J][r] : 0.f; } } }
#pragma unroll
            for (int pp = 0; pp < 2; ++pp) if (2 * pp <= I) {
                const f32x4 pa = d1[2 * pp], pb = d1[2 * pp + 1];
                v4u pw; pw.x = cvt_pk_bf16(pa.x, pa.y); pw.y = cvt_pk_bf16(pa.z, pa.w); pw.z = cvt_pk_bf16(pb.x, pb.y); pw.w = cvt_pk_bf16(pb.z, pb.w);
                oT = __builtin_amdgcn_mfma_f32_16x16x32_bf16(vpr[pp], __builtin_bit_cast(bf16x8, pw), oT, 0, 0, 0); }
            { v2u ow; ow.x = cvt_pk_bf16(oT.x, oT.y); ow.y = cvt_pk_bf16(oT.z, oT.w); *(v2u*)(GO + (row0 + 64 * (size_t)ch + 16 * I + l15) * 512) = ow; }
        }
#pragma unroll
        for (int K = 0; K < 4; ++K) {
            const f32x4 ebv = *(const LAS f32x4*)(EB + 16 * K + 4 * g4); S[K] *= ebv;
#pragma unroll
            for (int s = 0; s < 2; ++s) { const bf16x8 kdf = *(const LAS bf16x8*)(KDT + goff(16 * K + l15, 4 * s + g4)); S[K] = __builtin_amdgcn_mfma_f32_16x16x32_bf16(kdf, vnat[s], S[K], 0, 0, 0); } }
    }
#undef GLA_LOAD
    float* so = F.out + O_GLAP + (size_t)c * 64 * 128 + 16 * w + l15;
#pragma unroll
    for (int K = 0; K < 4; ++K)
#pragma unroll
        for (int r = 0; r < 4; ++r) so[(size_t)(16 * K + 4 * g4 + r) * 128] = S[K][r];
}
template <int NR> __device__ __forceinline__ void p5_combine_rows(const Frame& F, int row0, int rstride) {
    unsigned char* ws = F.ws; const int lane = F.lane, hh = lane >> 4, sub = lane & 15, col = hh * 128 + 8 * sub;
    float l0[NR], l1[NR], l2[NR]; v4u a[NR], b[NR], c[NR], gow[NR], gr[NR];
    const float* gg = F.i15 + 8 * sub; const f32x4 g0 = *(const f32x4*)gg, g1 = *(const f32x4*)(gg + 4);
#pragma unroll
    for (int r = 0; r < NR; ++r) { const int row = row0 + r * rstride;
        const float* lse = (const float*)(ws + WS_LSE) + (size_t)row * 12; l0[r] = lse[hh]; l1[r] = lse[4 + hh]; l2[r] = lse[8 + hh];
        const bf16* og = (const bf16*)(ws + WS_OG) + (size_t)row * 1536 + col; a[r] = *(const v4u*)og; b[r] = *(const v4u*)(og + 512); c[r] = *(const v4u*)(og + 1024);
        gow[r] = *(const v4u*)((const bf16*)(ws + WS_GO) + (size_t)row * 512 + col); gr[r] = *(const v4u*)((const bf16*)(ws + WS_GRS) + (size_t)row * 512 + col); }
#pragma unroll
    for (int r = 0; r < NR; ++r) { const int row = row0 + r * rstride;
        const float mx = fmaxf(l0[r], fmaxf(l1[r], l2[r]));
        float w0 = __expf(l0[r] - mx), w1 = __expf(l1[r] - mx), w2 = __expf(l2[r] - mx); const float wi = 1.0f / (w0 + w1 + w2); w0 *= wi; w1 *= wi; w2 *= wi;
        v4u o;
        o.x = cvt_pk_bf16(w0 * bflo(a[r].x) + w1 * bflo(b[r].x) + w2 * bflo(c[r].x), w0 * bfhi(a[r].x) + w1 * bfhi(b[r].x) + w2 * bfhi(c[r].x));
        o.y = cvt_pk_bf16(w0 * bflo(a[r].y) + w1 * bflo(b[r].y) + w2 * bflo(c[r].y), w0 * bfhi(a[r].y) + w1 * bfhi(b[r].y) + w2 * bfhi(c[r].y));
        o.z = cvt_pk_bf16(w0 * bflo(a[r].z) + w1 * bflo(b[r].z) + w2 * bflo(c[r].z), w0 * bfhi(a[r].z) + w1 * bfhi(b[r].z) + w2 * bfhi(c[r].z));
        o.w = cvt_pk_bf16(w0 * bflo(a[r].w) + w1 * bflo(b[r].w) + w2 * bflo(c[r].w), w0 * bfhi(a[r].w) + w1 * bfhi(b[r].w) + w2 * bfhi(c[r].w));
        bf16* oall = (bf16*)(ws + WS_OALL) + (size_t)row * 1536;
        *(v4u*)(oall + col) = o;
        const f32x4 x0 = {bflo(gow[r].x), bfhi(gow[r].x), bflo(gow[r].y), bfhi(gow[r].y)}, x1 = {bflo(gow[r].z), bfhi(gow[r].z), bflo(gow[r].w), bfhi(gow[r].w)};
        float ss = (x0.x * x0.x + x0.y * x0.y) + (x0.z * x0.z + x0.w * x0.w) + (x1.x * x1.x + x1.y * x1.y) + (x1.z * x1.z + x1.w * x1.w);
        ss += __shfl_xor(ss, 1); ss += __shfl_xor(ss, 2); ss += __shfl_xor(ss, 4); ss += __shfl_xor(ss, 8);
        const float rstd = 1.0f / sqrtf(ss * (1.f / 128.f) + EPS);
        v4u y;
        y.x = cvt_pk_bf16(x0.x * rstd * g0.x * bflo(gr[r].x), x0.y * rstd * g0.y * bfhi(gr[r].x)); y.y = cvt_pk_bf16(x0.z * rstd * g0.z * bflo(gr[r].y), x0.w * rstd * g0.w * bfhi(gr[r].y));
        y.z = cvt_pk_bf16(x1.x * rstd * g1.x * bflo(gr[r].z), x1.y * rstd * g1.y * bfhi(gr[r].z)); y.w = cvt_pk_bf16(x1.z * rstd * g1.z * bflo(gr[r].w), x1.w * rstd * g1.w * bfhi(gr[r].w));
        *(v4u*)(oall + 512 + col) = y; }
}
template <int NR> __device__ __forceinline__ void p10_final_rows(const Frame& F, int row0, int rstride) {
    const GAS f32x4* gr = (const GAS f32x4*)F.i24 + 2 * F.lane; const f32x4 g00 = gr[0], g01 = gr[1], g10 = gr[128], g11 = gr[129];
    v4u v[NR][2];
#pragma unroll
    for (int r = 0; r < NR; ++r) { const GAS v4u* xr = (const GAS v4u*)((const bf16*)(F.ws + WS_Y16) + (size_t)(row0 + r * rstride) * D) + F.lane; v[r][0] = xr[0]; v[r][1] = xr[64]; }
#pragma unroll
    for (int r = 0; r < NR; ++r) { float x[2][8]; float s = 0.f;
#pragma unroll
        for (int j = 0; j < 2; ++j) { x[j][0] = bflo(v[r][j].x); x[j][1] = bfhi(v[r][j].x); x[j][2] = bflo(v[r][j].y); x[j][3] = bfhi(v[r][j].y); x[j][4] = bflo(v[r][j].z); x[j][5] = bfhi(v[r][j].z); x[j][6] = bflo(v[r][j].w); x[j][7] = bfhi(v[r][j].w);
#pragma unroll
            for (int e = 0; e < 8; ++e) s += x[j][e] * x[j][e]; }
        const float rstd = 1.0f / sqrtf(wave_sum(s) * (1.f / D) + EPS);
        GAS f32x4* yr = (GAS f32x4*)(F.out + (size_t)(row0 + r * rstride) * D) + 2 * F.lane;
        yr[0] = (f32x4){x[0][0] * rstd * g00.x, x[0][1] * rstd * g00.y, x[0][2] * rstd * g00.z, x[0][3] * rstd * g00.w};
        yr[1] = (f32x4){x[0][4] * rstd * g01.x, x[0][5] * rstd * g01.y, x[0][6] * rstd * g01.z, x[0][7] * rstd * g01.w};
        yr[128] = (f32x4){x[1][0] * rstd * g10.x, x[1][1] * rstd * g10.y, x[1][2] * rstd * g10.z, x[1][3] * rstd * g10.w};
        yr[129] = (f32x4){x[1][4] * rstd * g11.x, x[1][5] * rstd * g11.y, x[1][6] * rstd * g11.z, x[1][7] * rstd * g11.w}; }
}
__device__ __forceinline__ void phase1(Frame& F) {
    unsigned char* ws = F.ws; const int G = F.G, bx = (int)blockIdx.x;
    { pg8::Gemm g{(const bf16*)(ws + WS_XB), (const bf16*)(ws + WS_W1A), MR, 2 * FF, D, D, D}; typedef pg8::StaticOrderT<MR / 256, 2 * FF / 256> SO; SO S; S.init(MR, 2 * FF, G, bx);
      EpiSwiglu E{(bf16*)(ws + WS_G), nullptr}; pg8::gemm_phase<EpiSwiglu, SO>(F.lds + RING_OFF, g, S, E, F.wave, MK_STAGGER_A); }
    { pg8::Gemm g{(const bf16*)(ws + WS_MEMB), (const bf16*)(ws + WS_WMEM), MM, D, D, D, D}; typedef pg8::StaticOrderT<MM / 256, D / 256> SO; SO S; S.init(MM, D, G, (bx + G / 2) % G);
      EpiMemKV E{F.out + O_MEMKV, (bf16*)(ws + WS_MKV)}; pg8::gemm_phase<EpiMemKV, SO>(F.lds + RING_OFF, g, S, E, F.wave); }
}
__device__ __forceinline__ void phase2(Frame& F) {
    unsigned char* ws = F.ws; const int G = F.G, bx = (int)blockIdx.x;
    pg8::Gemm g{(const bf16*)(ws + WS_G), (const bf16*)(ws + WS_W1O), MR, D, FF, 64, FF};   typedef pg8::StaticOrderT<MR / 256, D / 256> SO; SO S; S.init(MR, D, G, bx);
    EpiResidX<true> E{F.i0, F.i1, (bf16*)(ws + WS_HB), (float*)(ws + WS_PQ1), 0.5f};
    S.lim = 1024; S.rev = 1; pg8::gemm_phase<EpiResidX<true>, SO, true, true>(F.lds + RING_OFF, g, S, E, F.wave);
    tail_phase<EpiResidX<true>, true>(F, g.A, 64, g.Bt, FF, FF, E, 0);
}
__device__ __forceinline__ void phase3(Frame& F) {
    unsigned char* ws = F.ws; const int G = F.G, bx = (int)blockIdx.x;
    pg8::Gemm g{(const bf16*)(ws + WS_HB), (const bf16*)(ws + WS_WIN), MR, NZ, D, D, D}; typedef pg8::StaticOrderT<MR / 256, NZ / 256> SO; SO S; S.init(MR, NZ, G, bx);
    EpiZ E{(const float*)(ws + WS_PQ1), (const float*)(ws + WS_ROPE), (const float*)(ws + WS_ROPE) + NPOS * 64, F.i14, F.out,
           (bf16*)(ws + WS_QS), (bf16*)(ws + WS_KS), (bf16*)(ws + WS_VS), (bf16*)(ws + WS_GQ), (bf16*)(ws + WS_GK), (bf16*)(ws + WS_GV), (bf16*)(ws + WS_GRS), (bf16*)(ws + WS_MQ), (bf16*)(ws + WS_GATE), (float*)(ws + WS_GA)};
    pg8::gemm_phase<EpiZ, SO>(F.lds + RING_OFF, g, S, E, F.wave, MK_STAGGER_Z);
}
constexpr int CW_Q = 64;
__device__ __forceinline__ int q_pull(const Frame& F, int q) {
    gu32* qw = (gu32*)(F.ws + WS_CTL) + CW_Q + 64 * q;
    volatile LAS unsigned* slot = (volatile LAS unsigned*)(F.lds + MISC_OFF) + 16;
    __syncthreads();
    if (F.tid == 0) *slot = __hip_atomic_fetch_add(qw, 1u, RLX_AGENT);
    __syncthreads();
    return (int)*slot;
}
__device__ __forceinline__ void phase4(Frame& F, const float* c0, const float* c1, const float* c2, const float* cm) {
    const int bx = (int)blockIdx.x;
    if (bx < NB * 4) p4_gla_chain_mfma(F, bx);
    else p4_sample_loop(F, c0, c1, c2, cm);
#pragma unroll 1
    for (int rep = 0; rep < (MK_P4_REPEAT == 2 ? 2 : 1); ++rep) for (;;) { const int it = q_pull(F, 1 + 4 * rep); if (it >= 768) break; attn_batch<0, 8>(F, 8 * (767 - it)); }
#pragma unroll 1
    for (int rep = 0; rep < (MK_P4_REPEAT == 3 ? 2 : 1); ++rep) for (;;) { const int it = q_pull(F, 2 + 4 * rep); if (it >= 256) break; attn_batch<1, 8>(F, 6144 + 8 * (255 - it)); }
    p4_sample_loop(F, c0, c1, c2, cm);
    if (MK_P4_REPEAT == 1) { __syncthreads(); p4_sample_loop(F, c0, c1, c2, cm, 4); }
    if (MK_P4_REPEAT == 4) { __syncthreads(); if (bx < NB * 4) p4_gla_chain_mfma(F, bx); }
    if (MK_P4_REPEAT == 5) { for (;;) { const int c = q_pull(F, 7); if (c >= DECB * 4) break; p4_gla_chain(F, MP + (c >> 2) * DECT, DECT, c & 3, F.i7 + (size_t)c * 64 * 128, F.out + O_GLAS + (size_t)c * 64 * 128); } }
    for (;;) { const int c = q_pull(F, 3); if (c >= DECB * 4) break; p4_gla_chain(F, MP + (c >> 2) * DECT, DECT, c & 3, F.i7 + (size_t)c * 64 * 128, F.out + O_GLAS + (size_t)c * 64 * 128); }
    if (F.G < NB * 4) { for (int c = F.G + bx; c < NB * 4; c += F.G) p4_gla_chain_mfma(F, c); }
}
__device__ __forceinline__ void phase5(Frame& F) {
    { const int st = F.G * NWAVES; int m = F.vcu * NWAVES + F.wave;
      for (; m + 3 * st < MR; m += 4 * st) p5_combine_rows<4>(F, m, st);
      for (; m < MR; m += st) p5_combine_rows<1>(F, m, st); }
}
__device__ __forceinline__ void phase6(Frame& F) {
    unsigned char* ws = F.ws; const int G = F.G, bx = (int)blockIdx.x;
    pg8::Gemm g{(const bf16*)(ws + WS_OALL), (const bf16*)(ws + WS_WBR), MR, D, 1536, 1536, 1536}; typedef pg8::StaticOrderT<MR / 256, D / 256> SO; SO S; S.init(MR, D, G, bx);
    S.lim = 1024; S.rev = 1; EpiMerge1 E{(const bf16*)(ws + WS_GATE), (bf16*)(ws + WS_MB)}; pg8::gemm_phase<EpiMerge1, SO>(F.lds + RING_OFF, g, S, E, F.wave);
    tail_phase_merge(F, g.A, g.Bt, E, 3);
}
__device__ __forceinline__ void phase7(Frame& F) {
    unsigned char* ws = F.ws; const int G = F.G, bx = (int)blockIdx.x;
    pg8::Gemm g{(const bf16*)(ws + WS_MB), (const bf16*)(ws + WS_WOUT), MR, D, D, D, D}; typedef pg8::StaticOrderT<MR / 256, D / 256> SO; SO S; S.init(MR, D, G, bx);
    EpiResidB<true> E{(const bf16*)(ws + WS_HB), (bf16*)(ws + WS_HB), (float*)(ws + WS_PQ2), 1.0f};
    S.lim = 1024; pg8::gemm_phase<EpiResidB<true>, SO>(F.lds + RING_OFF, g, S, E, F.wave);
    tail_phase<EpiResidB<true>>(F, g.A, D, g.Bt, D, D, E, 1);
}
__device__ __forceinline__ void phase8(Frame& F) {
    unsigned char* ws = F.ws; const int G = F.G, bx = (int)blockIdx.x;
    pg8::Gemm g{(const bf16*)(ws + WS_HB), (const bf16*)(ws + WS_W2A), MR, 2 * FF, D, D, D}; typedef pg8::StaticOrderT<MR / 256, 2 * FF / 256> SO; SO S; S.init(MR, 2 * FF, G, bx);
    EpiSwiglu E{(bf16*)(ws + WS_G), (const float*)(ws + WS_PQ2)}; pg8::gemm_phase<EpiSwiglu, SO>(F.lds + RING_OFF, g, S, E, F.wave, MK_STAGGER_A);
}
__device__ __forceinline__ void phase9(Frame& F) {
    unsigned char* ws = F.ws; const int G = F.G, bx = (int)blockIdx.x;
    pg8::Gemm g{(const bf16*)(ws + WS_G), (const bf16*)(ws + WS_W2O), MR, D, FF, 64, FF};   typedef pg8::StaticOrderT<MR / 256, D / 256> SO; SO S; S.init(MR, D, G, bx);
    EpiResidB<false> E{(const bf16*)(ws + WS_HB), (bf16*)(ws + WS_Y16), nullptr, 0.5f};
    S.lim = 1024; S.rev = 1; pg8::gemm_phase<EpiResidB<false>, SO, true, true>(F.lds + RING_OFF, g, S, E, F.wave);
    tail_phase<EpiResidB<false>, true>(F, g.A, 64, g.Bt, FF, FF, E, 2);
}
__device__ __forceinline__ void phase10(Frame& F) {
    { const int st = F.G * NWAVES; int m = F.vcu * NWAVES + F.wave;
      for (; m + 3 * st < MR; m += 4 * st) p10_final_rows<4>(F, m, st);
      for (; m < MR; m += st) p10_final_rows<1>(F, m, st); }
}
__device__ __forceinline__ void xcd_barrier_or_skip(const XcdBarrier& b, bool on, int wave) { if (on) xcd_barrier(b, wave); }
constexpr int N_PHASES = 11;
__global__ void __launch_bounds__(NWAVES * 64, 2) mk_fwd(Args args) {
    extern __shared__ __attribute__((aligned(16))) unsigned char lds[];
    Frame F;
    F.lds = (LAS unsigned char*)lds;
    F.wave = __builtin_amdgcn_readfirstlane((int)(threadIdx.x >> 6)); F.lane = lane_id(); F.tid = F.wave * 64 + F.lane;
    F.G = gridDim.x; { const int bx = blockIdx.x; F.vcu = (F.G % 8 == 0) ? (bx % 8) * (F.G / 8) + bx / 8 : bx; }
    F.i0 = args.in[0]; F.i1 = args.in[1]; F.i2 = args.in[2]; F.i3 = args.in[3]; F.i4 = args.in[4]; F.i5 = args.in[5]; F.i6 = args.in[6]; F.i7 = args.in[7]; F.i8 = args.in[8]; F.i9 = args.in[9]; F.i10 = args.in[10]; F.i11 = args.in[11]; F.i12 = args.in[12]; F.i13 = args.in[13]; F.i14 = args.in[14]; F.i15 = args.in[15]; F.i16 = args.in[16]; F.i17 = args.in[17]; F.i18 = args.in[18]; F.i19 = args.in[19]; F.i20 = args.in[20]; F.i21 = args.in[21]; F.i22 = args.in[22]; F.i23 = args.in[23]; F.i24 = args.in[24];
    F.out = args.out; F.ws = args.ws;
    unsigned char* ws = args.ws; gu32* ctl = (gu32*)(ws + WS_CTL);
    volatile LAS unsigned* MISC = (volatile LAS unsigned*)(F.lds + MISC_OFF);
    for (int u = F.tid; u < (LDS_BYTES - LDSCTL_OFF) / 4; u += NWAVES * 64) ((LAS unsigned*)(F.lds + LDSCTL_OFF))[u] = 0u;
    __syncthreads();
    XcdBarrier bar; bar.bar = (unsigned*)(ctl + CW_BAR); bar.x = 0; bar.st = nullptr;
    if (MK_N_LAUNCHES == 1) bar = xcd_barrier_post((unsigned*)(ctl + CW_BAR), MISC + 8, F.wave);
    const int lo = args.ph_lo, hi = args.ph_hi;
#define IN(k) (lo <= (k) && (k) < hi && (k) <= MK_STOP_AFTER)
#define GRID_BAR(k) do { if (IN((k) + 1)) xcd_barrier(bar, F.wave); } while (0)

#define RUN(k, call) do { if (IN(k)) { F.lane = lane_id(); F.tid = F.wave * 64 + F.lane; call; if (MK_REPEAT_PHASE == (k)) { xcd_barrier_or_skip(bar, MK_N_LAUNCHES == 1, F.wave); call; } GRID_BAR(k); } } while (0)
    RUN(0, p0_prologue(F));
    RUN(1, phase1(F));
    RUN(2, phase2(F));
    RUN(3, phase3(F));
    RUN(4, phase4(F, args.in[3], args.in[4], args.in[5], args.in[6]));
    RUN(5, phase5(F));
    RUN(6, phase6(F));
    RUN(7, phase7(F));
    RUN(8, phase8(F));
    RUN(9, phase9(F));
    if (IN(10)) { F.lane = lane_id(); F.tid = F.wave * 64 + F.lane; phase10(F); }
#undef RUN
#if MK_STOP_AFTER < 10
    if (hi == N_PHASES) {
        for (int m = F.vcu * NWAVES + F.wave; m < MR; m += G * NWAVES) {
            for (int c = F.lane; c < D; c += 64) {
                float v;
                if (MK_STOP_AFTER == 0) v = bf2f(((const bf16*)(ws + WS_WIN))[(size_t)(m % NZ) * D + c]);
                else if (MK_STOP_AFTER == 3) { const bf16* gt = (const bf16*)(ws + WS_GATE) + (size_t)m * 3072; v = bf2f(gt[c]) + bf2f(gt[1024 + c]) + bf2f(gt[2048 + c]); }
                else if (MK_STOP_AFTER <= 5) { const bf16* oa = (const bf16*)(ws + WS_OALL) + (size_t)m * 1536; v = bf2f(oa[c]) + bf2f(oa[1024 + (c & 511)]); }
                else if (MK_STOP_AFTER == 6) v = bf2f(((const bf16*)(ws + WS_MB))[(size_t)m * D + c]);
                else if (MK_STOP_AFTER == 7) v = ((const float*)(ws + WS_H))[(size_t)m * D + c];
                else v = bf2f(((const bf16*)(ws + WS_G))[(size_t)m * FF + c]) + bf2f(((const bf16*)(ws + WS_G))[(size_t)m * FF + 1792 + c]);
                F.out[(size_t)m * D + c] = v;
            }
        }
    }
#endif
#undef IN
#undef GRID_BAR
}

extern "C" void kernel_launch(void* const* d_in, const int* in_sizes, int n_in, void* d_out, int out_size, void* d_ws, size_t ws_size, hipStream_t stream) {
    static int grid = 0;
    if (grid == 0) {
        if (n_in != 25 || (size_t)out_size != O_END || ws_size < WS_END2) { fprintf(stderr, "kernel_launch: unexpected shapes: n_in %d out %d ws %zu (need %zu); nothing launched\n", n_in, out_size, ws_size, (size_t)WS_END2); grid = -1; return; }
        int dev = 0, cus = 0, per_cu = 0;
        if (hipGetDevice(&dev) != hipSuccess || hipDeviceGetAttribute(&cus, hipDeviceAttributeMultiprocessorCount, dev) != hipSuccess) { grid = -1; return; }
        if (hipFuncSetAttribute((const void*)mk_fwd, hipFuncAttributeMaxDynamicSharedMemorySize, LDS_BYTES) != hipSuccess) { fprintf(stderr, "kernel_launch: hipFuncSetAttribute failed\n"); grid = -1; return; }
        if (hipOccupancyMaxActiveBlocksPerMultiprocessor(&per_cu, (const void*)mk_fwd, NWAVES * 64, LDS_BYTES) != hipSuccess || per_cu < 1) fprintf(stderr, "kernel_launch: occupancy query reports %d\n", per_cu);
        (void)hipGetLastError();
        grid = cus;
    }
    if (grid < 0) return;
    if (hipMemsetAsync((char*)d_ws + WS_CTL, 0, CTL_ZERO_BYTES, stream) != hipSuccess) return;
    Args a{};
    for (int i = 0; i < 25; ++i) a.in[i] = (const float*)d_in[i];
    a.out = (float*)d_out; a.ws = (unsigned char*)d_ws; a.pad = 0;
    for (int li = 0; li < MK_N_LAUNCHES; ++li) {
        a.ph_lo = (MK_N_LAUNCHES == 1) ? 0 : li; a.ph_hi = (MK_N_LAUNCHES == 1) ? N_PHASES : li + 1; a.li = li;
        hipLaunchKernelGGL(mk_fwd, dim3(grid), dim3(NWAVES * 64), LDS_BYTES, stream, a);
        const hipError_t le = hipPeekAtLastError();
        if (le != hipSuccess) { fprintf(stderr, "kernel_launch: launch %d failed: %s\n", li, hipGetErrorName(le)); break; }
    }
}
```

```cpp
#include <hip/hip_runtime.h>
#include <cstdio>
#include <cstdint>

#ifndef MK_N_LAUNCHES
#define MK_N_LAUNCHES 1
#endif

#ifndef MK_REPEAT_PHASE
#define MK_REPEAT_PHASE -1
#endif
#ifndef MK_P4_REPEAT
#define MK_P4_REPEAT 0
#endif
#ifndef MK_STAGGER_A
#ifndef MK_WGM_N
#define MK_WGM_N 2
#endif
#ifndef MK_WGM_A
#define MK_WGM_A 4
#endif
#ifndef MK_WGM_Z
#define MK_WGM_Z 2
#endif
#define MK_STAGGER_A 0
#endif
#ifndef MK_STAGGER_Z
#define MK_STAGGER_Z 0
#endif
#ifndef MK_STOP_AFTER
#define MK_STOP_AFTER 10
#endif
#define GAS __attribute__((address_space(1)))
#define LAS __attribute__((address_space(3)))
typedef unsigned short bf16;
typedef unsigned v4u __attribute__((ext_vector_type(4)));
typedef unsigned v2u __attribute__((ext_vector_type(2)));
typedef float f32x4 __attribute__((ext_vector_type(4)));
typedef float f32x2 __attribute__((ext_vector_type(2)));
typedef short bf16x8 __attribute__((ext_vector_type(8)));
typedef short s16x4 __attribute__((ext_vector_type(4)));
typedef GAS unsigned gu32;

__device__ __forceinline__ int lane_id() { return (int)__builtin_amdgcn_mbcnt_hi(~0u, __builtin_amdgcn_mbcnt_lo(~0u, 0u)); }
constexpr int D = 1024, NB = 32, SEQ = 2048, DECB = 128, DECT = 4, PAST = 8192, MEML = 256;
constexpr int MP = NB * SEQ;
constexpr int MS = DECB * DECT;
constexpr int MR = MP + MS;
constexpr int MM = NB * MEML;
constexpr int FF = 2816, NZ = 9984;
constexpr int DIN = 6672;
constexpr int NPOS = SEQ + DECT;
constexpr float EPS = 1e-6f;
constexpr float QSCALE = 0.08838834764831845f * 1.4426950408889634f;
constexpr float LN2 = 0.6931471805599453f;

constexpr size_t O_Y = 0, O_YS = (size_t)MP * D, O_SWA0P = O_YS + (size_t)MS * D, O_SWA1P = O_SWA0P + (size_t)NB * 128 * 1024, O_SWA2P = O_SWA1P + (size_t)NB * 512 * 1024,
                 O_MEMKV = O_SWA2P + (size_t)NB * 2048 * 1024, O_GLAP = O_MEMKV + (size_t)MM * 1024, O_SWA0S = O_GLAP + (size_t)NB * 4 * 64 * 128, O_SWA1S = O_SWA0S + (size_t)MS * 1024,
                 O_SWA2S = O_SWA1S + (size_t)MS * 1024, O_GLAS = O_SWA2S + (size_t)MS * 1024, O_END = O_GLAS + (size_t)DECB * 4 * 64 * 128;
static_assert(O_END == 170917888ull, "output size");

constexpr size_t MiB = 1u << 20;
constexpr size_t al(size_t x) { return (x + 2 * MiB - 1) / (2 * MiB) * (2 * MiB); }
constexpr size_t WS_CTL = 0, CTL_ZERO_BYTES = 1 * MiB;
constexpr size_t WS_ROPE = 2 * MiB;
constexpr size_t WS_PQ1 = WS_ROPE + al((size_t)NPOS * 64 * 4 * 2);
constexpr size_t WS_PQ2 = WS_PQ1 + al((size_t)MR * 16 * 4);
constexpr size_t WS_W1A = WS_PQ2 + al((size_t)MR * 16 * 4);
constexpr size_t WS_W1O = WS_W1A + al((size_t)2 * FF * D * 2);
constexpr size_t WS_WIN = WS_W1O + al((size_t)D * FF * 2);
constexpr size_t WS_WBR = WS_WIN + al((size_t)NZ * D * 2);
constexpr size_t WS_WOUT = WS_WBR + al((size_t)3 * D * 512 * 2);
constexpr size_t WS_W2A = WS_WOUT + al((size_t)D * D * 2);
constexpr size_t WS_W2O = WS_W2A + al((size_t)2 * FF * D * 2);
constexpr size_t WS_WMEM = WS_W2O + al((size_t)D * FF * 2);
constexpr size_t WS_XB = WS_WMEM + al((size_t)D * D * 2);
constexpr size_t WS_MEMB = WS_XB + al((size_t)MR * D * 2);
constexpr size_t WS_MKV = WS_MEMB + al((size_t)MM * D * 2);
constexpr size_t WS_G = WS_MKV + al((size_t)MM * D * 2);
constexpr size_t WS_H = WS_G + al((size_t)MR * FF * 2);
constexpr size_t WS_HB = WS_H + al((size_t)MR * D * 4);
constexpr size_t WS_QS = WS_HB + al((size_t)MR * D * 2);
constexpr size_t WS_KS = WS_QS + al((size_t)MR * 1536 * 2);
constexpr size_t WS_VS = WS_KS + al((size_t)MR * 1536 * 2);
constexpr size_t WS_GQ = WS_VS + al((size_t)MR * 1536 * 2);
constexpr size_t WS_GK = WS_GQ + al((size_t)MR * 256 * 2);
constexpr size_t WS_GV = WS_GK + al((size_t)MR * 256 * 2);
constexpr size_t WS_GRS = WS_GV + al((size_t)MR * 512 * 2);
constexpr size_t WS_GA = WS_GRS + al((size_t)MR * 512 * 2);
constexpr size_t WS_MQ = WS_GA + al((size_t)MR * 256 * 4);
constexpr size_t WS_GATE = WS_MQ + al((size_t)MR * 512 * 2);
constexpr size_t WS_OG = WS_GATE + al((size_t)MR * 3072 * 2);
constexpr size_t WS_LSE = WS_OG + al((size_t)MR * 1536 * 2);
constexpr size_t WS_GO = WS_LSE + al((size_t)MR * 12 * 4);
constexpr size_t WS_OALL = WS_GO + al((size_t)MR * 512 * 4);
constexpr size_t WS_END = WS_OALL + al((size_t)MR * 1536 * 2);
constexpr size_t WS_SLAB = WS_END; constexpr size_t WS_END2 = WS_SLAB + al((size_t)8 * 4 * 4 * 8 * 2048 * 4);
constexpr size_t WS_T = WS_G, WS_MB = WS_XB, WS_Y16 = WS_XB;
static_assert((size_t)MR * D * 4 <= (size_t)MR * FF * 2, "T fits in G");

constexpr int CW_TMO = 0, CW_CODE = 1, CW_BAR = 4096, CW_TAIL = 8192;

constexpr int RING_OFF = 0, RING_BYTES = 131072;
constexpr int LDSCTL_OFF = RING_BYTES, MISC_OFF = LDSCTL_OFF + 320;
constexpr int LDS_BYTES = 147456;
constexpr int NWAVES = 8;

#define RLX_AGENT __ATOMIC_RELAXED, __HIP_MEMORY_SCOPE_AGENT
#define LDS_WAIT() asm volatile("s_waitcnt lgkmcnt(0)" ::: "memory")
#define VM_WAIT() asm volatile("s_waitcnt vmcnt(0)" ::: "memory")
__device__ __forceinline__ unsigned f2bf(float f) { unsigned u = __builtin_bit_cast(unsigned, f); return (u + 0x7fffu + ((u >> 16) & 1u)) >> 16; }
__device__ __forceinline__ unsigned pk2(float lo, float hi) { return f2bf(lo) | (f2bf(hi) << 16); }
__device__ __forceinline__ float bf2f(unsigned b) { return __builtin_bit_cast(float, b << 16); }
__device__ __forceinline__ float bflo(unsigned w) { return __builtin_bit_cast(float, w << 16); }
__device__ __forceinline__ float bfhi(unsigned w) { return __builtin_bit_cast(float, w & 0xffff0000u); }
typedef __bf16 bf16x2_t __attribute__((ext_vector_type(2)));
__device__ __forceinline__ unsigned cvt_pk_bf16(float lo, float hi) { const f32x2 v = {lo, hi}; const bf16x2_t b = __builtin_convertvector(v, bf16x2_t); return __builtin_bit_cast(unsigned, b); }
__device__ __forceinline__ float fast_exp2(float x) { return __builtin_amdgcn_exp2f(x); }
__device__ __forceinline__ float fast_rcp(float x) { return __builtin_amdgcn_rcpf(x); }
__device__ __forceinline__ float fast_log2(float x) { return __builtin_amdgcn_logf(x); }
__device__ __forceinline__ float sigmoidf_(float x) { return fast_rcp(1.0f + fast_exp2(-1.4426950408889634f * x)); }
__device__ __forceinline__ float siluf_(float x) { return x * sigmoidf_(x); }
__device__ __forceinline__ int perm32(int rho) { return 8 * ((rho >> 2) & 3) + 4 * (rho >> 4) + (rho & 3); }
__device__ __forceinline__ int sig_plain(int r) { return (r & ~31) + perm32(r & 31); }
__device__ __forceinline__ int sig_rope(int r7) { return 64 * ((r7 >> 4) & 1) + 16 * (r7 >> 5) + 4 * ((r7 >> 2) & 3) + (r7 & 3); }

namespace pg8 {
constexpr int BM = 256, BK = 64, HALF = 128, HTB = HALF * BK * 2, STAGE_BYTES = 8 * HTB, NXCD = 8, WGM = 2;
__host__ __device__ __forceinline__ int lds_byte(int r, int c) { const int st = (r >> 4) * 2 + (c >> 5), rr = r & 15, cc = c & 31, ob = rr * 64 + cc * 2; return st * 1024 + (ob ^ (((ob >> 9) & 1) << 5)); }
__host__ __device__ __forceinline__ void stage_rc(int b, int& R, int& C) { const int st = b / 1024, sb = b % 1024, swz = sb ^ (((sb >> 9) & 1) << 5); R = (st >> 1) * 16 + swz / 64; C = (st & 1) * 32 + (swz % 64) / 2; }
struct Unit { int pm, pn; };
struct Gemm { const bf16* A; const bf16* Bt; int M, N, K, lda, ldb; };
constexpr size_t TILED_KS = (size_t)256 * 64 * 2, TILED_PANEL = (size_t)(2816 / 64) * TILED_KS;
template <int NM, int NN> struct StaticOrderT {
    static constexpr int WGM = NN == 4 ? MK_WGM_N : (NN == 22 ? MK_WGM_A : MK_WGM_Z);
    int G, c, lim, rev;
    __host__ __device__ void init(int, int, int G_, int c_) { G = G_; c = c_; lim = NM * NN; rev = 0; }
    __host__ __device__ static __forceinline__ void unit_of(int L, Unit& u) {
        constexpr int nwg = NM * NN, q = nwg / NXCD, r = nwg % NXCD, nig = WGM * NN;
        const int xcd = L & (NXCD - 1), off = L >> 3;
        const int wgid = (xcd < r ? xcd * (q + 1) : r * (q + 1) + (xcd - r) * q) + off;
        const int gid = wgid / nig, x = wgid - gid * nig, fm = gid * WGM;
        if (NM % WGM == 0 || fm + WGM <= NM) { u.pm = fm + (x & (WGM - 1)); u.pn = x / WGM; }
        else { constexpr int gl = (NM % WGM) ? (NM % WGM) : WGM; u.pm = fm + x % gl; u.pn = x / gl; }
    }
    __host__ __device__ __forceinline__ bool next(int i, Unit& u) const { const int L = i * G + c; if (L >= lim) return false; unit_of(rev ? lim - 1 - L : L, u); return true; }
};
struct OneUnit { Unit u; int c; __host__ __device__ __forceinline__ bool next(int i, Unit& o) const { if (i) return false; o = u; return true; } };
template <class Epi, class Sched, bool ALIGN_EPI = true, bool ATILED = false>
__device__ __forceinline__ void gemm_phase(LAS unsigned char* lds, const Gemm g, const Sched& S, const Epi& E, const int wid, const int stagger_ticks = 0) {
    if (stagger_ticks > 0) { const unsigned long long t0 = __builtin_amdgcn_s_memrealtime(); const unsigned long long dl = (unsigned long long)(((S.c * 37) & 255) * stagger_ticks) >> 8;
        while (__builtin_amdgcn_s_memrealtime() - t0 < dl) __builtin_amdgcn_s_sleep(8); }
    const int lane = lane_id(), tid = wid * 64 + lane, wr = wid >> 2, wc = wid & 3, fr = lane & 15, fq = lane >> 4;
    const int K = g.K, nt = K / BK;
    unsigned voffA[2], voffB[2];
#pragma unroll
    for (int i = 0; i < 2; ++i) { int R, C; stage_rc(tid * 16 + i * 8192, R, C); voffA[i] = (unsigned)(R * g.lda + C) * 2u; voffB[i] = (unsigned)(R * g.ldb + C) * 2u; }
    const size_t kstep = (size_t)(BK * 2), kstepA = ATILED ? TILED_KS : kstep;
    const size_t hA = (size_t)HALF * g.lda * 2, tA = ATILED ? TILED_PANEL : 2 * hA, hB = (size_t)HALF * g.ldb * 2, tB = 2 * hB;
    const unsigned ldsw = (unsigned)wid * 1024u;
    const int aoff = lds_byte(wr * 64 + fr, fq * 8), boff = lds_byte(wc * 32 + fr, fq * 8);
#define PG8_SA(b, h) (((b) * 2 + (h)) * HTB)
#define PG8_SB(b, h) ((4 + (b) * 2 + (h)) * HTB)
#define PG8_STAGE(bufoff, gbase, voff) do { _Pragma("unroll") for (int _i = 0; _i < 2; ++_i) \
        __builtin_amdgcn_global_load_lds((const unsigned*)((const char*)(gbase) + (voff)[_i]), (LAS unsigned*)(lds + (bufoff) + ldsw + _i * 8192), 16, 0, 0); } while (0)
#define PG8_LDA(dst, b, h) do { _Pragma("unroll") for (int m = 0; m < 4; ++m) _Pragma("unroll") for (int k = 0; k < 2; ++k) dst[m][k] = *(const LAS bf16x8*)(lds + PG8_SA(b, h) + aoff + m * 2048 + k * 1024); } while (0)
#define PG8_LDB(dst, b, h) do { _Pragma("unroll") for (int n = 0; n < 2; ++n) _Pragma("unroll") for (int k = 0; k < 2; ++k) dst[n][k] = *(const LAS bf16x8*)(lds + PG8_SB(b, h) + boff + n * 2048 + k * 1024); } while (0)
#define PG8_MMA(ai, bj, At, Bt) do { __builtin_amdgcn_s_setprio(1); _Pragma("unroll") for (int m = 0; m < 4; ++m) _Pragma("unroll") for (int n = 0; n < 2; ++n) _Pragma("unroll") for (int k = 0; k < 2; ++k) \
        acc[ai][bj][m][n] = __builtin_amdgcn_mfma_f32_16x16x32_bf16(Bt[n][k], At[m][k], acc[ai][bj][m][n], 0, 0, 0); __builtin_amdgcn_s_setprio(0); } while (0)
#define PG8_WAIT_V(n) asm volatile("s_waitcnt vmcnt(" #n ")" ::: "memory")
#define PG8_WAIT_L(n) asm volatile("s_waitcnt lgkmcnt(" #n ")" ::: "memory")
#define PG8_BAR __builtin_amdgcn_s_barrier()
#define PG8_SCHED __builtin_amdgcn_sched_barrier(0)
    Unit cur, nxt; int ui = 0;
    if (!S.next(0, cur)) return;
    f32x4 acc[2][2][4][2];
#pragma unroll
    for (int a = 0; a < 2; ++a)
#pragma unroll
        for (int b = 0; b < 2; ++b)
#pragma unroll
            for (int m = 0; m < 4; ++m)
#pragma unroll
                for (int n = 0; n < 2; ++n) acc[a][b][m][n] = (f32x4){0.f, 0.f, 0.f, 0.f};
    bf16x8 At[4][2], B0[2][2], B1[2][2];
    const char* cA = (const char*)g.A + (size_t)cur.pm * tA; const char* cB = (const char*)g.Bt + (size_t)cur.pn * tB;
    PG8_STAGE(PG8_SB(0, 0), cB, voffB); PG8_STAGE(PG8_SB(0, 1), cB + hB, voffB); PG8_STAGE(PG8_SA(0, 0), cA, voffA); PG8_STAGE(PG8_SA(0, 1), cA + hA, voffA);
    if (wr == 1) PG8_BAR;
    PG8_WAIT_V(2); PG8_BAR;
    PG8_STAGE(PG8_SB(1, 0), cB + kstep, voffB); PG8_STAGE(PG8_SA(1, 0), cA + kstepA, voffA); PG8_STAGE(PG8_SB(1, 1), cB + hB + kstep, voffB);
    PG8_WAIT_V(6); PG8_BAR;
    for (;;) {
        const bool has_next = S.next(ui + 1, nxt);
        const char* nA = has_next ? (const char*)g.A + (size_t)nxt.pm * tA : cA; const char* nB = has_next ? (const char*)g.Bt + (size_t)nxt.pn * tB : cB;
        const int seg = Epi::HAS_MID ? 8 : nt;
        for (int t0 = 0; t0 < nt; t0 += seg) {
        if constexpr (Epi::HAS_MID) { if (t0) { PG8_SCHED; E.mid(acc, cur, t0, wr, wc, fr, fq); PG8_SCHED; } }
#pragma unroll 1
        for (int t = t0; t < t0 + seg; t += 2) {
            const bool last = (t == nt - 2);
            const char* a1 = cA + (size_t)(t + 1) * kstepA;
            const char* a2 = last ? nA : cA + (size_t)(t + 2) * kstepA; const char* b2 = last ? nB : cB + (size_t)(t + 2) * kstep;
            const char* a3 = a2 + kstepA; const char* b3 = b2 + kstep;
            PG8_LDB(B0, 0, 0); PG8_LDB(B1, 0, 1); PG8_SCHED; PG8_LDA(At, 0, 0); PG8_STAGE(PG8_SA(1, 1), a1 + hA, voffA);
            PG8_WAIT_V(8); PG8_WAIT_L(0); PG8_BAR; PG8_MMA(0, 0, At, B0); PG8_MMA(0, 1, At, B1); PG8_BAR; PG8_SCHED;
            PG8_LDA(At, 0, 1); PG8_STAGE(PG8_SB(0, 0), b2, voffB); PG8_STAGE(PG8_SB(0, 1), b2 + hB, voffB); PG8_STAGE(PG8_SA(0, 0), a2, voffA);
            PG8_WAIT_V(8); PG8_WAIT_L(0); PG8_BAR; PG8_MMA(1, 0, At, B0); PG8_MMA(1, 1, At, B1); PG8_BAR; PG8_SCHED;
            PG8_LDB(B0, 1, 0); PG8_LDB(B1, 1, 1); PG8_SCHED; PG8_LDA(At, 1, 0); PG8_STAGE(PG8_SA(0, 1), a2 + hA, voffA);
            PG8_WAIT_V(8); PG8_WAIT_L(0); PG8_BAR; PG8_MMA(0, 0, At, B0); PG8_MMA(0, 1, At, B1); PG8_BAR; PG8_SCHED;
            PG8_LDA(At, 1, 1); PG8_STAGE(PG8_SB(1, 0), b3, voffB); PG8_STAGE(PG8_SB(1, 1), b3 + hB, voffB); PG8_STAGE(PG8_SA(1, 0), a3, voffA);
            PG8_WAIT_V(8); PG8_WAIT_L(0); PG8_BAR; PG8_MMA(1, 0, At, B0); PG8_MMA(1, 1, At, B1); PG8_BAR; PG8_SCHED;
        }
        }
        if constexpr (ALIGN_EPI) { if (wr == 0) PG8_BAR; }
        E(acc, cur, wr, wc, fr, fq);
        if (!has_next) break;
#pragma unroll
        for (int a = 0; a < 2; ++a)
#pragma unroll
            for (int b = 0; b < 2; ++b)
#pragma unroll
                for (int m = 0; m < 4; ++m)
#pragma unroll
                    for (int n = 0; n < 2; ++n) acc[a][b][m][n] = (f32x4){0.f, 0.f, 0.f, 0.f};
        cur = nxt; cA = nA; cB = nB; ++ui;
        if constexpr (ALIGN_EPI) { if (wr == 1) PG8_BAR; }
    }
    PG8_WAIT_V(0);
    if constexpr (!ALIGN_EPI) { if (wr == 0) PG8_BAR; }
    PG8_BAR;
#undef PG8_SA
#undef PG8_SB
#undef PG8_STAGE
#undef PG8_LDA
#undef PG8_LDB
#undef PG8_MMA
#undef PG8_WAIT_V
#undef PG8_WAIT_L
#undef PG8_BAR
#undef PG8_SCHED
}
}
using pg8::Unit;

typedef const f32x4 (&AccRef)[2][2][4][2];
constexpr size_t G_KT = (size_t)256 * 64, G_PANEL = (FF / 64) * G_KT;
__device__ __forceinline__ size_t g_off(int row, int j) { return (size_t)(row >> 8) * G_PANEL + (size_t)(j >> 6) * G_KT + (size_t)(row & 255) * 64 + (j & 63); }
struct EpiSwiglu {
    static constexpr bool HAS_MID = false;
    bf16* G; const float* pq;
    __device__ __forceinline__ void operator()(AccRef acc, const Unit& u, int wr, int wc, int fr, int fq) const {
        const int row0 = u.pm * 256 + wr * 64 + fr;
        bf16* gb = G + ((size_t)u.pm * (FF / 64) + 2 * u.pn + (wc >> 1)) * G_KT + (size_t)((wr * 64 + fr) * 64 + (wc & 1) * 32 + 8 * fq);
        float sc[2][4];
#pragma unroll
        for (int ai = 0; ai < 2; ++ai)
#pragma unroll
            for (int m = 0; m < 4; ++m) { sc[ai][m] = 1.f;
                if (pq) { const f32x4 pv = *(const f32x4*)(pq + (size_t)(row0 + ai * 128 + m * 16) * 16 + 4 * fq); float t = (pv.x + pv.y) + (pv.z + pv.w); t += __shfl_xor(t, 16); t += __shfl_xor(t, 32); sc[ai][m] = __builtin_amdgcn_rsqf(t * (1.f / D) + EPS); } }
#pragma unroll
        for (int ai = 0; ai < 2; ++ai)
#pragma unroll
            for (int m = 0; m < 4; ++m) {
                const float s = sc[ai][m];
                float o[8];
#pragma unroll
                for (int n = 0; n < 2; ++n)
#pragma unroll
                    for (int i = 0; i < 4; ++i) { const float a = acc[ai][0][m][n][i] * s, b = acc[ai][1][m][n][i] * s; o[4 * n + i] = siluf_(a) * b; }
                v4u w; w.x = cvt_pk_bf16(o[0], o[1]); w.y = cvt_pk_bf16(o[2], o[3]); w.z = cvt_pk_bf16(o[4], o[5]); w.w = cvt_pk_bf16(o[6], o[7]);
                *(v4u*)(gb + (ai * 128 + m * 16) * 64) = w;
            }
    }
};
template <bool WRITE_PQ> struct EpiResidX {
    static constexpr bool HAS_MID = false;
    const float* baseP; const float* baseS; bf16* HB; float* pq; float scale;
    __device__ __forceinline__ void operator()(AccRef acc, const Unit& u, int wr, int wc, int fr, int fq) const {
        const int row0 = u.pm * 256 + wr * 64 + fr, c0 = u.pn * 256 + wc * 32 + 8 * fq; const bool smp = u.pm >= MP / 256;
        const float* bbase = (smp ? baseS : baseP) + (smp ? (size_t)(row0 - MP) * D : (size_t)row0 * D) + c0;
#pragma unroll
        for (int ai = 0; ai < 2; ++ai) {
            f32x4 bb[4][2][2];
#pragma unroll
            for (int m = 0; m < 4; ++m)
#pragma unroll
                for (int bj = 0; bj < 2; ++bj) { const float* bp = bbase + (size_t)(ai * 128 + m * 16) * D + bj * 128; bb[m][bj][0] = *(const f32x4*)bp; bb[m][bj][1] = *(const f32x4*)(bp + 4); }
#pragma unroll
            for (int m = 0; m < 4; ++m) {
                const int row = row0 + ai * 128 + m * 16; float ss = 0.f;
#pragma unroll
                for (int bj = 0; bj < 2; ++bj) {
                    const f32x4 o0 = bb[m][bj][0] + acc[ai][bj][m][0] * scale, o1 = bb[m][bj][1] + acc[ai][bj][m][1] * scale;
                    v4u w; w.x = cvt_pk_bf16(o0.x, o0.y); w.y = cvt_pk_bf16(o0.z, o0.w); w.z = cvt_pk_bf16(o1.x, o1.y); w.w = cvt_pk_bf16(o1.z, o1.w); *(v4u*)(HB + (size_t)row * D + c0 + bj * 128) = w;
                    if (WRITE_PQ) ss += (o0.x * o0.x + o0.y * o0.y) + (o0.z * o0.z + o0.w * o0.w) + (o1.x * o1.x + o1.y * o1.y) + (o1.z * o1.z + o1.w * o1.w);
                }
                if (WRITE_PQ) { ss += __shfl_xor(ss, 16); ss += __shfl_xor(ss, 32); if (fq == 0) pq[(size_t)row * 16 + u.pn * 4 + wc] = ss; }
            }
        }
    }
    template <int O> __device__ __forceinline__ void group(const f32x4 (&v)[8], const Unit& u, int wr, int wc, int fr, int fq) const {
        const int row0 = u.pm * 256 + wr * 64 + fr, c0 = u.pn * 256 + wc * 32 + 8 * fq; const bool smp = u.pm >= MP / 256;
        const float* bbase = (smp ? baseS : baseP) + (smp ? (size_t)(row0 - MP) * D : (size_t)row0 * D) + c0;
        f32x4 bb[2][2][2];
#pragma unroll
        for (int mm = 0; mm < 2; ++mm)
#pragma unroll
            for (int bj = 0; bj < 2; ++bj) { const float* bp = bbase + (size_t)((O >> 1) * 128 + (2 * (O & 1) + mm) * 16) * D + bj * 128; bb[mm][bj][0] = *(const f32x4*)bp; bb[mm][bj][1] = *(const f32x4*)(bp + 4); }
#pragma unroll
        for (int mm = 0; mm < 2; ++mm) { const int row = row0 + (O >> 1) * 128 + (2 * (O & 1) + mm) * 16; float ss = 0.f;
#pragma unroll
            for (int bj = 0; bj < 2; ++bj) {
                const f32x4 o0 = bb[mm][bj][0] + v[bj * 4 + mm * 2] * scale, o1 = bb[mm][bj][1] + v[bj * 4 + mm * 2 + 1] * scale;
                v4u w; w.x = cvt_pk_bf16(o0.x, o0.y); w.y = cvt_pk_bf16(o0.z, o0.w); w.z = cvt_pk_bf16(o1.x, o1.y); w.w = cvt_pk_bf16(o1.z, o1.w); *(v4u*)(HB + (size_t)row * D + c0 + bj * 128) = w;
                if (WRITE_PQ) ss += (o0.x * o0.x + o0.y * o0.y) + (o0.z * o0.z + o0.w * o0.w) + (o1.x * o1.x + o1.y * o1.y) + (o1.z * o1.z + o1.w * o1.w); }
            if (WRITE_PQ) { ss += __shfl_xor(ss, 16); ss += __shfl_xor(ss, 32); if (fq == 0) pq[(size_t)row * 16 + u.pn * 4 + wc] = ss; } }
    }
};
template <bool WRITE_PQ> struct EpiResidB {
    static constexpr bool HAS_MID = false;
    const bf16* base; bf16* out; float* pq; float scale;
    __device__ __forceinline__ void operator()(AccRef acc, const Unit& u, int wr, int wc, int fr, int fq) const {
        const int row0 = u.pm * 256 + wr * 64 + fr, c0 = u.pn * 256 + wc * 32 + 8 * fq;
#pragma unroll
        for (int ai = 0; ai < 2; ++ai) {
            v4u bb[4][2];
#pragma unroll
            for (int m = 0; m < 4; ++m)
#pragma unroll
                for (int bj = 0; bj < 2; ++bj) bb[m][bj] = *(const v4u*)(base + (size_t)(row0 + ai * 128 + m * 16) * D + c0 + bj * 128);
#pragma unroll
            for (int m = 0; m < 4; ++m) {
                const int row = row0 + ai * 128 + m * 16; float ss = 0.f;
#pragma unroll
                for (int bj = 0; bj < 2; ++bj) { const v4u g = bb[m][bj];
                    const f32x4 o0 = (f32x4){bflo(g.x), bfhi(g.x), bflo(g.y), bfhi(g.y)} + acc[ai][bj][m][0] * scale, o1 = (f32x4){bflo(g.z), bfhi(g.z), bflo(g.w), bfhi(g.w)} + acc[ai][bj][m][1] * scale;
                    v4u w; w.x = cvt_pk_bf16(o0.x, o0.y); w.y = cvt_pk_bf16(o0.z, o0.w); w.z = cvt_pk_bf16(o1.x, o1.y); w.w = cvt_pk_bf16(o1.z, o1.w); *(v4u*)(out + (size_t)row * D + c0 + bj * 128) = w;
                    if (WRITE_PQ) ss += (o0.x * o0.x + o0.y * o0.y) + (o0.z * o0.z + o0.w * o0.w) + (o1.x * o1.x + o1.y * o1.y) + (o1.z * o1.z + o1.w * o1.w);
                }
                if (WRITE_PQ) { ss += __shfl_xor(ss, 16); ss += __shfl_xor(ss, 32); if (fq == 0) pq[(size_t)row * 16 + u.pn * 4 + wc] = ss; }
            }
        }
    }
    template <int O> __device__ __forceinline__ void group(const f32x4 (&v)[8], const Unit& u, int wr, int wc, int fr, int fq) const {
        const int row0 = u.pm * 256 + wr * 64 + fr, c0 = u.pn * 256 + wc * 32 + 8 * fq;
        v4u bb[2][2];
#pragma unroll
        for (int mm = 0; mm < 2; ++mm)
#pragma unroll
            for (int bj = 0; bj < 2; ++bj) bb[mm][bj] = *(const v4u*)(base + (size_t)(row0 + (O >> 1) * 128 + (2 * (O & 1) + mm) * 16) * D + c0 + bj * 128);
#pragma unroll
        for (int mm = 0; mm < 2; ++mm) { const int row = row0 + (O >> 1) * 128 + (2 * (O & 1) + mm) * 16; float ss = 0.f;
#pragma unroll
            for (int bj = 0; bj < 2; ++bj) { const v4u g = bb[mm][bj];
                const f32x4 o0 = (f32x4){bflo(g.x), bfhi(g.x), bflo(g.y), bfhi(g.y)} + v[bj * 4 + mm * 2] * scale, o1 = (f32x4){bflo(g.z), bfhi(g.z), bflo(g.w), bfhi(g.w)} + v[bj * 4 + mm * 2 + 1] * scale;
                v4u w; w.x = cvt_pk_bf16(o0.x, o0.y); w.y = cvt_pk_bf16(o0.z, o0.w); w.z = cvt_pk_bf16(o1.x, o1.y); w.w = cvt_pk_bf16(o1.z, o1.w); *(v4u*)(out + (size_t)row * D + c0 + bj * 128) = w;
                if (WRITE_PQ) ss += (o0.x * o0.x + o0.y * o0.y) + (o0.z * o0.z + o0.w * o0.w) + (o1.x * o1.x + o1.y * o1.y) + (o1.z * o1.z + o1.w * o1.w); }
            if (WRITE_PQ) { ss += __shfl_xor(ss, 16); ss += __shfl_xor(ss, 32); if (fq == 0) pq[(size_t)row * 16 + u.pn * 4 + wc] = ss; } }
    }
};
struct EpiMemKV {
    static constexpr bool HAS_MID = false;
    float* out; bf16* MKV;
    __device__ __forceinline__ void operator()(AccRef acc, const Unit& u, int wr, int wc, int fr, int fq) const {
        const int row0 = u.pm * 256 + wr * 64 + fr, c0 = u.pn * 256 + wc * 32 + 8 * fq;
#pragma unroll
        for (int ai = 0; ai < 2; ++ai)
#pragma unroll
            for (int m = 0; m < 4; ++m) {
                const int row = row0 + ai * 128 + m * 16;
#pragma unroll
                for (int bj = 0; bj < 2; ++bj) { const f32x4 o0 = acc[ai][bj][m][0], o1 = acc[ai][bj][m][1]; float* op = out + (size_t)row * D + c0 + bj * 128;
                    *(f32x4*)op = o0; *(f32x4*)(op + 4) = o1;
                    v4u w; w.x = cvt_pk_bf16(o0.x, o0.y); w.y = cvt_pk_bf16(o0.z, o0.w); w.z = cvt_pk_bf16(o1.x, o1.y); w.w = cvt_pk_bf16(o1.z, o1.w); *(v4u*)(MKV + (size_t)row * D + c0 + bj * 128) = w; }
            }
    }
};
struct EpiMerge1 {
    static constexpr bool HAS_MID = true;
    const bf16* GATE; bf16* MB;
    __device__ __forceinline__ void mid(f32x4 (&acc)[2][2][4][2], const Unit& u, int t, int wr, int wc, int fr, int fq) const {
        const unsigned lo = (unsigned)(((wr * 64 + fr) * 3072 + wc * 32 + 8 * fq) * 2);
        const char* ub = (const char*)GATE + ((size_t)u.pm * 256 * 3072 + (size_t)((t >> 3) - 1) * 1024 + (size_t)u.pn * 256) * 2;
#pragma unroll
        for (int ai = 0; ai < 2; ++ai) {
            v4u gn[4][2], gd[4][2];
#pragma unroll
            for (int m = 0; m < 4; ++m)
#pragma unroll
                for (int bj = 0; bj < 2; ++bj) { const char* fb = ub + (size_t)((ai * 128 + m * 16) * 3072 + bj * 128) * 2; gn[m][bj] = *(const v4u*)(fb + lo); gd[m][bj] = *(const v4u*)(fb + 2048 + lo); }
#pragma unroll
            for (int m = 0; m < 4; ++m)
#pragma unroll
                for (int bj = 0; bj < 2; ++bj) { const v4u n_ = gn[m][bj], d_ = gd[m][bj];
                    const f32x4 r0 = {bflo(d_.x) * fast_rcp(bflo(n_.x)), bfhi(d_.x) * fast_rcp(bfhi(n_.x)), bflo(d_.y) * fast_rcp(bflo(n_.y)), bfhi(d_.y) * fast_rcp(bfhi(n_.y))};
                    const f32x4 r1 = {bflo(d_.z) * fast_rcp(bflo(n_.z)), bfhi(d_.z) * fast_rcp(bfhi(n_.z)), bflo(d_.w) * fast_rcp(bflo(n_.w)), bfhi(d_.w) * fast_rcp(bfhi(n_.w))};
                    acc[ai][bj][m][0] *= r0; acc[ai][bj][m][1] *= r1; }
            asm volatile("" ::: "memory");
        }
    }
    __device__ __forceinline__ void operator()(AccRef acc, const Unit& u, int wr, int wc, int fr, int fq) const {
        const int row0 = u.pm * 256 + wr * 64 + fr, c0 = u.pn * 256 + wc * 32 + 8 * fq;
        v4u gw[2][4][2];
#pragma unroll
        for (int ai = 0; ai < 2; ++ai)
#pragma unroll
            for (int m = 0; m < 4; ++m)
#pragma unroll
                for (int bj = 0; bj < 2; ++bj) gw[ai][m][bj] = *(const v4u*)(GATE + (size_t)(row0 + ai * 128 + m * 16) * 3072 + 2048 + c0 + bj * 128);
#pragma unroll
        for (int ai = 0; ai < 2; ++ai)
#pragma unroll
            for (int m = 0; m < 4; ++m) { const int row = row0 + ai * 128 + m * 16;
#pragma unroll
                for (int bj = 0; bj < 2; ++bj) { const v4u g = gw[ai][m][bj];
                    const f32x4 o0 = acc[ai][bj][m][0] * (f32x4){fast_rcp(bflo(g.x)), fast_rcp(bfhi(g.x)), fast_rcp(bflo(g.y)), fast_rcp(bfhi(g.y))}, o1 = acc[ai][bj][m][1] * (f32x4){fast_rcp(bflo(g.z)), fast_rcp(bfhi(g.z)), fast_rcp(bflo(g.w)), fast_rcp(bfhi(g.w))};
                    v4u w; w.x = cvt_pk_bf16(o0.x, o0.y); w.y = cvt_pk_bf16(o0.z, o0.w); w.z = cvt_pk_bf16(o1.x, o1.y); w.w = cvt_pk_bf16(o1.z, o1.w); *(v4u*)(MB + (size_t)row * D + c0 + bj * 128) = w;
                } }
    }
    template <int O> __device__ __forceinline__ void group(const f32x4 (&v)[8], const Unit& u, int wr, int wc, int fr, int fq) const {
        const int row0 = u.pm * 256 + wr * 64 + fr, c0 = u.pn * 256 + wc * 32 + 8 * fq;
#pragma unroll
        for (int mm = 0; mm < 2; ++mm) { const int row = row0 + (O >> 1) * 128 + (2 * (O & 1) + mm) * 16;
#pragma unroll
            for (int bj = 0; bj < 2; ++bj) { const f32x4 o0 = v[bj * 4 + mm * 2], o1 = v[bj * 4 + mm * 2 + 1];
                v4u w; w.x = cvt_pk_bf16(o0.x, o0.y); w.y = cvt_pk_bf16(o0.z, o0.w); w.z = cvt_pk_bf16(o1.x, o1.y); w.w = cvt_pk_bf16(o1.z, o1.w); *(v4u*)(MB + (size_t)row * D + c0 + bj * 128) = w; } }
    }
};
__device__ __forceinline__ size_t qkv_off(int row, int g, int h) {
    if (row >= MP) return (size_t)row * 1536 + g * 512 + h * 128;
    const int b = row >> 11, t = row & 2047, sh = 2 * g, p = ((t & ((1 << sh) - 1)) << (11 - sh)) + (t >> sh);
    return ((size_t)((g * NB + b) * 4 + h) * SEQ + p) * 128;
}
struct EpiZ {
    static constexpr bool HAS_MID = false;
    const float* pq; const float* ropeC; const float* ropeS; const float* bga; float* out;
    bf16 *QS, *KS, *VS, *GQ, *GK, *GV, *GRS, *MQ, *GATE; float* GA;
    template <int ACT> __device__ __forceinline__ void plain(AccRef acc, const float (&rs)[2][4], int row0, bf16* dst, int ld, int col0, float scale) const {
#pragma unroll
        for (int ai = 0; ai < 2; ++ai)
#pragma unroll
            for (int m = 0; m < 4; ++m) { const int row = row0 + ai * 128 + m * 16; const float s = rs[ai][m];
#pragma unroll
                for (int bj = 0; bj < 2; ++bj) { float o[8];
#pragma unroll
                    for (int n = 0; n < 2; ++n)
#pragma unroll
                        for (int i = 0; i < 4; ++i) { const float x = acc[ai][bj][m][n][i] * s; o[4 * n + i] = ACT == 0 ? x * scale : (ACT == 1 ? siluf_(x) : 1.0f + fast_exp2(fminf(-1.4426950408889634f * x, 80.f))); }
                    v4u w; w.x = cvt_pk_bf16(o[0], o[1]); w.y = cvt_pk_bf16(o[2], o[3]); w.z = cvt_pk_bf16(o[4], o[5]); w.w = cvt_pk_bf16(o[6], o[7]);
                    *(v4u*)(dst + (size_t)row * ld + col0 + bj * 128) = w; } }
    }
    __device__ __forceinline__ float* swa_dst(int row, int g, int kv, int h) const {
        if (row >= MP) return out + (g == 0 ? O_SWA0S : (g == 1 ? O_SWA1S : O_SWA2S)) + ((size_t)(row - MP) * 2 + kv) * 512 + h * 128;
        const int b = row >> 11, t = row & 2047, keep = 128 << (2 * g), t0 = SEQ - keep;
        if (t < t0) return nullptr;
        return out + (g == 0 ? O_SWA0P : (g == 1 ? O_SWA1P : O_SWA2P)) + (((size_t)b * keep + (t - t0)) * 2 + kv) * 512 + h * 128;
    }
    __device__ __forceinline__ void operator()(AccRef acc, const Unit& u, int wr, int wc, int fr, int fq) const {
        const int row0 = u.pm * 256 + wr * 64 + fr, pn = u.pn, cl = wc * 32 + 8 * fq;
        float rs[2][4];
#pragma unroll
        for (int ai = 0; ai < 2; ++ai)
#pragma unroll
            for (int m = 0; m < 4; ++m) { const int row = row0 + ai * 128 + m * 16;
                const f32x4 pv = *(const f32x4*)(pq + (size_t)row * 16 + 4 * fq); float t = (pv.x + pv.y) + (pv.z + pv.w); t += __shfl_xor(t, 16); t += __shfl_xor(t, 32); rs[ai][m] = __builtin_amdgcn_rsqf(t * (1.f / D) + EPS); }
        if (pn < 12) {
            const int isk = pn >= 6, g = (pn % 6) >> 1, hp = pn & 1, e0 = wc * 16 + 4 * fq;
#pragma unroll
            for (int ai = 0; ai < 2; ++ai) {
                f32x4 cs[4], sn[4];
#pragma unroll
                for (int m = 0; m < 4; ++m) { const int row = row0 + ai * 128 + m * 16; const int pidx = row < MP ? (row & 2047) : SEQ + ((row - MP) & 3);
                    cs[m] = *(const f32x4*)(ropeC + pidx * 64 + e0); sn[m] = *(const f32x4*)(ropeS + pidx * 64 + e0); }
#pragma unroll
                for (int m = 0; m < 4; ++m) { const int row = row0 + ai * 128 + m * 16; const float s = rs[ai][m];
#pragma unroll
                    for (int bj = 0; bj < 2; ++bj) { const int h = 2 * hp + bj;
                        const f32x4 x1 = acc[ai][bj][m][0] * s, x2 = acc[ai][bj][m][1] * s;
                        f32x4 r1 = x1 * cs[m] - x2 * sn[m], r2 = x2 * cs[m] + x1 * sn[m];
                        if (!isk) { r1 *= QSCALE; r2 *= QSCALE; }
                        bf16* dp = (isk ? KS : QS) + qkv_off(row, g, h) + e0;
                        v2u w1, w2; w1.x = cvt_pk_bf16(r1.x, r1.y); w1.y = cvt_pk_bf16(r1.z, r1.w); w2.x = cvt_pk_bf16(r2.x, r2.y); w2.y = cvt_pk_bf16(r2.z, r2.w);
                        *(v2u*)dp = w1; *(v2u*)(dp + 64) = w2;
                        if (isk) { float* fo = swa_dst(row, g, 0, h); if (fo) { *(f32x4*)(fo + e0) = r1; *(f32x4*)(fo + 64 + e0) = r2; } }
                    } }
            }
        } else if (pn < 18) {
            const int g = (pn - 12) >> 1, hp = pn & 1;
#pragma unroll
            for (int ai = 0; ai < 2; ++ai)
#pragma unroll
                for (int m = 0; m < 4; ++m) { const int row = row0 + ai * 128 + m * 16; const float s = rs[ai][m];
#pragma unroll
                    for (int bj = 0; bj < 2; ++bj) { const int h = 2 * hp + bj; const f32x4 o0 = acc[ai][bj][m][0] * s, o1 = acc[ai][bj][m][1] * s;
                        v4u w; w.x = cvt_pk_bf16(o0.x, o0.y); w.y = cvt_pk_bf16(o0.z, o0.w); w.z = cvt_pk_bf16(o1.x, o1.y); w.w = cvt_pk_bf16(o1.z, o1.w);
                        *(v4u*)(VS + qkv_off(row, g, h) + cl) = w;
                        float* fo = swa_dst(row, g, 1, h); if (fo) { *(f32x4*)(fo + cl) = o0; *(f32x4*)(fo + cl + 4) = o1; } } }
        } else if (pn == 18) plain<0>(acc, rs, row0, GQ, 256, cl, 0.125f);
        else if (pn == 19) plain<0>(acc, rs, row0, GK, 256, cl, 1.f);
        else if (pn < 22) plain<0>(acc, rs, row0, GV, 512, (pn - 20) * 256 + cl, 1.f);
        else if (pn < 24) plain<1>(acc, rs, row0, GRS, 512, (pn - 22) * 256 + cl, 1.f);
        else if (pn == 24) {
            f32x4 bv[2][2];
#pragma unroll
            for (int bj = 0; bj < 2; ++bj)
#pragma unroll
                for (int n = 0; n < 2; ++n) bv[bj][n] = *(const f32x4*)(bga + bj * 128 + cl + 4 * n);
#pragma unroll
            for (int ai = 0; ai < 2; ++ai)
#pragma unroll
                for (int m = 0; m < 4; ++m) { const int row = row0 + ai * 128 + m * 16; const float s = rs[ai][m];
#pragma unroll
                    for (int bj = 0; bj < 2; ++bj)
#pragma unroll
                        for (int n = 0; n < 2; ++n) { const int c = bj * 128 + cl + 4 * n; f32x4 o;
#pragma unroll
                            for (int i = 0; i < 4; ++i) { const float x = acc[ai][bj][m][n][i] * s + bv[bj][n][i];
                                o[i] = (fminf(x, 0.f) - LN2 * fast_log2(1.f + fast_exp2(-1.4426950408889634f * fabsf(x)))) * (1.f / 16.f); }
                            *(f32x4*)(GA + (size_t)row * 256 + c) = o; } }
        } else if (pn < 27) plain<0>(acc, rs, row0, MQ, 512, (pn - 25) * 256 + cl, QSCALE);
        else plain<2>(acc, rs, row0, GATE, 3072, (pn - 27) * 256 + cl, 1.f);
    }
};


constexpr int TS = 4;
template <int O> __device__ __forceinline__ void tail_store_group(const f32x4 (&acc)[2][2][4][2], float* dst) {
#pragma unroll
    for (int e = 0; e < 8; ++e) *(f32x4*)(dst + (size_t)e * 2048) = acc[O >> 1][e >> 2][2 * (O & 1) + ((e >> 1) & 1)][e & 1];
}
template <int O> __device__ __forceinline__ void tail_store_gated(const f32x4 (&acc)[2][2][4][2], const bf16* gp, float* dst) {
    v4u g[2][2];
#pragma unroll
    for (int mm = 0; mm < 2; ++mm)
#pragma unroll
        for (int bj = 0; bj < 2; ++bj) g[mm][bj] = *(const v4u*)(gp + (size_t)((O >> 1) * 128 + (2 * (O & 1) + mm) * 16) * 3072 + bj * 128);
#pragma unroll
    for (int e = 0; e < 8; ++e) { const v4u gv = g[(e >> 1) & 1][e >> 2];
        const f32x4 gg = (e & 1) ? (f32x4){fast_rcp(bflo(gv.z)), fast_rcp(bfhi(gv.z)), fast_rcp(bflo(gv.w)), fast_rcp(bfhi(gv.w))} : (f32x4){fast_rcp(bflo(gv.x)), fast_rcp(bfhi(gv.x)), fast_rcp(bflo(gv.y)), fast_rcp(bfhi(gv.y))};
        *(f32x4*)(dst + (size_t)e * 2048) = acc[O >> 1][e >> 2][2 * (O & 1) + ((e >> 1) & 1)][e & 1] * gg; }
}
template <class Base, bool GATED = false> struct EpiTail {
    static constexpr bool HAS_MID = false;
    Base E0; float* slab  ; gu32* flag; int s, wave; const bf16* gate  ;
    __device__ __forceinline__ void operator()(const f32x4 (&acc)[2][2][4][2], const Unit& u, int wr, int wc, int fr, int fq) const {
        const int lane = fq * 16 + fr; float* lb = slab + (size_t)(wave * 64 + lane) * 4;
        if (GATED) { const bf16* gp = gate + (size_t)(u.pm * 256 + wr * 64 + fr) * 3072 + u.pn * 256 + wc * 32 + 8 * fq;
            tail_store_gated<0>(acc, gp, lb + (size_t)((0 * TS + s) * 8) * 2048); tail_store_gated<1>(acc, gp, lb + (size_t)((1 * TS + s) * 8) * 2048);
            tail_store_gated<2>(acc, gp, lb + (size_t)((2 * TS + s) * 8) * 2048); tail_store_gated<3>(acc, gp, lb + (size_t)((3 * TS + s) * 8) * 2048); }
        else {
        tail_store_group<0>(acc, lb + (size_t)((0 * TS + s) * 8) * 2048); tail_store_group<1>(acc, lb + (size_t)((1 * TS + s) * 8) * 2048);
        tail_store_group<2>(acc, lb + (size_t)((2 * TS + s) * 8) * 2048); tail_store_group<3>(acc, lb + (size_t)((3 * TS + s) * 8) * 2048); }
        asm volatile("s_waitcnt vmcnt(0)" ::: "memory");
        asm volatile("s_waitcnt lgkmcnt(0)" ::: "memory"); __builtin_amdgcn_s_barrier(); asm volatile("" ::: "memory");
        if (wave == 0) {
            if (lane == 0) { __builtin_amdgcn_fence(__ATOMIC_RELEASE, "agent"); asm volatile("s_waitcnt vmcnt(0)" ::: "memory"); __hip_atomic_fetch_add(flag, 1u, RLX_AGENT); }
            unsigned spins = 0;
            while ((unsigned)__builtin_amdgcn_readfirstlane((int)__hip_atomic_load(flag, RLX_AGENT)) < (unsigned)TS) { __builtin_amdgcn_s_sleep(4); if (++spins > (1u << 22)) break; }
            __builtin_amdgcn_fence(__ATOMIC_ACQUIRE, "agent"); asm volatile("s_waitcnt vmcnt(0)" ::: "memory"); }
        asm volatile("s_waitcnt lgkmcnt(0)" ::: "memory"); __builtin_amdgcn_s_barrier(); asm volatile("" ::: "memory");
        const float* src = lb + (size_t)(s * TS * 8) * 2048;
        f32x4 t[TS][8];
#pragma unroll
        for (int ci = 0; ci < TS; ++ci)
#pragma unroll
            for (int e = 0; e < 8; ++e) t[ci][e] = *(const f32x4*)(src + (size_t)(ci * 8 + e) * 2048);
        f32x4 own[8];
#pragma unroll
        for (int e = 0; e < 8; ++e) own[e] = (t[0][e] + t[1][e]) + (t[2][e] + t[3][e]);
        if (s == 0) E0.template group<0>(own, u, wr, wc, fr, fq); else if (s == 1) E0.template group<1>(own, u, wr, wc, fr, fq);
        else if (s == 2) E0.template group<2>(own, u, wr, wc, fr, fq); else E0.template group<3>(own, u, wr, wc, fr, fq);
    }
};
#define XB_TMO      128
#define XB_XCNT(j)  (256  + 64 * (j))
#define XB_XSUB(j)  (1280 + 64 * (j))
#define XB_XGEN(j)  (2304 + 64 * (j))
#define XB_TOP      3328
#define XB_TOPGEN   3392
#define XCD_BAR_WORDS 3456
#define XB_SPIN_CAP (1u << 18)
__device__ __forceinline__ unsigned xb_ld(unsigned* p)              { return __hip_atomic_load(p, __ATOMIC_RELAXED, __HIP_MEMORY_SCOPE_AGENT); }
__device__ __forceinline__ unsigned xb_add(unsigned* p, unsigned v) { return __hip_atomic_fetch_add(p, v, __ATOMIC_RELAXED, __HIP_MEMORY_SCOPE_AGENT); }
__device__ __forceinline__ unsigned xb_xcc_id() { return (unsigned)__builtin_amdgcn_s_getreg((3 << 11) | 20) & 0xFu; }
#define XB_SPIN(cond, bar) do { unsigned _sp = 0; while (cond) { __builtin_amdgcn_s_sleep(1); \
    if ((++_sp & 255u) == 0u) { if (xb_ld(&(bar)[XB_TMO])) break; if (_sp > XB_SPIN_CAP) { atomicAdd(&(bar)[XB_TMO], 1u); break; } } } } while (0)
struct XcdBarrier { unsigned* bar; unsigned x; volatile LAS unsigned* st; };
__device__ __forceinline__ XcdBarrier xcd_barrier_post(unsigned* bar, volatile LAS unsigned* st, int wave) {
    XcdBarrier b; b.bar = bar; b.x = xb_xcc_id(); b.st = st;
    if (wave == 0 && lane_id() == 0) (void)xb_add(&bar[XB_XCNT(b.x)], 1u);
    return b;
}
__device__ __forceinline__ void xcd_barrier_complete(unsigned* bar, unsigned x, unsigned& nloc, unsigned& nx) {
    const unsigned G = gridDim.x * gridDim.y * gridDim.z;
    unsigned sum, cnt, mine, sp = 0u;
    for (;;) {
        sum = 0u; cnt = 0u; mine = 0u;
#pragma unroll
        for (unsigned j = 0; j < 16; ++j) { const unsigned c = xb_ld(&bar[XB_XCNT(j)]); sum += c; cnt += (c > 0u) ? 1u : 0u; mine = (j == x) ? c : mine; }
        if (sum == G) break;
        __builtin_amdgcn_s_sleep(1);
        if ((++sp & 255u) == 0u) { if (xb_ld(&bar[XB_TMO])) break; if (sp > XB_SPIN_CAP) { atomicAdd(&bar[XB_TMO], 1u); break; } }
    }
    nloc = mine > 0u ? mine : 1u; nx = cnt > 0u ? cnt : 1u;
}
__device__ __forceinline__ void xcd_barrier(const XcdBarrier& b, int wave) {
    asm volatile("s_waitcnt vmcnt(0)" ::: "memory");
    __syncthreads();
    if (wave == 0 && lane_id() == 0) {
        unsigned* bar = b.bar;
        __builtin_amdgcn_s_waitcnt(0);
        unsigned nloc = b.st[0], nx = b.st[1];
        if (nloc == 0u) { xcd_barrier_complete(bar, b.x, nloc, nx); b.st[0] = nloc; b.st[1] = nx; }
        const unsigned old = xb_add(&bar[XB_XSUB(b.x)], 1u);
        const unsigned gen = old / nloc;
        if (old + 1u == (gen + 1u) * nloc) {
            __builtin_amdgcn_fence(__ATOMIC_RELEASE, "agent");
            asm volatile("s_waitcnt vmcnt(0)" ::: "memory");
            const unsigned og = xb_add(&bar[XB_TOP], 1u);
            const unsigned tg = og / nx;
            if (og + 1u == (tg + 1u) * nx) xb_add(&bar[XB_TOPGEN], 1u);
            else XB_SPIN(xb_ld(&bar[XB_TOPGEN]) == tg, bar);
            __builtin_amdgcn_fence(__ATOMIC_ACQUIRE, "agent");
            xb_add(&bar[XB_XGEN(b.x)], 1u);
            asm volatile("s_waitcnt vmcnt(0)" ::: "memory");
        } else {
            XB_SPIN(xb_ld(&bar[XB_XGEN(b.x)]) == gen, bar);
            __builtin_amdgcn_fence(__ATOMIC_ACQUIRE, "agent");
            asm volatile("s_waitcnt vmcnt(0)" ::: "memory");
        }
    }
    __syncthreads();
}

struct Args { const float* in[25]; float* out; unsigned char* ws; int ph_lo, ph_hi, li, pad; };
struct Frame {
    LAS unsigned char* lds; int tid, lane, wave, vcu, G;
    const float *i0, *i1, *i2, *i3, *i4, *i5, *i6, *i7, *i8, *i9, *i10, *i11, *i12, *i13, *i14, *i15, *i16, *i17, *i18, *i19, *i20, *i21, *i22, *i23, *i24;
    float* out; unsigned char* ws;
};
__device__ __forceinline__ float wave_sum(float v) {
#pragma unroll
    for (int o = 1; o < 64; o <<= 1) v += __shfl_xor(v, o);
    return v;
}

template <class Base, bool ATILED = false> __device__ __forceinline__ void tail_phase(Frame& F, const bf16* A, int lda, const bf16* Bt, int ldb, int K, const Base& E0, int ps) {
    const int c = (int)blockIdx.x; if (c >= 8 * TS) return;
    const int j = c / TS, s = c % TS, nch = K / 128, c0 = (s * nch) / TS, c1 = ((s + 1) * nch) / TS;
    pg8::OneUnit S; S.c = c; pg8::StaticOrderT<MR / 256, D / 256>::unit_of(1024 + j, S.u);
    pg8::Gemm g{A + (ATILED ? (size_t)c0 * 2 * (pg8::TILED_KS / 2) : (size_t)c0 * 128), Bt + c0 * 128, MR, D, (c1 - c0) * 128, lda, ldb};
    EpiTail<Base> E{E0, (float*)(F.ws + WS_SLAB) + (size_t)j * (TS * TS * 8 * 2048), (gu32*)(F.ws + WS_CTL) + CW_TAIL + (ps * 8 + j) * 64, s, F.wave};
    pg8::gemm_phase<EpiTail<Base>, pg8::OneUnit, true, ATILED>(F.lds + RING_OFF, g, S, E, F.wave);
}
__device__ __forceinline__ void tail_phase_merge(Frame& F, const bf16* A, const bf16* Bt, const EpiMerge1& E0, int ps) {
    const int c = (int)blockIdx.x; if (c >= 8 * TS) return;
    const int j = c / TS, s = c % TS, k0 = s < 2 ? 512 * s : 1024 + 256 * (s - 2), kl = s < 2 ? 512 : 256, br = s < 2 ? s : 2;
    pg8::OneUnit S; S.c = c; pg8::StaticOrderT<MR / 256, D / 256>::unit_of(1024 + j, S.u);
    pg8::Gemm g{A + k0, Bt + k0, MR, D, kl, 1536, 1536};
    EpiTail<EpiMerge1, true> E{E0, (float*)(F.ws + WS_SLAB) + (size_t)j * (TS * TS * 8 * 2048), (gu32*)(F.ws + WS_CTL) + CW_TAIL + (ps * 8 + j) * 64, s, F.wave, E0.GATE + br * 1024};
    pg8::gemm_phase<EpiTail<EpiMerge1, true>, pg8::OneUnit>(F.lds + RING_OFF, g, S, E, F.wave);
}
enum WKind { WK_PLAIN = 0, WK_SWIGLU = 1, WK_IN = 2 };
__device__ __forceinline__ int p0_win_col(int np) {
    const int pn = np >> 8, r = np & 255;
    if (pn < 18) { const int qkv = pn / 6, g = (pn % 6) >> 1, hp = pn & 1, h = 2 * hp + (r >> 7); const int d = qkv < 2 ? sig_rope(r & 127) : sig_plain(r & 127); return ((qkv * 3 + g) * 4 + h) * 128 + d; }
    const int c = sig_plain(r);
    if (pn == 18) return 4608 + c;
    if (pn == 19) return 4864 + c;
    if (pn < 22) return 5120 + (pn - 20) * 256 + c;
    if (pn < 24) return 5632 + (pn - 22) * 256 + c;
    if (pn == 24) return -1 - c;
    if (pn < 27) return 6160 + (pn - 25) * 256 + c;
    return DIN + (pn - 27) * 256 + c;
}
__device__ __forceinline__ void p0_item(const Frame& F, int kind, const float* W, int ldw, const float* W2, const float* gain, const float* a2, bf16* WT, int K, int kb, int nb, LAS float* scr) {
    const int lane = F.lane, k0 = 64 * kb, n0 = 32 * nb, np = n0 + (lane & 31);
    int sc; const float* Wp = W; int ld = ldw;
    if (kind == WK_PLAIN) sc = sig_plain(np);
    else if (kind == WK_SWIGLU) { const int r = np & 255; sc = (r >> 7) * FF + (np >> 8) * 128 + sig_plain(r & 127); }
    else { sc = p0_win_col(np); if (sc >= DIN) { sc -= DIN; Wp = W2; ld = 3072; } }
    if (sc >= 0) {
#pragma unroll 8
        for (int i = 0; i < 32; ++i) { const int kk = 2 * i + (lane >> 5); float v = Wp[(size_t)(k0 + kk) * ld + sc]; if (gain) v *= gain[k0 + kk]; scr[kk * 33 + (lane & 31)] = v; }
    } else {
        const int j = -1 - sc; float a2c[16];
#pragma unroll
        for (int r = 0; r < 16; ++r) a2c[r] = a2[r * 256 + j];
        for (int i = 0; i < 32; ++i) { const int kk = 2 * i + (lane >> 5); const float* wr_ = W + (size_t)(k0 + kk) * ldw + 6144; float v = 0.f;
#pragma unroll
            for (int r = 0; r < 16; ++r) v += wr_[r] * a2c[r];
            scr[kk * 33 + (lane & 31)] = v * gain[k0 + kk]; }
    }
    LDS_WAIT(); asm volatile("" ::: "memory");
    const int c = lane & 7;
#pragma unroll
    for (int j = 0; j < 4; ++j) { const int n = (lane >> 3) + 8 * j; const LAS float* s = scr + (8 * c) * 33 + n;
        v4u o; o.x = pk2(s[0 * 33], s[1 * 33]); o.y = pk2(s[2 * 33], s[3 * 33]); o.z = pk2(s[4 * 33], s[5 * 33]); o.w = pk2(s[6 * 33], s[7 * 33]);
        *(GAS v4u*)(WT + (size_t)(n0 + n) * K + k0 + 8 * c) = o; }
    LDS_WAIT(); asm volatile("" ::: "memory");
}
template <int NR> __device__ __forceinline__ void rms_rows_to_bf16(int lane, const float* const (&xrow)[NR], const float* const (&gain)[NR], bf16* const (&orow)[NR]) {
    f32x4 v[NR][4]; float rstd[NR];
#pragma unroll
    for (int r = 0; r < NR; ++r)
#pragma unroll
        for (int j = 0; j < 4; ++j) v[r][j] = ((const GAS f32x4*)xrow[r] + lane)[64 * j];
#pragma unroll
    for (int r = 0; r < NR; ++r) { float s = 0.f;
#pragma unroll
        for (int j = 0; j < 4; ++j) s += (v[r][j].x * v[r][j].x + v[r][j].y * v[r][j].y) + (v[r][j].z * v[r][j].z + v[r][j].w * v[r][j].w);
        rstd[r] = 1.0f / sqrtf(wave_sum(s) * (1.f / D) + EPS); }
#pragma unroll
    for (int r = 0; r < NR; ++r) { GAS v2u* o8 = (GAS v2u*)orow[r] + lane; const GAS f32x4* gr = (const GAS f32x4*)gain[r] + lane;
#pragma unroll
        for (int j = 0; j < 4; ++j) { const f32x4 gg = gr[64 * j]; v2u w; w.x = pk2(v[r][j].x * rstd[r] * gg.x, v[r][j].y * rstd[r] * gg.y); w.y = pk2(v[r][j].z * rstd[r] * gg.z, v[r][j].w * rstd[r] * gg.w); o8[64 * j] = w; } }
}
__device__ __forceinline__ void sincos_d(double x, double& s, double& c) {
    const double TWO_PI = 6.283185307179586476925286766559;
    const double n = __builtin_rint(x / TWO_PI); const double r = x - n * TWO_PI, r2 = r * r;
    double ts = 1.0, tc = 1.0;
#pragma unroll
    for (int k = 14; k >= 1; --k) { ts = 1.0 - ts * r2 / (double)((2 * k) * (2 * k + 1)); tc = 1.0 - tc * r2 / (double)((2 * k - 1) * (2 * k)); }
    s = ts * r; c = tc;
}
__device__ __forceinline__ void p0_prologue(Frame& F) {
    unsigned char* ws = F.ws;
    LAS float* scr = (LAS float*)(F.lds + RING_OFF + F.wave * 16384);
    const int gw = F.vcu * NWAVES + F.wave, NGW = F.G * NWAVES;
    constexpr int I_A = 16 * 176, I_O = 44 * 32, I_IN = 16 * 312, I_BR = 8 * 32, I_SQ = 16 * 32;
    constexpr int NITEMS = 2 * I_A + 2 * I_O + I_IN + 3 * I_BR + 2 * I_SQ;
    for (int it = gw; it < NITEMS; it += NGW) {
        int r = it;
        if (r < I_A) { p0_item(F, WK_SWIGLU, F.i9, 2 * FF, nullptr, nullptr, nullptr, (bf16*)(ws + WS_W1A), D, r / 176, r % 176, scr); continue; } r -= I_A;
        if (r < I_A) { p0_item(F, WK_SWIGLU, F.i22, 2 * FF, nullptr, F.i21, nullptr, (bf16*)(ws + WS_W2A), D, r / 176, r % 176, scr); continue; } r -= I_A;
        if (r < I_O) { p0_item(F, WK_PLAIN, F.i10, D, nullptr, nullptr, nullptr, (bf16*)(ws + WS_W1O), FF, r / 32, r % 32, scr); continue; } r -= I_O;
        if (r < I_O) { p0_item(F, WK_PLAIN, F.i23, D, nullptr, nullptr, nullptr, (bf16*)(ws + WS_W2O), FF, r / 32, r % 32, scr); continue; } r -= I_O;
        if (r < I_IN) { p0_item(F, WK_IN, F.i12, DIN, F.i16, F.i11, F.i13, (bf16*)(ws + WS_WIN), D, r / 312, r % 312, scr); continue; } r -= I_IN;
        if (r < 3 * I_BR) { const int br = r / I_BR, q = r % I_BR; p0_item(F, WK_PLAIN, F.i17 + (size_t)br * 512 * D, D, nullptr, nullptr, nullptr, (bf16*)(ws + WS_WBR) + br * 512, 1536, q / 32, q % 32, scr); continue; } r -= 3 * I_BR;
        if (r < I_SQ) { p0_item(F, WK_PLAIN, F.i18, D, nullptr, nullptr, nullptr, (bf16*)(ws + WS_WOUT), D, r / 32, r % 32, scr); continue; } r -= I_SQ;
        p0_item(F, WK_PLAIN, F.i20, D, nullptr, nullptr, nullptr, (bf16*)(ws + WS_WMEM), D, r / 32, r % 32, scr);
    }
#define P0_ROW(m_, x_, g_, o_) do { const int mm_ = (m_); if (mm_ < MP) { x_ = F.i0 + (size_t)mm_ * D; g_ = F.i8; o_ = (bf16*)(ws + WS_XB) + (size_t)mm_ * D; } \
        else if (mm_ < MR) { x_ = F.i1 + (size_t)(mm_ - MP) * D; g_ = F.i8; o_ = (bf16*)(ws + WS_XB) + (size_t)mm_ * D; } \
        else { x_ = F.i2 + (size_t)(mm_ - MR) * D; g_ = F.i19; o_ = (bf16*)(ws + WS_MEMB) + (size_t)(mm_ - MR) * D; } } while (0)
    { int m = gw;
      for (; m + 3 * NGW < MR + MM; m += 4 * NGW) { const float* x[4]; const float* g[4]; bf16* o[4];
#pragma unroll
          for (int r = 0; r < 4; ++r) P0_ROW(m + r * NGW, x[r], g[r], o[r]);
          rms_rows_to_bf16<4>(F.lane, x, g, o); }
      for (; m < MR + MM; m += NGW) { const float* x[1]; const float* g[1]; bf16* o[1]; P0_ROW(m, x[0], g[0], o[0]); rms_rows_to_bf16<1>(F.lane, x, g, o); } }
#undef P0_ROW
    float* rc = (float*)(ws + WS_ROPE); float* rsn = rc + NPOS * 64;
    for (int i = (F.vcu * NWAVES * 64) + F.tid; i < NPOS * 64; i += F.G * NWAVES * 64) {
        const int p = i >> 6, e = i & 63; const int pos = p < SEQ ? p : PAST + (p - SEQ);
        const double y = -(double)e * 9.210340371976182736 / 64.0 / 16.0; double ex = 1.0;
#pragma unroll
        for (int k = 14; k >= 1; --k) ex = 1.0 + ex * y / (double)k;
        ex *= ex; ex *= ex; ex *= ex; ex *= ex;
        const float inv = (float)ex; const float ang = (float)pos * inv;
        double s, c; sincos_d((double)ang, s, c); rc[i] = (float)c; rsn[i] = (float)s;
    }
}

__device__ __forceinline__ int koff(int row, int ch) { return 256 * row + 16 * (ch ^ (row & 15)); }
__device__ __forceinline__ int voff(int row, int ch) { return 256 * row + 16 * (ch ^ ((row & 7) << 1)); }
typedef short v4i16_t __attribute__((ext_vector_type(4)));
__device__ __forceinline__ s16x4 vtr(const LAS unsigned char* p) { return __builtin_bit_cast(s16x4, __builtin_amdgcn_ds_read_tr16_b64_v4i16((LAS v4i16_t*)p)); }
struct AttnDesc { const bf16* Qp; const bf16* Kp; const bf16* Vp; bf16* Op; float* lsep; long qrow0, krow0, orow0; int qpitch, kpitch, opitch, qstride, kstride, ostride, kmin; };
template <int MODE> __device__ __forceinline__ AttnDesc attn_desc(const Frame& F, int id) {
    unsigned char* ws = F.ws; AttnDesc d;
    if (MODE == 0) {
        const int b = id / 192, rem = id % 192, gh = rem >> 4, u = rem & 15, g = gh >> 2;
        const int dil = g == 0 ? 1 : (g == 1 ? 4 : 16), r = g == 0 ? 0 : (g == 1 ? (u & 3) : u), n = g == 0 ? u : (g == 1 ? (u >> 2) : 0);
        const size_t hb = (size_t)((g * NB + b) * 4 + (gh & 3)) * SEQ * 128; const long pr = (long)r * (SEQ / dil);
        d.Qp = (const bf16*)(ws + WS_QS) + hb; d.Kp = (const bf16*)(ws + WS_KS) + hb; d.Vp = (const bf16*)(ws + WS_VS) + hb; d.Op = (bf16*)(ws + WS_OG) + gh * 128; d.lsep = (float*)(ws + WS_LSE) + gh;
        d.qrow0 = pr + 128 * n; d.krow0 = pr + 128 * (n - 1); d.orow0 = (long)b * SEQ + r + (long)128 * n * dil; d.qpitch = 128; d.kpitch = 128; d.opitch = 1536; d.qstride = 1; d.kstride = 1; d.ostride = dil; d.kmin = n == 0 ? 128 : 0;
    } else {
        const int j = id - 6144, b = j >> 6, h = (j >> 4) & 3, n = j & 15;
        d.Qp = (const bf16*)(ws + WS_MQ) + h * 128; d.Kp = (const bf16*)(ws + WS_MKV) + h * 128; d.Vp = (const bf16*)(ws + WS_MKV) + 512 + h * 128; d.Op = (bf16*)(ws + WS_OALL) + 1024 + h * 128; d.lsep = nullptr;
        d.qrow0 = (long)b * SEQ + 128 * n; d.orow0 = d.qrow0; d.ostride = 1; d.krow0 = (long)b * MEML; d.qpitch = 512; d.kpitch = 1024; d.opitch = 1536; d.qstride = 1; d.kstride = 1; d.kmin = 0;
    }
    return d;
}
template <int MODE> __device__ __forceinline__ void attn_scores(const Frame& F, const AttnDesc& d, const bf16x8 (&qf)[4], f32x4 (&S)[MODE == 0 ? 9 : 16], float& mx_out, float& ls_out) {
    const LAS unsigned char* ldsK = F.lds + RING_OFF;
    const int lane = F.lane, w = F.wave, l15 = lane & 15, g4 = lane >> 4;
    constexpr int NF = MODE == 0 ? 9 : 16;
    const int f0 = MODE == 0 ? w : 0; const bool half = MODE == 0 && d.kmin != 0;
#pragma unroll
    for (int i = 0; i < NF; ++i) { S[i] = (f32x4){0.f, 0.f, 0.f, 0.f};
        if (!(half && f0 + i < 8)) { const int krow = 16 * (f0 + i) + l15;
#pragma unroll
            for (int s = 0; s < 4; ++s) { const bf16x8 kf = *(const LAS bf16x8*)(ldsK + koff(krow, 4 * s + g4)); S[i] = __builtin_amdgcn_mfma_f32_16x16x32_bf16(kf, qf[s], S[i], 0, 0, 0); } } }
    float mx = -3.0e38f; const int iq = 16 * w + l15;
#pragma unroll
    for (int i = 0; i < NF; ++i)
#pragma unroll
        for (int r = 0; r < 4; ++r) { if (MODE == 0) { const int kj = 16 * (f0 + i) + 4 * g4 + r; const bool ok = kj >= iq && kj <= iq + 128 && kj >= d.kmin; S[i][r] = ok ? S[i][r] : -3.0e38f; } mx = fmaxf(mx, S[i][r]); }
    mx = fmaxf(mx, __shfl_xor(mx, 16)); mx = fmaxf(mx, __shfl_xor(mx, 32));
    float ls = 0.f;
#pragma unroll
    for (int i = 0; i < NF; ++i)
#pragma unroll
        for (int r = 0; r < 4; ++r) { const float p = fast_exp2(S[i][r] - mx); S[i][r] = p; ls += p; }
    ls += __shfl_xor(ls, 16); ls += __shfl_xor(ls, 32);
    mx_out = mx; ls_out = ls;
}
template <int MODE> __device__ __forceinline__ void attn_pv(const Frame& F, const AttnDesc& d, const f32x4 (&S)[MODE == 0 ? 9 : 16], float mx, float ls) {
    const LAS unsigned char* ldsV = F.lds + RING_OFF + 65536;
    const int lane = F.lane, w = F.wave, l15 = lane & 15, g4 = lane >> 4;
    constexpr int NF = MODE == 0 ? 9 : 16, NP = (NF + 1) / 2;
    const int f0 = MODE == 0 ? w : 0; const bool half = MODE == 0 && d.kmin != 0;
    f32x4 O[8];
#pragma unroll
    for (int df = 0; df < 8; ++df) O[df] = (f32x4){0.f, 0.f, 0.f, 0.f};
    const int q4 = l15 >> 2, p4 = lane & 3;
#pragma unroll
    for (int pr = 0; pr < NP; ++pr) {
        int fa = f0 + 2 * pr, fb = fa + 1; if (fb > 15) fb = 15;
        if (half && fb < 8) continue;
        if (half && fa < 8) fa = 8;
        const f32x4 pa = S[2 * pr], pb = (2 * pr + 1 < NF) ? S[(2 * pr + 1 < NF) ? 2 * pr + 1 : 0] : (f32x4){0.f, 0.f, 0.f, 0.f};
        v4u pw; pw.x = cvt_pk_bf16(pa.x, pa.y); pw.y = cvt_pk_bf16(pa.z, pa.w); pw.z = cvt_pk_bf16(pb.x, pb.y); pw.w = cvt_pk_bf16(pb.z, pb.w);
        const bf16x8 pf = __builtin_bit_cast(bf16x8, pw);
        const int ra = 16 * fa + 4 * g4 + q4, rb = 16 * fb + 4 * g4 + q4;
#pragma unroll
        for (int df = 0; df < 8; ++df) {
            const s16x4 t1 = vtr(ldsV + voff(ra, 2 * df + (p4 >> 1)) + 8 * (p4 & 1)), t2 = vtr(ldsV + voff(rb, 2 * df + (p4 >> 1)) + 8 * (p4 & 1));
            const bf16x8 vf = {t1[0], t1[1], t1[2], t1[3], t2[0], t2[1], t2[2], t2[3]};
            O[df] = __builtin_amdgcn_mfma_f32_16x16x32_bf16(vf, pf, O[df], 0, 0, 0);
        }
    }
    const float inv = 1.0f / ls;
    const long qrow = d.orow0 + (long)(16 * w + l15) * d.ostride;
    bf16* op = d.Op + qrow * d.opitch + 4 * g4;
#pragma unroll
    for (int df = 0; df < 8; ++df) { const f32x4 o = O[df] * inv; v2u wv; wv.x = cvt_pk_bf16(o.x, o.y); wv.y = cvt_pk_bf16(o.z, o.w); *(v2u*)(op + 16 * df) = wv; }
    if (MODE == 0 && g4 == 0) d.lsep[qrow * 12] = (mx + fast_log2(ls)) * LN2;
}
__device__ __forceinline__ void glds16(const void* gsrc, unsigned lds_dst) { unsigned keep;
    asm volatile("s_mov_b32 %0, m0\n\ts_mov_b32 m0, %2\n\ts_nop 0\n\tglobal_load_lds_dwordx4 %1, off\n\ts_mov_b32 m0, %0" : "=&s"(keep) : "v"(gsrc), "s"(lds_dst) : "memory"); }
__device__ __forceinline__ void attn_dma(const Frame& F, const AttnDesc& d, const bool isV) {
    const bf16* P = isV ? d.Vp : d.Kp;
    const unsigned base = (unsigned)__builtin_amdgcn_readfirstlane((int)(unsigned)(size_t)(F.lds + RING_OFF) + (isV ? 65536 : 0) + F.wave * 8192);
    if (d.kmin != 0 && F.wave < 4) return;
    const int slot = F.lane & 15, rsub = F.lane >> 4;
#pragma unroll
    for (int i = 0; i < 8; ++i) { const int row = 32 * F.wave + 4 * i + rsub, ch = isV ? (slot ^ ((row & 7) << 1)) : (slot ^ (row & 15));
        const bf16* gp = P + (d.krow0 + (long)row * d.kstride) * d.kpitch + ch * 8;
        glds16(gp, base + i * 1024); }
}
__device__ __forceinline__ void attn_loadq(const Frame& F, const AttnDesc& d, bf16x8 (&qf)[4]) {
    const long qrow = d.qrow0 + (long)(16 * F.wave + (F.lane & 15)) * d.qstride;
#pragma unroll
    for (int s = 0; s < 4; ++s) qf[s] = *(const bf16x8*)(d.Qp + qrow * d.qpitch + 32 * s + 8 * (F.lane >> 4));
}
#define ATT_BAR() do { asm volatile("s_waitcnt lgkmcnt(0)" ::: "memory"); __builtin_amdgcn_s_barrier(); asm volatile("" ::: "memory"); } while (0)
template <int MODE, int NU> __device__ __forceinline__ void attn_batch(const Frame& F, int id0) {
    AttnDesc d = attn_desc<MODE>(F, id0);
    bf16x8 qn[4], qc[4];
    attn_dma(F, d, false); attn_loadq(F, d, qn);
#pragma unroll
    for (int s = 0; s < 4; ++s) qc[s] = qn[s];
    attn_dma(F, d, true);
#pragma unroll 1
    for (int u = 0; u < NU; ++u) {
        asm volatile("s_waitcnt vmcnt(8)" ::: "memory"); ATT_BAR();
        f32x4 S[MODE == 0 ? 9 : 16]; float mx, ls;
        attn_scores<MODE>(F, d, qc, S, mx, ls);
        asm volatile("s_waitcnt vmcnt(0)" ::: "memory"); ATT_BAR();
        const bool more = u + 1 < NU;
        const AttnDesc dn = attn_desc<MODE>(F, id0 + (more ? u + 1 : u));
        if (more) { attn_dma(F, dn, false); if (MODE == 0) attn_loadq(F, dn, qn); }
        attn_pv<MODE>(F, d, S, mx, ls);
        ATT_BAR();
        if (more) {
            if (MODE != 0) attn_loadq(F, dn, qn);
#pragma unroll
            for (int s = 0; s < 4; ++s) qc[s] = qn[s];
            asm volatile("" : "+v"(qc[0]), "+v"(qc[1]), "+v"(qc[2]), "+v"(qc[3]));
            attn_dma(F, dn, true); }
        d = dn;
    }
    asm volatile("s_waitcnt vmcnt(0)" ::: "memory");
}
__device__ __forceinline__ void p4_sample_attn(const Frame& F, int wt, const float* c0, const float* c1, const float* c2, const float* cm) {
    unsigned char* ws = F.ws; const int lane = F.lane, sub = lane & 15, t = lane >> 4;
    const int db = wt >> 4, h = (wt >> 2) & 3, src = wt & 3;
    const int row = MP + db * 4 + t;
    const bf16* qp = src < 3 ? (const bf16*)(ws + WS_QS) + (size_t)row * 1536 + src * 512 + h * 128 + 8 * sub : (const bf16*)(ws + WS_MQ) + (size_t)row * 512 + h * 128 + 8 * sub;
    float q[8]; { const v4u qw = *(const v4u*)qp; q[0] = bflo(qw.x); q[1] = bfhi(qw.x); q[2] = bflo(qw.y); q[3] = bfhi(qw.y); q[4] = bflo(qw.z); q[5] = bfhi(qw.z); q[6] = bflo(qw.w); q[7] = bfhi(qw.w); }
    float mx = -3.0e38f, ls = 0.f, o[8];
#pragma unroll
    for (int j = 0; j < 8; ++j) o[j] = 0.f;
#define SA_STEP(K0, K1, V0, V1) do { float s_ = (q[0] * K0.x + q[1] * K0.y) + (q[2] * K0.z + q[3] * K0.w) + (q[4] * K1.x + q[5] * K1.y) + (q[6] * K1.z + q[7] * K1.w); \
        s_ += __shfl_xor(s_, 1); s_ += __shfl_xor(s_, 2); s_ += __shfl_xor(s_, 4); s_ += __shfl_xor(s_, 8); \
        const float mn_ = fmaxf(mx, s_), sc_ = fast_exp2(mx - mn_), p_ = fast_exp2(s_ - mn_); mx = mn_; ls = ls * sc_ + p_; \
        o[0] = o[0] * sc_ + p_ * V0.x; o[1] = o[1] * sc_ + p_ * V0.y; o[2] = o[2] * sc_ + p_ * V0.z; o[3] = o[3] * sc_ + p_ * V0.w; \
        o[4] = o[4] * sc_ + p_ * V1.x; o[5] = o[5] * sc_ + p_ * V1.y; o[6] = o[6] * sc_ + p_ * V1.z; o[7] = o[7] * sc_ + p_ * V1.w; } while (0)
    int nstart = 0, NK; const float* cache; int L = 256, dil = 1;
    if (src == 3) { cache = cm; NK = 256; }
    else { cache = src == 0 ? c0 : (src == 1 ? c1 : c2); L = 128 << (2 * src); dil = src == 0 ? 1 : (src == 1 ? 4 : 16); NK = 129; nstart = 4;
        for (int n = 0; n < 4; ++n) {
            const int idx = L + t - dil * n; f32x4 k0, k1, v0, v1;
            if (idx >= L) { const size_t ro = (size_t)(MP + db * 4 + (idx - L)) * 1536 + src * 512 + h * 128 + 8 * sub;
                const v4u kw = *(const v4u*)((const bf16*)(ws + WS_KS) + ro), vw = *(const v4u*)((const bf16*)(ws + WS_VS) + ro);
                k0 = (f32x4){bflo(kw.x), bfhi(kw.x), bflo(kw.y), bfhi(kw.y)}; k1 = (f32x4){bflo(kw.z), bfhi(kw.z), bflo(kw.w), bfhi(kw.w)};
                v0 = (f32x4){bflo(vw.x), bfhi(vw.x), bflo(vw.y), bfhi(vw.y)}; v1 = (f32x4){bflo(vw.z), bfhi(vw.z), bflo(vw.w), bfhi(vw.w)};
            } else { const float* kp = cache + (((size_t)db * L + idx) * 2) * 512 + h * 128 + 8 * sub;
                k0 = *(const f32x4*)kp; k1 = *(const f32x4*)(kp + 4); v0 = *(const f32x4*)(kp + 512); v1 = *(const f32x4*)(kp + 516); }
            SA_STEP(k0, k1, v0, v1);
        }
    }
    const float* kbase = cache + ((size_t)db * L * 2) * 512 + h * 128 + 8 * sub;
    const long kstep = src == 3 ? 1024 : -(long)dil * 1024; const long kfirst = src == 3 ? 0 : (long)(L + t) * 1024;
    int n = nstart;
    for (; n + 4 <= NK; n += 4) {
        f32x4 kk[4][2], vv[4][2];
#pragma unroll
        for (int j = 0; j < 4; ++j) { const float* kp = kbase + kfirst + (long)(n + j) * kstep; kk[j][0] = *(const f32x4*)kp; kk[j][1] = *(const f32x4*)(kp + 4); vv[j][0] = *(const f32x4*)(kp + 512); vv[j][1] = *(const f32x4*)(kp + 516); }
#pragma unroll
        for (int j = 0; j < 4; ++j) SA_STEP(kk[j][0], kk[j][1], vv[j][0], vv[j][1]);
    }
    for (; n < NK; ++n) { const float* kp = kbase + kfirst + (long)n * kstep; const f32x4 k0 = *(const f32x4*)kp, k1 = *(const f32x4*)(kp + 4), v0 = *(const f32x4*)(kp + 512), v1 = *(const f32x4*)(kp + 516); SA_STEP(k0, k1, v0, v1); }
#undef SA_STEP
    const float inv = 1.0f / ls;
    v4u w; w.x = cvt_pk_bf16(o[0] * inv, o[1] * inv); w.y = cvt_pk_bf16(o[2] * inv, o[3] * inv); w.z = cvt_pk_bf16(o[4] * inv, o[5] * inv); w.w = cvt_pk_bf16(o[6] * inv, o[7] * inv);
    if (src < 3) { *(v4u*)((bf16*)(ws + WS_OG) + (size_t)row * 1536 + src * 512 + h * 128 + 8 * sub) = w; if (sub == 0) ((float*)(ws + WS_LSE))[(size_t)row * 12 + src * 4 + h] = (mx + fast_log2(ls)) * LN2; }
    else *(v4u*)((bf16*)(ws + WS_OALL) + (size_t)row * 1536 + 1024 + h * 128 + 8 * sub) = w;
}
__device__ __forceinline__ void p4_sample_attn_shared(const Frame& F, int db, int h, const bool is_mem, const float* cache) {
    unsigned char* ws = F.ws; const int lane = F.lane, sub = lane & 15, gk = lane >> 4; const int rowq0 = MP + db * 4;
    float qv[4][8];
#pragma unroll
    for (int t = 0; t < 4; ++t) { const bf16* qp = is_mem ? (const bf16*)(ws + WS_MQ) + (size_t)(rowq0 + t) * 512 + h * 128 + 8 * sub : (const bf16*)(ws + WS_QS) + (size_t)(rowq0 + t) * 1536 + h * 128 + 8 * sub;
        const v4u qw = *(const v4u*)qp; qv[t][0] = bflo(qw.x); qv[t][1] = bfhi(qw.x); qv[t][2] = bflo(qw.y); qv[t][3] = bfhi(qw.y); qv[t][4] = bflo(qw.z); qv[t][5] = bfhi(qw.z); qv[t][6] = bflo(qw.w); qv[t][7] = bfhi(qw.w); }
    float m[4], l[4], o[4][8];
#pragma unroll
    for (int t = 0; t < 4; ++t) { m[t] = -3.0e38f; l[t] = 0.f;
#pragma unroll
        for (int j = 0; j < 8; ++j) o[t][j] = 0.f; }
#define SS_STEP(P, K0, K1, V0, V1) do { _Pragma("unroll") for (int t = 0; t < 4; ++t) { \
        float s_ = (qv[t][0] * K0.x + qv[t][1] * K0.y) + (qv[t][2] * K0.z + qv[t][3] * K0.w) + (qv[t][4] * K1.x + qv[t][5] * K1.y) + (qv[t][6] * K1.z + qv[t][7] * K1.w); \
        s_ += __shfl_xor(s_, 1); s_ += __shfl_xor(s_, 2); s_ += __shfl_xor(s_, 4); s_ += __shfl_xor(s_, 8); \
        const bool ok_ = is_mem || ((P) >= t && (P) <= 128 + t); \
        const float mn_ = ok_ ? fmaxf(m[t], s_) : m[t], sc_ = fast_exp2(m[t] - mn_), p_ = ok_ ? fast_exp2(s_ - mn_) : 0.f; m[t] = mn_; l[t] = l[t] * sc_ + p_; \
        o[t][0] = o[t][0] * sc_ + p_ * V0.x; o[t][1] = o[t][1] * sc_ + p_ * V0.y; o[t][2] = o[t][2] * sc_ + p_ * V0.z; o[t][3] = o[t][3] * sc_ + p_ * V0.w; \
        o[t][4] = o[t][4] * sc_ + p_ * V1.x; o[t][5] = o[t][5] * sc_ + p_ * V1.y; o[t][6] = o[t][6] * sc_ + p_ * V1.z; o[t][7] = o[t][7] * sc_ + p_ * V1.w; } } while (0)
    const int L = is_mem ? 256 : 128;
    const float* kbase = cache + ((size_t)db * L * 2) * 512 + h * 128 + 8 * sub + (size_t)gk * 1024;
    for (int j = 0; j < L / 4; j += 4) {
        f32x4 kk[4][2], vv[4][2];
#pragma unroll
        for (int e = 0; e < 4; ++e) { const float* kp = kbase + (size_t)(j + e) * 4096; kk[e][0] = *(const f32x4*)kp; kk[e][1] = *(const f32x4*)(kp + 4); vv[e][0] = *(const f32x4*)(kp + 512); vv[e][1] = *(const f32x4*)(kp + 516); }
#pragma unroll
        for (int e = 0; e < 4; ++e) SS_STEP(4 * (j + e) + gk, kk[e][0], kk[e][1], vv[e][0], vv[e][1]);
    }
    if (!is_mem) {
        const size_t ro = (size_t)(rowq0 + gk) * 1536 + h * 128 + 8 * sub;
        const v4u kw = *(const v4u*)((const bf16*)(ws + WS_KS) + ro), vw = *(const v4u*)((const bf16*)(ws + WS_VS) + ro);
        const f32x4 k0 = {bflo(kw.x), bfhi(kw.x), bflo(kw.y), bfhi(kw.y)}, k1 = {bflo(kw.z), bfhi(kw.z), bflo(kw.w), bfhi(kw.w)};
        const f32x4 v0 = {bflo(vw.x), bfhi(vw.x), bflo(vw.y), bfhi(vw.y)}, v1 = {bflo(vw.z), bfhi(vw.z), bflo(vw.w), bfhi(vw.w)};
        SS_STEP(128 + gk, k0, k1, v0, v1);
    }
#undef SS_STEP
    float mo = 0.f, lo = 1.f, oo[8];
#pragma unroll
    for (int j = 0; j < 8; ++j) oo[j] = 0.f;
#pragma unroll
    for (int t = 0; t < 4; ++t) {
        float mm = fmaxf(m[t], __shfl_xor(m[t], 16)); mm = fmaxf(mm, __shfl_xor(mm, 32));
        const float f = fast_exp2(m[t] - mm); float lt = l[t] * f; lt += __shfl_xor(lt, 16); lt += __shfl_xor(lt, 32);
        if (gk == t) { mo = mm; lo = lt; }
#pragma unroll
        for (int j = 0; j < 8; ++j) { float x = o[t][j] * f; x += __shfl_xor(x, 16); x += __shfl_xor(x, 32); if (gk == t) oo[j] = x; }
    }
    const float inv = 1.0f / lo; const int row = rowq0 + gk;
    v4u w; w.x = cvt_pk_bf16(oo[0] * inv, oo[1] * inv); w.y = cvt_pk_bf16(oo[2] * inv, oo[3] * inv); w.z = cvt_pk_bf16(oo[4] * inv, oo[5] * inv); w.w = cvt_pk_bf16(oo[6] * inv, oo[7] * inv);
    if (is_mem) *(v4u*)((bf16*)(ws + WS_OALL) + (size_t)row * 1536 + 1024 + h * 128 + 8 * sub) = w;
    else { *(v4u*)((bf16*)(ws + WS_OG) + (size_t)row * 1536 + h * 128 + 8 * sub) = w; if (sub == 0) ((float*)(ws + WS_LSE))[(size_t)row * 12 + h] = (mo + fast_log2(lo)) * LN2; }
}
__device__ __forceinline__ void p4_sample_task(const Frame& F, int it, const float* c0, const float* c1, const float* c2, const float* cm) {
    const int kind = it >> 9, idx = it & 511, db = idx >> 2, h = idx & 3;
    if (kind == 0) p4_sample_attn(F, db * 16 + h * 4 + 2, c0, c1, c2, cm);
    else if (kind == 1) p4_sample_attn(F, db * 16 + h * 4 + 1, c0, c1, c2, cm);
    else if (kind == 2) p4_sample_attn_shared(F, db, h, true, cm);
    else p4_sample_attn_shared(F, db, h, false, c0);
}
__device__ __forceinline__ void p4_sample_loop(const Frame& F, const float* c0, const float* c1, const float* c2, const float* cm, int q = 0) {
    gu32* qw = (gu32*)(F.ws + WS_CTL) + 64 + 64 * q;
    for (;;) { unsigned v = 0; if (F.lane == 0) v = __hip_atomic_fetch_add(qw, 1u, RLX_AGENT); const int it = (int)__builtin_amdgcn_readfirstlane(v);
        if (it >= 2048) break; p4_sample_task(F, it, c0, c1, c2, cm); }
}
__device__ __forceinline__ void p4_gla_chain(const Frame& F, int row0, int T, int h, const float* S0, float* Sout) {
    unsigned char* ws = F.ws; const int tid = F.tid, v = tid & 127, ks = __builtin_amdgcn_readfirstlane(tid >> 7);
    const float* GA = (const float*)(ws + WS_GA); const bf16* GQ = (const bf16*)(ws + WS_GQ); const bf16* GK = (const bf16*)(ws + WS_GK); const bf16* GV = (const bf16*)(ws + WS_GV); bf16* GO = (bf16*)(ws + WS_GO);
    LAS float* part = (LAS float*)(F.lds + RING_OFF);
    float S[16];
#pragma unroll
    for (int i = 0; i < 16; ++i) S[i] = S0 ? S0[(size_t)(16 * ks + i) * 128 + v] : 0.f;
    for (int t0 = 0; t0 < T; t0 += 16) {
        const int nb = (T - t0) < 16 ? (T - t0) : 16;
        __syncthreads();
        for (int tt = 0; tt < nb; ++tt) {
            const size_t row = (size_t)(row0 + t0 + tt);
            const float* ap = GA + row * 256 + h * 64 + 16 * ks; const v4u kw0 = *(const v4u*)(GK + row * 256 + h * 64 + 16 * ks), kw1 = *(const v4u*)(GK + row * 256 + h * 64 + 16 * ks + 8);
            const v4u qw0 = *(const v4u*)(GQ + row * 256 + h * 64 + 16 * ks), qw1 = *(const v4u*)(GQ + row * 256 + h * 64 + 16 * ks + 8);
            const float vv = bf2f(GV[row * 512 + h * 128 + v]);
            const f32x4 a0 = *(const f32x4*)ap, a1 = *(const f32x4*)(ap + 4), a2 = *(const f32x4*)(ap + 8), a3 = *(const f32x4*)(ap + 12);
            const float la[16] = {a0.x, a0.y, a0.z, a0.w, a1.x, a1.y, a1.z, a1.w, a2.x, a2.y, a2.z, a2.w, a3.x, a3.y, a3.z, a3.w};
            const float kk[16] = {bflo(kw0.x), bfhi(kw0.x), bflo(kw0.y), bfhi(kw0.y), bflo(kw0.z), bfhi(kw0.z), bflo(kw0.w), bfhi(kw0.w), bflo(kw1.x), bfhi(kw1.x), bflo(kw1.y), bfhi(kw1.y), bflo(kw1.z), bfhi(kw1.z), bflo(kw1.w), bfhi(kw1.w)};
            const float qq[16] = {bflo(qw0.x), bfhi(qw0.x), bflo(qw0.y), bfhi(qw0.y), bflo(qw0.z), bfhi(qw0.z), bflo(qw0.w), bfhi(qw0.w), bflo(qw1.x), bfhi(qw1.x), bflo(qw1.y), bfhi(qw1.y), bflo(qw1.z), bfhi(qw1.z), bflo(qw1.w), bfhi(qw1.w)};
            float o = 0.f;
#pragma unroll
            for (int i = 0; i < 16; ++i) { S[i] = fast_exp2(la[i] * 1.4426950408889634f) * S[i] + kk[i] * vv; o += qq[i] * S[i]; }
            part[(tt * 4 + ks) * 128 + v] = o;
        }
        __syncthreads();
        for (int e = tid; e < nb * 128; e += 512) { const int tt = e >> 7, vv_ = e & 127;
            GO[(size_t)(row0 + t0 + tt) * 512 + h * 128 + vv_] = (bf16)f2bf((part[(tt * 4 + 0) * 128 + vv_] + part[(tt * 4 + 1) * 128 + vv_]) + (part[(tt * 4 + 2) * 128 + vv_] + part[(tt * 4 + 3) * 128 + vv_])); }
    }
#pragma unroll
    for (int i = 0; i < 16; ++i) Sout[(size_t)(16 * ks + i) * 128 + v] = S[i];
}
constexpr int GL_QE = 0, GL_KE = 8192, GL_KDT = 16384, GL_VV = 24576, GL_EB = 40960, GL_TOT = 41216, GL_SET = 43264;
__device__ __forceinline__ int goff(int r, int c) { return 128 * r + 16 * (c ^ ((r >> 1) & 7)); }
__device__ __forceinline__ int gvoff(int row, int ch) { return 256 * row + 16 * (ch ^ (((row & 3) | ((((row >> 2) ^ (row >> 3)) & 1) << 2)) << 1)); }
__device__ __forceinline__ void p4_gla_chain_mfma(const Frame& F, int c) {
    unsigned char* ws = F.ws; const int tid = F.tid, lane = F.lane, w = F.wave, l15 = lane & 15, g4 = lane >> 4, q4 = l15 >> 2, p4 = lane & 3;
    const int b = c >> 2, h = c & 3; const size_t row0 = (size_t)b * SEQ;
    const float* GA = (const float*)(ws + WS_GA) + h * 64 + lane; const bf16* GQ = (const bf16*)(ws + WS_GQ) + h * 64 + lane; const bf16* GK = (const bf16*)(ws + WS_GK) + h * 64 + lane;
    const bf16* GV = (const bf16*)(ws + WS_GV) + h * 128 + (tid & 15) * 8; bf16* GO = (bf16*)(ws + WS_GO) + h * 128 + 16 * w + 4 * g4;
    constexpr float L2E = 1.4426950408889634f;
    f32x4 S[4];
#pragma unroll
    for (int K = 0; K < 4; ++K) S[K] = (f32x4){0.f, 0.f, 0.f, 0.f};
    float la[8]; unsigned short qh[8], kh[8]; v4u vr[2];
#define GLA_LOAD(ch) do { const size_t r_ = row0 + 64 * (size_t)(ch); \
        _Pragma("unroll") for (int t = 0; t < 8; ++t) { const size_t rr_ = (r_ + 8 * w + t) * 256; la[t] = GA[rr_]; qh[t] = GQ[rr_]; kh[t] = GK[rr_]; } \
        _Pragma("unroll") for (int e = 0; e < 2; ++e) vr[e] = *(const v4u*)(GV + (r_ + (tid >> 4) + 32 * e) * 512); } while (0)
    GLA_LOAD(0);
#pragma unroll 1
    for (int ch = 0; ch < SEQ / 64; ++ch) {
        LAS unsigned char* B = F.lds + RING_OFF + (ch & 1) * GL_SET;
        LAS float* TOT = (LAS float*)(B + GL_TOT); LAS float* EB = (LAS float*)(B + GL_EB);
        float cs[8], qv[8], kvv[8];
        cs[0] = la[0];
#pragma unroll
        for (int t = 1; t < 8; ++t) cs[t] = cs[t - 1] + la[t];
#pragma unroll
        for (int t = 0; t < 8; ++t) { qv[t] = bf2f(qh[t]); kvv[t] = bf2f(kh[t]); }
        TOT[w * 64 + lane] = cs[7];
#pragma unroll
        for (int e = 0; e < 2; ++e) *(LAS v4u*)(B + GL_VV + gvoff((tid >> 4) + 32 * e, tid & 15)) = vr[e];
        __syncthreads();
        float offs = 0.f, total = 0.f;
#pragma unroll
        for (int g = 0; g < 8; ++g) { const float tg = TOT[g * 64 + lane]; total += tg; offs += (g < w) ? tg : 0.f; }
        unsigned kd[8];
#pragma unroll
        for (int t = 0; t < 8; ++t) { const float bt = offs + cs[t]; const int i = 8 * w + t;
            const float e1 = fast_exp2(bt * L2E), e2 = fast_exp2(-bt * L2E), e3 = fast_exp2((total - bt) * L2E);
            *(LAS unsigned short*)(B + GL_QE + goff(i, lane >> 3) + 2 * (lane & 7)) = (unsigned short)f2bf(qv[t] * e1);
            *(LAS unsigned short*)(B + GL_KE + goff(i, lane >> 3) + 2 * (lane & 7)) = (unsigned short)f2bf(kvv[t] * e2);
            kd[t] = f2bf(kvv[t] * e3); }
        { v4u kw; kw.x = kd[0] | (kd[1] << 16); kw.y = kd[2] | (kd[3] << 16); kw.z = kd[4] | (kd[5] << 16); kw.w = kd[6] | (kd[7] << 16); *(LAS v4u*)(B + GL_KDT + goff(lane, w)) = kw; }
        if (w == 0) EB[lane] = fast_exp2(total * L2E);
        if (ch + 1 < SEQ / 64) GLA_LOAD(ch + 1);
        __syncthreads();
        const LAS unsigned char* QE = B + GL_QE; const LAS unsigned char* KE = B + GL_KE; const LAS unsigned char* KDT = B + GL_KDT; const LAS unsigned char* VV = B + GL_VV;
        bf16x8 kef[4][2];
#pragma unroll
        for (int J = 0; J < 4; ++J)
#pragma unroll
            for (int s = 0; s < 2; ++s) kef[J][s] = *(const LAS bf16x8*)(KE + goff(16 * J + l15, 4 * s + g4));
        bf16x8 vpr[2], vnat[2];
#pragma unroll
        for (int pp = 0; pp < 2; ++pp) { const int ra = 32 * pp + 4 * g4 + q4, rb = ra + 16;
            const s16x4 t1 = vtr(VV + gvoff(ra, 2 * w + (p4 >> 1)) + 8 * (p4 & 1)), t2 = vtr(VV + gvoff(rb, 2 * w + (p4 >> 1)) + 8 * (p4 & 1));
            vpr[pp] = (bf16x8){t1[0], t1[1], t1[2], t1[3], t2[0], t2[1], t2[2], t2[3]}; }
#pragma unroll
        for (int s = 0; s < 2; ++s) { const int r1 = 32 * s + 8 * g4 + q4, r2 = r1 + 4;
            const s16x4 t1 = vtr(VV + gvoff(r1, 2 * w + (p4 >> 1)) + 8 * (p4 & 1)), t2 = vtr(VV + gvoff(r2, 2 * w + (p4 >> 1)) + 8 * (p4 & 1));
            vnat[s] = (bf16x8){t1[0], t1[1], t1[2], t1[3], t2[0], t2[1], t2[2], t2[3]}; }
        bf16x8 sfr[2];
#pragma unroll
        for (int p = 0; p < 2; ++p) { v4u sw; sw.x = cvt_pk_bf16(S[2 * p].x, S[2 * p].y); sw.y = cvt_pk_bf16(S[2 * p].z, S[2 * p].w); sw.z = cvt_pk_bf16(S[2 * p + 1].x, S[2 * p + 1].y); sw.w = cvt_pk_bf16(S[2 * p + 1].z, S[2 * p + 1].w); sfr[p] = __builtin_bit_cast(bf16x8, sw); }
#pragma unroll
        for (int I = 0; I < 4; ++I) {
            f32x4 oT = (f32x4){0.f, 0.f, 0.f, 0.f};
#pragma unroll
            for (int p = 0; p < 2; ++p) {
                const v2u lo = *(const LAS v2u*)(QE + goff(16 * I + l15, 4 * p + (g4 >> 1)) + 8 * (g4 & 1)), hi = *(const LAS v2u*)(QE + goff(16 * I + l15, 4 * p + 2 + (g4 >> 1)) + 8 * (g4 & 1));
                const v4u bw = {lo.x, lo.y, hi.x, hi.y};
                oT = __builtin_amdgcn_mfma_f32_16x16x32_bf16(sfr[p], __builtin_bit_cast(bf16x8, bw), oT, 0, 0, 0); }
            bf16x8 qef[2];
#pragma unroll
            for (int s = 0; s < 2; ++s) qef[s] = *(const LAS bf16x8*)(QE + goff(16 * I + l15, 4 * s + g4));
            f32x4 d1[4];
#pragma unroll
            for (int J = 0; J < 4; ++J) { d1[J] = (f32x4){0.f, 0.f, 0.f, 0.f};
                if (J <= I) {
#pragma unroll
                    for (int s = 0; s < 2; ++s) d1[J] = __builtin_amdgcn_mfma_f32_16x16x32_bf16(kef[J][s], qef[s], d1[J], 0, 0, 0);
                    if (J == I) {
#pragma unroll
                        for (int r = 0; r < 4; ++r) d1[J][r] = (4 * g4 + r <= l15) ? d1[J][r] : 0.f; } } }
#pragma unroll
            for (int pp = 0; pp < 2; ++pp) if (2 * pp <= I) {
                const f32x4 pa = d1[2 * pp], pb = d1[2 * pp + 1];
                v4u pw; pw.x = cvt_pk_bf16(pa.x, pa.y); pw.y = cvt_pk_bf16(pa.z, pa.w); pw.z = cvt_pk_bf16(pb.x, pb.y); pw.w = cvt_pk_bf16(pb.z, pb.w);
                oT = __builtin_amdgcn_mfma_f32_16x16x32_bf16(vpr[pp], __builtin_bit_cast(bf16x8, pw), oT, 0, 0, 0); }
            { v2u ow; ow.x = cvt_pk_bf16(oT.x, oT.y); ow.y = cvt_pk_bf16(oT.z, oT.w); *(v2u*)(GO + (row0 + 64 * (size_t)ch + 16 * I + l15) * 512) = ow; }
        }
#pragma unroll
        for (int K = 0; K < 4; ++K) {
            const f32x4 ebv = *(const LAS f32x4*)(EB + 16 * K + 4 * g4); S[K] *= ebv;
#pragma unroll
            for (int s = 0; s < 2; ++s) { const bf16x8 kdf = *(const LAS bf16x8*)(KDT + goff(16 * K + l15, 4 * s + g4)); S[K] = __builtin_amdgcn_mfma_f32_16x16x32_bf16(kdf, vnat[s], S[K], 0, 0, 0); } }
    }
#undef GLA_LOAD
    float* so = F.out + O_GLAP + (size_t)c * 64 * 128 + 16 * w + l15;
#pragma unroll
    for (int K = 0; K < 4; ++K)
#pragma unroll
        for (int r = 0; r < 4; ++r) so[(size_t)(16 * K + 4 * g4 + r) * 128] = S[K][r];
}
template <int NR> __device__ __forceinline__ void p5_combine_rows(const Frame& F, int row0, int rstride) {
    unsigned char* ws = F.ws; const int lane = F.lane, hh = lane >> 4, sub = lane & 15, col = hh * 128 + 8 * sub;
    float l0[NR], l1[NR], l2[NR]; v4u a[NR], b[NR], c[NR], gow[NR], gr[NR];
    const float* gg = F.i15 + 8 * sub; const f32x4 g0 = *(const f32x4*)gg, g1 = *(const f32x4*)(gg + 4);
#pragma unroll
    for (int r = 0; r < NR; ++r) { const int row = row0 + r * rstride;
        const float* lse = (const float*)(ws + WS_LSE) + (size_t)row * 12; l0[r] = lse[hh]; l1[r] = lse[4 + hh]; l2[r] = lse[8 + hh];
        const bf16* og = (const bf16*)(ws + WS_OG) + (size_t)row * 1536 + col; a[r] = *(const v4u*)og; b[r] = *(const v4u*)(og + 512); c[r] = *(const v4u*)(og + 1024);
        gow[r] = *(const v4u*)((const bf16*)(ws + WS_GO) + (size_t)row * 512 + col); gr[r] = *(const v4u*)((const bf16*)(ws + WS_GRS) + (size_t)row * 512 + col); }
#pragma unroll
    for (int r = 0; r < NR; ++r) { const int row = row0 + r * rstride;
        const float mx = fmaxf(l0[r], fmaxf(l1[r], l2[r]));
        float w0 = __expf(l0[r] - mx), w1 = __expf(l1[r] - mx), w2 = __expf(l2[r] - mx); const float wi = 1.0f / (w0 + w1 + w2); w0 *= wi; w1 *= wi; w2 *= wi;
        v4u o;
        o.x = cvt_pk_bf16(w0 * bflo(a[r].x) + w1 * bflo(b[r].x) + w2 * bflo(c[r].x), w0 * bfhi(a[r].x) + w1 * bfhi(b[r].x) + w2 * bfhi(c[r].x));
        o.y = cvt_pk_bf16(w0 * bflo(a[r].y) + w1 * bflo(b[r].y) + w2 * bflo(c[r].y), w0 * bfhi(a[r].y) + w1 * bfhi(b[r].y) + w2 * bfhi(c[r].y));
        o.z = cvt_pk_bf16(w0 * bflo(a[r].z) + w1 * bflo(b[r].z) + w2 * bflo(c[r].z), w0 * bfhi(a[r].z) + w1 * bfhi(b[r].z) + w2 * bfhi(c[r].z));
        o.w = cvt_pk_bf16(w0 * bflo(a[r].w) + w1 * bflo(b[r].w) + w2 * bflo(c[r].w), w0 * bfhi(a[r].w) + w1 * bfhi(b[r].w) + w2 * bfhi(c[r].w));
        bf16* oall = (bf16*)(ws + WS_OALL) + (size_t)row * 1536;
        *(v4u*)(oall + col) = o;
        const f32x4 x0 = {bflo(gow[r].x), bfhi(gow[r].x), bflo(gow[r].y), bfhi(gow[r].y)}, x1 = {bflo(gow[r].z), bfhi(gow[r].z), bflo(gow[r].w), bfhi(gow[r].w)};
        float ss = (x0.x * x0.x + x0.y * x0.y) + (x0.z * x0.z + x0.w * x0.w) + (x1.x * x1.x + x1.y * x1.y) + (x1.z * x1.z + x1.w * x1.w);
        ss += __shfl_xor(ss, 1); ss += __shfl_xor(ss, 2); ss += __shfl_xor(ss, 4); ss += __shfl_xor(ss, 8);
        const float rstd = 1.0f / sqrtf(ss * (1.f / 128.f) + EPS);
        v4u y;
        y.x = cvt_pk_bf16(x0.x * rstd * g0.x * bflo(gr[r].x), x0.y * rstd * g0.y * bfhi(gr[r].x)); y.y = cvt_pk_bf16(x0.z * rstd * g0.z * bflo(gr[r].y), x0.w * rstd * g0.w * bfhi(gr[r].y));
        y.z = cvt_pk_bf16(x1.x * rstd * g1.x * bflo(gr[r].z), x1.y * rstd * g1.y * bfhi(gr[r].z)); y.w = cvt_pk_bf16(x1.z * rstd * g1.z * bflo(gr[r].w), x1.w * rstd * g1.w * bfhi(gr[r].w));
        *(v4u*)(oall + 512 + col) = y; }
}
template <int NR> __device__ __forceinline__ void p10_final_rows(const Frame& F, int row0, int rstride) {
    const GAS f32x4* gr = (const GAS f32x4*)F.i24 + 2 * F.lane; const f32x4 g00 = gr[0], g01 = gr[1], g10 = gr[128], g11 = gr[129];
    v4u v[NR][2];
#pragma unroll
    for (int r = 0; r < NR; ++r) { const GAS v4u* xr = (const GAS v4u*)((const bf16*)(F.ws + WS_Y16) + (size_t)(row0 + r * rstride) * D) + F.lane; v[r][0] = xr[0]; v[r][1] = xr[64]; }
#pragma unroll
    for (int r = 0; r < NR; ++r) { float x[2][8]; float s = 0.f;
#pragma unroll
        for (int j = 0; j < 2; ++j) { x[j][0] = bflo(v[r][j].x); x[j][1] = bfhi(v[r][j].x); x[j][2] = bflo(v[r][j].y); x[j][3] = bfhi(v[r][j].y); x[j][4] = bflo(v[r][j].z); x[j][5] = bfhi(v[r][j].z); x[j][6] = bflo(v[r][j].w); x[j][7] = bfhi(v[r][j].w);
#pragma unroll
            for (int e = 0; e < 8; ++e) s += x[j][e] * x[j][e]; }
        const float rstd = 1.0f / sqrtf(wave_sum(s) * (1.f / D) + EPS);
        GAS f32x4* yr = (GAS f32x4*)(F.out + (size_t)(row0 + r * rstride) * D) + 2 * F.lane;
        yr[0] = (f32x4){x[0][0] * rstd * g00.x, x[0][1] * rstd * g00.y, x[0][2] * rstd * g00.z, x[0][3] * rstd * g00.w};
        yr[1] = (f32x4){x[0][4] * rstd * g01.x, x[0][5] * rstd * g01.y, x[0][6] * rstd * g01.z, x[0][7] * rstd * g01.w};
        yr[128] = (f32x4){x[1][0] * rstd * g10.x, x[1][1] * rstd * g10.y, x[1][2] * rstd * g10.z, x[1][3] * rstd * g10.w};
        yr[129] = (f32x4){x[1][4] * rstd * g11.x, x[1][5] * rstd * g11.y, x[1][6] * rstd * g11.z, x[1][7] * rstd * g11.w}; }
}
__device__ __forceinline__ void phase1(Frame& F) {
    unsigned char* ws = F.ws; const int G = F.G, bx = (int)blockIdx.x;
    { pg8::Gemm g{(const bf16*)(ws + WS_XB), (const bf16*)(ws + WS_W1A), MR, 2 * FF, D, D, D}; typedef pg8::StaticOrderT<MR / 256, 2 * FF / 256> SO; SO S; S.init(MR, 2 * FF, G, bx);
      EpiSwiglu E{(bf16*)(ws + WS_G), nullptr}; pg8::gemm_phase<EpiSwiglu, SO>(F.lds + RING_OFF, g, S, E, F.wave, MK_STAGGER_A); }
    { pg8::Gemm g{(const bf16*)(ws + WS_MEMB), (const bf16*)(ws + WS_WMEM), MM, D, D, D, D}; typedef pg8::StaticOrderT<MM / 256, D / 256> SO; SO S; S.init(MM, D, G, (bx + G / 2) % G);
      EpiMemKV E{F.out + O_MEMKV, (bf16*)(ws + WS_MKV)}; pg8::gemm_phase<EpiMemKV, SO>(F.lds + RING_OFF, g, S, E, F.wave); }
}
__device__ __forceinline__ void phase2(Frame& F) {
    unsigned char* ws = F.ws; const int G = F.G, bx = (int)blockIdx.x;
    pg8::Gemm g{(const bf16*)(ws + WS_G), (const bf16*)(ws + WS_W1O), MR, D, FF, 64, FF};   typedef pg8::StaticOrderT<MR / 256, D / 256> SO; SO S; S.init(MR, D, G, bx);
    EpiResidX<true> E{F.i0, F.i1, (bf16*)(ws + WS_HB), (float*)(ws + WS_PQ1), 0.5f};
    S.lim = 1024; S.rev = 1; pg8::gemm_phase<EpiResidX<true>, SO, true, true>(F.lds + RING_OFF, g, S, E, F.wave);
    tail_phase<EpiResidX<true>, true>(F, g.A, 64, g.Bt, FF, FF, E, 0);
}
__device__ __forceinline__ void phase3(Frame& F) {
    unsigned char* ws = F.ws; const int G = F.G, bx = (int)blockIdx.x;
    pg8::Gemm g{(const bf16*)(ws + WS_HB), (const bf16*)(ws + WS_WIN), MR, NZ, D, D, D}; typedef pg8::StaticOrderT<MR / 256, NZ / 256> SO; SO S; S.init(MR, NZ, G, bx);
    EpiZ E{(const float*)(ws + WS_PQ1), (const float*)(ws + WS_ROPE), (const float*)(ws + WS_ROPE) + NPOS * 64, F.i14, F.out,
           (bf16*)(ws + WS_QS), (bf16*)(ws + WS_KS), (bf16*)(ws + WS_VS), (bf16*)(ws + WS_GQ), (bf16*)(ws + WS_GK), (bf16*)(ws + WS_GV), (bf16*)(ws + WS_GRS), (bf16*)(ws + WS_MQ), (bf16*)(ws + WS_GATE), (float*)(ws + WS_GA)};
    pg8::gemm_phase<EpiZ, SO>(F.lds + RING_OFF, g, S, E, F.wave, MK_STAGGER_Z);
}
constexpr int CW_Q = 64;
__device__ __forceinline__ int q_pull(const Frame& F, int q) {
    gu32* qw = (gu32*)(F.ws + WS_CTL) + CW_Q + 64 * q;
    volatile LAS unsigned* slot = (volatile LAS unsigned*)(F.lds + MISC_OFF) + 16;
    __syncthreads();
    if (F.tid == 0) *slot = __hip_atomic_fetch_add(qw, 1u, RLX_AGENT);
    __syncthreads();
    return (int)*slot;
}
__device__ __forceinline__ void phase4(Frame& F, const float* c0, const float* c1, const float* c2, const float* cm) {
    const int bx = (int)blockIdx.x;
    if (bx < NB * 4) p4_gla_chain_mfma(F, bx);
    else p4_sample_loop(F, c0, c1, c2, cm);
#pragma unroll 1
    for (int rep = 0; rep < (MK_P4_REPEAT == 2 ? 2 : 1); ++rep) for (;;) { const int it = q_pull(F, 1 + 4 * rep); if (it >= 768) break; attn_batch<0, 8>(F, 8 * (767 - it)); }
#pragma unroll 1
    for (int rep = 0; rep < (MK_P4_REPEAT == 3 ? 2 : 1); ++rep) for (;;) { const int it = q_pull(F, 2 + 4 * rep); if (it >= 256) break; attn_batch<1, 8>(F, 6144 + 8 * (255 - it)); }
    p4_sample_loop(F, c0, c1, c2, cm);
    if (MK_P4_REPEAT == 1) { __syncthreads(); p4_sample_loop(F, c0, c1, c2, cm, 4); }
    if (MK_P4_REPEAT == 4) { __syncthreads(); if (bx < NB * 4) p4_gla_chain_mfma(F, bx); }
    if (MK_P4_REPEAT == 5) { for (;;) { const int c = q_pull(F, 7); if (c >= DECB * 4) break; p4_gla_chain(F, MP + (c >> 2) * DECT, DECT, c & 3, F.i7 + (size_t)c * 64 * 128, F.out + O_GLAS + (size_t)c * 64 * 128); } }
    for (;;) { const int c = q_pull(F, 3); if (c >= DECB * 4) break; p4_gla_chain(F, MP + (c >> 2) * DECT, DECT, c & 3, F.i7 + (size_t)c * 64 * 128, F.out + O_GLAS + (size_t)c * 64 * 128); }
    if (F.G < NB * 4) { for (int c = F.G + bx; c < NB * 4; c += F.G) p4_gla_chain_mfma(F, c); }
}
__device__ __forceinline__ void phase5(Frame& F) {
    { const int st = F.G * NWAVES; int m = F.vcu * NWAVES + F.wave;
      for (; m + 3 * st < MR; m += 4 * st) p5_combine_rows<4>(F, m, st);
      for (; m < MR; m += st) p5_combine_rows<1>(F, m, st); }
}
__device__ __forceinline__ void phase6(Frame& F) {
    unsigned char* ws = F.ws; const int G = F.G, bx = (int)blockIdx.x;
    pg8::Gemm g{(const bf16*)(ws + WS_OALL), (const bf16*)(ws + WS_WBR), MR, D, 1536, 1536, 1536}; typedef pg8::StaticOrderT<MR / 256, D / 256> SO; SO S; S.init(MR, D, G, bx);
    S.lim = 1024; S.rev = 1; EpiMerge1 E{(const bf16*)(ws + WS_GATE), (bf16*)(ws + WS_MB)}; pg8::gemm_phase<EpiMerge1, SO>(F.lds + RING_OFF, g, S, E, F.wave);
    tail_phase_merge(F, g.A, g.Bt, E, 3);
}
__device__ __forceinline__ void phase7(Frame& F) {
    unsigned char* ws = F.ws; const int G = F.G, bx = (int)blockIdx.x;
    pg8::Gemm g{(const bf16*)(ws + WS_MB), (const bf16*)(ws + WS_WOUT), MR, D, D, D, D}; typedef pg8::StaticOrderT<MR / 256, D / 256> SO; SO S; S.init(MR, D, G, bx);
    EpiResidB<true> E{(const bf16*)(ws + WS_HB), (bf16*)(ws + WS_HB), (float*)(ws + WS_PQ2), 1.0f};
    S.lim = 1024; pg8::gemm_phase<EpiResidB<true>, SO>(F.lds + RING_OFF, g, S, E, F.wave);
    tail_phase<EpiResidB<true>>(F, g.A, D, g.Bt, D, D, E, 1);
}
__device__ __forceinline__ void phase8(Frame& F) {
    unsigned char* ws = F.ws; const int G = F.G, bx = (int)blockIdx.x;
    pg8::Gemm g{(const bf16*)(ws + WS_HB), (const bf16*)(ws + WS_W2A), MR, 2 * FF, D, D, D}; typedef pg8::StaticOrderT<MR / 256, 2 * FF / 256> SO; SO S; S.init(MR, 2 * FF, G, bx);
    EpiSwiglu E{(bf16*)(ws + WS_G), (const float*)(ws + WS_PQ2)}; pg8::gemm_phase<EpiSwiglu, SO>(F.lds + RING_OFF, g, S, E, F.wave, MK_STAGGER_A);
}
__device__ __forceinline__ void phase9(Frame& F) {
    unsigned char* ws = F.ws; const int G = F.G, bx = (int)blockIdx.x;
    pg8::Gemm g{(const bf16*)(ws + WS_G), (const bf16*)(ws + WS_W2O), MR, D, FF, 64, FF};   typedef pg8::StaticOrderT<MR / 256, D / 256> SO; SO S; S.init(MR, D, G, bx);
    EpiResidB<false> E{(const bf16*)(ws + WS_HB), (bf16*)(ws + WS_Y16), nullptr, 0.5f};
    S.lim = 1024; S.rev = 1; pg8::gemm_phase<EpiResidB<false>, SO, true, true>(F.lds + RING_OFF, g, S, E, F.wave);
    tail_phase<EpiResidB<false>, true>(F, g.A, 64, g.Bt, FF, FF, E, 2);
}
__device__ __forceinline__ void phase10(Frame& F) {
    { const int st = F.G * NWAVES; int m = F.vcu * NWAVES + F.wave;
      for (; m + 3 * st < MR; m += 4 * st) p10_final_rows<4>(F, m, st);
      for (; m < MR; m += st) p10_final_rows<1>(F, m, st); }
}
__device__ __forceinline__ void xcd_barrier_or_skip(const XcdBarrier& b, bool on, int wave) { if (on) xcd_barrier(b, wave); }
constexpr int N_PHASES = 11;
__global__ void __launch_bounds__(NWAVES * 64, 2) mk_fwd(Args args) {
    extern __shared__ __attribute__((aligned(16))) unsigned char lds[];
    Frame F;
    F.lds = (LAS unsigned char*)lds;
    F.wave = __builtin_amdgcn_readfirstlane((int)(threadIdx.x >> 6)); F.lane = lane_id(); F.tid = F.wave * 64 + F.lane;
    F.G = gridDim.x; { const int bx = blockIdx.x; F.vcu = (F.G % 8 == 0) ? (bx % 8) * (F.G / 8) + bx / 8 : bx; }
    F.i0 = args.in[0]; F.i1 = args.in[1]; F.i2 = args.in[2]; F.i3 = args.in[3]; F.i4 = args.in[4]; F.i5 = args.in[5]; F.i6 = args.in[6]; F.i7 = args.in[7]; F.i8 = args.in[8]; F.i9 = args.in[9]; F.i10 = args.in[10]; F.i11 = args.in[11]; F.i12 = args.in[12]; F.i13 = args.in[13]; F.i14 = args.in[14]; F.i15 = args.in[15]; F.i16 = args.in[16]; F.i17 = args.in[17]; F.i18 = args.in[18]; F.i19 = args.in[19]; F.i20 = args.in[20]; F.i21 = args.in[21]; F.i22 = args.in[22]; F.i23 = args.in[23]; F.i24 = args.in[24];
    F.out = args.out; F.ws = args.ws;
    unsigned char* ws = args.ws; gu32* ctl = (gu32*)(ws + WS_CTL);
    volatile LAS unsigned* MISC = (volatile LAS unsigned*)(F.lds + MISC_OFF);
    for (int u = F.tid; u < (LDS_BYTES - LDSCTL_OFF) / 4; u += NWAVES * 64) ((LAS unsigned*)(F.lds + LDSCTL_OFF))[u] = 0u;
    __syncthreads();
    XcdBarrier bar; bar.bar = (unsigned*)(ctl + CW_BAR); bar.x = 0; bar.st = nullptr;
    if (MK_N_LAUNCHES == 1) bar = xcd_barrier_post((unsigned*)(ctl + CW_BAR), MISC + 8, F.wave);
    const int lo = args.ph_lo, hi = args.ph_hi;
#define IN(k) (lo <= (k) && (k) < hi && (k) <= MK_STOP_AFTER)
#define GRID_BAR(k) do { if (IN((k) + 1)) xcd_barrier(bar, F.wave); } while (0)

#define RUN(k, call) do { if (IN(k)) { F.lane = lane_id(); F.tid = F.wave * 64 + F.lane; call; if (MK_REPEAT_PHASE == (k)) { xcd_barrier_or_skip(bar, MK_N_LAUNCHES == 1, F.wave); call; } GRID_BAR(k); } } while (0)
    RUN(0, p0_prologue(F));
    RUN(1, phase1(F));
    RUN(2, phase2(F));
    RUN(3, phase3(F));
    RUN(4, phase4(F, args.in[3], args.in[4], args.in[5], args.in[6]));
    RUN(5, phase5(F));
    RUN(6, phase6(F));
    RUN(7, phase7(F));
    RUN(8, phase8(F));
    RUN(9, phase9(F));
    if (IN(10)) { F.lane = lane_id(); F.tid = F.wave * 64 + F.lane; phase10(F); }
#undef RUN
#if MK_STOP_AFTER < 10
    if (hi == N_PHASES) {
        for (int m = F.vcu * NWAVES + F.wave; m < MR; m += G * NWAVES) {
            for (int c = F.lane; c < D; c += 64) {
                float v;
                if (MK_STOP_AFTER == 0) v = bf2f(((const bf16*)(ws + WS_WIN))[(size_t)(m % NZ) * D + c]);
                else if (MK_STOP_AFTER == 3) { const bf16* gt = (const bf16*)(ws + WS_GATE) + (size_t)m * 3072; v = bf2f(gt[c]) + bf2f(gt[1024 + c]) + bf2f(gt[2048 + c]); }
                else if (MK_STOP_AFTER <= 5) { const bf16* oa = (const bf16*)(ws + WS_OALL) + (size_t)m * 1536; v = bf2f(oa[c]) + bf2f(oa[1024 + (c & 511)]); }
                else if (MK_STOP_AFTER == 6) v = bf2f(((const bf16*)(ws + WS_MB))[(size_t)m * D + c]);
                else if (MK_STOP_AFTER == 7) v = ((const float*)(ws + WS_H))[(size_t)m * D + c];
                else v = bf2f(((const bf16*)(ws + WS_G))[(size_t)m * FF + c]) + bf2f(((const bf16*)(ws + WS_G))[(size_t)m * FF + 1792 + c]);
                F.out[(size_t)m * D + c] = v;
            }
        }
    }
#endif
#undef IN
#undef GRID_BAR
}

extern "C" void kernel_launch(void* const* d_in, const int* in_sizes, int n_in, void* d_out, int out_size, void* d_ws, size_t ws_size, hipStream_t stream) {
    static int grid = 0;
    if (grid == 0) {
        if (n_in != 25 || (size_t)out_size != O_END || ws_size < WS_END2) { fprintf(stderr, "kernel_launch: unexpected shapes: n_in %d out %d ws %zu (need %zu); nothing launched\n", n_in, out_size, ws_size, (size_t)WS_END2); grid = -1; return; }
        int dev = 0, cus = 0, per_cu = 0;
        if (hipGetDevice(&dev) != hipSuccess || hipDeviceGetAttribute(&cus, hipDeviceAttributeMultiprocessorCount, dev) != hipSuccess) { grid = -1; return; }
        if (hipFuncSetAttribute((const void*)mk_fwd, hipFuncAttributeMaxDynamicSharedMemorySize, LDS_BYTES) != hipSuccess) { fprintf(stderr, "kernel_launch: hipFuncSetAttribute failed\n"); grid = -1; return; }
        if (hipOccupancyMaxActiveBlocksPerMultiprocessor(&per_cu, (const void*)mk_fwd, NWAVES * 64, LDS_BYTES) != hipSuccess || per_cu < 1) fprintf(stderr, "kernel_launch: occupancy query reports %d\n", per_cu);
        (void)hipGetLastError();
        grid = cus;
    }
    if (grid < 0) return;
    if (hipMemsetAsync((char*)d_ws + WS_CTL, 0, CTL_ZERO_BYTES, stream) != hipSuccess) return;
    Args a{};
    for (int i = 0; i < 25; ++i) a.in[i] = (const float*)d_in[i];
    a.out = (float*)d_out; a.ws = (unsigned char*)d_ws; a.pad = 0;
    for (int li = 0; li < MK_N_LAUNCHES; ++li) {
        a.ph_lo = (MK_N_LAUNCHES == 1) ? 0 : li; a.ph_hi = (MK_N_LAUNCHES == 1) ? N_PHASES : li + 1; a.li = li;
        hipLaunchKernelGGL(mk_fwd, dim3(grid), dim3(NWAVES * 64), LDS_BYTES, stream, a);
        const hipError_t le = hipPeekAtLastError();
        if (le != hipSuccess) { fprintf(stderr, "kernel_launch: launch %d failed: %s\n", li, hipGetErrorName(le)); break; }
    }
}
```

```cpp
#include <hip/hip_runtime.h>
#include <cstdio>
#include <cstdint>

#ifndef MK_N_LAUNCHES
#define MK_N_LAUNCHES 1
#endif

#ifndef MK_REPEAT_PHASE
#define MK_REPEAT_PHASE -1
#endif
#ifndef MK_P4_REPEAT
#define MK_P4_REPEAT 0
#endif
#ifndef MK_STAGGER_A
#ifndef MK_WGM_N
#define MK_WGM_N 2
#endif
#ifndef MK_WGM_A
#define MK_WGM_A 4
#endif
#ifndef MK_WGM_Z
#define MK_WGM_Z 2
#endif
#define MK_STAGGER_A 0
#endif
#ifndef MK_STAGGER_Z
#define MK_STAGGER_Z 0
#endif
#ifndef MK_STOP_AFTER
#define MK_STOP_AFTER 10
#endif
#define GAS __attribute__((address_space(1)))
#define LAS __attribute__((address_space(3)))
typedef unsigned short bf16;
typedef unsigned v4u __attribute__((ext_vector_type(4)));
typedef unsigned v2u __attribute__((ext_vector_type(2)));
typedef float f32x4 __attribute__((ext_vector_type(4)));
typedef float f32x2 __attribute__((ext_vector_type(2)));
typedef short bf16x8 __attribute__((ext_vector_type(8)));
typedef short s16x4 __attribute__((ext_vector_type(4)));
typedef GAS unsigned gu32;

__device__ __forceinline__ int lane_id() { return (int)__builtin_amdgcn_mbcnt_hi(~0u, __builtin_amdgcn_mbcnt_lo(~0u, 0u)); }
constexpr int D = 1024, NB = 32, SEQ = 2048, DECB = 128, DECT = 4, PAST = 8192, MEML = 256;
constexpr int MP = NB * SEQ;
constexpr int MS = DECB * DECT;
constexpr int MR = MP + MS;
constexpr int MM = NB * MEML;
constexpr int FF = 2816, NZ = 9984;
constexpr int DIN = 6672;
constexpr int NPOS = SEQ + DECT;
constexpr float EPS = 1e-6f;
constexpr float QSCALE = 0.08838834764831845f * 1.4426950408889634f;
constexpr float LN2 = 0.6931471805599453f;

constexpr size_t O_Y = 0, O_YS = (size_t)MP * D, O_SWA0P = O_YS + (size_t)MS * D, O_SWA1P = O_SWA0P + (size_t)NB * 128 * 1024, O_SWA2P = O_SWA1P + (size_t)NB * 512 * 1024,
                 O_MEMKV = O_SWA2P + (size_t)NB * 2048 * 1024, O_GLAP = O_MEMKV + (size_t)MM * 1024, O_SWA0S = O_GLAP + (size_t)NB * 4 * 64 * 128, O_SWA1S = O_SWA0S + (size_t)MS * 1024,
                 O_SWA2S = O_SWA1S + (size_t)MS * 1024, O_GLAS = O_SWA2S + (size_t)MS * 1024, O_END = O_GLAS + (size_t)DECB * 4 * 64 * 128;
static_assert(O_END == 170917888ull, "output size");

constexpr size_t MiB = 1u << 20;
constexpr size_t al(size_t x) { return (x + 2 * MiB - 1) / (2 * MiB) * (2 * MiB); }
constexpr size_t WS_CTL = 0, CTL_ZERO_BYTES = 1 * MiB;
constexpr size_t WS_ROPE = 2 * MiB;
constexpr size_t WS_PQ1 = WS_ROPE + al((size_t)NPOS * 64 * 4 * 2);
constexpr size_t WS_PQ2 = WS_PQ1 + al((size_t)MR * 16 * 4);
constexpr size_t WS_W1A = WS_PQ2 + al((size_t)MR * 16 * 4);
constexpr size_t WS_W1O = WS_W1A + al((size_t)2 * FF * D * 2);
constexpr size_t WS_WIN = WS_W1O + al((size_t)D * FF * 2);
constexpr size_t WS_WBR = WS_WIN + al((size_t)NZ * D * 2);
constexpr size_t WS_WOUT = WS_WBR + al((size_t)3 * D * 512 * 2);
constexpr size_t WS_W2A = WS_WOUT + al((size_t)D * D * 2);
constexpr size_t WS_W2O = WS_W2A + al((size_t)2 * FF * D * 2);
constexpr size_t WS_WMEM = WS_W2O + al((size_t)D * FF * 2);
constexpr size_t WS_XB = WS_WMEM + al((size_t)D * D * 2);
constexpr size_t WS_MEMB = WS_XB + al((size_t)MR * D * 2);
constexpr size_t WS_MKV = WS_MEMB + al((size_t)MM * D * 2);
constexpr size_t WS_G = WS_MKV + al((size_t)MM * D * 2);
constexpr size_t WS_H = WS_G + al((size_t)MR * FF * 2);
constexpr size_t WS_HB = WS_H + al((size_t)MR * D * 4);
constexpr size_t WS_QS = WS_HB + al((size_t)MR * D * 2);
constexpr size_t WS_KS = WS_QS + al((size_t)MR * 1536 * 2);
constexpr size_t WS_VS = WS_KS + al((size_t)MR * 1536 * 2);
constexpr size_t WS_GQ = WS_VS + al((size_t)MR * 1536 * 2);
constexpr size_t WS_GK = WS_GQ + al((size_t)MR * 256 * 2);
constexpr size_t WS_GV = WS_GK + al((size_t)MR * 256 * 2);
constexpr size_t WS_GRS = WS_GV + al((size_t)MR * 512 * 2);
constexpr size_t WS_GA = WS_GRS + al((size_t)MR * 512 * 2);
constexpr size_t WS_MQ = WS_GA + al((size_t)MR * 256 * 4);
constexpr size_t WS_GATE = WS_MQ + al((size_t)MR * 512 * 2);
constexpr size_t WS_OG = WS_GATE + al((size_t)MR * 3072 * 2);
constexpr size_t WS_LSE = WS_OG + al((size_t)MR * 1536 * 2);
constexpr size_t WS_GO = WS_LSE + al((size_t)MR * 12 * 4);
constexpr size_t WS_OALL = WS_GO + al((size_t)MR * 512 * 4);
constexpr size_t WS_END = WS_OALL + al((size_t)MR * 1536 * 2);
constexpr size_t WS_SLAB = WS_END; constexpr size_t WS_END2 = WS_SLAB + al((size_t)8 * 4 * 4 * 8 * 2048 * 4);
constexpr size_t WS_T = WS_G, WS_MB = WS_XB, WS_Y16 = WS_XB;
static_assert((size_t)MR * D * 4 <= (size_t)MR * FF * 2, "T fits in G");

constexpr int CW_TMO = 0, CW_CODE = 1, CW_BAR = 4096, CW_TAIL = 8192;

constexpr int RING_OFF = 0, RING_BYTES = 131072;
constexpr int LDSCTL_OFF = RING_BYTES, MISC_OFF = LDSCTL_OFF + 320;
constexpr int LDS_BYTES = 147456;
constexpr int NWAVES = 8;

#define RLX_AGENT __ATOMIC_RELAXED, __HIP_MEMORY_SCOPE_AGENT
#define LDS_WAIT() asm volatile("s_waitcnt lgkmcnt(0)" ::: "memory")
#define VM_WAIT() asm volatile("s_waitcnt vmcnt(0)" ::: "memory")
__device__ __forceinline__ unsigned f2bf(float f) { unsigned u = __builtin_bit_cast(unsigned, f); return (u + 0x7fffu + ((u >> 16) & 1u)) >> 16; }
__device__ __forceinline__ unsigned pk2(float lo, float hi) { return f2bf(lo) | (f2bf(hi) << 16); }
__device__ __forceinline__ float bf2f(unsigned b) { return __builtin_bit_cast(float, b << 16); }
__device__ __forceinline__ float bflo(unsigned w) { return __builtin_bit_cast(float, w << 16); }
__device__ __forceinline__ float bfhi(unsigned w) { return __builtin_bit_cast(float, w & 0xffff0000u); }
typedef __bf16 bf16x2_t __attribute__((ext_vector_type(2)));
__device__ __forceinline__ unsigned cvt_pk_bf16(float lo, float hi) { const f32x2 v = {lo, hi}; const bf16x2_t b = __builtin_convertvector(v, bf16x2_t); return __builtin_bit_cast(unsigned, b); }
__device__ __forceinline__ float fast_exp2(float x) { return __builtin_amdgcn_exp2f(x); }
__device__ __forceinline__ float fast_rcp(float x) { return __builtin_amdgcn_rcpf(x); }
__device__ __forceinline__ float fast_log2(float x) { return __builtin_amdgcn_logf(x); }
__device__ __forceinline__ float sigmoidf_(float x) { return fast_rcp(1.0f + fast_exp2(-1.4426950408889634f * x)); }
__device__ __forceinline__ float siluf_(float x) { return x * sigmoidf_(x); }
__device__ __forceinline__ int perm32(int rho) { return 8 * ((rho >> 2) & 3) + 4 * (rho >> 4) + (rho & 3); }
__device__ __forceinline__ int sig_plain(int r) { return (r & ~31) + perm32(r & 31); }
__device__ __forceinline__ int sig_rope(int r7) { return 64 * ((r7 >> 4) & 1) + 16 * (r7 >> 5) + 4 * ((r7 >> 2) & 3) + (r7 & 3); }

namespace pg8 {
constexpr int BM = 256, BK = 64, HALF = 128, HTB = HALF * BK * 2, STAGE_BYTES = 8 * HTB, NXCD = 8, WGM = 2;
__host__ __device__ __forceinline__ int lds_byte(int r, int c) { const int st = (r >> 4) * 2 + (c >> 5), rr = r & 15, cc = c & 31, ob = rr * 64 + cc * 2; return st * 1024 + (ob ^ (((ob >> 9) & 1) << 5)); }
__host__ __device__ __forceinline__ void stage_rc(int b, int& R, int& C) { const int st = b / 1024, sb = b % 1024, swz = sb ^ (((sb >> 9) & 1) << 5); R = (st >> 1) * 16 + swz / 64; C = (st & 1) * 32 + (swz % 64) / 2; }
struct Unit { int pm, pn; };
struct Gemm { const bf16* A; const bf16* Bt; int M, N, K, lda, ldb; };
constexpr size_t TILED_KS = (size_t)256 * 64 * 2, TILED_PANEL = (size_t)(2816 / 64) * TILED_KS;
template <int NM, int NN> struct StaticOrderT {
    static constexpr int WGM = NN == 4 ? MK_WGM_N : (NN == 22 ? MK_WGM_A : MK_WGM_Z);
    int G, c, lim, rev;
    __host__ __device__ void init(int, int, int G_, int c_) { G = G_; c = c_; lim = NM * NN; rev = 0; }
    __host__ __device__ static __forceinline__ void unit_of(int L, Unit& u) {
        constexpr int nwg = NM * NN, q = nwg / NXCD, r = nwg % NXCD, nig = WGM * NN;
        const int xcd = L & (NXCD - 1), off = L >> 3;
        const int wgid = (xcd < r ? xcd * (q + 1) : r * (q + 1) + (xcd - r) * q) + off;
        const int gid = wgid / nig, x = wgid - gid * nig, fm = gid * WGM;
        if (NM % WGM == 0 || fm + WGM <= NM) { u.pm = fm + (x & (WGM - 1)); u.pn = x / WGM; }
        else { constexpr int gl = (NM % WGM) ? (NM % WGM) : WGM; u.pm = fm + x % gl; u.pn = x / gl; }
    }
    __host__ __device__ __forceinline__ bool next(int i, Unit& u) const { const int L = i * G + c; if (L >= lim) return false; unit_of(rev ? lim - 1 - L : L, u); return true; }
};
struct OneUnit { Unit u; int c; __host__ __device__ __forceinline__ bool next(int i, Unit& o) const { if (i) return false; o = u; return true; } };
template <class Epi, class Sched, bool ALIGN_EPI = true, bool ATILED = false>
__device__ __forceinline__ void gemm_phase(LAS unsigned char* lds, const Gemm g, const Sched& S, const Epi& E, const int wid, const int stagger_ticks = 0) {
    if (stagger_ticks > 0) { const unsigned long long t0 = __builtin_amdgcn_s_memrealtime(); const unsigned long long dl = (unsigned long long)(((S.c * 37) & 255) * stagger_ticks) >> 8;
        while (__builtin_amdgcn_s_memrealtime() - t0 < dl) __builtin_amdgcn_s_sleep(8); }
    const int lane = lane_id(), tid = wid * 64 + lane, wr = wid >> 2, wc = wid & 3, fr = lane & 15, fq = lane >> 4;
    const int K = g.K, nt = K / BK;
    unsigned voffA[2], voffB[2];
#pragma unroll
    for (int i = 0; i < 2; ++i) { int R, C; stage_rc(tid * 16 + i * 8192, R, C); voffA[i] = (unsigned)(R * g.lda + C) * 2u; voffB[i] = (unsigned)(R * g.ldb + C) * 2u; }
    const size_t kstep = (size_t)(BK * 2), kstepA = ATILED ? TILED_KS : kstep;
    const size_t hA = (size_t)HALF * g.lda * 2, tA = ATILED ? TILED_PANEL : 2 * hA, hB = (size_t)HALF * g.ldb * 2, tB = 2 * hB;
    const unsigned ldsw = (unsigned)wid * 1024u;
    const int aoff = lds_byte(wr * 64 + fr, fq * 8), boff = lds_byte(wc * 32 + fr, fq * 8);
#define PG8_SA(b, h) (((b) * 2 + (h)) * HTB)
#define PG8_SB(b, h) ((4 + (b) * 2 + (h)) * HTB)
#define PG8_STAGE(bufoff, gbase, voff) do { _Pragma("unroll") for (int _i = 0; _i < 2; ++_i) \
        __builtin_amdgcn_global_load_lds((const unsigned*)((const char*)(gbase) + (voff)[_i]), (LAS unsigned*)(lds + (bufoff) + ldsw + _i * 8192), 16, 0, 0); } while (0)
#define PG8_LDA(dst, b, h) do { _Pragma("unroll") for (int m = 0; m < 4; ++m) _Pragma("unroll") for (int k = 0; k < 2; ++k) dst[m][k] = *(const LAS bf16x8*)(lds + PG8_SA(b, h) + aoff + m * 2048 + k * 1024); } while (0)
#define PG8_LDB(dst, b, h) do { _Pragma("unroll") for (int n = 0; n < 2; ++n) _Pragma("unroll") for (int k = 0; k < 2; ++k) dst[n][k] = *(const LAS bf16x8*)(lds + PG8_SB(b, h) + boff + n * 2048 + k * 1024); } while (0)
#define PG8_MMA(ai, bj, At, Bt) do { __builtin_amdgcn_s_setprio(1); _Pragma("unroll") for (int m = 0; m < 4; ++m) _Pragma("unroll") for (int n = 0; n < 2; ++n) _Pragma("unroll") for (int k = 0; k < 2; ++k) \
        acc[ai][bj][m][n] = __builtin_amdgcn_mfma_f32_16x16x32_bf16(Bt[n][k], At[m][k], acc[ai][bj][m][n], 0, 0, 0); __builtin_amdgcn_s_setprio(0); } while (0)
#define PG8_WAIT_V(n) asm volatile("s_waitcnt vmcnt(" #n ")" ::: "memory")
#define PG8_WAIT_L(n) asm volatile("s_waitcnt lgkmcnt(" #n ")" ::: "memory")
#define PG8_BAR __builtin_amdgcn_s_barrier()
#define PG8_SCHED __builtin_amdgcn_sched_barrier(0)
    Unit cur, nxt; int ui = 0;
    if (!S.next(0, cur)) return;
    f32x4 acc[2][2][4][2];
#pragma unroll
    for (int a = 0; a < 2; ++a)
#pragma unroll
        for (int b = 0; b < 2; ++b)
#pragma unroll
            for (int m = 0; m < 4; ++m)
#pragma unroll
                for (int n = 0; n < 2; ++n) acc[a][b][m][n] = (f32x4){0.f, 0.f, 0.f, 0.f};
    bf16x8 At[4][2], B0[2][2], B1[2][2];
    const char* cA = (const char*)g.A + (size_t)cur.pm * tA; const char* cB = (const char*)g.Bt + (size_t)cur.pn * tB;
    PG8_STAGE(PG8_SB(0, 0), cB, voffB); PG8_STAGE(PG8_SB(0, 1), cB + hB, voffB); PG8_STAGE(PG8_SA(0, 0), cA, voffA); PG8_STAGE(PG8_SA(0, 1), cA + hA, voffA);
    if (wr == 1) PG8_BAR;
    PG8_WAIT_V(2); PG8_BAR;
    PG8_STAGE(PG8_SB(1, 0), cB + kstep, voffB); PG8_STAGE(PG8_SA(1, 0), cA + kstepA, voffA); PG8_STAGE(PG8_SB(1, 1), cB + hB + kstep, voffB);
    PG8_WAIT_V(6); PG8_BAR;
    for (;;) {
        const bool has_next = S.next(ui + 1, nxt);
        const char* nA = has_next ? (const char*)g.A + (size_t)nxt.pm * tA : cA; const char* nB = has_next ? (const char*)g.Bt + (size_t)nxt.pn * tB : cB;
        const int seg = Epi::HAS_MID ? 8 : nt;
        for (int t0 = 0; t0 < nt; t0 += seg) {
        if constexpr (Epi::HAS_MID) { if (t0) { PG8_SCHED; E.mid(acc, cur, t0, wr, wc, fr, fq); PG8_SCHED; } }
#pragma unroll 1
        for (int t = t0; t < t0 + seg; t += 2) {
            const bool last = (t == nt - 2);
            const char* a1 = cA + (size_t)(t + 1) * kstepA;
            const char* a2 = last ? nA : cA + (size_t)(t + 2) * kstepA; const char* b2 = last ? nB : cB + (size_t)(t + 2) * kstep;
            const char* a3 = a2 + kstepA; const char* b3 = b2 + kstep;
            PG8_LDB(B0, 0, 0); PG8_LDB(B1, 0, 1); PG8_SCHED; PG8_LDA(At, 0, 0); PG8_STAGE(PG8_SA(1, 1), a1 + hA, voffA);
            PG8_WAIT_V(8); PG8_WAIT_L(0); PG8_BAR; PG8_MMA(0, 0, At, B0); PG8_MMA(0, 1, At, B1); PG8_BAR; PG8_SCHED;
            PG8_LDA(At, 0, 1); PG8_STAGE(PG8_SB(0, 0), b2, voffB); PG8_STAGE(PG8_SB(0, 1), b2 + hB, voffB); PG8_STAGE(PG8_SA(0, 0), a2, voffA);
            PG8_WAIT_V(8); PG8_WAIT_L(0); PG8_BAR; PG8_MMA(1, 0, At, B0); PG8_MMA(1, 1, At, B1); PG8_BAR; PG8_SCHED;
            PG8_LDB(B0, 1, 0); PG8_LDB(B1, 1, 1); PG8_SCHED; PG8_LDA(At, 1, 0); PG8_STAGE(PG8_SA(0, 1), a2 + hA, voffA);
            PG8_WAIT_V(8); PG8_WAIT_L(0); PG8_BAR; PG8_MMA(0, 0, At, B0); PG8_MMA(0, 1, At, B1); PG8_BAR; PG8_SCHED;
            PG8_LDA(At, 1, 1); PG8_STAGE(PG8_SB(1, 0), b3, voffB); PG8_STAGE(PG8_SB(1, 1), b3 + hB, voffB); PG8_STAGE(PG8_SA(1, 0), a3, voffA);
            PG8_WAIT_V(8); PG8_WAIT_L(0); PG8_BAR; PG8_MMA(1, 0, At, B0); PG8_MMA(1, 1, At, B1); PG8_BAR; PG8_SCHED;
        }
        }
        if constexpr (ALIGN_EPI) { if (wr == 0) PG8_BAR; }
        E(acc, cur, wr, wc, fr, fq);
        if (!has_next) break;
#pragma unroll
        for (int a = 0; a < 2; ++a)
#pragma unroll
            for (int b = 0; b < 2; ++b)
#pragma unroll
                for (int m = 0; m < 4; ++m)
#pragma unroll
                    for (int n = 0; n < 2; ++n) acc[a][b][m][n] = (f32x4){0.f, 0.f, 0.f, 0.f};
        cur = nxt; cA = nA; cB = nB; ++ui;
        if constexpr (ALIGN_EPI) { if (wr == 1) PG8_BAR; }
    }
    PG8_WAIT_V(0);
    if constexpr (!ALIGN_EPI) { if (wr == 0) PG8_BAR; }
    PG8_BAR;
#undef PG8_SA
#undef PG8_SB
#undef PG8_STAGE
#undef PG8_LDA
#undef PG8_LDB
#undef PG8_MMA
#undef PG8_WAIT_V
#undef PG8_WAIT_L
#undef PG8_BAR
#undef PG8_SCHED
}
}
using pg8::Unit;

typedef const f32x4 (&AccRef)[2][2][4][2];
constexpr size_t G_KT = (size_t)256 * 64, G_PANEL = (FF / 64) * G_KT;
__device__ __forceinline__ size_t g_off(int row, int j) { return (size_t)(row >> 8) * G_PANEL + (size_t)(j >> 6) * G_KT + (size_t)(row & 255) * 64 + (j & 63); }
struct EpiSwiglu {
    static constexpr bool HAS_MID = false;
    bf16* G; const float* pq;
    __device__ __forceinline__ void operator()(AccRef acc, const Unit& u, int wr, int wc, int fr, int fq) const {
        const int row0 = u.pm * 256 + wr * 64 + fr;
        bf16* gb = G + ((size_t)u.pm * (FF / 64) + 2 * u.pn + (wc >> 1)) * G_KT + (size_t)((wr * 64 + fr) * 64 + (wc & 1) * 32 + 8 * fq);
        float sc[2][4];
#pragma unroll
        for (int ai = 0; ai < 2; ++ai)
#pragma unroll
            for (int m = 0; m < 4; ++m) { sc[ai][m] = 1.f;
                if (pq) { const f32x4 pv = *(const f32x4*)(pq + (size_t)(row0 + ai * 128 + m * 16) * 16 + 4 * fq); float t = (pv.x + pv.y) + (pv.z + pv.w); t += __shfl_xor(t, 16); t += __shfl_xor(t, 32); sc[ai][m] = __builtin_amdgcn_rsqf(t * (1.f / D) + EPS); } }
#pragma unroll
        for (int ai = 0; ai < 2; ++ai)
#pragma unroll
            for (int m = 0; m < 4; ++m) {
                const float s = sc[ai][m];
                float o[8];
#pragma unroll
                for (int n = 0; n < 2; ++n)
#pragma unroll
                    for (int i = 0; i < 4; ++i) { const float a = acc[ai][0][m][n][i] * s, b = acc[ai][1][m][n][i] * s; o[4 * n + i] = siluf_(a) * b; }
                v4u w; w.x = cvt_pk_bf16(o[0], o[1]); w.y = cvt_pk_bf16(o[2], o[3]); w.z = cvt_pk_bf16(o[4], o[5]); w.w = cvt_pk_bf16(o[6], o[7]);
                *(v4u*)(gb + (ai * 128 + m * 16) * 64) = w;
            }
    }
};
template <bool WRITE_PQ> struct EpiResidX {
    static constexpr bool HAS_MID = false;
    const float* baseP; const float* baseS; bf16* HB; float* pq; float scale;
    __device__ __forceinline__ void operator()(AccRef acc, const Unit& u, int wr, int wc, int fr, int fq) const {
        const int row0 = u.pm * 256 + wr * 64 + fr, c0 = u.pn * 256 + wc * 32 + 8 * fq; const bool smp = u.pm >= MP / 256;
        const float* bbase = (smp ? baseS : baseP) + (smp ? (size_t)(row0 - MP) * D : (size_t)row0 * D) + c0;
#pragma unroll
        for (int ai = 0; ai < 2; ++ai) {
            f32x4 bb[4][2][2];
#pragma unroll
            for (int m = 0; m < 4; ++m)
#pragma unroll
                for (int bj = 0; bj < 2; ++bj) { const float* bp = bbase + (size_t)(ai * 128 + m * 16) * D + bj * 128; bb[m][bj][0] = *(const f32x4*)bp; bb[m][bj][1] = *(const f32x4*)(bp + 4); }
#pragma unroll
            for (int m = 0; m < 4; ++m) {
                const int row = row0 + ai * 128 + m * 16; float ss = 0.f;
#pragma unroll
                for (int bj = 0; bj < 2; ++bj) {
                    const f32x4 o0 = bb[m][bj][0] + acc[ai][bj][m][0] * scale, o1 = bb[m][bj][1] + acc[ai][bj][m][1] * scale;
                    v4u w; w.x = cvt_pk_bf16(o0.x, o0.y); w.y = cvt_pk_bf16(o0.z, o0.w); w.z = cvt_pk_bf16(o1.x, o1.y); w.w = cvt_pk_bf16(o1.z, o1.w); *(v4u*)(HB + (size_t)row * D + c0 + bj * 128) = w;
                    if (WRITE_PQ) ss += (o0.x * o0.x + o0.y * o0.y) + (o0.z * o0.z + o0.w * o0.w) + (o1.x * o1.x + o1.y * o1.y) + (o1.z * o1.z + o1.w * o1.w);
                }
                if (WRITE_PQ) { ss += __shfl_xor(ss, 16); ss += __shfl_xor(ss, 32); if (fq == 0) pq[(size_t)row * 16 + u.pn * 4 + wc] = ss; }
            }
        }
    }
    template <int O> __device__ __forceinline__ void group(const f32x4 (&v)[8], const Unit& u, int wr, int wc, int fr, int fq) const {
        const int row0 = u.pm * 256 + wr * 64 + fr, c0 = u.pn * 256 + wc * 32 + 8 * fq; const bool smp = u.pm >= MP / 256;
        const float* bbase = (smp ? baseS : baseP) + (smp ? (size_t)(row0 - MP) * D : (size_t)row0 * D) + c0;
        f32x4 bb[2][2][2];
#pragma unroll
        for (int mm = 0; mm < 2; ++mm)
#pragma unroll
            for (int bj = 0; bj < 2; ++bj) { const float* bp = bbase + (size_t)((O >> 1) * 128 + (2 * (O & 1) + mm) * 16) * D + bj * 128; bb[mm][bj][0] = *(const f32x4*)bp; bb[mm][bj][1] = *(const f32x4*)(bp + 4); }
#pragma unroll
        for (int mm = 0; mm < 2; ++mm) { const int row = row0 + (O >> 1) * 128 + (2 * (O & 1) + mm) * 16; float ss = 0.f;
#pragma unroll
            for (int bj = 0; bj < 2; ++bj) {
                const f32x4 o0 = bb[mm][bj][0] + v[bj * 4 + mm * 2] * scale, o1 = bb[mm][bj][1] + v[bj * 4 + mm * 2 + 1] * scale;
                v4u w; w.x = cvt_pk_bf16(o0.x, o0.y); w.y = cvt_pk_bf16(o0.z, o0.w); w.z = cvt_pk_bf16(o1.x, o1.y); w.w = cvt_pk_bf16(o1.z, o1.w); *(v4u*)(HB + (size_t)row * D + c0 + bj * 128) = w;
                if (WRITE_PQ) ss += (o0.x * o0.x + o0.y * o0.y) + (o0.z * o0.z + o0.w * o0.w) + (o1.x * o1.x + o1.y * o1.y) + (o1.z * o1.z + o1.w * o1.w); }
            if (WRITE_PQ) { ss += __shfl_xor(ss, 16); ss += __shfl_xor(ss, 32); if (fq == 0) pq[(size_t)row * 16 + u.pn * 4 + wc] = ss; } }
    }
};
template <bool WRITE_PQ> struct EpiResidB {
    static constexpr bool HAS_MID = false;
    const bf16* base; bf16* out; float* pq; float scale;
    __device__ __forceinline__ void operator()(AccRef acc, const Unit& u, int wr, int wc, int fr, int fq) const {
        const int row0 = u.pm * 256 + wr * 64 + fr, c0 = u.pn * 256 + wc * 32 + 8 * fq;
#pragma unroll
        for (int ai = 0; ai < 2; ++ai) {
            v4u bb[4][2];
#pragma unroll
            for (int m = 0; m < 4; ++m)
#pragma unroll
                for (int bj = 0; bj < 2; ++bj) bb[m][bj] = *(const v4u*)(base + (size_t)(row0 + ai * 128 + m * 16) * D + c0 + bj * 128);
#pragma unroll
            for (int m = 0; m < 4; ++m) {
                const int row = row0 + ai * 128 + m * 16; float ss = 0.f;
#pragma unroll
                for (int bj = 0; bj < 2; ++bj) { const v4u g = bb[m][bj];
                    const f32x4 o0 = (f32x4){bflo(g.x), bfhi(g.x), bflo(g.y), bfhi(g.y)} + acc[ai][bj][m][0] * scale, o1 = (f32x4){bflo(g.z), bfhi(g.z), bflo(g.w), bfhi(g.w)} + acc[ai][bj][m][1] * scale;
                    v4u w; w.x = cvt_pk_bf16(o0.x, o0.y); w.y = cvt_pk_bf16(o0.z, o0.w); w.z = cvt_pk_bf16(o1.x, o1.y); w.w = cvt_pk_bf16(o1.z, o1.w); *(v4u*)(out + (size_t)row * D + c0 + bj * 128) = w;
                    if (WRITE_PQ) ss += (o0.x * o0.x + o0.y * o0.y) + (o0.z * o0.z + o0.w * o0.w) + (o1.x * o1.x + o1.y * o1.y) + (o1.z * o1.z + o1.w * o1.w);
                }
                if (WRITE_PQ) { ss += __shfl_xor(ss, 16); ss += __shfl_xor(ss, 32); if (fq == 0) pq[(size_t)row * 16 + u.pn * 4 + wc] = ss; }
            }
        }
    }
    template <int O> __device__ __forceinline__ void group(const f32x4 (&v)[8], const Unit& u, int wr, int wc, int fr, int fq) const {
        const int row0 = u.pm * 256 + wr * 64 + fr, c0 = u.pn * 256 + wc * 32 + 8 * fq;
        v4u bb[2][2];
#pragma unroll
        for (int mm = 0; mm < 2; ++mm)
#pragma unroll
            for (int bj = 0; bj < 2; ++bj) bb[mm][bj] = *(const v4u*)(base + (size_t)(row0 + (O >> 1) * 128 + (2 * (O & 1) + mm) * 16) * D + c0 + bj * 128);
#pragma unroll
        for (int mm = 0; mm < 2; ++mm) { const int row = row0 + (O >> 1) * 128 + (2 * (O & 1) + mm) * 16; float ss = 0.f;
#pragma unroll
            for (int bj = 0; bj < 2; ++bj) { const v4u g = bb[mm][bj];
                const f32x4 o0 = (f32x4){bflo(g.x), bfhi(g.x), bflo(g.y), bfhi(g.y)} + v[bj * 4 + mm * 2] * scale, o1 = (f32x4){bflo(g.z), bfhi(g.z), bflo(g.w), bfhi(g.w)} + v[bj * 4 + mm * 2 + 1] * scale;
                v4u w; w.x = cvt_pk_bf16(o0.x, o0.y); w.y = cvt_pk_bf16(o0.z, o0.w); w.z = cvt_pk_bf16(o1.x, o1.y); w.w = cvt_pk_bf16(o1.z, o1.w); *(v4u*)(out + (size_t)row * D + c0 + bj * 128) = w;
                if (WRITE_PQ) ss += (o0.x * o0.x + o0.y * o0.y) + (o0.z * o0.z + o0.w * o0.w) + (o1.x * o1.x + o1.y * o1.y) + (o1.z * o1.z + o1.w * o1.w); }
            if (WRITE_PQ) { ss += __shfl_xor(ss, 16); ss += __shfl_xor(ss, 32); if (fq == 0) pq[(size_t)row * 16 + u.pn * 4 + wc] = ss; } }
    }
};
struct EpiMemKV {
    static constexpr bool HAS_MID = false;
    float* out; bf16* MKV;
    __device__ __forceinline__ void operator()(AccRef acc, const Unit& u, int wr, int wc, int fr, int fq) const {
        const int row0 = u.pm * 256 + wr * 64 + fr, c0 = u.pn * 256 + wc * 32 + 8 * fq;
#pragma unroll
        for (int ai = 0; ai < 2; ++ai)
#pragma unroll
            for (int m = 0; m < 4; ++m) {
                const int row = row0 + ai * 128 + m * 16;
#pragma unroll
                for (int bj = 0; bj < 2; ++bj) { const f32x4 o0 = acc[ai][bj][m][0], o1 = acc[ai][bj][m][1]; float* op = out + (size_t)row * D + c0 + bj * 128;
                    *(f32x4*)op = o0; *(f32x4*)(op + 4) = o1;
                    v4u w; w.x = cvt_pk_bf16(o0.x, o0.y); w.y = cvt_pk_bf16(o0.z, o0.w); w.z = cvt_pk_bf16(o1.x, o1.y); w.w = cvt_pk_bf16(o1.z, o1.w); *(v4u*)(MKV + (size_t)row * D + c0 + bj * 128) = w; }
            }
    }
};
struct EpiMerge1 {
    static constexpr bool HAS_MID = true;
    const bf16* GATE; bf16* MB;
    __device__ __forceinline__ void mid(f32x4 (&acc)[2][2][4][2], const Unit& u, int t, int wr, int wc, int fr, int fq) const {
        const unsigned lo = (unsigned)(((wr * 64 + fr) * 3072 + wc * 32 + 8 * fq) * 2);
        const char* ub = (const char*)GATE + ((size_t)u.pm * 256 * 3072 + (size_t)((t >> 3) - 1) * 1024 + (size_t)u.pn * 256) * 2;
#pragma unroll
        for (int ai = 0; ai < 2; ++ai) {
            v4u gn[4][2], gd[4][2];
#pragma unroll
            for (int m = 0; m < 4; ++m)
#pragma unroll
                for (int bj = 0; bj < 2; ++bj) { const char* fb = ub + (size_t)((ai * 128 + m * 16) * 3072 + bj * 128) * 2; gn[m][bj] = *(const v4u*)(fb + lo); gd[m][bj] = *(const v4u*)(fb + 2048 + lo); }
#pragma unroll
            for (int m = 0; m < 4; ++m)
#pragma unroll
                for (int bj = 0; bj < 2; ++bj) { const v4u n_ = gn[m][bj], d_ = gd[m][bj];
                    const f32x4 r0 = {bflo(n_.x) * fast_rcp(fmaxf(bflo(d_.x), 1e-30f)), bfhi(n_.x) * fast_rcp(fmaxf(bfhi(d_.x), 1e-30f)), bflo(n_.y) * fast_rcp(fmaxf(bflo(d_.y), 1e-30f)), bfhi(n_.y) * fast_rcp(fmaxf(bfhi(d_.y), 1e-30f))};
                    const f32x4 r1 = {bflo(n_.z) * fast_rcp(fmaxf(bflo(d_.z), 1e-30f)), bfhi(n_.z) * fast_rcp(fmaxf(bfhi(d_.z), 1e-30f)), bflo(n_.w) * fast_rcp(fmaxf(bflo(d_.w), 1e-30f)), bfhi(n_.w) * fast_rcp(fmaxf(bfhi(d_.w), 1e-30f))};
                    acc[ai][bj][m][0] *= r0; acc[ai][bj][m][1] *= r1; }
            asm volatile("" ::: "memory");
        }
    }
    __device__ __forceinline__ void operator()(AccRef acc, const Unit& u, int wr, int wc, int fr, int fq) const {
        const int row0 = u.pm * 256 + wr * 64 + fr, c0 = u.pn * 256 + wc * 32 + 8 * fq;
        v4u gw[2][4][2];
#pragma unroll
        for (int ai = 0; ai < 2; ++ai)
#pragma unroll
            for (int m = 0; m < 4; ++m)
#pragma unroll
                for (int bj = 0; bj < 2; ++bj) gw[ai][m][bj] = *(const v4u*)(GATE + (size_t)(row0 + ai * 128 + m * 16) * 3072 + 2048 + c0 + bj * 128);
#pragma unroll
        for (int ai = 0; ai < 2; ++ai)
#pragma unroll
            for (int m = 0; m < 4; ++m) { const int row = row0 + ai * 128 + m * 16;
#pragma unroll
                for (int bj = 0; bj < 2; ++bj) { const v4u g = gw[ai][m][bj];
                    const f32x4 o0 = acc[ai][bj][m][0] * (f32x4){bflo(g.x), bfhi(g.x), bflo(g.y), bfhi(g.y)}, o1 = acc[ai][bj][m][1] * (f32x4){bflo(g.z), bfhi(g.z), bflo(g.w), bfhi(g.w)};
                    v4u w; w.x = cvt_pk_bf16(o0.x, o0.y); w.y = cvt_pk_bf16(o0.z, o0.w); w.z = cvt_pk_bf16(o1.x, o1.y); w.w = cvt_pk_bf16(o1.z, o1.w); *(v4u*)(MB + (size_t)row * D + c0 + bj * 128) = w;
                } }
    }
    template <int O> __device__ __forceinline__ void group(const f32x4 (&v)[8], const Unit& u, int wr, int wc, int fr, int fq) const {
        const int row0 = u.pm * 256 + wr * 64 + fr, c0 = u.pn * 256 + wc * 32 + 8 * fq;
#pragma unroll
        for (int mm = 0; mm < 2; ++mm) { const int row = row0 + (O >> 1) * 128 + (2 * (O & 1) + mm) * 16;
#pragma unroll
            for (int bj = 0; bj < 2; ++bj) { const f32x4 o0 = v[bj * 4 + mm * 2], o1 = v[bj * 4 + mm * 2 + 1];
                v4u w; w.x = cvt_pk_bf16(o0.x, o0.y); w.y = cvt_pk_bf16(o0.z, o0.w); w.z = cvt_pk_bf16(o1.x, o1.y); w.w = cvt_pk_bf16(o1.z, o1.w); *(v4u*)(MB + (size_t)row * D + c0 + bj * 128) = w; } }
    }
};
__device__ __forceinline__ size_t qkv_off(int row, int g, int h) {
    if (row >= MP) return (size_t)row * 1536 + g * 512 + h * 128;
    const int b = row >> 11, t = row & 2047, sh = 2 * g, p = ((t & ((1 << sh) - 1)) << (11 - sh)) + (t >> sh);
    return ((size_t)((g * NB + b) * 4 + h) * SEQ + p) * 128;
}
struct EpiZ {
    static constexpr bool HAS_MID = false;
    const float* pq; const float* ropeC; const float* ropeS; const float* bga; float* out;
    bf16 *QS, *KS, *VS, *GQ, *GK, *GV, *GRS, *MQ, *GATE; float* GA;
    template <int ACT> __device__ __forceinline__ void plain(AccRef acc, const float (&rs)[2][4], int row0, bf16* dst, int ld, int col0, float scale) const {
#pragma unroll
        for (int ai = 0; ai < 2; ++ai)
#pragma unroll
            for (int m = 0; m < 4; ++m) { const int row = row0 + ai * 128 + m * 16; const float s = rs[ai][m];
#pragma unroll
                for (int bj = 0; bj < 2; ++bj) { float o[8];
#pragma unroll
                    for (int n = 0; n < 2; ++n)
#pragma unroll
                        for (int i = 0; i < 4; ++i) { const float x = acc[ai][bj][m][n][i] * s; o[4 * n + i] = ACT == 0 ? x * scale : (ACT == 1 ? siluf_(x) : sigmoidf_(x)); }
                    v4u w; w.x = cvt_pk_bf16(o[0], o[1]); w.y = cvt_pk_bf16(o[2], o[3]); w.z = cvt_pk_bf16(o[4], o[5]); w.w = cvt_pk_bf16(o[6], o[7]);
                    *(v4u*)(dst + (size_t)row * ld + col0 + bj * 128) = w; } }
    }
    __device__ __forceinline__ float* swa_dst(int row, int g, int kv, int h) const {
        if (row >= MP) return out + (g == 0 ? O_SWA0S : (g == 1 ? O_SWA1S : O_SWA2S)) + ((size_t)(row - MP) * 2 + kv) * 512 + h * 128;
        const int b = row >> 11, t = row & 2047, keep = 128 << (2 * g), t0 = SEQ - keep;
        if (t < t0) return nullptr;
        return out + (g == 0 ? O_SWA0P : (g == 1 ? O_SWA1P : O_SWA2P)) + (((size_t)b * keep + (t - t0)) * 2 + kv) * 512 + h * 128;
    }
    __device__ __forceinline__ void operator()(AccRef acc, const Unit& u, int wr, int wc, int fr, int fq) const {
        const int row0 = u.pm * 256 + wr * 64 + fr, pn = u.pn, cl = wc * 32 + 8 * fq;
        float rs[2][4];
#pragma unroll
        for (int ai = 0; ai < 2; ++ai)
#pragma unroll
            for (int m = 0; m < 4; ++m) { const int row = row0 + ai * 128 + m * 16;
                const f32x4 pv = *(const f32x4*)(pq + (size_t)row * 16 + 4 * fq); float t = (pv.x + pv.y) + (pv.z + pv.w); t += __shfl_xor(t, 16); t += __shfl_xor(t, 32); rs[ai][m] = __builtin_amdgcn_rsqf(t * (1.f / D) + EPS); }
        if (pn < 12) {
            const int isk = pn >= 6, g = (pn % 6) >> 1, hp = pn & 1, e0 = wc * 16 + 4 * fq;
#pragma unroll
            for (int ai = 0; ai < 2; ++ai) {
                f32x4 cs[4], sn[4];
#pragma unroll
                for (int m = 0; m < 4; ++m) { const int row = row0 + ai * 128 + m * 16; const int pidx = row < MP ? (row & 2047) : SEQ + ((row - MP) & 3);
                    cs[m] = *(const f32x4*)(ropeC + pidx * 64 + e0); sn[m] = *(const f32x4*)(ropeS + pidx * 64 + e0); }
#pragma unroll
                for (int m = 0; m < 4; ++m) { const int row = row0 + ai * 128 + m * 16; const float s = rs[ai][m];
#pragma unroll
                    for (int bj = 0; bj < 2; ++bj) { const int h = 2 * hp + bj;
                        const f32x4 x1 = acc[ai][bj][m][0] * s, x2 = acc[ai][bj][m][1] * s;
                        f32x4 r1 = x1 * cs[m] - x2 * sn[m], r2 = x2 * cs[m] + x1 * sn[m];
                        if (!isk) { r1 *= QSCALE; r2 *= QSCALE; }
                        bf16* dp = (isk ? KS : QS) + qkv_off(row, g, h) + e0;
                        v2u w1, w2; w1.x = cvt_pk_bf16(r1.x, r1.y); w1.y = cvt_pk_bf16(r1.z, r1.w); w2.x = cvt_pk_bf16(r2.x, r2.y); w2.y = cvt_pk_bf16(r2.z, r2.w);
                        *(v2u*)dp = w1; *(v2u*)(dp + 64) = w2;
                        if (isk) { float* fo = swa_dst(row, g, 0, h); if (fo) { *(f32x4*)(fo + e0) = r1; *(f32x4*)(fo + 64 + e0) = r2; } }
                    } }
            }
        } else if (pn < 18) {
            const int g = (pn - 12) >> 1, hp = pn & 1;
#pragma unroll
            for (int ai = 0; ai < 2; ++ai)
#pragma unroll
                for (int m = 0; m < 4; ++m) { const int row = row0 + ai * 128 + m * 16; const float s = rs[ai][m];
#pragma unroll
                    for (int bj = 0; bj < 2; ++bj) { const int h = 2 * hp + bj; const f32x4 o0 = acc[ai][bj][m][0] * s, o1 = acc[ai][bj][m][1] * s;
                        v4u w; w.x = cvt_pk_bf16(o0.x, o0.y); w.y = cvt_pk_bf16(o0.z, o0.w); w.z = cvt_pk_bf16(o1.x, o1.y); w.w = cvt_pk_bf16(o1.z, o1.w);
                        *(v4u*)(VS + qkv_off(row, g, h) + cl) = w;
                        float* fo = swa_dst(row, g, 1, h); if (fo) { *(f32x4*)(fo + cl) = o0; *(f32x4*)(fo + cl + 4) = o1; } } }
        } else if (pn == 18) plain<0>(acc, rs, row0, GQ, 256, cl, 0.125f);
        else if (pn == 19) plain<0>(acc, rs, row0, GK, 256, cl, 1.f);
        else if (pn < 22) plain<0>(acc, rs, row0, GV, 512, (pn - 20) * 256 + cl, 1.f);
        else if (pn < 24) plain<1>(acc, rs, row0, GRS, 512, (pn - 22) * 256 + cl, 1.f);
        else if (pn == 24) {
            f32x4 bv[2][2];
#pragma unroll
            for (int bj = 0; bj < 2; ++bj)
#pragma unroll
                for (int n = 0; n < 2; ++n) bv[bj][n] = *(const f32x4*)(bga + bj * 128 + cl + 4 * n);
#pragma unroll
            for (int ai = 0; ai < 2; ++ai)
#pragma unroll
                for (int m = 0; m < 4; ++m) { const int row = row0 + ai * 128 + m * 16; const float s = rs[ai][m];
#pragma unroll
                    for (int bj = 0; bj < 2; ++bj)
#pragma unroll
                        for (int n = 0; n < 2; ++n) { const int c = bj * 128 + cl + 4 * n; f32x4 o;
#pragma unroll
                            for (int i = 0; i < 4; ++i) { const float x = acc[ai][bj][m][n][i] * s + bv[bj][n][i];
                                o[i] = (fminf(x, 0.f) - LN2 * fast_log2(1.f + fast_exp2(-1.4426950408889634f * fabsf(x)))) * (1.f / 16.f); }
                            *(f32x4*)(GA + (size_t)row * 256 + c) = o; } }
        } else if (pn < 27) plain<0>(acc, rs, row0, MQ, 512, (pn - 25) * 256 + cl, QSCALE);
        else plain<2>(acc, rs, row0, GATE, 3072, (pn - 27) * 256 + cl, 1.f);
    }
};


constexpr int TS = 4;
template <int O> __device__ __forceinline__ void tail_store_group(const f32x4 (&acc)[2][2][4][2], float* dst) {
#pragma unroll
    for (int e = 0; e < 8; ++e) *(f32x4*)(dst + (size_t)e * 2048) = acc[O >> 1][e >> 2][2 * (O & 1) + ((e >> 1) & 1)][e & 1];
}
template <int O> __device__ __forceinline__ void tail_store_gated(const f32x4 (&acc)[2][2][4][2], const bf16* gp, float* dst) {
    v4u g[2][2];
#pragma unroll
    for (int mm = 0; mm < 2; ++mm)
#pragma unroll
        for (int bj = 0; bj < 2; ++bj) g[mm][bj] = *(const v4u*)(gp + (size_t)((O >> 1) * 128 + (2 * (O & 1) + mm) * 16) * 3072 + bj * 128);
#pragma unroll
    for (int e = 0; e < 8; ++e) { const v4u gv = g[(e >> 1) & 1][e >> 2];
        const f32x4 gg = (e & 1) ? (f32x4){bflo(gv.z), bfhi(gv.z), bflo(gv.w), bfhi(gv.w)} : (f32x4){bflo(gv.x), bfhi(gv.x), bflo(gv.y), bfhi(gv.y)};
        *(f32x4*)(dst + (size_t)e * 2048) = acc[O >> 1][e >> 2][2 * (O & 1) + ((e >> 1) & 1)][e & 1] * gg; }
}
template <class Base, bool GATED = false> struct EpiTail {
    static constexpr bool HAS_MID = false;
    Base E0; float* slab  ; gu32* flag; int s, wave; const bf16* gate  ;
    __device__ __forceinline__ void operator()(const f32x4 (&acc)[2][2][4][2], const Unit& u, int wr, int wc, int fr, int fq) const {
        const int lane = fq * 16 + fr; float* lb = slab + (size_t)(wave * 64 + lane) * 4;
        if (GATED) { const bf16* gp = gate + (size_t)(u.pm * 256 + wr * 64 + fr) * 3072 + u.pn * 256 + wc * 32 + 8 * fq;
            tail_store_gated<0>(acc, gp, lb + (size_t)((0 * TS + s) * 8) * 2048); tail_store_gated<1>(acc, gp, lb + (size_t)((1 * TS + s) * 8) * 2048);
            tail_store_gated<2>(acc, gp, lb + (size_t)((2 * TS + s) * 8) * 2048); tail_store_gated<3>(acc, gp, lb + (size_t)((3 * TS + s) * 8) * 2048); }
        else {
        tail_store_group<0>(acc, lb + (size_t)((0 * TS + s) * 8) * 2048); tail_store_group<1>(acc, lb + (size_t)((1 * TS + s) * 8) * 2048);
        tail_store_group<2>(acc, lb + (size_t)((2 * TS + s) * 8) * 2048); tail_store_group<3>(acc, lb + (size_t)((3 * TS + s) * 8) * 2048); }
        asm volatile("s_waitcnt vmcnt(0)" ::: "memory");
        asm volatile("s_waitcnt lgkmcnt(0)" ::: "memory"); __builtin_amdgcn_s_barrier(); asm volatile("" ::: "memory");
        if (wave == 0) {
            if (lane == 0) { __builtin_amdgcn_fence(__ATOMIC_RELEASE, "agent"); asm volatile("s_waitcnt vmcnt(0)" ::: "memory"); __hip_atomic_fetch_add(flag, 1u, RLX_AGENT); }
            unsigned spins = 0;
            while ((unsigned)__builtin_amdgcn_readfirstlane((int)__hip_atomic_load(flag, RLX_AGENT)) < (unsigned)TS) { __builtin_amdgcn_s_sleep(4); if (++spins > (1u << 22)) break; }
            __builtin_amdgcn_fence(__ATOMIC_ACQUIRE, "agent"); asm volatile("s_waitcnt vmcnt(0)" ::: "memory"); }
        asm volatile("s_waitcnt lgkmcnt(0)" ::: "memory"); __builtin_amdgcn_s_barrier(); asm volatile("" ::: "memory");
        const float* src = lb + (size_t)(s * TS * 8) * 2048;
        f32x4 t[TS][8];
#pragma unroll
        for (int ci = 0; ci < TS; ++ci)
#pragma unroll
            for (int e = 0; e < 8; ++e) t[ci][e] = *(const f32x4*)(src + (size_t)(ci * 8 + e) * 2048);
        f32x4 own[8];
#pragma unroll
        for (int e = 0; e < 8; ++e) own[e] = (t[0][e] + t[1][e]) + (t[2][e] + t[3][e]);
        if (s == 0) E0.template group<0>(own, u, wr, wc, fr, fq); else if (s == 1) E0.template group<1>(own, u, wr, wc, fr, fq);
        else if (s == 2) E0.template group<2>(own, u, wr, wc, fr, fq); else E0.template group<3>(own, u, wr, wc, fr, fq);
    }
};
#define XB_TMO      128
#define XB_XCNT(j)  (256  + 64 * (j))
#define XB_XSUB(j)  (1280 + 64 * (j))
#define XB_XGEN(j)  (2304 + 64 * (j))
#define XB_TOP      3328
#define XB_TOPGEN   3392
#define XCD_BAR_WORDS 3456
#define XB_SPIN_CAP (1u << 18)
__device__ __forceinline__ unsigned xb_ld(unsigned* p)              { return __hip_atomic_load(p, __ATOMIC_RELAXED, __HIP_MEMORY_SCOPE_AGENT); }
__device__ __forceinline__ unsigned xb_add(unsigned* p, unsigned v) { return __hip_atomic_fetch_add(p, v, __ATOMIC_RELAXED, __HIP_MEMORY_SCOPE_AGENT); }
__device__ __forceinline__ unsigned xb_xcc_id() { return (unsigned)__builtin_amdgcn_s_getreg((3 << 11) | 20) & 0xFu; }
#define XB_SPIN(cond, bar) do { unsigned _sp = 0; while (cond) { __builtin_amdgcn_s_sleep(1); \
    if ((++_sp & 255u) == 0u) { if (xb_ld(&(bar)[XB_TMO])) break; if (_sp > XB_SPIN_CAP) { atomicAdd(&(bar)[XB_TMO], 1u); break; } } } } while (0)
struct XcdBarrier { unsigned* bar; unsigned x; volatile LAS unsigned* st; };
__device__ __forceinline__ XcdBarrier xcd_barrier_post(unsigned* bar, volatile LAS unsigned* st, int wave) {
    XcdBarrier b; b.bar = bar; b.x = xb_xcc_id(); b.st = st;
    if (wave == 0 && lane_id() == 0) (void)xb_add(&bar[XB_XCNT(b.x)], 1u);
    return b;
}
__device__ __forceinline__ void xcd_barrier_complete(unsigned* bar, unsigned x, unsigned& nloc, unsigned& nx) {
    const unsigned G = gridDim.x * gridDim.y * gridDim.z;
    unsigned sum, cnt, mine, sp = 0u;
    for (;;) {
        sum = 0u; cnt = 0u; mine = 0u;
#pragma unroll
        for (unsigned j = 0; j < 16; ++j) { const unsigned c = xb_ld(&bar[XB_XCNT(j)]); sum += c; cnt += (c > 0u) ? 1u : 0u; mine = (j == x) ? c : mine; }
        if (sum == G) break;
        __builtin_amdgcn_s_sleep(1);
        if ((++sp & 255u) == 0u) { if (xb_ld(&bar[XB_TMO])) break; if (sp > XB_SPIN_CAP) { atomicAdd(&bar[XB_TMO], 1u); break; } }
    }
    nloc = mine > 0u ? mine : 1u; nx = cnt > 0u ? cnt : 1u;
}
__device__ __forceinline__ void xcd_barrier(const XcdBarrier& b, int wave) {
    asm volatile("s_waitcnt vmcnt(0)" ::: "memory");
    __syncthreads();
    if (wave == 0 && lane_id() == 0) {
        unsigned* bar = b.bar;
        __builtin_amdgcn_s_waitcnt(0);
        unsigned nloc = b.st[0], nx = b.st[1];
        if (nloc == 0u) { xcd_barrier_complete(bar, b.x, nloc, nx); b.st[0] = nloc; b.st[1] = nx; }
        const unsigned old = xb_add(&bar[XB_XSUB(b.x)], 1u);
        const unsigned gen = old / nloc;
        if (old + 1u == (gen + 1u) * nloc) {
            __builtin_amdgcn_fence(__ATOMIC_RELEASE, "agent");
            asm volatile("s_waitcnt vmcnt(0)" ::: "memory");
            const unsigned og = xb_add(&bar[XB_TOP], 1u);
            const unsigned tg = og / nx;
            if (og + 1u == (tg + 1u) * nx) xb_add(&bar[XB_TOPGEN], 1u);
            else XB_SPIN(xb_ld(&bar[XB_TOPGEN]) == tg, bar);
            __builtin_amdgcn_fence(__ATOMIC_ACQUIRE, "agent");
            xb_add(&bar[XB_XGEN(b.x)], 1u);
            asm volatile("s_waitcnt vmcnt(0)" ::: "memory");
        } else {
            XB_SPIN(xb_ld(&bar[XB_XGEN(b.x)]) == gen, bar);
            __builtin_amdgcn_fence(__ATOMIC_ACQUIRE, "agent");
            asm volatile("s_waitcnt vmcnt(0)" ::: "memory");
        }
    }
    __syncthreads();
}

struct Args { const float* in[25]; float* out; unsigned char* ws; int ph_lo, ph_hi, li, pad; };
struct Frame {
    LAS unsigned char* lds; int tid, lane, wave, vcu, G;
    const float *i0, *i1, *i2, *i3, *i4, *i5, *i6, *i7, *i8, *i9, *i10, *i11, *i12, *i13, *i14, *i15, *i16, *i17, *i18, *i19, *i20, *i21, *i22, *i23, *i24;
    float* out; unsigned char* ws;
};
__device__ __forceinline__ float wave_sum(float v) {
#pragma unroll
    for (int o = 1; o < 64; o <<= 1) v += __shfl_xor(v, o);
    return v;
}

template <class Base, bool ATILED = false> __device__ __forceinline__ void tail_phase(Frame& F, const bf16* A, int lda, const bf16* Bt, int ldb, int K, const Base& E0, int ps) {
    const int c = (int)blockIdx.x; if (c >= 8 * TS) return;
    const int j = c / TS, s = c % TS, nch = K / 128, c0 = (s * nch) / TS, c1 = ((s + 1) * nch) / TS;
    pg8::OneUnit S; S.c = c; pg8::StaticOrderT<MR / 256, D / 256>::unit_of(1024 + j, S.u);
    pg8::Gemm g{A + (ATILED ? (size_t)c0 * 2 * (pg8::TILED_KS / 2) : (size_t)c0 * 128), Bt + c0 * 128, MR, D, (c1 - c0) * 128, lda, ldb};
    EpiTail<Base> E{E0, (float*)(F.ws + WS_SLAB) + (size_t)j * (TS * TS * 8 * 2048), (gu32*)(F.ws + WS_CTL) + CW_TAIL + (ps * 8 + j) * 64, s, F.wave};
    pg8::gemm_phase<EpiTail<Base>, pg8::OneUnit, true, ATILED>(F.lds + RING_OFF, g, S, E, F.wave);
}
__device__ __forceinline__ void tail_phase_merge(Frame& F, const bf16* A, const bf16* Bt, const EpiMerge1& E0, int ps) {
    const int c = (int)blockIdx.x; if (c >= 8 * TS) return;
    const int j = c / TS, s = c % TS, k0 = s < 2 ? 512 * s : 1024 + 256 * (s - 2), kl = s < 2 ? 512 : 256, br = s < 2 ? s : 2;
    pg8::OneUnit S; S.c = c; pg8::StaticOrderT<MR / 256, D / 256>::unit_of(1024 + j, S.u);
    pg8::Gemm g{A + k0, Bt + k0, MR, D, kl, 1536, 1536};
    EpiTail<EpiMerge1, true> E{E0, (float*)(F.ws + WS_SLAB) + (size_t)j * (TS * TS * 8 * 2048), (gu32*)(F.ws + WS_CTL) + CW_TAIL + (ps * 8 + j) * 64, s, F.wave, E0.GATE + br * 1024};
    pg8::gemm_phase<EpiTail<EpiMerge1, true>, pg8::OneUnit>(F.lds + RING_OFF, g, S, E, F.wave);
}
enum WKind { WK_PLAIN = 0, WK_SWIGLU = 1, WK_IN = 2 };
__device__ __forceinline__ int p0_win_col(int np) {
    const int pn = np >> 8, r = np & 255;
    if (pn < 18) { const int qkv = pn / 6, g = (pn % 6) >> 1, hp = pn & 1, h = 2 * hp + (r >> 7); const int d = qkv < 2 ? sig_rope(r & 127) : sig_plain(r & 127); return ((qkv * 3 + g) * 4 + h) * 128 + d; }
    const int c = sig_plain(r);
    if (pn == 18) return 4608 + c;
    if (pn == 19) return 4864 + c;
    if (pn < 22) return 5120 + (pn - 20) * 256 + c;
    if (pn < 24) return 5632 + (pn - 22) * 256 + c;
    if (pn == 24) return -1 - c;
    if (pn < 27) return 6160 + (pn - 25) * 256 + c;
    return DIN + (pn - 27) * 256 + c;
}
__device__ __forceinline__ void p0_item(const Frame& F, int kind, const float* W, int ldw, const float* W2, const float* gain, const float* a2, bf16* WT, int K, int kb, int nb, LAS float* scr) {
    const int lane = F.lane, k0 = 64 * kb, n0 = 32 * nb, np = n0 + (lane & 31);
    int sc; const float* Wp = W; int ld = ldw;
    if (kind == WK_PLAIN) sc = sig_plain(np);
    else if (kind == WK_SWIGLU) { const int r = np & 255; sc = (r >> 7) * FF + (np >> 8) * 128 + sig_plain(r & 127); }
    else { sc = p0_win_col(np); if (sc >= DIN) { sc -= DIN; Wp = W2; ld = 3072; } }
    if (sc >= 0) {
#pragma unroll 8
        for (int i = 0; i < 32; ++i) { const int kk = 2 * i + (lane >> 5); float v = Wp[(size_t)(k0 + kk) * ld + sc]; if (gain) v *= gain[k0 + kk]; scr[kk * 33 + (lane & 31)] = v; }
    } else {
        const int j = -1 - sc; float a2c[16];
#pragma unroll
        for (int r = 0; r < 16; ++r) a2c[r] = a2[r * 256 + j];
        for (int i = 0; i < 32; ++i) { const int kk = 2 * i + (lane >> 5); const float* wr_ = W + (size_t)(k0 + kk) * ldw + 6144; float v = 0.f;
#pragma unroll
            for (int r = 0; r < 16; ++r) v += wr_[r] * a2c[r];
            scr[kk * 33 + (lane & 31)] = v * gain[k0 + kk]; }
    }
    LDS_WAIT(); asm volatile("" ::: "memory");
    const int c = lane & 7;
#pragma unroll
    for (int j = 0; j < 4; ++j) { const int n = (lane >> 3) + 8 * j; const LAS float* s = scr + (8 * c) * 33 + n;
        v4u o; o.x = pk2(s[0 * 33], s[1 * 33]); o.y = pk2(s[2 * 33], s[3 * 33]); o.z = pk2(s[4 * 33], s[5 * 33]); o.w = pk2(s[6 * 33], s[7 * 33]);
        *(GAS v4u*)(WT + (size_t)(n0 + n) * K + k0 + 8 * c) = o; }
    LDS_WAIT(); asm volatile("" ::: "memory");
}
template <int NR> __device__ __forceinline__ void rms_rows_to_bf16(int lane, const float* const (&xrow)[NR], const float* const (&gain)[NR], bf16* const (&orow)[NR]) {
    f32x4 v[NR][4]; float rstd[NR];
#pragma unroll
    for (int r = 0; r < NR; ++r)
#pragma unroll
        for (int j = 0; j < 4; ++j) v[r][j] = ((const GAS f32x4*)xrow[r] + lane)[64 * j];
#pragma unroll
    for (int r = 0; r < NR; ++r) { float s = 0.f;
#pragma unroll
        for (int j = 0; j < 4; ++j) s += (v[r][j].x * v[r][j].x + v[r][j].y * v[r][j].y) + (v[r][j].z * v[r][j].z + v[r][j].w * v[r][j].w);
        rstd[r] = 1.0f / sqrtf(wave_sum(s) * (1.f / D) + EPS); }
#pragma unroll
    for (int r = 0; r < NR; ++r) { GAS v2u* o8 = (GAS v2u*)orow[r] + lane; const GAS f32x4* gr = (const GAS f32x4*)gain[r] + lane;
#pragma unroll
        for (int j = 0; j < 4; ++j) { const f32x4 gg = gr[64 * j]; v2u w; w.x = pk2(v[r][j].x * rstd[r] * gg.x, v[r][j].y * rstd[r] * gg.y); w.y = pk2(v[r][j].z * rstd[r] * gg.z, v[r][j].w * rstd[r] * gg.w); o8[64 * j] = w; } }
}
__device__ __forceinline__ void sincos_d(double x, double& s, double& c) {
    const double TWO_PI = 6.283185307179586476925286766559;
    const double n = __builtin_rint(x / TWO_PI); const double r = x - n * TWO_PI, r2 = r * r;
    double ts = 1.0, tc = 1.0;
#pragma unroll
    for (int k = 14; k >= 1; --k) { ts = 1.0 - ts * r2 / (double)((2 * k) * (2 * k + 1)); tc = 1.0 - tc * r2 / (double)((2 * k - 1) * (2 * k)); }
    s = ts * r; c = tc;
}
__device__ __forceinline__ void p0_prologue(Frame& F) {
    unsigned char* ws = F.ws;
    LAS float* scr = (LAS float*)(F.lds + RING_OFF + F.wave * 16384);
    const int gw = F.vcu * NWAVES + F.wave, NGW = F.G * NWAVES;
    constexpr int I_A = 16 * 176, I_O = 44 * 32, I_IN = 16 * 312, I_BR = 8 * 32, I_SQ = 16 * 32;
    constexpr int NITEMS = 2 * I_A + 2 * I_O + I_IN + 3 * I_BR + 2 * I_SQ;
    for (int it = gw; it < NITEMS; it += NGW) {
        int r = it;
        if (r < I_A) { p0_item(F, WK_SWIGLU, F.i9, 2 * FF, nullptr, nullptr, nullptr, (bf16*)(ws + WS_W1A), D, r / 176, r % 176, scr); continue; } r -= I_A;
        if (r < I_A) { p0_item(F, WK_SWIGLU, F.i22, 2 * FF, nullptr, F.i21, nullptr, (bf16*)(ws + WS_W2A), D, r / 176, r % 176, scr); continue; } r -= I_A;
        if (r < I_O) { p0_item(F, WK_PLAIN, F.i10, D, nullptr, nullptr, nullptr, (bf16*)(ws + WS_W1O), FF, r / 32, r % 32, scr); continue; } r -= I_O;
        if (r < I_O) { p0_item(F, WK_PLAIN, F.i23, D, nullptr, nullptr, nullptr, (bf16*)(ws + WS_W2O), FF, r / 32, r % 32, scr); continue; } r -= I_O;
        if (r < I_IN) { p0_item(F, WK_IN, F.i12, DIN, F.i16, F.i11, F.i13, (bf16*)(ws + WS_WIN), D, r / 312, r % 312, scr); continue; } r -= I_IN;
        if (r < 3 * I_BR) { const int br = r / I_BR, q = r % I_BR; p0_item(F, WK_PLAIN, F.i17 + (size_t)br * 512 * D, D, nullptr, nullptr, nullptr, (bf16*)(ws + WS_WBR) + br * 512, 1536, q / 32, q % 32, scr); continue; } r -= 3 * I_BR;
        if (r < I_SQ) { p0_item(F, WK_PLAIN, F.i18, D, nullptr, nullptr, nullptr, (bf16*)(ws + WS_WOUT), D, r / 32, r % 32, scr); continue; } r -= I_SQ;
        p0_item(F, WK_PLAIN, F.i20, D, nullptr, nullptr, nullptr, (bf16*)(ws + WS_WMEM), D, r / 32, r % 32, scr);
    }
#define P0_ROW(m_, x_, g_, o_) do { const int mm_ = (m_); if (mm_ < MP) { x_ = F.i0 + (size_t)mm_ * D; g_ = F.i8; o_ = (bf16*)(ws + WS_XB) + (size_t)mm_ * D; } \
        else if (mm_ < MR) { x_ = F.i1 + (size_t)(mm_ - MP) * D; g_ = F.i8; o_ = (bf16*)(ws + WS_XB) + (size_t)mm_ * D; } \
        else { x_ = F.i2 + (size_t)(mm_ - MR) * D; g_ = F.i19; o_ = (bf16*)(ws + WS_MEMB) + (size_t)(mm_ - MR) * D; } } while (0)
    { int m = gw;
      for (; m + 3 * NGW < MR + MM; m += 4 * NGW) { const float* x[4]; const float* g[4]; bf16* o[4];
#pragma unroll
          for (int r = 0; r < 4; ++r) P0_ROW(m + r * NGW, x[r], g[r], o[r]);
          rms_rows_to_bf16<4>(F.lane, x, g, o); }
      for (; m < MR + MM; m += NGW) { const float* x[1]; const float* g[1]; bf16* o[1]; P0_ROW(m, x[0], g[0], o[0]); rms_rows_to_bf16<1>(F.lane, x, g, o); } }
#undef P0_ROW
    float* rc = (float*)(ws + WS_ROPE); float* rsn = rc + NPOS * 64;
    for (int i = (F.vcu * NWAVES * 64) + F.tid; i < NPOS * 64; i += F.G * NWAVES * 64) {
        const int p = i >> 6, e = i & 63; const int pos = p < SEQ ? p : PAST + (p - SEQ);
        const double y = -(double)e * 9.210340371976182736 / 64.0 / 16.0; double ex = 1.0;
#pragma unroll
        for (int k = 14; k >= 1; --k) ex = 1.0 + ex * y / (double)k;
        ex *= ex; ex *= ex; ex *= ex; ex *= ex;
        const float inv = (float)ex; const float ang = (float)pos * inv;
        double s, c; sincos_d((double)ang, s, c); rc[i] = (float)c; rsn[i] = (float)s;
    }
}

__device__ __forceinline__ int koff(int row, int ch) { return 256 * row + 16 * (ch ^ (row & 15)); }
__device__ __forceinline__ int voff(int row, int ch) { return 256 * row + 16 * (ch ^ ((row & 7) << 1)); }
typedef short v4i16_t __attribute__((ext_vector_type(4)));
__device__ __forceinline__ s16x4 vtr(const LAS unsigned char* p) { return __builtin_bit_cast(s16x4, __builtin_amdgcn_ds_read_tr16_b64_v4i16((LAS v4i16_t*)p)); }
struct AttnDesc { const bf16* Qp; const bf16* Kp; const bf16* Vp; bf16* Op; float* lsep; long qrow0, krow0, orow0; int qpitch, kpitch, opitch, qstride, kstride, ostride, kmin; };
template <int MODE> __device__ __forceinline__ AttnDesc attn_desc(const Frame& F, int id) {
    unsigned char* ws = F.ws; AttnDesc d;
    if (MODE == 0) {
        const int b = id / 192, rem = id % 192, gh = rem >> 4, u = rem & 15, g = gh >> 2;
        const int dil = g == 0 ? 1 : (g == 1 ? 4 : 16), r = g == 0 ? 0 : (g == 1 ? (u & 3) : u), n = g == 0 ? u : (g == 1 ? (u >> 2) : 0);
        const size_t hb = (size_t)((g * NB + b) * 4 + (gh & 3)) * SEQ * 128; const long pr = (long)r * (SEQ / dil);
        d.Qp = (const bf16*)(ws + WS_QS) + hb; d.Kp = (const bf16*)(ws + WS_KS) + hb; d.Vp = (const bf16*)(ws + WS_VS) + hb; d.Op = (bf16*)(ws + WS_OG) + gh * 128; d.lsep = (float*)(ws + WS_LSE) + gh;
        d.qrow0 = pr + 128 * n; d.krow0 = pr + 128 * (n - 1); d.orow0 = (long)b * SEQ + r + (long)128 * n * dil; d.qpitch = 128; d.kpitch = 128; d.opitch = 1536; d.qstride = 1; d.kstride = 1; d.ostride = dil; d.kmin = n == 0 ? 128 : 0;
    } else {
        const int j = id - 6144, b = j >> 6, h = (j >> 4) & 3, n = j & 15;
        d.Qp = (const bf16*)(ws + WS_MQ) + h * 128; d.Kp = (const bf16*)(ws + WS_MKV) + h * 128; d.Vp = (const bf16*)(ws + WS_MKV) + 512 + h * 128; d.Op = (bf16*)(ws + WS_OALL) + 1024 + h * 128; d.lsep = nullptr;
        d.qrow0 = (long)b * SEQ + 128 * n; d.orow0 = d.qrow0; d.ostride = 1; d.krow0 = (long)b * MEML; d.qpitch = 512; d.kpitch = 1024; d.opitch = 1536; d.qstride = 1; d.kstride = 1; d.kmin = 0;
    }
    return d;
}
template <int MODE> __device__ __forceinline__ void attn_scores(const Frame& F, const AttnDesc& d, const bf16x8 (&qf)[4], f32x4 (&S)[MODE == 0 ? 9 : 16], float& mx_out, float& ls_out) {
    const LAS unsigned char* ldsK = F.lds + RING_OFF;
    const int lane = F.lane, w = F.wave, l15 = lane & 15, g4 = lane >> 4;
    constexpr int NF = MODE == 0 ? 9 : 16;
    const int f0 = MODE == 0 ? w : 0; const bool half = MODE == 0 && d.kmin != 0;
#pragma unroll
    for (int i = 0; i < NF; ++i) { S[i] = (f32x4){0.f, 0.f, 0.f, 0.f};
        if (!(half && f0 + i < 8)) { const int krow = 16 * (f0 + i) + l15;
#pragma unroll
            for (int s = 0; s < 4; ++s) { const bf16x8 kf = *(const LAS bf16x8*)(ldsK + koff(krow, 4 * s + g4)); S[i] = __builtin_amdgcn_mfma_f32_16x16x32_bf16(kf, qf[s], S[i], 0, 0, 0); } } }
    float mx = -3.0e38f; const int iq = 16 * w + l15;
#pragma unroll
    for (int i = 0; i < NF; ++i)
#pragma unroll
        for (int r = 0; r < 4; ++r) { if (MODE == 0) { const int kj = 16 * (f0 + i) + 4 * g4 + r; const bool ok = kj >= iq && kj <= iq + 128 && kj >= d.kmin; S[i][r] = ok ? S[i][r] : -3.0e38f; } mx = fmaxf(mx, S[i][r]); }
    mx = fmaxf(mx, __shfl_xor(mx, 16)); mx = fmaxf(mx, __shfl_xor(mx, 32));
    float ls = 0.f;
#pragma unroll
    for (int i = 0; i < NF; ++i)
#pragma unroll
        for (int r = 0; r < 4; ++r) { const float p = fast_exp2(S[i][r] - mx); S[i][r] = p; ls += p; }
    ls += __shfl_xor(ls, 16); ls += __shfl_xor(ls, 32);
    mx_out = mx; ls_out = ls;
}
template <int MODE> __device__ __forceinline__ void attn_pv(const Frame& F, const AttnDesc& d, const f32x4 (&S)[MODE == 0 ? 9 : 16], float mx, float ls) {
    const LAS unsigned char* ldsV = F.lds + RING_OFF + 65536;
    const int lane = F.lane, w = F.wave, l15 = lane & 15, g4 = lane >> 4;
    constexpr int NF = MODE == 0 ? 9 : 16, NP = (NF + 1) / 2;
    const int f0 = MODE == 0 ? w : 0; const bool half = MODE == 0 && d.kmin != 0;
    f32x4 O[8];
#pragma unroll
    for (int df = 0; df < 8; ++df) O[df] = (f32x4){0.f, 0.f, 0.f, 0.f};
    const int q4 = l15 >> 2, p4 = lane & 3;
#pragma unroll
    for (int pr = 0; pr < NP; ++pr) {
        int fa = f0 + 2 * pr, fb = fa + 1; if (fb > 15) fb = 15;
        if (half && fb < 8) continue;
        if (half && fa < 8) fa = 8;
        const f32x4 pa = S[2 * pr], pb = (2 * pr + 1 < NF) ? S[(2 * pr + 1 < NF) ? 2 * pr + 1 : 0] : (f32x4){0.f, 0.f, 0.f, 0.f};
        v4u pw; pw.x = cvt_pk_bf16(pa.x, pa.y); pw.y = cvt_pk_bf16(pa.z, pa.w); pw.z = cvt_pk_bf16(pb.x, pb.y); pw.w = cvt_pk_bf16(pb.z, pb.w);
        const bf16x8 pf = __builtin_bit_cast(bf16x8, pw);
        const int ra = 16 * fa + 4 * g4 + q4, rb = 16 * fb + 4 * g4 + q4;
#pragma unroll
        for (int df = 0; df < 8; ++df) {
            const s16x4 t1 = vtr(ldsV + voff(ra, 2 * df + (p4 >> 1)) + 8 * (p4 & 1)), t2 = vtr(ldsV + voff(rb, 2 * df + (p4 >> 1)) + 8 * (p4 & 1));
            const bf16x8 vf = {t1[0], t1[1], t1[2], t1[3], t2[0], t2[1], t2[2], t2[3]};
            O[df] = __builtin_amdgcn_mfma_f32_16x16x32_bf16(vf, pf, O[df], 0, 0, 0);
        }
    }
    const float inv = 1.0f / ls;
    const long qrow = d.orow0 + (long)(16 * w + l15) * d.ostride;
    bf16* op = d.Op + qrow * d.opitch + 4 * g4;
#pragma unroll
    for (int df = 0; df < 8; ++df) { const f32x4 o = O[df] * inv; v2u wv; wv.x = cvt_pk_bf16(o.x, o.y); wv.y = cvt_pk_bf16(o.z, o.w); *(v2u*)(op + 16 * df) = wv; }
    if (MODE == 0 && g4 == 0) d.lsep[qrow * 12] = (mx + fast_log2(ls)) * LN2;
}
__device__ __forceinline__ void glds16(const void* gsrc, unsigned lds_dst) { unsigned keep;
    asm volatile("s_mov_b32 %0, m0\n\ts_mov_b32 m0, %2\n\ts_nop 0\n\tglobal_load_lds_dwordx4 %1, off\n\ts_mov_b32 m0, %0" : "=&s"(keep) : "v"(gsrc), "s"(lds_dst) : "memory"); }
__device__ __forceinline__ void attn_dma(const Frame& F, const AttnDesc& d, const bool isV) {
    const bf16* P = isV ? d.Vp : d.Kp;
    const unsigned base = (unsigned)__builtin_amdgcn_readfirstlane((int)(unsigned)(size_t)(F.lds + RING_OFF) + (isV ? 65536 : 0) + F.wave * 8192);
    if (d.kmin != 0 && F.wave < 4) return;
    const int slot = F.lane & 15, rsub = F.lane >> 4;
#pragma unroll
    for (int i = 0; i < 8; ++i) { const int row = 32 * F.wave + 4 * i + rsub, ch = isV ? (slot ^ ((row & 7) << 1)) : (slot ^ (row & 15));
        const bf16* gp = P + (d.krow0 + (long)row * d.kstride) * d.kpitch + ch * 8;
        glds16(gp, base + i * 1024); }
}
__device__ __forceinline__ void attn_loadq(const Frame& F, const AttnDesc& d, bf16x8 (&qf)[4]) {
    const long qrow = d.qrow0 + (long)(16 * F.wave + (F.lane & 15)) * d.qstride;
#pragma unroll
    for (int s = 0; s < 4; ++s) qf[s] = *(const bf16x8*)(d.Qp + qrow * d.qpitch + 32 * s + 8 * (F.lane >> 4));
}
#define ATT_BAR() do { asm volatile("s_waitcnt lgkmcnt(0)" ::: "memory"); __builtin_amdgcn_s_barrier(); asm volatile("" ::: "memory"); } while (0)
template <int MODE, int NU> __device__ __forceinline__ void attn_batch(const Frame& F, int id0) {
    AttnDesc d = attn_desc<MODE>(F, id0);
    bf16x8 qn[4], qc[4];
    attn_dma(F, d, false); attn_loadq(F, d, qn);
#pragma unroll
    for (int s = 0; s < 4; ++s) qc[s] = qn[s];
    attn_dma(F, d, true);
#pragma unroll 1
    for (int u = 0; u < NU; ++u) {
        asm volatile("s_waitcnt vmcnt(8)" ::: "memory"); ATT_BAR();
        f32x4 S[MODE == 0 ? 9 : 16]; float mx, ls;
        attn_scores<MODE>(F, d, qc, S, mx, ls);
        asm volatile("s_waitcnt vmcnt(0)" ::: "memory"); ATT_BAR();
        const bool more = u + 1 < NU;
        const AttnDesc dn = attn_desc<MODE>(F, id0 + (more ? u + 1 : u));
        if (more) { attn_dma(F, dn, false); if (MODE == 0) attn_loadq(F, dn, qn); }
        attn_pv<MODE>(F, d, S, mx, ls);
        ATT_BAR();
        if (more) {
            if (MODE != 0) attn_loadq(F, dn, qn);
#pragma unroll
            for (int s = 0; s < 4; ++s) qc[s] = qn[s];
            asm volatile("" : "+v"(qc[0]), "+v"(qc[1]), "+v"(qc[2]), "+v"(qc[3]));
            attn_dma(F, dn, true); }
        d = dn;
    }
    asm volatile("s_waitcnt vmcnt(0)" ::: "memory");
}
__device__ __forceinline__ void p4_sample_attn(const Frame& F, int wt, const float* c0, const float* c1, const float* c2, const float* cm) {
    unsigned char* ws = F.ws; const int lane = F.lane, sub = lane & 15, t = lane >> 4;
    const int db = wt >> 4, h = (wt >> 2) & 3, src = wt & 3;
    const int row = MP + db * 4 + t;
    const bf16* qp = src < 3 ? (const bf16*)(ws + WS_QS) + (size_t)row * 1536 + src * 512 + h * 128 + 8 * sub : (const bf16*)(ws + WS_MQ) + (size_t)row * 512 + h * 128 + 8 * sub;
    float q[8]; { const v4u qw = *(const v4u*)qp; q[0] = bflo(qw.x); q[1] = bfhi(qw.x); q[2] = bflo(qw.y); q[3] = bfhi(qw.y); q[4] = bflo(qw.z); q[5] = bfhi(qw.z); q[6] = bflo(qw.w); q[7] = bfhi(qw.w); }
    float mx = -3.0e38f, ls = 0.f, o[8];
#pragma unroll
    for (int j = 0; j < 8; ++j) o[j] = 0.f;
#define SA_STEP(K0, K1, V0, V1) do { float s_ = (q[0] * K0.x + q[1] * K0.y) + (q[2] * K0.z + q[3] * K0.w) + (q[4] * K1.x + q[5] * K1.y) + (q[6] * K1.z + q[7] * K1.w); \
        s_ += __shfl_xor(s_, 1); s_ += __shfl_xor(s_, 2); s_ += __shfl_xor(s_, 4); s_ += __shfl_xor(s_, 8); \
        const float mn_ = fmaxf(mx, s_), sc_ = fast_exp2(mx - mn_), p_ = fast_exp2(s_ - mn_); mx = mn_; ls = ls * sc_ + p_; \
        o[0] = o[0] * sc_ + p_ * V0.x; o[1] = o[1] * sc_ + p_ * V0.y; o[2] = o[2] * sc_ + p_ * V0.z; o[3] = o[3] * sc_ + p_ * V0.w; \
        o[4] = o[4] * sc_ + p_ * V1.x; o[5] = o[5] * sc_ + p_ * V1.y; o[6] = o[6] * sc_ + p_ * V1.z; o[7] = o[7] * sc_ + p_ * V1.w; } while (0)
    int nstart = 0, NK; const float* cache; int L = 256, dil = 1;
    if (src == 3) { cache = cm; NK = 256; }
    else { cache = src == 0 ? c0 : (src == 1 ? c1 : c2); L = 128 << (2 * src); dil = src == 0 ? 1 : (src == 1 ? 4 : 16); NK = 129; nstart = 4;
        for (int n = 0; n < 4; ++n) {
            const int idx = L + t - dil * n; f32x4 k0, k1, v0, v1;
            if (idx >= L) { const size_t ro = (size_t)(MP + db * 4 + (idx - L)) * 1536 + src * 512 + h * 128 + 8 * sub;
                const v4u kw = *(const v4u*)((const bf16*)(ws + WS_KS) + ro), vw = *(const v4u*)((const bf16*)(ws + WS_VS) + ro);
                k0 = (f32x4){bflo(kw.x), bfhi(kw.x), bflo(kw.y), bfhi(kw.y)}; k1 = (f32x4){bflo(kw.z), bfhi(kw.z), bflo(kw.w), bfhi(kw.w)};
                v0 = (f32x4){bflo(vw.x), bfhi(vw.x), bflo(vw.y), bfhi(vw.y)}; v1 = (f32x4){bflo(vw.z), bfhi(vw.z), bflo(vw.w), bfhi(vw.w)};
            } else { const float* kp = cache + (((size_t)db * L + idx) * 2) * 512 + h * 128 + 8 * sub;
                k0 = *(const f32x4*)kp; k1 = *(const f32x4*)(kp + 4); v0 = *(const f32x4*)(kp + 512); v1 = *(const f32x4*)(kp + 516); }
            SA_STEP(k0, k1, v0, v1);
        }
    }
    const float* kbase = cache + ((size_t)db * L * 2) * 512 + h * 128 + 8 * sub;
    const long kstep = src == 3 ? 1024 : -(long)dil * 1024; const long kfirst = src == 3 ? 0 : (long)(L + t) * 1024;
    int n = nstart;
    for (; n + 4 <= NK; n += 4) {
        f32x4 kk[4][2], vv[4][2];
#pragma unroll
        for (int j = 0; j < 4; ++j) { const float* kp = kbase + kfirst + (long)(n + j) * kstep; kk[j][0] = *(const f32x4*)kp; kk[j][1] = *(const f32x4*)(kp + 4); vv[j][0] = *(const f32x4*)(kp + 512); vv[j][1] = *(const f32x4*)(kp + 516); }
#pragma unroll
        for (int j = 0; j < 4; ++j) SA_STEP(kk[j][0], kk[j][1], vv[j][0], vv[j][1]);
    }
    for (; n < NK; ++n) { const float* kp = kbase + kfirst + (long)n * kstep; const f32x4 k0 = *(const f32x4*)kp, k1 = *(const f32x4*)(kp + 4), v0 = *(const f32x4*)(kp + 512), v1 = *(const f32x4*)(kp + 516); SA_STEP(k0, k1, v0, v1); }
#undef SA_STEP
    const float inv = 1.0f / ls;
    v4u w; w.x = cvt_pk_bf16(o[0] * inv, o[1] * inv); w.y = cvt_pk_bf16(o[2] * inv, o[3] * inv); w.z = cvt_pk_bf16(o[4] * inv, o[5] * inv); w.w = cvt_pk_bf16(o[6] * inv, o[7] * inv);
    if (src < 3) { *(v4u*)((bf16*)(ws + WS_OG) + (size_t)row * 1536 + src * 512 + h * 128 + 8 * sub) = w; if (sub == 0) ((float*)(ws + WS_LSE))[(size_t)row * 12 + src * 4 + h] = (mx + fast_log2(ls)) * LN2; }
    else *(v4u*)((bf16*)(ws + WS_OALL) + (size_t)row * 1536 + 1024 + h * 128 + 8 * sub) = w;
}
__device__ __forceinline__ void p4_sample_attn_shared(const Frame& F, int db, int h, const bool is_mem, const float* cache) {
    unsigned char* ws = F.ws; const int lane = F.lane, sub = lane & 15, gk = lane >> 4; const int rowq0 = MP + db * 4;
    float qv[4][8];
#pragma unroll
    for (int t = 0; t < 4; ++t) { const bf16* qp = is_mem ? (const bf16*)(ws + WS_MQ) + (size_t)(rowq0 + t) * 512 + h * 128 + 8 * sub : (const bf16*)(ws + WS_QS) + (size_t)(rowq0 + t) * 1536 + h * 128 + 8 * sub;
        const v4u qw = *(const v4u*)qp; qv[t][0] = bflo(qw.x); qv[t][1] = bfhi(qw.x); qv[t][2] = bflo(qw.y); qv[t][3] = bfhi(qw.y); qv[t][4] = bflo(qw.z); qv[t][5] = bfhi(qw.z); qv[t][6] = bflo(qw.w); qv[t][7] = bfhi(qw.w); }
    float m[4], l[4], o[4][8];
#pragma unroll
    for (int t = 0; t < 4; ++t) { m[t] = -3.0e38f; l[t] = 0.f;
#pragma unroll
        for (int j = 0; j < 8; ++j) o[t][j] = 0.f; }
#define SS_STEP(P, K0, K1, V0, V1) do { _Pragma("unroll") for (int t = 0; t < 4; ++t) { \
        float s_ = (qv[t][0] * K0.x + qv[t][1] * K0.y) + (qv[t][2] * K0.z + qv[t][3] * K0.w) + (qv[t][4] * K1.x + qv[t][5] * K1.y) + (qv[t][6] * K1.z + qv[t][7] * K1.w); \
        s_ += __shfl_xor(s_, 1); s_ += __shfl_xor(s_, 2); s_ += __shfl_xor(s_, 4); s_ += __shfl_xor(s_, 8); \
        const bool ok_ = is_mem || ((P) >= t && (P) <= 128 + t); \
        const float mn_ = ok_ ? fmaxf(m[t], s_) : m[t], sc_ = fast_exp2(m[t] - mn_), p_ = ok_ ? fast_exp2(s_ - mn_) : 0.f; m[t] = mn_; l[t] = l[t] * sc_ + p_; \
        o[t][0] = o[t][0] * sc_ + p_ * V0.x; o[t][1] = o[t][1] * sc_ + p_ * V0.y; o[t][2] = o[t][2] * sc_ + p_ * V0.z; o[t][3] = o[t][3] * sc_ + p_ * V0.w; \
        o[t][4] = o[t][4] * sc_ + p_ * V1.x; o[t][5] = o[t][5] * sc_ + p_ * V1.y; o[t][6] = o[t][6] * sc_ + p_ * V1.z; o[t][7] = o[t][7] * sc_ + p_ * V1.w; } } while (0)
    const int L = is_mem ? 256 : 128;
    const float* kbase = cache + ((size_t)db * L * 2) * 512 + h * 128 + 8 * sub + (size_t)gk * 1024;
    for (int j = 0; j < L / 4; j += 4) {
        f32x4 kk[4][2], vv[4][2];
#pragma unroll
        for (int e = 0; e < 4; ++e) { const float* kp = kbase + (size_t)(j + e) * 4096; kk[e][0] = *(const f32x4*)kp; kk[e][1] = *(const f32x4*)(kp + 4); vv[e][0] = *(const f32x4*)(kp + 512); vv[e][1] = *(const f32x4*)(kp + 516); }
#pragma unroll
        for (int e = 0; e < 4; ++e) SS_STEP(4 * (j + e) + gk, kk[e][0], kk[e][1], vv[e][0], vv[e][1]);
    }
    if (!is_mem) {
        const size_t ro = (size_t)(rowq0 + gk) * 1536 + h * 128 + 8 * sub;
        const v4u kw = *(const v4u*)((const bf16*)(ws + WS_KS) + ro), vw = *(const v4u*)((const bf16*)(ws + WS_VS) + ro);
        const f32x4 k0 = {bflo(kw.x), bfhi(kw.x), bflo(kw.y), bfhi(kw.y)}, k1 = {bflo(kw.z), bfhi(kw.z), bflo(kw.w), bfhi(kw.w)};
        const f32x4 v0 = {bflo(vw.x), bfhi(vw.x), bflo(vw.y), bfhi(vw.y)}, v1 = {bflo(vw.z), bfhi(vw.z), bflo(vw.w), bfhi(vw.w)};
        SS_STEP(128 + gk, k0, k1, v0, v1);
    }
#undef SS_STEP
    float mo = 0.f, lo = 1.f, oo[8];
#pragma unroll
    for (int j = 0; j < 8; ++j) oo[j] = 0.f;
#pragma unroll
    for (int t = 0; t < 4; ++t) {
        float mm = fmaxf(m[t], __shfl_xor(m[t], 16)); mm = fmaxf(mm, __shfl_xor(mm, 32));
        const float f = fast_exp2(m[t] - mm); float lt = l[t] * f; lt += __shfl_xor(lt, 16); lt += __shfl_xor(lt, 32);
        if (gk == t) { mo = mm; lo = lt; }
#pragma unroll
        for (int j = 0; j < 8; ++j) { float x = o[t][j] * f; x += __shfl_xor(x, 16); x += __shfl_xor(x, 32); if (gk == t) oo[j] = x; }
    }
    const float inv = 1.0f / lo; const int row = rowq0 + gk;
    v4u w; w.x = cvt_pk_bf16(oo[0] * inv, oo[1] * inv); w.y = cvt_pk_bf16(oo[2] * inv, oo[3] * inv); w.z = cvt_pk_bf16(oo[4] * inv, oo[5] * inv); w.w = cvt_pk_bf16(oo[6] * inv, oo[7] * inv);
    if (is_mem) *(v4u*)((bf16*)(ws + WS_OALL) + (size_t)row * 1536 + 1024 + h * 128 + 8 * sub) = w;
    else { *(v4u*)((bf16*)(ws + WS_OG) + (size_t)row * 1536 + h * 128 + 8 * sub) = w; if (sub == 0) ((float*)(ws + WS_LSE))[(size_t)row * 12 + h] = (mo + fast_log2(lo)) * LN2; }
}
__device__ __forceinline__ void p4_sample_task(const Frame& F, int it, const float* c0, const float* c1, const float* c2, const float* cm) {
    const int kind = it >> 9, idx = it & 511, db = idx >> 2, h = idx & 3;
    if (kind == 0) p4_sample_attn(F, db * 16 + h * 4 + 2, c0, c1, c2, cm);
    else if (kind == 1) p4_sample_attn(F, db * 16 + h * 4 + 1, c0, c1, c2, cm);
    else if (kind == 2) p4_sample_attn_shared(F, db, h, true, cm);
    else p4_sample_attn_shared(F, db, h, false, c0);
}
__device__ __forceinline__ void p4_sample_loop(const Frame& F, const float* c0, const float* c1, const float* c2, const float* cm, int q = 0) {
    gu32* qw = (gu32*)(F.ws + WS_CTL) + 64 + 64 * q;
    for (;;) { unsigned v = 0; if (F.lane == 0) v = __hip_atomic_fetch_add(qw, 1u, RLX_AGENT); const int it = (int)__builtin_amdgcn_readfirstlane(v);
        if (it >= 2048) break; p4_sample_task(F, it, c0, c1, c2, cm); }
}
__device__ __forceinline__ void p4_gla_chain(const Frame& F, int row0, int T, int h, const float* S0, float* Sout) {
    unsigned char* ws = F.ws; const int tid = F.tid, v = tid & 127, ks = __builtin_amdgcn_readfirstlane(tid >> 7);
    const float* GA = (const float*)(ws + WS_GA); const bf16* GQ = (const bf16*)(ws + WS_GQ); const bf16* GK = (const bf16*)(ws + WS_GK); const bf16* GV = (const bf16*)(ws + WS_GV); bf16* GO = (bf16*)(ws + WS_GO);
    LAS float* part = (LAS float*)(F.lds + RING_OFF);
    float S[16];
#pragma unroll
    for (int i = 0; i < 16; ++i) S[i] = S0 ? S0[(size_t)(16 * ks + i) * 128 + v] : 0.f;
    for (int t0 = 0; t0 < T; t0 += 16) {
        const int nb = (T - t0) < 16 ? (T - t0) : 16;
        __syncthreads();
        for (int tt = 0; tt < nb; ++tt) {
            const size_t row = (size_t)(row0 + t0 + tt);
            const float* ap = GA + row * 256 + h * 64 + 16 * ks; const v4u kw0 = *(const v4u*)(GK + row * 256 + h * 64 + 16 * ks), kw1 = *(const v4u*)(GK + row * 256 + h * 64 + 16 * ks + 8);
            const v4u qw0 = *(const v4u*)(GQ + row * 256 + h * 64 + 16 * ks), qw1 = *(const v4u*)(GQ + row * 256 + h * 64 + 16 * ks + 8);
            const float vv = bf2f(GV[row * 512 + h * 128 + v]);
            const f32x4 a0 = *(const f32x4*)ap, a1 = *(const f32x4*)(ap + 4), a2 = *(const f32x4*)(ap + 8), a3 = *(const f32x4*)(ap + 12);
            const float la[16] = {a0.x, a0.y, a0.z, a0.w, a1.x, a1.y, a1.z, a1.w, a2.x, a2.y, a2.z, a2.w, a3.x, a3.y, a3.z, a3.w};
            const float kk[16] = {bflo(kw0.x), bfhi(kw0.x), bflo(kw0.y), bfhi(kw0.y), bflo(kw0.z), bfhi(kw0.z), bflo(kw0.w), bfhi(kw0.w), bflo(kw1.x), bfhi(kw1.x), bflo(kw1.y), bfhi(kw1.y), bflo(kw1.z), bfhi(kw1.z), bflo(kw1.w), bfhi(kw1.w)};
            const float qq[16] = {bflo(qw0.x), bfhi(qw0.x), bflo(qw0.y), bfhi(qw0.y), bflo(qw0.z), bfhi(qw0.z), bflo(qw0.w), bfhi(qw0.w), bflo(qw1.x), bfhi(qw1.x), bflo(qw1.y), bfhi(qw1.y), bflo(qw1.z), bfhi(qw1.z), bflo(qw1.w), bfhi(qw1.w)};
            float o = 0.f;
#pragma unroll
            for (int i = 0; i < 16; ++i) { S[i] = fast_exp2(la[i] * 1.4426950408889634f) * S[i] + kk[i] * vv; o += qq[i] * S[i]; }
            part[(tt * 4 + ks) * 128 + v] = o;
        }
        __syncthreads();
        for (int e = tid; e < nb * 128; e += 512) { const int tt = e >> 7, vv_ = e & 127;
            GO[(size_t)(row0 + t0 + tt) * 512 + h * 128 + vv_] = (bf16)f2bf((part[(tt * 4 + 0) * 128 + vv_] + part[(tt * 4 + 1) * 128 + vv_]) + (part[(tt * 4 + 2) * 128 + vv_] + part[(tt * 4 + 3) * 128 + vv_])); }
    }
#pragma unroll
    for (int i = 0; i < 16; ++i) Sout[(size_t)(16 * ks + i) * 128 + v] = S[i];
}
constexpr int GL_QE = 0, GL_KE = 8192, GL_KDT = 16384, GL_VV = 24576, GL_EB = 40960, GL_TOT = 41216, GL_SET = 43264;
__device__ __forceinline__ int goff(int r, int c) { return 128 * r + 16 * (c ^ ((r >> 1) & 7)); }
__device__ __forceinline__ int gvoff(int row, int ch) { return 256 * row + 16 * (ch ^ (((row & 3) | ((((row >> 2) ^ (row >> 3)) & 1) << 2)) << 1)); }
__device__ __forceinline__ void p4_gla_chain_mfma(const Frame& F, int c) {
    unsigned char* ws = F.ws; const int tid = F.tid, lane = F.lane, w = F.wave, l15 = lane & 15, g4 = lane >> 4, q4 = l15 >> 2, p4 = lane & 3;
    const int b = c >> 2, h = c & 3; const size_t row0 = (size_t)b * SEQ;
    const float* GA = (const float*)(ws + WS_GA) + h * 64 + lane; const bf16* GQ = (const bf16*)(ws + WS_GQ) + h * 64 + lane; const bf16* GK = (const bf16*)(ws + WS_GK) + h * 64 + lane;
    const bf16* GV = (const bf16*)(ws + WS_GV) + h * 128 + (tid & 15) * 8; bf16* GO = (bf16*)(ws + WS_GO) + h * 128 + 16 * w + 4 * g4;
    constexpr float L2E = 1.4426950408889634f;
    f32x4 S[4];
#pragma unroll
    for (int K = 0; K < 4; ++K) S[K] = (f32x4){0.f, 0.f, 0.f, 0.f};
    float la[8]; unsigned short qh[8], kh[8]; v4u vr[2];
#define GLA_LOAD(ch) do { const size_t r_ = row0 + 64 * (size_t)(ch); \
        _Pragma("unroll") for (int t = 0; t < 8; ++t) { const size_t rr_ = (r_ + 8 * w + t) * 256; la[t] = GA[rr_]; qh[t] = GQ[rr_]; kh[t] = GK[rr_]; } \
        _Pragma("unroll") for (int e = 0; e < 2; ++e) vr[e] = *(const v4u*)(GV + (r_ + (tid >> 4) + 32 * e) * 512); } while (0)
    GLA_LOAD(0);
#pragma unroll 1
    for (int ch = 0; ch < SEQ / 64; ++ch) {
        LAS unsigned char* B = F.lds + RING_OFF + (ch & 1) * GL_SET;
        LAS float* TOT = (LAS float*)(B + GL_TOT); LAS float* EB = (LAS float*)(B + GL_EB);
        float cs[8], qv[8], kvv[8];
        cs[0] = la[0];
#pragma unroll
        for (int t = 1; t < 8; ++t) cs[t] = cs[t - 1] + la[t];
#pragma unroll
        for (int t = 0; t < 8; ++t) { qv[t] = bf2f(qh[t]); kvv[t] = bf2f(kh[t]); }
        TOT[w * 64 + lane] = cs[7];
#pragma unroll
        for (int e = 0; e < 2; ++e) *(LAS v4u*)(B + GL_VV + gvoff((tid >> 4) + 32 * e, tid & 15)) = vr[e];
        __syncthreads();
        float offs = 0.f, total = 0.f;
#pragma unroll
        for (int g = 0; g < 8; ++g) { const float tg = TOT[g * 64 + lane]; total += tg; offs += (g < w) ? tg : 0.f; }
        unsigned kd[8];
#pragma unroll
        for (int t = 0; t < 8; ++t) { const float bt = offs + cs[t]; const int i = 8 * w + t;
            const float e1 = fast_exp2(bt * L2E), e2 = fast_exp2(-bt * L2E), e3 = fast_exp2((total - bt) * L2E);
            *(LAS unsigned short*)(B + GL_QE + goff(i, lane >> 3) + 2 * (lane & 7)) = (unsigned short)f2bf(qv[t] * e1);
            *(LAS unsigned short*)(B + GL_KE + goff(i, lane >> 3) + 2 * (lane & 7)) = (unsigned short)f2bf(kvv[t] * e2);
            kd[t] = f2bf(kvv[t] * e3); }
        { v4u kw; kw.x = kd[0] | (kd[1] << 16); kw.y = kd[2] | (kd[3] << 16); kw.z = kd[4] | (kd[5] << 16); kw.w = kd[6] | (kd[7] << 16); *(LAS v4u*)(B + GL_KDT + goff(lane, w)) = kw; }
        if (w == 0) EB[lane] = fast_exp2(total * L2E);
        if (ch + 1 < SEQ / 64) GLA_LOAD(ch + 1);
        __syncthreads();
        const LAS unsigned char* QE = B + GL_QE; const LAS unsigned char* KE = B + GL_KE; const LAS unsigned char* KDT = B + GL_KDT; const LAS unsigned char* VV = B + GL_VV;
        bf16x8 kef[4][2];
#pragma unroll
        for (int J = 0; J < 4; ++J)
#pragma unroll
            for (int s = 0; s < 2; ++s) kef[J][s] = *(const LAS bf16x8*)(KE + goff(16 * J + l15, 4 * s + g4));
        bf16x8 vpr[2], vnat[2];
#pragma unroll
        for (int pp = 0; pp < 2; ++pp) { const int ra = 32 * pp + 4 * g4 + q4, rb = ra + 16;
            const s16x4 t1 = vtr(VV + gvoff(ra, 2 * w + (p4 >> 1)) + 8 * (p4 & 1)), t2 = vtr(VV + gvoff(rb, 2 * w + (p4 >> 1)) + 8 * (p4 & 1));
            vpr[pp] = (bf16x8){t1[0], t1[1], t1[2], t1[3], t2[0], t2[1], t2[2], t2[3]}; }
#pragma unroll
        for (int s = 0; s < 2; ++s) { const int r1 = 32 * s + 8 * g4 + q4, r2 = r1 + 4;
            const s16x4 t1 = vtr(VV + gvoff(r1, 2 * w + (p4 >> 1)) + 8 * (p4 & 1)), t2 = vtr(VV + gvoff(r2, 2 * w + (p4 >> 1)) + 8 * (p4 & 1));
            vnat[s] = (bf16x8){t1[0], t1[1], t1[2], t1[3], t2[0], t2[1], t2[2], t2[3]}; }
        bf16x8 sfr[2];
#pragma unroll
        for (int p = 0; p < 2; ++p) { v4u sw; sw.x = cvt_pk_bf16(S[2 * p].x, S[2 * p].y); sw.y = cvt_pk_bf16(S[2 * p].z, S[2 * p].w); sw.z = cvt_pk_bf16(S[2 * p + 1].x, S[2 * p + 1].y); sw.w = cvt_pk_bf16(S[2 * p + 1].z, S[2 * p + 1].w); sfr[p] = __builtin_bit_cast(bf16x8, sw); }
#pragma unroll
        for (int I = 0; I < 4; ++I) {
            f32x4 oT = (f32x4){0.f, 0.f, 0.f, 0.f};
#pragma unroll
            for (int p = 0; p < 2; ++p) {
                const v2u lo = *(const LAS v2u*)(QE + goff(16 * I + l15, 4 * p + (g4 >> 1)) + 8 * (g4 & 1)), hi = *(const LAS v2u*)(QE + goff(16 * I + l15, 4 * p + 2 + (g4 >> 1)) + 8 * (g4 & 1));
                const v4u bw = {lo.x, lo.y, hi.x, hi.y};
                oT = __builtin_amdgcn_mfma_f32_16x16x32_bf16(sfr[p], __builtin_bit_cast(bf16x8, bw), oT, 0, 0, 0); }
            bf16x8 qef[2];
#pragma unroll
            for (int s = 0; s < 2; ++s) qef[s] = *(const LAS bf16x8*)(QE + goff(16 * I + l15, 4 * s + g4));
            f32x4 d1[4];
#pragma unroll
            for (int J = 0; J < 4; ++J) { d1[J] = (f32x4){0.f, 0.f, 0.f, 0.f};
                if (J <= I) {
#pragma unroll
                    for (int s = 0; s < 2; ++s) d1[J] = __builtin_amdgcn_mfma_f32_16x16x32_bf16(kef[J][s], qef[s], d1[J], 0, 0, 0);
                    if (J == I) {
#pragma unroll
                        for (int r = 0; r < 4; ++r) d1[J][r] = (4 * g4 + r <= l15) ? d1[J][r] : 0.f; } } }
#pragma unroll
            for (int pp = 0; pp < 2; ++pp) if (2 * pp <= I) {
                const f32x4 pa = d1[2 * pp], pb = d1[2 * pp + 1];
                v4u pw; pw.x = cvt_pk_bf16(pa.x, pa.y); pw.y = cvt_pk_bf16(pa.z, pa.w); pw.z = cvt_pk_bf16(pb.x, pb.y); pw.w = cvt_pk_bf16(pb.z, pb.w);
                oT = __builtin_amdgcn_mfma_f32_16x16x32_bf16(vpr[pp], __builtin_bit_cast(bf16x8, pw), oT, 0, 0, 0); }
            { v2u ow; ow.x = cvt_pk_bf16(oT.x, oT.y); ow.y = cvt_pk_bf16(oT.z, oT.w); *(v2u*)(GO + (row0 + 64 * (size_t)ch + 16 * I + l15) * 512) = ow; }
        }
#pragma unroll
        for (int K = 0; K < 4; ++K) {
            const f32x4 ebv = *(const LAS f32x4*)(EB + 16 * K + 4 * g4); S[K] *= ebv;
#pragma unroll
            for (int s = 0; s < 2; ++s) { const bf16x8 kdf = *(const LAS bf16x8*)(KDT + goff(16 * K + l15, 4 * s + g4)); S[K] = __builtin_amdgcn_mfma_f32_16x16x32_bf16(kdf, vnat[s], S[K], 0, 0, 0); } }
    }
#undef GLA_LOAD
    float* so = F.out + O_GLAP + (size_t)c * 64 * 128 + 16 * w + l15;
#pragma unroll
    for (int K = 0; K < 4; ++K)
#pragma unroll
        for (int r = 0; r < 4; ++r) so[(size_t)(16 * K + 4 * g4 + r) * 128] = S[K][r];
}
template <int NR> __device__ __forceinline__ void p5_combine_rows(const Frame& F, int row0, int rstride) {
    unsigned char* ws = F.ws; const int lane = F.lane, hh = lane >> 4, sub = lane & 15, col = hh * 128 + 8 * sub;
    float l0[NR], l1[NR], l2[NR]; v4u a[NR], b[NR], c[NR], gow[NR], gr[NR];
    const float* gg = F.i15 + 8 * sub; const f32x4 g0 = *(const f32x4*)gg, g1 = *(const f32x4*)(gg + 4);
#pragma unroll
    for (int r = 0; r < NR; ++r) { const int row = row0 + r * rstride;
        const float* lse = (const float*)(ws + WS_LSE) + (size_t)row * 12; l0[r] = lse[hh]; l1[r] = lse[4 + hh]; l2[r] = lse[8 + hh];
        const bf16* og = (const bf16*)(ws + WS_OG) + (size_t)row * 1536 + col; a[r] = *(const v4u*)og; b[r] = *(const v4u*)(og + 512); c[r] = *(const v4u*)(og + 1024);
        gow[r] = *(const v4u*)((const bf16*)(ws + WS_GO) + (size_t)row * 512 + col); gr[r] = *(const v4u*)((const bf16*)(ws + WS_GRS) + (size_t)row * 512 + col); }
#pragma unroll
    for (int r = 0; r < NR; ++r) { const int row = row0 + r * rstride;
        const float mx = fmaxf(l0[r], fmaxf(l1[r], l2[r]));
        float w0 = __expf(l0[r] - mx), w1 = __expf(l1[r] - mx), w2 = __expf(l2[r] - mx); const float wi = 1.0f / (w0 + w1 + w2); w0 *= wi; w1 *= wi; w2 *= wi;
        v4u o;
        o.x = cvt_pk_bf16(w0 * bflo(a[r].x) + w1 * bflo(b[r].x) + w2 * bflo(c[r].x), w0 * bfhi(a[r].x) + w1 * bfhi(b[r].x) + w2 * bfhi(c[r].x));
        o.y = cvt_pk_bf16(w0 * bflo(a[r].y) + w1 * bflo(b[r].y) + w2 * bflo(c[r].y), w0 * bfhi(a[r].y) + w1 * bfhi(b[r].y) + w2 * bfhi(c[r].y));
        o.z = cvt_pk_bf16(w0 * bflo(a[r].z) + w1 * bflo(b[r].z) + w2 * bflo(c[r].z), w0 * bfhi(a[r].z) + w1 * bfhi(b[r].z) + w2 * bfhi(c[r].z));
        o.w = cvt_pk_bf16(w0 * bflo(a[r].w) + w1 * bflo(b[r].w) + w2 * bflo(c[r].w), w0 * bfhi(a[r].w) + w1 * bfhi(b[r].w) + w2 * bfhi(c[r].w));
        bf16* oall = (bf16*)(ws + WS_OALL) + (size_t)row * 1536;
        *(v4u*)(oall + col) = o;
        const f32x4 x0 = {bflo(gow[r].x), bfhi(gow[r].x), bflo(gow[r].y), bfhi(gow[r].y)}, x1 = {bflo(gow[r].z), bfhi(gow[r].z), bflo(gow[r].w), bfhi(gow[r].w)};
        float ss = (x0.x * x0.x + x0.y * x0.y) + (x0.z * x0.z + x0.w * x0.w) + (x1.x * x1.x + x1.y * x1.y) + (x1.z * x1.z + x1.w * x1.w);
        ss += __shfl_xor(ss, 1); ss += __shfl_xor(ss, 2); ss += __shfl_xor(ss, 4); ss += __shfl_xor(ss, 8);
        const float rstd = 1.0f / sqrtf(ss * (1.f / 128.f) + EPS);
        v4u y;
        y.x = cvt_pk_bf16(x0.x * rstd * g0.x * bflo(gr[r].x), x0.y * rstd * g0.y * bfhi(gr[r].x)); y.y = cvt_pk_bf16(x0.z * rstd * g0.z * bflo(gr[r].y), x0.w * rstd * g0.w * bfhi(gr[r].y));
        y.z = cvt_pk_bf16(x1.x * rstd * g1.x * bflo(gr[r].z), x1.y * rstd * g1.y * bfhi(gr[r].z)); y.w = cvt_pk_bf16(x1.z * rstd * g1.z * bflo(gr[r].w), x1.w * rstd * g1.w * bfhi(gr[r].w));
        *(v4u*)(oall + 512 + col) = y; }
}
template <int NR> __device__ __forceinline__ void p10_final_rows(const Frame& F, int row0, int rstride) {
    const GAS f32x4* gr = (const GAS f32x4*)F.i24 + 2 * F.lane; const f32x4 g00 = gr[0], g01 = gr[1], g10 = gr[128], g11 = gr[129];
    v4u v[NR][2];
#pragma unroll
    for (int r = 0; r < NR; ++r) { const GAS v4u* xr = (const GAS v4u*)((const bf16*)(F.ws + WS_Y16) + (size_t)(row0 + r * rstride) * D) + F.lane; v[r][0] = xr[0]; v[r][1] = xr[64]; }
#pragma unroll
    for (int r = 0; r < NR; ++r) { float x[2][8]; float s = 0.f;
#pragma unroll
        for (int j = 0; j < 2; ++j) { x[j][0] = bflo(v[r][j].x); x[j][1] = bfhi(v[r][j].x); x[j][2] = bflo(v[r][j].y); x[j][3] = bfhi(v[r][j].y); x[j][4] = bflo(v[r][j].z); x[j][5] = bfhi(v[r][j].z); x[j][6] = bflo(v[r][j].w); x[j][7] = bfhi(v[r][j].w);
#pragma unroll
            for (int e = 0; e < 8; ++e) s += x[j][e] * x[j][e]; }
        const float rstd = 1.0f / sqrtf(wave_sum(s) * (1.f / D) + EPS);
        GAS f32x4* yr = (GAS f32x4*)(F.out + (size_t)(row0 + r * rstride) * D) + 2 * F.lane;
        yr[0] = (f32x4){x[0][0] * rstd * g00.x, x[0][1] * rstd * g00.y, x[0][2] * rstd * g00.z, x[0][3] * rstd * g00.w};
        yr[1] = (f32x4){x[0][4] * rstd * g01.x, x[0][5] * rstd * g01.y, x[0][6] * rstd * g01.z, x[0][7] * rstd * g01.w};
        yr[128] = (f32x4){x[1][0] * rstd * g10.x, x[1][1] * rstd * g10.y, x[1][2] * rstd * g10.z, x[1][3] * rstd * g10.w};
        yr[129] = (f32x4){x[1][4] * rstd * g11.x, x[1][5] * rstd * g11.y, x[1][6] * rstd * g11.z, x[1][7] * rstd * g11.w}; }
}
__device__ __forceinline__ void phase1(Frame& F) {
    unsigned char* ws = F.ws; const int G = F.G, bx = (int)blockIdx.x;
    { pg8::Gemm g{(const bf16*)(ws + WS_XB), (const bf16*)(ws + WS_W1A), MR, 2 * FF, D, D, D}; typedef pg8::StaticOrderT<MR / 256, 2 * FF / 256> SO; SO S; S.init(MR, 2 * FF, G, bx);
      EpiSwiglu E{(bf16*)(ws + WS_G), nullptr}; pg8::gemm_phase<EpiSwiglu, SO>(F.lds + RING_OFF, g, S, E, F.wave, MK_STAGGER_A); }
    { pg8::Gemm g{(const bf16*)(ws + WS_MEMB), (const bf16*)(ws + WS_WMEM), MM, D, D, D, D}; typedef pg8::StaticOrderT<MM / 256, D / 256> SO; SO S; S.init(MM, D, G, (bx + G / 2) % G);
      EpiMemKV E{F.out + O_MEMKV, (bf16*)(ws + WS_MKV)}; pg8::gemm_phase<EpiMemKV, SO>(F.lds + RING_OFF, g, S, E, F.wave); }
}
__device__ __forceinline__ void phase2(Frame& F) {
    unsigned char* ws = F.ws; const int G = F.G, bx = (int)blockIdx.x;
    pg8::Gemm g{(const bf16*)(ws + WS_G), (const bf16*)(ws + WS_W1O), MR, D, FF, 64, FF};   typedef pg8::StaticOrderT<MR / 256, D / 256> SO; SO S; S.init(MR, D, G, bx);
    EpiResidX<true> E{F.i0, F.i1, (bf16*)(ws + WS_HB), (float*)(ws + WS_PQ1), 0.5f};
    S.lim = 1024; S.rev = 1; pg8::gemm_phase<EpiResidX<true>, SO, true, true>(F.lds + RING_OFF, g, S, E, F.wave);
    tail_phase<EpiResidX<true>, true>(F, g.A, 64, g.Bt, FF, FF, E, 0);
}
__device__ __forceinline__ void phase3(Frame& F) {
    unsigned char* ws = F.ws; const int G = F.G, bx = (int)blockIdx.x;
    pg8::Gemm g{(const bf16*)(ws + WS_HB), (const bf16*)(ws + WS_WIN), MR, NZ, D, D, D}; typedef pg8::StaticOrderT<MR / 256, NZ / 256> SO; SO S; S.init(MR, NZ, G, bx);
    EpiZ E{(const float*)(ws + WS_PQ1), (const float*)(ws + WS_ROPE), (const float*)(ws + WS_ROPE) + NPOS * 64, F.i14, F.out,
           (bf16*)(ws + WS_QS), (bf16*)(ws + WS_KS), (bf16*)(ws + WS_VS), (bf16*)(ws + WS_GQ), (bf16*)(ws + WS_GK), (bf16*)(ws + WS_GV), (bf16*)(ws + WS_GRS), (bf16*)(ws + WS_MQ), (bf16*)(ws + WS_GATE), (float*)(ws + WS_GA)};
    pg8::gemm_phase<EpiZ, SO>(F.lds + RING_OFF, g, S, E, F.wave, MK_STAGGER_Z);
}
constexpr int CW_Q = 64;
__device__ __forceinline__ int q_pull(const Frame& F, int q) {
    gu32* qw = (gu32*)(F.ws + WS_CTL) + CW_Q + 64 * q;
    volatile LAS unsigned* slot = (volatile LAS unsigned*)(F.lds + MISC_OFF) + 16;
    __syncthreads();
    if (F.tid == 0) *slot = __hip_atomic_fetch_add(qw, 1u, RLX_AGENT);
    __syncthreads();
    return (int)*slot;
}
__device__ __forceinline__ void phase4(Frame& F, const float* c0, const float* c1, const float* c2, const float* cm) {
    const int bx = (int)blockIdx.x;
    if (bx < NB * 4) p4_gla_chain_mfma(F, bx);
    else p4_sample_loop(F, c0, c1, c2, cm);
#pragma unroll 1
    for (int rep = 0; rep < (MK_P4_REPEAT == 2 ? 2 : 1); ++rep) for (;;) { const int it = q_pull(F, 1 + 4 * rep); if (it >= 768) break; attn_batch<0, 8>(F, 8 * (767 - it)); }
#pragma unroll 1
    for (int rep = 0; rep < (MK_P4_REPEAT == 3 ? 2 : 1); ++rep) for (;;) { const int it = q_pull(F, 2 + 4 * rep); if (it >= 256) break; attn_batch<1, 8>(F, 6144 + 8 * (255 - it)); }
    p4_sample_loop(F, c0, c1, c2, cm);
    if (MK_P4_REPEAT == 1) { __syncthreads(); p4_sample_loop(F, c0, c1, c2, cm, 4); }
    if (MK_P4_REPEAT == 4) { __syncthreads(); if (bx < NB * 4) p4_gla_chain_mfma(F, bx); }
    if (MK_P4_REPEAT == 5) { for (;;) { const int c = q_pull(F, 7); if (c >= DECB * 4) break; p4_gla_chain(F, MP + (c >> 2) * DECT, DECT, c & 3, F.i7 + (size_t)c * 64 * 128, F.out + O_GLAS + (size_t)c * 64 * 128); } }
    for (;;) { const int c = q_pull(F, 3); if (c >= DECB * 4) break; p4_gla_chain(F, MP + (c >> 2) * DECT, DECT, c & 3, F.i7 + (size_t)c * 64 * 128, F.out + O_GLAS + (size_t)c * 64 * 128); }
    if (F.G < NB * 4) { for (int c = F.G + bx; c < NB * 4; c += F.G) p4_gla_chain_mfma(F, c); }
}
__device__ __forceinline__ void phase5(Frame& F) {
    { const int st = F.G * NWAVES; int m = F.vcu * NWAVES + F.wave;
      for (; m + 3 * st < MR; m += 4 * st) p5_combine_rows<4>(F, m, st);
      for (; m < MR; m += st) p5_combine_rows<1>(F, m, st); }
}
__device__ __forceinline__ void phase6(Frame& F) {
    unsigned char* ws = F.ws; const int G = F.G, bx = (int)blockIdx.x;
    pg8::Gemm g{(const bf16*)(ws + WS_OALL), (const bf16*)(ws + WS_WBR), MR, D, 1536, 1536, 1536}; typedef pg8::StaticOrderT<MR / 256, D / 256> SO; SO S; S.init(MR, D, G, bx);
    S.lim = 1024; S.rev = 1; EpiMerge1 E{(const bf16*)(ws + WS_GATE), (bf16*)(ws + WS_MB)}; pg8::gemm_phase<EpiMerge1, SO>(F.lds + RING_OFF, g, S, E, F.wave);
    tail_phase_merge(F, g.A, g.Bt, E, 3);
}
__device__ __forceinline__ void phase7(Frame& F) {
    unsigned char* ws = F.ws; const int G = F.G, bx = (int)blockIdx.x;
    pg8::Gemm g{(const bf16*)(ws + WS_MB), (const bf16*)(ws + WS_WOUT), MR, D, D, D, D}; typedef pg8::StaticOrderT<MR / 256, D / 256> SO; SO S; S.init(MR, D, G, bx);
    EpiResidB<true> E{(const bf16*)(ws + WS_HB), (bf16*)(ws + WS_HB), (float*)(ws + WS_PQ2), 1.0f};
    S.lim = 1024; pg8::gemm_phase<EpiResidB<true>, SO>(F.lds + RING_OFF, g, S, E, F.wave);
    tail_phase<EpiResidB<true>>(F, g.A, D, g.Bt, D, D, E, 1);
}
__device__ __forceinline__ void phase8(Frame& F) {
    unsigned char* ws = F.ws; const int G = F.G, bx = (int)blockIdx.x;
    pg8::Gemm g{(const bf16*)(ws + WS_HB), (const bf16*)(ws + WS_W2A), MR, 2 * FF, D, D, D}; typedef pg8::StaticOrderT<MR / 256, 2 * FF / 256> SO; SO S; S.init(MR, 2 * FF, G, bx);
    EpiSwiglu E{(bf16*)(ws + WS_G), (const float*)(ws + WS_PQ2)}; pg8::gemm_phase<EpiSwiglu, SO>(F.lds + RING_OFF, g, S, E, F.wave, MK_STAGGER_A);
}
__device__ __forceinline__ void phase9(Frame& F) {
    unsigned char* ws = F.ws; const int G = F.G, bx = (int)blockIdx.x;
    pg8::Gemm g{(const bf16*)(ws + WS_G), (const bf16*)(ws + WS_W2O), MR, D, FF, 64, FF};   typedef pg8::StaticOrderT<MR / 256, D / 256> SO; SO S; S.init(MR, D, G, bx);
    EpiResidB<false> E{(const bf16*)(ws + WS_HB), (bf16*)(ws + WS_Y16), nullptr, 0.5f};
    S.lim = 1024; S.rev = 1; pg8::gemm_phase<EpiResidB<false>, SO, true, true>(F.lds + RING_OFF, g, S, E, F.wave);
    tail_phase<EpiResidB<false>, true>(F, g.A, 64, g.Bt, FF, FF, E, 2);
}
__device__ __forceinline__ void phase10(Frame& F) {
    { const int st = F.G * NWAVES; int m = F.vcu * NWAVES + F.wave;
      for (; m + 3 * st < MR; m += 4 * st) p10_final_rows<4>(F, m, st);
      for (; m < MR; m += st) p10_final_rows<1>(F, m, st); }
}
__device__ __forceinline__ void xcd_barrier_or_skip(const XcdBarrier& b, bool on, int wave) { if (on) xcd_barrier(b, wave); }
constexpr int N_PHASES = 11;
__global__ void __launch_bounds__(NWAVES * 64, 2) mk_fwd(Args args) {
    extern __shared__ __attribute__((aligned(16))) unsigned char lds[];
    Frame F;
    F.lds = (LAS unsigned char*)lds;
    F.wave = __builtin_amdgcn_readfirstlane((int)(threadIdx.x >> 6)); F.lane = lane_id(); F.tid = F.wave * 64 + F.lane;
    F.G = gridDim.x; { const int bx = blockIdx.x; F.vcu = (F.G % 8 == 0) ? (bx % 8) * (F.G / 8) + bx / 8 : bx; }
    F.i0 = args.in[0]; F.i1 = args.in[1]; F.i2 = args.in[2]; F.i3 = args.in[3]; F.i4 = args.in[4]; F.i5 = args.in[5]; F.i6 = args.in[6]; F.i7 = args.in[7]; F.i8 = args.in[8]; F.i9 = args.in[9]; F.i10 = args.in[10]; F.i11 = args.in[11]; F.i12 = args.in[12]; F.i13 = args.in[13]; F.i14 = args.in[14]; F.i15 = args.in[15]; F.i16 = args.in[16]; F.i17 = args.in[17]; F.i18 = args.in[18]; F.i19 = args.in[19]; F.i20 = args.in[20]; F.i21 = args.in[21]; F.i22 = args.in[22]; F.i23 = args.in[23]; F.i24 = args.in[24];
    F.out = args.out; F.ws = args.ws;
    unsigned char* ws = args.ws; gu32* ctl = (gu32*)(ws + WS_CTL);
    volatile LAS unsigned* MISC = (volatile LAS unsigned*)(F.lds + MISC_OFF);
    for (int u = F.tid; u < (LDS_BYTES - LDSCTL_OFF) / 4; u += NWAVES * 64) ((LAS unsigned*)(F.lds + LDSCTL_OFF))[u] = 0u;
    __syncthreads();
    XcdBarrier bar; bar.bar = (unsigned*)(ctl + CW_BAR); bar.x = 0; bar.st = nullptr;
    if (MK_N_LAUNCHES == 1) bar = xcd_barrier_post((unsigned*)(ctl + CW_BAR), MISC + 8, F.wave);
    const int lo = args.ph_lo, hi = args.ph_hi;
#define IN(k) (lo <= (k) && (k) < hi && (k) <= MK_STOP_AFTER)
#define GRID_BAR(k) do { if (IN((k) + 1)) xcd_barrier(bar, F.wave); } while (0)

#define RUN(k, call) do { if (IN(k)) { F.lane = lane_id(); F.tid = F.wave * 64 + F.lane; call; if (MK_REPEAT_PHASE == (k)) { xcd_barrier_or_skip(bar, MK_N_LAUNCHES == 1, F.wave); call; } GRID_BAR(k); } } while (0)
    RUN(0, p0_prologue(F));
    RUN(1, phase1(F));
    RUN(2, phase2(F));
    RUN(3, phase3(F));
    RUN(4, phase4(F, args.in[3], args.in[4], args.in[5], args.in[6]));
    RUN(5, phase5(F));
    RUN(6, phase6(F));
    RUN(7, phase7(F));
    RUN(8, phase8(F));
    RUN(9, phase9(F));
    if (IN(10)) { F.lane = lane_id(); F.tid = F.wave * 64 + F.lane; phase10(F); }
#undef RUN
#if MK_STOP_AFTER < 10
    if (hi == N_PHASES) {
        for (int m = F.vcu * NWAVES + F.wave; m < MR; m += G * NWAVES) {
            for (int c = F.lane; c < D; c += 64) {
                float v;
                if (MK_STOP_AFTER == 0) v = bf2f(((const bf16*)(ws + WS_WIN))[(size_t)(m % NZ) * D + c]);
                else if (MK_STOP_AFTER == 3) { const bf16* gt = (const bf16*)(ws + WS_GATE) + (size_t)m * 3072; v = bf2f(gt[c]) + bf2f(gt[1024 + c]) + bf2f(gt[2048 + c]); }
                else if (MK_STOP_AFTER <= 5) { const bf16* oa = (const bf16*)(ws + WS_OALL) + (size_t)m * 1536; v = bf2f(oa[c]) + bf2f(oa[1024 + (c & 511)]); }
                else if (MK_STOP_AFTER == 6) v = bf2f(((const bf16*)(ws + WS_MB))[(size_t)m * D + c]);
                else if (MK_STOP_AFTER == 7) v = ((const float*)(ws + WS_H))[(size_t)m * D + c];
                else v = bf2f(((const bf16*)(ws + WS_G))[(size_t)m * FF + c]) + bf2f(((const bf16*)(ws + WS_G))[(size_t)m * FF + 1792 + c]);
                F.out[(size_t)m * D + c] = v;
            }
        }
    }
#endif
#undef IN
#undef GRID_BAR
}

extern "C" void kernel_launch(void* const* d_in, const int* in_sizes, int n_in, void* d_out, int out_size, void* d_ws, size_t ws_size, hipStream_t stream) {
    static int grid = 0;
    if (grid == 0) {
        if (n_in != 25 || (size_t)out_size != O_END || ws_size < WS_END2) { fprintf(stderr, "kernel_launch: unexpected shapes: n_in %d out %d ws %zu (need %zu); nothing launched\n", n_in, out_size, ws_size, (size_t)WS_END2); grid = -1; return; }
        int dev = 0, cus = 0, per_cu = 0;
        if (hipGetDevice(&dev) != hipSuccess || hipDeviceGetAttribute(&cus, hipDeviceAttributeMultiprocessorCount, dev) != hipSuccess) { grid = -1; return; }
        if (hipFuncSetAttribute((const void*)mk_fwd, hipFuncAttributeMaxDynamicSharedMemorySize, LDS_BYTES) != hipSuccess) { fprintf(stderr, "kernel_launch: hipFuncSetAttribute failed\n"); grid = -1; return; }
        if (hipOccupancyMaxActiveBlocksPerMultiprocessor(&per_cu, (const void*)mk_fwd, NWAVES * 64, LDS_BYTES) != hipSuccess || per_cu < 1) fprintf(stderr, "kernel_launch: occupancy query reports %d\n", per_cu);
        (void)hipGetLastError();
        grid = cus;
    }
    if (grid < 0) return;
    if (hipMemsetAsync((char*)d_ws + WS_CTL, 0, CTL_ZERO_BYTES, stream) != hipSuccess) return;
    Args a{};
    for (int i = 0; i < 25; ++i) a.in[i] = (const float*)d_in[i];
    a.out = (float*)d_out; a.ws = (unsigned char*)d_ws; a.pad = 0;
    for (int li = 0; li < MK_N_LAUNCHES; ++li) {
        a.ph_lo = (MK_N_LAUNCHES == 1) ? 0 : li; a.ph_hi = (MK_N_LAUNCHES == 1) ? N_PHASES : li + 1; a.li = li;
        hipLaunchKernelGGL(mk_fwd, dim3(grid), dim3(NWAVES * 64), LDS_BYTES, stream, a);
        const hipError_t le = hipPeekAtLastError();
        if (le != hipSuccess) { fprintf(stderr, "kernel_launch: launch %d failed: %s\n", li, hipGetErrorName(le)); break; }
    }
}
```

```cpp
#include <hip/hip_runtime.h>
#include <cstdio>
#include <cstdint>

#ifndef MK_N_LAUNCHES
#define MK_N_LAUNCHES 1
#endif

#ifndef MK_REPEAT_PHASE
#define MK_REPEAT_PHASE -1
#endif
#ifndef MK_P4_REPEAT
#define MK_P4_REPEAT 0
#endif
#ifndef MK_STAGGER_A
#ifndef MK_WGM_N
#define MK_WGM_N 2
#endif
#ifndef MK_WGM_A
#define MK_WGM_A 4
#endif
#ifndef MK_WGM_Z
#define MK_WGM_Z 2
#endif
#define MK_STAGGER_A 0
#endif
#ifndef MK_STAGGER_Z
#define MK_STAGGER_Z 0
#endif
#ifndef MK_STOP_AFTER
#define MK_STOP_AFTER 10
#endif
#define GAS __attribute__((address_space(1)))
#define LAS __attribute__((address_space(3)))
typedef unsigned short bf16;
typedef unsigned v4u __attribute__((ext_vector_type(4)));
typedef unsigned v2u __attribute__((ext_vector_type(2)));
typedef float f32x4 __attribute__((ext_vector_type(4)));
typedef float f32x2 __attribute__((ext_vector_type(2)));
typedef short bf16x8 __attribute__((ext_vector_type(8)));
typedef short s16x4 __attribute__((ext_vector_type(4)));
typedef GAS unsigned gu32;

__device__ __forceinline__ int lane_id() { return (int)__builtin_amdgcn_mbcnt_hi(~0u, __builtin_amdgcn_mbcnt_lo(~0u, 0u)); }
constexpr int D = 1024, NB = 32, SEQ = 2048, DECB = 128, DECT = 4, PAST = 8192, MEML = 256;
constexpr int MP = NB * SEQ;
constexpr int MS = DECB * DECT;
constexpr int MR = MP + MS;
constexpr int MM = NB * MEML;
constexpr int FF = 2816, NZ = 9984;
constexpr int DIN = 6672;
constexpr int NPOS = SEQ + DECT;
constexpr float EPS = 1e-6f;
constexpr float QSCALE = 0.08838834764831845f * 1.4426950408889634f;
constexpr float LN2 = 0.6931471805599453f;

constexpr size_t O_Y = 0, O_YS = (size_t)MP * D, O_SWA0P = O_YS + (size_t)MS * D, O_SWA1P = O_SWA0P + (size_t)NB * 128 * 1024, O_SWA2P = O_SWA1P + (size_t)NB * 512 * 1024,
                 O_MEMKV = O_SWA2P + (size_t)NB * 2048 * 1024, O_GLAP = O_MEMKV + (size_t)MM * 1024, O_SWA0S = O_GLAP + (size_t)NB * 4 * 64 * 128, O_SWA1S = O_SWA0S + (size_t)MS * 1024,
                 O_SWA2S = O_SWA1S + (size_t)MS * 1024, O_GLAS = O_SWA2S + (size_t)MS * 1024, O_END = O_GLAS + (size_t)DECB * 4 * 64 * 128;
static_assert(O_END == 170917888ull, "output size");

constexpr size_t MiB = 1u << 20;
constexpr size_t al(size_t x) { return (x + 2 * MiB - 1) / (2 * MiB) * (2 * MiB); }
constexpr size_t WS_CTL = 0, CTL_ZERO_BYTES = 1 * MiB;
constexpr size_t WS_ROPE = 2 * MiB;
constexpr size_t WS_PQ1 = WS_ROPE + al((size_t)NPOS * 64 * 4 * 2);
constexpr size_t WS_PQ2 = WS_PQ1 + al((size_t)MR * 16 * 4);
constexpr size_t WS_W1A = WS_PQ2 + al((size_t)MR * 16 * 4);
constexpr size_t WS_W1O = WS_W1A + al((size_t)2 * FF * D * 2);
constexpr size_t WS_WIN = WS_W1O + al((size_t)D * FF * 2);
constexpr size_t WS_WBR = WS_WIN + al((size_t)NZ * D * 2);
constexpr size_t WS_WOUT = WS_WBR + al((size_t)3 * D * 512 * 2);
constexpr size_t WS_W2A = WS_WOUT + al((size_t)D * D * 2);
constexpr size_t WS_W2O = WS_W2A + al((size_t)2 * FF * D * 2);
constexpr size_t WS_WMEM = WS_W2O + al((size_t)D * FF * 2);
constexpr size_t WS_XB = WS_WMEM + al((size_t)D * D * 2);
constexpr size_t WS_MEMB = WS_XB + al((size_t)MR * D * 2);
constexpr size_t WS_MKV = WS_MEMB + al((size_t)MM * D * 2);
constexpr size_t WS_G = WS_MKV + al((size_t)MM * D * 2);
constexpr size_t WS_H = WS_G + al((size_t)MR * FF * 2);
constexpr size_t WS_HB = WS_H + al((size_t)MR * D * 4);
constexpr size_t WS_QS = WS_HB + al((size_t)MR * D * 2);
constexpr size_t WS_KS = WS_QS + al((size_t)MR * 1536 * 2);
constexpr size_t WS_VS = WS_KS + al((size_t)MR * 1536 * 2);
constexpr size_t WS_GQ = WS_VS + al((size_t)MR * 1536 * 2);
constexpr size_t WS_GK = WS_GQ + al((size_t)MR * 256 * 2);
constexpr size_t WS_GV = WS_GK + al((size_t)MR * 256 * 2);
constexpr size_t WS_GRS = WS_GV + al((size_t)MR * 512 * 2);
constexpr size_t WS_GA = WS_GRS + al((size_t)MR * 512 * 2);
constexpr size_t WS_MQ = WS_GA + al((size_t)MR * 256 * 4);
constexpr size_t WS_GATE = WS_MQ + al((size_t)MR * 512 * 2);
constexpr size_t WS_OG = WS_GATE + al((size_t)MR * 3072 * 2);
constexpr size_t WS_LSE = WS_OG + al((size_t)MR * 1536 * 2);
constexpr size_t WS_GO = WS_LSE + al((size_t)MR * 12 * 4);
constexpr size_t WS_OALL = WS_GO + al((size_t)MR * 512 * 4);
constexpr size_t WS_END = WS_OALL + al((size_t)MR * 1536 * 2);
constexpr size_t WS_SLAB = WS_END; constexpr size_t WS_END2 = WS_SLAB + al((size_t)8 * 4 * 4 * 8 * 2048 * 4);
constexpr size_t WS_T = WS_G, WS_MB = WS_XB, WS_Y16 = WS_XB;
static_assert((size_t)MR * D * 4 <= (size_t)MR * FF * 2, "T fits in G");

constexpr int CW_TMO = 0, CW_CODE = 1, CW_BAR = 4096, CW_TAIL = 8192;

constexpr int RING_OFF = 0, RING_BYTES = 131072;
constexpr int LDSCTL_OFF = RING_BYTES, MISC_OFF = LDSCTL_OFF + 320;
constexpr int LDS_BYTES = 147456;
constexpr int NWAVES = 8;

#define RLX_AGENT __ATOMIC_RELAXED, __HIP_MEMORY_SCOPE_AGENT
#define LDS_WAIT() asm volatile("s_waitcnt lgkmcnt(0)" ::: "memory")
#define VM_WAIT() asm volatile("s_waitcnt vmcnt(0)" ::: "memory")
__device__ __forceinline__ unsigned f2bf(float f) { unsigned u = __builtin_bit_cast(unsigned, f); return (u + 0x7fffu + ((u >> 16) & 1u)) >> 16; }
__device__ __forceinline__ unsigned pk2(float lo, float hi) { return f2bf(lo) | (f2bf(hi) << 16); }
__device__ __forceinline__ float bf2f(unsigned b) { return __builtin_bit_cast(float, b << 16); }
__device__ __forceinline__ float bflo(unsigned w) { return __builtin_bit_cast(float, w << 16); }
__device__ __forceinline__ float bfhi(unsigned w) { return __builtin_bit_cast(float, w & 0xffff0000u); }
typedef __bf16 bf16x2_t __attribute__((ext_vector_type(2)));
__device__ __forceinline__ unsigned cvt_pk_bf16(float lo, float hi) { const f32x2 v = {lo, hi}; const bf16x2_t b = __builtin_convertvector(v, bf16x2_t); return __builtin_bit_cast(unsigned, b); }
__device__ __forceinline__ float fast_exp2(float x) { return __builtin_amdgcn_exp2f(x); }
__device__ __forceinline__ float fast_rcp(float x) { return __builtin_amdgcn_rcpf(x); }
__device__ __forceinline__ float fast_log2(float x) { return __builtin_amdgcn_logf(x); }
__device__ __forceinline__ float sigmoidf_(float x) { return fast_rcp(1.0f + fast_exp2(-1.4426950408889634f * x)); }
__device__ __forceinline__ float siluf_(float x) { return x * sigmoidf_(x); }
__device__ __forceinline__ int perm32(int rho) { return 8 * ((rho >> 2) & 3) + 4 * (rho >> 4) + (rho & 3); }
__device__ __forceinline__ int sig_plain(int r) { return (r & ~31) + perm32(r & 31); }
__device__ __forceinline__ int sig_rope(int r7) { return 64 * ((r7 >> 4) & 1) + 16 * (r7 >> 5) + 4 * ((r7 >> 2) & 3) + (r7 & 3); }

namespace pg8 {
constexpr int BM = 256, BK = 64, HALF = 128, HTB = HALF * BK * 2, STAGE_BYTES = 8 * HTB, NXCD = 8, WGM = 2;
__host__ __device__ __forceinline__ int lds_byte(int r, int c) { const int st = (r >> 4) * 2 + (c >> 5), rr = r & 15, cc = c & 31, ob = rr * 64 + cc * 2; return st * 1024 + (ob ^ (((ob >> 9) & 1) << 5)); }
__host__ __device__ __forceinline__ void stage_rc(int b, int& R, int& C) { const int st = b / 1024, sb = b % 1024, swz = sb ^ (((sb >> 9) & 1) << 5); R = (st >> 1) * 16 + swz / 64; C = (st & 1) * 32 + (swz % 64) / 2; }
struct Unit { int pm, pn; };
struct Gemm { const bf16* A; const bf16* Bt; int M, N, K, lda, ldb; };
constexpr size_t TILED_KS = (size_t)256 * 64 * 2, TILED_PANEL = (size_t)(2816 / 64) * TILED_KS;
template <int NM, int NN> struct StaticOrderT {
    static constexpr int WGM = NN == 4 ? MK_WGM_N : (NN == 22 ? MK_WGM_A : MK_WGM_Z);
    int G, c, lim, rev;
    __host__ __device__ void init(int, int, int G_, int c_) { G = G_; c = c_; lim = NM * NN; rev = 0; }
    __host__ __device__ static __forceinline__ void unit_of(int L, Unit& u) {
        constexpr int nwg = NM * NN, q = nwg / NXCD, r = nwg % NXCD, nig = WGM * NN;
        const int xcd = L & (NXCD - 1), off = L >> 3;
        const int wgid = (xcd < r ? xcd * (q + 1) : r * (q + 1) + (xcd - r) * q) + off;
        const int gid = wgid / nig, x = wgid - gid * nig, fm = gid * WGM;
        if (NM % WGM == 0 || fm + WGM <= NM) { u.pm = fm + (x & (WGM - 1)); u.pn = x / WGM; }
        else { constexpr int gl = (NM % WGM) ? (NM % WGM) : WGM; u.pm = fm + x % gl; u.pn = x / gl; }
    }
    __host__ __device__ __forceinline__ bool next(int i, Unit& u) const { const int L = i * G + c; if (L >= lim) return false; unit_of(rev ? lim - 1 - L : L, u); return true; }
};
struct OneUnit { Unit u; int c; __host__ __device__ __forceinline__ bool next(int i, Unit& o) const { if (i) return false; o = u; return true; } };
template <class Epi, class Sched, bool ALIGN_EPI = true, bool ATILED = false>
__device__ __forceinline__ void gemm_phase(LAS unsigned char* lds, const Gemm g, const Sched& S, const Epi& E, const int wid, const int stagger_ticks = 0) {
    if (stagger_ticks > 0) { const unsigned long long t0 = __builtin_amdgcn_s_memrealtime(); const unsigned long long dl = (unsigned long long)(((S.c * 37) & 255) * stagger_ticks) >> 8;
        while (__builtin_amdgcn_s_memrealtime() - t0 < dl) __builtin_amdgcn_s_sleep(8); }
    const int lane = lane_id(), tid = wid * 64 + lane, wr = wid >> 2, wc = wid & 3, fr = lane & 15, fq = lane >> 4;
    const int K = g.K, nt = K / BK;
    unsigned voffA[2], voffB[2];
#pragma unroll
    for (int i = 0; i < 2; ++i) { int R, C; stage_rc(tid * 16 + i * 8192, R, C); voffA[i] = (unsigned)(R * g.lda + C) * 2u; voffB[i] = (unsigned)(R * g.ldb + C) * 2u; }
    const size_t kstep = (size_t)(BK * 2), kstepA = ATILED ? TILED_KS : kstep;
    const size_t hA = (size_t)HALF * g.lda * 2, tA = ATILED ? TILED_PANEL : 2 * hA, hB = (size_t)HALF * g.ldb * 2, tB = 2 * hB;
    const unsigned ldsw = (unsigned)wid * 1024u;
    const int aoff = lds_byte(wr * 64 + fr, fq * 8), boff = lds_byte(wc * 32 + fr, fq * 8);
#define PG8_SA(b, h) (((b) * 2 + (h)) * HTB)
#define PG8_SB(b, h) ((4 + (b) * 2 + (h)) * HTB)
#define PG8_STAGE(bufoff, gbase, voff) do { _Pragma("unroll") for (int _i = 0; _i < 2; ++_i) \
        __builtin_amdgcn_global_load_lds((const unsigned*)((const char*)(gbase) + (voff)[_i]), (LAS unsigned*)(lds + (bufoff) + ldsw + _i * 8192), 16, 0, 0); } while (0)
#define PG8_LDA(dst, b, h) do { _Pragma("unroll") for (int m = 0; m < 4; ++m) _Pragma("unroll") for (int k = 0; k < 2; ++k) dst[m][k] = *(const LAS bf16x8*)(lds + PG8_SA(b, h) + aoff + m * 2048 + k * 1024); } while (0)
#define PG8_LDB(dst, b, h) do { _Pragma("unroll") for (int n = 0; n < 2; ++n) _Pragma("unroll") for (int k = 0; k < 2; ++k) dst[n][k] = *(const LAS bf16x8*)(lds + PG8_SB(b, h) + boff + n * 2048 + k * 1024); } while (0)
#define PG8_MMA(ai, bj, At, Bt) do { __builtin_amdgcn_s_setprio(1); _Pragma("unroll") for (int m = 0; m < 4; ++m) _Pragma("unroll") for (int n = 0; n < 2; ++n) _Pragma("unroll") for (int k = 0; k < 2; ++k) \
        acc[ai][bj][m][n] = __builtin_amdgcn_mfma_f32_16x16x32_bf16(Bt[n][k], At[m][k], acc[ai][bj][m][n], 0, 0, 0); __builtin_amdgcn_s_setprio(0); } while (0)
#define PG8_WAIT_V(n) asm volatile("s_waitcnt vmcnt(" #n ")" ::: "memory")
#define PG8_WAIT_L(n) asm volatile("s_waitcnt lgkmcnt(" #n ")" ::: "memory")
#define PG8_BAR __builtin_amdgcn_s_barrier()
#define PG8_SCHED __builtin_amdgcn_sched_barrier(0)
    Unit cur, nxt; int ui = 0;
    if (!S.next(0, cur)) return;
    f32x4 acc[2][2][4][2];
#pragma unroll
    for (int a = 0; a < 2; ++a)
#pragma unroll
        for (int b = 0; b < 2; ++b)
#pragma unroll
            for (int m = 0; m < 4; ++m)
#pragma unroll
                for (int n = 0; n < 2; ++n) acc[a][b][m][n] = (f32x4){0.f, 0.f, 0.f, 0.f};
    bf16x8 At[4][2], B0[2][2], B1[2][2];
    const char* cA = (const char*)g.A + (size_t)cur.pm * tA; const char* cB = (const char*)g.Bt + (size_t)cur.pn * tB;
    PG8_STAGE(PG8_SB(0, 0), cB, voffB); PG8_STAGE(PG8_SB(0, 1), cB + hB, voffB); PG8_STAGE(PG8_SA(0, 0), cA, voffA); PG8_STAGE(PG8_SA(0, 1), cA + hA, voffA);
    if (wr == 1) PG8_BAR;
    PG8_WAIT_V(2); PG8_BAR;
    PG8_STAGE(PG8_SB(1, 0), cB + kstep, voffB); PG8_STAGE(PG8_SA(1, 0), cA + kstepA, voffA); PG8_STAGE(PG8_SB(1, 1), cB + hB + kstep, voffB);
    PG8_WAIT_V(6); PG8_BAR;
    for (;;) {
        const bool has_next = S.next(ui + 1, nxt);
        const char* nA = has_next ? (const char*)g.A + (size_t)nxt.pm * tA : cA; const char* nB = has_next ? (const char*)g.Bt + (size_t)nxt.pn * tB : cB;
        const int seg = Epi::HAS_MID ? 8 : nt;
        for (int t0 = 0; t0 < nt; t0 += seg) {
        if constexpr (Epi::HAS_MID) { if (t0) { PG8_SCHED; E.mid(acc, cur, t0, wr, wc, fr, fq); PG8_SCHED; } }
#pragma unroll 1
        for (int t = t0; t < t0 + seg; t += 2) {
            const bool last = (t == nt - 2);
            const char* a1 = cA + (size_t)(t + 1) * kstepA;
            const char* a2 = last ? nA : cA + (size_t)(t + 2) * kstepA; const char* b2 = last ? nB : cB + (size_t)(t + 2) * kstep;
            const char* a3 = a2 + kstepA; const char* b3 = b2 + kstep;
            PG8_LDB(B0, 0, 0); PG8_LDB(B1, 0, 1); PG8_SCHED; PG8_LDA(At, 0, 0); PG8_STAGE(PG8_SA(1, 1), a1 + hA, voffA);
            PG8_WAIT_V(8); PG8_WAIT_L(0); PG8_BAR; PG8_MMA(0, 0, At, B0); PG8_MMA(0, 1, At, B1); PG8_BAR; PG8_SCHED;
            PG8_LDA(At, 0, 1); PG8_STAGE(PG8_SB(0, 0), b2, voffB); PG8_STAGE(PG8_SB(0, 1), b2 + hB, voffB); PG8_STAGE(PG8_SA(0, 0), a2, voffA);
            PG8_WAIT_V(8); PG8_WAIT_L(0); PG8_BAR; PG8_MMA(1, 0, At, B0); PG8_MMA(1, 1, At, B1); PG8_BAR; PG8_SCHED;
            PG8_LDB(B0, 1, 0); PG8_LDB(B1, 1, 1); PG8_SCHED; PG8_LDA(At, 1, 0); PG8_STAGE(PG8_SA(0, 1), a2 + hA, voffA);
            PG8_WAIT_V(8); PG8_WAIT_L(0); PG8_BAR; PG8_MMA(0, 0, At, B0); PG8_MMA(0, 1, At, B1); PG8_BAR; PG8_SCHED;
            PG8_LDA(At, 1, 1); PG8_STAGE(PG8_SB(1, 0), b3, voffB); PG8_STAGE(PG8_SB(1, 1), b3 + hB, voffB); PG8_STAGE(PG8_SA(1, 0), a3, voffA);
            PG8_WAIT_V(8); PG8_WAIT_L(0); PG8_BAR; PG8_MMA(1, 0, At, B0); PG8_MMA(1, 1, At, B1); PG8_BAR; PG8_SCHED;
        }
        }
        if constexpr (ALIGN_EPI) { if (wr == 0) PG8_BAR; }
        E(acc, cur, wr, wc, fr, fq);
        if (!has_next) break;
#pragma unroll
        for (int a = 0; a < 2; ++a)
#pragma unroll
            for (int b = 0; b < 2; ++b)
#pragma unroll
                for (int m = 0; m < 4; ++m)
#pragma unroll
                    for (int n = 0; n < 2; ++n) acc[a][b][m][n] = (f32x4){0.f, 0.f, 0.f, 0.f};
        cur = nxt; cA = nA; cB = nB; ++ui;
        if constexpr (ALIGN_EPI) { if (wr == 1) PG8_BAR; }
    }
    PG8_WAIT_V(0);
    if constexpr (!ALIGN_EPI) { if (wr == 0) PG8_BAR; }
    PG8_BAR;
#undef PG8_SA
#undef PG8_SB
#undef PG8_STAGE
#undef PG8_LDA
#undef PG8_LDB
#undef PG8_MMA
#undef PG8_WAIT_V
#undef PG8_WAIT_L
#undef PG8_BAR
#undef PG8_SCHED
}
}
using pg8::Unit;

typedef const f32x4 (&AccRef)[2][2][4][2];
constexpr size_t G_KT = (size_t)256 * 64, G_PANEL = (FF / 64) * G_KT;
__device__ __forceinline__ size_t g_off(int row, int j) { return (size_t)(row >> 8) * G_PANEL + (size_t)(j >> 6) * G_KT + (size_t)(row & 255) * 64 + (j & 63); }
struct EpiSwiglu {
    static constexpr bool HAS_MID = false;
    bf16* G; const float* pq;
    __device__ __forceinline__ void operator()(AccRef acc, const Unit& u, int wr, int wc, int fr, int fq) const {
        const int row0 = u.pm * 256 + wr * 64 + fr;
        bf16* gb = G + ((size_t)u.pm * (FF / 64) + 2 * u.pn + (wc >> 1)) * G_KT + (size_t)((wr * 64 + fr) * 64 + (wc & 1) * 32 + 8 * fq);
        float sc[2][4];
#pragma unroll
        for (int ai = 0; ai < 2; ++ai)
#pragma unroll
            for (int m = 0; m < 4; ++m) { sc[ai][m] = 1.f;
                if (pq) { const f32x4 pv = *(const f32x4*)(pq + (size_t)(row0 + ai * 128 + m * 16) * 16 + 4 * fq); float t = (pv.x + pv.y) + (pv.z + pv.w); t += __shfl_xor(t, 16); t += __shfl_xor(t, 32); sc[ai][m] = __builtin_amdgcn_rsqf(t * (1.f / D) + EPS); } }
#pragma unroll
        for (int ai = 0; ai < 2; ++ai)
#pragma unroll
            for (int m = 0; m < 4; ++m) {
                const float s = sc[ai][m];
                float o[8];
#pragma unroll
                for (int n = 0; n < 2; ++n)
#pragma unroll
                    for (int i = 0; i < 4; ++i) { const float a = acc[ai][0][m][n][i] * s, b = acc[ai][1][m][n][i] * s; o[4 * n + i] = siluf_(a) * b; }
                v4u w; w.x = cvt_pk_bf16(o[0], o[1]); w.y = cvt_pk_bf16(o[2], o[3]); w.z = cvt_pk_bf16(o[4], o[5]); w.w = cvt_pk_bf16(o[6], o[7]);
                *(v4u*)(gb + (ai * 128 + m * 16) * 64) = w;
            }
    }
};
template <bool WRITE_PQ> struct EpiResidX {
    static constexpr bool HAS_MID = false;
    const float* baseP; const float* baseS; bf16* HB; float* pq; float scale;
    __device__ __forceinline__ void operator()(AccRef acc, const Unit& u, int wr, int wc, int fr, int fq) const {
        const int row0 = u.pm * 256 + wr * 64 + fr, c0 = u.pn * 256 + wc * 32 + 8 * fq; const bool smp = u.pm >= MP / 256;
        const float* bbase = (smp ? baseS : baseP) + (smp ? (size_t)(row0 - MP) * D : (size_t)row0 * D) + c0;
#pragma unroll
        for (int ai = 0; ai < 2; ++ai) {
            f32x4 bb[4][2][2];
#pragma unroll
            for (int m = 0; m < 4; ++m)
#pragma unroll
                for (int bj = 0; bj < 2; ++bj) { const float* bp = bbase + (size_t)(ai * 128 + m * 16) * D + bj * 128; bb[m][bj][0] = *(const f32x4*)bp; bb[m][bj][1] = *(const f32x4*)(bp + 4); }
#pragma unroll
            for (int m = 0; m < 4; ++m) {
                const int row = row0 + ai * 128 + m * 16; float ss = 0.f;
#pragma unroll
                for (int bj = 0; bj < 2; ++bj) {
                    const f32x4 o0 = bb[m][bj][0] + acc[ai][bj][m][0] * scale, o1 = bb[m][bj][1] + acc[ai][bj][m][1] * scale;
                    v4u w; w.x = cvt_pk_bf16(o0.x, o0.y); w.y = cvt_pk_bf16(o0.z, o0.w); w.z = cvt_pk_bf16(o1.x, o1.y); w.w = cvt_pk_bf16(o1.z, o1.w); *(v4u*)(HB + (size_t)row * D + c0 + bj * 128) = w;
                    if (WRITE_PQ) ss += (o0.x * o0.x + o0.y * o0.y) + (o0.z * o0.z + o0.w * o0.w) + (o1.x * o1.x + o1.y * o1.y) + (o1.z * o1.z + o1.w * o1.w);
                }
                if (WRITE_PQ) { ss += __shfl_xor(ss, 16); ss += __shfl_xor(ss, 32); if (fq == 0) pq[(size_t)row * 16 + u.pn * 4 + wc] = ss; }
            }
        }
    }
    template <int O> __device__ __forceinline__ void group(const f32x4 (&v)[8], const Unit& u, int wr, int wc, int fr, int fq) const {
        const int row0 = u.pm * 256 + wr * 64 + fr, c0 = u.pn * 256 + wc * 32 + 8 * fq; const bool smp = u.pm >= MP / 256;
        const float* bbase = (smp ? baseS : baseP) + (smp ? (size_t)(row0 - MP) * D : (size_t)row0 * D) + c0;
        f32x4 bb[2][2][2];
#pragma unroll
        for (int mm = 0; mm < 2; ++mm)
#pragma unroll
            for (int bj = 0; bj < 2; ++bj) { const float* bp = bbase + (size_t)((O >> 1) * 128 + (2 * (O & 1) + mm) * 16) * D + bj * 128; bb[mm][bj][0] = *(const f32x4*)bp; bb[mm][bj][1] = *(const f32x4*)(bp + 4); }
#pragma unroll
        for (int mm = 0; mm < 2; ++mm) { const int row = row0 + (O >> 1) * 128 + (2 * (O & 1) + mm) * 16; float ss = 0.f;
#pragma unroll
            for (int bj = 0; bj < 2; ++bj) {
                const f32x4 o0 = bb[mm][bj][0] + v[bj * 4 + mm * 2] * scale, o1 = bb[mm][bj][1] + v[bj * 4 + mm * 2 + 1] * scale;
                v4u w; w.x = cvt_pk_bf16(o0.x, o0.y); w.y = cvt_pk_bf16(o0.z, o0.w); w.z = cvt_pk_bf16(o1.x, o1.y); w.w = cvt_pk_bf16(o1.z, o1.w); *(v4u*)(HB + (size_t)row * D + c0 + bj * 128) = w;
                if (WRITE_PQ) ss += (o0.x * o0.x + o0.y * o0.y) + (o0.z * o0.z + o0.w * o0.w) + (o1.x * o1.x + o1.y * o1.y) + (o1.z * o1.z + o1.w * o1.w); }
            if (WRITE_PQ) { ss += __shfl_xor(ss, 16); ss += __shfl_xor(ss, 32); if (fq == 0) pq[(size_t)row * 16 + u.pn * 4 + wc] = ss; } }
    }
};
template <bool WRITE_PQ> struct EpiResidB {
    static constexpr bool HAS_MID = false;
    const bf16* base; bf16* out; float* pq; float scale;
    __device__ __forceinline__ void operator()(AccRef acc, const Unit& u, int wr, int wc, int fr, int fq) const {
        const int row0 = u.pm * 256 + wr * 64 + fr, c0 = u.pn * 256 + wc * 32 + 8 * fq;
#pragma unroll
        for (int ai = 0; ai < 2; ++ai) {
            v4u bb[4][2];
#pragma unroll
            for (int m = 0; m < 4; ++m)
#pragma unroll
                for (int bj = 0; bj < 2; ++bj) bb[m][bj] = *(const v4u*)(base + (size_t)(row0 + ai * 128 + m * 16) * D + c0 + bj * 128);
#pragma unroll
            for (int m = 0; m < 4; ++m) {
                const int row = row0 + ai * 128 + m * 16; float ss = 0.f;
#pragma unroll
                for (int bj = 0; bj < 2; ++bj) { const v4u g = bb[m][bj];
                    const f32x4 o0 = (f32x4){bflo(g.x), bfhi(g.x), bflo(g.y), bfhi(g.y)} + acc[ai][bj][m][0] * scale, o1 = (f32x4){bflo(g.z), bfhi(g.z), bflo(g.w), bfhi(g.w)} + acc[ai][bj][m][1] * scale;
                    v4u w; w.x = cvt_pk_bf16(o0.x, o0.y); w.y = cvt_pk_bf16(o0.z, o0.w); w.z = cvt_pk_bf16(o1.x, o1.y); w.w = cvt_pk_bf16(o1.z, o1.w); *(v4u*)(out + (size_t)row * D + c0 + bj * 128) = w;
                    if (WRITE_PQ) ss += (o0.x * o0.x + o0.y * o0.y) + (o0.z * o0.z + o0.w * o0.w) + (o1.x * o1.x + o1.y * o1.y) + (o1.z * o1.z + o1.w * o1.w);
                }
                if (WRITE_PQ) { ss += __shfl_xor(ss, 16); ss += __shfl_xor(ss, 32); if (fq == 0) pq[(size_t)row * 16 + u.pn * 4 + wc] = ss; }
            }
        }
    }
    template <int O> __device__ __forceinline__ void group(const f32x4 (&v)[8], const Unit& u, int wr, int wc, int fr, int fq) const {
        const int row0 = u.pm * 256 + wr * 64 + fr, c0 = u.pn * 256 + wc * 32 + 8 * fq;
        v4u bb[2][2];
#pragma unroll
        for (int mm = 0; mm < 2; ++mm)
#pragma unroll
            for (int bj = 0; bj < 2; ++bj) bb[mm][bj] = *(const v4u*)(base + (size_t)(row0 + (O >> 1) * 128 + (2 * (O & 1) + mm) * 16) * D + c0 + bj * 128);
#pragma unroll
        for (int mm = 0; mm < 2; ++mm) { const int row = row0 + (O >> 1) * 128 + (2 * (O & 1) + mm) * 16; float ss = 0.f;
#pragma unroll
            for (int bj = 0; bj < 2; ++bj) { const v4u g = bb[mm][bj];
                const f32x4 o0 = (f32x4){bflo(g.x), bfhi(g.x), bflo(g.y), bfhi(g.y)} + v[bj * 4 + mm * 2] * scale, o1 = (f32x4){bflo(g.z), bfhi(g.z), bflo(g.w), bfhi(g.w)} + v[bj * 4 + mm * 2 + 1] * scale;
                v4u w; w.x = cvt_pk_bf16(o0.x, o0.y); w.y = cvt_pk_bf16(o0.z, o0.w); w.z = cvt_pk_bf16(o1.x, o1.y); w.w = cvt_pk_bf16(o1.z, o1.w); *(v4u*)(out + (size_t)row * D + c0 + bj * 128) = w;
                if (WRITE_PQ) ss += (o0.x * o0.x + o0.y * o0.y) + (o0.z * o0.z + o0.w * o0.w) + (o1.x * o1.x + o1.y * o1.y) + (o1.z * o1.z + o1.w * o1.w); }
            if (WRITE_PQ) { ss += __shfl_xor(ss, 16); ss += __shfl_xor(ss, 32); if (fq == 0) pq[(size_t)row * 16 + u.pn * 4 + wc] = ss; } }
    }
};
struct EpiMemKV {
    static constexpr bool HAS_MID = false;
    float* out; bf16* MKV;
    __device__ __forceinline__ void operator()(AccRef acc, const Unit& u, int wr, int wc, int fr, int fq) const {
        const int row0 = u.pm * 256 + wr * 64 + fr, c0 = u.pn * 256 + wc * 32 + 8 * fq;
#pragma unroll
        for (int ai = 0; ai < 2; ++ai)
#pragma unroll
            for (int m = 0; m < 4; ++m) {
                const int row = row0 + ai * 128 + m * 16;
#pragma unroll
                for (int bj = 0; bj < 2; ++bj) { const f32x4 o0 = acc[ai][bj][m][0], o1 = acc[ai][bj][m][1]; float* op = out + (size_t)row * D + c0 + bj * 128;
                    *(f32x4*)op = o0; *(f32x4*)(op + 4) = o1;
                    v4u w; w.x = cvt_pk_bf16(o0.x, o0.y); w.y = cvt_pk_bf16(o0.z, o0.w); w.z = cvt_pk_bf16(o1.x, o1.y); w.w = cvt_pk_bf16(o1.z, o1.w); *(v4u*)(MKV + (size_t)row * D + c0 + bj * 128) = w; }
            }
    }
};
struct EpiMerge1 {
    static constexpr bool HAS_MID = true;
    const bf16* GATE; bf16* MB;
    __device__ __forceinline__ void mid(f32x4 (&acc)[2][2][4][2], const Unit& u, int t, int wr, int wc, int fr, int fq) const {
        const unsigned lo = (unsigned)(((wr * 64 + fr) * 3072 + wc * 32 + 8 * fq) * 2);
        const char* ub = (const char*)GATE + ((size_t)u.pm * 256 * 3072 + (size_t)((t >> 3) - 1) * 1024 + (size_t)u.pn * 256) * 2;
#pragma unroll
        for (int ai = 0; ai < 2; ++ai) {
            v4u gn[4][2], gd[4][2];
#pragma unroll
            for (int m = 0; m < 4; ++m)
#pragma unroll
                for (int bj = 0; bj < 2; ++bj) { const char* fb = ub + (size_t)((ai * 128 + m * 16) * 3072 + bj * 128) * 2; gn[m][bj] = *(const v4u*)(fb + lo); gd[m][bj] = *(const v4u*)(fb + 2048 + lo); }
#pragma unroll
            for (int m = 0; m < 4; ++m)
#pragma unroll
                for (int bj = 0; bj < 2; ++bj) { const v4u n_ = gn[m][bj], d_ = gd[m][bj];
                    const f32x4 r0 = {bflo(n_.x) * fast_rcp(fmaxf(bflo(d_.x), 1e-30f)), bfhi(n_.x) * fast_rcp(fmaxf(bfhi(d_.x), 1e-30f)), bflo(n_.y) * fast_rcp(fmaxf(bflo(d_.y), 1e-30f)), bfhi(n_.y) * fast_rcp(fmaxf(bfhi(d_.y), 1e-30f))};
                    const f32x4 r1 = {bflo(n_.z) * fast_rcp(fmaxf(bflo(d_.z), 1e-30f)), bfhi(n_.z) * fast_rcp(fmaxf(bfhi(d_.z), 1e-30f)), bflo(n_.w) * fast_rcp(fmaxf(bflo(d_.w), 1e-30f)), bfhi(n_.w) * fast_rcp(fmaxf(bfhi(d_.w), 1e-30f))};
                    acc[ai][bj][m][0] *= r0; acc[ai][bj][m][1] *= r1; }
            asm volatile("" ::: "memory");
        }
    }
    __device__ __forceinline__ void operator()(AccRef acc, const Unit& u, int wr, int wc, int fr, int fq) const {
        const int row0 = u.pm * 256 + wr * 64 + fr, c0 = u.pn * 256 + wc * 32 + 8 * fq;
        v4u gw[2][4][2];
#pragma unroll
        for (int ai = 0; ai < 2; ++ai)
#pragma unroll
            for (int m = 0; m < 4; ++m)
#pragma unroll
                for (int bj = 0; bj < 2; ++bj) gw[ai][m][bj] = *(const v4u*)(GATE + (size_t)(row0 + ai * 128 + m * 16) * 3072 + 2048 + c0 + bj * 128);
#pragma unroll
        for (int ai = 0; ai < 2; ++ai)
#pragma unroll
            for (int m = 0; m < 4; ++m) { const int row = row0 + ai * 128 + m * 16;
#pragma unroll
                for (int bj = 0; bj < 2; ++bj) { const v4u g = gw[ai][m][bj];
                    const f32x4 o0 = acc[ai][bj][m][0] * (f32x4){bflo(g.x), bfhi(g.x), bflo(g.y), bfhi(g.y)}, o1 = acc[ai][bj][m][1] * (f32x4){bflo(g.z), bfhi(g.z), bflo(g.w), bfhi(g.w)};
                    v4u w; w.x = cvt_pk_bf16(o0.x, o0.y); w.y = cvt_pk_bf16(o0.z, o0.w); w.z = cvt_pk_bf16(o1.x, o1.y); w.w = cvt_pk_bf16(o1.z, o1.w); *(v4u*)(MB + (size_t)row * D + c0 + bj * 128) = w;
                } }
    }
    template <int O> __device__ __forceinline__ void group(const f32x4 (&v)[8], const Unit& u, int wr, int wc, int fr, int fq) const {
        const int row0 = u.pm * 256 + wr * 64 + fr, c0 = u.pn * 256 + wc * 32 + 8 * fq;
#pragma unroll
        for (int mm = 0; mm < 2; ++mm) { const int row = row0 + (O >> 1) * 128 + (2 * (O & 1) + mm) * 16;
#pragma unroll
            for (int bj = 0; bj < 2; ++bj) { const f32x4 o0 = v[bj * 4 + mm * 2], o1 = v[bj * 4 + mm * 2 + 1];
                v4u w; w.x = cvt_pk_bf16(o0.x, o0.y); w.y = cvt_pk_bf16(o0.z, o0.w); w.z = cvt_pk_bf16(o1.x, o1.y); w.w = cvt_pk_bf16(o1.z, o1.w); *(v4u*)(MB + (size_t)row * D + c0 + bj * 128) = w; } }
    }
};
__device__ __forceinline__ size_t qkv_off(int row, int g, int h) {
    if (row >= MP) return (size_t)row * 1536 + g * 512 + h * 128;
    const int b = row >> 11, t = row & 2047, sh = 2 * g, p = ((t & ((1 << sh) - 1)) << (11 - sh)) + (t >> sh);
    return ((size_t)((g * NB + b) * 4 + h) * SEQ + p) * 128;
}
struct EpiZ {
    static constexpr bool HAS_MID = false;
    const float* pq; const float* ropeC; const float* ropeS; const float* bga; float* out;
    bf16 *QS, *KS, *VS, *GQ, *GK, *GV, *GRS, *MQ, *GATE; float* GA;
    template <int ACT> __device__ __forceinline__ void plain(AccRef acc, const float (&rs)[2][4], int pm, int tl0, bf16* dst, int ld, int ucol, int cl, float scale) const {
        const unsigned lo = (unsigned)(tl0 * ld + cl) * 2u;
#pragma unroll
        for (int ai = 0; ai < 2; ++ai)
#pragma unroll
            for (int m = 0; m < 4; ++m) { const float s = rs[ai][m];
#pragma unroll
                for (int bj = 0; bj < 2; ++bj) { float o[8];
#pragma unroll
                    for (int n = 0; n < 2; ++n)
#pragma unroll
                        for (int i = 0; i < 4; ++i) { const float x = acc[ai][bj][m][n][i] * s; o[4 * n + i] = ACT == 0 ? x * scale : (ACT == 1 ? siluf_(x) : sigmoidf_(x)); }
                    v4u w; w.x = cvt_pk_bf16(o[0], o[1]); w.y = cvt_pk_bf16(o[2], o[3]); w.z = cvt_pk_bf16(o[4], o[5]); w.w = cvt_pk_bf16(o[6], o[7]);
                    char* ub = (char*)(dst + (size_t)(pm * 256 + ai * 128 + m * 16) * ld + ucol + bj * 128);
                    *(v4u*)(ub + lo) = w; } }
    }
    __device__ __forceinline__ void operator()(AccRef acc, const Unit& u, int wr, int wc, int fr, int fq) const {
        const int pm = __builtin_amdgcn_readfirstlane(u.pm), pn = __builtin_amdgcn_readfirstlane(u.pn);
        const int tl0 = wr * 64 + fr, row0 = pm * 256 + tl0, cl = wc * 32 + 8 * fq;
        float rs[2][4];
        { const char* pb = (const char*)(pq + (size_t)pm * 256 * 16); const unsigned lp = (unsigned)(tl0 * 16 + 4 * fq) * 4u;
#pragma unroll
          for (int ai = 0; ai < 2; ++ai)
#pragma unroll
            for (int m = 0; m < 4; ++m) {
                const f32x4 pv = *(const f32x4*)(pb + (size_t)(ai * 128 + m * 16) * 64 + lp); float t = (pv.x + pv.y) + (pv.z + pv.w); t += __shfl_xor(t, 16); t += __shfl_xor(t, 32); rs[ai][m] = __builtin_amdgcn_rsqf(t * (1.f / D) + EPS); } }
        if (pn < 18) {
            const bool smp = pm >= MP / 256; const int kind = pn / 6, g = (pn % 6) >> 1, hp = pn & 1, sh = 2 * g, keep = 128 << sh, t0 = SEQ - keep, b = pm >> 3, tb = (pm & 7) * 256;
            const unsigned Lq = (unsigned)(smp ? tl0 * 1536 : ((((tl0 & ((1 << sh) - 1)) << (11 - sh)) + (tl0 >> sh)) * 128)) * 2u;
            const unsigned Lf = (unsigned)tl0 * 4096u;
            bf16* qbase = (bf16*)((char*)QS + (kind == 0 ? (size_t)0 : (kind == 1 ? WS_KS - WS_QS : WS_VS - WS_QS)));
            float* fbase = out + (smp ? (g == 0 ? O_SWA0S : (g == 1 ? O_SWA1S : O_SWA2S)) : (g == 0 ? O_SWA0P : (g == 1 ? O_SWA1P : O_SWA2P)));
            const int kv = kind - 1;
            if (kind < 2) {
                const int e0 = wc * 16 + 4 * fq;
                const unsigned lt = (unsigned)((smp ? SEQ + (tl0 & 3) : tl0) * 64 + e0) * 4u;
#pragma unroll
                for (int ai = 0; ai < 2; ++ai) {
                    const bool kept = kind == 1 && (smp || tb + ai * 128 >= t0);
                    f32x4 cs[4], sn[4];
#pragma unroll
                    for (int m = 0; m < 4; ++m) { const size_t ut = smp ? 0 : (size_t)(tb + ai * 128 + m * 16) * 64 * 4;
                        cs[m] = *(const f32x4*)((const char*)ropeC + ut + lt); sn[m] = *(const f32x4*)((const char*)ropeS + ut + lt); }
#pragma unroll
                    for (int m = 0; m < 4; ++m) { const int ro = ai * 128 + m * 16; const float s = rs[ai][m];
#pragma unroll
                        for (int bj = 0; bj < 2; ++bj) { const int h = 2 * hp + bj;
                            const f32x4 x1 = acc[ai][bj][m][0] * s, x2 = acc[ai][bj][m][1] * s;
                            f32x4 r1 = x1 * cs[m] - x2 * sn[m], r2 = x2 * cs[m] + x1 * sn[m];
                            if (kind == 0) { r1 *= QSCALE; r2 *= QSCALE; }
                            const size_t uq = smp ? ((size_t)(pm * 256 + ro) * 1536 + g * 512 + h * 128) : (((size_t)((g * NB + b) * 4 + h) * SEQ + ((tb + ro) >> sh)) * 128);
                            char* qp = (char*)(qbase + uq + e0);
                            v2u w1, w2; w1.x = cvt_pk_bf16(r1.x, r1.y); w1.y = cvt_pk_bf16(r1.z, r1.w); w2.x = cvt_pk_bf16(r2.x, r2.y); w2.y = cvt_pk_bf16(r2.z, r2.w);
                            *(v2u*)(qp + Lq) = w1; *(v2u*)(qp + 128 + Lq) = w2;
                            if (kept) { const size_t uf = smp ? (((size_t)(pm * 256 - MP + ro) * 2 + kv) * 512 + h * 128) : ((((size_t)b * keep + (tb + ro - t0)) * 2 + kv) * 512 + h * 128);
                                char* fp = (char*)(fbase + uf + e0); *(f32x4*)(fp + Lf) = r1; *(f32x4*)(fp + 256 + Lf) = r2; }
                        } }
                }
            } else {
#pragma unroll
                for (int ai = 0; ai < 2; ++ai) {
                    const bool kept = smp || tb + ai * 128 >= t0;
#pragma unroll
                    for (int m = 0; m < 4; ++m) { const int ro = ai * 128 + m * 16; const float s = rs[ai][m];
#pragma unroll
                        for (int bj = 0; bj < 2; ++bj) { const int h = 2 * hp + bj; const f32x4 o0 = acc[ai][bj][m][0] * s, o1 = acc[ai][bj][m][1] * s;
                            v4u w; w.x = cvt_pk_bf16(o0.x, o0.y); w.y = cvt_pk_bf16(o0.z, o0.w); w.z = cvt_pk_bf16(o1.x, o1.y); w.w = cvt_pk_bf16(o1.z, o1.w);
                            const size_t uq = smp ? ((size_t)(pm * 256 + ro) * 1536 + g * 512 + h * 128) : (((size_t)((g * NB + b) * 4 + h) * SEQ + ((tb + ro) >> sh)) * 128);
                            char* qp = (char*)(qbase + uq + cl); *(v4u*)(qp + Lq) = w;
                            if (kept) { const size_t uf = smp ? (((size_t)(pm * 256 - MP + ro) * 2 + kv) * 512 + h * 128) : ((((size_t)b * keep + (tb + ro - t0)) * 2 + kv) * 512 + h * 128);
                                char* fp = (char*)(fbase + uf + cl); *(f32x4*)(fp + Lf) = o0; *(f32x4*)(fp + 16 + Lf) = o1; } } }
                }
            }
        } else if (pn == 18) plain<0>(acc, rs, pm, tl0, GQ, 256, 0, cl, 0.125f);
        else if (pn == 19) plain<0>(acc, rs, pm, tl0, GK, 256, 0, cl, 1.f);
        else if (pn < 22) plain<0>(acc, rs, pm, tl0, GV, 512, (pn - 20) * 256, cl, 1.f);
        else if (pn < 24) plain<1>(acc, rs, pm, tl0, GRS, 512, (pn - 22) * 256, cl, 1.f);
        else if (pn == 24) {
            f32x4 bv[2][2];
#pragma unroll
            for (int bj = 0; bj < 2; ++bj)
#pragma unroll
                for (int n = 0; n < 2; ++n) bv[bj][n] = *(const f32x4*)(bga + bj * 128 + cl + 4 * n);
#pragma unroll
            for (int ai = 0; ai < 2; ++ai)
#pragma unroll
                for (int m = 0; m < 4; ++m) { const int row = row0 + ai * 128 + m * 16; const float s = rs[ai][m];
#pragma unroll
                    for (int bj = 0; bj < 2; ++bj)
#pragma unroll
                        for (int n = 0; n < 2; ++n) { const int c = bj * 128 + cl + 4 * n; f32x4 o;
#pragma unroll
                            for (int i = 0; i < 4; ++i) { const float x = acc[ai][bj][m][n][i] * s + bv[bj][n][i];
                                o[i] = (fminf(x, 0.f) - LN2 * fast_log2(1.f + fast_exp2(-1.4426950408889634f * fabsf(x)))) * (1.f / 16.f); }
                            *(f32x4*)(GA + (size_t)row * 256 + c) = o; } }
        } else if (pn < 27) plain<0>(acc, rs, pm, tl0, MQ, 512, (pn - 25) * 256, cl, QSCALE);
        else plain<2>(acc, rs, pm, tl0, GATE, 3072, (pn - 27) * 256, cl, 1.f);
    }
};


constexpr int TS = 4;
template <int O> __device__ __forceinline__ void tail_store_group(const f32x4 (&acc)[2][2][4][2], float* dst) {
#pragma unroll
    for (int e = 0; e < 8; ++e) *(f32x4*)(dst + (size_t)e * 2048) = acc[O >> 1][e >> 2][2 * (O & 1) + ((e >> 1) & 1)][e & 1];
}
template <int O> __device__ __forceinline__ void tail_store_gated(const f32x4 (&acc)[2][2][4][2], const bf16* gp, float* dst) {
    v4u g[2][2];
#pragma unroll
    for (int mm = 0; mm < 2; ++mm)
#pragma unroll
        for (int bj = 0; bj < 2; ++bj) g[mm][bj] = *(const v4u*)(gp + (size_t)((O >> 1) * 128 + (2 * (O & 1) + mm) * 16) * 3072 + bj * 128);
#pragma unroll
    for (int e = 0; e < 8; ++e) { const v4u gv = g[(e >> 1) & 1][e >> 2];
        const f32x4 gg = (e & 1) ? (f32x4){bflo(gv.z), bfhi(gv.z), bflo(gv.w), bfhi(gv.w)} : (f32x4){bflo(gv.x), bfhi(gv.x), bflo(gv.y), bfhi(gv.y)};
        *(f32x4*)(dst + (size_t)e * 2048) = acc[O >> 1][e >> 2][2 * (O & 1) + ((e >> 1) & 1)][e & 1] * gg; }
}
template <class Base, bool GATED = false> struct EpiTail {
    static constexpr bool HAS_MID = false;
    Base E0; float* slab  ; gu32* flag; int s, wave; const bf16* gate  ;
    __device__ __forceinline__ void operator()(const f32x4 (&acc)[2][2][4][2], const Unit& u, int wr, int wc, int fr, int fq) const {
        const int lane = fq * 16 + fr; float* lb = slab + (size_t)(wave * 64 + lane) * 4;
        if (GATED) { const bf16* gp = gate + (size_t)(u.pm * 256 + wr * 64 + fr) * 3072 + u.pn * 256 + wc * 32 + 8 * fq;
            tail_store_gated<0>(acc, gp, lb + (size_t)((0 * TS + s) * 8) * 2048); tail_store_gated<1>(acc, gp, lb + (size_t)((1 * TS + s) * 8) * 2048);
            tail_store_gated<2>(acc, gp, lb + (size_t)((2 * TS + s) * 8) * 2048); tail_store_gated<3>(acc, gp, lb + (size_t)((3 * TS + s) * 8) * 2048); }
        else {
        tail_store_group<0>(acc, lb + (size_t)((0 * TS + s) * 8) * 2048); tail_store_group<1>(acc, lb + (size_t)((1 * TS + s) * 8) * 2048);
        tail_store_group<2>(acc, lb + (size_t)((2 * TS + s) * 8) * 2048); tail_store_group<3>(acc, lb + (size_t)((3 * TS + s) * 8) * 2048); }
        asm volatile("s_waitcnt vmcnt(0)" ::: "memory");
        asm volatile("s_waitcnt lgkmcnt(0)" ::: "memory"); __builtin_amdgcn_s_barrier(); asm volatile("" ::: "memory");
        if (wave == 0) {
            if (lane == 0) { __builtin_amdgcn_fence(__ATOMIC_RELEASE, "agent"); asm volatile("s_waitcnt vmcnt(0)" ::: "memory"); __hip_atomic_fetch_add(flag, 1u, RLX_AGENT); }
            unsigned spins = 0;
            while ((unsigned)__builtin_amdgcn_readfirstlane((int)__hip_atomic_load(flag, RLX_AGENT)) < (unsigned)TS) { __builtin_amdgcn_s_sleep(4); if (++spins > (1u << 22)) break; }
            __builtin_amdgcn_fence(__ATOMIC_ACQUIRE, "agent"); asm volatile("s_waitcnt vmcnt(0)" ::: "memory"); }
        asm volatile("s_waitcnt lgkmcnt(0)" ::: "memory"); __builtin_amdgcn_s_barrier(); asm volatile("" ::: "memory");
        const float* src = lb + (size_t)(s * TS * 8) * 2048;
        f32x4 t[TS][8];
#pragma unroll
        for (int ci = 0; ci < TS; ++ci)
#pragma unroll
            for (int e = 0; e < 8; ++e) t[ci][e] = *(const f32x4*)(src + (size_t)(ci * 8 + e) * 2048);
        f32x4 own[8];
#pragma unroll
        for (int e = 0; e < 8; ++e) own[e] = (t[0][e] + t[1][e]) + (t[2][e] + t[3][e]);
        if (s == 0) E0.template group<0>(own, u, wr, wc, fr, fq); else if (s == 1) E0.template group<1>(own, u, wr, wc, fr, fq);
        else if (s == 2) E0.template group<2>(own, u, wr, wc, fr, fq); else E0.template group<3>(own, u, wr, wc, fr, fq);
    }
};
#define XB_TMO      128
#define XB_XCNT(j)  (256  + 64 * (j))
#define XB_XSUB(j)  (1280 + 64 * (j))
#define XB_XGEN(j)  (2304 + 64 * (j))
#define XB_TOP      3328
#define XB_TOPGEN   3392
#define XCD_BAR_WORDS 3456
#define XB_SPIN_CAP (1u << 18)
__device__ __forceinline__ unsigned xb_ld(unsigned* p)              { return __hip_atomic_load(p, __ATOMIC_RELAXED, __HIP_MEMORY_SCOPE_AGENT); }
__device__ __forceinline__ unsigned xb_add(unsigned* p, unsigned v) { return __hip_atomic_fetch_add(p, v, __ATOMIC_RELAXED, __HIP_MEMORY_SCOPE_AGENT); }
__device__ __forceinline__ unsigned xb_xcc_id() { return (unsigned)__builtin_amdgcn_s_getreg((3 << 11) | 20) & 0xFu; }
#define XB_SPIN(cond, bar) do { unsigned _sp = 0; while (cond) { __builtin_amdgcn_s_sleep(1); \
    if ((++_sp & 255u) == 0u) { if (xb_ld(&(bar)[XB_TMO])) break; if (_sp > XB_SPIN_CAP) { atomicAdd(&(bar)[XB_TMO], 1u); break; } } } } while (0)
struct XcdBarrier { unsigned* bar; unsigned x; volatile LAS unsigned* st; };
__device__ __forceinline__ XcdBarrier xcd_barrier_post(unsigned* bar, volatile LAS unsigned* st, int wave) {
    XcdBarrier b; b.bar = bar; b.x = xb_xcc_id(); b.st = st;
    if (wave == 0 && lane_id() == 0) (void)xb_add(&bar[XB_XCNT(b.x)], 1u);
    return b;
}
__device__ __forceinline__ void xcd_barrier_complete(unsigned* bar, unsigned x, unsigned& nloc, unsigned& nx) {
    const unsigned G = gridDim.x * gridDim.y * gridDim.z;
    unsigned sum, cnt, mine, sp = 0u;
    for (;;) {
        sum = 0u; cnt = 0u; mine = 0u;
#pragma unroll
        for (unsigned j = 0; j < 16; ++j) { const unsigned c = xb_ld(&bar[XB_XCNT(j)]); sum += c; cnt += (c > 0u) ? 1u : 0u; mine = (j == x) ? c : mine; }
        if (sum == G) break;
        __builtin_amdgcn_s_sleep(1);
        if ((++sp & 255u) == 0u) { if (xb_ld(&bar[XB_TMO])) break; if (sp > XB_SPIN_CAP) { atomicAdd(&bar[XB_TMO], 1u); break; } }
    }
    nloc = mine > 0u ? mine : 1u; nx = cnt > 0u ? cnt : 1u;
}
__device__ __forceinline__ void xcd_barrier(const XcdBarrier& b, int wave) {
    asm volatile("s_waitcnt vmcnt(0)" ::: "memory");
    __syncthreads();
    if (wave == 0 && lane_id() == 0) {
        unsigned* bar = b.bar;
        __builtin_amdgcn_s_waitcnt(0);
        unsigned nloc = b.st[0], nx = b.st[1];
        if (nloc == 0u) { xcd_barrier_complete(bar, b.x, nloc, nx); b.st[0] = nloc; b.st[1] = nx; }
        const unsigned old = xb_add(&bar[XB_XSUB(b.x)], 1u);
        const unsigned gen = old / nloc;
        if (old + 1u == (gen + 1u) * nloc) {
            __builtin_amdgcn_fence(__ATOMIC_RELEASE, "agent");
            asm volatile("s_waitcnt vmcnt(0)" ::: "memory");
            const unsigned og = xb_add(&bar[XB_TOP], 1u);
            const unsigned tg = og / nx;
            if (og + 1u == (tg + 1u) * nx) xb_add(&bar[XB_TOPGEN], 1u);
            else XB_SPIN(xb_ld(&bar[XB_TOPGEN]) == tg, bar);
            __builtin_amdgcn_fence(__ATOMIC_ACQUIRE, "agent");
            xb_add(&bar[XB_XGEN(b.x)], 1u);
            asm volatile("s_waitcnt vmcnt(0)" ::: "memory");
        } else {
            XB_SPIN(xb_ld(&bar[XB_XGEN(b.x)]) == gen, bar);
            __builtin_amdgcn_fence(__ATOMIC_ACQUIRE, "agent");
            asm volatile("s_waitcnt vmcnt(0)" ::: "memory");
        }
    }
    __syncthreads();
}

struct Args { const float* in[25]; float* out; unsigned char* ws; int ph_lo, ph_hi, li, pad; };
struct Frame {
    LAS unsigned char* lds; int tid, lane, wave, vcu, G;
    const float *i0, *i1, *i2, *i3, *i4, *i5, *i6, *i7, *i8, *i9, *i10, *i11, *i12, *i13, *i14, *i15, *i16, *i17, *i18, *i19, *i20, *i21, *i22, *i23, *i24;
    float* out; unsigned char* ws;
};
__device__ __forceinline__ float wave_sum(float v) {
#pragma unroll
    for (int o = 1; o < 64; o <<= 1) v += __shfl_xor(v, o);
    return v;
}

template <class Base, bool ATILED = false> __device__ __forceinline__ void tail_phase(Frame& F, const bf16* A, int lda, const bf16* Bt, int ldb, int K, const Base& E0, int ps) {
    const int c = (int)blockIdx.x; if (c >= 8 * TS) return;
    const int j = c / TS, s = c % TS, nch = K / 128, c0 = (s * nch) / TS, c1 = ((s + 1) * nch) / TS;
    pg8::OneUnit S; S.c = c; pg8::StaticOrderT<MR / 256, D / 256>::unit_of(1024 + j, S.u);
    pg8::Gemm g{A + (ATILED ? (size_t)c0 * 2 * (pg8::TILED_KS / 2) : (size_t)c0 * 128), Bt + c0 * 128, MR, D, (c1 - c0) * 128, lda, ldb};
    EpiTail<Base> E{E0, (float*)(F.ws + WS_SLAB) + (size_t)j * (TS * TS * 8 * 2048), (gu32*)(F.ws + WS_CTL) + CW_TAIL + (ps * 8 + j) * 64, s, F.wave};
    pg8::gemm_phase<EpiTail<Base>, pg8::OneUnit, true, ATILED>(F.lds + RING_OFF, g, S, E, F.wave);
}
__device__ __forceinline__ void tail_phase_merge(Frame& F, const bf16* A, const bf16* Bt, const EpiMerge1& E0, int ps) {
    const int c = (int)blockIdx.x; if (c >= 8 * TS) return;
    const int j = c / TS, s = c % TS, k0 = s < 2 ? 512 * s : 1024 + 256 * (s - 2), kl = s < 2 ? 512 : 256, br = s < 2 ? s : 2;
    pg8::OneUnit S; S.c = c; pg8::StaticOrderT<MR / 256, D / 256>::unit_of(1024 + j, S.u);
    pg8::Gemm g{A + k0, Bt + k0, MR, D, kl, 1536, 1536};
    EpiTail<EpiMerge1, true> E{E0, (float*)(F.ws + WS_SLAB) + (size_t)j * (TS * TS * 8 * 2048), (gu32*)(F.ws + WS_CTL) + CW_TAIL + (ps * 8 + j) * 64, s, F.wave, E0.GATE + br * 1024};
    pg8::gemm_phase<EpiTail<EpiMerge1, true>, pg8::OneUnit>(F.lds + RING_OFF, g, S, E, F.wave);
}
enum WKind { WK_PLAIN = 0, WK_SWIGLU = 1, WK_IN = 2 };
__device__ __forceinline__ int p0_win_col(int np) {
    const int pn = np >> 8, r = np & 255;
    if (pn < 18) { const int qkv = pn / 6, g = (pn % 6) >> 1, hp = pn & 1, h = 2 * hp + (r >> 7); const int d = qkv < 2 ? sig_rope(r & 127) : sig_plain(r & 127); return ((qkv * 3 + g) * 4 + h) * 128 + d; }
    const int c = sig_plain(r);
    if (pn == 18) return 4608 + c;
    if (pn == 19) return 4864 + c;
    if (pn < 22) return 5120 + (pn - 20) * 256 + c;
    if (pn < 24) return 5632 + (pn - 22) * 256 + c;
    if (pn == 24) return -1 - c;
    if (pn < 27) return 6160 + (pn - 25) * 256 + c;
    return DIN + (pn - 27) * 256 + c;
}
__device__ __forceinline__ void p0_item(const Frame& F, int kind, const float* W, int ldw, const float* W2, const float* gain, const float* a2, bf16* WT, int K, int kb, int nb, LAS float* scr) {
    const int lane = F.lane, k0 = 64 * kb, n0 = 32 * nb, np = n0 + (lane & 31);
    int sc; const float* Wp = W; int ld = ldw;
    if (kind == WK_PLAIN) sc = sig_plain(np);
    else if (kind == WK_SWIGLU) { const int r = np & 255; sc = (r >> 7) * FF + (np >> 8) * 128 + sig_plain(r & 127); }
    else { sc = p0_win_col(np); if (sc >= DIN) { sc -= DIN; Wp = W2; ld = 3072; } }
    if (sc >= 0) {
#pragma unroll 8
        for (int i = 0; i < 32; ++i) { const int kk = 2 * i + (lane >> 5); float v = Wp[(size_t)(k0 + kk) * ld + sc]; if (gain) v *= gain[k0 + kk]; scr[kk * 33 + (lane & 31)] = v; }
    } else {
        const int j = -1 - sc; float a2c[16];
#pragma unroll
        for (int r = 0; r < 16; ++r) a2c[r] = a2[r * 256 + j];
        for (int i = 0; i < 32; ++i) { const int kk = 2 * i + (lane >> 5); const float* wr_ = W + (size_t)(k0 + kk) * ldw + 6144; float v = 0.f;
#pragma unroll
            for (int r = 0; r < 16; ++r) v += wr_[r] * a2c[r];
            scr[kk * 33 + (lane & 31)] = v * gain[k0 + kk]; }
    }
    LDS_WAIT(); asm volatile("" ::: "memory");
    const int c = lane & 7;
#pragma unroll
    for (int j = 0; j < 4; ++j) { const int n = (lane >> 3) + 8 * j; const LAS float* s = scr + (8 * c) * 33 + n;
        v4u o; o.x = pk2(s[0 * 33], s[1 * 33]); o.y = pk2(s[2 * 33], s[3 * 33]); o.z = pk2(s[4 * 33], s[5 * 33]); o.w = pk2(s[6 * 33], s[7 * 33]);
        *(GAS v4u*)(WT + (size_t)(n0 + n) * K + k0 + 8 * c) = o; }
    LDS_WAIT(); asm volatile("" ::: "memory");
}
template <int NR> __device__ __forceinline__ void rms_rows_to_bf16(int lane, const float* const (&xrow)[NR], const float* const (&gain)[NR], bf16* const (&orow)[NR]) {
    f32x4 v[NR][4]; float rstd[NR];
#pragma unroll
    for (int r = 0; r < NR; ++r)
#pragma unroll
        for (int j = 0; j < 4; ++j) v[r][j] = ((const GAS f32x4*)xrow[r] + lane)[64 * j];
#pragma unroll
    for (int r = 0; r < NR; ++r) { float s = 0.f;
#pragma unroll
        for (int j = 0; j < 4; ++j) s += (v[r][j].x * v[r][j].x + v[r][j].y * v[r][j].y) + (v[r][j].z * v[r][j].z + v[r][j].w * v[r][j].w);
        rstd[r] = 1.0f / sqrtf(wave_sum(s) * (1.f / D) + EPS); }
#pragma unroll
    for (int r = 0; r < NR; ++r) { GAS v2u* o8 = (GAS v2u*)orow[r] + lane; const GAS f32x4* gr = (const GAS f32x4*)gain[r] + lane;
#pragma unroll
        for (int j = 0; j < 4; ++j) { const f32x4 gg = gr[64 * j]; v2u w; w.x = pk2(v[r][j].x * rstd[r] * gg.x, v[r][j].y * rstd[r] * gg.y); w.y = pk2(v[r][j].z * rstd[r] * gg.z, v[r][j].w * rstd[r] * gg.w); o8[64 * j] = w; } }
}
__device__ __forceinline__ void sincos_d(double x, double& s, double& c) {
    const double TWO_PI = 6.283185307179586476925286766559;
    const double n = __builtin_rint(x / TWO_PI); const double r = x - n * TWO_PI, r2 = r * r;
    double ts = 1.0, tc = 1.0;
#pragma unroll
    for (int k = 14; k >= 1; --k) { ts = 1.0 - ts * r2 / (double)((2 * k) * (2 * k + 1)); tc = 1.0 - tc * r2 / (double)((2 * k - 1) * (2 * k)); }
    s = ts * r; c = tc;
}
__device__ __forceinline__ void p0_prologue(Frame& F) {
    unsigned char* ws = F.ws;
    LAS float* scr = (LAS float*)(F.lds + RING_OFF + F.wave * 16384);
    const int gw = F.vcu * NWAVES + F.wave, NGW = F.G * NWAVES;
    constexpr int I_A = 16 * 176, I_O = 44 * 32, I_IN = 16 * 312, I_BR = 8 * 32, I_SQ = 16 * 32;
    constexpr int NITEMS = 2 * I_A + 2 * I_O + I_IN + 3 * I_BR + 2 * I_SQ;
    for (int it = gw; it < NITEMS; it += NGW) {
        int r = it;
        if (r < I_A) { p0_item(F, WK_SWIGLU, F.i9, 2 * FF, nullptr, nullptr, nullptr, (bf16*)(ws + WS_W1A), D, r / 176, r % 176, scr); continue; } r -= I_A;
        if (r < I_A) { p0_item(F, WK_SWIGLU, F.i22, 2 * FF, nullptr, F.i21, nullptr, (bf16*)(ws + WS_W2A), D, r / 176, r % 176, scr); continue; } r -= I_A;
        if (r < I_O) { p0_item(F, WK_PLAIN, F.i10, D, nullptr, nullptr, nullptr, (bf16*)(ws + WS_W1O), FF, r / 32, r % 32, scr); continue; } r -= I_O;
        if (r < I_O) { p0_item(F, WK_PLAIN, F.i23, D, nullptr, nullptr, nullptr, (bf16*)(ws + WS_W2O), FF, r / 32, r % 32, scr); continue; } r -= I_O;
        if (r < I_IN) { p0_item(F, WK_IN, F.i12, DIN, F.i16, F.i11, F.i13, (bf16*)(ws + WS_WIN), D, r / 312, r % 312, scr); continue; } r -= I_IN;
        if (r < 3 * I_BR) { const int br = r / I_BR, q = r % I_BR; p0_item(F, WK_PLAIN, F.i17 + (size_t)br * 512 * D, D, nullptr, nullptr, nullptr, (bf16*)(ws + WS_WBR) + br * 512, 1536, q / 32, q % 32, scr); continue; } r -= 3 * I_BR;
        if (r < I_SQ) { p0_item(F, WK_PLAIN, F.i18, D, nullptr, nullptr, nullptr, (bf16*)(ws + WS_WOUT), D, r / 32, r % 32, scr); continue; } r -= I_SQ;
        p0_item(F, WK_PLAIN, F.i20, D, nullptr, nullptr, nullptr, (bf16*)(ws + WS_WMEM), D, r / 32, r % 32, scr);
    }
#define P0_ROW(m_, x_, g_, o_) do { const int mm_ = (m_); if (mm_ < MP) { x_ = F.i0 + (size_t)mm_ * D; g_ = F.i8; o_ = (bf16*)(ws + WS_XB) + (size_t)mm_ * D; } \
        else if (mm_ < MR) { x_ = F.i1 + (size_t)(mm_ - MP) * D; g_ = F.i8; o_ = (bf16*)(ws + WS_XB) + (size_t)mm_ * D; } \
        else { x_ = F.i2 + (size_t)(mm_ - MR) * D; g_ = F.i19; o_ = (bf16*)(ws + WS_MEMB) + (size_t)(mm_ - MR) * D; } } while (0)
    { int m = gw;
      for (; m + 3 * NGW < MR + MM; m += 4 * NGW) { const float* x[4]; const float* g[4]; bf16* o[4];
#pragma unroll
          for (int r = 0; r < 4; ++r) P0_ROW(m + r * NGW, x[r], g[r], o[r]);
          rms_rows_to_bf16<4>(F.lane, x, g, o); }
      for (; m < MR + MM; m += NGW) { const float* x[1]; const float* g[1]; bf16* o[1]; P0_ROW(m, x[0], g[0], o[0]); rms_rows_to_bf16<1>(F.lane, x, g, o); } }
#undef P0_ROW
    float* rc = (float*)(ws + WS_ROPE); float* rsn = rc + NPOS * 64;
    for (int i = (F.vcu * NWAVES * 64) + F.tid; i < NPOS * 64; i += F.G * NWAVES * 64) {
        const int p = i >> 6, e = i & 63; const int pos = p < SEQ ? p : PAST + (p - SEQ);
        const double y = -(double)e * 9.210340371976182736 / 64.0 / 16.0; double ex = 1.0;
#pragma unroll
        for (int k = 14; k >= 1; --k) ex = 1.0 + ex * y / (double)k;
        ex *= ex; ex *= ex; ex *= ex; ex *= ex;
        const float inv = (float)ex; const float ang = (float)pos * inv;
        double s, c; sincos_d((double)ang, s, c); rc[i] = (float)c; rsn[i] = (float)s;
    }
}

__device__ __forceinline__ int koff(int row, int ch) { return 256 * row + 16 * (ch ^ (row & 15)); }
__device__ __forceinline__ int voff(int row, int ch) { return 256 * row + 16 * (ch ^ ((row & 7) << 1)); }
typedef short v4i16_t __attribute__((ext_vector_type(4)));
__device__ __forceinline__ s16x4 vtr(const LAS unsigned char* p) { return __builtin_bit_cast(s16x4, __builtin_amdgcn_ds_read_tr16_b64_v4i16((LAS v4i16_t*)p)); }
struct AttnDesc { const bf16* Qp; const bf16* Kp; const bf16* Vp; bf16* Op; float* lsep; long qrow0, krow0, orow0; int qpitch, kpitch, opitch, qstride, kstride, ostride, kmin; };
template <int MODE> __device__ __forceinline__ AttnDesc attn_desc(const Frame& F, int id) {
    unsigned char* ws = F.ws; AttnDesc d;
    if (MODE == 0) {
        const int b = id / 192, rem = id % 192, gh = rem >> 4, u = rem & 15, g = gh >> 2;
        const int dil = g == 0 ? 1 : (g == 1 ? 4 : 16), r = g == 0 ? 0 : (g == 1 ? (u & 3) : u), n = g == 0 ? u : (g == 1 ? (u >> 2) : 0);
        const size_t hb = (size_t)((g * NB + b) * 4 + (gh & 3)) * SEQ * 128; const long pr = (long)r * (SEQ / dil);
        d.Qp = (const bf16*)(ws + WS_QS) + hb; d.Kp = (const bf16*)(ws + WS_KS) + hb; d.Vp = (const bf16*)(ws + WS_VS) + hb; d.Op = (bf16*)(ws + WS_OG) + gh * 128; d.lsep = (float*)(ws + WS_LSE) + gh;
        d.qrow0 = pr + 128 * n; d.krow0 = pr + 128 * (n - 1); d.orow0 = (long)b * SEQ + r + (long)128 * n * dil; d.qpitch = 128; d.kpitch = 128; d.opitch = 1536; d.qstride = 1; d.kstride = 1; d.ostride = dil; d.kmin = n == 0 ? 128 : 0;
    } else {
        const int j = id - 6144, b = j >> 6, h = (j >> 4) & 3, n = j & 15;
        d.Qp = (const bf16*)(ws + WS_MQ) + h * 128; d.Kp = (const bf16*)(ws + WS_MKV) + h * 128; d.Vp = (const bf16*)(ws + WS_MKV) + 512 + h * 128; d.Op = (bf16*)(ws + WS_OALL) + 1024 + h * 128; d.lsep = nullptr;
        d.qrow0 = (long)b * SEQ + 128 * n; d.orow0 = d.qrow0; d.ostride = 1; d.krow0 = (long)b * MEML; d.qpitch = 512; d.kpitch = 1024; d.opitch = 1536; d.qstride = 1; d.kstride = 1; d.kmin = 0;
    }
    return d;
}
template <int MODE> __device__ __forceinline__ void attn_scores(const Frame& F, const AttnDesc& d, const bf16x8 (&qf)[4], f32x4 (&S)[MODE == 0 ? 9 : 16], float& mx_out, float& ls_out) {
    const LAS unsigned char* ldsK = F.lds + RING_OFF;
    const int lane = F.lane, w = F.wave, l15 = lane & 15, g4 = lane >> 4;
    constexpr int NF = MODE == 0 ? 9 : 16;
    const int f0 = MODE == 0 ? w : 0; const bool half = MODE == 0 && d.kmin != 0;
#pragma unroll
    for (int i = 0; i < NF; ++i) { S[i] = (f32x4){0.f, 0.f, 0.f, 0.f};
        if (!(half && f0 + i < 8)) { const int krow = 16 * (f0 + i) + l15;
#pragma unroll
            for (int s = 0; s < 4; ++s) { const bf16x8 kf = *(const LAS bf16x8*)(ldsK + koff(krow, 4 * s + g4)); S[i] = __builtin_amdgcn_mfma_f32_16x16x32_bf16(kf, qf[s], S[i], 0, 0, 0); } } }
    float mx = -3.0e38f; const int iq = 16 * w + l15;
#pragma unroll
    for (int i = 0; i < NF; ++i)
#pragma unroll
        for (int r = 0; r < 4; ++r) { if (MODE == 0) { const int kj = 16 * (f0 + i) + 4 * g4 + r; const bool ok = kj >= iq && kj <= iq + 128 && kj >= d.kmin; S[i][r] = ok ? S[i][r] : -3.0e38f; } mx = fmaxf(mx, S[i][r]); }
    mx = fmaxf(mx, __shfl_xor(mx, 16)); mx = fmaxf(mx, __shfl_xor(mx, 32));
    float ls = 0.f;
#pragma unroll
    for (int i = 0; i < NF; ++i)
#pragma unroll
        for (int r = 0; r < 4; ++r) { const float p = fast_exp2(S[i][r] - mx); S[i][r] = p; ls += p; }
    ls += __shfl_xor(ls, 16); ls += __shfl_xor(ls, 32);
    mx_out = mx; ls_out = ls;
}
template <int MODE> __device__ __forceinline__ void attn_pv(const Frame& F, const AttnDesc& d, const f32x4 (&S)[MODE == 0 ? 9 : 16], float mx, float ls) {
    const LAS unsigned char* ldsV = F.lds + RING_OFF + 65536;
    const int lane = F.lane, w = F.wave, l15 = lane & 15, g4 = lane >> 4;
    constexpr int NF = MODE == 0 ? 9 : 16, NP = (NF + 1) / 2;
    const int f0 = MODE == 0 ? w : 0; const bool half = MODE == 0 && d.kmin != 0;
    f32x4 O[8];
#pragma unroll
    for (int df = 0; df < 8; ++df) O[df] = (f32x4){0.f, 0.f, 0.f, 0.f};
    const int q4 = l15 >> 2, p4 = lane & 3;
#pragma unroll
    for (int pr = 0; pr < NP; ++pr) {
        int fa = f0 + 2 * pr, fb = fa + 1; if (fb > 15) fb = 15;
        if (half && fb < 8) continue;
        if (half && fa < 8) fa = 8;
        const f32x4 pa = S[2 * pr], pb = (2 * pr + 1 < NF) ? S[(2 * pr + 1 < NF) ? 2 * pr + 1 : 0] : (f32x4){0.f, 0.f, 0.f, 0.f};
        v4u pw; pw.x = cvt_pk_bf16(pa.x, pa.y); pw.y = cvt_pk_bf16(pa.z, pa.w); pw.z = cvt_pk_bf16(pb.x, pb.y); pw.w = cvt_pk_bf16(pb.z, pb.w);
        const bf16x8 pf = __builtin_bit_cast(bf16x8, pw);
        const int ra = 16 * fa + 4 * g4 + q4, rb = 16 * fb + 4 * g4 + q4;
#pragma unroll
        for (int df = 0; df < 8; ++df) {
            const s16x4 t1 = vtr(ldsV + voff(ra, 2 * df + (p4 >> 1)) + 8 * (p4 & 1)), t2 = vtr(ldsV + voff(rb, 2 * df + (p4 >> 1)) + 8 * (p4 & 1));
            const bf16x8 vf = {t1[0], t1[1], t1[2], t1[3], t2[0], t2[1], t2[2], t2[3]};
            O[df] = __builtin_amdgcn_mfma_f32_16x16x32_bf16(vf, pf, O[df], 0, 0, 0);
        }
    }
    const float inv = 1.0f / ls;
    const long qrow = d.orow0 + (long)(16 * w + l15) * d.ostride;
    bf16* op = d.Op + qrow * d.opitch + 4 * g4;
#pragma unroll
    for (int df = 0; df < 8; ++df) { const f32x4 o = O[df] * inv; v2u wv; wv.x = cvt_pk_bf16(o.x, o.y); wv.y = cvt_pk_bf16(o.z, o.w); *(v2u*)(op + 16 * df) = wv; }
    if (MODE == 0 && g4 == 0) d.lsep[qrow * 12] = (mx + fast_log2(ls)) * LN2;
}
__device__ __forceinline__ void glds16(const void* gsrc, unsigned lds_dst) { unsigned keep;
    asm volatile("s_mov_b32 %0, m0\n\ts_mov_b32 m0, %2\n\ts_nop 0\n\tglobal_load_lds_dwordx4 %1, off\n\ts_mov_b32 m0, %0" : "=&s"(keep) : "v"(gsrc), "s"(lds_dst) : "memory"); }
__device__ __forceinline__ void attn_dma(const Frame& F, const AttnDesc& d, const bool isV) {
    const bf16* P = isV ? d.Vp : d.Kp;
    const unsigned base = (unsigned)__builtin_amdgcn_readfirstlane((int)(unsigned)(size_t)(F.lds + RING_OFF) + (isV ? 65536 : 0) + F.wave * 8192);
    if (d.kmin != 0 && F.wave < 4) return;
    const int slot = F.lane & 15, rsub = F.lane >> 4;
#pragma unroll
    for (int i = 0; i < 8; ++i) { const int row = 32 * F.wave + 4 * i + rsub, ch = isV ? (slot ^ ((row & 7) << 1)) : (slot ^ (row & 15));
        const bf16* gp = P + (d.krow0 + (long)row * d.kstride) * d.kpitch + ch * 8;
        glds16(gp, base + i * 1024); }
}
__device__ __forceinline__ void attn_loadq(const Frame& F, const AttnDesc& d, bf16x8 (&qf)[4]) {
    const long qrow = d.qrow0 + (long)(16 * F.wave + (F.lane & 15)) * d.qstride;
#pragma unroll
    for (int s = 0; s < 4; ++s) qf[s] = *(const bf16x8*)(d.Qp + qrow * d.qpitch + 32 * s + 8 * (F.lane >> 4));
}
#define ATT_BAR() do { asm volatile("s_waitcnt lgkmcnt(0)" ::: "memory"); __builtin_amdgcn_s_barrier(); asm volatile("" ::: "memory"); } while (0)
template <int MODE, int NU> __device__ __forceinline__ void attn_batch(const Frame& F, int id0) {
    AttnDesc d = attn_desc<MODE>(F, id0);
    bf16x8 qn[4], qc[4];
    attn_dma(F, d, false); attn_loadq(F, d, qn);
#pragma unroll
    for (int s = 0; s < 4; ++s) qc[s] = qn[s];
    attn_dma(F, d, true);
#pragma unroll 1
    for (int u = 0; u < NU; ++u) {
        asm volatile("s_waitcnt vmcnt(8)" ::: "memory"); ATT_BAR();
        f32x4 S[MODE == 0 ? 9 : 16]; float mx, ls;
        attn_scores<MODE>(F, d, qc, S, mx, ls);
        asm volatile("s_waitcnt vmcnt(0)" ::: "memory"); ATT_BAR();
        const bool more = u + 1 < NU;
        const AttnDesc dn = attn_desc<MODE>(F, id0 + (more ? u + 1 : u));
        if (more) { attn_dma(F, dn, false); if (MODE == 0) attn_loadq(F, dn, qn); }
        attn_pv<MODE>(F, d, S, mx, ls);
        ATT_BAR();
        if (more) {
            if (MODE != 0) attn_loadq(F, dn, qn);
#pragma unroll
            for (int s = 0; s < 4; ++s) qc[s] = qn[s];
            asm volatile("" : "+v"(qc[0]), "+v"(qc[1]), "+v"(qc[2]), "+v"(qc[3]));
            attn_dma(F, dn, true); }
        d = dn;
    }
    asm volatile("s_waitcnt vmcnt(0)" ::: "memory");
}
__device__ __forceinline__ void p4_sample_attn(const Frame& F, int wt, const float* c0, const float* c1, const float* c2, const float* cm) {
    unsigned char* ws = F.ws; const int lane = F.lane, sub = lane & 15, t = lane >> 4;
    const int db = wt >> 4, h = (wt >> 2) & 3, src = wt & 3;
    const int row = MP + db * 4 + t;
    const bf16* qp = src < 3 ? (const bf16*)(ws + WS_QS) + (size_t)row * 1536 + src * 512 + h * 128 + 8 * sub : (const bf16*)(ws + WS_MQ) + (size_t)row * 512 + h * 128 + 8 * sub;
    float q[8]; { const v4u qw = *(const v4u*)qp; q[0] = bflo(qw.x); q[1] = bfhi(qw.x); q[2] = bflo(qw.y); q[3] = bfhi(qw.y); q[4] = bflo(qw.z); q[5] = bfhi(qw.z); q[6] = bflo(qw.w); q[7] = bfhi(qw.w); }
    float mx = -3.0e38f, ls = 0.f, o[8];
#pragma unroll
    for (int j = 0; j < 8; ++j) o[j] = 0.f;
#define SA_STEP(K0, K1, V0, V1) do { float s_ = (q[0] * K0.x + q[1] * K0.y) + (q[2] * K0.z + q[3] * K0.w) + (q[4] * K1.x + q[5] * K1.y) + (q[6] * K1.z + q[7] * K1.w); \
        s_ += __shfl_xor(s_, 1); s_ += __shfl_xor(s_, 2); s_ += __shfl_xor(s_, 4); s_ += __shfl_xor(s_, 8); \
        const float mn_ = fmaxf(mx, s_), sc_ = fast_exp2(mx - mn_), p_ = fast_exp2(s_ - mn_); mx = mn_; ls = ls * sc_ + p_; \
        o[0] = o[0] * sc_ + p_ * V0.x; o[1] = o[1] * sc_ + p_ * V0.y; o[2] = o[2] * sc_ + p_ * V0.z; o[3] = o[3] * sc_ + p_ * V0.w; \
        o[4] = o[4] * sc_ + p_ * V1.x; o[5] = o[5] * sc_ + p_ * V1.y; o[6] = o[6] * sc_ + p_ * V1.z; o[7] = o[7] * sc_ + p_ * V1.w; } while (0)
    int nstart = 0, NK; const float* cache; int L = 256, dil = 1;
    if (src == 3) { cache = cm; NK = 256; }
    else { cache = src == 0 ? c0 : (src == 1 ? c1 : c2); L = 128 << (2 * src); dil = src == 0 ? 1 : (src == 1 ? 4 : 16); NK = 129; nstart = 4;
        for (int n = 0; n < 4; ++n) {
            const int idx = L + t - dil * n; f32x4 k0, k1, v0, v1;
            if (idx >= L) { const size_t ro = (size_t)(MP + db * 4 + (idx - L)) * 1536 + src * 512 + h * 128 + 8 * sub;
                const v4u kw = *(const v4u*)((const bf16*)(ws + WS_KS) + ro), vw = *(const v4u*)((const bf16*)(ws + WS_VS) + ro);
                k0 = (f32x4){bflo(kw.x), bfhi(kw.x), bflo(kw.y), bfhi(kw.y)}; k1 = (f32x4){bflo(kw.z), bfhi(kw.z), bflo(kw.w), bfhi(kw.w)};
                v0 = (f32x4){bflo(vw.x), bfhi(vw.x), bflo(vw.y), bfhi(vw.y)}; v1 = (f32x4){bflo(vw.z), bfhi(vw.z), bflo(vw.w), bfhi(vw.w)};
            } else { const float* kp = cache + (((size_t)db * L + idx) * 2) * 512 + h * 128 + 8 * sub;
                k0 = *(const f32x4*)kp; k1 = *(const f32x4*)(kp + 4); v0 = *(const f32x4*)(kp + 512); v1 = *(const f32x4*)(kp + 516); }
            SA_STEP(k0, k1, v0, v1);
        }
    }
    const float* kbase = cache + ((size_t)db * L * 2) * 512 + h * 128 + 8 * sub;
    const long kstep = src == 3 ? 1024 : -(long)dil * 1024; const long kfirst = src == 3 ? 0 : (long)(L + t) * 1024;
    int n = nstart;
    for (; n + 4 <= NK; n += 4) {
        f32x4 kk[4][2], vv[4][2];
#pragma unroll
        for (int j = 0; j < 4; ++j) { const float* kp = kbase + kfirst + (long)(n + j) * kstep; kk[j][0] = *(const f32x4*)kp; kk[j][1] = *(const f32x4*)(kp + 4); vv[j][0] = *(const f32x4*)(kp + 512); vv[j][1] = *(const f32x4*)(kp + 516); }
#pragma unroll
        for (int j = 0; j < 4; ++j) SA_STEP(kk[j][0], kk[j][1], vv[j][0], vv[j][1]);
    }
    for (; n < NK; ++n) { const float* kp = kbase + kfirst + (long)n * kstep; const f32x4 k0 = *(const f32x4*)kp, k1 = *(const f32x4*)(kp + 4), v0 = *(const f32x4*)(kp + 512), v1 = *(const f32x4*)(kp + 516); SA_STEP(k0, k1, v0, v1); }
#undef SA_STEP
    const float inv = 1.0f / ls;
    v4u w; w.x = cvt_pk_bf16(o[0] * inv, o[1] * inv); w.y = cvt_pk_bf16(o[2] * inv, o[3] * inv); w.z = cvt_pk_bf16(o[4] * inv, o[5] * inv); w.w = cvt_pk_bf16(o[6] * inv, o[7] * inv);
    if (src < 3) { *(v4u*)((bf16*)(ws + WS_OG) + (size_t)row * 1536 + src * 512 + h * 128 + 8 * sub) = w; if (sub == 0) ((float*)(ws + WS_LSE))[(size_t)row * 12 + src * 4 + h] = (mx + fast_log2(ls)) * LN2; }
    else *(v4u*)((bf16*)(ws + WS_OALL) + (size_t)row * 1536 + 1024 + h * 128 + 8 * sub) = w;
}
__device__ __forceinline__ void p4_sample_attn_shared(const Frame& F, int db, int h, const bool is_mem, const float* cache) {
    unsigned char* ws = F.ws; const int lane = F.lane, sub = lane & 15, gk = lane >> 4; const int rowq0 = MP + db * 4;
    float qv[4][8];
#pragma unroll
    for (int t = 0; t < 4; ++t) { const bf16* qp = is_mem ? (const bf16*)(ws + WS_MQ) + (size_t)(rowq0 + t) * 512 + h * 128 + 8 * sub : (const bf16*)(ws + WS_QS) + (size_t)(rowq0 + t) * 1536 + h * 128 + 8 * sub;
        const v4u qw = *(const v4u*)qp; qv[t][0] = bflo(qw.x); qv[t][1] = bfhi(qw.x); qv[t][2] = bflo(qw.y); qv[t][3] = bfhi(qw.y); qv[t][4] = bflo(qw.z); qv[t][5] = bfhi(qw.z); qv[t][6] = bflo(qw.w); qv[t][7] = bfhi(qw.w); }
    float m[4], l[4], o[4][8];
#pragma unroll
    for (int t = 0; t < 4; ++t) { m[t] = -3.0e38f; l[t] = 0.f;
#pragma unroll
        for (int j = 0; j < 8; ++j) o[t][j] = 0.f; }
#define SS_STEP(P, K0, K1, V0, V1) do { _Pragma("unroll") for (int t = 0; t < 4; ++t) { \
        float s_ = (qv[t][0] * K0.x + qv[t][1] * K0.y) + (qv[t][2] * K0.z + qv[t][3] * K0.w) + (qv[t][4] * K1.x + qv[t][5] * K1.y) + (qv[t][6] * K1.z + qv[t][7] * K1.w); \
        s_ += __shfl_xor(s_, 1); s_ += __shfl_xor(s_, 2); s_ += __shfl_xor(s_, 4); s_ += __shfl_xor(s_, 8); \
        const bool ok_ = is_mem || ((P) >= t && (P) <= 128 + t); \
        const float mn_ = ok_ ? fmaxf(m[t], s_) : m[t], sc_ = fast_exp2(m[t] - mn_), p_ = ok_ ? fast_exp2(s_ - mn_) : 0.f; m[t] = mn_; l[t] = l[t] * sc_ + p_; \
        o[t][0] = o[t][0] * sc_ + p_ * V0.x; o[t][1] = o[t][1] * sc_ + p_ * V0.y; o[t][2] = o[t][2] * sc_ + p_ * V0.z; o[t][3] = o[t][3] * sc_ + p_ * V0.w; \
        o[t][4] = o[t][4] * sc_ + p_ * V1.x; o[t][5] = o[t][5] * sc_ + p_ * V1.y; o[t][6] = o[t][6] * sc_ + p_ * V1.z; o[t][7] = o[t][7] * sc_ + p_ * V1.w; } } while (0)
    const int L = is_mem ? 256 : 128;
    const float* kbase = cache + ((size_t)db * L * 2) * 512 + h * 128 + 8 * sub + (size_t)gk * 1024;
    for (int j = 0; j < L / 4; j += 4) {
        f32x4 kk[4][2], vv[4][2];
#pragma unroll
        for (int e = 0; e < 4; ++e) { const float* kp = kbase + (size_t)(j + e) * 4096; kk[e][0] = *(const f32x4*)kp; kk[e][1] = *(const f32x4*)(kp + 4); vv[e][0] = *(const f32x4*)(kp + 512); vv[e][1] = *(const f32x4*)(kp + 516); }
#pragma unroll
        for (int e = 0; e < 4; ++e) SS_STEP(4 * (j + e) + gk, kk[e][0], kk[e][1], vv[e][0], vv[e][1]);
    }
    if (!is_mem) {
        const size_t ro = (size_t)(rowq0 + gk) * 1536 + h * 128 + 8 * sub;
        const v4u kw = *(const v4u*)((const bf16*)(ws + WS_KS) + ro), vw = *(const v4u*)((const bf16*)(ws + WS_VS) + ro);
        const f32x4 k0 = {bflo(kw.x), bfhi(kw.x), bflo(kw.y), bfhi(kw.y)}, k1 = {bflo(kw.z), bfhi(kw.z), bflo(kw.w), bfhi(kw.w)};
        const f32x4 v0 = {bflo(vw.x), bfhi(vw.x), bflo(vw.y), bfhi(vw.y)}, v1 = {bflo(vw.z), bfhi(vw.z), bflo(vw.w), bfhi(vw.w)};
        SS_STEP(128 + gk, k0, k1, v0, v1);
    }
#undef SS_STEP
    float mo = 0.f, lo = 1.f, oo[8];
#pragma unroll
    for (int j = 0; j < 8; ++j) oo[j] = 0.f;
#pragma unroll
    for (int t = 0; t < 4; ++t) {
        float mm = fmaxf(m[t], __shfl_xor(m[t], 16)); mm = fmaxf(mm, __shfl_xor(mm, 32));
        const float f = fast_exp2(m[t] - mm); float lt = l[t] * f; lt += __shfl_xor(lt, 16); lt += __shfl_xor(lt, 32);
        if (gk == t) { mo = mm; lo = lt; }
#pragma unroll
        for (int j = 0; j < 8; ++j) { float x = o[t][j] * f; x += __shfl_xor(x, 16); x += __shfl_xor(x, 32); if (gk == t) oo[j] = x; }
    }
    const float inv = 1.0f / lo; const int row = rowq0 + gk;
    v4u w; w.x = cvt_pk_bf16(oo[0] * inv, oo[1] * inv); w.y = cvt_pk_bf16(oo[2] * inv, oo[3] * inv); w.z = cvt_pk_bf16(oo[4] * inv, oo[5] * inv); w.w = cvt_pk_bf16(oo[6] * inv, oo[7] * inv);
    if (is_mem) *(v4u*)((bf16*)(ws + WS_OALL) + (size_t)row * 1536 + 1024 + h * 128 + 8 * sub) = w;
    else { *(v4u*)((bf16*)(ws + WS_OG) + (size_t)row * 1536 + h * 128 + 8 * sub) = w; if (sub == 0) ((float*)(ws + WS_LSE))[(size_t)row * 12 + h] = (mo + fast_log2(lo)) * LN2; }
}
__device__ __forceinline__ void p4_sample_task(const Frame& F, int it, const float* c0, const float* c1, const float* c2, const float* cm) {
    const int kind = it >> 9, idx = it & 511, db = idx >> 2, h = idx & 3;
    if (kind == 0) p4_sample_attn(F, db * 16 + h * 4 + 2, c0, c1, c2, cm);
    else if (kind == 1) p4_sample_attn(F, db * 16 + h * 4 + 1, c0, c1, c2, cm);
    else if (kind == 2) p4_sample_attn_shared(F, db, h, true, cm);
    else p4_sample_attn_shared(F, db, h, false, c0);
}
__device__ __forceinline__ void p4_sample_loop(const Frame& F, const float* c0, const float* c1, const float* c2, const float* cm, int q = 0) {
    gu32* qw = (gu32*)(F.ws + WS_CTL) + 64 + 64 * q;
    for (;;) { unsigned v = 0; if (F.lane == 0) v = __hip_atomic_fetch_add(qw, 1u, RLX_AGENT); const int it = (int)__builtin_amdgcn_readfirstlane(v);
        if (it >= 2048) break; p4_sample_task(F, it, c0, c1, c2, cm); }
}
__device__ __forceinline__ void p4_gla_chain(const Frame& F, int row0, int T, int h, const float* S0, float* Sout) {
    unsigned char* ws = F.ws; const int tid = F.tid, v = tid & 127, ks = __builtin_amdgcn_readfirstlane(tid >> 7);
    const float* GA = (const float*)(ws + WS_GA); const bf16* GQ = (const bf16*)(ws + WS_GQ); const bf16* GK = (const bf16*)(ws + WS_GK); const bf16* GV = (const bf16*)(ws + WS_GV); bf16* GO = (bf16*)(ws + WS_GO);
    LAS float* part = (LAS float*)(F.lds + RING_OFF);
    float S[16];
#pragma unroll
    for (int i = 0; i < 16; ++i) S[i] = S0 ? S0[(size_t)(16 * ks + i) * 128 + v] : 0.f;
    for (int t0 = 0; t0 < T; t0 += 16) {
        const int nb = (T - t0) < 16 ? (T - t0) : 16;
        __syncthreads();
        for (int tt = 0; tt < nb; ++tt) {
            const size_t row = (size_t)(row0 + t0 + tt);
            const float* ap = GA + row * 256 + h * 64 + 16 * ks; const v4u kw0 = *(const v4u*)(GK + row * 256 + h * 64 + 16 * ks), kw1 = *(const v4u*)(GK + row * 256 + h * 64 + 16 * ks + 8);
            const v4u qw0 = *(const v4u*)(GQ + row * 256 + h * 64 + 16 * ks), qw1 = *(const v4u*)(GQ + row * 256 + h * 64 + 16 * ks + 8);
            const float vv = bf2f(GV[row * 512 + h * 128 + v]);
            const f32x4 a0 = *(const f32x4*)ap, a1 = *(const f32x4*)(ap + 4), a2 = *(const f32x4*)(ap + 8), a3 = *(const f32x4*)(ap + 12);
            const float la[16] = {a0.x, a0.y, a0.z, a0.w, a1.x, a1.y, a1.z, a1.w, a2.x, a2.y, a2.z, a2.w, a3.x, a3.y, a3.z, a3.w};
            const float kk[16] = {bflo(kw0.x), bfhi(kw0.x), bflo(kw0.y), bfhi(kw0.y), bflo(kw0.z), bfhi(kw0.z), bflo(kw0.w), bfhi(kw0.w), bflo(kw1.x), bfhi(kw1.x), bflo(kw1.y), bfhi(kw1.y), bflo(kw1.z), bfhi(kw1.z), bflo(kw1.w), bfhi(kw1.w)};
            const float qq[16] = {bflo(qw0.x), bfhi(qw0.x), bflo(qw0.y), bfhi(qw0.y), bflo(qw0.z), bfhi(qw0.z), bflo(qw0.w), bfhi(qw0.w), bflo(qw1.x), bfhi(qw1.x), bflo(qw1.y), bfhi(qw1.y), bflo(qw1.z), bfhi(qw1.z), bflo(qw1.w), bfhi(qw1.w)};
            float o = 0.f;
#pragma unroll
            for (int i = 0; i < 16; ++i) { S[i] = fast_exp2(la[i] * 1.4426950408889634f) * S[i] + kk[i] * vv; o += qq[i] * S[i]; }
            part[(tt * 4 + ks) * 128 + v] = o;
        }
        __syncthreads();
        for (int e = tid; e < nb * 128; e += 512) { const int tt = e >> 7, vv_ = e & 127;
            GO[(size_t)(row0 + t0 + tt) * 512 + h * 128 + vv_] = (bf16)f2bf((part[(tt * 4 + 0) * 128 + vv_] + part[(tt * 4 + 1) * 128 + vv_]) + (part[(tt * 4 + 2) * 128 + vv_] + part[(tt * 4 + 3) * 128 + vv_])); }
    }
#pragma unroll
    for (int i = 0; i < 16; ++i) Sout[(size_t)(16 * ks + i) * 128 + v] = S[i];
}
constexpr int GL_QE = 0, GL_KE = 8192, GL_KDT = 16384, GL_VV = 24576, GL_EB = 40960, GL_TOT = 41216, GL_SET = 43264;
__device__ __forceinline__ int goff(int r, int c) { return 128 * r + 16 * (c ^ ((r >> 1) & 7)); }
__device__ __forceinline__ int gvoff(int row, int ch) { return 256 * row + 16 * (ch ^ (((row & 3) | ((((row >> 2) ^ (row >> 3)) & 1) << 2)) << 1)); }
__device__ __forceinline__ void p4_gla_chain_mfma(const Frame& F, int c) {
    unsigned char* ws = F.ws; const int tid = F.tid, lane = F.lane, w = F.wave, l15 = lane & 15, g4 = lane >> 4, q4 = l15 >> 2, p4 = lane & 3;
    const int b = c >> 2, h = c & 3; const size_t row0 = (size_t)b * SEQ;
    const float* GA = (const float*)(ws + WS_GA) + h * 64 + lane; const bf16* GQ = (const bf16*)(ws + WS_GQ) + h * 64 + lane; const bf16* GK = (const bf16*)(ws + WS_GK) + h * 64 + lane;
    const bf16* GV = (const bf16*)(ws + WS_GV) + h * 128 + (tid & 15) * 8; bf16* GO = (bf16*)(ws + WS_GO) + h * 128 + 16 * w + 4 * g4;
    constexpr float L2E = 1.4426950408889634f;
    f32x4 S[4];
#pragma unroll
    for (int K = 0; K < 4; ++K) S[K] = (f32x4){0.f, 0.f, 0.f, 0.f};
    float la[8]; unsigned short qh[8], kh[8]; v4u vr[2];
#define GLA_LOAD(ch) do { const size_t r_ = row0 + 64 * (size_t)(ch); \
        _Pragma("unroll") for (int t = 0; t < 8; ++t) { const size_t rr_ = (r_ + 8 * w + t) * 256; la[t] = GA[rr_]; qh[t] = GQ[rr_]; kh[t] = GK[rr_]; } \
        _Pragma("unroll") for (int e = 0; e < 2; ++e) vr[e] = *(const v4u*)(GV + (r_ + (tid >> 4) + 32 * e) * 512); } while (0)
    GLA_LOAD(0);
#pragma unroll 1
    for (int ch = 0; ch < SEQ / 64; ++ch) {
        LAS unsigned char* B = F.lds + RING_OFF + (ch & 1) * GL_SET;
        LAS float* TOT = (LAS float*)(B + GL_TOT); LAS float* EB = (LAS float*)(B + GL_EB);
        float cs[8], qv[8], kvv[8];
        cs[0] = la[0];
#pragma unroll
        for (int t = 1; t < 8; ++t) cs[t] = cs[t - 1] + la[t];
#pragma unroll
        for (int t = 0; t < 8; ++t) { qv[t] = bf2f(qh[t]); kvv[t] = bf2f(kh[t]); }
        TOT[w * 64 + lane] = cs[7];
#pragma unroll
        for (int e = 0; e < 2; ++e) *(LAS v4u*)(B + GL_VV + gvoff((tid >> 4) + 32 * e, tid & 15)) = vr[e];
        __syncthreads();
        float offs = 0.f, total = 0.f;
#pragma unroll
        for (int g = 0; g < 8; ++g) { const float tg = TOT[g * 64 + lane]; total += tg; offs += (g < w) ? tg : 0.f; }
        unsigned kd[8];
#pragma unroll
        for (int t = 0; t < 8; ++t) { const float bt = offs + cs[t]; const int i = 8 * w + t;
            const float e1 = fast_exp2(bt * L2E), e2 = fast_exp2(-bt * L2E), e3 = fast_exp2((total - bt) * L2E);
            *(LAS unsigned short*)(B + GL_QE + goff(i, lane >> 3) + 2 * (lane & 7)) = (unsigned short)f2bf(qv[t] * e1);
            *(LAS unsigned short*)(B + GL_KE + goff(i, lane >> 3) + 2 * (lane & 7)) = (unsigned short)f2bf(kvv[t] * e2);
            kd[t] = f2bf(kvv[t] * e3); }
        { v4u kw; kw.x = kd[0] | (kd[1] << 16); kw.y = kd[2] | (kd[3] << 16); kw.z = kd[4] | (kd[5] << 16); kw.w = kd[6] | (kd[7] << 16); *(LAS v4u*)(B + GL_KDT + goff(lane, w)) = kw; }
        if (w == 0) EB[lane] = fast_exp2(total * L2E);
        if (ch + 1 < SEQ / 64) GLA_LOAD(ch + 1);
        __syncthreads();
        const LAS unsigned char* QE = B + GL_QE; const LAS unsigned char* KE = B + GL_KE; const LAS unsigned char* KDT = B + GL_KDT; const LAS unsigned char* VV = B + GL_VV;
        bf16x8 kef[4][2];
#pragma unroll
        for (int J = 0; J < 4; ++J)
#pragma unroll
            for (int s = 0; s < 2; ++s) kef[J][s] = *(const LAS bf16x8*)(KE + goff(16 * J + l15, 4 * s + g4));
        bf16x8 vpr[2], vnat[2];
#pragma unroll
        for (int pp = 0; pp < 2; ++pp) { const int ra = 32 * pp + 4 * g4 + q4, rb = ra + 16;
            const s16x4 t1 = vtr(VV + gvoff(ra, 2 * w + (p4 >> 1)) + 8 * (p4 & 1)), t2 = vtr(VV + gvoff(rb, 2 * w + (p4 >> 1)) + 8 * (p4 & 1));
            vpr[pp] = (bf16x8){t1[0], t1[1], t1[2], t1[3], t2[0], t2[1], t2[2], t2[3]}; }
#pragma unroll
        for (int s = 0; s < 2; ++s) { const int r1 = 32 * s + 8 * g4 + q4, r2 = r1 + 4;
            const s16x4 t1 = vtr(VV + gvoff(r1, 2 * w + (p4 >> 1)) + 8 * (p4 & 1)), t2 = vtr(VV + gvoff(r2, 2 * w + (p4 >> 1)) + 8 * (p4 & 1));
            vnat[s] = (bf16x8){t1[0], t1[1], t1[2], t1[3], t2[0], t2[1], t2[2], t2[3]}; }
        bf16x8 sfr[2];
#pragma unroll
        for (int p = 0; p < 2; ++p) { v4u sw; sw.x = cvt_pk_bf16(S[2 * p].x, S[2 * p].y); sw.y = cvt_pk_bf16(S[2 * p].z, S[2 * p].w); sw.z = cvt_pk_bf16(S[2 * p + 1].x, S[2 * p + 1].y); sw.w = cvt_pk_bf16(S[2 * p + 1].z, S[2 * p + 1].w); sfr[p] = __builtin_bit_cast(bf16x8, sw); }
#pragma unroll
        for (int I = 0; I < 4; ++I) {
            f32x4 oT = (f32x4){0.f, 0.f, 0.f, 0.f};
#pragma unroll
            for (int p = 0; p < 2; ++p) {
                const v2u lo = *(const LAS v2u*)(QE + goff(16 * I + l15, 4 * p + (g4 >> 1)) + 8 * (g4 & 1)), hi = *(const LAS v2u*)(QE + goff(16 * I + l15, 4 * p + 2 + (g4 >> 1)) + 8 * (g4 & 1));
                const v4u bw = {lo.x, lo.y, hi.x, hi.y};
                oT = __builtin_amdgcn_mfma_f32_16x16x32_bf16(sfr[p], __builtin_bit_cast(bf16x8, bw), oT, 0, 0, 0); }
            bf16x8 qef[2];
#pragma unroll
            for (int s = 0; s < 2; ++s) qef[s] = *(const LAS bf16x8*)(QE + goff(16 * I + l15, 4 * s + g4));
            f32x4 d1[4];
#pragma unroll
            for (int J = 0; J < 4; ++J) { d1[J] = (f32x4){0.f, 0.f, 0.f, 0.f};
                if (J <= I) {
#pragma unroll
                    for (int s = 0; s < 2; ++s) d1[J] = __builtin_amdgcn_mfma_f32_16x16x32_bf16(kef[J][s], qef[s], d1[J], 0, 0, 0);
                    if (J == I) {
#pragma unroll
                        for (int r = 0; r < 4; ++r) d1[J][r] = (4 * g4 + r <= l15) ? d1[J][r] : 0.f; } } }
#pragma unroll
            for (int pp = 0; pp < 2; ++pp) if (2 * pp <= I) {
                const f32x4 pa = d1[2 * pp], pb = d1[2 * pp + 1];
                v4u pw; pw.x = cvt_pk_bf16(pa.x, pa.y); pw.y = cvt_pk_bf16(pa.z, pa.w); pw.z = cvt_pk_bf16(pb.x, pb.y); pw.w = cvt_pk_bf16(pb.z, pb.w);
                oT = __builtin_amdgcn_mfma_f32_16x16x32_bf16(vpr[pp], __builtin_bit_cast(bf16x8, pw), oT, 0, 0, 0); }
            { v2u ow; ow.x = cvt_pk_bf16(oT.x, oT.y); ow.y = cvt_pk_bf16(oT.z, oT.w); *(v2u*)(GO + (row0 + 64 * (size_t)ch + 16 * I + l15) * 512) = ow; }
        }
#pragma unroll
        for (int K = 0; K < 4; ++K) {
            const f32x4 ebv = *(const LAS f32x4*)(EB + 16 * K + 4 * g4); S[K] *= ebv;
#pragma unroll
            for (int s = 0; s < 2; ++s) { const bf16x8 kdf = *(const LAS bf16x8*)(KDT + goff(16 * K + l15, 4 * s + g4)); S[K] = __builtin_amdgcn_mfma_f32_16x16x32_bf16(kdf, vnat[s], S[K], 0, 0, 0); } }
    }
#undef GLA_LOAD
    float* so = F.out + O_GLAP + (size_t)c * 64 * 128 + 16 * w + l15;
#pragma unroll
    for (int K = 0; K < 4; ++K)
#pragma unroll
        for (int r = 0; r < 4; ++r) so[(size_t)(16 * K + 4 * g4 + r) * 128] = S[K][r];
}
template <int NR> __device__ __forceinline__ void p5_combine_rows(const Frame& F, int row0, int rstride) {
    unsigned char* ws = F.ws; const int lane = F.lane, hh = lane >> 4, sub = lane & 15, col = hh * 128 + 8 * sub;
    float l0[NR], l1[NR], l2[NR]; v4u a[NR], b[NR], c[NR], gow[NR], gr[NR];
    const float* gg = F.i15 + 8 * sub; const f32x4 g0 = *(const f32x4*)gg, g1 = *(const f32x4*)(gg + 4);
#pragma unroll
    for (int r = 0; r < NR; ++r) { const int row = row0 + r * rstride;
        const float* lse = (const float*)(ws + WS_LSE) + (size_t)row * 12; l0[r] = lse[hh]; l1[r] = lse[4 + hh]; l2[r] = lse[8 + hh];
        const bf16* og = (const bf16*)(ws + WS_OG) + (size_t)row * 1536 + col; a[r] = *(const v4u*)og; b[r] = *(const v4u*)(og + 512); c[r] = *(const v4u*)(og + 1024);
        gow[r] = *(const v4u*)((const bf16*)(ws + WS_GO) + (size_t)row * 512 + col); gr[r] = *(const v4u*)((const bf16*)(ws + WS_GRS) + (size_t)row * 512 + col); }
#pragma unroll
    for (int r = 0; r < NR; ++r) { const int row = row0 + r * rstride;
        const float mx = fmaxf(l0[r], fmaxf(l1[r], l2[r]));
        float w0 = __expf(l0[r] - mx), w1 = __expf(l1[r] - mx), w2 = __expf(l2[r] - mx); const float wi = 1.0f / (w0 + w1 + w2); w0 *= wi; w1 *= wi; w2 *= wi;
        v4u o;
        o.x = cvt_pk_bf16(w0 * bflo(a[r].x) + w1 * bflo(b[r].x) + w2 * bflo(c[r].x), w0 * bfhi(a[r].x) + w1 * bfhi(b[r].x) + w2 * bfhi(c[r].x));
        o.y = cvt_pk_bf16(w0 * bflo(a[r].y) + w1 * bflo(b[r].y) + w2 * bflo(c[r].y), w0 * bfhi(a[r].y) + w1 * bfhi(b[r].y) + w2 * bfhi(c[r].y));
        o.z = cvt_pk_bf16(w0 * bflo(a[r].z) + w1 * bflo(b[r].z) + w2 * bflo(c[r].z), w0 * bfhi(a[r].z) + w1 * bfhi(b[r].z) + w2 * bfhi(c[r].z));
        o.w = cvt_pk_bf16(w0 * bflo(a[r].w) + w1 * bflo(b[r].w) + w2 * bflo(c[r].w), w0 * bfhi(a[r].w) + w1 * bfhi(b[r].w) + w2 * bfhi(c[r].w));
        bf16* oall = (bf16*)(ws + WS_OALL) + (size_t)row * 1536;
        *(v4u*)(oall + col) = o;
        const f32x4 x0 = {bflo(gow[r].x), bfhi(gow[r].x), bflo(gow[r].y), bfhi(gow[r].y)}, x1 = {bflo(gow[r].z), bfhi(gow[r].z), bflo(gow[r].w), bfhi(gow[r].w)};
        float ss = (x0.x * x0.x + x0.y * x0.y) + (x0.z * x0.z + x0.w * x0.w) + (x1.x * x1.x + x1.y * x1.y) + (x1.z * x1.z + x1.w * x1.w);
        ss += __shfl_xor(ss, 1); ss += __shfl_xor(ss, 2); ss += __shfl_xor(ss, 4); ss += __shfl_xor(ss, 8);
        const float rstd = 1.0f / sqrtf(ss * (1.f / 128.f) + EPS);
        v4u y;
        y.x = cvt_pk_bf16(x0.x * rstd * g0.x * bflo(gr[r].x), x0.y * rstd * g0.y * bfhi(gr[r].x)); y.y = cvt_pk_bf16(x0.z * rstd * g0.z * bflo(gr[r].y), x0.w * rstd * g0.w * bfhi(gr[r].y));
        y.z = cvt_pk_bf16(x1.x * rstd * g1.x * bflo(gr[r].z), x1.y * rstd * g1.y * bfhi(gr[r].z)); y.w = cvt_pk_bf16(x1.z * rstd * g1.z * bflo(gr[r].w), x1.w * rstd * g1.w * bfhi(gr[r].w));
        *(v4u*)(oall + 512 + col) = y; }
}
template <int NR> __device__ __forceinline__ void p10_final_rows(const Frame& F, int row0, int rstride) {
    const GAS f32x4* gr = (const GAS f32x4*)F.i24 + 2 * F.lane; const f32x4 g00 = gr[0], g01 = gr[1], g10 = gr[128], g11 = gr[129];
    v4u v[NR][2];
#pragma unroll
    for (int r = 0; r < NR; ++r) { const GAS v4u* xr = (const GAS v4u*)((const bf16*)(F.ws + WS_Y16) + (size_t)(row0 + r * rstride) * D) + F.lane; v[r][0] = xr[0]; v[r][1] = xr[64]; }
#pragma unroll
    for (int r = 0; r < NR; ++r) { float x[2][8]; float s = 0.f;
#pragma unroll
        for (int j = 0; j < 2; ++j) { x[j][0] = bflo(v[r][j].x); x[j][1] = bfhi(v[r][j].x); x[j][2] = bflo(v[r][j].y); x[j][3] = bfhi(v[r][j].y); x[j][4] = bflo(v[r][j].z); x[j][5] = bfhi(v[r][j].z); x[j][6] = bflo(v[r][j].w); x[j][7] = bfhi(v[r][j].w);
#pragma unroll
            for (int e = 0; e < 8; ++e) s += x[j][e] * x[j][e]; }
        const float rstd = 1.0f / sqrtf(wave_sum(s) * (1.f / D) + EPS);
        GAS f32x4* yr = (GAS f32x4*)(F.out + (size_t)(row0 + r * rstride) * D) + 2 * F.lane;
        yr[0] = (f32x4){x[0][0] * rstd * g00.x, x[0][1] * rstd * g00.y, x[0][2] * rstd * g00.z, x[0][3] * rstd * g00.w};
        yr[1] = (f32x4){x[0][4] * rstd * g01.x, x[0][5] * rstd * g01.y, x[0][6] * rstd * g01.z, x[0][7] * rstd * g01.w};
        yr[128] = (f32x4){x[1][0] * rstd * g10.x, x[1][1] * rstd * g10.y, x[1][2] * rstd * g10.z, x[1][3] * rstd * g10.w};
        yr[129] = (f32x4){x[1][4] * rstd * g11.x, x[1][5] * rstd * g11.y, x[1][6] * rstd * g11.z, x[1][7] * rstd * g11.w}; }
}
__device__ __forceinline__ void phase1(Frame& F) {
    unsigned char* ws = F.ws; const int G = F.G, bx = (int)blockIdx.x;
    { pg8::Gemm g{(const bf16*)(ws + WS_XB), (const bf16*)(ws + WS_W1A), MR, 2 * FF, D, D, D}; typedef pg8::StaticOrderT<MR / 256, 2 * FF / 256> SO; SO S; S.init(MR, 2 * FF, G, bx);
      EpiSwiglu E{(bf16*)(ws + WS_G), nullptr}; pg8::gemm_phase<EpiSwiglu, SO>(F.lds + RING_OFF, g, S, E, F.wave, MK_STAGGER_A); }
    { pg8::Gemm g{(const bf16*)(ws + WS_MEMB), (const bf16*)(ws + WS_WMEM), MM, D, D, D, D}; typedef pg8::StaticOrderT<MM / 256, D / 256> SO; SO S; S.init(MM, D, G, (bx + G / 2) % G);
      EpiMemKV E{F.out + O_MEMKV, (bf16*)(ws + WS_MKV)}; pg8::gemm_phase<EpiMemKV, SO>(F.lds + RING_OFF, g, S, E, F.wave); }
}
__device__ __forceinline__ void phase2(Frame& F) {
    unsigned char* ws = F.ws; const int G = F.G, bx = (int)blockIdx.x;
    pg8::Gemm g{(const bf16*)(ws + WS_G), (const bf16*)(ws + WS_W1O), MR, D, FF, 64, FF};   typedef pg8::StaticOrderT<MR / 256, D / 256> SO; SO S; S.init(MR, D, G, bx);
    EpiResidX<true> E{F.i0, F.i1, (bf16*)(ws + WS_HB), (float*)(ws + WS_PQ1), 0.5f};
    S.lim = 1024; S.rev = 1; pg8::gemm_phase<EpiResidX<true>, SO, true, true>(F.lds + RING_OFF, g, S, E, F.wave);
    tail_phase<EpiResidX<true>, true>(F, g.A, 64, g.Bt, FF, FF, E, 0);
}
__device__ __forceinline__ void phase3(Frame& F) {
    unsigned char* ws = F.ws; const int G = F.G, bx = (int)blockIdx.x;
    pg8::Gemm g{(const bf16*)(ws + WS_HB), (const bf16*)(ws + WS_WIN), MR, NZ, D, D, D}; typedef pg8::StaticOrderT<MR / 256, NZ / 256> SO; SO S; S.init(MR, NZ, G, bx);
    EpiZ E{(const float*)(ws + WS_PQ1), (const float*)(ws + WS_ROPE), (const float*)(ws + WS_ROPE) + NPOS * 64, F.i14, F.out,
           (bf16*)(ws + WS_QS), (bf16*)(ws + WS_KS), (bf16*)(ws + WS_VS), (bf16*)(ws + WS_GQ), (bf16*)(ws + WS_GK), (bf16*)(ws + WS_GV), (bf16*)(ws + WS_GRS), (bf16*)(ws + WS_MQ), (bf16*)(ws + WS_GATE), (float*)(ws + WS_GA)};
    pg8::gemm_phase<EpiZ, SO>(F.lds + RING_OFF, g, S, E, F.wave, MK_STAGGER_Z);
}
constexpr int CW_Q = 64;
__device__ __forceinline__ int q_pull(const Frame& F, int q) {
    gu32* qw = (gu32*)(F.ws + WS_CTL) + CW_Q + 64 * q;
    volatile LAS unsigned* slot = (volatile LAS unsigned*)(F.lds + MISC_OFF) + 16;
    __syncthreads();
    if (F.tid == 0) *slot = __hip_atomic_fetch_add(qw, 1u, RLX_AGENT);
    __syncthreads();
    return (int)*slot;
}
__device__ __forceinline__ void phase4(Frame& F, const float* c0, const float* c1, const float* c2, const float* cm) {
    const int bx = (int)blockIdx.x;
    if (bx < NB * 4) p4_gla_chain_mfma(F, bx);
    else p4_sample_loop(F, c0, c1, c2, cm);
#pragma unroll 1
    for (int rep = 0; rep < (MK_P4_REPEAT == 2 ? 2 : 1); ++rep) for (;;) { const int it = q_pull(F, 1 + 4 * rep); if (it >= 768) break; attn_batch<0, 8>(F, 8 * (767 - it)); }
#pragma unroll 1
    for (int rep = 0; rep < (MK_P4_REPEAT == 3 ? 2 : 1); ++rep) for (;;) { const int it = q_pull(F, 2 + 4 * rep); if (it >= 256) break; attn_batch<1, 8>(F, 6144 + 8 * (255 - it)); }
    p4_sample_loop(F, c0, c1, c2, cm);
    if (MK_P4_REPEAT == 1) { __syncthreads(); p4_sample_loop(F, c0, c1, c2, cm, 4); }
    if (MK_P4_REPEAT == 4) { __syncthreads(); if (bx < NB * 4) p4_gla_chain_mfma(F, bx); }
    if (MK_P4_REPEAT == 5) { for (;;) { const int c = q_pull(F, 7); if (c >= DECB * 4) break; p4_gla_chain(F, MP + (c >> 2) * DECT, DECT, c & 3, F.i7 + (size_t)c * 64 * 128, F.out + O_GLAS + (size_t)c * 64 * 128); } }
    for (;;) { const int c = q_pull(F, 3); if (c >= DECB * 4) break; p4_gla_chain(F, MP + (c >> 2) * DECT, DECT, c & 3, F.i7 + (size_t)c * 64 * 128, F.out + O_GLAS + (size_t)c * 64 * 128); }
    if (F.G < NB * 4) { for (int c = F.G + bx; c < NB * 4; c += F.G) p4_gla_chain_mfma(F, c); }
}
__device__ __forceinline__ void phase5(Frame& F) {
    { const int st = F.G * NWAVES; int m = F.vcu * NWAVES + F.wave;
      for (; m + 3 * st < MR; m += 4 * st) p5_combine_rows<4>(F, m, st);
      for (; m < MR; m += st) p5_combine_rows<1>(F, m, st); }
}
__device__ __forceinline__ void phase6(Frame& F) {
    unsigned char* ws = F.ws; const int G = F.G, bx = (int)blockIdx.x;
    pg8::Gemm g{(const bf16*)(ws + WS_OALL), (const bf16*)(ws + WS_WBR), MR, D, 1536, 1536, 1536}; typedef pg8::StaticOrderT<MR / 256, D / 256> SO; SO S; S.init(MR, D, G, bx);
    S.lim = 1024; S.rev = 1; EpiMerge1 E{(const bf16*)(ws + WS_GATE), (bf16*)(ws + WS_MB)}; pg8::gemm_phase<EpiMerge1, SO>(F.lds + RING_OFF, g, S, E, F.wave);
    tail_phase_merge(F, g.A, g.Bt, E, 3);
}
__device__ __forceinline__ void phase7(Frame& F) {
    unsigned char* ws = F.ws; const int G = F.G, bx = (int)blockIdx.x;
    pg8::Gemm g{(const bf16*)(ws + WS_MB), (const bf16*)(ws + WS_WOUT), MR, D, D, D, D}; typedef pg8::StaticOrderT<MR / 256, D / 256> SO; SO S; S.init(MR, D, G, bx);
    EpiResidB<true> E{(const bf16*)(ws + WS_HB), (bf16*)(ws + WS_HB), (float*)(ws + WS_PQ2), 1.0f};
    S.lim = 1024; pg8::gemm_phase<EpiResidB<true>, SO>(F.lds + RING_OFF, g, S, E, F.wave);
    tail_phase<EpiResidB<true>>(F, g.A, D, g.Bt, D, D, E, 1);
}
__device__ __forceinline__ void phase8(Frame& F) {
    unsigned char* ws = F.ws; const int G = F.G, bx = (int)blockIdx.x;
    pg8::Gemm g{(const bf16*)(ws + WS_HB), (const bf16*)(ws + WS_W2A), MR, 2 * FF, D, D, D}; typedef pg8::StaticOrderT<MR / 256, 2 * FF / 256> SO; SO S; S.init(MR, 2 * FF, G, bx);
    EpiSwiglu E{(bf16*)(ws + WS_G), (const float*)(ws + WS_PQ2)}; pg8::gemm_phase<EpiSwiglu, SO>(F.lds + RING_OFF, g, S, E, F.wave, MK_STAGGER_A);
}
__device__ __forceinline__ void phase9(Frame& F) {
    unsigned char* ws = F.ws; const int G = F.G, bx = (int)blockIdx.x;
    pg8::Gemm g{(const bf16*)(ws + WS_G), (const bf16*)(ws + WS_W2O), MR, D, FF, 64, FF};   typedef pg8::StaticOrderT<MR / 256, D / 256> SO; SO S; S.init(MR, D, G, bx);
    EpiResidB<false> E{(const bf16*)(ws + WS_HB), (bf16*)(ws + WS_Y16), nullptr, 0.5f};
    S.lim = 1024; S.rev = 1; pg8::gemm_phase<EpiResidB<false>, SO, true, true>(F.lds + RING_OFF, g, S, E, F.wave);
    tail_phase<EpiResidB<false>, true>(F, g.A, 64, g.Bt, FF, FF, E, 2);
}
__device__ __forceinline__ void phase10(Frame& F) {
    { const int st = F.G * NWAVES; int m = F.vcu * NWAVES + F.wave;
      for (; m + 3 * st < MR; m += 4 * st) p10_final_rows<4>(F, m, st);
      for (; m < MR; m += st) p10_final_rows<1>(F, m, st); }
}
__device__ __forceinline__ void xcd_barrier_or_skip(const XcdBarrier& b, bool on, int wave) { if (on) xcd_barrier(b, wave); }
constexpr int N_PHASES = 11;
__global__ void __launch_bounds__(NWAVES * 64, 2) mk_fwd(Args args) {
    extern __shared__ __attribute__((aligned(16))) unsigned char lds[];
    Frame F;
    F.lds = (LAS unsigned char*)lds;
    F.wave = __builtin_amdgcn_readfirstlane((int)(threadIdx.x >> 6)); F.lane = lane_id(); F.tid = F.wave * 64 + F.lane;
    F.G = gridDim.x; { const int bx = blockIdx.x; F.vcu = (F.G % 8 == 0) ? (bx % 8) * (F.G / 8) + bx / 8 : bx; }
    F.i0 = args.in[0]; F.i1 = args.in[1]; F.i2 = args.in[2]; F.i3 = args.in[3]; F.i4 = args.in[4]; F.i5 = args.in[5]; F.i6 = args.in[6]; F.i7 = args.in[7]; F.i8 = args.in[8]; F.i9 = args.in[9]; F.i10 = args.in[10]; F.i11 = args.in[11]; F.i12 = args.in[12]; F.i13 = args.in[13]; F.i14 = args.in[14]; F.i15 = args.in[15]; F.i16 = args.in[16]; F.i17 = args.in[17]; F.i18 = args.in[18]; F.i19 = args.in[19]; F.i20 = args.in[20]; F.i21 = args.in[21]; F.i22 = args.in[22]; F.i23 = args.in[23]; F.i24 = args.in[24];
    F.out = args.out; F.ws = args.ws;
    unsigned char* ws = args.ws; gu32* ctl = (gu32*)(ws + WS_CTL);
    volatile LAS unsigned* MISC = (volatile LAS unsigned*)(F.lds + MISC_OFF);
    for (int u = F.tid; u < (LDS_BYTES - LDSCTL_OFF) / 4; u += NWAVES * 64) ((LAS unsigned*)(F.lds + LDSCTL_OFF))[u] = 0u;
    __syncthreads();
    XcdBarrier bar; bar.bar = (unsigned*)(ctl + CW_BAR); bar.x = 0; bar.st = nullptr;
    if (MK_N_LAUNCHES == 1) bar = xcd_barrier_post((unsigned*)(ctl + CW_BAR), MISC + 8, F.wave);
    const int lo = args.ph_lo, hi = args.ph_hi;
#define IN(k) (lo <= (k) && (k) < hi && (k) <= MK_STOP_AFTER)
#define GRID_BAR(k) do { if (IN((k) + 1)) xcd_barrier(bar, F.wave); } while (0)

#define RUN(k, call) do { if (IN(k)) { F.lane = lane_id(); F.tid = F.wave * 64 + F.lane; call; if (MK_REPEAT_PHASE == (k)) { xcd_barrier_or_skip(bar, MK_N_LAUNCHES == 1, F.wave); call; } GRID_BAR(k); } } while (0)
    RUN(0, p0_prologue(F));
    RUN(1, phase1(F));
    RUN(2, phase2(F));
    RUN(3, phase3(F));
    RUN(4, phase4(F, args.in[3], args.in[4], args.in[5], args.in[6]));
    RUN(5, phase5(F));
    RUN(6, phase6(F));
    RUN(7, phase7(F));
    RUN(8, phase8(F));
    RUN(9, phase9(F));
    if (IN(10)) { F.lane = lane_id(); F.tid = F.wave * 64 + F.lane; phase10(F); }
#undef RUN
#if MK_STOP_AFTER < 10
    if (hi == N_PHASES) {
        for (int m = F.vcu * NWAVES + F.wave; m < MR; m += G * NWAVES) {
            for (int c = F.lane; c < D; c += 64) {
                float v;
                if (MK_STOP_AFTER == 0) v = bf2f(((const bf16*)(ws + WS_WIN))[(size_t)(m % NZ) * D + c]);
                else if (MK_STOP_AFTER == 3) { const bf16* gt = (const bf16*)(ws + WS_GATE) + (size_t)m * 3072; v = bf2f(gt[c]) + bf2f(gt[1024 + c]) + bf2f(gt[2048 + c]); }
                else if (MK_STOP_AFTER <= 5) { const bf16* oa = (const bf16*)(ws + WS_OALL) + (size_t)m * 1536; v = bf2f(oa[c]) + bf2f(oa[1024 + (c & 511)]); }
                else if (MK_STOP_AFTER == 6) v = bf2f(((const bf16*)(ws + WS_MB))[(size_t)m * D + c]);
                else if (MK_STOP_AFTER == 7) v = ((const float*)(ws + WS_H))[(size_t)m * D + c];
                else v = bf2f(((const bf16*)(ws + WS_G))[(size_t)m * FF + c]) + bf2f(((const bf16*)(ws + WS_G))[(size_t)m * FF + 1792 + c]);
                F.out[(size_t)m * D + c] = v;
            }
        }
    }
#endif
#undef IN
#undef GRID_BAR
}

extern "C" void kernel_launch(void* const* d_in, const int* in_sizes, int n_in, void* d_out, int out_size, void* d_ws, size_t ws_size, hipStream_t stream) {
    static int grid = 0;
    if (grid == 0) {
        if (n_in != 25 || (size_t)out_size != O_END || ws_size < WS_END2) { fprintf(stderr, "kernel_launch: unexpected shapes: n_in %d out %d ws %zu (need %zu); nothing launched\n", n_in, out_size, ws_size, (size_t)WS_END2); grid = -1; return; }
        int dev = 0, cus = 0, per_cu = 0;
        if (hipGetDevice(&dev) != hipSuccess || hipDeviceGetAttribute(&cus, hipDeviceAttributeMultiprocessorCount, dev) != hipSuccess) { grid = -1; return; }
        if (hipFuncSetAttribute((const void*)mk_fwd, hipFuncAttributeMaxDynamicSharedMemorySize, LDS_BYTES) != hipSuccess) { fprintf(stderr, "kernel_launch: hipFuncSetAttribute failed\n"); grid = -1; return; }
        if (hipOccupancyMaxActiveBlocksPerMultiprocessor(&per_cu, (const void*)mk_fwd, NWAVES * 64, LDS_BYTES) != hipSuccess || per_cu < 1) fprintf(stderr, "kernel_launch: occupancy query reports %d\n", per_cu);
        (void)hipGetLastError();
        grid = cus;
    }
    if (grid < 0) return;
    if (hipMemsetAsync((char*)d_ws + WS_CTL, 0, CTL_ZERO_BYTES, stream) != hipSuccess) return;
    Args a{};
    for (int i = 0; i < 25; ++i) a.in[i] = (const float*)d_in[i];
    a.out = (float*)d_out; a.ws = (unsigned char*)d_ws; a.pad = 0;
    for (int li = 0; li < MK_N_LAUNCHES; ++li) {
        a.ph_lo = (MK_N_LAUNCHES == 1) ? 0 : li; a.ph_hi = (MK_N_LAUNCHES == 1) ? N_PHASES : li + 1; a.li = li;
        hipLaunchKernelGGL(mk_fwd, dim3(grid), dim3(NWAVES * 64), LDS_BYTES, stream, a);
        const hipError_t le = hipPeekAtLastError();
        if (le != hipSuccess) { fprintf(stderr, "kernel_launch: launch %d failed: %s\n", li, hipGetErrorName(le)); break; }
    }
}
```

```cpp
#include <hip/hip_runtime.h>
#include <cstdio>
#include <cstdint>

#ifndef MK_N_LAUNCHES
#define MK_N_LAUNCHES 1
#endif

#ifndef MK_REPEAT_PHASE
#define MK_REPEAT_PHASE -1
#endif
#ifndef MK_P4_REPEAT
#define MK_P4_REPEAT 0
#endif
#ifndef MK_STAGGER_A
#ifndef MK_WGM_N
#define MK_WGM_N 2
#endif
#ifndef MK_WGM_A
#define MK_WGM_A 4
#endif
#ifndef MK_WGM_Z
#define MK_WGM_Z 2
#endif
#define MK_STAGGER_A 0
#endif
#ifndef MK_STAGGER_Z
#define MK_STAGGER_Z 0
#endif
#ifndef MK_STOP_AFTER
#define MK_STOP_AFTER 10
#endif
#define GAS __attribute__((address_space(1)))
#define LAS __attribute__((address_space(3)))
typedef unsigned short bf16;
typedef unsigned v4u __attribute__((ext_vector_type(4)));
typedef unsigned v2u __attribute__((ext_vector_type(2)));
typedef float f32x4 __attribute__((ext_vector_type(4)));
typedef float f32x2 __attribute__((ext_vector_type(2)));
typedef short bf16x8 __attribute__((ext_vector_type(8)));
typedef short s16x4 __attribute__((ext_vector_type(4)));
typedef GAS unsigned gu32;

__device__ __forceinline__ int lane_id() { return (int)__builtin_amdgcn_mbcnt_hi(~0u, __builtin_amdgcn_mbcnt_lo(~0u, 0u)); }
constexpr int D = 1024, NB = 32, SEQ = 2048, DECB = 128, DECT = 4, PAST = 8192, MEML = 256;
constexpr int MP = NB * SEQ;
constexpr int MS = DECB * DECT;
constexpr int MR = MP + MS;
constexpr int MM = NB * MEML;
constexpr int FF = 2816, NZ = 9984;
constexpr int DIN = 6672;
constexpr int NPOS = SEQ + DECT;
constexpr float EPS = 1e-6f;
constexpr float QSCALE = 0.08838834764831845f * 1.4426950408889634f;
constexpr float LN2 = 0.6931471805599453f;

constexpr size_t O_Y = 0, O_YS = (size_t)MP * D, O_SWA0P = O_YS + (size_t)MS * D, O_SWA1P = O_SWA0P + (size_t)NB * 128 * 1024, O_SWA2P = O_SWA1P + (size_t)NB * 512 * 1024,
                 O_MEMKV = O_SWA2P + (size_t)NB * 2048 * 1024, O_GLAP = O_MEMKV + (size_t)MM * 1024, O_SWA0S = O_GLAP + (size_t)NB * 4 * 64 * 128, O_SWA1S = O_SWA0S + (size_t)MS * 1024,
                 O_SWA2S = O_SWA1S + (size_t)MS * 1024, O_GLAS = O_SWA2S + (size_t)MS * 1024, O_END = O_GLAS + (size_t)DECB * 4 * 64 * 128;
static_assert(O_END == 170917888ull, "output size");

constexpr size_t MiB = 1u << 20;
constexpr size_t al(size_t x) { return (x + 2 * MiB - 1) / (2 * MiB) * (2 * MiB); }
constexpr size_t WS_CTL = 0, CTL_ZERO_BYTES = 1 * MiB;
constexpr size_t WS_ROPE = 2 * MiB;
constexpr size_t WS_PQ1 = WS_ROPE + al((size_t)NPOS * 64 * 4 * 2);
constexpr size_t WS_PQ2 = WS_PQ1 + al((size_t)MR * 16 * 4);
constexpr size_t WS_W1A = WS_PQ2 + al((size_t)MR * 16 * 4);
constexpr size_t WS_W1O = WS_W1A + al((size_t)2 * FF * D * 2);
constexpr size_t WS_WIN = WS_W1O + al((size_t)D * FF * 2);
constexpr size_t WS_WBR = WS_WIN + al((size_t)NZ * D * 2);
constexpr size_t WS_WOUT = WS_WBR + al((size_t)3 * D * 512 * 2);
constexpr size_t WS_W2A = WS_WOUT + al((size_t)D * D * 2);
constexpr size_t WS_W2O = WS_W2A + al((size_t)2 * FF * D * 2);
constexpr size_t WS_WMEM = WS_W2O + al((size_t)D * FF * 2);
constexpr size_t WS_XB = WS_WMEM + al((size_t)D * D * 2);
constexpr size_t WS_MEMB = WS_XB + al((size_t)MR * D * 2);
constexpr size_t WS_MKV = WS_MEMB + al((size_t)MM * D * 2);
constexpr size_t WS_G = WS_MKV + al((size_t)MM * D * 2);
constexpr size_t WS_H = WS_G + al((size_t)MR * FF * 2);
constexpr size_t WS_HB = WS_H + al((size_t)MR * D * 4);
constexpr size_t WS_QS = WS_HB + al((size_t)MR * D * 2);
constexpr size_t WS_KS = WS_QS + al((size_t)MR * 1536 * 2);
constexpr size_t WS_VS = WS_KS + al((size_t)MR * 1536 * 2);
constexpr size_t WS_GQ = WS_VS + al((size_t)MR * 1536 * 2);
constexpr size_t WS_GK = WS_GQ + al((size_t)MR * 256 * 2);
constexpr size_t WS_GV = WS_GK + al((size_t)MR * 256 * 2);
constexpr size_t WS_GRS = WS_GV + al((size_t)MR * 512 * 2);
constexpr size_t WS_GA = WS_GRS + al((size_t)MR * 512 * 2);
constexpr size_t WS_MQ = WS_GA + al((size_t)MR * 256 * 4);
constexpr size_t WS_GATE = WS_MQ + al((size_t)MR * 512 * 2);
constexpr size_t WS_OG = WS_GATE + al((size_t)MR * 3072 * 2);
constexpr size_t WS_LSE = WS_OG + al((size_t)MR * 1536 * 2);
constexpr size_t WS_GO = WS_LSE + al((size_t)MR * 12 * 4);
constexpr size_t WS_OALL = WS_GO + al((size_t)MR * 512 * 4);
constexpr size_t WS_END = WS_OALL + al((size_t)MR * 1536 * 2);
constexpr size_t WS_SLAB = WS_END; constexpr size_t WS_END2 = WS_SLAB + al((size_t)8 * 4 * 4 * 8 * 2048 * 4);
constexpr size_t WS_T = WS_G, WS_MB = WS_XB, WS_Y16 = WS_XB;
static_assert((size_t)MR * D * 4 <= (size_t)MR * FF * 2, "T fits in G");

constexpr int CW_TMO = 0, CW_CODE = 1, CW_BAR = 4096, CW_TAIL = 8192;

constexpr int RING_OFF = 0, RING_BYTES = 131072;
constexpr int LDSCTL_OFF = RING_BYTES, MISC_OFF = LDSCTL_OFF + 320;
constexpr int LDS_BYTES = 147456;
constexpr int NWAVES = 8;

#define RLX_AGENT __ATOMIC_RELAXED, __HIP_MEMORY_SCOPE_AGENT
#define LDS_WAIT() asm volatile("s_waitcnt lgkmcnt(0)" ::: "memory")
#define VM_WAIT() asm volatile("s_waitcnt vmcnt(0)" ::: "memory")
__device__ __forceinline__ unsigned f2bf(float f) { unsigned u = __builtin_bit_cast(unsigned, f); return (u + 0x7fffu + ((u >> 16) & 1u)) >> 16; }
__device__ __forceinline__ unsigned pk2(float lo, float hi) { return f2bf(lo) | (f2bf(hi) << 16); }
__device__ __forceinline__ float bf2f(unsigned b) { return __builtin_bit_cast(float, b << 16); }
__device__ __forceinline__ float bflo(unsigned w) { return __builtin_bit_cast(float, w << 16); }
__device__ __forceinline__ float bfhi(unsigned w) { return __builtin_bit_cast(float, w & 0xffff0000u); }
typedef __bf16 bf16x2_t __attribute__((ext_vector_type(2)));
__device__ __forceinline__ unsigned cvt_pk_bf16(float lo, float hi) { const f32x2 v = {lo, hi}; const bf16x2_t b = __builtin_convertvector(v, bf16x2_t); return __builtin_bit_cast(unsigned, b); }
__device__ __forceinline__ float fast_exp2(float x) { return __builtin_amdgcn_exp2f(x); }
__device__ __forceinline__ float fast_rcp(float x) { return __builtin_amdgcn_rcpf(x); }
__device__ __forceinline__ float fast_log2(float x) { return __builtin_amdgcn_logf(x); }
__device__ __forceinline__ float sigmoidf_(float x) { return fast_rcp(1.0f + fast_exp2(-1.4426950408889634f * x)); }
__device__ __forceinline__ float siluf_(float x) { return x * sigmoidf_(x); }
__device__ __forceinline__ int perm32(int rho) { return 8 * ((rho >> 2) & 3) + 4 * (rho >> 4) + (rho & 3); }
__device__ __forceinline__ int sig_plain(int r) { return (r & ~31) + perm32(r & 31); }
__device__ __forceinline__ int sig_rope(int r7) { return 64 * ((r7 >> 4) & 1) + 16 * (r7 >> 5) + 4 * ((r7 >> 2) & 3) + (r7 & 3); }

namespace pg8 {
constexpr int BM = 256, BK = 64, HALF = 128, HTB = HALF * BK * 2, STAGE_BYTES = 8 * HTB, NXCD = 8, WGM = 2;
__host__ __device__ __forceinline__ int lds_byte(int r, int c) { const int st = (r >> 4) * 2 + (c >> 5), rr = r & 15, cc = c & 31, ob = rr * 64 + cc * 2; return st * 1024 + (ob ^ (((ob >> 9) & 1) << 5)); }
__host__ __device__ __forceinline__ void stage_rc(int b, int& R, int& C) { const int st = b / 1024, sb = b % 1024, swz = sb ^ (((sb >> 9) & 1) << 5); R = (st >> 1) * 16 + swz / 64; C = (st & 1) * 32 + (swz % 64) / 2; }
struct Unit { int pm, pn; };
struct Gemm { const bf16* A; const bf16* Bt; int M, N, K, lda, ldb; };
constexpr size_t TILED_KS = (size_t)256 * 64 * 2, TILED_PANEL = (size_t)(2816 / 64) * TILED_KS;
template <int NM, int NN> struct StaticOrderT {
    static constexpr int WGM = NN == 4 ? MK_WGM_N : (NN == 22 ? MK_WGM_A : MK_WGM_Z);
    int G, c, lim, rev;
    __host__ __device__ void init(int, int, int G_, int c_) { G = G_; c = c_; lim = NM * NN; rev = 0; }
    __host__ __device__ static __forceinline__ void unit_of(int L, Unit& u) {
        constexpr int nwg = NM * NN, q = nwg / NXCD, r = nwg % NXCD, nig = WGM * NN;
        const int xcd = L & (NXCD - 1), off = L >> 3;
        const int wgid = (xcd < r ? xcd * (q + 1) : r * (q + 1) + (xcd - r) * q) + off;
        const int gid = wgid / nig, x = wgid - gid * nig, fm = gid * WGM;
        if (NM % WGM == 0 || fm + WGM <= NM) { u.pm = fm + (x & (WGM - 1)); u.pn = x / WGM; }
        else { constexpr int gl = (NM % WGM) ? (NM % WGM) : WGM; u.pm = fm + x % gl; u.pn = x / gl; }
    }
    __host__ __device__ __forceinline__ bool next(int i, Unit& u) const { const int L = i * G + c; if (L >= lim) return false; unit_of(rev ? lim - 1 - L : L, u); return true; }
};
struct OneUnit { Unit u; int c; __host__ __device__ __forceinline__ bool next(int i, Unit& o) const { if (i) return false; o = u; return true; } };
template <class Epi, class Sched, bool ALIGN_EPI = true, bool ATILED = false>
__device__ __forceinline__ void gemm_phase(LAS unsigned char* lds, const Gemm g, const Sched& S, const Epi& E, const int wid, const int stagger_ticks = 0) {
    if (stagger_ticks > 0) { const unsigned long long t0 = __builtin_amdgcn_s_memrealtime(); const unsigned long long dl = (unsigned long long)(((S.c * 37) & 255) * stagger_ticks) >> 8;
        while (__builtin_amdgcn_s_memrealtime() - t0 < dl) __builtin_amdgcn_s_sleep(8); }
    const int lane = lane_id(), tid = wid * 64 + lane, wr = wid >> 2, wc = wid & 3, fr = lane & 15, fq = lane >> 4;
    const int K = g.K, nt = K / BK;
    unsigned voffA[2], voffB[2];
#pragma unroll
    for (int i = 0; i < 2; ++i) { int R, C; stage_rc(tid * 16 + i * 8192, R, C); voffA[i] = (unsigned)(R * g.lda + C) * 2u; voffB[i] = (unsigned)(R * g.ldb + C) * 2u; }
    const size_t kstep = (size_t)(BK * 2), kstepA = ATILED ? TILED_KS : kstep;
    const size_t hA = (size_t)HALF * g.lda * 2, tA = ATILED ? TILED_PANEL : 2 * hA, hB = (size_t)HALF * g.ldb * 2, tB = 2 * hB;
    const unsigned ldsw = (unsigned)wid * 1024u;
    const int aoff = lds_byte(wr * 64 + fr, fq * 8), boff = lds_byte(wc * 32 + fr, fq * 8);
#define PG8_SA(b, h) (((b) * 2 + (h)) * HTB)
#define PG8_SB(b, h) ((4 + (b) * 2 + (h)) * HTB)
#define PG8_STAGE(bufoff, gbase, voff) do { _Pragma("unroll") for (int _i = 0; _i < 2; ++_i) \
        __builtin_amdgcn_global_load_lds((const unsigned*)((const char*)(gbase) + (voff)[_i]), (LAS unsigned*)(lds + (bufoff) + ldsw + _i * 8192), 16, 0, 0); } while (0)
#define PG8_LDA(dst, b, h) do { _Pragma("unroll") for (int m = 0; m < 4; ++m) _Pragma("unroll") for (int k = 0; k < 2; ++k) dst[m][k] = *(const LAS bf16x8*)(lds + PG8_SA(b, h) + aoff + m * 2048 + k * 1024); } while (0)
#define PG8_LDB(dst, b, h) do { _Pragma("unroll") for (int n = 0; n < 2; ++n) _Pragma("unroll") for (int k = 0; k < 2; ++k) dst[n][k] = *(const LAS bf16x8*)(lds + PG8_SB(b, h) + boff + n * 2048 + k * 1024); } while (0)
#define PG8_MMA(ai, bj, At, Bt) do { __builtin_amdgcn_s_setprio(1); _Pragma("unroll") for (int m = 0; m < 4; ++m) _Pragma("unroll") for (int n = 0; n < 2; ++n) _Pragma("unroll") for (int k = 0; k < 2; ++k) \
        acc[ai][bj][m][n] = __builtin_amdgcn_mfma_f32_16x16x32_bf16(Bt[n][k], At[m][k], acc[ai][bj][m][n], 0, 0, 0); __builtin_amdgcn_s_setprio(0); } while (0)
#define PG8_WAIT_V(n) asm volatile("s_waitcnt vmcnt(" #n ")" ::: "memory")
#define PG8_WAIT_L(n) asm volatile("s_waitcnt lgkmcnt(" #n ")" ::: "memory")
#define PG8_BAR __builtin_amdgcn_s_barrier()
#define PG8_SCHED __builtin_amdgcn_sched_barrier(0)
    Unit cur, nxt; int ui = 0;
    if (!S.next(0, cur)) return;
    f32x4 acc[2][2][4][2];
#pragma unroll
    for (int a = 0; a < 2; ++a)
#pragma unroll
        for (int b = 0; b < 2; ++b)
#pragma unroll
            for (int m = 0; m < 4; ++m)
#pragma unroll
                for (int n = 0; n < 2; ++n) acc[a][b][m][n] = (f32x4){0.f, 0.f, 0.f, 0.f};
    bf16x8 At[4][2], B0[2][2], B1[2][2];
    const char* cA = (const char*)g.A + (size_t)cur.pm * tA; const char* cB = (const char*)g.Bt + (size_t)cur.pn * tB;
    PG8_STAGE(PG8_SB(0, 0), cB, voffB); PG8_STAGE(PG8_SB(0, 1), cB + hB, voffB); PG8_STAGE(PG8_SA(0, 0), cA, voffA); PG8_STAGE(PG8_SA(0, 1), cA + hA, voffA);
    if (wr == 1) PG8_BAR;
    PG8_WAIT_V(2); PG8_BAR;
    PG8_STAGE(PG8_SB(1, 0), cB + kstep, voffB); PG8_STAGE(PG8_SA(1, 0), cA + kstepA, voffA); PG8_STAGE(PG8_SB(1, 1), cB + hB + kstep, voffB);
    PG8_WAIT_V(6); PG8_BAR;
    for (;;) {
        const bool has_next = S.next(ui + 1, nxt);
        const char* nA = has_next ? (const char*)g.A + (size_t)nxt.pm * tA : cA; const char* nB = has_next ? (const char*)g.Bt + (size_t)nxt.pn * tB : cB;
        const int seg = Epi::HAS_MID ? 8 : nt;
        for (int t0 = 0; t0 < nt; t0 += seg) {
        if constexpr (Epi::HAS_MID) { if (t0) { PG8_SCHED; E.mid(acc, cur, t0, wr, wc, fr, fq); PG8_SCHED; } }
#pragma unroll 1
        for (int t = t0; t < t0 + seg; t += 2) {
            const bool last = (t == nt - 2);
            const char* a1 = cA + (size_t)(t + 1) * kstepA;
            const char* a2 = last ? nA : cA + (size_t)(t + 2) * kstepA; const char* b2 = last ? nB : cB + (size_t)(t + 2) * kstep;
            const char* a3 = a2 + kstepA; const char* b3 = b2 + kstep;
            PG8_LDB(B0, 0, 0); PG8_LDB(B1, 0, 1); PG8_SCHED; PG8_LDA(At, 0, 0); PG8_STAGE(PG8_SA(1, 1), a1 + hA, voffA);
            PG8_WAIT_V(8); PG8_WAIT_L(0); PG8_BAR; PG8_MMA(0, 0, At, B0); PG8_MMA(0, 1, At, B1); PG8_BAR; PG8_SCHED;
            PG8_LDA(At, 0, 1); PG8_STAGE(PG8_SB(0, 0), b2, voffB); PG8_STAGE(PG8_SB(0, 1), b2 + hB, voffB); PG8_STAGE(PG8_SA(0, 0), a2, voffA);
            PG8_WAIT_V(8); PG8_WAIT_L(0); PG8_BAR; PG8_MMA(1, 0, At, B0); PG8_MMA(1, 1, At, B1); PG8_BAR; PG8_SCHED;
            PG8_LDB(B0, 1, 0); PG8_LDB(B1, 1, 1); PG8_SCHED; PG8_LDA(At, 1, 0); PG8_STAGE(PG8_SA(0, 1), a2 + hA, voffA);
            PG8_WAIT_V(8); PG8_WAIT_L(0); PG8_BAR; PG8_MMA(0, 0, At, B0); PG8_MMA(0, 1, At, B1); PG8_BAR; PG8_SCHED;
            PG8_LDA(At, 1, 1); PG8_STAGE(PG8_SB(1, 0), b3, voffB); PG8_STAGE(PG8_SB(1, 1), b3 + hB, voffB); PG8_STAGE(PG8_SA(1, 0), a3, voffA);
            PG8_WAIT_V(8); PG8_WAIT_L(0); PG8_BAR; PG8_MMA(1, 0, At, B0); PG8_MMA(1, 1, At, B1); PG8_BAR; PG8_SCHED;
        }
        }
        if constexpr (ALIGN_EPI) { if (wr == 0) PG8_BAR; }
        E(acc, cur, wr, wc, fr, fq);
        if (!has_next) break;
#pragma unroll
        for (int a = 0; a < 2; ++a)
#pragma unroll
            for (int b = 0; b < 2; ++b)
#pragma unroll
                for (int m = 0; m < 4; ++m)
#pragma unroll
                    for (int n = 0; n < 2; ++n) acc[a][b][m][n] = (f32x4){0.f, 0.f, 0.f, 0.f};
        cur = nxt; cA = nA; cB = nB; ++ui;
        if constexpr (ALIGN_EPI) { if (wr == 1) PG8_BAR; }
    }
    PG8_WAIT_V(0);
    if constexpr (!ALIGN_EPI) { if (wr == 0) PG8_BAR; }
    PG8_BAR;
#undef PG8_SA
#undef PG8_SB
#undef PG8_STAGE
#undef PG8_LDA
#undef PG8_LDB
#undef PG8_MMA
#undef PG8_WAIT_V
#undef PG8_WAIT_L
#undef PG8_BAR
#undef PG8_SCHED
}
}
using pg8::Unit;

typedef const f32x4 (&AccRef)[2][2][4][2];
constexpr size_t G_KT = (size_t)256 * 64, G_PANEL = (FF / 64) * G_KT;
__device__ __forceinline__ size_t g_off(int row, int j) { return (size_t)(row >> 8) * G_PANEL + (size_t)(j >> 6) * G_KT + (size_t)(row & 255) * 64 + (j & 63); }
struct EpiSwiglu {
    static constexpr bool HAS_MID = false;
    bf16* G; const float* pq;
    __device__ __forceinline__ void operator()(AccRef acc, const Unit& u, int wr, int wc, int fr, int fq) const {
        const int row0 = u.pm * 256 + wr * 64 + fr;
        bf16* gb = G + ((size_t)u.pm * (FF / 64) + 2 * u.pn + (wc >> 1)) * G_KT + (size_t)((wr * 64 + fr) * 64 + (wc & 1) * 32 + 8 * fq);
        float sc[2][4];
#pragma unroll
        for (int ai = 0; ai < 2; ++ai)
#pragma unroll
            for (int m = 0; m < 4; ++m) { sc[ai][m] = 1.f;
                if (pq) { const f32x4 pv = *(const f32x4*)(pq + (size_t)(row0 + ai * 128 + m * 16) * 16 + 4 * fq); float t = (pv.x + pv.y) + (pv.z + pv.w); t += __shfl_xor(t, 16); t += __shfl_xor(t, 32); sc[ai][m] = __builtin_amdgcn_rsqf(t * (1.f / D) + EPS); } }
#pragma unroll
        for (int ai = 0; ai < 2; ++ai)
#pragma unroll
            for (int m = 0; m < 4; ++m) {
                const float s = sc[ai][m];
                float o[8];
#pragma unroll
                for (int n = 0; n < 2; ++n)
#pragma unroll
                    for (int i = 0; i < 4; ++i) { const float a = acc[ai][0][m][n][i] * s, b = acc[ai][1][m][n][i] * s; o[4 * n + i] = siluf_(a) * b; }
                v4u w; w.x = cvt_pk_bf16(o[0], o[1]); w.y = cvt_pk_bf16(o[2], o[3]); w.z = cvt_pk_bf16(o[4], o[5]); w.w = cvt_pk_bf16(o[6], o[7]);
                *(v4u*)(gb + (ai * 128 + m * 16) * 64) = w;
            }
    }
};
template <bool WRITE_PQ> struct EpiResidX {
    static constexpr bool HAS_MID = false;
    const float* baseP; const float* baseS; bf16* HB; float* pq; float scale;
    __device__ __forceinline__ void operator()(AccRef acc, const Unit& u, int wr, int wc, int fr, int fq) const {
        const int row0 = u.pm * 256 + wr * 64 + fr, c0 = u.pn * 256 + wc * 32 + 8 * fq; const bool smp = u.pm >= MP / 256;
        const float* bbase = (smp ? baseS : baseP) + (smp ? (size_t)(row0 - MP) * D : (size_t)row0 * D) + c0;
#pragma unroll
        for (int ai = 0; ai < 2; ++ai) {
            f32x4 bb[4][2][2];
#pragma unroll
            for (int m = 0; m < 4; ++m)
#pragma unroll
                for (int bj = 0; bj < 2; ++bj) { const float* bp = bbase + (size_t)(ai * 128 + m * 16) * D + bj * 128; bb[m][bj][0] = *(const f32x4*)bp; bb[m][bj][1] = *(const f32x4*)(bp + 4); }
#pragma unroll
            for (int m = 0; m < 4; ++m) {
                const int row = row0 + ai * 128 + m * 16; float ss = 0.f;
#pragma unroll
                for (int bj = 0; bj < 2; ++bj) {
                    const f32x4 o0 = bb[m][bj][0] + acc[ai][bj][m][0] * scale, o1 = bb[m][bj][1] + acc[ai][bj][m][1] * scale;
                    v4u w; w.x = cvt_pk_bf16(o0.x, o0.y); w.y = cvt_pk_bf16(o0.z, o0.w); w.z = cvt_pk_bf16(o1.x, o1.y); w.w = cvt_pk_bf16(o1.z, o1.w); *(v4u*)(HB + (size_t)row * D + c0 + bj * 128) = w;
                    if (WRITE_PQ) ss += (o0.x * o0.x + o0.y * o0.y) + (o0.z * o0.z + o0.w * o0.w) + (o1.x * o1.x + o1.y * o1.y) + (o1.z * o1.z + o1.w * o1.w);
                }
                if (WRITE_PQ) { ss += __shfl_xor(ss, 16); ss += __shfl_xor(ss, 32); if (fq == 0) pq[(size_t)row * 16 + u.pn * 4 + wc] = ss; }
            }
        }
    }
    template <int O> __device__ __forceinline__ void group(const f32x4 (&v)[8], const Unit& u, int wr, int wc, int fr, int fq) const {
        const int row0 = u.pm * 256 + wr * 64 + fr, c0 = u.pn * 256 + wc * 32 + 8 * fq; const bool smp = u.pm >= MP / 256;
        const float* bbase = (smp ? baseS : baseP) + (smp ? (size_t)(row0 - MP) * D : (size_t)row0 * D) + c0;
        f32x4 bb[2][2][2];
#pragma unroll
        for (int mm = 0; mm < 2; ++mm)
#pragma unroll
            for (int bj = 0; bj < 2; ++bj) { const float* bp = bbase + (size_t)((O >> 1) * 128 + (2 * (O & 1) + mm) * 16) * D + bj * 128; bb[mm][bj][0] = *(const f32x4*)bp; bb[mm][bj][1] = *(const f32x4*)(bp + 4); }
#pragma unroll
        for (int mm = 0; mm < 2; ++mm) { const int row = row0 + (O >> 1) * 128 + (2 * (O & 1) + mm) * 16; float ss = 0.f;
#pragma unroll
            for (int bj = 0; bj < 2; ++bj) {
                const f32x4 o0 = bb[mm][bj][0] + v[bj * 4 + mm * 2] * scale, o1 = bb[mm][bj][1] + v[bj * 4 + mm * 2 + 1] * scale;
                v4u w; w.x = cvt_pk_bf16(o0.x, o0.y); w.y = cvt_pk_bf16(o0.z, o0.w); w.z = cvt_pk_bf16(o1.x, o1.y); w.w = cvt_pk_bf16(o1.z, o1.w); *(v4u*)(HB + (size_t)row * D + c0 + bj * 128) = w;
                if (WRITE_PQ) ss += (o0.x * o0.x + o0.y * o0.y) + (o0.z * o0.z + o0.w * o0.w) + (o1.x * o1.x + o1.y * o1.y) + (o1.z * o1.z + o1.w * o1.w); }
            if (WRITE_PQ) { ss += __shfl_xor(ss, 16); ss += __shfl_xor(ss, 32); if (fq == 0) pq[(size_t)row * 16 + u.pn * 4 + wc] = ss; } }
    }
};
template <bool WRITE_PQ> struct EpiResidB {
    static constexpr bool HAS_MID = false;
    const bf16* base; bf16* out; float* pq; float scale;
    __device__ __forceinline__ void operator()(AccRef acc, const Unit& u, int wr, int wc, int fr, int fq) const {
        const int row0 = u.pm * 256 + wr * 64 + fr, c0 = u.pn * 256 + wc * 32 + 8 * fq;
#pragma unroll
        for (int ai = 0; ai < 2; ++ai) {
            v4u bb[4][2];
#pragma unroll
            for (int m = 0; m < 4; ++m)
#pragma unroll
                for (int bj = 0; bj < 2; ++bj) bb[m][bj] = *(const v4u*)(base + (size_t)(row0 + ai * 128 + m * 16) * D + c0 + bj * 128);
#pragma unroll
            for (int m = 0; m < 4; ++m) {
                const int row = row0 + ai * 128 + m * 16; float ss = 0.f;
#pragma unroll
                for (int bj = 0; bj < 2; ++bj) { const v4u g = bb[m][bj];
                    const f32x4 o0 = (f32x4){bflo(g.x), bfhi(g.x), bflo(g.y), bfhi(g.y)} + acc[ai][bj][m][0] * scale, o1 = (f32x4){bflo(g.z), bfhi(g.z), bflo(g.w), bfhi(g.w)} + acc[ai][bj][m][1] * scale;
                    v4u w; w.x = cvt_pk_bf16(o0.x, o0.y); w.y = cvt_pk_bf16(o0.z, o0.w); w.z = cvt_pk_bf16(o1.x, o1.y); w.w = cvt_pk_bf16(o1.z, o1.w); *(v4u*)(out + (size_t)row * D + c0 + bj * 128) = w;
                    if (WRITE_PQ) ss += (o0.x * o0.x + o0.y * o0.y) + (o0.z * o0.z + o0.w * o0.w) + (o1.x * o1.x + o1.y * o1.y) + (o1.z * o1.z + o1.w * o1.w);
                }
                if (WRITE_PQ) { ss += __shfl_xor(ss, 16); ss += __shfl_xor(ss, 32); if (fq == 0) pq[(size_t)row * 16 + u.pn * 4 + wc] = ss; }
            }
        }
    }
    template <int O> __device__ __forceinline__ void group(const f32x4 (&v)[8], const Unit& u, int wr, int wc, int fr, int fq) const {
        const int row0 = u.pm * 256 + wr * 64 + fr, c0 = u.pn * 256 + wc * 32 + 8 * fq;
        v4u bb[2][2];
#pragma unroll
        for (int mm = 0; mm < 2; ++mm)
#pragma unroll
            for (int bj = 0; bj < 2; ++bj) bb[mm][bj] = *(const v4u*)(base + (size_t)(row0 + (O >> 1) * 128 + (2 * (O & 1) + mm) * 16) * D + c0 + bj * 128);
#pragma unroll
        for (int mm = 0; mm < 2; ++mm) { const int row = row0 + (O >> 1) * 128 + (2 * (O & 1) + mm) * 16; float ss = 0.f;
#pragma unroll
            for (int bj = 0; bj < 2; ++bj) { const v4u g = bb[mm][bj];
                const f32x4 o0 = (f32x4){bflo(g.x), bfhi(g.x), bflo(g.y), bfhi(g.y)} + v[bj * 4 + mm * 2] * scale, o1 = (f32x4){bflo(g.z), bfhi(g.z), bflo(g.w), bfhi(g.w)} + v[bj * 4 + mm * 2 + 1] * scale;
                v4u w; w.x = cvt_pk_bf16(o0.x, o0.y); w.y = cvt_pk_bf16(o0.z, o0.w); w.z = cvt_pk_bf16(o1.x, o1.y); w.w = cvt_pk_bf16(o1.z, o1.w); *(v4u*)(out + (size_t)row * D + c0 + bj * 128) = w;
                if (WRITE_PQ) ss += (o0.x * o0.x + o0.y * o0.y) + (o0.z * o0.z + o0.w * o0.w) + (o1.x * o1.x + o1.y * o1.y) + (o1.z * o1.z + o1.w * o1.w); }
            if (WRITE_PQ) { ss += __shfl_xor(ss, 16); ss += __shfl_xor(ss, 32); if (fq == 0) pq[(size_t)row * 16 + u.pn * 4 + wc] = ss; } }
    }
};
struct EpiMemKV {
    static constexpr bool HAS_MID = false;
    float* out; bf16* MKV;
    __device__ __forceinline__ void operator()(AccRef acc, const Unit& u, int wr, int wc, int fr, int fq) const {
        const int row0 = u.pm * 256 + wr * 64 + fr, c0 = u.pn * 256 + wc * 32 + 8 * fq;
#pragma unroll
        for (int ai = 0; ai < 2; ++ai)
#pragma unroll
            for (int m = 0; m < 4; ++m) {
                const int row = row0 + ai * 128 + m * 16;
#pragma unroll
                for (int bj = 0; bj < 2; ++bj) { const f32x4 o0 = acc[ai][bj][m][0], o1 = acc[ai][bj][m][1]; float* op = out + (size_t)row * D + c0 + bj * 128;
                    *(f32x4*)op = o0; *(f32x4*)(op + 4) = o1;
                    v4u w; w.x = cvt_pk_bf16(o0.x, o0.y); w.y = cvt_pk_bf16(o0.z, o0.w); w.z = cvt_pk_bf16(o1.x, o1.y); w.w = cvt_pk_bf16(o1.z, o1.w); *(v4u*)(MKV + (size_t)row * D + c0 + bj * 128) = w; }
            }
    }
};
struct EpiMerge1 {
    static constexpr bool HAS_MID = true;
    const bf16* GATE; bf16* MB;
    __device__ __forceinline__ void mid(f32x4 (&acc)[2][2][4][2], const Unit& u, int t, int wr, int wc, int fr, int fq) const {
        const unsigned lo = (unsigned)(((wr * 64 + fr) * 3072 + wc * 32 + 8 * fq) * 2);
        const char* ub = (const char*)GATE + ((size_t)u.pm * 256 * 3072 + (size_t)((t >> 3) - 1) * 1024 + (size_t)u.pn * 256) * 2;
#pragma unroll
        for (int ai = 0; ai < 2; ++ai) {
            v4u gn[4][2], gd[4][2];
#pragma unroll
            for (int m = 0; m < 4; ++m)
#pragma unroll
                for (int bj = 0; bj < 2; ++bj) { const char* fb = ub + (size_t)((ai * 128 + m * 16) * 3072 + bj * 128) * 2; gn[m][bj] = *(const v4u*)(fb + lo); gd[m][bj] = *(const v4u*)(fb + 2048 + lo); }
#pragma unroll
            for (int m = 0; m < 4; ++m)
#pragma unroll
                for (int bj = 0; bj < 2; ++bj) { const v4u n_ = gn[m][bj], d_ = gd[m][bj];
                    const f32x4 r0 = {bflo(n_.x) * fast_rcp(fmaxf(bflo(d_.x), 1e-30f)), bfhi(n_.x) * fast_rcp(fmaxf(bfhi(d_.x), 1e-30f)), bflo(n_.y) * fast_rcp(fmaxf(bflo(d_.y), 1e-30f)), bfhi(n_.y) * fast_rcp(fmaxf(bfhi(d_.y), 1e-30f))};
                    const f32x4 r1 = {bflo(n_.z) * fast_rcp(fmaxf(bflo(d_.z), 1e-30f)), bfhi(n_.z) * fast_rcp(fmaxf(bfhi(d_.z), 1e-30f)), bflo(n_.w) * fast_rcp(fmaxf(bflo(d_.w), 1e-30f)), bfhi(n_.w) * fast_rcp(fmaxf(bfhi(d_.w), 1e-30f))};
                    acc[ai][bj][m][0] *= r0; acc[ai][bj][m][1] *= r1; }
            asm volatile("" ::: "memory");
        }
    }
    __device__ __forceinline__ void operator()(AccRef acc, const Unit& u, int wr, int wc, int fr, int fq) const {
        const int row0 = u.pm * 256 + wr * 64 + fr, c0 = u.pn * 256 + wc * 32 + 8 * fq;
        v4u gw[2][4][2];
#pragma unroll
        for (int ai = 0; ai < 2; ++ai)
#pragma unroll
            for (int m = 0; m < 4; ++m)
#pragma unroll
                for (int bj = 0; bj < 2; ++bj) gw[ai][m][bj] = *(const v4u*)(GATE + (size_t)(row0 + ai * 128 + m * 16) * 3072 + 2048 + c0 + bj * 128);
#pragma unroll
        for (int ai = 0; ai < 2; ++ai)
#pragma unroll
            for (int m = 0; m < 4; ++m) { const int row = row0 + ai * 128 + m * 16;
#pragma unroll
                for (int bj = 0; bj < 2; ++bj) { const v4u g = gw[ai][m][bj];
                    const f32x4 o0 = acc[ai][bj][m][0] * (f32x4){bflo(g.x), bfhi(g.x), bflo(g.y), bfhi(g.y)}, o1 = acc[ai][bj][m][1] * (f32x4){bflo(g.z), bfhi(g.z), bflo(g.w), bfhi(g.w)};
                    v4u w; w.x = cvt_pk_bf16(o0.x, o0.y); w.y = cvt_pk_bf16(o0.z, o0.w); w.z = cvt_pk_bf16(o1.x, o1.y); w.w = cvt_pk_bf16(o1.z, o1.w); *(v4u*)(MB + (size_t)row * D + c0 + bj * 128) = w;
                } }
    }
    template <int O> __device__ __forceinline__ void group(const f32x4 (&v)[8], const Unit& u, int wr, int wc, int fr, int fq) const {
        const int row0 = u.pm * 256 + wr * 64 + fr, c0 = u.pn * 256 + wc * 32 + 8 * fq;
#pragma unroll
        for (int mm = 0; mm < 2; ++mm) { const int row = row0 + (O >> 1) * 128 + (2 * (O & 1) + mm) * 16;
#pragma unroll
            for (int bj = 0; bj < 2; ++bj) { const f32x4 o0 = v[bj * 4 + mm * 2], o1 = v[bj * 4 + mm * 2 + 1];
                v4u w; w.x = cvt_pk_bf16(o0.x, o0.y); w.y = cvt_pk_bf16(o0.z, o0.w); w.z = cvt_pk_bf16(o1.x, o1.y); w.w = cvt_pk_bf16(o1.z, o1.w); *(v4u*)(MB + (size_t)row * D + c0 + bj * 128) = w; } }
    }
};
__device__ __forceinline__ size_t qkv_off(int row, int g, int h) {
    if (row >= MP) return (size_t)row * 1536 + g * 512 + h * 128;
    const int b = row >> 11, t = row & 2047, sh = 2 * g, p = ((t & ((1 << sh) - 1)) << (11 - sh)) + (t >> sh);
    return ((size_t)((g * NB + b) * 4 + h) * SEQ + p) * 128;
}
struct EpiZ {
    static constexpr bool HAS_MID = false;
    const float* pq; const float* ropeC; const float* ropeS; const float* bga; float* out;
    bf16 *QS, *KS, *VS, *GQ, *GK, *GV, *GRS, *MQ, *GATE; float* GA;
    template <int ACT> __device__ __forceinline__ void plain(AccRef acc, const float (&rs)[2][4], int pm, int tl0, bf16* dst, int ld, int ucol, int cl, float scale) const {
        const unsigned lo = (unsigned)(tl0 * ld + cl) * 2u;
#pragma unroll
        for (int ai = 0; ai < 2; ++ai)
#pragma unroll
            for (int m = 0; m < 4; ++m) { const float s = rs[ai][m];
#pragma unroll
                for (int bj = 0; bj < 2; ++bj) { float o[8];
#pragma unroll
                    for (int n = 0; n < 2; ++n)
#pragma unroll
                        for (int i = 0; i < 4; ++i) { const float x = acc[ai][bj][m][n][i] * s; o[4 * n + i] = ACT == 0 ? x * scale : (ACT == 1 ? siluf_(x) : sigmoidf_(x)); }
                    v4u w; w.x = cvt_pk_bf16(o[0], o[1]); w.y = cvt_pk_bf16(o[2], o[3]); w.z = cvt_pk_bf16(o[4], o[5]); w.w = cvt_pk_bf16(o[6], o[7]);
                    char* ub = (char*)(dst + (size_t)(pm * 256 + ai * 128 + m * 16) * ld + ucol + bj * 128);
                    *(v4u*)(ub + lo) = w; } }
    }
    __device__ __forceinline__ void operator()(AccRef acc, const Unit& u, int wr, int wc, int fr, int fq) const {
        const int pm = __builtin_amdgcn_readfirstlane(u.pm), pn = __builtin_amdgcn_readfirstlane(u.pn);
        const int tl0 = wr * 64 + fr, row0 = pm * 256 + tl0, cl = wc * 32 + 8 * fq;
        float rs[2][4];
        { const char* pb = (const char*)(pq + (size_t)pm * 256 * 16); const unsigned lp = (unsigned)(tl0 * 16 + 4 * fq) * 4u;
#pragma unroll
          for (int ai = 0; ai < 2; ++ai)
#pragma unroll
            for (int m = 0; m < 4; ++m) {
                const f32x4 pv = *(const f32x4*)(pb + (size_t)(ai * 128 + m * 16) * 64 + lp); float t = (pv.x + pv.y) + (pv.z + pv.w); t += __shfl_xor(t, 16); t += __shfl_xor(t, 32); rs[ai][m] = __builtin_amdgcn_rsqf(t * (1.f / D) + EPS); } }
        if (pn < 18) {
            const bool smp = pm >= MP / 256; const int kind = pn / 6, g = (pn % 6) >> 1, hp = pn & 1, sh = 2 * g, keep = 128 << sh, t0 = SEQ - keep, b = pm >> 3, tb = (pm & 7) * 256;
            const unsigned Lq = (unsigned)(smp ? tl0 * 1536 : ((((tl0 & ((1 << sh) - 1)) << (11 - sh)) + (tl0 >> sh)) * 128)) * 2u;
            const unsigned Lf = (unsigned)tl0 * 4096u;
            bf16* qbase = (bf16*)((char*)QS + (kind == 0 ? (size_t)0 : (kind == 1 ? WS_KS - WS_QS : WS_VS - WS_QS)));
            float* fbase = out + (smp ? (g == 0 ? O_SWA0S : (g == 1 ? O_SWA1S : O_SWA2S)) : (g == 0 ? O_SWA0P : (g == 1 ? O_SWA1P : O_SWA2P)));
            const int kv = kind - 1;
            if (kind < 2) {
                const int e0 = wc * 16 + 4 * fq;
                const unsigned lt = (unsigned)((smp ? SEQ + (tl0 & 3) : tl0) * 64 + e0) * 4u;
#pragma unroll
                for (int ai = 0; ai < 2; ++ai) {
                    const bool kept = kind == 1 && (smp || tb + ai * 128 >= t0);
                    f32x4 cs[4], sn[4];
#pragma unroll
                    for (int m = 0; m < 4; ++m) { const size_t ut = smp ? 0 : (size_t)(tb + ai * 128 + m * 16) * 64 * 4;
                        cs[m] = *(const f32x4*)((const char*)ropeC + ut + lt); sn[m] = *(const f32x4*)((const char*)ropeS + ut + lt); }
#pragma unroll
                    for (int m = 0; m < 4; ++m) { const int ro = ai * 128 + m * 16; const float s = rs[ai][m];
#pragma unroll
                        for (int bj = 0; bj < 2; ++bj) { const int h = 2 * hp + bj;
                            const f32x4 x1 = acc[ai][bj][m][0] * s, x2 = acc[ai][bj][m][1] * s;
                            f32x4 r1 = x1 * cs[m] - x2 * sn[m], r2 = x2 * cs[m] + x1 * sn[m];
                            if (kind == 0) { r1 *= QSCALE; r2 *= QSCALE; }
                            const size_t uq = smp ? ((size_t)(pm * 256 + ro) * 1536 + g * 512 + h * 128) : (((size_t)((g * NB + b) * 4 + h) * SEQ + ((tb + ro) >> sh)) * 128);
                            char* qp = (char*)(qbase + uq + e0);
                            v2u w1, w2; w1.x = cvt_pk_bf16(r1.x, r1.y); w1.y = cvt_pk_bf16(r1.z, r1.w); w2.x = cvt_pk_bf16(r2.x, r2.y); w2.y = cvt_pk_bf16(r2.z, r2.w);
                            *(v2u*)(qp + Lq) = w1; *(v2u*)(qp + 128 + Lq) = w2;
                            if (kept) { const size_t uf = smp ? (((size_t)(pm * 256 - MP + ro) * 2 + kv) * 512 + h * 128) : ((((size_t)b * keep + (tb + ro - t0)) * 2 + kv) * 512 + h * 128);
                                char* fp = (char*)(fbase + uf + e0); *(f32x4*)(fp + Lf) = r1; *(f32x4*)(fp + 256 + Lf) = r2; }
                        } }
                }
            } else {
#pragma unroll
                for (int ai = 0; ai < 2; ++ai) {
                    const bool kept = smp || tb + ai * 128 >= t0;
#pragma unroll
                    for (int m = 0; m < 4; ++m) { const int ro = ai * 128 + m * 16; const float s = rs[ai][m];
#pragma unroll
                        for (int bj = 0; bj < 2; ++bj) { const int h = 2 * hp + bj; const f32x4 o0 = acc[ai][bj][m][0] * s, o1 = acc[ai][bj][m][1] * s;
                            v4u w; w.x = cvt_pk_bf16(o0.x, o0.y); w.y = cvt_pk_bf16(o0.z, o0.w); w.z = cvt_pk_bf16(o1.x, o1.y); w.w = cvt_pk_bf16(o1.z, o1.w);
                            const size_t uq = smp ? ((size_t)(pm * 256 + ro) * 1536 + g * 512 + h * 128) : (((size_t)((g * NB + b) * 4 + h) * SEQ + ((tb + ro) >> sh)) * 128);
                            char* qp = (char*)(qbase + uq + cl); *(v4u*)(qp + Lq) = w;
                            if (kept) { const size_t uf = smp ? (((size_t)(pm * 256 - MP + ro) * 2 + kv) * 512 + h * 128) : ((((size_t)b * keep + (tb + ro - t0)) * 2 + kv) * 512 + h * 128);
                                char* fp = (char*)(fbase + uf + cl); *(f32x4*)(fp + Lf) = o0; *(f32x4*)(fp + 16 + Lf) = o1; } } }
                }
            }
        } else if (pn == 18) plain<0>(acc, rs, pm, tl0, GQ, 256, 0, cl, 0.125f);
        else if (pn == 19) plain<0>(acc, rs, pm, tl0, GK, 256, 0, cl, 1.f);
        else if (pn < 22) plain<0>(acc, rs, pm, tl0, GV, 512, (pn - 20) * 256, cl, 1.f);
        else if (pn < 24) plain<1>(acc, rs, pm, tl0, GRS, 512, (pn - 22) * 256, cl, 1.f);
        else if (pn == 24) {
            f32x4 bv[2][2];
#pragma unroll
            for (int bj = 0; bj < 2; ++bj)
#pragma unroll
                for (int n = 0; n < 2; ++n) bv[bj][n] = *(const f32x4*)(bga + bj * 128 + cl + 4 * n);
#pragma unroll
            for (int ai = 0; ai < 2; ++ai)
#pragma unroll
                for (int m = 0; m < 4; ++m) { const int row = row0 + ai * 128 + m * 16; const float s = rs[ai][m];
#pragma unroll
                    for (int bj = 0; bj < 2; ++bj)
#pragma unroll
                        for (int n = 0; n < 2; ++n) { const int c = bj * 128 + cl + 4 * n; f32x4 o;
#pragma unroll
                            for (int i = 0; i < 4; ++i) { const float x = acc[ai][bj][m][n][i] * s + bv[bj][n][i];
                                o[i] = (fminf(x, 0.f) - LN2 * fast_log2(1.f + fast_exp2(-1.4426950408889634f * fabsf(x)))) * (1.f / 16.f); }
                            *(f32x4*)(GA + (size_t)row * 256 + c) = o; } }
        } else if (pn < 27) plain<0>(acc, rs, pm, tl0, MQ, 512, (pn - 25) * 256, cl, QSCALE);
        else plain<2>(acc, rs, pm, tl0, GATE, 3072, (pn - 27) * 256, cl, 1.f);
    }
};


constexpr int TS = 4;
template <int O> __device__ __forceinline__ void tail_store_group(const f32x4 (&acc)[2][2][4][2], float* dst) {
#pragma unroll
    for (int e = 0; e < 8; ++e) *(f32x4*)(dst + (size_t)e * 2048) = acc[O >> 1][e >> 2][2 * (O & 1) + ((e >> 1) & 1)][e & 1];
}
template <int O> __device__ __forceinline__ void tail_store_gated(const f32x4 (&acc)[2][2][4][2], const bf16* gp, float* dst) {
    v4u g[2][2];
#pragma unroll
    for (int mm = 0; mm < 2; ++mm)
#pragma unroll
        for (int bj = 0; bj < 2; ++bj) g[mm][bj] = *(const v4u*)(gp + (size_t)((O >> 1) * 128 + (2 * (O & 1) + mm) * 16) * 3072 + bj * 128);
#pragma unroll
    for (int e = 0; e < 8; ++e) { const v4u gv = g[(e >> 1) & 1][e >> 2];
        const f32x4 gg = (e & 1) ? (f32x4){bflo(gv.z), bfhi(gv.z), bflo(gv.w), bfhi(gv.w)} : (f32x4){bflo(gv.x), bfhi(gv.x), bflo(gv.y), bfhi(gv.y)};
        *(f32x4*)(dst + (size_t)e * 2048) = acc[O >> 1][e >> 2][2 * (O & 1) + ((e >> 1) & 1)][e & 1] * gg; }
}
template <class Base, bool GATED = false> struct EpiTail {
    static constexpr bool HAS_MID = false;
    Base E0; float* slab  ; gu32* flag; int s, wave; const bf16* gate  ;
    __device__ __forceinline__ void operator()(const f32x4 (&acc)[2][2][4][2], const Unit& u, int wr, int wc, int fr, int fq) const {
        const int lane = fq * 16 + fr; float* lb = slab + (size_t)(wave * 64 + lane) * 4;
        if (GATED) { const bf16* gp = gate + (size_t)(u.pm * 256 + wr * 64 + fr) * 3072 + u.pn * 256 + wc * 32 + 8 * fq;
            tail_store_gated<0>(acc, gp, lb + (size_t)((0 * TS + s) * 8) * 2048); tail_store_gated<1>(acc, gp, lb + (size_t)((1 * TS + s) * 8) * 2048);
            tail_store_gated<2>(acc, gp, lb + (size_t)((2 * TS + s) * 8) * 2048); tail_store_gated<3>(acc, gp, lb + (size_t)((3 * TS + s) * 8) * 2048); }
        else {
        tail_store_group<0>(acc, lb + (size_t)((0 * TS + s) * 8) * 2048); tail_store_group<1>(acc, lb + (size_t)((1 * TS + s) * 8) * 2048);
        tail_store_group<2>(acc, lb + (size_t)((2 * TS + s) * 8) * 2048); tail_store_group<3>(acc, lb + (size_t)((3 * TS + s) * 8) * 2048); }
        asm volatile("s_waitcnt vmcnt(0)" ::: "memory");
        asm volatile("s_waitcnt lgkmcnt(0)" ::: "memory"); __builtin_amdgcn_s_barrier(); asm volatile("" ::: "memory");
        if (wave == 0) {
            if (lane == 0) { __builtin_amdgcn_fence(__ATOMIC_RELEASE, "agent"); asm volatile("s_waitcnt vmcnt(0)" ::: "memory"); __hip_atomic_fetch_add(flag, 1u, RLX_AGENT); }
            unsigned spins = 0;
            while ((unsigned)__builtin_amdgcn_readfirstlane((int)__hip_atomic_load(flag, RLX_AGENT)) < (unsigned)TS) { __builtin_amdgcn_s_sleep(4); if (++spins > (1u << 22)) break; }
            __builtin_amdgcn_fence(__ATOMIC_ACQUIRE, "agent"); asm volatile("s_waitcnt vmcnt(0)" ::: "memory"); }
        asm volatile("s_waitcnt lgkmcnt(0)" ::: "memory"); __builtin_amdgcn_s_barrier(); asm volatile("" ::: "memory");
        const float* src = lb + (size_t)(s * TS * 8) * 2048;
        f32x4 t[TS][8];
#pragma unroll
        for (int ci = 0; ci < TS; ++ci)
#pragma unroll
            for (int e = 0; e < 8; ++e) t[ci][e] = *(const f32x4*)(src + (size_t)(ci * 8 + e) * 2048);
        f32x4 own[8];
#pragma unroll
        for (int e = 0; e < 8; ++e) own[e] = (t[0][e] + t[1][e]) + (t[2][e] + t[3][e]);
        if (s == 0) E0.template group<0>(own, u, wr, wc, fr, fq); else if (s == 1) E0.template group<1>(own, u, wr, wc, fr, fq);
        else if (s == 2) E0.template group<2>(own, u, wr, wc, fr, fq); else E0.template group<3>(own, u, wr, wc, fr, fq);
    }
};
#define XB_TMO      128
#define XB_XCNT(j)  (256  + 64 * (j))
#define XB_XSUB(j)  (1280 + 64 * (j))
#define XB_XGEN(j)  (2304 + 64 * (j))
#define XB_TOP      3328
#define XB_TOPGEN   3392
#define XCD_BAR_WORDS 3456
#define XB_SPIN_CAP (1u << 18)
__device__ __forceinline__ unsigned xb_ld(unsigned* p)              { return __hip_atomic_load(p, __ATOMIC_RELAXED, __HIP_MEMORY_SCOPE_AGENT); }
__device__ __forceinline__ unsigned xb_add(unsigned* p, unsigned v) { return __hip_atomic_fetch_add(p, v, __ATOMIC_RELAXED, __HIP_MEMORY_SCOPE_AGENT); }
__device__ __forceinline__ unsigned xb_xcc_id() { return (unsigned)__builtin_amdgcn_s_getreg((3 << 11) | 20) & 0xFu; }
#define XB_SPIN(cond, bar) do { unsigned _sp = 0; while (cond) { __builtin_amdgcn_s_sleep(1); \
    if ((++_sp & 255u) == 0u) { if (xb_ld(&(bar)[XB_TMO])) break; if (_sp > XB_SPIN_CAP) { atomicAdd(&(bar)[XB_TMO], 1u); break; } } } } while (0)
struct XcdBarrier { unsigned* bar; unsigned x; volatile LAS unsigned* st; };
__device__ __forceinline__ XcdBarrier xcd_barrier_post(unsigned* bar, volatile LAS unsigned* st, int wave) {
    XcdBarrier b; b.bar = bar; b.x = xb_xcc_id(); b.st = st;
    if (wave == 0 && lane_id() == 0) (void)xb_add(&bar[XB_XCNT(b.x)], 1u);
    return b;
}
__device__ __forceinline__ void xcd_barrier_complete(unsigned* bar, unsigned x, unsigned& nloc, unsigned& nx) {
    const unsigned G = gridDim.x * gridDim.y * gridDim.z;
    unsigned sum, cnt, mine, sp = 0u;
    for (;;) {
        sum = 0u; cnt = 0u; mine = 0u;
#pragma unroll
        for (unsigned j = 0; j < 16; ++j) { const unsigned c = xb_ld(&bar[XB_XCNT(j)]); sum += c; cnt += (c > 0u) ? 1u : 0u; mine = (j == x) ? c : mine; }
        if (sum == G) break;
        __builtin_amdgcn_s_sleep(1);
        if ((++sp & 255u) == 0u) { if (xb_ld(&bar[XB_TMO])) break; if (sp > XB_SPIN_CAP) { atomicAdd(&bar[XB_TMO], 1u); break; } }
    }
    nloc = mine > 0u ? mine : 1u; nx = cnt > 0u ? cnt : 1u;
}
__device__ __forceinline__ void xcd_barrier(const XcdBarrier& b, int wave) {
    asm volatile("s_waitcnt vmcnt(0)" ::: "memory");
    __syncthreads();
    if (wave == 0 && lane_id() == 0) {
        unsigned* bar = b.bar;
        __builtin_amdgcn_s_waitcnt(0);
        unsigned nloc = b.st[0], nx = b.st[1];
        if (nloc == 0u) { xcd_barrier_complete(bar, b.x, nloc, nx); b.st[0] = nloc; b.st[1] = nx; }
        const unsigned old = xb_add(&bar[XB_XSUB(b.x)], 1u);
        const unsigned gen = old / nloc;
        if (old + 1u == (gen + 1u) * nloc) {
            __builtin_amdgcn_fence(__ATOMIC_RELEASE, "agent");
            asm volatile("s_waitcnt vmcnt(0)" ::: "memory");
            const unsigned og = xb_add(&bar[XB_TOP], 1u);
            const unsigned tg = og / nx;
            if (og + 1u == (tg + 1u) * nx) xb_add(&bar[XB_TOPGEN], 1u);
            else XB_SPIN(xb_ld(&bar[XB_TOPGEN]) == tg, bar);
            __builtin_amdgcn_fence(__ATOMIC_ACQUIRE, "agent");
            xb_add(&bar[XB_XGEN(b.x)], 1u);
            asm volatile("s_waitcnt vmcnt(0)" ::: "memory");
        } else {
            XB_SPIN(xb_ld(&bar[XB_XGEN(b.x)]) == gen, bar);
            __builtin_amdgcn_fence(__ATOMIC_ACQUIRE, "agent");
            asm volatile("s_waitcnt vmcnt(0)" ::: "memory");
        }
    }
    __syncthreads();
}

struct Args { const float* in[25]; float* out; unsigned char* ws; int ph_lo, ph_hi, li, pad; };
struct Frame {
    LAS unsigned char* lds; int tid, lane, wave, vcu, G;
    const float *i0, *i1, *i2, *i3, *i4, *i5, *i6, *i7, *i8, *i9, *i10, *i11, *i12, *i13, *i14, *i15, *i16, *i17, *i18, *i19, *i20, *i21, *i22, *i23, *i24;
    float* out; unsigned char* ws;
};
__device__ __forceinline__ float wave_sum(float v) {
#pragma unroll
    for (int o = 1; o < 64; o <<= 1) v += __shfl_xor(v, o);
    return v;
}

template <class Base, bool ATILED = false> __device__ __forceinline__ void tail_phase(Frame& F, const bf16* A, int lda, const bf16* Bt, int ldb, int K, const Base& E0, int ps) {
    const int c = (int)blockIdx.x; if (c >= 8 * TS) return;
    const int j = c / TS, s = c % TS, nch = K / 128, c0 = (s * nch) / TS, c1 = ((s + 1) * nch) / TS;
    pg8::OneUnit S; S.c = c; pg8::StaticOrderT<MR / 256, D / 256>::unit_of(1024 + j, S.u);
    pg8::Gemm g{A + (ATILED ? (size_t)c0 * 2 * (pg8::TILED_KS / 2) : (size_t)c0 * 128), Bt + c0 * 128, MR, D, (c1 - c0) * 128, lda, ldb};
    EpiTail<Base> E{E0, (float*)(F.ws + WS_SLAB) + (size_t)j * (TS * TS * 8 * 2048), (gu32*)(F.ws + WS_CTL) + CW_TAIL + (ps * 8 + j) * 64, s, F.wave};
    pg8::gemm_phase<EpiTail<Base>, pg8::OneUnit, true, ATILED>(F.lds + RING_OFF, g, S, E, F.wave);
}
__device__ __forceinline__ void tail_phase_merge(Frame& F, const bf16* A, const bf16* Bt, const EpiMerge1& E0, int ps) {
    const int c = (int)blockIdx.x; if (c >= 8 * TS) return;
    const int j = c / TS, s = c % TS, k0 = s < 2 ? 512 * s : 1024 + 256 * (s - 2), kl = s < 2 ? 512 : 256, br = s < 2 ? s : 2;
    pg8::OneUnit S; S.c = c; pg8::StaticOrderT<MR / 256, D / 256>::unit_of(1024 + j, S.u);
    pg8::Gemm g{A + k0, Bt + k0, MR, D, kl, 1536, 1536};
    EpiTail<EpiMerge1, true> E{E0, (float*)(F.ws + WS_SLAB) + (size_t)j * (TS * TS * 8 * 2048), (gu32*)(F.ws + WS_CTL) + CW_TAIL + (ps * 8 + j) * 64, s, F.wave, E0.GATE + br * 1024};
    pg8::gemm_phase<EpiTail<EpiMerge1, true>, pg8::OneUnit>(F.lds + RING_OFF, g, S, E, F.wave);
}
enum WKind { WK_PLAIN = 0, WK_SWIGLU = 1, WK_IN = 2 };
__device__ __forceinline__ int p0_win_col(int np) {
    const int pn = np >> 8, r = np & 255;
    if (pn < 18) { const int qkv = pn / 6, g = (pn % 6) >> 1, hp = pn & 1, h = 2 * hp + (r >> 7); const int d = qkv < 2 ? sig_rope(r & 127) : sig_plain(r & 127); return ((qkv * 3 + g) * 4 + h) * 128 + d; }
    const int c = sig_plain(r);
    if (pn == 18) return 4608 + c;
    if (pn == 19) return 4864 + c;
    if (pn < 22) return 5120 + (pn - 20) * 256 + c;
    if (pn < 24) return 5632 + (pn - 22) * 256 + c;
    if (pn == 24) return -1 - c;
    if (pn < 27) return 6160 + (pn - 25) * 256 + c;
    return DIN + (pn - 27) * 256 + c;
}
__device__ __forceinline__ void p0_item(const Frame& F, int kind, const float* W, int ldw, const float* W2, const float* gain, const float* a2, bf16* WT, int K, int kb, int nb, LAS float* scr) {
    const int lane = F.lane, k0 = 64 * kb, n0 = 32 * nb, np = n0 + (lane & 31);
    int sc; const float* Wp = W; int ld = ldw;
    if (kind == WK_PLAIN) sc = sig_plain(np);
    else if (kind == WK_SWIGLU) { const int r = np & 255; sc = (r >> 7) * FF + (np >> 8) * 128 + sig_plain(r & 127); }
    else { sc = p0_win_col(np); if (sc >= DIN) { sc -= DIN; Wp = W2; ld = 3072; } }
    if (sc >= 0) {
#pragma unroll 8
        for (int i = 0; i < 32; ++i) { const int kk = 2 * i + (lane >> 5); float v = Wp[(size_t)(k0 + kk) * ld + sc]; if (gain) v *= gain[k0 + kk]; scr[kk * 33 + (lane & 31)] = v; }
    } else {
        const int j = -1 - sc; float a2c[16];
#pragma unroll
        for (int r = 0; r < 16; ++r) a2c[r] = a2[r * 256 + j];
        for (int i = 0; i < 32; ++i) { const int kk = 2 * i + (lane >> 5); const float* wr_ = W + (size_t)(k0 + kk) * ldw + 6144; float v = 0.f;
#pragma unroll
            for (int r = 0; r < 16; ++r) v += wr_[r] * a2c[r];
            scr[kk * 33 + (lane & 31)] = v * gain[k0 + kk]; }
    }
    LDS_WAIT(); asm volatile("" ::: "memory");
    const int c = lane & 7;
#pragma unroll
    for (int j = 0; j < 4; ++j) { const int n = (lane >> 3) + 8 * j; const LAS float* s = scr + (8 * c) * 33 + n;
        v4u o; o.x = pk2(s[0 * 33], s[1 * 33]); o.y = pk2(s[2 * 33], s[3 * 33]); o.z = pk2(s[4 * 33], s[5 * 33]); o.w = pk2(s[6 * 33], s[7 * 33]);
        *(GAS v4u*)(WT + (size_t)(n0 + n) * K + k0 + 8 * c) = o; }
    LDS_WAIT(); asm volatile("" ::: "memory");
}
template <int NR> __device__ __forceinline__ void rms_rows_to_bf16(int lane, const float* const (&xrow)[NR], const float* const (&gain)[NR], bf16* const (&orow)[NR]) {
    f32x4 v[NR][4]; float rstd[NR];
#pragma unroll
    for (int r = 0; r < NR; ++r)
#pragma unroll
        for (int j = 0; j < 4; ++j) v[r][j] = ((const GAS f32x4*)xrow[r] + lane)[64 * j];
#pragma unroll
    for (int r = 0; r < NR; ++r) { float s = 0.f;
#pragma unroll
        for (int j = 0; j < 4; ++j) s += (v[r][j].x * v[r][j].x + v[r][j].y * v[r][j].y) + (v[r][j].z * v[r][j].z + v[r][j].w * v[r][j].w);
        rstd[r] = 1.0f / sqrtf(wave_sum(s) * (1.f / D) + EPS); }
#pragma unroll
    for (int r = 0; r < NR; ++r) { GAS v2u* o8 = (GAS v2u*)orow[r] + lane; const GAS f32x4* gr = (const GAS f32x4*)gain[r] + lane;
#pragma unroll
        for (int j = 0; j < 4; ++j) { const f32x4 gg = gr[64 * j]; v2u w; w.x = pk2(v[r][j].x * rstd[r] * gg.x, v[r][j].y * rstd[r] * gg.y); w.y = pk2(v[r][j].z * rstd[r] * gg.z, v[r][j].w * rstd[r] * gg.w); o8[64 * j] = w; } }
}
__device__ __forceinline__ void sincos_d(double x, double& s, double& c) {
    const double TWO_PI = 6.283185307179586476925286766559;
    const double n = __builtin_rint(x / TWO_PI); const double r = x - n * TWO_PI, r2 = r * r;
    double ts = 1.0, tc = 1.0;
#pragma unroll
    for (int k = 14; k >= 1; --k) { ts = 1.0 - ts * r2 / (double)((2 * k) * (2 * k + 1)); tc = 1.0 - tc * r2 / (double)((2 * k - 1) * (2 * k)); }
    s = ts * r; c = tc;
}
__device__ __forceinline__ void p0_prologue(Frame& F) {
    unsigned char* ws = F.ws;
    LAS float* scr = (LAS float*)(F.lds + RING_OFF + F.wave * 16384);
    const int gw = F.vcu * NWAVES + F.wave, NGW = F.G * NWAVES;
    constexpr int I_A = 16 * 176, I_O = 44 * 32, I_IN = 16 * 312, I_BR = 8 * 32, I_SQ = 16 * 32;
    constexpr int NITEMS = 2 * I_A + 2 * I_O + I_IN + 3 * I_BR + 2 * I_SQ;
    for (int it = gw; it < NITEMS; it += NGW) {
        int r = it;
        if (r < I_A) { p0_item(F, WK_SWIGLU, F.i9, 2 * FF, nullptr, nullptr, nullptr, (bf16*)(ws + WS_W1A), D, r / 176, r % 176, scr); continue; } r -= I_A;
        if (r < I_A) { p0_item(F, WK_SWIGLU, F.i22, 2 * FF, nullptr, F.i21, nullptr, (bf16*)(ws + WS_W2A), D, r / 176, r % 176, scr); continue; } r -= I_A;
        if (r < I_O) { p0_item(F, WK_PLAIN, F.i10, D, nullptr, nullptr, nullptr, (bf16*)(ws + WS_W1O), FF, r / 32, r % 32, scr); continue; } r -= I_O;
        if (r < I_O) { p0_item(F, WK_PLAIN, F.i23, D, nullptr, nullptr, nullptr, (bf16*)(ws + WS_W2O), FF, r / 32, r % 32, scr); continue; } r -= I_O;
        if (r < I_IN) { p0_item(F, WK_IN, F.i12, DIN, F.i16, F.i11, F.i13, (bf16*)(ws + WS_WIN), D, r / 312, r % 312, scr); continue; } r -= I_IN;
        if (r < 3 * I_BR) { const int br = r / I_BR, q = r % I_BR; p0_item(F, WK_PLAIN, F.i17 + (size_t)br * 512 * D, D, nullptr, nullptr, nullptr, (bf16*)(ws + WS_WBR) + br * 512, 1536, q / 32, q % 32, scr); continue; } r -= 3 * I_BR;
        if (r < I_SQ) { p0_item(F, WK_PLAIN, F.i18, D, nullptr, nullptr, nullptr, (bf16*)(ws + WS_WOUT), D, r / 32, r % 32, scr); continue; } r -= I_SQ;
        p0_item(F, WK_PLAIN, F.i20, D, nullptr, nullptr, nullptr, (bf16*)(ws + WS_WMEM), D, r / 32, r % 32, scr);
    }
#define P0_ROW(m_, x_, g_, o_) do { const int mm_ = (m_); if (mm_ < MP) { x_ = F.i0 + (size_t)mm_ * D; g_ = F.i8; o_ = (bf16*)(ws + WS_XB) + (size_t)mm_ * D; } \
        else if (mm_ < MR) { x_ = F.i1 + (size_t)(mm_ - MP) * D; g_ = F.i8; o_ = (bf16*)(ws + WS_XB) + (size_t)mm_ * D; } \
        else { x_ = F.i2 + (size_t)(mm_ - MR) * D; g_ = F.i19; o_ = (bf16*)(ws + WS_MEMB) + (size_t)(mm_ - MR) * D; } } while (0)
    { int m = gw;
      for (; m + 3 * NGW < MR + MM; m += 4 * NGW) { const float* x[4]; const float* g[4]; bf16* o[4];
#pragma unroll
          for (int r = 0; r < 4; ++r) P0_ROW(m + r * NGW, x[r], g[r], o[r]);
          rms_rows_to_bf16<4>(F.lane, x, g, o); }
      for (; m < MR + MM; m += NGW) { const float* x[1]; const float* g[1]; bf16* o[1]; P0_ROW(m, x[0], g[0], o[0]); rms_rows_to_bf16<1>(F.lane, x, g, o); } }
#undef P0_ROW
    float* rc = (float*)(ws + WS_ROPE); float* rsn = rc + NPOS * 64;
    for (int i = (F.vcu * NWAVES * 64) + F.tid; i < NPOS * 64; i += F.G * NWAVES * 64) {
        const int p = i >> 6, e = i & 63; const int pos = p < SEQ ? p : PAST + (p - SEQ);
        const double y = -(double)e * 9.210340371976182736 / 64.0 / 16.0; double ex = 1.0;
#pragma unroll
        for (int k = 14; k >= 1; --k) ex = 1.0 + ex * y / (double)k;
        ex *= ex; ex *= ex; ex *= ex; ex *= ex;
        const float inv = (float)ex; const float ang = (float)pos * inv;
        double s, c; sincos_d((double)ang, s, c); rc[i] = (float)c; rsn[i] = (float)s;
    }
}

__device__ __forceinline__ int koff(int row, int ch) { return 256 * row + 16 * (ch ^ (row & 15)); }
__device__ __forceinline__ int voff(int row, int ch) { return 256 * row + 16 * (ch ^ ((row & 7) << 1)); }
typedef short v4i16_t __attribute__((ext_vector_type(4)));
__device__ __forceinline__ s16x4 vtr(const LAS unsigned char* p) { return __builtin_bit_cast(s16x4, __builtin_amdgcn_ds_read_tr16_b64_v4i16((LAS v4i16_t*)p)); }
struct AttnDesc { const bf16* Qp; const bf16* Kp; const bf16* Vp; bf16* Op; float* lsep; long qrow0, krow0, orow0; int qpitch, kpitch, opitch, qstride, kstride, ostride, kmin; };
template <int MODE> __device__ __forceinline__ AttnDesc attn_desc(const Frame& F, int id) {
    unsigned char* ws = F.ws; AttnDesc d;
    if (MODE == 0) {
        const int b = id / 192, rem = id % 192, gh = rem >> 4, u = rem & 15, g = gh >> 2;
        const int dil = g == 0 ? 1 : (g == 1 ? 4 : 16), r = g == 0 ? 0 : (g == 1 ? (u & 3) : u), n = g == 0 ? u : (g == 1 ? (u >> 2) : 0);
        const size_t hb = (size_t)((g * NB + b) * 4 + (gh & 3)) * SEQ * 128; const long pr = (long)r * (SEQ / dil);
        d.Qp = (const bf16*)(ws + WS_QS) + hb; d.Kp = (const bf16*)(ws + WS_KS) + hb; d.Vp = (const bf16*)(ws + WS_VS) + hb; d.Op = (bf16*)(ws + WS_OG) + gh * 128; d.lsep = (float*)(ws + WS_LSE) + gh;
        d.qrow0 = pr + 128 * n; d.krow0 = pr + 128 * (n - 1); d.orow0 = (long)b * SEQ + r + (long)128 * n * dil; d.qpitch = 128; d.kpitch = 128; d.opitch = 1536; d.qstride = 1; d.kstride = 1; d.ostride = dil; d.kmin = n == 0 ? 128 : 0;
    } else {
        const int j = id - 6144, b = j >> 6, h = (j >> 4) & 3, n = j & 15;
        d.Qp = (const bf16*)(ws + WS_MQ) + h * 128; d.Kp = (const bf16*)(ws + WS_MKV) + h * 128; d.Vp = (const bf16*)(ws + WS_MKV) + 512 + h * 128; d.Op = (bf16*)(ws + WS_OALL) + 1024 + h * 128; d.lsep = nullptr;
        d.qrow0 = (long)b * SEQ + 128 * n; d.orow0 = d.qrow0; d.ostride = 1; d.krow0 = (long)b * MEML; d.qpitch = 512; d.kpitch = 1024; d.opitch = 1536; d.qstride = 1; d.kstride = 1; d.kmin = 0;
    }
    return d;
}
template <int MODE> __device__ __forceinline__ void attn_scores(const Frame& F, const AttnDesc& d, const bf16x8 (&qf)[4], f32x4 (&S)[MODE == 0 ? 9 : 16], float& mx_out, float& ls_out) {
    const LAS unsigned char* ldsK = F.lds + RING_OFF;
    const int lane = F.lane, w = F.wave, l15 = lane & 15, g4 = lane >> 4;
    constexpr int NF = MODE == 0 ? 9 : 16;
    const int f0 = MODE == 0 ? w : 0; const bool half = MODE == 0 && d.kmin != 0;
#pragma unroll
    for (int i = 0; i < NF; ++i) { S[i] = (f32x4){0.f, 0.f, 0.f, 0.f};
        if (!(half && f0 + i < 8)) { const int krow = 16 * (f0 + i) + l15;
#pragma unroll
            for (int s = 0; s < 4; ++s) { const bf16x8 kf = *(const LAS bf16x8*)(ldsK + koff(krow, 4 * s + g4)); S[i] = __builtin_amdgcn_mfma_f32_16x16x32_bf16(kf, qf[s], S[i], 0, 0, 0); } } }
    float mx = -3.0e38f; const int iq = 16 * w + l15;
#pragma unroll
    for (int i = 0; i < NF; ++i)
#pragma unroll
        for (int r = 0; r < 4; ++r) { if (MODE == 0) { const int kj = 16 * (f0 + i) + 4 * g4 + r; const bool ok = kj >= iq && kj <= iq + 128 && kj >= d.kmin; S[i][r] = ok ? S[i][r] : -3.0e38f; } mx = fmaxf(mx, S[i][r]); }
    mx = fmaxf(mx, __shfl_xor(mx, 16)); mx = fmaxf(mx, __shfl_xor(mx, 32));
    float ls = 0.f;
#pragma unroll
    for (int i = 0; i < NF; ++i)
#pragma unroll
        for (int r = 0; r < 4; ++r) { const float p = fast_exp2(S[i][r] - mx); S[i][r] = p; ls += p; }
    ls += __shfl_xor(ls, 16); ls += __shfl_xor(ls, 32);
    mx_out = mx; ls_out = ls;
}
template <int MODE> __device__ __forceinline__ void attn_pv(const Frame& F, const AttnDesc& d, const f32x4 (&S)[MODE == 0 ? 9 : 16], float mx, float ls) {
    const LAS unsigned char* ldsV = F.lds + RING_OFF + 65536;
    const int lane = F.lane, w = F.wave, l15 = lane & 15, g4 = lane >> 4;
    constexpr int NF = MODE == 0 ? 9 : 16, NP = (NF + 1) / 2;
    const int f0 = MODE == 0 ? w : 0; const bool half = MODE == 0 && d.kmin != 0;
    f32x4 O[8];
#pragma unroll
    for (int df = 0; df < 8; ++df) O[df] = (f32x4){0.f, 0.f, 0.f, 0.f};
    const int q4 = l15 >> 2, p4 = lane & 3;
#pragma unroll
    for (int pr = 0; pr < NP; ++pr) {
        int fa = f0 + 2 * pr, fb = fa + 1; if (fb > 15) fb = 15;
        if (half && fb < 8) continue;
        if (half && fa < 8) fa = 8;
        const f32x4 pa = S[2 * pr], pb = (2 * pr + 1 < NF) ? S[(2 * pr + 1 < NF) ? 2 * pr + 1 : 0] : (f32x4){0.f, 0.f, 0.f, 0.f};
        v4u pw; pw.x = cvt_pk_bf16(pa.x, pa.y); pw.y = cvt_pk_bf16(pa.z, pa.w); pw.z = cvt_pk_bf16(pb.x, pb.y); pw.w = cvt_pk_bf16(pb.z, pb.w);
        const bf16x8 pf = __builtin_bit_cast(bf16x8, pw);
        const int ra = 16 * fa + 4 * g4 + q4, rb = 16 * fb + 4 * g4 + q4;
#pragma unroll
        for (int df = 0; df < 8; ++df) {
            const s16x4 t1 = vtr(ldsV + voff(ra, 2 * df + (p4 >> 1)) + 8 * (p4 & 1)), t2 = vtr(ldsV + voff(rb, 2 * df + (p4 >> 1)) + 8 * (p4 & 1));
            const bf16x8 vf = {t1[0], t1[1], t1[2], t1[3], t2[0], t2[1], t2[2], t2[3]};
            O[df] = __builtin_amdgcn_mfma_f32_16x16x32_bf16(vf, pf, O[df], 0, 0, 0);
        }
    }
    const float inv = 1.0f / ls;
    const long qrow = d.orow0 + (long)(16 * w + l15) * d.ostride;
    bf16* op = d.Op + qrow * d.opitch + 4 * g4;
#pragma unroll
    for (int df = 0; df < 8; ++df) { const f32x4 o = O[df] * inv; v2u wv; wv.x = cvt_pk_bf16(o.x, o.y); wv.y = cvt_pk_bf16(o.z, o.w); *(v2u*)(op + 16 * df) = wv; }
    if (MODE == 0 && g4 == 0) d.lsep[qrow * 12] = (mx + fast_log2(ls)) * LN2;
}
__device__ __forceinline__ void glds16(const void* gsrc, unsigned lds_dst) { unsigned keep;
    asm volatile("s_mov_b32 %0, m0\n\ts_mov_b32 m0, %2\n\ts_nop 0\n\tglobal_load_lds_dwordx4 %1, off\n\ts_mov_b32 m0, %0" : "=&s"(keep) : "v"(gsrc), "s"(lds_dst) : "memory"); }
__device__ __forceinline__ void attn_dma(const Frame& F, const AttnDesc& d, const bool isV) {
    const bf16* P = isV ? d.Vp : d.Kp;
    const unsigned base = (unsigned)__builtin_amdgcn_readfirstlane((int)(unsigned)(size_t)(F.lds + RING_OFF) + (isV ? 65536 : 0) + F.wave * 8192);
    if (d.kmin != 0 && F.wave < 4) return;
    const int slot = F.lane & 15, rsub = F.lane >> 4;
#pragma unroll
    for (int i = 0; i < 8; ++i) { const int row = 32 * F.wave + 4 * i + rsub, ch = isV ? (slot ^ ((row & 7) << 1)) : (slot ^ (row & 15));
        const bf16* gp = P + (d.krow0 + (long)row * d.kstride) * d.kpitch + ch * 8;
        glds16(gp, base + i * 1024); }
}
__device__ __forceinline__ void attn_loadq(const Frame& F, const AttnDesc& d, bf16x8 (&qf)[4]) {
    const long qrow = d.qrow0 + (long)(16 * F.wave + (F.lane & 15)) * d.qstride;
#pragma unroll
    for (int s = 0; s < 4; ++s) qf[s] = *(const bf16x8*)(d.Qp + qrow * d.qpitch + 32 * s + 8 * (F.lane >> 4));
}
#define ATT_BAR() do { asm volatile("s_waitcnt lgkmcnt(0)" ::: "memory"); __builtin_amdgcn_s_barrier(); asm volatile("" ::: "memory"); } while (0)
template <int MODE, int NU> __device__ __forceinline__ void attn_batch(const Frame& F, int id0) {
    AttnDesc d = attn_desc<MODE>(F, id0);
    bf16x8 qn[4], qc[4];
    attn_dma(F, d, false); attn_loadq(F, d, qn);
#pragma unroll
    for (int s = 0; s < 4; ++s) qc[s] = qn[s];
    attn_dma(F, d, true);
#pragma unroll 1
    for (int u = 0; u < NU; ++u) {
        asm volatile("s_waitcnt vmcnt(8)" ::: "memory"); ATT_BAR();
        f32x4 S[MODE == 0 ? 9 : 16]; float mx, ls;
        attn_scores<MODE>(F, d, qc, S, mx, ls);
        asm volatile("s_waitcnt vmcnt(0)" ::: "memory"); ATT_BAR();
        const bool more = u + 1 < NU;
        const AttnDesc dn = attn_desc<MODE>(F, id0 + (more ? u + 1 : u));
        if (more) { attn_dma(F, dn, false); if (MODE == 0) attn_loadq(F, dn, qn); }
        attn_pv<MODE>(F, d, S, mx, ls);
        ATT_BAR();
        if (more) {
            if (MODE != 0) attn_loadq(F, dn, qn);
#pragma unroll
            for (int s = 0; s < 4; ++s) qc[s] = qn[s];
            asm volatile("" : "+v"(qc[0]), "+v"(qc[1]), "+v"(qc[2]), "+v"(qc[3]));
            attn_dma(F, dn, true); }
        d = dn;
    }
    asm volatile("s_waitcnt vmcnt(0)" ::: "memory");
}
__device__ __forceinline__ void p4_sample_attn(const Frame& F, int wt, const float* c0, const float* c1, const float* c2, const float* cm) {
    unsigned char* ws = F.ws; const int lane = F.lane, sub = lane & 15, t = lane >> 4;
    const int db = wt >> 4, h = (wt >> 2) & 3, src = wt & 3;
    const int row = MP + db * 4 + t;
    const bf16* qp = src < 3 ? (const bf16*)(ws + WS_QS) + (size_t)row * 1536 + src * 512 + h * 128 + 8 * sub : (const bf16*)(ws + WS_MQ) + (size_t)row * 512 + h * 128 + 8 * sub;
    float q[8]; { const v4u qw = *(const v4u*)qp; q[0] = bflo(qw.x); q[1] = bfhi(qw.x); q[2] = bflo(qw.y); q[3] = bfhi(qw.y); q[4] = bflo(qw.z); q[5] = bfhi(qw.z); q[6] = bflo(qw.w); q[7] = bfhi(qw.w); }
    float mx = -3.0e38f, ls = 0.f, o[8];
#pragma unroll
    for (int j = 0; j < 8; ++j) o[j] = 0.f;
#define SA_STEP(K0, K1, V0, V1) do { float s_ = (q[0] * K0.x + q[1] * K0.y) + (q[2] * K0.z + q[3] * K0.w) + (q[4] * K1.x + q[5] * K1.y) + (q[6] * K1.z + q[7] * K1.w); \
        s_ += __shfl_xor(s_, 1); s_ += __shfl_xor(s_, 2); s_ += __shfl_xor(s_, 4); s_ += __shfl_xor(s_, 8); \
        const float mn_ = fmaxf(mx, s_), sc_ = fast_exp2(mx - mn_), p_ = fast_exp2(s_ - mn_); mx = mn_; ls = ls * sc_ + p_; \
        o[0] = o[0] * sc_ + p_ * V0.x; o[1] = o[1] * sc_ + p_ * V0.y; o[2] = o[2] * sc_ + p_ * V0.z; o[3] = o[3] * sc_ + p_ * V0.w; \
        o[4] = o[4] * sc_ + p_ * V1.x; o[5] = o[5] * sc_ + p_ * V1.y; o[6] = o[6] * sc_ + p_ * V1.z; o[7] = o[7] * sc_ + p_ * V1.w; } while (0)
    int nstart = 0, NK; const float* cache; int L = 256, dil = 1;
    if (src == 3) { cache = cm; NK = 256; }
    else { cache = src == 0 ? c0 : (src == 1 ? c1 : c2); L = 128 << (2 * src); dil = src == 0 ? 1 : (src == 1 ? 4 : 16); NK = 129; nstart = 4;
        for (int n = 0; n < 4; ++n) {
            const int idx = L + t - dil * n; f32x4 k0, k1, v0, v1;
            if (idx >= L) { const size_t ro = (size_t)(MP + db * 4 + (idx - L)) * 1536 + src * 512 + h * 128 + 8 * sub;
                const v4u kw = *(const v4u*)((const bf16*)(ws + WS_KS) + ro), vw = *(const v4u*)((const bf16*)(ws + WS_VS) + ro);
                k0 = (f32x4){bflo(kw.x), bfhi(kw.x), bflo(kw.y), bfhi(kw.y)}; k1 = (f32x4){bflo(kw.z), bfhi(kw.z), bflo(kw.w), bfhi(kw.w)};
                v0 = (f32x4){bflo(vw.x), bfhi(vw.x), bflo(vw.y), bfhi(vw.y)}; v1 = (f32x4){bflo(vw.z), bfhi(vw.z), bflo(vw.w), bfhi(vw.w)};
            } else { const float* kp = cache + (((size_t)db * L + idx) * 2) * 512 + h * 128 + 8 * sub;
                k0 = *(const f32x4*)kp; k1 = *(const f32x4*)(kp + 4); v0 = *(const f32x4*)(kp + 512); v1 = *(const f32x4*)(kp + 516); }
            SA_STEP(k0, k1, v0, v1);
        }
    }
    const float* kbase = cache + ((size_t)db * L * 2) * 512 + h * 128 + 8 * sub;
    const long kstep = src == 3 ? 1024 : -(long)dil * 1024; const long kfirst = src == 3 ? 0 : (long)(L + t) * 1024;
    int n = nstart;
    for (; n + 4 <= NK; n += 4) {
        f32x4 kk[4][2], vv[4][2];
#pragma unroll
        for (int j = 0; j < 4; ++j) { const float* kp = kbase + kfirst + (long)(n + j) * kstep; kk[j][0] = *(const f32x4*)kp; kk[j][1] = *(const f32x4*)(kp + 4); vv[j][0] = *(const f32x4*)(kp + 512); vv[j][1] = *(const f32x4*)(kp + 516); }
#pragma unroll
        for (int j = 0; j < 4; ++j) SA_STEP(kk[j][0], kk[j][1], vv[j][0], vv[j][1]);
    }
    for (; n < NK; ++n) { const float* kp = kbase + kfirst + (long)n * kstep; const f32x4 k0 = *(const f32x4*)kp, k1 = *(const f32x4*)(kp + 4), v0 = *(const f32x4*)(kp + 512), v1 = *(const f32x4*)(kp + 516); SA_STEP(k0, k1, v0, v1); }
#undef SA_STEP
    const float inv = 1.0f / ls;
    v4u w; w.x = cvt_pk_bf16(o[0] * inv, o[1] * inv); w.y = cvt_pk_bf16(o[2] * inv, o[3] * inv); w.z = cvt_pk_bf16(o[4] * inv, o[5] * inv); w.w = cvt_pk_bf16(o[6] * inv, o[7] * inv);
    if (src < 3) { *(v4u*)((bf16*)(ws + WS_OG) + (size_t)row * 1536 + src * 512 + h * 128 + 8 * sub) = w; if (sub == 0) ((float*)(ws + WS_LSE))[(size_t)row * 12 + src * 4 + h] = (mx + fast_log2(ls)) * LN2; }
    else *(v4u*)((bf16*)(ws + WS_OALL) + (size_t)row * 1536 + 1024 + h * 128 + 8 * sub) = w;
}
__device__ __forceinline__ void p4_sample_attn_shared(const Frame& F, int db, int h, const bool is_mem, const float* cache) {
    unsigned char* ws = F.ws; const int lane = F.lane, sub = lane & 15, gk = lane >> 4; const int rowq0 = MP + db * 4;
    float qv[4][8];
#pragma unroll
    for (int t = 0; t < 4; ++t) { const bf16* qp = is_mem ? (const bf16*)(ws + WS_MQ) + (size_t)(rowq0 + t) * 512 + h * 128 + 8 * sub : (const bf16*)(ws + WS_QS) + (size_t)(rowq0 + t) * 1536 + h * 128 + 8 * sub;
        const v4u qw = *(const v4u*)qp; qv[t][0] = bflo(qw.x); qv[t][1] = bfhi(qw.x); qv[t][2] = bflo(qw.y); qv[t][3] = bfhi(qw.y); qv[t][4] = bflo(qw.z); qv[t][5] = bfhi(qw.z); qv[t][6] = bflo(qw.w); qv[t][7] = bfhi(qw.w); }
    float m[4], l[4], o[4][8];
#pragma unroll
    for (int t = 0; t < 4; ++t) { m[t] = -3.0e38f; l[t] = 0.f;
#pragma unroll
        for (int j = 0; j < 8; ++j) o[t][j] = 0.f; }
#define SS_STEP(P, K0, K1, V0, V1) do { _Pragma("unroll") for (int t = 0; t < 4; ++t) { \
        float s_ = (qv[t][0] * K0.x + qv[t][1] * K0.y) + (qv[t][2] * K0.z + qv[t][3] * K0.w) + (qv[t][4] * K1.x + qv[t][5] * K1.y) + (qv[t][6] * K1.z + qv[t][7] * K1.w); \
        s_ += __shfl_xor(s_, 1); s_ += __shfl_xor(s_, 2); s_ += __shfl_xor(s_, 4); s_ += __shfl_xor(s_, 8); \
        const bool ok_ = is_mem || ((P) >= t && (P) <= 128 + t); \
        const float mn_ = ok_ ? fmaxf(m[t], s_) : m[t], sc_ = fast_exp2(m[t] - mn_), p_ = ok_ ? fast_exp2(s_ - mn_) : 0.f; m[t] = mn_; l[t] = l[t] * sc_ + p_; \
        o[t][0] = o[t][0] * sc_ + p_ * V0.x; o[t][1] = o[t][1] * sc_ + p_ * V0.y; o[t][2] = o[t][2] * sc_ + p_ * V0.z; o[t][3] = o[t][3] * sc_ + p_ * V0.w; \
        o[t][4] = o[t][4] * sc_ + p_ * V1.x; o[t][5] = o[t][5] * sc_ + p_ * V1.y; o[t][6] = o[t][6] * sc_ + p_ * V1.z; o[t][7] = o[t][7] * sc_ + p_ * V1.w; } } while (0)
    const int L = is_mem ? 256 : 128;
    const float* kbase = cache + ((size_t)db * L * 2) * 512 + h * 128 + 8 * sub + (size_t)gk * 1024;
    for (int j = 0; j < L / 4; j += 4) {
        f32x4 kk[4][2], vv[4][2];
#pragma unroll
        for (int e = 0; e < 4; ++e) { const float* kp = kbase + (size_t)(j + e) * 4096; kk[e][0] = *(const f32x4*)kp; kk[e][1] = *(const f32x4*)(kp + 4); vv[e][0] = *(const f32x4*)(kp + 512); vv[e][1] = *(const f32x4*)(kp + 516); }
#pragma unroll
        for (int e = 0; e < 4; ++e) SS_STEP(4 * (j + e) + gk, kk[e][0], kk[e][1], vv[e][0], vv[e][1]);
    }
    if (!is_mem) {
        const size_t ro = (size_t)(rowq0 + gk) * 1536 + h * 128 + 8 * sub;
        const v4u kw = *(const v4u*)((const bf16*)(ws + WS_KS) + ro), vw = *(const v4u*)((const bf16*)(ws + WS_VS) + ro);
        const f32x4 k0 = {bflo(kw.x), bfhi(kw.x), bflo(kw.y), bfhi(kw.y)}, k1 = {bflo(kw.z), bfhi(kw.z), bflo(kw.w), bfhi(kw.w)};
        const f32x4 v0 = {bflo(vw.x), bfhi(vw.x), bflo(vw.y), bfhi(vw.y)}, v1 = {bflo(vw.z), bfhi(vw.z), bflo(vw.w), bfhi(vw.w)};
        SS_STEP(128 + gk, k0, k1, v0, v1);
    }
#undef SS_STEP
    float mo = 0.f, lo = 1.f, oo[8];
#pragma unroll
    for (int j = 0; j < 8; ++j) oo[j] = 0.f;
#pragma unroll
    for (int t = 0; t < 4; ++t) {
        float mm = fmaxf(m[t], __shfl_xor(m[t], 16)); mm = fmaxf(mm, __shfl_xor(mm, 32));
        const float f = fast_exp2(m[t] - mm); float lt = l[t] * f; lt += __shfl_xor(lt, 16); lt += __shfl_xor(lt, 32);
        if (gk == t) { mo = mm; lo = lt; }
#pragma unroll
        for (int j = 0; j < 8; ++j) { float x = o[t][j] * f; x += __shfl_xor(x, 16); x += __shfl_xor(x, 32); if (gk == t) oo[j] = x; }
    }
    const float inv = 1.0f / lo; const int row = rowq0 + gk;
    v4u w; w.x = cvt_pk_bf16(oo[0] * inv, oo[1] * inv); w.y = cvt_pk_bf16(oo[2] * inv, oo[3] * inv); w.z = cvt_pk_bf16(oo[4] * inv, oo[5] * inv); w.w = cvt_pk_bf16(oo[6] * inv, oo[7] * inv);
    if (is_mem) *(v4u*)((bf16*)(ws + WS_OALL) + (size_t)row * 1536 + 1024 + h * 128 + 8 * sub) = w;
    else { *(v4u*)((bf16*)(ws + WS_OG) + (size_t)row * 1536 + h * 128 + 8 * sub) = w; if (sub == 0) ((float*)(ws + WS_LSE))[(size_t)row * 12 + h] = (mo + fast_log2(lo)) * LN2; }
}
__device__ __forceinline__ void p4_sample_task(const Frame& F, int it, const float* c0, const float* c1, const float* c2, const float* cm) {
    const int kind = it >> 9, idx = it & 511, db = idx >> 2, h = idx & 3;
    if (kind == 0) p4_sample_attn(F, db * 16 + h * 4 + 2, c0, c1, c2, cm);
    else if (kind == 1) p4_sample_attn(F, db * 16 + h * 4 + 1, c0, c1, c2, cm);
    else if (kind == 2) p4_sample_attn_shared(F, db, h, true, cm);
    else p4_sample_attn_shared(F, db, h, false, c0);
}
__device__ __forceinline__ void p4_sample_loop(const Frame& F, const float* c0, const float* c1, const float* c2, const float* cm, int q = 0) {
    gu32* qw = (gu32*)(F.ws + WS_CTL) + 64 + 64 * q;
    for (;;) { unsigned v = 0; if (F.lane == 0) v = __hip_atomic_fetch_add(qw, 1u, RLX_AGENT); const int it = (int)__builtin_amdgcn_readfirstlane(v);
        if (it >= 2048) break; p4_sample_task(F, it, c0, c1, c2, cm); }
}
__device__ __forceinline__ void p4_gla_chain(const Frame& F, int row0, int T, int h, const float* S0, float* Sout) {
    unsigned char* ws = F.ws; const int tid = F.tid, v = tid & 127, ks = __builtin_amdgcn_readfirstlane(tid >> 7);
    const float* GA = (const float*)(ws + WS_GA); const bf16* GQ = (const bf16*)(ws + WS_GQ); const bf16* GK = (const bf16*)(ws + WS_GK); const bf16* GV = (const bf16*)(ws + WS_GV); bf16* GO = (bf16*)(ws + WS_GO);
    LAS float* part = (LAS float*)(F.lds + RING_OFF);
    float S[16];
#pragma unroll
    for (int i = 0; i < 16; ++i) S[i] = S0 ? S0[(size_t)(16 * ks + i) * 128 + v] : 0.f;
    for (int t0 = 0; t0 < T; t0 += 16) {
        const int nb = (T - t0) < 16 ? (T - t0) : 16;
        __syncthreads();
        for (int tt = 0; tt < nb; ++tt) {
            const size_t row = (size_t)(row0 + t0 + tt);
            const float* ap = GA + row * 256 + h * 64 + 16 * ks; const v4u kw0 = *(const v4u*)(GK + row * 256 + h * 64 + 16 * ks), kw1 = *(const v4u*)(GK + row * 256 + h * 64 + 16 * ks + 8);
            const v4u qw0 = *(const v4u*)(GQ + row * 256 + h * 64 + 16 * ks), qw1 = *(const v4u*)(GQ + row * 256 + h * 64 + 16 * ks + 8);
            const float vv = bf2f(GV[row * 512 + h * 128 + v]);
            const f32x4 a0 = *(const f32x4*)ap, a1 = *(const f32x4*)(ap + 4), a2 = *(const f32x4*)(ap + 8), a3 = *(const f32x4*)(ap + 12);
            const float la[16] = {a0.x, a0.y, a0.z, a0.w, a1.x, a1.y, a1.z, a1.w, a2.x, a2.y, a2.z, a2.w, a3.x, a3.y, a3.z, a3.w};
            const float kk[16] = {bflo(kw0.x), bfhi(kw0.x), bflo(kw0.y), bfhi(kw0.y), bflo(kw0.z), bfhi(kw0.z), bflo(kw0.w), bfhi(kw0.w), bflo(kw1.x), bfhi(kw1.x), bflo(kw1.y), bfhi(kw1.y), bflo(kw1.z), bfhi(kw1.z), bflo(kw1.w), bfhi(kw1.w)};
            const float qq[16] = {bflo(qw0.x), bfhi(qw0.x), bflo(qw0.y), bfhi(qw0.y), bflo(qw0.z), bfhi(qw0.z), bflo(qw0.w), bfhi(qw0.w), bflo(qw1.x), bfhi(qw1.x), bflo(qw1.y), bfhi(qw1.y), bflo(qw1.z), bfhi(qw1.z), bflo(qw1.w), bfhi(qw1.w)};
            float o = 0.f;
#pragma unroll
            for (int i = 0; i < 16; ++i) { S[i] = fast_exp2(la[i] * 1.4426950408889634f) * S[i] + kk[i] * vv; o += qq[i] * S[i]; }
            part[(tt * 4 + ks) * 128 + v] = o;
        }
        __syncthreads();
        for (int e = tid; e < nb * 128; e += 512) { const int tt = e >> 7, vv_ = e & 127;
            GO[(size_t)(row0 + t0 + tt) * 512 + h * 128 + vv_] = (bf16)f2bf((part[(tt * 4 + 0) * 128 + vv_] + part[(tt * 4 + 1) * 128 + vv_]) + (part[(tt * 4 + 2) * 128 + vv_] + part[(tt * 4 + 3) * 128 + vv_])); }
    }
#pragma unroll
    for (int i = 0; i < 16; ++i) Sout[(size_t)(16 * ks + i) * 128 + v] = S[i];
}
constexpr int GL_QE = 0, GL_KE = 8192, GL_KDT = 16384, GL_VV = 24576, GL_EB = 40960, GL_TOT = 41216, GL_SET = 43264;
__device__ __forceinline__ int goff(int r, int c) { return 128 * r + 16 * (c ^ ((r >> 1) & 7)); }
__device__ __forceinline__ int gvoff(int row, int ch) { return 256 * row + 16 * (ch ^ (((row & 3) | ((((row >> 2) ^ (row >> 3)) & 1) << 2)) << 1)); }
__device__ __forceinline__ void p4_gla_chain_mfma(const Frame& F, int c) {
    unsigned char* ws = F.ws; const int tid = F.tid, lane = F.lane, w = F.wave, l15 = lane & 15, g4 = lane >> 4, q4 = l15 >> 2, p4 = lane & 3;
    const int b = c >> 2, h = c & 3; const size_t row0 = (size_t)b * SEQ;
    const float* GA = (const float*)(ws + WS_GA) + h * 64 + lane; const bf16* GQ = (const bf16*)(ws + WS_GQ) + h * 64 + lane; const bf16* GK = (const bf16*)(ws + WS_GK) + h * 64 + lane;
    const bf16* GV = (const bf16*)(ws + WS_GV) + h * 128 + (tid & 15) * 8; bf16* GO = (bf16*)(ws + WS_GO) + h * 128 + 16 * w + 4 * g4;
    constexpr float L2E = 1.4426950408889634f;
    f32x4 S[4];
#pragma unroll
    for (int K = 0; K < 4; ++K) S[K] = (f32x4){0.f, 0.f, 0.f, 0.f};
    float la[8]; unsigned short qh[8], kh[8]; v4u vr[2];
#define GLA_LOAD(ch) do { const size_t r_ = row0 + 64 * (size_t)(ch); \
        _Pragma("unroll") for (int t = 0; t < 8; ++t) { const size_t rr_ = (r_ + 8 * w + t) * 256; la[t] = GA[rr_]; qh[t] = GQ[rr_]; kh[t] = GK[rr_]; } \
        _Pragma("unroll") for (int e = 0; e < 2; ++e) vr[e] = *(const v4u*)(GV + (r_ + (tid >> 4) + 32 * e) * 512); } while (0)
    GLA_LOAD(0);
#pragma unroll 1
    for (int ch = 0; ch < SEQ / 64; ++ch) {
        LAS unsigned char* B = F.lds + RING_OFF + (ch & 1) * GL_SET;
        LAS float* TOT = (LAS float*)(B + GL_TOT); LAS float* EB = (LAS float*)(B + GL_EB);
        float cs[8], qv[8], kvv[8];
        cs[0] = la[0];
#pragma unroll
        for (int t = 1; t < 8; ++t) cs[t] = cs[t - 1] + la[t];
#pragma unroll
        for (int t = 0; t < 8; ++t) { qv[t] = bf2f(qh[t]); kvv[t] = bf2f(kh[t]); }
        TOT[w * 64 + lane] = cs[7];
#pragma unroll
        for (int e = 0; e < 2; ++e) *(LAS v4u*)(B + GL_VV + gvoff((tid >> 4) + 32 * e, tid & 15)) = vr[e];
        __syncthreads();
        float offs = 0.f, total = 0.f;
#pragma unroll
        for (int g = 0; g < 8; ++g) { const float tg = TOT[g * 64 + lane]; total += tg; offs += (g < w) ? tg : 0.f; }
        unsigned kd[8];
#pragma unroll
        for (int t = 0; t < 8; ++t) { const float bt = offs + cs[t]; const int i = 8 * w + t;
            const float e1 = fast_exp2(bt * L2E), e2 = fast_exp2(-bt * L2E), e3 = fast_exp2((total - bt) * L2E);
            *(LAS unsigned short*)(B + GL_QE + goff(i, lane >> 3) + 2 * (lane & 7)) = (unsigned short)f2bf(qv[t] * e1);
            *(LAS unsigned short*)(B + GL_KE + goff(i, lane >> 3) + 2 * (lane & 7)) = (unsigned short)f2bf(kvv[t] * e2);
            kd[t] = f2bf(kvv[t] * e3); }
        { v4u kw; kw.x = kd[0] | (kd[1] << 16); kw.y = kd[2] | (kd[3] << 16); kw.z = kd[4] | (kd[5] << 16); kw.w = kd[6] | (kd[7] << 16); *(LAS v4u*)(B + GL_KDT + goff(lane, w)) = kw; }
        if (w == 0) EB[lane] = fast_exp2(total * L2E);
        if (ch + 1 < SEQ / 64) GLA_LOAD(ch + 1);
        __syncthreads();
        const LAS unsigned char* QE = B + GL_QE; const LAS unsigned char* KE = B + GL_KE; const LAS unsigned char* KDT = B + GL_KDT; const LAS unsigned char* VV = B + GL_VV;
        bf16x8 kef[4][2];
#pragma unroll
        for (int J = 0; J < 4; ++J)
#pragma unroll
            for (int s = 0; s < 2; ++s) kef[J][s] = *(const LAS bf16x8*)(KE + goff(16 * J + l15, 4 * s + g4));
        bf16x8 vpr[2], vnat[2];
#pragma unroll
        for (int pp = 0; pp < 2; ++pp) { const int ra = 32 * pp + 4 * g4 + q4, rb = ra + 16;
            const s16x4 t1 = vtr(VV + gvoff(ra, 2 * w + (p4 >> 1)) + 8 * (p4 & 1)), t2 = vtr(VV + gvoff(rb, 2 * w + (p4 >> 1)) + 8 * (p4 & 1));
            vpr[pp] = (bf16x8){t1[0], t1[1], t1[2], t1[3], t2[0], t2[1], t2[2], t2[3]}; }
#pragma unroll
        for (int s = 0; s < 2; ++s) { const int r1 = 32 * s + 8 * g4 + q4, r2 = r1 + 4;
            const s16x4 t1 = vtr(VV + gvoff(r1, 2 * w + (p4 >> 1)) + 8 * (p4 & 1)), t2 = vtr(VV + gvoff(r2, 2 * w + (p4 >> 1)) + 8 * (p4 & 1));
            vnat[s] = (bf16x8){t1[0], t1[1], t1[2], t1[3], t2[0], t2[1], t2[2], t2[3]}; }
        bf16x8 sfr[2];
#pragma unroll
        for (int p = 0; p < 2; ++p) { v4u sw; sw.x = cvt_pk_bf16(S[2 * p].x, S[2 * p].y); sw.y = cvt_pk_bf16(S[2 * p].z, S[2 * p].w); sw.z = cvt_pk_bf16(S[2 * p + 1].x, S[2 * p + 1].y); sw.w = cvt_pk_bf16(S[2 * p + 1].z, S[2 * p + 1].w); sfr[p] = __builtin_bit_cast(bf16x8, sw); }
#pragma unroll
        for (int I = 0; I < 4; ++I) {
            f32x4 oT = (f32x4){0.f, 0.f, 0.f, 0.f};
#pragma unroll
            for (int p = 0; p < 2; ++p) {
                const v2u lo = *(const LAS v2u*)(QE + goff(16 * I + l15, 4 * p + (g4 >> 1)) + 8 * (g4 & 1)), hi = *(const LAS v2u*)(QE + goff(16 * I + l15, 4 * p + 2 + (g4 >> 1)) + 8 * (g4 & 1));
                const v4u bw = {lo.x, lo.y, hi.x, hi.y};
                oT = __builtin_amdgcn_mfma_f32_16x16x32_bf16(sfr[p], __builtin_bit_cast(bf16x8, bw), oT, 0, 0, 0); }
            bf16x8 qef[2];
#pragma unroll
            for (int s = 0; s < 2; ++s) qef[s] = *(const LAS bf16x8*)(QE + goff(16 * I + l15, 4 * s + g4));
            f32x4 d1[4];
#pragma unroll
            for (int J = 0; J < 4; ++J) { d1[J] = (f32x4){0.f, 0.f, 0.f, 0.f};
                if (J <= I) {
#pragma unroll
                    for (int s = 0; s < 2; ++s) d1[J] = __builtin_amdgcn_mfma_f32_16x16x32_bf16(kef[J][s], qef[s], d1[J], 0, 0, 0);
                    if (J == I) {
#pragma unroll
                        for (int r = 0; r < 4; ++r) d1[J][r] = (4 * g4 + r <= l15) ? d1[J][r] : 0.f; } } }
#pragma unroll
            for (int pp = 0; pp < 2; ++pp) if (2 * pp <= I) {
                const f32x4 pa = d1[2 * pp], pb = d1[2 * pp + 1];
                v4u pw; pw.x = cvt_pk_bf16(pa.x, pa.y); pw.y = cvt_pk_bf16(pa.z, pa.w); pw.z = cvt_pk_bf16(pb.x, pb.y); pw.w = cvt_pk_bf16(pb.z, pb.w);
                oT = __builtin_amdgcn_mfma_f32_16x16x32_bf16(vpr[pp], __builtin_bit_cast(bf16x8, pw), oT, 0, 0, 0); }
            { v2u ow; ow.x = cvt_pk_bf16(oT.x, oT.y); ow.y = cvt_pk_bf16(oT.z, oT.w); *(v2u*)(GO + (row0 + 64 * (size_t)ch + 16 * I + l15) * 512) = ow; }
        }
#pragma unroll
        for (int K = 0; K < 4; ++K) {
            const f32x4 ebv = *(const LAS f32x4*)(EB + 16 * K + 4 * g4); S[K] *= ebv;
#pragma unroll
            for (int s = 0; s < 2; ++s) { const bf16x8 kdf = *(const LAS bf16x8*)(KDT + goff(16 * K + l15, 4 * s + g4)); S[K] = __builtin_amdgcn_mfma_f32_16x16x32_bf16(kdf, vnat[s], S[K], 0, 0, 0); } }
    }
#undef GLA_LOAD
    float* so = F.out + O_GLAP + (size_t)c * 64 * 128 + 16 * w + l15;
#pragma unroll
    for (int K = 0; K < 4; ++K)
#pragma unroll
        for (int r = 0; r < 4; ++r) so[(size_t)(16 * K + 4 * g4 + r) * 128] = S[K][r];
}
template <int NR> __device__ __forceinline__ void p5_combine_rows(const Frame& F, int row0, int rstride) {
    unsigned char* ws = F.ws; const int lane = F.lane, hh = lane >> 4, sub = lane & 15, col = hh * 128 + 8 * sub;
    float l0[NR], l1[NR], l2[NR]; v4u a[NR], b[NR], c[NR], gow[NR], gr[NR];
    const float* gg = F.i15 + 8 * sub; const f32x4 g0 = *(const f32x4*)gg, g1 = *(const f32x4*)(gg + 4);
#pragma unroll
    for (int r = 0; r < NR; ++r) { const int row = row0 + r * rstride;
        const float* lse = (const float*)(ws + WS_LSE) + (size_t)row * 12; l0[r] = lse[hh]; l1[r] = lse[4 + hh]; l2[r] = lse[8 + hh];
        const bf16* og = (const bf16*)(ws + WS_OG) + (size_t)row * 1536 + col; a[r] = *(const v4u*)og; b[r] = *(const v4u*)(og + 512); c[r] = *(const v4u*)(og + 1024);
        gow[r] = *(const v4u*)((const bf16*)(ws + WS_GO) + (size_t)row * 512 + col); gr[r] = *(const v4u*)((const bf16*)(ws + WS_GRS) + (size_t)row * 512 + col); }
#pragma unroll
    for (int r = 0; r < NR; ++r) { const int row = row0 + r * rstride;
        const float mx = fmaxf(l0[r], fmaxf(l1[r], l2[r]));
        float w0 = __expf(l0[r] - mx), w1 = __expf(l1[r] - mx), w2 = __expf(l2[r] - mx); const float wi = 1.0f / (w0 + w1 + w2); w0 *= wi; w1 *= wi; w2 *= wi;
        v4u o;
        o.x = cvt_pk_bf16(w0 * bflo(a[r].x) + w1 * bflo(b[r].x) + w2 * bflo(c[r].x), w0 * bfhi(a[r].x) + w1 * bfhi(b[r].x) + w2 * bfhi(c[r].x));
        o.y = cvt_pk_bf16(w0 * bflo(a[r].y) + w1 * bflo(b[r].y) + w2 * bflo(c[r].y), w0 * bfhi(a[r].y) + w1 * bfhi(b[r].y) + w2 * bfhi(c[r].y));
        o.z = cvt_pk_bf16(w0 * bflo(a[r].z) + w1 * bflo(b[r].z) + w2 * bflo(c[r].z), w0 * bfhi(a[r].z) + w1 * bfhi(b[r].z) + w2 * bfhi(c[r].z));
        o.w = cvt_pk_bf16(w0 * bflo(a[r].w) + w1 * bflo(b[r].w) + w2 * bflo(c[r].w), w0 * bfhi(a[r].w) + w1 * bfhi(b[r].w) + w2 * bfhi(c[r].w));
        bf16* oall = (bf16*)(ws + WS_OALL) + (size_t)row * 1536;
        *(v4u*)(oall + col) = o;
        const f32x4 x0 = {bflo(gow[r].x), bfhi(gow[r].x), bflo(gow[r].y), bfhi(gow[r].y)}, x1 = {bflo(gow[r].z), bfhi(gow[r].z), bflo(gow[r].w), bfhi(gow[r].w)};
        float ss = (x0.x * x0.x + x0.y * x0.y) + (x0.z * x0.z + x0.w * x0.w) + (x1.x * x1.x + x1.y * x1.y) + (x1.z * x1.z + x1.w * x1.w);
        ss += __shfl_xor(ss, 1); ss += __shfl_xor(ss, 2); ss += __shfl_xor(ss, 4); ss += __shfl_xor(ss, 8);
        const float rstd = 1.0f / sqrtf(ss * (1.f / 128.f) + EPS);
        v4u y;
        y.x = cvt_pk_bf16(x0.x * rstd * g0.x * bflo(gr[r].x), x0.y * rstd * g0.y * bfhi(gr[r].x)); y.y = cvt_pk_bf16(x0.z * rstd * g0.z * bflo(gr[r].y), x0.w * rstd * g0.w * bfhi(gr[r].y));
        y.z = cvt_pk_bf16(x1.x * rstd * g1.x * bflo(gr[r].z), x1.y * rstd * g1.y * bfhi(gr[r].z)); y.w = cvt_pk_bf16(x1.z * rstd * g1.z * bflo(gr[r].w), x1.w * rstd * g1.w * bfhi(gr[r].w));
        *(v4u*)(oall + 512 + col) = y; }
}
template <int NR> __device__ __forceinline__ void p10_final_rows(const Frame& F, int row0, int rstride) {
    const GAS f32x4* gr = (const GAS f32x4*)F.i24 + 2 * F.lane; const f32x4 g00 = gr[0], g01 = gr[1], g10 = gr[128], g11 = gr[129];
    v4u v[NR][2];
#pragma unroll
    for (int r = 0; r < NR; ++r) { const GAS v4u* xr = (const GAS v4u*)((const bf16*)(F.ws + WS_Y16) + (size_t)(row0 + r * rstride) * D) + F.lane; v[r][0] = xr[0]; v[r][1] = xr[64]; }
#pragma unroll
    for (int r = 0; r < NR; ++r) { float x[2][8]; float s = 0.f;
#pragma unroll
        for (int j = 0; j < 2; ++j) { x[j][0] = bflo(v[r][j].x); x[j][1] = bfhi(v[r][j].x); x[j][2] = bflo(v[r][j].y); x[j][3] = bfhi(v[r][j].y); x[j][4] = bflo(v[r][j].z); x[j][5] = bfhi(v[r][j].z); x[j][6] = bflo(v[r][j].w); x[j][7] = bfhi(v[r][j].w);
#pragma unroll
            for (int e = 0; e < 8; ++e) s += x[j][e] * x[j][e]; }
        const float rstd = 1.0f / sqrtf(wave_sum(s) * (1.f / D) + EPS);
        GAS f32x4* yr = (GAS f32x4*)(F.out + (size_t)(row0 + r * rstride) * D) + 2 * F.lane;
        yr[0] = (f32x4){x[0][0] * rstd * g00.x, x[0][1] * rstd * g00.y, x[0][2] * rstd * g00.z, x[0][3] * rstd * g00.w};
        yr[1] = (f32x4){x[0][4] * rstd * g01.x, x[0][5] * rstd * g01.y, x[0][6] * rstd * g01.z, x[0][7] * rstd * g01.w};
        yr[128] = (f32x4){x[1][0] * rstd * g10.x, x[1][1] * rstd * g10.y, x[1][2] * rstd * g10.z, x[1][3] * rstd * g10.w};
        yr[129] = (f32x4){x[1][4] * rstd * g11.x, x[1][5] * rstd * g11.y, x[1][6] * rstd * g11.z, x[1][7] * rstd * g11.w}; }
}
__device__ __forceinline__ void phase1(Frame& F) {
    unsigned char* ws = F.ws; const int G = F.G, bx = (int)blockIdx.x;
    { pg8::Gemm g{(const bf16*)(ws + WS_XB), (const bf16*)(ws + WS_W1A), MR, 2 * FF, D, D, D}; typedef pg8::StaticOrderT<MR / 256, 2 * FF / 256> SO; SO S; S.init(MR, 2 * FF, G, bx);
      EpiSwiglu E{(bf16*)(ws + WS_G), nullptr}; pg8::gemm_phase<EpiSwiglu, SO>(F.lds + RING_OFF, g, S, E, F.wave, MK_STAGGER_A); }
    { pg8::Gemm g{(const bf16*)(ws + WS_MEMB), (const bf16*)(ws + WS_WMEM), MM, D, D, D, D}; typedef pg8::StaticOrderT<MM / 256, D / 256> SO; SO S; S.init(MM, D, G, (bx + G / 2) % G);
      EpiMemKV E{F.out + O_MEMKV, (bf16*)(ws + WS_MKV)}; pg8::gemm_phase<EpiMemKV, SO>(F.lds + RING_OFF, g, S, E, F.wave); }
}
__device__ __forceinline__ void phase2(Frame& F) {
    unsigned char* ws = F.ws; const int G = F.G, bx = (int)blockIdx.x;
    pg8::Gemm g{(const bf16*)(ws + WS_G), (const bf16*)(ws + WS_W1O), MR, D, FF, 64, FF};   typedef pg8::StaticOrderT<MR / 256, D / 256> SO; SO S; S.init(MR, D, G, bx);
    EpiResidX<true> E{F.i0, F.i1, (bf16*)(ws + WS_HB), (float*)(ws + WS_PQ1), 0.5f};
    S.lim = 1024; S.rev = 1; pg8::gemm_phase<EpiResidX<true>, SO, true, true>(F.lds + RING_OFF, g, S, E, F.wave);
    tail_phase<EpiResidX<true>, true>(F, g.A, 64, g.Bt, FF, FF, E, 0);
}
__device__ __forceinline__ void phase3(Frame& F) {
    unsigned char* ws = F.ws; const int G = F.G, bx = (int)blockIdx.x;
    pg8::Gemm g{(const bf16*)(ws + WS_HB), (const bf16*)(ws + WS_WIN), MR, NZ, D, D, D}; typedef pg8::StaticOrderT<MR / 256, NZ / 256> SO; SO S; S.init(MR, NZ, G, bx);
    EpiZ E{(const float*)(ws + WS_PQ1), (const float*)(ws + WS_ROPE), (const float*)(ws + WS_ROPE) + NPOS * 64, F.i14, F.out,
           (bf16*)(ws + WS_QS), (bf16*)(ws + WS_KS), (bf16*)(ws + WS_VS), (bf16*)(ws + WS_GQ), (bf16*)(ws + WS_GK), (bf16*)(ws + WS_GV), (bf16*)(ws + WS_GRS), (bf16*)(ws + WS_MQ), (bf16*)(ws + WS_GATE), (float*)(ws + WS_GA)};
    pg8::gemm_phase<EpiZ, SO>(F.lds + RING_OFF, g, S, E, F.wave, MK_STAGGER_Z);
}
constexpr int CW_Q = 64;
__device__ __forceinline__ int q_pull(const Frame& F, int q) {
    gu32* qw = (gu32*)(F.ws + WS_CTL) + CW_Q + 64 * q;
    volatile LAS unsigned* slot = (volatile LAS unsigned*)(F.lds + MISC_OFF) + 16;
    __syncthreads();
    if (F.tid == 0) *slot = __hip_atomic_fetch_add(qw, 1u, RLX_AGENT);
    __syncthreads();
    return (int)*slot;
}
__device__ __forceinline__ void phase4(Frame& F, const float* c0, const float* c1, const float* c2, const float* cm) {
    const int bx = (int)blockIdx.x;
    if (bx < NB * 4) p4_gla_chain_mfma(F, bx);
#pragma unroll 1
    for (int rep = 0; rep < (MK_P4_REPEAT == 2 ? 2 : 1); ++rep) for (;;) { const int it = q_pull(F, 1 + 4 * rep); if (it >= 768) break; attn_batch<0, 8>(F, 8 * (767 - it)); }
#pragma unroll 1
    for (int rep = 0; rep < (MK_P4_REPEAT == 3 ? 2 : 1); ++rep) for (;;) { const int it = q_pull(F, 2 + 4 * rep); if (it >= 256) break; attn_batch<1, 8>(F, 6144 + 8 * (255 - it)); }
    p4_sample_loop(F, c0, c1, c2, cm);
    if (MK_P4_REPEAT == 1) { __syncthreads(); p4_sample_loop(F, c0, c1, c2, cm, 4); }
    if (MK_P4_REPEAT == 4) { __syncthreads(); if (bx < NB * 4) p4_gla_chain_mfma(F, bx); }
    if (MK_P4_REPEAT == 5) { for (;;) { const int c = q_pull(F, 7); if (c >= DECB * 4) break; p4_gla_chain(F, MP + (c >> 2) * DECT, DECT, c & 3, F.i7 + (size_t)c * 64 * 128, F.out + O_GLAS + (size_t)c * 64 * 128); } }
    for (;;) { const int c = q_pull(F, 3); if (c >= DECB * 4) break; p4_gla_chain(F, MP + (c >> 2) * DECT, DECT, c & 3, F.i7 + (size_t)c * 64 * 128, F.out + O_GLAS + (size_t)c * 64 * 128); }
    if (F.G < NB * 4) { for (int c = F.G + bx; c < NB * 4; c += F.G) p4_gla_chain_mfma(F, c); }
}
__device__ __forceinline__ void phase5(Frame& F) {
    { const int st = F.G * NWAVES; int m = F.vcu * NWAVES + F.wave;
      for (; m + 3 * st < MR; m += 4 * st) p5_combine_rows<4>(F, m, st);
      for (; m < MR; m += st) p5_combine_rows<1>(F, m, st); }
}
__device__ __forceinline__ void phase6(Frame& F) {
    unsigned char* ws = F.ws; const int G = F.G, bx = (int)blockIdx.x;
    pg8::Gemm g{(const bf16*)(ws + WS_OALL), (const bf16*)(ws + WS_WBR), MR, D, 1536, 1536, 1536}; typedef pg8::StaticOrderT<MR / 256, D / 256> SO; SO S; S.init(MR, D, G, bx);
    S.lim = 1024; S.rev = 1; EpiMerge1 E{(const bf16*)(ws + WS_GATE), (bf16*)(ws + WS_MB)}; pg8::gemm_phase<EpiMerge1, SO>(F.lds + RING_OFF, g, S, E, F.wave);
    tail_phase_merge(F, g.A, g.Bt, E, 3);
}
__device__ __forceinline__ void phase7(Frame& F) {
    unsigned char* ws = F.ws; const int G = F.G, bx = (int)blockIdx.x;
    pg8::Gemm g{(const bf16*)(ws + WS_MB), (const bf16*)(ws + WS_WOUT), MR, D, D, D, D}; typedef pg8::StaticOrderT<MR / 256, D / 256> SO; SO S; S.init(MR, D, G, bx);
    EpiResidB<true> E{(const bf16*)(ws + WS_HB), (bf16*)(ws + WS_HB), (float*)(ws + WS_PQ2), 1.0f};
    S.lim = 1024; pg8::gemm_phase<EpiResidB<true>, SO>(F.lds + RING_OFF, g, S, E, F.wave);
    tail_phase<EpiResidB<true>>(F, g.A, D, g.Bt, D, D, E, 1);
}
__device__ __forceinline__ void phase8(Frame& F) {
    unsigned char* ws = F.ws; const int G = F.G, bx = (int)blockIdx.x;
    pg8::Gemm g{(const bf16*)(ws + WS_HB), (const bf16*)(ws + WS_W2A), MR, 2 * FF, D, D, D}; typedef pg8::StaticOrderT<MR / 256, 2 * FF / 256> SO; SO S; S.init(MR, 2 * FF, G, bx);
    EpiSwiglu E{(bf16*)(ws + WS_G), (const float*)(ws + WS_PQ2)}; pg8::gemm_phase<EpiSwiglu, SO>(F.lds + RING_OFF, g, S, E, F.wave, MK_STAGGER_A);
}
__device__ __forceinline__ void phase9(Frame& F) {
    unsigned char* ws = F.ws; const int G = F.G, bx = (int)blockIdx.x;
    pg8::Gemm g{(const bf16*)(ws + WS_G), (const bf16*)(ws + WS_W2O), MR, D, FF, 64, FF};   typedef pg8::StaticOrderT<MR / 256, D / 256> SO; SO S; S.init(MR, D, G, bx);
    EpiResidB<false> E{(const bf16*)(ws + WS_HB), (bf16*)(ws + WS_Y16), nullptr, 0.5f};
    S.lim = 1024; S.rev = 1; pg8::gemm_phase<EpiResidB<false>, SO, true, true>(F.lds + RING_OFF, g, S, E, F.wave);
    tail_phase<EpiResidB<false>, true>(F, g.A, 64, g.Bt, FF, FF, E, 2);
}
__device__ __forceinline__ void phase10(Frame& F) {
    { const int st = F.G * NWAVES; int m = F.vcu * NWAVES + F.wave;
      for (; m + 3 * st < MR; m += 4 * st) p10_final_rows<4>(F, m, st);
      for (; m < MR; m += st) p10_final_rows<1>(F, m, st); }
}
__device__ __forceinline__ void xcd_barrier_or_skip(const XcdBarrier& b, bool on, int wave) { if (on) xcd_barrier(b, wave); }
constexpr int N_PHASES = 11;
__global__ void __launch_bounds__(NWAVES * 64, 2) mk_fwd(Args args) {
    extern __shared__ __attribute__((aligned(16))) unsigned char lds[];
    Frame F;
    F.lds = (LAS unsigned char*)lds;
    F.wave = __builtin_amdgcn_readfirstlane((int)(threadIdx.x >> 6)); F.lane = lane_id(); F.tid = F.wave * 64 + F.lane;
    F.G = gridDim.x; { const int bx = blockIdx.x; F.vcu = (F.G % 8 == 0) ? (bx % 8) * (F.G / 8) + bx / 8 : bx; }
    F.i0 = args.in[0]; F.i1 = args.in[1]; F.i2 = args.in[2]; F.i3 = args.in[3]; F.i4 = args.in[4]; F.i5 = args.in[5]; F.i6 = args.in[6]; F.i7 = args.in[7]; F.i8 = args.in[8]; F.i9 = args.in[9]; F.i10 = args.in[10]; F.i11 = args.in[11]; F.i12 = args.in[12]; F.i13 = args.in[13]; F.i14 = args.in[14]; F.i15 = args.in[15]; F.i16 = args.in[16]; F.i17 = args.in[17]; F.i18 = args.in[18]; F.i19 = args.in[19]; F.i20 = args.in[20]; F.i21 = args.in[21]; F.i22 = args.in[22]; F.i23 = args.in[23]; F.i24 = args.in[24];
    F.out = args.out; F.ws = args.ws;
    unsigned char* ws = args.ws; gu32* ctl = (gu32*)(ws + WS_CTL);
    volatile LAS unsigned* MISC = (volatile LAS unsigned*)(F.lds + MISC_OFF);
    for (int u = F.tid; u < (LDS_BYTES - LDSCTL_OFF) / 4; u += NWAVES * 64) ((LAS unsigned*)(F.lds + LDSCTL_OFF))[u] = 0u;
    __syncthreads();
    XcdBarrier bar; bar.bar = (unsigned*)(ctl + CW_BAR); bar.x = 0; bar.st = nullptr;
    if (MK_N_LAUNCHES == 1) bar = xcd_barrier_post((unsigned*)(ctl + CW_BAR), MISC + 8, F.wave);
    const int lo = args.ph_lo, hi = args.ph_hi;
#define IN(k) (lo <= (k) && (k) < hi && (k) <= MK_STOP_AFTER)
#define GRID_BAR(k) do { if (IN((k) + 1)) xcd_barrier(bar, F.wave); } while (0)

#define RUN(k, call) do { if (IN(k)) { F.lane = lane_id(); F.tid = F.wave * 64 + F.lane; call; if (MK_REPEAT_PHASE == (k)) { xcd_barrier_or_skip(bar, MK_N_LAUNCHES == 1, F.wave); call; } GRID_BAR(k); } } while (0)
    RUN(0, p0_prologue(F));
    RUN(1, phase1(F));
    RUN(2, phase2(F));
    RUN(3, phase3(F));
    RUN(4, phase4(F, args.in[3], args.in[4], args.in[5], args.in[6]));
    RUN(5, phase5(F));
    RUN(6, phase6(F));
    RUN(7, phase7(F));
    RUN(8, phase8(F));
    RUN(9, phase9(F));
    if (IN(10)) { F.lane = lane_id(); F.tid = F.wave * 64 + F.lane; phase10(F); }
#undef RUN
#if MK_STOP_AFTER < 10
    if (hi == N_PHASES) {
        for (int m = F.vcu * NWAVES + F.wave; m < MR; m += G * NWAVES) {
            for (int c = F.lane; c < D; c += 64) {
                float v;
                if (MK_STOP_AFTER == 0) v = bf2f(((const bf16*)(ws + WS_WIN))[(size_t)(m % NZ) * D + c]);
                else if (MK_STOP_AFTER == 3) { const bf16* gt = (const bf16*)(ws + WS_GATE) + (size_t)m * 3072; v = bf2f(gt[c]) + bf2f(gt[1024 + c]) + bf2f(gt[2048 + c]); }
                else if (MK_STOP_AFTER <= 5) { const bf16* oa = (const bf16*)(ws + WS_OALL) + (size_t)m * 1536; v = bf2f(oa[c]) + bf2f(oa[1024 + (c & 511)]); }
                else if (MK_STOP_AFTER == 6) v = bf2f(((const bf16*)(ws + WS_MB))[(size_t)m * D + c]);
                else if (MK_STOP_AFTER == 7) v = ((const float*)(ws + WS_H))[(size_t)m * D + c];
                else v = bf2f(((const bf16*)(ws + WS_G))[(size_t)m * FF + c]) + bf2f(((const bf16*)(ws + WS_G))[(size_t)m * FF + 1792 + c]);
                F.out[(size_t)m * D + c] = v;
            }
        }
    }
#endif
#undef IN
#undef GRID_BAR
}

extern "C" void kernel_launch(void* const* d_in, const int* in_sizes, int n_in, void* d_out, int out_size, void* d_ws, size_t ws_size, hipStream_t stream) {
    static int grid = 0;
    if (grid == 0) {
        if (n_in != 25 || (size_t)out_size != O_END || ws_size < WS_END2) { fprintf(stderr, "kernel_launch: unexpected shapes: n_in %d out %d ws %zu (need %zu); nothing launched\n", n_in, out_size, ws_size, (size_t)WS_END2); grid = -1; return; }
        int dev = 0, cus = 0, per_cu = 0;
        if (hipGetDevice(&dev) != hipSuccess || hipDeviceGetAttribute(&cus, hipDeviceAttributeMultiprocessorCount, dev) != hipSuccess) { grid = -1; return; }
        if (hipFuncSetAttribute((const void*)mk_fwd, hipFuncAttributeMaxDynamicSharedMemorySize, LDS_BYTES) != hipSuccess) { fprintf(stderr, "kernel_launch: hipFuncSetAttribute failed\n"); grid = -1; return; }
        if (hipOccupancyMaxActiveBlocksPerMultiprocessor(&per_cu, (const void*)mk_fwd, NWAVES * 64, LDS_BYTES) != hipSuccess || per_cu < 1) fprintf(stderr, "kernel_launch: occupancy query reports %d\n", per_cu);
        (void)hipGetLastError();
        grid = cus;
    }
    if (grid < 0) return;
    if (hipMemsetAsync((char*)d_ws + WS_CTL, 0, CTL_ZERO_BYTES, stream) != hipSuccess) return;
    Args a{};
    for (int i = 0; i < 25; ++i) a.in[i] = (const float*)d_in[i];
    a.out = (float*)d_out; a.ws = (unsigned char*)d_ws; a.pad = 0;
    for (int li = 0; li < MK_N_LAUNCHES; ++li) {
        a.ph_lo = (MK_N_LAUNCHES == 1) ? 0 : li; a.ph_hi = (MK_N_LAUNCHES == 1) ? N_PHASES : li + 1; a.li = li;
        hipLaunchKernelGGL(mk_fwd, dim3(grid), dim3(NWAVES * 64), LDS_BYTES, stream, a);
        const hipError_t le = hipPeekAtLastError();
        if (le != hipSuccess) { fprintf(stderr, "kernel_launch: launch %d failed: %s\n", li, hipGetErrorName(le)); break; }
    }
}
```
